# Optimizing an MI355X kernel written in HIP

```python
import math
import jax, jax.numpy as jnp
from jax import lax
import numpy as np

D_MODEL = 1024
BATCH = 1
SEQ = 16384
DEPTH = 2

ATT_GROUPS = ((128, 1), (512, 4), (2048, 16))
ATT_HEADS_PER_GROUP = 4
ATT_HEAD_DIM = 64
ATT_HEADS = len(ATT_GROUPS) * ATT_HEADS_PER_GROUP
ATT_WIDTH = ATT_HEADS * ATT_HEAD_DIM
ATT_OUT_WIDTH = ATT_HEADS_PER_GROUP * ATT_HEAD_DIM
BAND_BLOCK = 64
ROPE_THETA = 10000.0
DN_HEADS = 6
DN_HEAD_DIM = 128
DN_WIDTH = DN_HEADS * DN_HEAD_DIM
DN_CONV = 5
DN_CHUNK = 64
FFN_DIM = ((8 * D_MODEL // 3 + 127) // 128) * 128
IN_SIZES = (ATT_WIDTH, ATT_WIDTH, ATT_WIDTH, 3 * DN_WIDTH, DN_WIDTH, 2 * DN_HEADS, 2 * DN_HEADS, D_MODEL, D_MODEL)
N_IN = sum(IN_SIZES)
N_SUBLAYERS = 3
EPS = 1e-6
NEG_INF = -1e30

kernel_name = 'hybrid_dilated_attn_gated_deltanet_macaron_block'


def rmsnorm(t, gain):
    t32 = t.astype(jnp.float32)
    y = t32 * lax.rsqrt(jnp.mean(t32 * t32, axis=-1, keepdims=True) + EPS)
    return (y * gain.astype(jnp.float32)).astype(t.dtype)


def ada_pre(t, gain, shift, scale):
    return rmsnorm(t, gain) * (1.0 + scale[:, None, :]) + shift[:, None, :]


def swiglu(h, w_in, w_out):
    gu = h @ w_in
    g, u = jnp.split(gu, 2, axis=-1)
    return (jax.nn.silu(g) * u) @ w_out


def rotary(t, positions):
    e = t.shape[-1]
    half = e // 2
    inv = ROPE_THETA ** (-jnp.arange(half, dtype=jnp.float32) * 2.0 / e)
    ang = positions.astype(jnp.float32)[:, :, None] * inv
    cos = jnp.cos(ang)[:, :, None, :]
    sin = jnp.sin(ang)[:, :, None, :]
    t32 = t.astype(jnp.float32)
    t1, t2 = t32[..., :half], t32[..., half:]
    return jnp.concatenate([t1 * cos - t2 * sin, t2 * cos + t1 * sin], axis=-1).astype(t.dtype)


def dilated_window_attention(q, k, v, window, dilation):
    B, S, H, E = q.shape
    radius = window // (2 * dilation)
    L = S // dilation
    nb = -(-L // BAND_BLOCK)
    pad = nb * BAND_BLOCK - L

    def to_classes(t):
        return t.reshape(B, L, dilation, H, E).transpose(0, 2, 3, 1, 4)

    qb = jnp.pad(to_classes(q), ((0, 0), (0, 0), (0, 0), (0, pad), (0, 0)))
    qb = qb.reshape(B, dilation, H, nb, BAND_BLOCK, E)

    def key_windows(t):
        tp = jnp.pad(to_classes(t), ((0, 0), (0, 0), (0, 0), (BAND_BLOCK, pad + BAND_BLOCK), (0, 0)))
        tp = tp.reshape(B, dilation, H, nb + 2, BAND_BLOCK, E)
        return jnp.concatenate([tp[:, :, :, :-2], tp[:, :, :, 1:-1], tp[:, :, :, 2:]], axis=-2)

    kw = key_windows(k)
    vw = key_windows(v)
    scores = jnp.einsum('bdhnqe,bdhnke->bdhnqk', qb, kw, preferred_element_type=jnp.float32) * (E ** -0.5)
    qi = jnp.arange(BAND_BLOCK)[:, None]
    kj = jnp.arange(3 * BAND_BLOCK)[None, :] - BAND_BLOCK
    kpos = jnp.arange(nb)[:, None, None] * BAND_BLOCK + kj
    valid = (jnp.abs(kj - qi) <= radius) & (kpos >= 0) & (kpos < L)
    scores = jnp.where(valid, scores, NEG_INF)
    m = jnp.max(scores, axis=-1, keepdims=True)
    p = jnp.exp(scores - m)
    den = jnp.sum(p, axis=-1, keepdims=True)
    o = jnp.einsum('bdhnqk,bdhnke->bdhnqe', p, vw.astype(jnp.float32)) / den
    lse = (m + jnp.log(den))[..., 0]
    o = o.reshape(B, dilation, H, nb * BAND_BLOCK, E)[:, :, :, :L]
    o = o.transpose(0, 3, 1, 2, 4).reshape(B, S, H, E)
    lse = lse.reshape(B, dilation, H, nb * BAND_BLOCK)[..., :L]
    lse = lse.transpose(0, 3, 1, 2).reshape(B, S, H)
    return o, lse


def short_conv(t, w):
    C = t.shape[-1]
    pad = w.shape[0] // 2
    return lax.conv_general_dilated(t, w[:, None, :].astype(t.dtype), window_strides=(1,),
                                    padding=[(pad, pad)], dimension_numbers=('NWC', 'WIO', 'NWC'),
                                    feature_group_count=C)


def l2norm(t):
    return t * lax.rsqrt(jnp.sum(t * t, axis=-1, keepdims=True) + EPS)


def gated_delta_chunked(q, k, v, beta, g):
    B, H, S, DK = q.shape
    DV = v.shape[-1]
    C = DN_CHUNK
    N = S // C
    q = q.reshape(B, H, N, C, DK)
    k = k.reshape(B, H, N, C, DK)
    v = v.reshape(B, H, N, C, DV)
    beta = beta.reshape(B, H, N, C)
    G = jnp.cumsum(g.reshape(B, H, N, C), axis=-1)
    incl = jnp.tril(jnp.ones((C, C), dtype=bool))
    strict = jnp.tril(jnp.ones((C, C), dtype=bool), -1)
    decay = jnp.exp(jnp.where(incl, G[..., :, None] - G[..., None, :], NEG_INF))
    kb = k * beta[..., None]
    m_low = jnp.where(strict, jnp.einsum('bhnid,bhnjd->bhnij', kb, k) * decay, 0.0)
    tmat = m_low + jnp.eye(C, dtype=jnp.float32)
    rhs = jnp.concatenate([v * beta[..., None], kb * jnp.exp(G)[..., None]], axis=-1)
    sol = lax.linalg.triangular_solve(tmat, rhs, left_side=True, lower=True, unit_diagonal=True)
    u, w = sol[..., :DV], sol[..., DV:]
    attn = jnp.einsum('bhnid,bhnjd->bhnij', q, k) * decay
    qg = q * jnp.exp(G)[..., None]
    kdec = k * jnp.exp(G[..., -1:] - G)[..., None]
    glast = jnp.exp(G[..., -1])

    def step(state, inp):
        u_c, w_c, attn_c, qg_c, kdec_c, gl_c = inp
        v_new = u_c - jnp.einsum('bhcd,bhde->bhce', w_c, state)
        o_c = jnp.einsum('bhcd,bhde->bhce', qg_c, state) + jnp.einsum('bhij,bhje->bhie', attn_c, v_new)
        state = state * gl_c[..., None, None] + jnp.einsum('bhcd,bhce->bhde', kdec_c, v_new)
        return state, o_c

    xs = tuple(jnp.moveaxis(t, 2, 0) for t in (u, w, attn, qg, kdec, glast))
    _, o = lax.scan(step, jnp.zeros((B, H, DK, DV), jnp.float32), xs)
    return jnp.moveaxis(o, 0, 2).reshape(B, H, S, DV)


def hybrid_mixer(h, positions, w_in, conv_w, a_log, dt_bias, dn_norm_w, w_branch_att, w_branch_dn, w_out):
    B, S, _ = h.shape
    proj = h @ w_in
    split_idx = [int(i) for i in np.cumsum(IN_SIZES)[:-1]]
    q_a, k_a, v_a, dn_qkv, z, beta_raw, alpha_raw, gate_att, gate_dn = jnp.split(proj, split_idx, axis=-1)

    def att_heads(t):
        return t.reshape(B, S, ATT_HEADS, ATT_HEAD_DIM)
    q_a = rotary(att_heads(q_a), positions)
    k_a = rotary(att_heads(k_a), positions)
    v_a = att_heads(v_a)
    outs, lses = [], []
    for gi, (window, dilation) in enumerate(ATT_GROUPS):
        sl = slice(gi * ATT_HEADS_PER_GROUP, (gi + 1) * ATT_HEADS_PER_GROUP)
        o_g, lse_g = dilated_window_attention(q_a[:, :, sl], k_a[:, :, sl], v_a[:, :, sl], window, dilation)
        outs.append(o_g)
        lses.append(lse_g)
    mix = jax.nn.softmax(jnp.stack(lses, axis=0), axis=0)
    o_att = jnp.sum(mix[..., None] * jnp.stack(outs, axis=0), axis=0)
    o_att = o_att.reshape(B, S, ATT_OUT_WIDTH).astype(h.dtype)

    dn = jax.nn.silu(short_conv(dn_qkv, conv_w))
    q_d, k_d, v_d = jnp.split(dn, 3, axis=-1)

    def dn_heads(t):
        return t.reshape(B, S, DN_HEADS, DN_HEAD_DIM).transpose(0, 2, 1, 3).astype(jnp.float32)
    q_d = l2norm(dn_heads(q_d)) * (DN_HEAD_DIM ** -0.5)
    k_d = l2norm(dn_heads(k_d))
    v_d = dn_heads(v_d)
    beta = jax.nn.sigmoid(beta_raw.astype(jnp.float32)).reshape(B, S, 2, DN_HEADS).transpose(2, 0, 3, 1)
    alpha = alpha_raw.astype(jnp.float32).reshape(B, S, 2, DN_HEADS).transpose(2, 0, 3, 1)
    log_decay = -jnp.exp(a_log.astype(jnp.float32))[:, None, :, None] * jax.nn.softplus(
        alpha + dt_bias.astype(jnp.float32)[:, None, :, None])
    o_fwd = gated_delta_chunked(q_d, k_d, v_d, beta[0], log_decay[0])
    rev = lambda t: jnp.flip(t, axis=2)
    o_bwd = rev(gated_delta_chunked(rev(q_d), rev(k_d), rev(v_d), rev(beta[1]), rev(log_decay[1])))
    o_dn = (o_fwd + o_bwd).transpose(0, 2, 1, 3)
    o_dn = o_dn * lax.rsqrt(jnp.mean(o_dn * o_dn, axis=-1, keepdims=True) + EPS) * dn_norm_w.astype(jnp.float32)
    o_dn = o_dn * jax.nn.silu(z.astype(jnp.float32).reshape(B, S, DN_HEADS, DN_HEAD_DIM))
    o_dn = o_dn.reshape(B, S, DN_WIDTH).astype(h.dtype)

    y = jax.nn.sigmoid(gate_att) * (o_att @ w_branch_att) + jax.nn.sigmoid(gate_dn) * (o_dn @ w_branch_dn)
    return y @ w_out


def setup_inputs(seed: int = 0) -> dict:
    key = jax.random.key(seed)
    ks = jax.random.split(key, 20)
    f32 = jnp.float32
    D = D_MODEL
    x = jax.random.normal(ks[0], (BATCH, SEQ, D), f32)
    c = jax.random.normal(ks[1], (BATCH, D), f32)
    offset = jax.random.randint(ks[2], (BATCH, 1), 0, 4096, dtype=jnp.int32)
    positions = (offset + jnp.arange(SEQ, dtype=jnp.int32)[None, :]).astype(jnp.int32)
    w_ada = jax.random.normal(ks[3], (DEPTH, D, 3 * N_SUBLAYERS * D), f32) * (0.5 * D ** -0.5)
    b_ada = jax.random.normal(ks[4], (DEPTH, 3 * N_SUBLAYERS * D), f32) * 0.02
    norm_pre = 1.0 + 0.02 * jax.random.normal(ks[5], (DEPTH, N_SUBLAYERS, D), f32)
    norm_post = 1.0 + 0.02 * jax.random.normal(ks[6], (DEPTH, N_SUBLAYERS, D), f32)
    ffn_w_in = jax.random.normal(ks[7], (DEPTH, 2, D, 2 * FFN_DIM), f32) * D ** -0.5
    ffn_w_out = jax.random.normal(ks[8], (DEPTH, 2, FFN_DIM, D), f32) * FFN_DIM ** -0.5
    w_in = jax.random.normal(ks[9], (DEPTH, D, N_IN), f32) * D ** -0.5
    conv_w = jax.random.normal(ks[10], (DEPTH, DN_CONV, 3 * DN_WIDTH), f32) * DN_CONV ** -0.5
    a_log = jnp.log(jax.random.uniform(ks[11], (DEPTH, 2, DN_HEADS), f32, 1.0, 16.0))
    dt = jnp.exp(jax.random.uniform(ks[12], (DEPTH, 2, DN_HEADS), f32, math.log(1e-3), math.log(1e-1)))
    dt_bias = dt + jnp.log(-jnp.expm1(-dt))
    dn_norm_w = 1.0 + 0.02 * jax.random.normal(ks[13], (DEPTH, DN_HEAD_DIM), f32)
    w_branch_att = jax.random.normal(ks[14], (DEPTH, ATT_OUT_WIDTH, D), f32) * ATT_OUT_WIDTH ** -0.5
    w_branch_dn = jax.random.normal(ks[15], (DEPTH, DN_WIDTH, D), f32) * DN_WIDTH ** -0.5
    w_out = jax.random.normal(ks[16], (DEPTH, D, D), f32) * D ** -0.5
    return {'x': x, 'c': c, 'positions': positions, 'w_ada': w_ada, 'b_ada': b_ada,
            'norm_pre': norm_pre, 'norm_post': norm_post, 'ffn_w_in': ffn_w_in, 'ffn_w_out': ffn_w_out,
            'w_in': w_in, 'conv_w': conv_w, 'a_log': a_log, 'dt_bias': dt_bias, 'dn_norm_w': dn_norm_w,
            'w_branch_att': w_branch_att, 'w_branch_dn': w_branch_dn, 'w_out': w_out}


def reference(x, c, positions, w_ada, b_ada, norm_pre, norm_post, ffn_w_in, ffn_w_out, w_in, conv_w,
              a_log, dt_bias, dn_norm_w, w_branch_att, w_branch_dn, w_out):
    B = x.shape[0]
    for l in range(DEPTH):
        mod = (jax.nn.silu(c) @ w_ada[l] + b_ada[l]).reshape(B, N_SUBLAYERS, 3, D_MODEL)
        shift, scale, gate = mod[:, :, 0], mod[:, :, 1], mod[:, :, 2]
        h = ada_pre(x, norm_pre[l, 0], shift[:, 0], scale[:, 0])
        y = swiglu(h, ffn_w_in[l, 0], ffn_w_out[l, 0])
        x = x + 0.5 * gate[:, 0, None, :] * rmsnorm(y, norm_post[l, 0])
        h = ada_pre(x, norm_pre[l, 1], shift[:, 1], scale[:, 1])
        y = hybrid_mixer(h, positions, w_in[l], conv_w[l], a_log[l], dt_bias[l], dn_norm_w[l],
                         w_branch_att[l], w_branch_dn[l], w_out[l])
        x = x + gate[:, 1, None, :] * rmsnorm(y, norm_post[l, 1])
        h = ada_pre(x, norm_pre[l, 2], shift[:, 2], scale[:, 2])
        y = swiglu(h, ffn_w_in[l, 1], ffn_w_out[l, 1])
        x = x + 0.5 * gate[:, 2, None, :] * rmsnorm(y, norm_post[l, 2])
    return x
```

```cpp
#include <hip/hip_runtime.h>
#include <cstdio>
#include <cstdint>
namespace pg8 {
#define PG8_LAS __attribute__((address_space(3)))
typedef unsigned short bf16_t;
typedef short bf16x8 __attribute__((ext_vector_type(8)));
typedef float f32x4 __attribute__((ext_vector_type(4)));
typedef unsigned u32x4 __attribute__((ext_vector_type(4)));
constexpr int BM = 256, BK = 64, HALF = 128, HTB = HALF * BK * 2  , STAGE_BYTES = 8 * HTB, NXCD = 8, WGM = 8;

__host__ __device__ __forceinline__ int lds_byte(int r, int c) { const int st = (r >> 4) * 2 + (c >> 5), rr = r & 15, cc = c & 31, ob = rr * 64 + cc * 2; return st * 1024 + (ob ^ (((ob >> 9) & 1) << 5)); }
__host__ __device__ __forceinline__ void stage_rc(int b, int& R, int& C) { const int st = b / 1024, sb = b % 1024, swz = sb ^ (((sb >> 9) & 1) << 5); R = (st >> 1) * 16 + swz / 64; C = (st & 1) * 32 + (swz % 64) / 2; }
__host__ __device__ __forceinline__ int perm32(int rho) { const int n = rho >> 4, i = rho & 15; return 8 * (i >> 2) + 4 * n + (i & 3); }

struct Unit { int pm, pn; };
struct Gemm { const bf16_t* A; const bf16_t* Bt; int M, N, K, pad_; };

struct StaticOrder {
    int nM, nN, nwg, G, c;
    __host__ __device__ void init(int M, int N, int G_, int c_) { nM = M / BM; nN = N / BM; nwg = nM * nN; G = G_; c = c_; }
    __host__ __device__ bool next(int i, Unit& u) const {
        const long L = (long)i * G + c; if (L >= nwg) return false;
        int wgid = (int)L; { const int q = nwg / NXCD, r = nwg % NXCD, xcd = wgid % NXCD, off = wgid / NXCD; wgid = (xcd < r ? xcd * (q + 1) : r * (q + 1) + (xcd - r) * q) + off; }
        const int nig = WGM * nN, gid = wgid / nig, fm = gid * WGM, gsz = (nM - fm) < WGM ? (nM - fm) : WGM;
        u.pm = fm + ((wgid % nig) % gsz); u.pn = (wgid % nig) / gsz; return true;
    }
    __device__ __forceinline__ void a_ready(const Unit&) const {}
    __device__ __forceinline__ void done(const Unit&) const {}
};

__device__ __forceinline__ unsigned cvt_pk_bf16(float lo, float hi) { unsigned r; asm volatile("v_cvt_pk_bf16_f32 %0, %1, %2" : "=v"(r) : "v"(lo), "v"(hi)); return r; }
typedef float f32x2 __attribute__((ext_vector_type(2)));
__device__ __forceinline__ f32x2 gelu_pk(f32x2 v) {
    const f32x2 av = __builtin_elementwise_abs(v), d = av * 0.2316418882f + 1.0f;
    f32x2 t; t.x = __builtin_amdgcn_rcpf(d.x); t.y = __builtin_amdgcn_rcpf(d.y);
    f32x2 q = t * 0.5307027145f + (-0.7265760135f); q = q * t + 0.7107068705f; q = q * t + (-0.142248368f); q = q * t + 0.127414796f; q = q * t;
    const f32x2 s = (v * v) * (-0.72134752044f);
    f32x2 e; e.x = __builtin_amdgcn_exp2f(s.x); e.y = __builtin_amdgcn_exp2f(s.y);
    const f32x2 m = v * (q * e), r = v - m;
    f32x2 o; o.x = v.x < 0.f ? m.x : r.x; o.y = v.y < 0.f ? m.y : r.y; return o;
}

template <int ACT  > struct EpiBf16 {
    static constexpr bool PERM = true, AFTER_DRAIN = false; static_assert(ACT == 0 || ACT == 1, "EpiBf16: ACT is 0 (none) or 1 (gelu_pk)");
    bf16_t* O; int ldc; const float* bias; int split_cols; size_t split_stride; float scale0;
    __device__ __forceinline__ void operator()(const f32x4 (&acc)[2][2][4][2], const Unit& u, int wr, int wc, int fr, int fq) const {
        const int row0 = u.pm * BM + wr * 64 + fr; int colt = u.pn * BM; bf16_t* base = O;
        float sc = 1.f; if (split_cols) { const int t = colt / split_cols; base += (size_t)t * split_stride; colt -= t * split_cols; if (t == 0) sc = scale0; }
        const int col0 = colt + wc * 32 + 8 * fq, bcol0 = u.pn * BM + wc * 32 + 8 * fq;
        f32x4 bv[2][2];
#pragma unroll
        for (int bj = 0; bj < 2; ++bj)
#pragma unroll
            for (int n = 0; n < 2; ++n) bv[bj][n] = bias ? *(const f32x4*)(bias + bcol0 + bj * HALF + 4 * n) : (f32x4){0.f, 0.f, 0.f, 0.f};
#pragma unroll
        for (int ai = 0; ai < 2; ++ai)
#pragma unroll
            for (int m = 0; m < 4; ++m) { bf16_t* rowp = base + (size_t)(row0 + ai * HALF + m * 16) * ldc + col0;
#pragma unroll
                for (int bj = 0; bj < 2; ++bj) { f32x4 v0 = acc[ai][bj][m][0] + bv[bj][0], v1 = acc[ai][bj][m][1] + bv[bj][1];
                    if (ACT == 1) { f32x2 a = gelu_pk((f32x2){v0[0], v0[1]}), b = gelu_pk((f32x2){v0[2], v0[3]}), c = gelu_pk((f32x2){v1[0], v1[1]}), d = gelu_pk((f32x2){v1[2], v1[3]});
                        v0 = (f32x4){a.x, a.y, b.x, b.y}; v1 = (f32x4){c.x, c.y, d.x, d.y}; }
                    v0 = v0 * sc; v1 = v1 * sc; u32x4 w; w.x = cvt_pk_bf16(v0[0], v0[1]); w.y = cvt_pk_bf16(v0[2], v0[3]); w.z = cvt_pk_bf16(v1[0], v1[1]); w.w = cvt_pk_bf16(v1[2], v1[3]);
                    *(u32x4*)(rowp + bj * HALF) = w; } }
    }
};

struct PanelStats {
    unsigned* xbuf;
    unsigned* cnt;
    unsigned* tmo;
    int ntn; float eps;
    unsigned code;
    __device__ __forceinline__ bool run(const f32x4 (&v)[2][2][4][2], const Unit& u, int wr, int wc, int fr, int fq, PG8_LAS unsigned char* lds, int wid, int lane) const {
        typedef float f32x2v __attribute__((ext_vector_type(2)));
        PG8_LAS f32x2v* P = (PG8_LAS f32x2v*)lds;
        PG8_LAS f32x2v* S = (PG8_LAS f32x2v*)(lds + 8192);
        PG8_LAS unsigned* flag = (PG8_LAS unsigned*)(lds + 8192 + 2048);
#pragma unroll
        for (int ai = 0; ai < 2; ++ai)
#pragma unroll
            for (int m = 0; m < 4; ++m) {
                float s = 0.f;
#pragma unroll
                for (int bj = 0; bj < 2; ++bj)
#pragma unroll
                    for (int n = 0; n < 2; ++n) { const f32x4 x = v[ai][bj][m][n]; s += (x[0] + x[1]) + (x[2] + x[3]); }
                s += __shfl_xor(s, 16); s += __shfl_xor(s, 32);
                const float mw = s * (1.0f / 64.0f); float q = 0.f;
#pragma unroll
                for (int bj = 0; bj < 2; ++bj)
#pragma unroll
                    for (int n = 0; n < 2; ++n) { const f32x4 d = v[ai][bj][m][n] - mw; q += (d[0] * d[0] + d[1] * d[1]) + (d[2] * d[2] + d[3] * d[3]); }
                q += __shfl_xor(q, 16); q += __shfl_xor(q, 32);
                if (fq == 0) P[(ai * HALF + wr * 64 + m * 16 + fr) * 4 + wc] = (f32x2v){mw, q};
            }
        asm volatile("s_waitcnt lgkmcnt(0)" ::: "memory"); __builtin_amdgcn_s_barrier(); asm volatile("" ::: "memory");
#if defined(BROKEN_EXCHANGE_NO_WAIT)
#warning BROKEN CONTROL BUILD: the row-statistics exchange does not wait; results are wrong by design
        if (blockIdx.x >= 64) { const long long t0_ = clock64(); while (clock64() - t0_ < 60000) __builtin_amdgcn_s_sleep(8); }
#endif
        const int row = wid * 32 + (lane & 31);
        if (lane < 32) {
            const f32x2v a = P[row * 4 + 0], b = P[row * 4 + 1], c = P[row * 4 + 2], d = P[row * 4 + 3];
            const float mt = (a.x + b.x + c.x + d.x) * 0.25f;
            const float da = a.x - mt, db = b.x - mt, dc = c.x - mt, dd = d.x - mt;
            const float m2 = (a.y + b.y) + (c.y + d.y) + 64.0f * ((da * da + db * db) + (dc * dc + dd * dd));
            unsigned long long* slot = (unsigned long long*)xbuf + ((size_t)(u.pm * BM + row) * 4 + u.pn);
            __hip_atomic_store(slot, ((unsigned long long)__float_as_uint(m2) << 32) | __float_as_uint(mt), __ATOMIC_RELAXED, __HIP_MEMORY_SCOPE_AGENT);
        }
        asm volatile("s_waitcnt vmcnt(0)" ::: "memory");
        if (lane == 0) __hip_atomic_fetch_add(cnt + 64 * u.pm, 1u, __ATOMIC_RELAXED, __HIP_MEMORY_SCOPE_AGENT);
        if (wid == 0) {
            bool dead = false; const unsigned long long t0 = __builtin_amdgcn_s_memrealtime(); const unsigned want = 8u * (unsigned)ntn;
            for (;;) {
#if defined(BROKEN_EXCHANGE_NO_WAIT)
                break;
#endif
                if ((unsigned)__builtin_amdgcn_readfirstlane(__hip_atomic_load(cnt + 64 * u.pm, __ATOMIC_RELAXED, __HIP_MEMORY_SCOPE_AGENT)) >= want) break;
                if (__builtin_amdgcn_s_memrealtime() - t0 > 2000000ull) {
                    if (lane == 0) { unsigned expect = 0u; __hip_atomic_compare_exchange_strong(tmo + 1, &expect, code | (unsigned)(u.pm & 0xff), __ATOMIC_RELAXED, __ATOMIC_RELAXED, __HIP_MEMORY_SCOPE_AGENT);
                                     __hip_atomic_store(tmo, 1u, __ATOMIC_RELAXED, __HIP_MEMORY_SCOPE_AGENT); }
                    dead = true; break; }
                __builtin_amdgcn_s_sleep(2);
            }
            __builtin_amdgcn_fence(__ATOMIC_ACQUIRE, "agent");
            if (lane == 0) flag[0] = dead ? 1u : 0u;
        }
        asm volatile("s_waitcnt vmcnt(0) lgkmcnt(0)" ::: "memory"); __builtin_amdgcn_s_barrier(); asm volatile("" ::: "memory");
        const bool bad = flag[0] != 0u;
        if (lane < 32) {
            const unsigned long long* slot = (const unsigned long long*)xbuf + (size_t)(u.pm * BM + row) * 4; float mt[4], m2[4]; float ms = 0.f;
#pragma unroll
            for (int t = 0; t < 4; ++t) { if (t < ntn) { const unsigned long long w = __hip_atomic_load(slot + t, __ATOMIC_RELAXED, __HIP_MEMORY_SCOPE_AGENT); mt[t] = __uint_as_float((unsigned)w); m2[t] = __uint_as_float((unsigned)(w >> 32)); } else { mt[t] = 0.f; m2[t] = 0.f; } ms += mt[t]; }
            const float mean = ms / (float)ntn; float q = 0.f;
#pragma unroll
            for (int t = 0; t < 4; ++t) if (t < ntn) { const float dm = mt[t] - mean; q += m2[t] + 256.0f * dm * dm; }
            S[row] = (f32x2v){mean, 1.0f / sqrtf(q / (256.0f * (float)ntn) + eps)};
        }
        asm volatile("s_waitcnt lgkmcnt(0)" ::: "memory"); __builtin_amdgcn_s_barrier(); asm volatile("" ::: "memory");
        return bad;
    }
};
struct EpiLnRes {
    static constexpr bool PERM = false, AFTER_DRAIN = true;
    const float* base; float* out; int ldc; const float* bias; PanelStats st; unsigned poison;
    __device__ __forceinline__ void fused(f32x4 (&acc)[2][2][4][2], const Unit& u, int wr, int wc, int fr, int fq, PG8_LAS unsigned char* lds, int wid, int lane) const {
        typedef float f32x2v __attribute__((ext_vector_type(2)));
        const PG8_LAS f32x2v* S = (const PG8_LAS f32x2v*)(lds + 8192);
        const int col0 = u.pn * BM + wc * 32 + 4 * fq;
#pragma unroll
        for (int bj = 0; bj < 2; ++bj)
#pragma unroll
            for (int n = 0; n < 2; ++n) { const f32x4 bv = bias ? *(const f32x4*)(bias + col0 + bj * HALF + n * 16) : (f32x4){0.f, 0.f, 0.f, 0.f};
#pragma unroll
                for (int ai = 0; ai < 2; ++ai)
#pragma unroll
                    for (int m = 0; m < 4; ++m) acc[ai][bj][m][n] += bv; }
        f32x4 pre[4][2][2];
#pragma unroll
        for (int m = 0; m < 4; ++m) { const size_t off = (size_t)(u.pm * BM + wr * 64 + m * 16 + fr) * ldc + col0;
#pragma unroll
            for (int bj = 0; bj < 2; ++bj)
#pragma unroll
                for (int n = 0; n < 2; ++n) pre[m][bj][n] = *(const f32x4*)(base + off + bj * HALF + n * 16); }
        const bool bad = st.run(acc, u, wr, wc, fr, fq, lds, wid, lane) || poison != 0u;
        const float qnan = __builtin_nanf("");
#pragma unroll
        for (int ai = 0; ai < 2; ++ai)
#pragma unroll
            for (int m = 0; m < 4; ++m) { const int r = ai * HALF + wr * 64 + m * 16 + fr; const f32x2v sr = S[r]; const size_t off = (size_t)(u.pm * BM + r) * ldc + col0;
#pragma unroll
                for (int bj = 0; bj < 2; ++bj)
#pragma unroll
                    for (int n = 0; n < 2; ++n) { const f32x4 bs = ai == 0 ? pre[m][bj][n] : *(const f32x4*)(base + off + bj * HALF + n * 16); f32x4 o = bs + (acc[ai][bj][m][n] - sr.x) * sr.y;
                        if (bad) o = (f32x4){qnan, qnan, qnan, qnan}; *(f32x4*)(out + off + bj * HALF + n * 16) = o; }
                if (m & 1) asm volatile("" ::: "memory"); }
    }
};
struct EpiLnResLn {
    static constexpr bool PERM = false, AFTER_DRAIN = true;
    const float* base; float* out; bf16_t* xn; int ldc; const float* bias; PanelStats st1, st2; unsigned poison;
    __device__ __forceinline__ void fused(f32x4 (&acc)[2][2][4][2], const Unit& u, int wr, int wc, int fr, int fq, PG8_LAS unsigned char* lds, int wid, int lane) const {
        typedef float f32x2v __attribute__((ext_vector_type(2))); typedef unsigned u32x2v __attribute__((ext_vector_type(2)));
        const PG8_LAS f32x2v* S = (const PG8_LAS f32x2v*)(lds + 8192);
        const int col0 = u.pn * BM + wc * 32 + 4 * fq;
#pragma unroll
        for (int bj = 0; bj < 2; ++bj)
#pragma unroll
            for (int n = 0; n < 2; ++n) { const f32x4 bv = bias ? *(const f32x4*)(bias + col0 + bj * HALF + n * 16) : (f32x4){0.f, 0.f, 0.f, 0.f};
#pragma unroll
                for (int ai = 0; ai < 2; ++ai)
#pragma unroll
                    for (int m = 0; m < 4; ++m) acc[ai][bj][m][n] += bv; }
        bool bad = st1.run(acc, u, wr, wc, fr, fq, lds, wid, lane) || poison != 0u;
        const float qnan = __builtin_nanf("");
#pragma unroll
        for (int ai = 0; ai < 2; ++ai)
#pragma unroll
            for (int m = 0; m < 4; ++m) { const int r = ai * HALF + wr * 64 + m * 16 + fr; const f32x2v sr = S[r]; const size_t off = (size_t)(u.pm * BM + r) * ldc + col0;
#pragma unroll
                for (int bj = 0; bj < 2; ++bj)
#pragma unroll
                    for (int n = 0; n < 2; ++n) { const f32x4 bs = *(const f32x4*)(base + off + bj * HALF + n * 16); acc[ai][bj][m][n] = bs + (acc[ai][bj][m][n] - sr.x) * sr.y; }
                asm volatile("" : "+v"(acc[ai][0][m][0]), "+v"(acc[ai][0][m][1]), "+v"(acc[ai][1][m][0]), "+v"(acc[ai][1][m][1]));
                if (m & 1) asm volatile("" ::: "memory"); }
        const bool bad1 = bad;
        bad = st2.run(acc, u, wr, wc, fr, fq, lds, wid, lane) || bad;
#pragma unroll
        for (int ai = 0; ai < 2; ++ai)
#pragma unroll
            for (int m = 0; m < 4; ++m) { const int r = ai * HALF + wr * 64 + m * 16 + fr; const f32x2v sr = S[r]; const size_t off = (size_t)(u.pm * BM + r) * ldc + col0;
#pragma unroll
                for (int bj = 0; bj < 2; ++bj)
#pragma unroll
                    for (int n = 0; n < 2; ++n) { const f32x4 x1 = acc[ai][bj][m][n]; *(f32x4*)(out + off + bj * HALF + n * 16) = bad1 ? (f32x4){qnan, qnan, qnan, qnan} : x1;
                        const f32x4 o = (x1 - sr.x) * sr.y; u32x2v w; w.x = cvt_pk_bf16(o[0], o[1]); w.y = cvt_pk_bf16(o[2], o[3]);
                        if (bad) { w.x = 0x7fc07fc0u; w.y = 0x7fc07fc0u; } *(u32x2v*)(xn + off + bj * HALF + n * 16) = w; }
                asm volatile("" ::: "memory"); }
    }
};

template <class Epi, class Sched, bool ALIGN_EPI = false, bool SP2 = false>
__device__ __forceinline__ void gemm_phase(PG8_LAS unsigned char* lds, const Gemm g, const Sched& S, const Epi& E) {
    const int tid = threadIdx.x, wid = __builtin_amdgcn_readfirstlane(tid >> 6), lane = tid & 63, wr = wid >> 2, wc = wid & 3, fr = lane & 15, fq = lane >> 4;
    const int K = g.K, nt = K / BK;
    unsigned voffA[2], voffB[2];
#pragma unroll
    for (int i = 0; i < 2; ++i) { int R, C; stage_rc(tid * 16 + i * 8192, R, C); const int Rb = Epi::PERM ? ((R & ~31) + perm32(R & 31)) : R;
        voffA[i] = (unsigned)(R * K + C) * 2u; voffB[i] = (unsigned)(Rb * K + C) * 2u; }
    const size_t kstep = (size_t)(BK * 2);
    const size_t hstep = (size_t)HALF * K * 2;
    const size_t tstep = 2 * hstep;
    const unsigned ldsw = (unsigned)wid * 1024u;
    const int aoff = lds_byte(wr * 64 + fr, fq * 8), boff = lds_byte(wc * 32 + fr, fq * 8);
#define PG8_SA(b, h) (((b) * 2 + (h)) * HTB)
#define PG8_SB(b, h) ((4 + (b) * 2 + (h)) * HTB)
#define PG8_STAGE(bufoff, gbase, voff) do { _Pragma("unroll") for (int _i = 0; _i < 2; ++_i) \
        __builtin_amdgcn_global_load_lds((const unsigned*)((const char*)(gbase) + (voff)[_i]), (PG8_LAS unsigned*)(lds + (bufoff) + ldsw + _i * 8192), 16, 0, 0); } while (0)
#define PG8_LDA(dst, b, h) do { _Pragma("unroll") for (int m = 0; m < 4; ++m) _Pragma("unroll") for (int k = 0; k < 2; ++k) dst[m][k] = *(const PG8_LAS bf16x8*)(lds + PG8_SA(b, h) + aoff + m * 2048 + k * 1024); } while (0)
#define PG8_LDB(dst, b, h) do { _Pragma("unroll") for (int n = 0; n < 2; ++n) _Pragma("unroll") for (int k = 0; k < 2; ++k) dst[n][k] = *(const PG8_LAS bf16x8*)(lds + PG8_SB(b, h) + boff + n * 2048 + k * 1024); } while (0)
#define PG8_MMA(ai, bj, At, Bt) do { __builtin_amdgcn_s_setprio(1); _Pragma("unroll") for (int m = 0; m < 4; ++m) _Pragma("unroll") for (int n = 0; n < 2; ++n) _Pragma("unroll") for (int k = 0; k < 2; ++k) \
        acc[ai][bj][m][n] = __builtin_amdgcn_mfma_f32_16x16x32_bf16(Bt[n][k], At[m][k], acc[ai][bj][m][n], 0, 0, 0); __builtin_amdgcn_s_setprio(0); } while (0)
#define PG8_WAIT_V(n) asm volatile("s_waitcnt vmcnt(" #n ")" ::: "memory")
#define PG8_WAIT_L(n) asm volatile("s_waitcnt lgkmcnt(" #n ")" ::: "memory")
#define PG8_BAR __builtin_amdgcn_s_barrier()
#define PG8_SCHED __builtin_amdgcn_sched_barrier(0)
    Unit cur, nxt; int ui = 0;
    if (!S.next(0, cur)) return;
    f32x4 acc[2][2][4][2];
#pragma unroll
    for (int a = 0; a < 2; ++a)
#pragma unroll
        for (int b = 0; b < 2; ++b)
#pragma unroll
            for (int m = 0; m < 4; ++m)
#pragma unroll
                for (int n = 0; n < 2; ++n) acc[a][b][m][n] = (f32x4){0.f, 0.f, 0.f, 0.f};
    bf16x8 At[4][2], B0[2][2], B1[2][2];
    const char* cA = (const char*)g.A + (size_t)cur.pm * tstep; const char* cB = (const char*)g.Bt + (size_t)cur.pn * tstep;
    S.a_ready(cur);
    if constexpr (SP2) {
        PG8_STAGE(PG8_SB(0, 0), cB, voffB); PG8_STAGE(PG8_SB(0, 1), cB + hstep, voffB); PG8_STAGE(PG8_SA(0, 0), cA, voffA); PG8_STAGE(PG8_SA(0, 1), cA + hstep, voffA);
        if (wr == 1) PG8_BAR;
        PG8_WAIT_V(2); PG8_BAR;
        PG8_STAGE(PG8_SB(1, 0), cB + kstep, voffB); PG8_STAGE(PG8_SA(1, 0), cA + kstep, voffA); PG8_STAGE(PG8_SB(1, 1), cB + hstep + kstep, voffB);
        PG8_WAIT_V(6); PG8_BAR;
    } else {
        PG8_STAGE(PG8_SB(0, 0), cB, voffB); PG8_STAGE(PG8_SA(0, 0), cA, voffA); PG8_STAGE(PG8_SB(0, 1), cB + hstep, voffB); PG8_STAGE(PG8_SA(0, 1), cA + hstep, voffA);
        if (wr == 1) PG8_BAR;
        PG8_WAIT_V(4); PG8_BAR;
        PG8_STAGE(PG8_SB(1, 0), cB + kstep, voffB); PG8_STAGE(PG8_SA(1, 0), cA + kstep, voffA); PG8_STAGE(PG8_SB(1, 1), cB + hstep + kstep, voffB);
        PG8_WAIT_V(6); PG8_BAR;
    }
    for (;;) {
        const bool has_next = S.next(ui + 1, nxt);
        const char* nA = has_next ? (const char*)g.A + (size_t)nxt.pm * tstep : cA; const char* nB = has_next ? (const char*)g.Bt + (size_t)nxt.pn * tstep : cB;
        for (int t = 0; t < nt; t += 2) {
            const bool last = (t == nt - 2);
            const char* a1 = cA + (size_t)(t + 1) * kstep;
            const char* a2 = last ? nA : cA + (size_t)(t + 2) * kstep; const char* b2 = last ? nB : cB + (size_t)(t + 2) * kstep;
            const char* a3 = a2 + kstep; const char* b3 = b2 + kstep;
            if (last && has_next) S.a_ready(nxt);
            if constexpr (SP2) {
            PG8_LDB(B0, 0, 0); PG8_LDB(B1, 0, 1); PG8_SCHED; PG8_LDA(At, 0, 0); PG8_STAGE(PG8_SA(1, 1), a1 + hstep, voffA);
            PG8_WAIT_V(8); PG8_WAIT_L(0); PG8_BAR; PG8_MMA(0, 0, At, B0); PG8_MMA(0, 1, At, B1); PG8_BAR; PG8_SCHED;
            PG8_LDA(At, 0, 1); PG8_STAGE(PG8_SB(0, 0), b2, voffB); PG8_STAGE(PG8_SB(0, 1), b2 + hstep, voffB); PG8_STAGE(PG8_SA(0, 0), a2, voffA);
            PG8_WAIT_V(8); PG8_WAIT_L(0); PG8_BAR; PG8_MMA(1, 0, At, B0); PG8_MMA(1, 1, At, B1); PG8_BAR; PG8_SCHED;
            PG8_LDB(B0, 1, 0); PG8_LDB(B1, 1, 1); PG8_SCHED; PG8_LDA(At, 1, 0); PG8_STAGE(PG8_SA(0, 1), a2 + hstep, voffA);
            PG8_WAIT_V(8); PG8_WAIT_L(0); PG8_BAR; PG8_MMA(0, 0, At, B0); PG8_MMA(0, 1, At, B1); PG8_BAR; PG8_SCHED;
            PG8_LDA(At, 1, 1); PG8_STAGE(PG8_SB(1, 0), b3, voffB); PG8_STAGE(PG8_SB(1, 1), b3 + hstep, voffB); PG8_STAGE(PG8_SA(1, 0), a3, voffA);
            PG8_WAIT_V(8); PG8_WAIT_L(0); PG8_BAR; PG8_MMA(1, 0, At, B0); PG8_MMA(1, 1, At, B1); PG8_BAR; PG8_SCHED;
            } else {
            PG8_LDB(B0, 0, 0); PG8_SCHED; PG8_LDA(At, 0, 0); PG8_STAGE(PG8_SA(1, 1), a1 + hstep, voffA);
            PG8_WAIT_L(8); PG8_BAR; PG8_WAIT_L(0); PG8_MMA(0, 0, At, B0); PG8_BAR; PG8_SCHED;
            PG8_LDB(B1, 0, 1); PG8_STAGE(PG8_SB(0, 0), b2, voffB);
            PG8_BAR; PG8_WAIT_L(0); PG8_MMA(0, 1, At, B1); PG8_BAR;
            PG8_LDA(At, 0, 1); PG8_STAGE(PG8_SA(0, 0), a2, voffA);
            PG8_BAR; PG8_WAIT_L(0); PG8_MMA(1, 0, At, B0); PG8_BAR; PG8_SCHED;
            PG8_STAGE(PG8_SB(0, 1), b2 + hstep, voffB);
            PG8_WAIT_V(6); PG8_BAR; PG8_MMA(1, 1, At, B1); PG8_BAR;
            PG8_LDB(B0, 1, 0); PG8_SCHED; PG8_LDA(At, 1, 0); PG8_STAGE(PG8_SA(0, 1), a2 + hstep, voffA);
            PG8_WAIT_L(8); PG8_BAR; PG8_WAIT_L(0); PG8_MMA(0, 0, At, B0); PG8_BAR; PG8_SCHED;
            PG8_LDB(B1, 1, 1); PG8_STAGE(PG8_SB(1, 0), b3, voffB);
            PG8_BAR; PG8_WAIT_L(0); PG8_MMA(0, 1, At, B1); PG8_BAR;
            PG8_LDA(At, 1, 1); PG8_STAGE(PG8_SA(1, 0), a3, voffA);
            PG8_BAR; PG8_WAIT_L(0); PG8_MMA(1, 0, At, B0); PG8_BAR; PG8_SCHED;
            PG8_STAGE(PG8_SB(1, 1), b3 + hstep, voffB);
            PG8_WAIT_V(6); PG8_BAR; PG8_MMA(1, 1, At, B1); PG8_BAR;
            }
        }
        if constexpr (ALIGN_EPI) { if (wr == 0) PG8_BAR; }
        if constexpr (!Epi::AFTER_DRAIN) { E(acc, cur, wr, wc, fr, fq); S.done(cur); }
        if (!has_next) break;
#pragma unroll
        for (int a = 0; a < 2; ++a)
#pragma unroll
            for (int b = 0; b < 2; ++b)
#pragma unroll
                for (int m = 0; m < 4; ++m)
#pragma unroll
                    for (int n = 0; n < 2; ++n) acc[a][b][m][n] = (f32x4){0.f, 0.f, 0.f, 0.f};
        cur = nxt; cA = nA; cB = nB; ++ui;
        if constexpr (ALIGN_EPI) { if (wr == 1) PG8_BAR; }
    }
    PG8_WAIT_V(0);
    if constexpr (!ALIGN_EPI) { if (wr == 0) PG8_BAR; }
    PG8_BAR;
    if constexpr (Epi::AFTER_DRAIN) { E.fused(acc, cur, wr, wc, fr, fq, lds, wid, lane); S.done(cur); }
#undef PG8_SA
#undef PG8_SB
#undef PG8_STAGE
#undef PG8_LDA
#undef PG8_LDB
#undef PG8_MMA
#undef PG8_WAIT_V
#undef PG8_WAIT_L
#undef PG8_BAR
#undef PG8_SCHED
}
}
constexpr int S_ = 16384, D_ = 1024, FF_ = 2816, NIN_ = 7448, NINP_ = 7680;
constexpr int NTHREADS = 512;
constexpr size_t MiB = 1u << 20;
constexpr size_t WS_CTL = 0;
constexpr size_t WS_MOD = 1 * MiB;
constexpr size_t WS_ROPE = 2 * MiB;
constexpr size_t WS_W = 6 * MiB;
constexpr size_t W_FFIN0 = 0, W_FFIN1 = 11 * MiB, W_FFOUT0 = 22 * MiB, W_FFOUT1 = 27 * MiB + MiB / 2, W_IN = 33 * MiB, W_BATT = 48 * MiB, W_BDN = 48 * MiB + MiB / 2, W_OUT = 50 * MiB;
constexpr size_t WS_H = 58 * MiB;
constexpr size_t WS_R = 90 * MiB;
constexpr size_t R_ACT = 0, R_Y = 88 * MiB;
constexpr size_t R_PA = 0, R_PD = 72 * MiB, R_PZ = 144 * MiB, R_AB = 232 * MiB, R_GB = 234 * MiB, R_OATT = 236 * MiB;
constexpr size_t WS_END = 352 * MiB;

typedef unsigned short bf16;
typedef unsigned v4u __attribute__((ext_vector_type(4)));
typedef unsigned v2u __attribute__((ext_vector_type(2)));
typedef float f32x4 __attribute__((ext_vector_type(4)));
typedef float f32x2 __attribute__((ext_vector_type(2)));
#define LAS __attribute__((address_space(3)))

__device__ __forceinline__ unsigned f2bf(float f) { unsigned u = __builtin_bit_cast(unsigned, f); return (u + 0x7fffu + ((u >> 16) & 1u)) >> 16; }
__device__ __forceinline__ unsigned pk2(float lo, float hi) { return f2bf(lo) | (f2bf(hi) << 16); }
__device__ __forceinline__ float bf2f(unsigned short b) { return __builtin_bit_cast(float, (unsigned)b << 16); }
__device__ __forceinline__ float bflo(unsigned w) { return __builtin_bit_cast(float, w << 16); }
__device__ __forceinline__ float bfhi(unsigned w) { return __builtin_bit_cast(float, w & 0xffff0000u); }
__device__ __forceinline__ float wave_sum(float v) {
#pragma unroll
    for (int o = 1; o < 64; o <<= 1) v += __shfl_xor(v, o);
    return v;
}
__device__ __forceinline__ float sigmoidf_(float x) { return 1.0f / (1.0f + __expf(-x)); }
__device__ __forceinline__ float siluf_(float x) { return x / (1.0f + __expf(-x)); }

namespace pg8 {
struct EpiSwiglu {
    static constexpr bool PERM = true, AFTER_DRAIN = false;
    bf16_t* O; int ldc; int pad_;
    __device__ __forceinline__ void operator()(const f32x4 (&acc)[2][2][4][2], const Unit& u, int wr, int wc, int fr, int fq) const {
        const int row0 = u.pm * BM + wr * 64 + fr, col0 = u.pn * 128 + wc * 32 + 8 * fq;
#pragma unroll
        for (int ai = 0; ai < 2; ++ai)
#pragma unroll
            for (int m = 0; m < 4; ++m) {
                bf16_t* rowp = O + (size_t)(row0 + ai * HALF + m * 16) * ldc + col0;
                float v[8];
#pragma unroll
                for (int n = 0; n < 2; ++n)
#pragma unroll
                    for (int e = 0; e < 4; ++e) { const float g = acc[ai][0][m][n][e], uu = acc[ai][1][m][n][e]; v[n * 4 + e] = g * __builtin_amdgcn_rcpf(1.0f + __expf(-g)) * uu; }
                u32x4 w; w.x = cvt_pk_bf16(v[0], v[1]); w.y = cvt_pk_bf16(v[2], v[3]); w.z = cvt_pk_bf16(v[4], v[5]); w.w = cvt_pk_bf16(v[6], v[7]);
                *(u32x4*)rowp = w;
            }
    }
};
struct EpiF32 {
    static constexpr bool PERM = false, AFTER_DRAIN = false;
    float* O; int ldc; int pad_;
    __device__ __forceinline__ void operator()(const f32x4 (&acc)[2][2][4][2], const Unit& u, int wr, int wc, int fr, int fq) const {
        const int row0 = u.pm * BM + wr * 64 + fr, col0 = u.pn * BM + wc * 32 + 4 * fq;
#pragma unroll
        for (int ai = 0; ai < 2; ++ai)
#pragma unroll
            for (int m = 0; m < 4; ++m) {
                float* rowp = O + (size_t)(row0 + ai * HALF + m * 16) * ldc + col0;
#pragma unroll
                for (int bj = 0; bj < 2; ++bj)
#pragma unroll
                    for (int n = 0; n < 2; ++n) *(f32x4*)(rowp + bj * HALF + n * 16) = acc[ai][bj][m][n];
            }
    }
};
struct EpiInProj {
    static constexpr bool PERM = true, AFTER_DRAIN = false;
    bf16_t* PA; bf16_t* PD; bf16_t* PZ; float* AB;
    __device__ __forceinline__ void operator()(const f32x4 (&acc)[2][2][4][2], const Unit& u, int wr, int wc, int fr, int fq) const {
        const int row0 = u.pm * BM + wr * 64 + fr;
        if (u.pn == 29) {
            if (wc == 0) {
#pragma unroll
                for (int ai = 0; ai < 2; ++ai)
#pragma unroll
                    for (int m = 0; m < 4; ++m) {
                        float* rowp = AB + (size_t)(row0 + ai * HALF + m * 16) * 32 + 8 * fq;
                        *(f32x4*)rowp = acc[ai][0][m][0]; *(f32x4*)(rowp + 4) = acc[ai][0][m][1];
                    }
            }
            return;
        }
        bf16_t* base; int ldc, ct;
        if (u.pn < 9) { base = PA; ldc = 2304; ct = u.pn; } else if (u.pn < 18) { base = PD; ldc = 2304; ct = u.pn - 9; } else { base = PZ; ldc = 2816; ct = u.pn - 18; }
        const int col0 = ct * BM + wc * 32 + 8 * fq;
#pragma unroll
        for (int ai = 0; ai < 2; ++ai)
#pragma unroll
            for (int m = 0; m < 4; ++m) {
                bf16_t* rowp = base + (size_t)(row0 + ai * HALF + m * 16) * ldc + col0;
#pragma unroll
                for (int bj = 0; bj < 2; ++bj) { const f32x4 v0 = acc[ai][bj][m][0], v1 = acc[ai][bj][m][1];
                    u32x4 w; w.x = cvt_pk_bf16(v0[0], v0[1]); w.y = cvt_pk_bf16(v0[2], v0[3]); w.z = cvt_pk_bf16(v1[0], v1[1]); w.w = cvt_pk_bf16(v1[2], v1[3]);
                    *(u32x4*)(rowp + bj * HALF) = w; }
            }
    }
};
struct EpiGateF32 {
    static constexpr bool PERM = false, AFTER_DRAIN = false;
    float* O; const bf16_t* gate; int ldg; int pad_;
    __device__ __forceinline__ void operator()(const f32x4 (&acc)[2][2][4][2], const Unit& u, int wr, int wc, int fr, int fq) const {
        const int row0 = u.pm * BM + wr * 64 + fr, col0 = u.pn * BM + wc * 32 + 4 * fq;
#pragma unroll
        for (int ai = 0; ai < 2; ++ai)
#pragma unroll
            for (int m = 0; m < 4; ++m) {
                const size_t r = (size_t)(row0 + ai * HALF + m * 16);
#pragma unroll
                for (int bj = 0; bj < 2; ++bj)
#pragma unroll
                    for (int n = 0; n < 2; ++n) { const int c = col0 + bj * HALF + n * 16;
                        const v2u gw = *(const v2u*)(gate + r * ldg + c);
                        f32x4 a = acc[ai][bj][m][n];
                        a[0] *= sigmoidf_(bflo(gw.x)); a[1] *= sigmoidf_(bfhi(gw.x)); a[2] *= sigmoidf_(bflo(gw.y)); a[3] *= sigmoidf_(bfhi(gw.y));
                        *(f32x4*)(O + r * 1024 + c) = a; }
            }
    }
};
struct EpiGateAddBf16 {
    static constexpr bool PERM = false, AFTER_DRAIN = false;
    bf16_t* O; const float* T1; const bf16_t* gate; int ldg; int pad_;
    __device__ __forceinline__ void operator()(const f32x4 (&acc)[2][2][4][2], const Unit& u, int wr, int wc, int fr, int fq) const {
        const int row0 = u.pm * BM + wr * 64 + fr, col0 = u.pn * BM + wc * 32 + 4 * fq;
#pragma unroll
        for (int ai = 0; ai < 2; ++ai)
#pragma unroll
            for (int m = 0; m < 4; ++m) {
                const size_t r = (size_t)(row0 + ai * HALF + m * 16);
#pragma unroll
                for (int bj = 0; bj < 2; ++bj)
#pragma unroll
                    for (int n = 0; n < 2; ++n) { const int c = col0 + bj * HALF + n * 16;
                        const v2u gw = *(const v2u*)(gate + r * ldg + c);
                        const f32x4 t = *(const f32x4*)(T1 + r * 1024 + c);
                        f32x4 a = acc[ai][bj][m][n];
                        a[0] = t[0] + a[0] * sigmoidf_(bflo(gw.x)); a[1] = t[1] + a[1] * sigmoidf_(bfhi(gw.x)); a[2] = t[2] + a[2] * sigmoidf_(bflo(gw.y)); a[3] = t[3] + a[3] * sigmoidf_(bfhi(gw.y));
                        v2u w; w.x = cvt_pk_bf16(a[0], a[1]); w.y = cvt_pk_bf16(a[2], a[3]);
                        *(v2u*)(O + r * 1024 + c) = w; }
            }
    }
};
}

template <class Epi>
__global__ void __launch_bounds__(NTHREADS, 2) k_gemm(pg8::Gemm g, Epi E) {
    extern __shared__ __attribute__((aligned(16))) unsigned char lds[];
    pg8::StaticOrder S; S.init(g.M, g.N, (int)gridDim.x, (int)blockIdx.x);
    pg8::gemm_phase<Epi, pg8::StaticOrder, true, true>((LAS unsigned char*)lds, g, S, E);
}

__device__ __forceinline__ int srcmap(int mode, int n) {
    if (mode == 0) return n;
    if (mode == 1) return (n >> 8) * 128 + (n & 127) + ((n >> 7) & 1) * 2816;
    if (n < 5376) return n;
    if (n < 6400) return 5400 + (n - 5376);
    if (n < 7424) return 6424 + (n - 6400);
    if (n < 7448) return 5376 + (n - 7424);
    return -1;
}
struct ConvJob { const float* W; bf16* WT; int K, Nsrc, Ndst, mode, item0, pad_; };
struct ConvArgs { ConvJob j[8]; int njobs, nitems, pad0_, pad1_; };
__global__ void __launch_bounds__(NTHREADS) k_convert(ConvArgs a) {
    __shared__ float scr_all[8][64 * 33];
    const int lane = threadIdx.x & 63, wave = threadIdx.x >> 6;
    float* scr = scr_all[wave];
    const int gw = blockIdx.x * 8 + wave, NGW = gridDim.x * 8;
    for (int it = gw; it < a.nitems; it += NGW) {
        int ji = 0;
#pragma unroll
        for (int q = 1; q < 8; ++q) if (q < a.njobs && it >= a.j[q].item0) ji = q;
        const ConvJob J = a.j[ji];
        const int item = it - J.item0;
        const int nblk = J.Ndst / 32, kb = item / nblk, nb = item % nblk, k0 = 64 * kb, n0 = 32 * nb;
        const int sc = srcmap(J.mode, n0 + (lane & 31));
#pragma unroll 8
        for (int i = 0; i < 32; ++i) { const int kk = 2 * i + (lane >> 5); scr[kk * 33 + (lane & 31)] = sc >= 0 ? J.W[(size_t)(k0 + kk) * J.Nsrc + sc] : 0.f; }
        __builtin_amdgcn_s_waitcnt(0xc07f);
        __builtin_amdgcn_wave_barrier();
        const int c = lane & 7;
#pragma unroll
        for (int j = 0; j < 4; ++j) { const int n = (lane >> 3) + 8 * j; const float* s = scr + (8 * c) * 33 + n;
            v4u o; o.x = pk2(s[0 * 33], s[1 * 33]); o.y = pk2(s[2 * 33], s[3 * 33]); o.z = pk2(s[4 * 33], s[5 * 33]); o.w = pk2(s[6 * 33], s[7 * 33]);
            *(v4u*)(J.WT + (size_t)(n0 + n) * J.K + k0 + 8 * c) = o; }
        __builtin_amdgcn_s_waitcnt(0xc07f);
        __builtin_amdgcn_wave_barrier();
    }
}

__global__ void __launch_bounds__(NTHREADS) k_ada(const float* c, const float* w_ada, const float* b_ada, float* mod) {
    __shared__ float red[8][64];
    const int lane = threadIdx.x & 63, wave = threadIdx.x >> 6;
    for (int u = blockIdx.x; u < 2 * 144; u += gridDim.x) {
        const int l = u / 144, n = (u % 144) * 64 + lane;
        const float* W = w_ada + (size_t)l * 1024 * 9216 + n;
        float s = 0.f;
        for (int k = wave * 128; k < wave * 128 + 128; ++k) s += siluf_(c[k]) * W[(size_t)k * 9216];
        red[wave][lane] = s;
        __syncthreads();
        if (wave == 0) { float t = b_ada[l * 9216 + n];
#pragma unroll
            for (int w = 0; w < 8; ++w) t += red[w][lane];
            mod[l * 9216 + n] = t; }
        __syncthreads();
    }
}
__global__ void k_rope(const int* pos, float* tab) {
    const int idx = blockIdx.x * blockDim.x + threadIdx.x;
    if (idx >= S_ * 32) return;
    const int t = idx >> 5, i = idx & 31;
    const float inv = (float)pow(10000.0, -(double)i / 32.0);
    const float ang = (float)pos[t] * inv;
    float sn, cs; sincosf(ang, &sn, &cs);
    tab[idx] = cs; tab[S_ * 32 + idx] = sn;
}

struct RowArgs { const float* xi; const float* y; float* xo; bf16* h; const float* wpost; const float* gate; const float* wpre; const float* shift; const float* scale; float coef; int pad_; };
__global__ void __launch_bounds__(NTHREADS) k_rows(RowArgs a) {
    const int lane = threadIdx.x & 63, wave = threadIdx.x >> 6;
    const int gw = blockIdx.x * 8 + wave, NGW = gridDim.x * 8;
    for (int r = gw; r < S_; r += NGW) {
        f32x4 x[4];
        const f32x4* xr = (const f32x4*)(a.xi + (size_t)r * D_) + lane;
#pragma unroll
        for (int j = 0; j < 4; ++j) x[j] = xr[64 * j];
        if (a.y) {
            f32x4 y[4]; float s = 0.f;
            const f32x4* yr = (const f32x4*)(a.y + (size_t)r * D_) + lane;
#pragma unroll
            for (int j = 0; j < 4; ++j) { y[j] = yr[64 * j]; s += (y[j].x * y[j].x + y[j].y * y[j].y) + (y[j].z * y[j].z + y[j].w * y[j].w); }
            const float rs = 1.0f / sqrtf(wave_sum(s) * (1.f / D_) + 1e-6f);
#pragma unroll
            for (int j = 0; j < 4; ++j) { const f32x4 wp = ((const f32x4*)a.wpost)[lane + 64 * j], g = ((const f32x4*)a.gate)[lane + 64 * j];
                x[j] = x[j] + a.coef * g * ((y[j] * rs) * wp); }
            f32x4* xw = (f32x4*)(a.xo + (size_t)r * D_) + lane;
#pragma unroll
            for (int j = 0; j < 4; ++j) xw[64 * j] = x[j];
        }
        if (a.h) {
            float s = 0.f;
#pragma unroll
            for (int j = 0; j < 4; ++j) s += (x[j].x * x[j].x + x[j].y * x[j].y) + (x[j].z * x[j].z + x[j].w * x[j].w);
            const float rs = 1.0f / sqrtf(wave_sum(s) * (1.f / D_) + 1e-6f);
            v2u* hw = (v2u*)(a.h + (size_t)r * D_) + lane;
#pragma unroll
            for (int j = 0; j < 4; ++j) { const f32x4 wp = ((const f32x4*)a.wpre)[lane + 64 * j], sc = ((const f32x4*)a.scale)[lane + 64 * j], sh = ((const f32x4*)a.shift)[lane + 64 * j];
                const f32x4 v = ((x[j] * rs) * wp) * (1.0f + sc) + sh;
                v2u w; w.x = pk2(v.x, v.y); w.y = pk2(v.z, v.w); hw[64 * j] = w; }
        }
    }
}
constexpr int ATT_PITCH = 68;
__global__ void __launch_bounds__(NTHREADS) k_attn_v1(const bf16* PA, const float* rope, bf16* OG, float* LSE) {
    extern __shared__ __attribute__((aligned(16))) unsigned char lds[];
    float* qs = (float*)lds; float* ks = qs + 64 * ATT_PITCH; float* vs = ks + 192 * ATT_PITCH;
    const int tid = threadIdx.x, lane = tid & 63, wave = tid >> 6;
    for (int u = blockIdx.x; u < 3072; u += gridDim.x) {
        const int hg = u & 3, w = (u >> 2) & 255, gi = u >> 10;
        const int dil = 1 << (2 * gi), L = S_ / dil, r = w % dil, nb = w / dil, head = gi * 4 + hg;
        __syncthreads();
        for (int rr = wave; rr < 448; rr += 8) {
            int mm, colbase; float* dst; bool rot; float sc = 1.f;
            if (rr < 64) { mm = nb * 64 + rr; colbase = head * 64; dst = qs + rr * ATT_PITCH; rot = true; sc = 0.125f; }
            else if (rr < 256) { mm = nb * 64 - 64 + (rr - 64); colbase = 768 + head * 64; dst = ks + (rr - 64) * ATT_PITCH; rot = true; }
            else { mm = nb * 64 - 64 + (rr - 256); colbase = 1536 + head * 64; dst = vs + (rr - 256) * ATT_PITCH; rot = false; }
            float val = 0.f;
            if (mm >= 0 && mm < L) {
                const int tok = mm * dil + r;
                val = bf2f(PA[(size_t)tok * 2304 + colbase + lane]);
                if (rot) {
                    const float other = __shfl_xor(val, 32);
                    const float cs = rope[tok * 32 + (lane & 31)], sn = rope[S_ * 32 + tok * 32 + (lane & 31)];
                    val = (lane < 32) ? (val * cs - other * sn) : (val * cs + other * sn);
                }
            }
            dst[lane] = val * sc;
        }
        __syncthreads();
        const int i = tid >> 3, part = tid & 7;
        float q[64], acc[64];
#pragma unroll
        for (int d = 0; d < 64; d += 4) { const f32x4 t = *(const f32x4*)(qs + i * ATT_PITCH + d); q[d] = t.x; q[d + 1] = t.y; q[d + 2] = t.z; q[d + 3] = t.w; }
#pragma unroll
        for (int d = 0; d < 64; ++d) acc[d] = 0.f;
        float m = -1e30f, l = 0.f;
        for (int jj = 0; jj < 24; ++jj) {
            const int j = part + 8 * jj, mm = nb * 64 - 64 + j, dj = j - 64 - i;
            const bool ok = (dj <= 64) && (dj >= -64) && (mm >= 0) && (mm < L);
            if (ok) {
                const float* kr = ks + j * ATT_PITCH; float s = 0.f;
#pragma unroll
                for (int d = 0; d < 64; d += 4) { const f32x4 t = *(const f32x4*)(kr + d); s += q[d] * t.x + q[d + 1] * t.y + q[d + 2] * t.z + q[d + 3] * t.w; }
                const float mn = fmaxf(m, s), al = __expf(m - mn), p = __expf(s - mn);
                l = l * al + p; m = mn;
                const float* vr = vs + j * ATT_PITCH;
#pragma unroll
                for (int d = 0; d < 64; d += 4) { const f32x4 t = *(const f32x4*)(vr + d);
                    acc[d] = acc[d] * al + p * t.x; acc[d + 1] = acc[d + 1] * al + p * t.y; acc[d + 2] = acc[d + 2] * al + p * t.z; acc[d + 3] = acc[d + 3] * al + p * t.w; }
            }
        }
        float mt = fmaxf(m, __shfl_xor(m, 1)); mt = fmaxf(mt, __shfl_xor(mt, 2)); mt = fmaxf(mt, __shfl_xor(mt, 4));
        const float f = __expf(m - mt);
        l *= f; l += __shfl_xor(l, 1); l += __shfl_xor(l, 2); l += __shfl_xor(l, 4);
#pragma unroll
        for (int d = 0; d < 64; ++d) acc[d] *= f;
        const bool b2 = part & 4, b1 = part & 2, b0 = part & 1;
        float r32[32], r16[16], r8[8];
#pragma unroll
        for (int d = 0; d < 32; ++d) { const float keep = b2 ? acc[32 + d] : acc[d], send = b2 ? acc[d] : acc[32 + d]; r32[d] = keep + __shfl_xor(send, 4); }
#pragma unroll
        for (int d = 0; d < 16; ++d) { const float keep = b1 ? r32[16 + d] : r32[d], send = b1 ? r32[d] : r32[16 + d]; r16[d] = keep + __shfl_xor(send, 2); }
#pragma unroll
        for (int d = 0; d < 8; ++d) { const float keep = b0 ? r16[8 + d] : r16[d], send = b0 ? r16[d] : r16[8 + d]; r8[d] = keep + __shfl_xor(send, 1); }
        const float il = 1.0f / l;
        const int tok = (nb * 64 + i) * dil + r;
        v4u o; o.x = pk2(r8[0] * il, r8[1] * il); o.y = pk2(r8[2] * il, r8[3] * il); o.z = pk2(r8[4] * il, r8[5] * il); o.w = pk2(r8[6] * il, r8[7] * il);
        *(v4u*)(OG + ((size_t)gi * S_ + tok) * 256 + hg * 64 + part * 8) = o;
        if (part == 0) LSE[((size_t)gi * S_ + tok) * 4 + hg] = mt + logf(l);
    }
}

__global__ void __launch_bounds__(NTHREADS) k_dnprep(const bf16* PD, const float* AB, const float* convw, const float* a_log, const float* dt_bias, bf16* QKVd, float* GB) {
    const int lane = threadIdx.x & 63, wave = threadIdx.x >> 6;
    const int gw = blockIdx.x * 8 + wave, NGW = gridDim.x * 8;
    for (int t = gw; t < S_; t += NGW) {
        for (int seg = 0; seg < 18; ++seg) {
            const int c0 = seg * 128 + 2 * lane;
            float a0 = 0.f, a1 = 0.f;
#pragma unroll
            for (int j = 0; j < 5; ++j) { const int tt = t + j - 2;
                if (tt >= 0 && tt < S_) { const unsigned w = *(const unsigned*)(PD + (size_t)tt * 2304 + c0); const f32x2 cw = *(const f32x2*)(convw + j * 2304 + c0);
                    a0 += bflo(w) * cw.x; a1 += bfhi(w) * cw.y; } }
            a0 = siluf_(a0); a1 = siluf_(a1);
            if (seg < 12) { const float ss = wave_sum(a0 * a0 + a1 * a1); const float sc = (1.0f / sqrtf(ss + 1e-6f)) * (seg < 6 ? 0.08838834764831845f : 1.0f); a0 *= sc; a1 *= sc; }
            *(unsigned*)(QKVd + (size_t)t * 2304 + c0) = pk2(a0, a1);
        }
        if (lane < 12) {
            const float braw = AB[(size_t)t * 32 + lane], araw = AB[(size_t)t * 32 + 12 + lane];
            const float x = araw + dt_bias[lane];
            const float sp = fmaxf(x, 0.f) + log1pf(expf(-fabsf(x)));
            GB[(size_t)lane * S_ + t] = -expf(a_log[lane]) * sp;
            GB[(size_t)(12 + lane) * S_ + t] = 1.0f / (1.0f + expf(-braw));
        }
    }
}

__global__ void __launch_bounds__(256) k_dn_naive(const bf16* QKVd, const float* GB, bf16* ODIR) {
    __shared__ float qb[32][128], kb[32][128], vb[32][128], gb[32], bb[32];
    const int tid = threadIdx.x, c = tid >> 1, half = tid & 1;
    const int dir = blockIdx.x / 6, h = blockIdx.x % 6;
    float St[64];
#pragma unroll
    for (int a = 0; a < 64; ++a) St[a] = 0.f;
    const float* G = GB + (size_t)(dir * 6 + h) * S_; const float* BE = GB + (size_t)(12 + dir * 6 + h) * S_;
    for (int s0 = 0; s0 < S_; s0 += 32) {
        __syncthreads();
        for (int e = tid; e < 32 * 128; e += 256) { const int rr = e >> 7, cc = e & 127; const int tok = dir ? (S_ - 1 - (s0 + rr)) : (s0 + rr);
            const bf16* p = QKVd + (size_t)tok * 2304 + h * 128 + cc;
            qb[rr][cc] = bf2f(p[0]); kb[rr][cc] = bf2f(p[768]); vb[rr][cc] = bf2f(p[1536]); }
        if (tid < 32) { const int tok = dir ? (S_ - 1 - (s0 + tid)) : (s0 + tid); gb[tid] = G[tok]; bb[tid] = BE[tok]; }
        __syncthreads();
        for (int rr = 0; rr < 32; ++rr) {
            const float* kr = &kb[rr][half * 64]; const float* qr = &qb[rr][half * 64];
            float ksum = 0.f;
#pragma unroll
            for (int a = 0; a < 64; a += 4) { const f32x4 t = *(const f32x4*)(kr + a); ksum += t.x * St[a] + t.y * St[a + 1] + t.z * St[a + 2] + t.w * St[a + 3]; }
            ksum += __shfl_xor(ksum, 1);
            const float eg = expf(gb[rr]);
            const float coef = bb[rr] * (vb[rr][c] - eg * ksum);
            float o = 0.f;
#pragma unroll
            for (int a = 0; a < 64; a += 4) { const f32x4 t = *(const f32x4*)(kr + a); const f32x4 qq = *(const f32x4*)(qr + a);
                St[a] = eg * St[a] + t.x * coef; St[a + 1] = eg * St[a + 1] + t.y * coef; St[a + 2] = eg * St[a + 2] + t.z * coef; St[a + 3] = eg * St[a + 3] + t.w * coef;
                o += qq.x * St[a] + qq.y * St[a + 1] + qq.z * St[a + 2] + qq.w * St[a + 3]; }
            o += __shfl_xor(o, 1);
            if (half == 0) { const int tok = dir ? (S_ - 1 - (s0 + rr)) : (s0 + rr); ODIR[((size_t)dir * S_ + tok) * 768 + h * 128 + c] = (bf16)f2bf(o); }
        }
    }
}

__global__ void __launch_bounds__(NTHREADS) k_final(const bf16* ODIR, const bf16* PZ, const float* dnw, const bf16* OG, const float* LSE, bf16* ODN, bf16* OATT) {
    const int lane = threadIdx.x & 63, wave = threadIdx.x >> 6;
    const int gw = blockIdx.x * 8 + wave, NGW = gridDim.x * 8;
    for (int t = gw; t < S_; t += NGW) {
#pragma unroll
        for (int h = 0; h < 6; ++h) {
            const int c = h * 128 + 2 * lane;
            const unsigned wf = *(const unsigned*)(ODIR + (size_t)t * 768 + c), wb = *(const unsigned*)(ODIR + ((size_t)S_ + t) * 768 + c);
            float o0 = bflo(wf) + bflo(wb), o1 = bfhi(wf) + bfhi(wb);
            const float ms = wave_sum(o0 * o0 + o1 * o1) * (1.0f / 128.0f);
            const float sc = 1.0f / sqrtf(ms + 1e-6f);
            const unsigned zw = *(const unsigned*)(PZ + (size_t)t * 2816 + c);
            const f32x2 nw = *(const f32x2*)(dnw + 2 * lane);
            o0 = o0 * sc * nw.x * siluf_(bflo(zw)); o1 = o1 * sc * nw.y * siluf_(bfhi(zw));
            *(unsigned*)(ODN + (size_t)t * 768 + c) = pk2(o0, o1);
        }
        {
            const int ch = 4 * lane, hg = lane >> 4;
            const float l0 = LSE[(size_t)t * 4 + hg], l1 = LSE[((size_t)S_ + t) * 4 + hg], l2 = LSE[((size_t)2 * S_ + t) * 4 + hg];
            const float mx = fmaxf(l0, fmaxf(l1, l2));
            float w0 = expf(l0 - mx), w1 = expf(l1 - mx), w2 = expf(l2 - mx);
            const float inv = 1.0f / (w0 + w1 + w2); w0 *= inv; w1 *= inv; w2 *= inv;
            const v2u a = *(const v2u*)(OG + (size_t)t * 256 + ch), b = *(const v2u*)(OG + ((size_t)S_ + t) * 256 + ch), cc = *(const v2u*)(OG + ((size_t)2 * S_ + t) * 256 + ch);
            v2u o;
            o.x = pk2(w0 * bflo(a.x) + w1 * bflo(b.x) + w2 * bflo(cc.x), w0 * bfhi(a.x) + w1 * bfhi(b.x) + w2 * bfhi(cc.x));
            o.y = pk2(w0 * bflo(a.y) + w1 * bflo(b.y) + w2 * bflo(cc.y), w0 * bfhi(a.y) + w1 * bfhi(b.y) + w2 * bfhi(cc.y));
            *(v2u*)(OATT + (size_t)t * 256 + ch) = o;
        }
    }
}
template <class Epi> static void launch_gemm(hipStream_t st, const bf16* A, const bf16* Bt, int N, int K, const Epi& E) {
    pg8::Gemm g{A, Bt, S_, N, K};
    hipLaunchKernelGGL(k_gemm<Epi>, dim3(256), dim3(NTHREADS), pg8::STAGE_BYTES, st, g, E);
}
extern "C" void kernel_launch(void* const* d_in, const int* in_sizes, int n_in, void* d_out, int out_size, void* d_ws, size_t ws_size, hipStream_t stream) {
    static bool inited = false;
    if (!inited) {
        inited = true;
        (void)hipFuncSetAttribute((const void*)k_gemm<pg8::EpiSwiglu>, hipFuncAttributeMaxDynamicSharedMemorySize, pg8::STAGE_BYTES);
        (void)hipFuncSetAttribute((const void*)k_gemm<pg8::EpiF32>, hipFuncAttributeMaxDynamicSharedMemorySize, pg8::STAGE_BYTES);
        (void)hipFuncSetAttribute((const void*)k_gemm<pg8::EpiInProj>, hipFuncAttributeMaxDynamicSharedMemorySize, pg8::STAGE_BYTES);
        (void)hipFuncSetAttribute((const void*)k_gemm<pg8::EpiGateF32>, hipFuncAttributeMaxDynamicSharedMemorySize, pg8::STAGE_BYTES);
        (void)hipFuncSetAttribute((const void*)k_gemm<pg8::EpiGateAddBf16>, hipFuncAttributeMaxDynamicSharedMemorySize, pg8::STAGE_BYTES);
        (void)hipFuncSetAttribute((const void*)k_attn_v1, hipFuncAttributeMaxDynamicSharedMemorySize, 448 * ATT_PITCH * 4);
        if (ws_size < WS_END) fprintf(stderr, "kernel_launch: workspace too small: %zu < %zu\n", ws_size, (size_t)WS_END);
    }
    const float* x_in = (const float*)d_in[0]; const float* c = (const float*)d_in[1]; const int* pos = (const int*)d_in[2];
    const float* w_ada = (const float*)d_in[3]; const float* b_ada = (const float*)d_in[4]; const float* norm_pre = (const float*)d_in[5]; const float* norm_post = (const float*)d_in[6];
    const float* ffn_w_in = (const float*)d_in[7]; const float* ffn_w_out = (const float*)d_in[8]; const float* w_in = (const float*)d_in[9]; const float* conv_w = (const float*)d_in[10];
    const float* a_log = (const float*)d_in[11]; const float* dt_bias = (const float*)d_in[12]; const float* dn_norm_w = (const float*)d_in[13];
    const float* w_batt = (const float*)d_in[14]; const float* w_bdn = (const float*)d_in[15]; const float* w_out = (const float*)d_in[16];
    float* out = (float*)d_out; unsigned char* ws = (unsigned char*)d_ws;
    float* MOD = (float*)(ws + WS_MOD); float* ROPE = (float*)(ws + WS_ROPE);
    bf16* Wb = (bf16*)(ws + WS_W);
    bf16* Wffin[2] = {(bf16*)(ws + WS_W + W_FFIN0), (bf16*)(ws + WS_W + W_FFIN1)}; bf16* Wffout[2] = {(bf16*)(ws + WS_W + W_FFOUT0), (bf16*)(ws + WS_W + W_FFOUT1)};
    bf16* Win = (bf16*)(ws + WS_W + W_IN); bf16* Wbatt = (bf16*)(ws + WS_W + W_BATT); bf16* Wbdn = (bf16*)(ws + WS_W + W_BDN); bf16* Wout = (bf16*)(ws + WS_W + W_OUT);
    (void)Wb;
    bf16* H = (bf16*)(ws + WS_H); unsigned char* R = ws + WS_R;
    bf16* ACT = (bf16*)(R + R_ACT); float* Y = (float*)(R + R_Y);
    bf16* PA = (bf16*)(R + R_PA); bf16* PD = (bf16*)(R + R_PD); bf16* PZ = (bf16*)(R + R_PZ); float* AB = (float*)(R + R_AB); float* GB = (float*)(R + R_GB); bf16* OATT = (bf16*)(R + R_OATT);
    bf16* OG = (bf16*)(ws + WS_H); float* LSE = (float*)(ws + WS_H + 24 * MiB);
    bf16* QKVd = (bf16*)(R + R_PA); bf16* ODIR = (bf16*)(R + R_PD); bf16* ODN = (bf16*)(R + R_PD + 48 * MiB);
    float* T1 = (float*)(R + R_PA); bf16* YM = (bf16*)(ws + WS_H); float* Y2 = (float*)(R + R_PA);

    hipLaunchKernelGGL(k_ada, dim3(256), dim3(NTHREADS), 0, stream, c, w_ada, b_ada, MOD);
    hipLaunchKernelGGL(k_rope, dim3(S_ * 32 / 256), dim3(256), 0, stream, pos, ROPE);
    { RowArgs a{}; a.xi = x_in; a.y = nullptr; a.xo = nullptr; a.h = H; a.wpre = norm_pre; a.shift = MOD + 0 * 1024; a.scale = MOD + 1 * 1024; a.coef = 0.f;
      hipLaunchKernelGGL(k_rows, dim3(256), dim3(NTHREADS), 0, stream, a); }
    for (int l = 0; l < 2; ++l) {
        const float* mod = MOD + l * 9216;
        {   ConvArgs ca{}; int it = 0, nj = 0;
            auto add = [&](const float* W, bf16* WT, int K, int Nsrc, int Ndst, int mode) { ConvJob& J = ca.j[nj++]; J.W = W; J.WT = WT; J.K = K; J.Nsrc = Nsrc; J.Ndst = Ndst; J.mode = mode; J.item0 = it; it += (K / 64) * (Ndst / 32); };
            add(ffn_w_in + ((size_t)l * 2 + 0) * 1024 * 5632, Wffin[0], 1024, 5632, 5632, 1);
            add(ffn_w_in + ((size_t)l * 2 + 1) * 1024 * 5632, Wffin[1], 1024, 5632, 5632, 1);
            add(ffn_w_out + ((size_t)l * 2 + 0) * 2816 * 1024, Wffout[0], 2816, 1024, 1024, 0);
            add(ffn_w_out + ((size_t)l * 2 + 1) * 2816 * 1024, Wffout[1], 2816, 1024, 1024, 0);
            add(w_in + (size_t)l * 1024 * NIN_, Win, 1024, NIN_, NINP_, 2);
            add(w_batt + (size_t)l * 256 * 1024, Wbatt, 256, 1024, 1024, 0);
            add(w_bdn + (size_t)l * 768 * 1024, Wbdn, 768, 1024, 1024, 0);
            add(w_out + (size_t)l * 1024 * 1024, Wout, 1024, 1024, 1024, 0);
            ca.njobs = nj; ca.nitems = it;
            hipLaunchKernelGGL(k_convert, dim3(256), dim3(NTHREADS), 0, stream, ca); }
        for (int f = 0; f < 2; ++f) {
            if (f == 1) {
                { pg8::EpiInProj E{}; E.PA = PA; E.PD = PD; E.PZ = PZ; E.AB = AB; launch_gemm(stream, H, Win, NINP_, 1024, E); }
                hipLaunchKernelGGL(k_attn_v1, dim3(256), dim3(NTHREADS), 448 * ATT_PITCH * 4, stream, (const bf16*)PA, (const float*)ROPE, OG, LSE);
                hipLaunchKernelGGL(k_dnprep, dim3(256), dim3(NTHREADS), 0, stream, (const bf16*)PD, (const float*)AB, conv_w + (size_t)l * 5 * 2304, a_log + l * 12, dt_bias + l * 12, QKVd, GB);
                hipLaunchKernelGGL(k_dn_naive, dim3(12), dim3(256), 0, stream, (const bf16*)QKVd, (const float*)GB, ODIR);
                hipLaunchKernelGGL(k_final, dim3(256), dim3(NTHREADS), 0, stream, (const bf16*)ODIR, (const bf16*)PZ, dn_norm_w + l * 128, (const bf16*)OG, (const float*)LSE, ODN, OATT);
                { pg8::EpiGateF32 E{}; E.O = T1; E.gate = PZ + 768; E.ldg = 2816; launch_gemm(stream, OATT, Wbatt, 1024, 256, E); }
                { pg8::EpiGateAddBf16 E{}; E.O = YM; E.T1 = T1; E.gate = PZ + 1792; E.ldg = 2816; launch_gemm(stream, ODN, Wbdn, 1024, 768, E); }
                { pg8::EpiF32 E{}; E.O = Y2; E.ldc = 1024; launch_gemm(stream, YM, Wout, 1024, 1024, E); }
                { RowArgs a{}; a.xi = out; a.y = Y2; a.xo = out; a.h = H; a.wpost = norm_post + (l * 3 + 1) * 1024; a.gate = mod + (1 * 3 + 2) * 1024; a.coef = 1.0f;
                  a.wpre = norm_pre + (l * 3 + 2) * 1024; a.shift = mod + (2 * 3 + 0) * 1024; a.scale = mod + (2 * 3 + 1) * 1024;
                  hipLaunchKernelGGL(k_rows, dim3(256), dim3(NTHREADS), 0, stream, a); }
            }
            const int s = f * 2;
            { pg8::EpiSwiglu E{}; E.O = ACT; E.ldc = FF_; launch_gemm(stream, H, Wffin[f], 2 * FF_, 1024, E); }
            { pg8::EpiF32 E{}; E.O = Y; E.ldc = 1024; launch_gemm(stream, ACT, Wffout[f], 1024, FF_, E); }
            { RowArgs a{}; a.xi = (l == 0 && f == 0) ? x_in : out; a.y = Y; a.xo = out; a.wpost = norm_post + (l * 3 + s) * 1024; a.gate = mod + (s * 3 + 2) * 1024; a.coef = 0.5f;
              if (f == 0) { a.h = H; a.wpre = norm_pre + (l * 3 + 1) * 1024; a.shift = mod + (1 * 3 + 0) * 1024; a.scale = mod + (1 * 3 + 1) * 1024; }
              else if (l == 0) { a.h = H; a.wpre = norm_pre + (1 * 3 + 0) * 1024; a.shift = MOD + 9216 + 0 * 1024; a.scale = MOD + 9216 + 1 * 1024; }
              else { a.h = nullptr; }
              hipLaunchKernelGGL(k_rows, dim3(256), dim3(NTHREADS), 0, stream, a); }
        }
    }
}
```

```cpp
#include <hip/hip_runtime.h>
#include <cstdio>
#include <cstdint>
__device__ __forceinline__ int lane_id_() { int l; asm volatile("v_mbcnt_lo_u32_b32 %0, -1, 0\n\tv_mbcnt_hi_u32_b32 %0, -1, %0" : "=v"(l)); return l; }
namespace pg8 {
#define PG8_LAS __attribute__((address_space(3)))
typedef unsigned short bf16_t;
typedef short bf16x8 __attribute__((ext_vector_type(8)));
typedef float f32x4 __attribute__((ext_vector_type(4)));
typedef unsigned u32x4 __attribute__((ext_vector_type(4)));
constexpr int BM = 256, BK = 64, HALF = 128, HTB = HALF * BK * 2  , STAGE_BYTES = 8 * HTB, NXCD = 8, WGM = 8;

__host__ __device__ __forceinline__ int lds_byte(int r, int c) { const int st = (r >> 4) * 2 + (c >> 5), rr = r & 15, cc = c & 31, ob = rr * 64 + cc * 2; return st * 1024 + (ob ^ (((ob >> 9) & 1) << 5)); }
__host__ __device__ __forceinline__ void stage_rc(int b, int& R, int& C) { const int st = b / 1024, sb = b % 1024, swz = sb ^ (((sb >> 9) & 1) << 5); R = (st >> 1) * 16 + swz / 64; C = (st & 1) * 32 + (swz % 64) / 2; }
__host__ __device__ __forceinline__ int perm32(int rho) { const int n = rho >> 4, i = rho & 15; return 8 * (i >> 2) + 4 * n + (i & 3); }

struct Unit { int pm, pn; };
struct Gemm { const bf16_t* A; const bf16_t* Bt; int M, N, K, pad_; };

struct StaticOrder {
    int nM, nN, nwg, G, c;
    __host__ __device__ void init(int M, int N, int G_, int c_) { nM = M / BM; nN = N / BM; nwg = nM * nN; G = G_; c = c_; }
    __host__ __device__ bool next(int i, Unit& u) const {
        const long L = (long)i * G + c; if (L >= nwg) return false;
        int wgid = (int)L; { const int q = nwg / NXCD, r = nwg % NXCD, xcd = wgid % NXCD, off = wgid / NXCD; wgid = (xcd < r ? xcd * (q + 1) : r * (q + 1) + (xcd - r) * q) + off; }
        const int nig = WGM * nN, gid = wgid / nig, fm = gid * WGM, gsz = (nM - fm) < WGM ? (nM - fm) : WGM;
        u.pm = fm + ((wgid % nig) % gsz); u.pn = (wgid % nig) / gsz; return true;
    }
    __device__ __forceinline__ void a_ready(const Unit&) const {}
    __device__ __forceinline__ void done(const Unit&) const {}
};

__device__ __forceinline__ unsigned cvt_pk_bf16(float lo, float hi) { unsigned r; asm volatile("v_cvt_pk_bf16_f32 %0, %1, %2" : "=v"(r) : "v"(lo), "v"(hi)); return r; }
typedef float f32x2 __attribute__((ext_vector_type(2)));
__device__ __forceinline__ f32x2 gelu_pk(f32x2 v) {
    const f32x2 av = __builtin_elementwise_abs(v), d = av * 0.2316418882f + 1.0f;
    f32x2 t; t.x = __builtin_amdgcn_rcpf(d.x); t.y = __builtin_amdgcn_rcpf(d.y);
    f32x2 q = t * 0.5307027145f + (-0.7265760135f); q = q * t + 0.7107068705f; q = q * t + (-0.142248368f); q = q * t + 0.127414796f; q = q * t;
    const f32x2 s = (v * v) * (-0.72134752044f);
    f32x2 e; e.x = __builtin_amdgcn_exp2f(s.x); e.y = __builtin_amdgcn_exp2f(s.y);
    const f32x2 m = v * (q * e), r = v - m;
    f32x2 o; o.x = v.x < 0.f ? m.x : r.x; o.y = v.y < 0.f ? m.y : r.y; return o;
}

template <int ACT  > struct EpiBf16 {
    static constexpr bool PERM = true, AFTER_DRAIN = false; static_assert(ACT == 0 || ACT == 1, "EpiBf16: ACT is 0 (none) or 1 (gelu_pk)");
    bf16_t* O; int ldc; const float* bias; int split_cols; size_t split_stride; float scale0;
    __device__ __forceinline__ void operator()(const f32x4 (&acc)[2][2][4][2], const Unit& u, int wr, int wc, int fr, int fq) const {
        const int row0 = u.pm * BM + wr * 64 + fr; int colt = u.pn * BM; bf16_t* base = O;
        float sc = 1.f; if (split_cols) { const int t = colt / split_cols; base += (size_t)t * split_stride; colt -= t * split_cols; if (t == 0) sc = scale0; }
        const int col0 = colt + wc * 32 + 8 * fq, bcol0 = u.pn * BM + wc * 32 + 8 * fq;
        f32x4 bv[2][2];
#pragma unroll
        for (int bj = 0; bj < 2; ++bj)
#pragma unroll
            for (int n = 0; n < 2; ++n) bv[bj][n] = bias ? *(const f32x4*)(bias + bcol0 + bj * HALF + 4 * n) : (f32x4){0.f, 0.f, 0.f, 0.f};
#pragma unroll
        for (int ai = 0; ai < 2; ++ai)
#pragma unroll
            for (int m = 0; m < 4; ++m) { bf16_t* rowp = base + (size_t)(row0 + ai * HALF + m * 16) * ldc + col0;
#pragma unroll
                for (int bj = 0; bj < 2; ++bj) { f32x4 v0 = acc[ai][bj][m][0] + bv[bj][0], v1 = acc[ai][bj][m][1] + bv[bj][1];
                    if (ACT == 1) { f32x2 a = gelu_pk((f32x2){v0[0], v0[1]}), b = gelu_pk((f32x2){v0[2], v0[3]}), c = gelu_pk((f32x2){v1[0], v1[1]}), d = gelu_pk((f32x2){v1[2], v1[3]});
                        v0 = (f32x4){a.x, a.y, b.x, b.y}; v1 = (f32x4){c.x, c.y, d.x, d.y}; }
                    v0 = v0 * sc; v1 = v1 * sc; u32x4 w; w.x = cvt_pk_bf16(v0[0], v0[1]); w.y = cvt_pk_bf16(v0[2], v0[3]); w.z = cvt_pk_bf16(v1[0], v1[1]); w.w = cvt_pk_bf16(v1[2], v1[3]);
                    *(u32x4*)(rowp + bj * HALF) = w; } }
    }
};

struct PanelStats {
    unsigned* xbuf;
    unsigned* cnt;
    unsigned* tmo;
    int ntn; float eps;
    unsigned code;
    __device__ __forceinline__ bool run(const f32x4 (&v)[2][2][4][2], const Unit& u, int wr, int wc, int fr, int fq, PG8_LAS unsigned char* lds, int wid, int lane) const {
        typedef float f32x2v __attribute__((ext_vector_type(2)));
        PG8_LAS f32x2v* P = (PG8_LAS f32x2v*)lds;
        PG8_LAS f32x2v* S = (PG8_LAS f32x2v*)(lds + 8192);
        PG8_LAS unsigned* flag = (PG8_LAS unsigned*)(lds + 8192 + 2048);
#pragma unroll
        for (int ai = 0; ai < 2; ++ai)
#pragma unroll
            for (int m = 0; m < 4; ++m) {
                float s = 0.f;
#pragma unroll
                for (int bj = 0; bj < 2; ++bj)
#pragma unroll
                    for (int n = 0; n < 2; ++n) { const f32x4 x = v[ai][bj][m][n]; s += (x[0] + x[1]) + (x[2] + x[3]); }
                s += __shfl_xor(s, 16); s += __shfl_xor(s, 32);
                const float mw = s * (1.0f / 64.0f); float q = 0.f;
#pragma unroll
                for (int bj = 0; bj < 2; ++bj)
#pragma unroll
                    for (int n = 0; n < 2; ++n) { const f32x4 d = v[ai][bj][m][n] - mw; q += (d[0] * d[0] + d[1] * d[1]) + (d[2] * d[2] + d[3] * d[3]); }
                q += __shfl_xor(q, 16); q += __shfl_xor(q, 32);
                if (fq == 0) P[(ai * HALF + wr * 64 + m * 16 + fr) * 4 + wc] = (f32x2v){mw, q};
            }
        asm volatile("s_waitcnt lgkmcnt(0)" ::: "memory"); __builtin_amdgcn_s_barrier(); asm volatile("" ::: "memory");
#if defined(BROKEN_EXCHANGE_NO_WAIT)
#warning BROKEN CONTROL BUILD: the row-statistics exchange does not wait; results are wrong by design
        if (blockIdx.x >= 64) { const long long t0_ = clock64(); while (clock64() - t0_ < 60000) __builtin_amdgcn_s_sleep(8); }
#endif
        const int row = wid * 32 + (lane & 31);
        if (lane < 32) {
            const f32x2v a = P[row * 4 + 0], b = P[row * 4 + 1], c = P[row * 4 + 2], d = P[row * 4 + 3];
            const float mt = (a.x + b.x + c.x + d.x) * 0.25f;
            const float da = a.x - mt, db = b.x - mt, dc = c.x - mt, dd = d.x - mt;
            const float m2 = (a.y + b.y) + (c.y + d.y) + 64.0f * ((da * da + db * db) + (dc * dc + dd * dd));
            unsigned long long* slot = (unsigned long long*)xbuf + ((size_t)(u.pm * BM + row) * 4 + u.pn);
            __hip_atomic_store(slot, ((unsigned long long)__float_as_uint(m2) << 32) | __float_as_uint(mt), __ATOMIC_RELAXED, __HIP_MEMORY_SCOPE_AGENT);
        }
        asm volatile("s_waitcnt vmcnt(0)" ::: "memory");
        if (lane == 0) __hip_atomic_fetch_add(cnt + 64 * u.pm, 1u, __ATOMIC_RELAXED, __HIP_MEMORY_SCOPE_AGENT);
        if (wid == 0) {
            bool dead = false; const unsigned long long t0 = __builtin_amdgcn_s_memrealtime(); const unsigned want = 8u * (unsigned)ntn;
            for (;;) {
#if defined(BROKEN_EXCHANGE_NO_WAIT)
                break;
#endif
                if ((unsigned)__builtin_amdgcn_readfirstlane(__hip_atomic_load(cnt + 64 * u.pm, __ATOMIC_RELAXED, __HIP_MEMORY_SCOPE_AGENT)) >= want) break;
                if (__builtin_amdgcn_s_memrealtime() - t0 > 2000000ull) {
                    if (lane == 0) { unsigned expect = 0u; __hip_atomic_compare_exchange_strong(tmo + 1, &expect, code | (unsigned)(u.pm & 0xff), __ATOMIC_RELAXED, __ATOMIC_RELAXED, __HIP_MEMORY_SCOPE_AGENT);
                                     __hip_atomic_store(tmo, 1u, __ATOMIC_RELAXED, __HIP_MEMORY_SCOPE_AGENT); }
                    dead = true; break; }
                __builtin_amdgcn_s_sleep(2);
            }
            __builtin_amdgcn_fence(__ATOMIC_ACQUIRE, "agent");
            if (lane == 0) flag[0] = dead ? 1u : 0u;
        }
        asm volatile("s_waitcnt vmcnt(0) lgkmcnt(0)" ::: "memory"); __builtin_amdgcn_s_barrier(); asm volatile("" ::: "memory");
        const bool bad = flag[0] != 0u;
        if (lane < 32) {
            const unsigned long long* slot = (const unsigned long long*)xbuf + (size_t)(u.pm * BM + row) * 4; float mt[4], m2[4]; float ms = 0.f;
#pragma unroll
            for (int t = 0; t < 4; ++t) { if (t < ntn) { const unsigned long long w = __hip_atomic_load(slot + t, __ATOMIC_RELAXED, __HIP_MEMORY_SCOPE_AGENT); mt[t] = __uint_as_float((unsigned)w); m2[t] = __uint_as_float((unsigned)(w >> 32)); } else { mt[t] = 0.f; m2[t] = 0.f; } ms += mt[t]; }
            const float mean = ms / (float)ntn; float q = 0.f;
#pragma unroll
            for (int t = 0; t < 4; ++t) if (t < ntn) { const float dm = mt[t] - mean; q += m2[t] + 256.0f * dm * dm; }
            S[row] = (f32x2v){mean, 1.0f / sqrtf(q / (256.0f * (float)ntn) + eps)};
        }
        asm volatile("s_waitcnt lgkmcnt(0)" ::: "memory"); __builtin_amdgcn_s_barrier(); asm volatile("" ::: "memory");
        return bad;
    }
};
struct EpiLnRes {
    static constexpr bool PERM = false, AFTER_DRAIN = true;
    const float* base; float* out; int ldc; const float* bias; PanelStats st; unsigned poison;
    __device__ __forceinline__ void fused(f32x4 (&acc)[2][2][4][2], const Unit& u, int wr, int wc, int fr, int fq, PG8_LAS unsigned char* lds, int wid, int lane) const {
        typedef float f32x2v __attribute__((ext_vector_type(2)));
        const PG8_LAS f32x2v* S = (const PG8_LAS f32x2v*)(lds + 8192);
        const int col0 = u.pn * BM + wc * 32 + 4 * fq;
#pragma unroll
        for (int bj = 0; bj < 2; ++bj)
#pragma unroll
            for (int n = 0; n < 2; ++n) { const f32x4 bv = bias ? *(const f32x4*)(bias + col0 + bj * HALF + n * 16) : (f32x4){0.f, 0.f, 0.f, 0.f};
#pragma unroll
                for (int ai = 0; ai < 2; ++ai)
#pragma unroll
                    for (int m = 0; m < 4; ++m) acc[ai][bj][m][n] += bv; }
        f32x4 pre[4][2][2];
#pragma unroll
        for (int m = 0; m < 4; ++m) { const size_t off = (size_t)(u.pm * BM + wr * 64 + m * 16 + fr) * ldc + col0;
#pragma unroll
            for (int bj = 0; bj < 2; ++bj)
#pragma unroll
                for (int n = 0; n < 2; ++n) pre[m][bj][n] = *(const f32x4*)(base + off + bj * HALF + n * 16); }
        const bool bad = st.run(acc, u, wr, wc, fr, fq, lds, wid, lane) || poison != 0u;
        const float qnan = __builtin_nanf("");
#pragma unroll
        for (int ai = 0; ai < 2; ++ai)
#pragma unroll
            for (int m = 0; m < 4; ++m) { const int r = ai * HALF + wr * 64 + m * 16 + fr; const f32x2v sr = S[r]; const size_t off = (size_t)(u.pm * BM + r) * ldc + col0;
#pragma unroll
                for (int bj = 0; bj < 2; ++bj)
#pragma unroll
                    for (int n = 0; n < 2; ++n) { const f32x4 bs = ai == 0 ? pre[m][bj][n] : *(const f32x4*)(base + off + bj * HALF + n * 16); f32x4 o = bs + (acc[ai][bj][m][n] - sr.x) * sr.y;
                        if (bad) o = (f32x4){qnan, qnan, qnan, qnan}; *(f32x4*)(out + off + bj * HALF + n * 16) = o; }
                if (m & 1) asm volatile("" ::: "memory"); }
    }
};
struct EpiLnResLn {
    static constexpr bool PERM = false, AFTER_DRAIN = true;
    const float* base; float* out; bf16_t* xn; int ldc; const float* bias; PanelStats st1, st2; unsigned poison;
    __device__ __forceinline__ void fused(f32x4 (&acc)[2][2][4][2], const Unit& u, int wr, int wc, int fr, int fq, PG8_LAS unsigned char* lds, int wid, int lane) const {
        typedef float f32x2v __attribute__((ext_vector_type(2))); typedef unsigned u32x2v __attribute__((ext_vector_type(2)));
        const PG8_LAS f32x2v* S = (const PG8_LAS f32x2v*)(lds + 8192);
        const int col0 = u.pn * BM + wc * 32 + 4 * fq;
#pragma unroll
        for (int bj = 0; bj < 2; ++bj)
#pragma unroll
            for (int n = 0; n < 2; ++n) { const f32x4 bv = bias ? *(const f32x4*)(bias + col0 + bj * HALF + n * 16) : (f32x4){0.f, 0.f, 0.f, 0.f};
#pragma unroll
                for (int ai = 0; ai < 2; ++ai)
#pragma unroll
                    for (int m = 0; m < 4; ++m) acc[ai][bj][m][n] += bv; }
        bool bad = st1.run(acc, u, wr, wc, fr, fq, lds, wid, lane) || poison != 0u;
        const float qnan = __builtin_nanf("");
#pragma unroll
        for (int ai = 0; ai < 2; ++ai)
#pragma unroll
            for (int m = 0; m < 4; ++m) { const int r = ai * HALF + wr * 64 + m * 16 + fr; const f32x2v sr = S[r]; const size_t off = (size_t)(u.pm * BM + r) * ldc + col0;
#pragma unroll
                for (int bj = 0; bj < 2; ++bj)
#pragma unroll
                    for (int n = 0; n < 2; ++n) { const f32x4 bs = *(const f32x4*)(base + off + bj * HALF + n * 16); acc[ai][bj][m][n] = bs + (acc[ai][bj][m][n] - sr.x) * sr.y; }
                asm volatile("" : "+v"(acc[ai][0][m][0]), "+v"(acc[ai][0][m][1]), "+v"(acc[ai][1][m][0]), "+v"(acc[ai][1][m][1]));
                if (m & 1) asm volatile("" ::: "memory"); }
        const bool bad1 = bad;
        bad = st2.run(acc, u, wr, wc, fr, fq, lds, wid, lane) || bad;
#pragma unroll
        for (int ai = 0; ai < 2; ++ai)
#pragma unroll
            for (int m = 0; m < 4; ++m) { const int r = ai * HALF + wr * 64 + m * 16 + fr; const f32x2v sr = S[r]; const size_t off = (size_t)(u.pm * BM + r) * ldc + col0;
#pragma unroll
                for (int bj = 0; bj < 2; ++bj)
#pragma unroll
                    for (int n = 0; n < 2; ++n) { const f32x4 x1 = acc[ai][bj][m][n]; *(f32x4*)(out + off + bj * HALF + n * 16) = bad1 ? (f32x4){qnan, qnan, qnan, qnan} : x1;
                        const f32x4 o = (x1 - sr.x) * sr.y; u32x2v w; w.x = cvt_pk_bf16(o[0], o[1]); w.y = cvt_pk_bf16(o[2], o[3]);
                        if (bad) { w.x = 0x7fc07fc0u; w.y = 0x7fc07fc0u; } *(u32x2v*)(xn + off + bj * HALF + n * 16) = w; }
                asm volatile("" ::: "memory"); }
    }
};

template <class Epi, class Sched, bool ALIGN_EPI = false, bool SP2 = false>
__device__ __forceinline__ void gemm_phase(PG8_LAS unsigned char* lds, const Gemm g, const Sched& S, const Epi& E, int wv) {
    int tid_ = wv * 64 + lane_id_(); asm volatile("" : "+v"(tid_));
    const int tid = tid_, wid = __builtin_amdgcn_readfirstlane(tid >> 6), lane = tid & 63, wr = wid >> 2, wc = wid & 3, fr = lane & 15, fq = lane >> 4;
    const int K = g.K, nt = K / BK;
    unsigned voffA[2], voffB[2];
#pragma unroll
    for (int i = 0; i < 2; ++i) { int R, C; stage_rc(tid * 16 + i * 8192, R, C); const int Rb = Epi::PERM ? ((R & ~31) + perm32(R & 31)) : R;
        voffA[i] = (unsigned)(R * K + C) * 2u; voffB[i] = (unsigned)(Rb * K + C) * 2u; }
    const size_t kstep = (size_t)(BK * 2);
    const size_t hstep = (size_t)HALF * K * 2;
    const size_t tstep = 2 * hstep;
    const unsigned ldsw = (unsigned)wid * 1024u;
    const int aoff = lds_byte(wr * 64 + fr, fq * 8), boff = lds_byte(wc * 32 + fr, fq * 8);
#define PG8_SA(b, h) (((b) * 2 + (h)) * HTB)
#define PG8_SB(b, h) ((4 + (b) * 2 + (h)) * HTB)
#define PG8_STAGE(bufoff, gbase, voff) do { _Pragma("unroll") for (int _i = 0; _i < 2; ++_i) \
        __builtin_amdgcn_global_load_lds((const unsigned*)((const char*)(gbase) + (voff)[_i]), (PG8_LAS unsigned*)(lds + (bufoff) + ldsw + _i * 8192), 16, 0, 0); } while (0)
#define PG8_LDA(dst, b, h) do { _Pragma("unroll") for (int m = 0; m < 4; ++m) _Pragma("unroll") for (int k = 0; k < 2; ++k) dst[m][k] = *(const PG8_LAS bf16x8*)(lds + PG8_SA(b, h) + aoff + m * 2048 + k * 1024); } while (0)
#define PG8_LDB(dst, b, h) do { _Pragma("unroll") for (int n = 0; n < 2; ++n) _Pragma("unroll") for (int k = 0; k < 2; ++k) dst[n][k] = *(const PG8_LAS bf16x8*)(lds + PG8_SB(b, h) + boff + n * 2048 + k * 1024); } while (0)
#define PG8_MMA(ai, bj, At, Bt) do { __builtin_amdgcn_s_setprio(1); _Pragma("unroll") for (int m = 0; m < 4; ++m) _Pragma("unroll") for (int n = 0; n < 2; ++n) _Pragma("unroll") for (int k = 0; k < 2; ++k) \
        acc[ai][bj][m][n] = __builtin_amdgcn_mfma_f32_16x16x32_bf16(Bt[n][k], At[m][k], acc[ai][bj][m][n], 0, 0, 0); __builtin_amdgcn_s_setprio(0); } while (0)
#define PG8_WAIT_V(n) asm volatile("s_waitcnt vmcnt(" #n ")" ::: "memory")
#define PG8_WAIT_L(n) asm volatile("s_waitcnt lgkmcnt(" #n ")" ::: "memory")
#define PG8_BAR __builtin_amdgcn_s_barrier()
#define PG8_SCHED __builtin_amdgcn_sched_barrier(0)
    Unit cur, nxt; int ui = 0;
    if (!S.next(0, cur)) return;
    f32x4 acc[2][2][4][2];
#pragma unroll
    for (int a = 0; a < 2; ++a)
#pragma unroll
        for (int b = 0; b < 2; ++b)
#pragma unroll
            for (int m = 0; m < 4; ++m)
#pragma unroll
                for (int n = 0; n < 2; ++n) acc[a][b][m][n] = (f32x4){0.f, 0.f, 0.f, 0.f};
    bf16x8 At[4][2], B0[2][2], B1[2][2];
    const char* cA = (const char*)g.A + (size_t)cur.pm * tstep; const char* cB = (const char*)g.Bt + (size_t)cur.pn * tstep;
    S.a_ready(cur);
    if constexpr (SP2) {
        PG8_STAGE(PG8_SB(0, 0), cB, voffB); PG8_STAGE(PG8_SB(0, 1), cB + hstep, voffB); PG8_STAGE(PG8_SA(0, 0), cA, voffA); PG8_STAGE(PG8_SA(0, 1), cA + hstep, voffA);
        if (wr == 1) PG8_BAR;
        PG8_WAIT_V(2); PG8_BAR;
        PG8_STAGE(PG8_SB(1, 0), cB + kstep, voffB); PG8_STAGE(PG8_SA(1, 0), cA + kstep, voffA); PG8_STAGE(PG8_SB(1, 1), cB + hstep + kstep, voffB);
        PG8_WAIT_V(6); PG8_BAR;
    } else {
        PG8_STAGE(PG8_SB(0, 0), cB, voffB); PG8_STAGE(PG8_SA(0, 0), cA, voffA); PG8_STAGE(PG8_SB(0, 1), cB + hstep, voffB); PG8_STAGE(PG8_SA(0, 1), cA + hstep, voffA);
        if (wr == 1) PG8_BAR;
        PG8_WAIT_V(4); PG8_BAR;
        PG8_STAGE(PG8_SB(1, 0), cB + kstep, voffB); PG8_STAGE(PG8_SA(1, 0), cA + kstep, voffA); PG8_STAGE(PG8_SB(1, 1), cB + hstep + kstep, voffB);
        PG8_WAIT_V(6); PG8_BAR;
    }
    for (;;) {
        const bool has_next = S.next(ui + 1, nxt);
        const char* nA = has_next ? (const char*)g.A + (size_t)nxt.pm * tstep : cA; const char* nB = has_next ? (const char*)g.Bt + (size_t)nxt.pn * tstep : cB;
        for (int t = 0; t < nt; t += 2) {
            const bool last = (t == nt - 2);
            const char* a1 = cA + (size_t)(t + 1) * kstep;
            const char* a2 = last ? nA : cA + (size_t)(t + 2) * kstep; const char* b2 = last ? nB : cB + (size_t)(t + 2) * kstep;
            const char* a3 = a2 + kstep; const char* b3 = b2 + kstep;
            if (last && has_next) S.a_ready(nxt);
            if constexpr (SP2) {
            PG8_LDB(B0, 0, 0); PG8_LDB(B1, 0, 1); PG8_SCHED; PG8_LDA(At, 0, 0); PG8_STAGE(PG8_SA(1, 1), a1 + hstep, voffA);
            PG8_WAIT_V(8); PG8_WAIT_L(0); PG8_BAR; PG8_MMA(0, 0, At, B0); PG8_MMA(0, 1, At, B1); PG8_BAR; PG8_SCHED;
            PG8_LDA(At, 0, 1); PG8_STAGE(PG8_SB(0, 0), b2, voffB); PG8_STAGE(PG8_SB(0, 1), b2 + hstep, voffB); PG8_STAGE(PG8_SA(0, 0), a2, voffA);
            PG8_WAIT_V(8); PG8_WAIT_L(0); PG8_BAR; PG8_MMA(1, 0, At, B0); PG8_MMA(1, 1, At, B1); PG8_BAR; PG8_SCHED;
            PG8_LDB(B0, 1, 0); PG8_LDB(B1, 1, 1); PG8_SCHED; PG8_LDA(At, 1, 0); PG8_STAGE(PG8_SA(0, 1), a2 + hstep, voffA);
            PG8_WAIT_V(8); PG8_WAIT_L(0); PG8_BAR; PG8_MMA(0, 0, At, B0); PG8_MMA(0, 1, At, B1); PG8_BAR; PG8_SCHED;
            PG8_LDA(At, 1, 1); PG8_STAGE(PG8_SB(1, 0), b3, voffB); PG8_STAGE(PG8_SB(1, 1), b3 + hstep, voffB); PG8_STAGE(PG8_SA(1, 0), a3, voffA);
            PG8_WAIT_V(8); PG8_WAIT_L(0); PG8_BAR; PG8_MMA(1, 0, At, B0); PG8_MMA(1, 1, At, B1); PG8_BAR; PG8_SCHED;
            } else {
            PG8_LDB(B0, 0, 0); PG8_SCHED; PG8_LDA(At, 0, 0); PG8_STAGE(PG8_SA(1, 1), a1 + hstep, voffA);
            PG8_WAIT_L(8); PG8_BAR; PG8_WAIT_L(0); PG8_MMA(0, 0, At, B0); PG8_BAR; PG8_SCHED;
            PG8_LDB(B1, 0, 1); PG8_STAGE(PG8_SB(0, 0), b2, voffB);
            PG8_BAR; PG8_WAIT_L(0); PG8_MMA(0, 1, At, B1); PG8_BAR;
            PG8_LDA(At, 0, 1); PG8_STAGE(PG8_SA(0, 0), a2, voffA);
            PG8_BAR; PG8_WAIT_L(0); PG8_MMA(1, 0, At, B0); PG8_BAR; PG8_SCHED;
            PG8_STAGE(PG8_SB(0, 1), b2 + hstep, voffB);
            PG8_WAIT_V(6); PG8_BAR; PG8_MMA(1, 1, At, B1); PG8_BAR;
            PG8_LDB(B0, 1, 0); PG8_SCHED; PG8_LDA(At, 1, 0); PG8_STAGE(PG8_SA(0, 1), a2 + hstep, voffA);
            PG8_WAIT_L(8); PG8_BAR; PG8_WAIT_L(0); PG8_MMA(0, 0, At, B0); PG8_BAR; PG8_SCHED;
            PG8_LDB(B1, 1, 1); PG8_STAGE(PG8_SB(1, 0), b3, voffB);
            PG8_BAR; PG8_WAIT_L(0); PG8_MMA(0, 1, At, B1); PG8_BAR;
            PG8_LDA(At, 1, 1); PG8_STAGE(PG8_SA(1, 0), a3, voffA);
            PG8_BAR; PG8_WAIT_L(0); PG8_MMA(1, 0, At, B0); PG8_BAR; PG8_SCHED;
            PG8_STAGE(PG8_SB(1, 1), b3 + hstep, voffB);
            PG8_WAIT_V(6); PG8_BAR; PG8_MMA(1, 1, At, B1); PG8_BAR;
            }
        }
        if constexpr (ALIGN_EPI) { if (wr == 0) PG8_BAR; }
        if constexpr (!Epi::AFTER_DRAIN) { E(acc, cur, wr, wc, fr, fq); S.done(cur); }
        if (!has_next) break;
#pragma unroll
        for (int a = 0; a < 2; ++a)
#pragma unroll
            for (int b = 0; b < 2; ++b)
#pragma unroll
                for (int m = 0; m < 4; ++m)
#pragma unroll
                    for (int n = 0; n < 2; ++n) acc[a][b][m][n] = (f32x4){0.f, 0.f, 0.f, 0.f};
        cur = nxt; cA = nA; cB = nB; ++ui;
        if constexpr (ALIGN_EPI) { if (wr == 1) PG8_BAR; }
    }
    PG8_WAIT_V(0);
    if constexpr (!ALIGN_EPI) { if (wr == 0) PG8_BAR; }
    PG8_BAR;
    if constexpr (Epi::AFTER_DRAIN) { E.fused(acc, cur, wr, wc, fr, fq, lds, wid, lane); S.done(cur); }
#undef PG8_SA
#undef PG8_SB
#undef PG8_STAGE
#undef PG8_LDA
#undef PG8_LDB
#undef PG8_MMA
#undef PG8_WAIT_V
#undef PG8_WAIT_L
#undef PG8_BAR
#undef PG8_SCHED
}
}
constexpr int S_ = 16384, D_ = 1024, FF_ = 2816, NIN_ = 7448, NINP_ = 7680;
constexpr int NTHREADS = 512;
constexpr size_t MiB = 1u << 20;
constexpr size_t WS_CTL = 0;
constexpr size_t WS_MOD = 1 * MiB;
constexpr size_t WS_ROPE = 2 * MiB;
constexpr size_t WS_W = 6 * MiB;
constexpr size_t W_FFIN0 = 0, W_FFIN1 = 11 * MiB, W_FFOUT0 = 22 * MiB, W_FFOUT1 = 27 * MiB + MiB / 2, W_IN = 33 * MiB, W_BATT = 48 * MiB, W_BDN = 48 * MiB + MiB / 2, W_OUT = 50 * MiB;
constexpr size_t WS_H = 58 * MiB;
constexpr size_t WS_R = 90 * MiB;
constexpr size_t R_ACT = 0, R_Y = 88 * MiB;
constexpr size_t R_PA = 0, R_PD = 72 * MiB, R_PZ = 144 * MiB, R_AB = 232 * MiB, R_GB = 234 * MiB, R_OATT = 236 * MiB;
constexpr size_t WS_END = 352 * MiB;

typedef unsigned short bf16;
typedef unsigned v4u __attribute__((ext_vector_type(4)));
typedef unsigned v2u __attribute__((ext_vector_type(2)));
typedef float f32x4 __attribute__((ext_vector_type(4)));
typedef float f32x2 __attribute__((ext_vector_type(2)));
#define LAS __attribute__((address_space(3)))

__device__ __forceinline__ unsigned f2bf(float f) { unsigned u = __builtin_bit_cast(unsigned, f); return (u + 0x7fffu + ((u >> 16) & 1u)) >> 16; }
__device__ __forceinline__ unsigned pk2(float lo, float hi) { return f2bf(lo) | (f2bf(hi) << 16); }
__device__ __forceinline__ float bf2f(unsigned short b) { return __builtin_bit_cast(float, (unsigned)b << 16); }
__device__ __forceinline__ float bflo(unsigned w) { return __builtin_bit_cast(float, w << 16); }
__device__ __forceinline__ float bfhi(unsigned w) { return __builtin_bit_cast(float, w & 0xffff0000u); }
__device__ __forceinline__ float wave_sum(float v) {
#pragma unroll
    for (int o = 1; o < 64; o <<= 1) v += __shfl_xor(v, o);
    return v;
}
__device__ __forceinline__ float sigmoidf_(float x) { return 1.0f / (1.0f + __expf(-x)); }
__device__ __forceinline__ float siluf_(float x) { return x / (1.0f + __expf(-x)); }

namespace pg8 {
struct EpiSwiglu {
    static constexpr bool PERM = true, AFTER_DRAIN = false;
    bf16_t* O; int ldc; int pad_;
    __device__ __forceinline__ void operator()(const f32x4 (&acc)[2][2][4][2], const Unit& u, int wr, int wc, int fr, int fq) const {
        const int row0 = u.pm * BM + wr * 64 + fr, col0 = u.pn * 128 + wc * 32 + 8 * fq;
#pragma unroll
        for (int ai = 0; ai < 2; ++ai)
#pragma unroll
            for (int m = 0; m < 4; ++m) {
                bf16_t* rowp = O + (size_t)(row0 + ai * HALF + m * 16) * ldc + col0;
                float v[8];
#pragma unroll
                for (int n = 0; n < 2; ++n)
#pragma unroll
                    for (int e = 0; e < 4; ++e) { const float g = acc[ai][0][m][n][e], uu = acc[ai][1][m][n][e]; v[n * 4 + e] = g * __builtin_amdgcn_rcpf(1.0f + __expf(-g)) * uu; }
                u32x4 w; w.x = cvt_pk_bf16(v[0], v[1]); w.y = cvt_pk_bf16(v[2], v[3]); w.z = cvt_pk_bf16(v[4], v[5]); w.w = cvt_pk_bf16(v[6], v[7]);
                *(u32x4*)rowp = w;
            }
    }
};
struct EpiF32 {
    static constexpr bool PERM = false, AFTER_DRAIN = false;
    float* O; int ldc; int pad_;
    __device__ __forceinline__ void operator()(const f32x4 (&acc)[2][2][4][2], const Unit& u, int wr, int wc, int fr, int fq) const {
        const int row0 = u.pm * BM + wr * 64 + fr, col0 = u.pn * BM + wc * 32 + 4 * fq;
#pragma unroll
        for (int ai = 0; ai < 2; ++ai)
#pragma unroll
            for (int m = 0; m < 4; ++m) {
                float* rowp = O + (size_t)(row0 + ai * HALF + m * 16) * ldc + col0;
#pragma unroll
                for (int bj = 0; bj < 2; ++bj)
#pragma unroll
                    for (int n = 0; n < 2; ++n) *(f32x4*)(rowp + bj * HALF + n * 16) = acc[ai][bj][m][n];
            }
    }
};
struct EpiInProj {
    static constexpr bool PERM = true, AFTER_DRAIN = false;
    bf16_t* PA; bf16_t* PD; bf16_t* PZ; float* AB;
    __device__ __forceinline__ void operator()(const f32x4 (&acc)[2][2][4][2], const Unit& u, int wr, int wc, int fr, int fq) const {
        const int row0 = u.pm * BM + wr * 64 + fr;
        if (u.pn == 29) {
            if (wc == 0) {
#pragma unroll
                for (int ai = 0; ai < 2; ++ai)
#pragma unroll
                    for (int m = 0; m < 4; ++m) {
                        float* rowp = AB + (size_t)(row0 + ai * HALF + m * 16) * 32 + 8 * fq;
                        *(f32x4*)rowp = acc[ai][0][m][0]; *(f32x4*)(rowp + 4) = acc[ai][0][m][1];
                    }
            }
            return;
        }
        bf16_t* base; int ldc, ct;
        if (u.pn < 9) { base = PA; ldc = 2304; ct = u.pn; } else if (u.pn < 18) { base = PD; ldc = 2304; ct = u.pn - 9; } else { base = PZ; ldc = 2816; ct = u.pn - 18; }
        const int col0 = ct * BM + wc * 32 + 8 * fq;
#pragma unroll
        for (int ai = 0; ai < 2; ++ai)
#pragma unroll
            for (int m = 0; m < 4; ++m) {
                bf16_t* rowp = base + (size_t)(row0 + ai * HALF + m * 16) * ldc + col0;
#pragma unroll
                for (int bj = 0; bj < 2; ++bj) { const f32x4 v0 = acc[ai][bj][m][0], v1 = acc[ai][bj][m][1];
                    u32x4 w; w.x = cvt_pk_bf16(v0[0], v0[1]); w.y = cvt_pk_bf16(v0[2], v0[3]); w.z = cvt_pk_bf16(v1[0], v1[1]); w.w = cvt_pk_bf16(v1[2], v1[3]);
                    *(u32x4*)(rowp + bj * HALF) = w; }
            }
    }
};
struct EpiGateF32 {
    static constexpr bool PERM = false, AFTER_DRAIN = false;
    float* O; const bf16_t* gate; int ldg; int pad_;
    __device__ __forceinline__ void operator()(const f32x4 (&acc)[2][2][4][2], const Unit& u, int wr, int wc, int fr, int fq) const {
        const int row0 = u.pm * BM + wr * 64 + fr, col0 = u.pn * BM + wc * 32 + 4 * fq;
#pragma unroll
        for (int ai = 0; ai < 2; ++ai)
#pragma unroll
            for (int m = 0; m < 4; ++m) {
                const size_t r = (size_t)(row0 + ai * HALF + m * 16);
#pragma unroll
                for (int bj = 0; bj < 2; ++bj)
#pragma unroll
                    for (int n = 0; n < 2; ++n) { const int c = col0 + bj * HALF + n * 16;
                        const v2u gw = *(const v2u*)(gate + r * ldg + c);
                        f32x4 a = acc[ai][bj][m][n];
                        a[0] *= sigmoidf_(bflo(gw.x)); a[1] *= sigmoidf_(bfhi(gw.x)); a[2] *= sigmoidf_(bflo(gw.y)); a[3] *= sigmoidf_(bfhi(gw.y));
                        *(f32x4*)(O + r * 1024 + c) = a; }
            }
    }
};
struct EpiGateAddBf16 {
    static constexpr bool PERM = false, AFTER_DRAIN = false;
    bf16_t* O; const float* T1; const bf16_t* gate; int ldg; int pad_;
    __device__ __forceinline__ void operator()(const f32x4 (&acc)[2][2][4][2], const Unit& u, int wr, int wc, int fr, int fq) const {
        const int row0 = u.pm * BM + wr * 64 + fr, col0 = u.pn * BM + wc * 32 + 4 * fq;
#pragma unroll
        for (int ai = 0; ai < 2; ++ai)
#pragma unroll
            for (int m = 0; m < 4; ++m) {
                const size_t r = (size_t)(row0 + ai * HALF + m * 16);
#pragma unroll
                for (int bj = 0; bj < 2; ++bj)
#pragma unroll
                    for (int n = 0; n < 2; ++n) { const int c = col0 + bj * HALF + n * 16;
                        const v2u gw = *(const v2u*)(gate + r * ldg + c);
                        const f32x4 t = *(const f32x4*)(T1 + r * 1024 + c);
                        f32x4 a = acc[ai][bj][m][n];
                        a[0] = t[0] + a[0] * sigmoidf_(bflo(gw.x)); a[1] = t[1] + a[1] * sigmoidf_(bfhi(gw.x)); a[2] = t[2] + a[2] * sigmoidf_(bflo(gw.y)); a[3] = t[3] + a[3] * sigmoidf_(bfhi(gw.y));
                        v2u w; w.x = cvt_pk_bf16(a[0], a[1]); w.y = cvt_pk_bf16(a[2], a[3]);
                        *(v2u*)(O + r * 1024 + c) = w; }
            }
    }
};
}


#define GAS __attribute__((address_space(1)))
struct Params { const float* in[17]; float* out; unsigned char* ws; };
#define XB_TMO      128
#define XB_XCNT(j)  (256  + 64 * (j))
#define XB_XSUB(j)  (1280 + 64 * (j))
#define XB_XGEN(j)  (2304 + 64 * (j))
#define XB_TOP      3328
#define XB_TOPGEN   3392
#define XCD_BAR_WORDS 3456
#define XB_SPIN_CAP (1u << 18)

__device__ __forceinline__ unsigned xb_ld(unsigned* p)              { return __hip_atomic_load(p, __ATOMIC_RELAXED, __HIP_MEMORY_SCOPE_AGENT); }
__device__ __forceinline__ unsigned xb_add(unsigned* p, unsigned v) { return __hip_atomic_fetch_add(p, v, __ATOMIC_RELAXED, __HIP_MEMORY_SCOPE_AGENT); }
__device__ __forceinline__ unsigned xb_xcc_id() { return (unsigned)__builtin_amdgcn_s_getreg((3 << 11) | 20) & 0xFu; }
#define XB_SPIN(cond, bar) do { unsigned _sp = 0; while (cond) { __builtin_amdgcn_s_sleep(1); \
    if ((++_sp & 255u) == 0u) { if (xb_ld(&(bar)[XB_TMO])) break; if (_sp > XB_SPIN_CAP) { atomicAdd(&(bar)[XB_TMO], 1u); break; } } } } while (0)

struct XcdBarrier {
    unsigned* bar; unsigned x;
    volatile LAS unsigned* st;
};

__device__ __forceinline__ XcdBarrier xcd_barrier_post(unsigned* bar, volatile LAS unsigned* st) {
    XcdBarrier b; b.bar = bar; b.x = xb_xcc_id(); b.st = st;
    if (threadIdx.x == 0) (void)xb_add(&bar[XB_XCNT(b.x)], 1u);
    return b;
}
__device__ __forceinline__ void xcd_barrier_complete(unsigned* bar, unsigned x, unsigned& nloc, unsigned& nx) {
    const unsigned G = gridDim.x * gridDim.y * gridDim.z;
    unsigned sum, cnt, mine, sp = 0u;
    for (;;) {
        sum = 0u; cnt = 0u; mine = 0u;
#pragma unroll
        for (unsigned j = 0; j < 16; ++j) { const unsigned c = xb_ld(&bar[XB_XCNT(j)]); sum += c; cnt += (c > 0u) ? 1u : 0u; mine = (j == x) ? c : mine; }
        if (sum == G) break;
        __builtin_amdgcn_s_sleep(1);
        if ((++sp & 255u) == 0u) { if (xb_ld(&bar[XB_TMO])) break; if (sp > XB_SPIN_CAP) { atomicAdd(&bar[XB_TMO], 1u); break; } }
    }
    nloc = mine > 0u ? mine : 1u; nx = cnt > 0u ? cnt : 1u;
}

__device__ __forceinline__ void xcd_barrier(const XcdBarrier& b, int wv) {
    const bool leader_thread = (wv == 0) && (lane_id_() == 0);
    asm volatile("s_waitcnt vmcnt(0)" ::: "memory");
    __syncthreads();
    if (leader_thread) {
        unsigned* bar = b.bar;
        __builtin_amdgcn_s_waitcnt(0);
        unsigned nloc = b.st[0], nx = b.st[1];
        if (nloc == 0u) { xcd_barrier_complete(bar, b.x, nloc, nx); b.st[0] = nloc; b.st[1] = nx; }
        const unsigned old = xb_add(&bar[XB_XSUB(b.x)], 1u);
        const unsigned gen = old / nloc;
        if (old + 1u == (gen + 1u) * nloc) {
            __builtin_amdgcn_fence(__ATOMIC_RELEASE, "agent");
            asm volatile("s_waitcnt vmcnt(0)" ::: "memory");
            const unsigned og = xb_add(&bar[XB_TOP], 1u);
            const unsigned tg = og / nx;
            if (og + 1u == (tg + 1u) * nx) xb_add(&bar[XB_TOPGEN], 1u);
            else XB_SPIN(xb_ld(&bar[XB_TOPGEN]) == tg, bar);
            __builtin_amdgcn_fence(__ATOMIC_ACQUIRE, "agent");
            xb_add(&bar[XB_XGEN(b.x)], 1u);
            asm volatile("s_waitcnt vmcnt(0)" ::: "memory");
        } else {
            XB_SPIN(xb_ld(&bar[XB_XGEN(b.x)]) == gen, bar);
            __builtin_amdgcn_fence(__ATOMIC_ACQUIRE, "agent");
            asm volatile("s_waitcnt vmcnt(0)" ::: "memory");
        }
    }
    __syncthreads();
}

#define BID ((int)blockIdx.x)
#define GSZ ((int)gridDim.x)
__device__ __forceinline__ int srcmap(int mode, int n) {
    if (mode == 0) return n;
    if (mode == 1) return (n >> 8) * 128 + (n & 127) + ((n >> 7) & 1) * 2816;
    if (n < 5376) return n;
    if (n < 6400) return 5400 + (n - 5376);
    if (n < 7424) return 6424 + (n - 6400);
    if (n < 7448) return 5376 + (n - 7424);
    return -1;
}
__device__ __forceinline__ void conv_item(const float* W, bf16* WT, int K, int Nsrc, int Ndst, int mode, int item, float* scr, int lane) {
    const int nblk = Ndst / 32, kb = item / nblk, nb = item % nblk, k0 = 64 * kb, n0 = 32 * nb;
    const int sc = srcmap(mode, n0 + (lane & 31));
#pragma unroll 8
    for (int i = 0; i < 32; ++i) { const int kk = 2 * i + (lane >> 5); scr[kk * 33 + (lane & 31)] = sc >= 0 ? W[(size_t)(k0 + kk) * Nsrc + sc] : 0.f; }
    __builtin_amdgcn_s_waitcnt(0xc07f); __builtin_amdgcn_wave_barrier();
    const int c = lane & 7;
#pragma unroll
    for (int j = 0; j < 4; ++j) { const int n = (lane >> 3) + 8 * j; const float* s = scr + (8 * c) * 33 + n;
        v4u o; o.x = pk2(s[0 * 33], s[1 * 33]); o.y = pk2(s[2 * 33], s[3 * 33]); o.z = pk2(s[4 * 33], s[5 * 33]); o.w = pk2(s[6 * 33], s[7 * 33]);
        *(v4u*)(WT + (size_t)(n0 + n) * K + k0 + 8 * c) = o; }
    __builtin_amdgcn_s_waitcnt(0xc07f); __builtin_amdgcn_wave_barrier();
}
__device__ __forceinline__ void ph_convert(const Params& P, int l, unsigned char* lds, int wv) {
    int tid_ = wv * 64 + lane_id_(); asm volatile("" : "+v"(tid_)); const int lane = tid_ & 63, wave = tid_ >> 6;
    float* scr = (float*)lds + wave * (64 * 33);
    unsigned char* wb = P.ws + WS_W;
    constexpr int I_FI = 16 * 176, I_FO = 44 * 32, I_IN = 16 * 240, I_BA = 4 * 32, I_BD = 12 * 32, I_O = 16 * 32;
    constexpr int NIT = 2 * I_FI + 2 * I_FO + I_IN + I_BA + I_BD + I_O;
    for (int it = BID * 8 + wave; it < NIT; it += GSZ * 8) {
        int r = it;
        if (r < 2 * I_FI) { const int f = r / I_FI; conv_item(P.in[7] + ((size_t)l * 2 + f) * 1024 * 5632, (bf16*)(wb + (f ? W_FFIN1 : W_FFIN0)), 1024, 5632, 5632, 1, r % I_FI, scr, lane); continue; } r -= 2 * I_FI;
        if (r < 2 * I_FO) { const int f = r / I_FO; conv_item(P.in[8] + ((size_t)l * 2 + f) * 2816 * 1024, (bf16*)(wb + (f ? W_FFOUT1 : W_FFOUT0)), 2816, 1024, 1024, 0, r % I_FO, scr, lane); continue; } r -= 2 * I_FO;
        if (r < I_IN) { conv_item(P.in[9] + (size_t)l * 1024 * NIN_, (bf16*)(wb + W_IN), 1024, NIN_, NINP_, 2, r, scr, lane); continue; } r -= I_IN;
        if (r < I_BA) { conv_item(P.in[14] + (size_t)l * 256 * 1024, (bf16*)(wb + W_BATT), 256, 1024, 1024, 0, r, scr, lane); continue; } r -= I_BA;
        if (r < I_BD) { conv_item(P.in[15] + (size_t)l * 768 * 1024, (bf16*)(wb + W_BDN), 768, 1024, 1024, 0, r, scr, lane); continue; } r -= I_BD;
        conv_item(P.in[16] + (size_t)l * 1024 * 1024, (bf16*)(wb + W_OUT), 1024, 1024, 1024, 0, r, scr, lane);
    }
}
__device__ __forceinline__ void ph_ada(const Params& P, unsigned char* lds, int wv) {
    float* red = (float*)(lds + 72 * 1024);
    int tid_ = wv * 64 + lane_id_(); asm volatile("" : "+v"(tid_)); const int lane = tid_ & 63, wave = tid_ >> 6;
    const float* c = P.in[1]; const float* w_ada = P.in[3]; const float* b_ada = P.in[4]; float* mod = (float*)(P.ws + WS_MOD);
    for (int u = BID; u < 2 * 144; u += GSZ) {
        const int l = u / 144, n = (u % 144) * 64 + lane;
        const float* W = w_ada + (size_t)l * 1024 * 9216 + n;
        float s = 0.f;
        for (int k = wave * 128; k < wave * 128 + 128; ++k) s += siluf_(c[k]) * W[(size_t)k * 9216];
        red[wave * 64 + lane] = s;
        __syncthreads();
        if (wave == 0) { float t = b_ada[l * 9216 + n];
#pragma unroll
            for (int w = 0; w < 8; ++w) t += red[w * 64 + lane];
            mod[l * 9216 + n] = t; }
        __syncthreads();
    }
}
__device__ const float ROPE_INV[32] = {1.000000000e+00f, 7.498942018e-01f, 5.623413324e-01f, 4.216965139e-01f, 3.162277639e-01f, 2.371373773e-01f, 1.778279394e-01f, 1.333521456e-01f, 1.000000015e-01f, 7.498942316e-02f, 5.623413250e-02f, 4.216964915e-02f, 3.162277490e-02f, 2.371373773e-02f, 1.778279431e-02f, 1.333521400e-02f, 9.999999776e-03f, 7.498942316e-03f, 5.623413250e-03f, 4.216964822e-03f, 3.162277630e-03f, 2.371373819e-03f, 1.778279431e-03f, 1.333521446e-03f, 1.000000047e-03f, 7.498941850e-04f, 5.623413017e-04f, 4.216965172e-04f, 3.162277571e-04f, 2.371373703e-04f, 1.778279402e-04f, 1.333521504e-04f};
__device__ __forceinline__ void ph_rope(const Params& P, int wv) {
    const int* pos = (const int*)P.in[2]; float* tab = (float*)(P.ws + WS_ROPE);
    int tid_ = wv * 64 + lane_id_(); asm volatile("" : "+v"(tid_));
    for (int idx = BID * NTHREADS + tid_; idx < S_ * 32; idx += GSZ * NTHREADS) {
        const int t = idx >> 5, i = idx & 31;
        const float inv = ROPE_INV[i];
        const float ang = (float)pos[t] * inv;
        float sn, cs; sincosf(ang, &sn, &cs);
        tab[idx] = cs; tab[S_ * 32 + idx] = sn;
    }
}
struct RowArgs { const float* xi; const float* y; float* xo; bf16* h; const float* wpost; const float* gate; const float* wpre; const float* shift; const float* scale; float coef; };
__device__ __forceinline__ void ph_rows(const RowArgs& a, int wv) {
    int tid_ = wv * 64 + lane_id_(); asm volatile("" : "+v"(tid_)); const int lane = tid_ & 63, wave = tid_ >> 6;
    for (int r = BID * 8 + wave; r < S_; r += GSZ * 8) {
        f32x4 x[4];
        const f32x4* xr = (const f32x4*)(a.xi + (size_t)r * D_) + lane;
#pragma unroll
        for (int j = 0; j < 4; ++j) x[j] = xr[64 * j];
        if (a.y) {
            f32x4 y[4]; float s = 0.f;
            const f32x4* yr = (const f32x4*)(a.y + (size_t)r * D_) + lane;
#pragma unroll
            for (int j = 0; j < 4; ++j) { y[j] = yr[64 * j]; s += (y[j].x * y[j].x + y[j].y * y[j].y) + (y[j].z * y[j].z + y[j].w * y[j].w); }
            const float rs = 1.0f / sqrtf(wave_sum(s) * (1.f / D_) + 1e-6f);
#pragma unroll
            for (int j = 0; j < 4; ++j) { const f32x4 wp = ((const f32x4*)a.wpost)[lane + 64 * j], g = ((const f32x4*)a.gate)[lane + 64 * j];
                x[j] = x[j] + a.coef * g * ((y[j] * rs) * wp); }
            f32x4* xw = (f32x4*)(a.xo + (size_t)r * D_) + lane;
#pragma unroll
            for (int j = 0; j < 4; ++j) xw[64 * j] = x[j];
        }
        if (a.h) {
            float s = 0.f;
#pragma unroll
            for (int j = 0; j < 4; ++j) s += (x[j].x * x[j].x + x[j].y * x[j].y) + (x[j].z * x[j].z + x[j].w * x[j].w);
            const float rs = 1.0f / sqrtf(wave_sum(s) * (1.f / D_) + 1e-6f);
            v2u* hw = (v2u*)(a.h + (size_t)r * D_) + lane;
#pragma unroll
            for (int j = 0; j < 4; ++j) { const f32x4 wp = ((const f32x4*)a.wpre)[lane + 64 * j], sc = ((const f32x4*)a.scale)[lane + 64 * j], sh = ((const f32x4*)a.shift)[lane + 64 * j];
                const f32x4 v = ((x[j] * rs) * wp) * (1.0f + sc) + sh;
                v2u w; w.x = pk2(v.x, v.y); w.y = pk2(v.z, v.w); hw[64 * j] = w; }
        }
    }
}
constexpr int ATT_PITCH = 68;
__device__ __forceinline__ void ph_attn_v1(const bf16* PA, const float* rope, bf16* OG, float* LSE, unsigned char* lds, int wv) {
    float* qs = (float*)lds; float* ks = qs + 64 * ATT_PITCH; float* vs = ks + 192 * ATT_PITCH;
    int tid_ = wv * 64 + lane_id_(); asm volatile("" : "+v"(tid_)); const int tid = tid_, lane = tid & 63, wave = tid >> 6;
    for (int u = BID; u < 3072; u += GSZ) {
        const int hg = u & 3, w = (u >> 2) & 255, gi = u >> 10;
        const int dil = 1 << (2 * gi), L = S_ / dil, r = w % dil, nb = w / dil, head = gi * 4 + hg;
        __syncthreads();
        for (int rr = wave; rr < 448; rr += 8) {
            int mm, colbase; float* dst; bool rot; float sc = 1.f;
            if (rr < 64) { mm = nb * 64 + rr; colbase = head * 64; dst = qs + rr * ATT_PITCH; rot = true; sc = 0.125f; }
            else if (rr < 256) { mm = nb * 64 - 64 + (rr - 64); colbase = 768 + head * 64; dst = ks + (rr - 64) * ATT_PITCH; rot = true; }
            else { mm = nb * 64 - 64 + (rr - 256); colbase = 1536 + head * 64; dst = vs + (rr - 256) * ATT_PITCH; rot = false; }
            float val = 0.f;
            if (mm >= 0 && mm < L) {
                const int tok = mm * dil + r;
                val = bf2f(PA[(size_t)tok * 2304 + colbase + lane]);
                if (rot) {
                    const float other = __shfl_xor(val, 32);
                    const float cs = rope[tok * 32 + (lane & 31)], sn = rope[S_ * 32 + tok * 32 + (lane & 31)];
                    val = (lane < 32) ? (val * cs - other * sn) : (val * cs + other * sn);
                }
            }
            dst[lane] = val * sc;
        }
        __syncthreads();
        const int i = tid >> 3, part = tid & 7;
        float q[64], acc[64];
#pragma unroll
        for (int d = 0; d < 64; d += 4) { const f32x4 t = *(const f32x4*)(qs + i * ATT_PITCH + d); q[d] = t.x; q[d + 1] = t.y; q[d + 2] = t.z; q[d + 3] = t.w; }
#pragma unroll
        for (int d = 0; d < 64; ++d) acc[d] = 0.f;
        float m = -1e30f, l = 0.f;
        for (int jj = 0; jj < 24; ++jj) {
            const int j = part + 8 * jj, mm = nb * 64 - 64 + j, dj = j - 64 - i;
            const bool ok = (dj <= 64) && (dj >= -64) && (mm >= 0) && (mm < L);
            if (ok) {
                const float* kr = ks + j * ATT_PITCH; float s = 0.f;
#pragma unroll
                for (int d = 0; d < 64; d += 4) { const f32x4 t = *(const f32x4*)(kr + d); s += q[d] * t.x + q[d + 1] * t.y + q[d + 2] * t.z + q[d + 3] * t.w; }
                const float mn = fmaxf(m, s), al = __expf(m - mn), p = __expf(s - mn);
                l = l * al + p; m = mn;
                const float* vr = vs + j * ATT_PITCH;
#pragma unroll
                for (int d = 0; d < 64; d += 4) { const f32x4 t = *(const f32x4*)(vr + d);
                    acc[d] = acc[d] * al + p * t.x; acc[d + 1] = acc[d + 1] * al + p * t.y; acc[d + 2] = acc[d + 2] * al + p * t.z; acc[d + 3] = acc[d + 3] * al + p * t.w; }
            }
        }
        float mt = fmaxf(m, __shfl_xor(m, 1)); mt = fmaxf(mt, __shfl_xor(mt, 2)); mt = fmaxf(mt, __shfl_xor(mt, 4));
        const float f = __expf(m - mt);
        l *= f; l += __shfl_xor(l, 1); l += __shfl_xor(l, 2); l += __shfl_xor(l, 4);
#pragma unroll
        for (int d = 0; d < 64; ++d) acc[d] *= f;
        const bool b2 = part & 4, b1 = part & 2, b0 = part & 1;
        float r32[32], r16[16], r8[8];
#pragma unroll
        for (int d = 0; d < 32; ++d) { const float keep = b2 ? acc[32 + d] : acc[d], send = b2 ? acc[d] : acc[32 + d]; r32[d] = keep + __shfl_xor(send, 4); }
#pragma unroll
        for (int d = 0; d < 16; ++d) { const float keep = b1 ? r32[16 + d] : r32[d], send = b1 ? r32[d] : r32[16 + d]; r16[d] = keep + __shfl_xor(send, 2); }
#pragma unroll
        for (int d = 0; d < 8; ++d) { const float keep = b0 ? r16[8 + d] : r16[d], send = b0 ? r16[d] : r16[8 + d]; r8[d] = keep + __shfl_xor(send, 1); }
        const float il = 1.0f / l;
        const int tok = (nb * 64 + i) * dil + r;
        v4u o; o.x = pk2(r8[0] * il, r8[1] * il); o.y = pk2(r8[2] * il, r8[3] * il); o.z = pk2(r8[4] * il, r8[5] * il); o.w = pk2(r8[6] * il, r8[7] * il);
        *(v4u*)(OG + ((size_t)gi * S_ + tok) * 256 + hg * 64 + part * 8) = o;
        if (part == 0) LSE[((size_t)gi * S_ + tok) * 4 + hg] = mt + logf(l);
    }
}

__device__ __forceinline__ void ph_dnprep(const bf16* PD, const float* AB, const float* convw, const float* a_log, const float* dt_bias, bf16* QKVd, float* GB, int wv) {
    int tid_ = wv * 64 + lane_id_(); asm volatile("" : "+v"(tid_)); const int lane = tid_ & 63, wave = tid_ >> 6;
    const int gw = BID * 8 + wave, NGW = GSZ * 8;
    for (int t = gw; t < S_; t += NGW) {
        for (int seg = 0; seg < 18; ++seg) {
            const int c0 = seg * 128 + 2 * lane;
            float a0 = 0.f, a1 = 0.f;
#pragma unroll
            for (int j = 0; j < 5; ++j) { const int tt = t + j - 2;
                if (tt >= 0 && tt < S_) { const unsigned w = *(const unsigned*)(PD + (size_t)tt * 2304 + c0); const f32x2 cw = *(const f32x2*)(convw + j * 2304 + c0);
                    a0 += bflo(w) * cw.x; a1 += bfhi(w) * cw.y; } }
            a0 = siluf_(a0); a1 = siluf_(a1);
            if (seg < 12) { const float ss = wave_sum(a0 * a0 + a1 * a1); const float sc = (1.0f / sqrtf(ss + 1e-6f)) * (seg < 6 ? 0.08838834764831845f : 1.0f); a0 *= sc; a1 *= sc; }
            *(unsigned*)(QKVd + (size_t)t * 2304 + c0) = pk2(a0, a1);
        }
        if (lane < 12) {
            const float braw = AB[(size_t)t * 32 + lane], araw = AB[(size_t)t * 32 + 12 + lane];
            const float x = araw + dt_bias[lane];
            const float sp = fmaxf(x, 0.f) + log1pf(expf(-fabsf(x)));
            GB[(size_t)lane * S_ + t] = -expf(a_log[lane]) * sp;
            GB[(size_t)(12 + lane) * S_ + t] = 1.0f / (1.0f + expf(-braw));
        }
    }
}

__device__ __forceinline__ void ph_final(const bf16* ODIR, const bf16* PZ, const float* dnw, const bf16* OG, const float* LSE, bf16* ODN, bf16* OATT, int wv) {
    int tid_ = wv * 64 + lane_id_(); asm volatile("" : "+v"(tid_)); const int lane = tid_ & 63, wave = tid_ >> 6;
    const int gw = BID * 8 + wave, NGW = GSZ * 8;
    for (int t = gw; t < S_; t += NGW) {
#pragma unroll
        for (int h = 0; h < 6; ++h) {
            const int c = h * 128 + 2 * lane;
            const unsigned wf = *(const unsigned*)(ODIR + (size_t)t * 768 + c), wb = *(const unsigned*)(ODIR + ((size_t)S_ + t) * 768 + c);
            float o0 = bflo(wf) + bflo(wb), o1 = bfhi(wf) + bfhi(wb);
            const float ms = wave_sum(o0 * o0 + o1 * o1) * (1.0f / 128.0f);
            const float sc = 1.0f / sqrtf(ms + 1e-6f);
            const unsigned zw = *(const unsigned*)(PZ + (size_t)t * 2816 + c);
            const f32x2 nw = *(const f32x2*)(dnw + 2 * lane);
            o0 = o0 * sc * nw.x * siluf_(bflo(zw)); o1 = o1 * sc * nw.y * siluf_(bfhi(zw));
            *(unsigned*)(ODN + (size_t)t * 768 + c) = pk2(o0, o1);
        }
        {
            const int ch = 4 * lane, hg = lane >> 4;
            const float l0 = LSE[(size_t)t * 4 + hg], l1 = LSE[((size_t)S_ + t) * 4 + hg], l2 = LSE[((size_t)2 * S_ + t) * 4 + hg];
            const float mx = fmaxf(l0, fmaxf(l1, l2));
            float w0 = expf(l0 - mx), w1 = expf(l1 - mx), w2 = expf(l2 - mx);
            const float inv = 1.0f / (w0 + w1 + w2); w0 *= inv; w1 *= inv; w2 *= inv;
            const v2u a = *(const v2u*)(OG + (size_t)t * 256 + ch), b = *(const v2u*)(OG + ((size_t)S_ + t) * 256 + ch), cc = *(const v2u*)(OG + ((size_t)2 * S_ + t) * 256 + ch);
            v2u o;
            o.x = pk2(w0 * bflo(a.x) + w1 * bflo(b.x) + w2 * bflo(cc.x), w0 * bfhi(a.x) + w1 * bfhi(b.x) + w2 * bfhi(cc.x));
            o.y = pk2(w0 * bflo(a.y) + w1 * bflo(b.y) + w2 * bflo(cc.y), w0 * bfhi(a.y) + w1 * bfhi(b.y) + w2 * bfhi(cc.y));
            *(v2u*)(OATT + (size_t)t * 256 + ch) = o;
        }
    }
}
__device__ __forceinline__ void ph_dn_naive(const bf16* QKVd, const float* GB, bf16* ODIR, unsigned char* lds, int wv) {
    if (BID >= 12) return;
    float* qb = (float*)lds; float* kb = qb + 32 * 128; float* vb = kb + 32 * 128; float* gb = vb + 32 * 128; float* bb = gb + 32;
    int tid_ = wv * 64 + lane_id_(); asm volatile("" : "+v"(tid_)); const int tid = tid_, c = (tid & 255) >> 1, half = tid & 1;
    const int dir = BID / 6, h = BID % 6;
    float St[64];
#pragma unroll
    for (int a = 0; a < 64; ++a) St[a] = 0.f;
    const float* G = GB + (size_t)(dir * 6 + h) * S_; const float* BE = GB + (size_t)(12 + dir * 6 + h) * S_;
    for (int s0 = 0; s0 < S_; s0 += 32) {
        __syncthreads();
        for (int e = tid; e < 32 * 128; e += NTHREADS) { const int rr = e >> 7, cc = e & 127; const int tok = dir ? (S_ - 1 - (s0 + rr)) : (s0 + rr);
            const bf16* p = QKVd + (size_t)tok * 2304 + h * 128 + cc;
            qb[rr * 128 + cc] = bf2f(p[0]); kb[rr * 128 + cc] = bf2f(p[768]); vb[rr * 128 + cc] = bf2f(p[1536]); }
        if (tid < 32) { const int tok = dir ? (S_ - 1 - (s0 + tid)) : (s0 + tid); gb[tid] = G[tok]; bb[tid] = BE[tok]; }
        __syncthreads();
        if (tid < 256) {
            for (int rr = 0; rr < 32; ++rr) {
                const float* kr = kb + rr * 128 + half * 64; const float* qr = qb + rr * 128 + half * 64;
                float ksum = 0.f;
#pragma unroll
                for (int a = 0; a < 64; a += 4) { const f32x4 t = *(const f32x4*)(kr + a); ksum += t.x * St[a] + t.y * St[a + 1] + t.z * St[a + 2] + t.w * St[a + 3]; }
                ksum += __shfl_xor(ksum, 1);
                const float eg = expf(gb[rr]);
                const float coef = bb[rr] * (vb[rr * 128 + c] - eg * ksum);
                float o = 0.f;
#pragma unroll
                for (int a = 0; a < 64; a += 4) { const f32x4 t = *(const f32x4*)(kr + a); const f32x4 qq = *(const f32x4*)(qr + a);
                    St[a] = eg * St[a] + t.x * coef; St[a + 1] = eg * St[a + 1] + t.y * coef; St[a + 2] = eg * St[a + 2] + t.z * coef; St[a + 3] = eg * St[a + 3] + t.w * coef;
                    o += qq.x * St[a] + qq.y * St[a + 1] + qq.z * St[a + 2] + qq.w * St[a + 3]; }
                o += __shfl_xor(o, 1);
                if (half == 0) { const int tok = dir ? (S_ - 1 - (s0 + rr)) : (s0 + rr); ODIR[((size_t)dir * S_ + tok) * 768 + h * 128 + c] = (bf16)f2bf(o); }
            }
        }
    }
}
constexpr int LDS_RING = 131072, LDS_CTL_OFF = LDS_RING, LDS_BYTES = 147456;
constexpr int CW_BAR = 4096;
__device__ __forceinline__ unsigned char* wsp(const Params& P) { unsigned char* w = P.ws; asm volatile("" : "+s"(w)); return w; }
template <class Epi> __device__ __forceinline__ void run_gemm(LAS unsigned char* lds, const bf16* A, const bf16* Bt, int N, int K, const Epi& E, int wv) {
    pg8::Gemm g{A, Bt, S_, N, K, 0};
    pg8::StaticOrder S; S.init(S_, N, GSZ, BID);
    pg8::gemm_phase<Epi, pg8::StaticOrder, true, true>(lds, g, S, E, wv);
}
__global__ void __launch_bounds__(NTHREADS, 2) mega_fwd(Params P) {
    extern __shared__ __attribute__((aligned(16))) unsigned char lds_raw[];
    LAS unsigned char* lds = (LAS unsigned char*)lds_raw;
    const int wv = __builtin_amdgcn_readfirstlane((int)threadIdx.x >> 6);
    { const int tid0 = threadIdx.x;
      for (int u = tid0; u < (LDS_BYTES - LDS_CTL_OFF) / 4; u += NTHREADS) ((LAS unsigned*)(lds + LDS_CTL_OFF))[u] = 0u;
      __syncthreads();
      XcdBarrier b0 = xcd_barrier_post((unsigned*)(P.ws + WS_CTL) + CW_BAR, (volatile LAS unsigned*)(lds + LDS_CTL_OFF + 320) + 8);
      if (tid0 == 0) ((volatile LAS unsigned*)(lds + LDS_CTL_OFF + 320))[10] = b0.x;
      __syncthreads(); }
#define GRID_BAR() do { XcdBarrier b_; b_.bar = (unsigned*)(wsp(P) + WS_CTL) + CW_BAR; b_.st = (volatile LAS unsigned*)(lds + LDS_CTL_OFF + 320) + 8; b_.x = b_.st[2]; xcd_barrier(b_, wv); } while (0)
#define WSB() wsp(P)
    ph_ada(P, lds_raw, wv); ph_rope(P, wv); ph_convert(P, 0, lds_raw, wv);
    GRID_BAR();
    { unsigned char* ws = WSB(); float* MOD = (float*)(ws + WS_MOD);
      RowArgs a; a.xi = P.in[0]; a.y = nullptr; a.xo = nullptr; a.h = (bf16*)(ws + WS_H); a.wpost = nullptr; a.gate = nullptr; a.wpre = P.in[5]; a.shift = MOD; a.scale = MOD + 1024; a.coef = 0.f; ph_rows(a, wv); }
    GRID_BAR();
#pragma unroll 1
    for (int l = 0; l < 2; ++l) {
#pragma unroll 1
        for (int f = 0; f < 2; ++f) {
            if (f == 1) {
                { unsigned char* ws = WSB(); unsigned char* R = ws + WS_R;
                  pg8::EpiInProj E; E.PA = (bf16*)(R + R_PA); E.PD = (bf16*)(R + R_PD); E.PZ = (bf16*)(R + R_PZ); E.AB = (float*)(R + R_AB);
                  run_gemm(lds, (const bf16*)(ws + WS_H), (const bf16*)(ws + WS_W + W_IN), NINP_, 1024, E, wv); }
                GRID_BAR();
                { unsigned char* ws = WSB(); unsigned char* R = ws + WS_R;
                  ph_attn_v1((const bf16*)(R + R_PA), (const float*)(ws + WS_ROPE), (bf16*)(ws + WS_H), (float*)(ws + WS_H + 24 * MiB), lds_raw, wv); }
                GRID_BAR();
                { unsigned char* ws = WSB(); unsigned char* R = ws + WS_R;
                  ph_dnprep((const bf16*)(R + R_PD), (const float*)(R + R_AB), P.in[10] + (size_t)l * 5 * 2304, P.in[11] + l * 12, P.in[12] + l * 12, (bf16*)(R + R_PA), (float*)(R + R_GB), wv); }
                GRID_BAR();
                { unsigned char* ws = WSB(); unsigned char* R = ws + WS_R;
                  ph_dn_naive((const bf16*)(R + R_PA), (const float*)(R + R_GB), (bf16*)(R + R_PD), lds_raw, wv); }
                GRID_BAR();
                { unsigned char* ws = WSB(); unsigned char* R = ws + WS_R;
                  ph_final((const bf16*)(R + R_PD), (const bf16*)(R + R_PZ), P.in[13] + l * 128, (const bf16*)(ws + WS_H), (const float*)(ws + WS_H + 24 * MiB), (bf16*)(R + R_PD + 48 * MiB), (bf16*)(R + R_OATT), wv); }
                GRID_BAR();
                { unsigned char* ws = WSB(); unsigned char* R = ws + WS_R;
                  pg8::EpiGateF32 E; E.O = (float*)(R + R_PA); E.gate = (const bf16*)(R + R_PZ) + 768; E.ldg = 2816; E.pad_ = 0;
                  run_gemm(lds, (const bf16*)(R + R_OATT), (const bf16*)(ws + WS_W + W_BATT), 1024, 256, E, wv); }
                { unsigned char* ws = WSB(); unsigned char* R = ws + WS_R;
                  pg8::EpiGateAddBf16 E; E.O = (bf16*)(ws + WS_H); E.T1 = (const float*)(R + R_PA); E.gate = (const bf16*)(R + R_PZ) + 1792; E.ldg = 2816; E.pad_ = 0;
                  run_gemm(lds, (const bf16*)(R + R_PD + 48 * MiB), (const bf16*)(ws + WS_W + W_BDN), 1024, 768, E, wv); }
                GRID_BAR();
                { unsigned char* ws = WSB(); unsigned char* R = ws + WS_R;
                  pg8::EpiF32 E; E.O = (float*)(R + R_PA); E.ldc = 1024; E.pad_ = 0; run_gemm(lds, (const bf16*)(ws + WS_H), (const bf16*)(ws + WS_W + W_OUT), 1024, 1024, E, wv); }
                GRID_BAR();
                { unsigned char* ws = WSB(); unsigned char* R = ws + WS_R; const float* mod = (const float*)(ws + WS_MOD) + l * 9216;
                  RowArgs a; a.xi = P.out; a.y = (const float*)(R + R_PA); a.xo = P.out; a.h = (bf16*)(ws + WS_H); a.wpost = P.in[6] + (l * 3 + 1) * 1024; a.gate = mod + (1 * 3 + 2) * 1024; a.coef = 1.0f;
                  a.wpre = P.in[5] + (l * 3 + 2) * 1024; a.shift = mod + (2 * 3 + 0) * 1024; a.scale = mod + (2 * 3 + 1) * 1024; ph_rows(a, wv); }
                GRID_BAR();
            }
            const int s = f * 2;
            { unsigned char* ws = WSB(); unsigned char* R = ws + WS_R;
              pg8::EpiSwiglu E; E.O = (bf16*)(R + R_ACT); E.ldc = FF_; E.pad_ = 0; run_gemm(lds, (const bf16*)(ws + WS_H), (const bf16*)(ws + WS_W + (f ? W_FFIN1 : W_FFIN0)), 2 * FF_, 1024, E, wv); }
            GRID_BAR();
            { unsigned char* ws = WSB(); unsigned char* R = ws + WS_R;
              pg8::EpiF32 E; E.O = (float*)(R + R_Y); E.ldc = 1024; E.pad_ = 0; run_gemm(lds, (const bf16*)(R + R_ACT), (const bf16*)(ws + WS_W + (f ? W_FFOUT1 : W_FFOUT0)), 1024, FF_, E, wv); }
            GRID_BAR();
            { unsigned char* ws = WSB(); unsigned char* R = ws + WS_R; const float* MOD = (const float*)(ws + WS_MOD); const float* mod = MOD + l * 9216;
              RowArgs a; a.xi = (l == 0 && f == 0) ? P.in[0] : P.out; a.y = (const float*)(R + R_Y); a.xo = P.out; a.wpost = P.in[6] + (l * 3 + s) * 1024; a.gate = mod + (s * 3 + 2) * 1024; a.coef = 0.5f;
              if (f == 0) { a.h = (bf16*)(ws + WS_H); a.wpre = P.in[5] + (l * 3 + 1) * 1024; a.shift = mod + (1 * 3 + 0) * 1024; a.scale = mod + (1 * 3 + 1) * 1024; }
              else if (l == 0) { a.h = (bf16*)(ws + WS_H); a.wpre = P.in[5] + (1 * 3 + 0) * 1024; a.shift = MOD + 9216; a.scale = MOD + 9216 + 1024; }
              else { a.h = nullptr; a.wpre = nullptr; a.shift = nullptr; a.scale = nullptr; }
              ph_rows(a, wv);
              if (f == 1 && l == 0) ph_convert(P, 1, lds_raw, wv); }
            GRID_BAR();
        }
    }
}

extern "C" void kernel_launch(void* const* d_in, const int* in_sizes, int n_in, void* d_out, int out_size, void* d_ws, size_t ws_size, hipStream_t stream) {
    static int grid = 0;
    if (grid == 0) {
        if (n_in != 17 || ws_size < WS_END) { fprintf(stderr, "kernel_launch: unexpected n_in %d / ws_size %zu\n", n_in, ws_size); grid = -1; return; }
        int dev = 0, cus = 0, per_cu = 0;
        if (hipGetDevice(&dev) != hipSuccess || hipDeviceGetAttribute(&cus, hipDeviceAttributeMultiprocessorCount, dev) != hipSuccess) { grid = -1; return; }
        if (hipFuncSetAttribute((const void*)mega_fwd, hipFuncAttributeMaxDynamicSharedMemorySize, LDS_BYTES) != hipSuccess) { fprintf(stderr, "kernel_launch: hipFuncSetAttribute failed\n"); grid = -1; return; }
        if (hipOccupancyMaxActiveBlocksPerMultiprocessor(&per_cu, (const void*)mega_fwd, NTHREADS, LDS_BYTES) != hipSuccess || per_cu < 1) { fprintf(stderr, "kernel_launch: occupancy query says %d\n", per_cu); per_cu = 1; }
        (void)hipGetLastError();
        grid = cus;
        if (grid > 256) grid = 256;
    }
    if (grid < 0) return;
    (void)hipMemsetAsync((char*)d_ws + WS_CTL, 0, 1 * MiB, stream);
    Params p{};
    for (int i = 0; i < 17; ++i) p.in[i] = (const float*)d_in[i];
    p.out = (float*)d_out; p.ws = (unsigned char*)d_ws;
    hipLaunchKernelGGL(mega_fwd, dim3(grid), dim3(NTHREADS), LDS_BYTES, stream, p);
}
```

```cpp
#include <hip/hip_runtime.h>
#include <cstdio>
#include <cstdint>
__device__ __forceinline__ int lane_id_() { int l; asm volatile("v_mbcnt_lo_u32_b32 %0, -1, 0\n\tv_mbcnt_hi_u32_b32 %0, -1, %0" : "=v"(l)); return l; }
namespace pg8 {
#define PG8_LAS __attribute__((address_space(3)))
typedef unsigned short bf16_t;
typedef short bf16x8 __attribute__((ext_vector_type(8)));
typedef float f32x4 __attribute__((ext_vector_type(4)));
typedef unsigned u32x4 __attribute__((ext_vector_type(4)));
constexpr int BM = 256, BK = 64, HALF = 128, HTB = HALF * BK * 2  , STAGE_BYTES = 8 * HTB, NXCD = 8, WGM = 8;

__host__ __device__ __forceinline__ int lds_byte(int r, int c) { const int st = (r >> 4) * 2 + (c >> 5), rr = r & 15, cc = c & 31, ob = rr * 64 + cc * 2; return st * 1024 + (ob ^ (((ob >> 9) & 1) << 5)); }
__host__ __device__ __forceinline__ void stage_rc(int b, int& R, int& C) { const int st = b / 1024, sb = b % 1024, swz = sb ^ (((sb >> 9) & 1) << 5); R = (st >> 1) * 16 + swz / 64; C = (st & 1) * 32 + (swz % 64) / 2; }
__host__ __device__ __forceinline__ int perm32(int rho) { const int n = rho >> 4, i = rho & 15; return 8 * (i >> 2) + 4 * n + (i & 3); }

struct Unit { int pm, pn; };
struct Gemm { const bf16_t* A; const bf16_t* Bt; int M, N, K, pad_; };

struct StaticOrder {
    int nM, nN, nwg, G, c;
    __host__ __device__ void init(int M, int N, int G_, int c_) { nM = M / BM; nN = N / BM; nwg = nM * nN; G = G_; c = c_; }
    __host__ __device__ bool next(int i, Unit& u) const {
        const long L = (long)i * G + c; if (L >= nwg) return false;
        int wgid = (int)L; { const int q = nwg / NXCD, r = nwg % NXCD, xcd = wgid % NXCD, off = wgid / NXCD; wgid = (xcd < r ? xcd * (q + 1) : r * (q + 1) + (xcd - r) * q) + off; }
        const int nig = WGM * nN, gid = wgid / nig, fm = gid * WGM, gsz = (nM - fm) < WGM ? (nM - fm) : WGM;
        u.pm = fm + ((wgid % nig) % gsz); u.pn = (wgid % nig) / gsz; return true;
    }
    __device__ __forceinline__ void a_ready(const Unit&) const {}
    __device__ __forceinline__ void done(const Unit&) const {}
};

__device__ __forceinline__ unsigned cvt_pk_bf16(float lo, float hi) { unsigned r; asm volatile("v_cvt_pk_bf16_f32 %0, %1, %2" : "=v"(r) : "v"(lo), "v"(hi)); return r; }
typedef float f32x2 __attribute__((ext_vector_type(2)));
__device__ __forceinline__ f32x2 gelu_pk(f32x2 v) {
    const f32x2 av = __builtin_elementwise_abs(v), d = av * 0.2316418882f + 1.0f;
    f32x2 t; t.x = __builtin_amdgcn_rcpf(d.x); t.y = __builtin_amdgcn_rcpf(d.y);
    f32x2 q = t * 0.5307027145f + (-0.7265760135f); q = q * t + 0.7107068705f; q = q * t + (-0.142248368f); q = q * t + 0.127414796f; q = q * t;
    const f32x2 s = (v * v) * (-0.72134752044f);
    f32x2 e; e.x = __builtin_amdgcn_exp2f(s.x); e.y = __builtin_amdgcn_exp2f(s.y);
    const f32x2 m = v * (q * e), r = v - m;
    f32x2 o; o.x = v.x < 0.f ? m.x : r.x; o.y = v.y < 0.f ? m.y : r.y; return o;
}

template <int ACT  > struct EpiBf16 {
    static constexpr bool PERM = true, AFTER_DRAIN = false; static_assert(ACT == 0 || ACT == 1, "EpiBf16: ACT is 0 (none) or 1 (gelu_pk)");
    bf16_t* O; int ldc; const float* bias; int split_cols; size_t split_stride; float scale0;
    __device__ __forceinline__ void operator()(const f32x4 (&acc)[2][2][4][2], const Unit& u, int wr, int wc, int fr, int fq) const {
        const int row0 = u.pm * BM + wr * 64 + fr; int colt = u.pn * BM; bf16_t* base = O;
        float sc = 1.f; if (split_cols) { const int t = colt / split_cols; base += (size_t)t * split_stride; colt -= t * split_cols; if (t == 0) sc = scale0; }
        const int col0 = colt + wc * 32 + 8 * fq, bcol0 = u.pn * BM + wc * 32 + 8 * fq;
        f32x4 bv[2][2];
#pragma unroll
        for (int bj = 0; bj < 2; ++bj)
#pragma unroll
            for (int n = 0; n < 2; ++n) bv[bj][n] = bias ? *(const f32x4*)(bias + bcol0 + bj * HALF + 4 * n) : (f32x4){0.f, 0.f, 0.f, 0.f};
#pragma unroll
        for (int ai = 0; ai < 2; ++ai)
#pragma unroll
            for (int m = 0; m < 4; ++m) { bf16_t* rowp = base + (size_t)(row0 + ai * HALF + m * 16) * ldc + col0;
#pragma unroll
                for (int bj = 0; bj < 2; ++bj) { f32x4 v0 = acc[ai][bj][m][0] + bv[bj][0], v1 = acc[ai][bj][m][1] + bv[bj][1];
                    if (ACT == 1) { f32x2 a = gelu_pk((f32x2){v0[0], v0[1]}), b = gelu_pk((f32x2){v0[2], v0[3]}), c = gelu_pk((f32x2){v1[0], v1[1]}), d = gelu_pk((f32x2){v1[2], v1[3]});
                        v0 = (f32x4){a.x, a.y, b.x, b.y}; v1 = (f32x4){c.x, c.y, d.x, d.y}; }
                    v0 = v0 * sc; v1 = v1 * sc; u32x4 w; w.x = cvt_pk_bf16(v0[0], v0[1]); w.y = cvt_pk_bf16(v0[2], v0[3]); w.z = cvt_pk_bf16(v1[0], v1[1]); w.w = cvt_pk_bf16(v1[2], v1[3]);
                    *(u32x4*)(rowp + bj * HALF) = w; } }
    }
};

struct PanelStats {
    unsigned* xbuf;
    unsigned* cnt;
    unsigned* tmo;
    int ntn; float eps;
    unsigned code;
    __device__ __forceinline__ bool run(const f32x4 (&v)[2][2][4][2], const Unit& u, int wr, int wc, int fr, int fq, PG8_LAS unsigned char* lds, int wid, int lane) const {
        typedef float f32x2v __attribute__((ext_vector_type(2)));
        PG8_LAS f32x2v* P = (PG8_LAS f32x2v*)lds;
        PG8_LAS f32x2v* S = (PG8_LAS f32x2v*)(lds + 8192);
        PG8_LAS unsigned* flag = (PG8_LAS unsigned*)(lds + 8192 + 2048);
#pragma unroll
        for (int ai = 0; ai < 2; ++ai)
#pragma unroll
            for (int m = 0; m < 4; ++m) {
                float s = 0.f;
#pragma unroll
                for (int bj = 0; bj < 2; ++bj)
#pragma unroll
                    for (int n = 0; n < 2; ++n) { const f32x4 x = v[ai][bj][m][n]; s += (x[0] + x[1]) + (x[2] + x[3]); }
                s += __shfl_xor(s, 16); s += __shfl_xor(s, 32);
                const float mw = s * (1.0f / 64.0f); float q = 0.f;
#pragma unroll
                for (int bj = 0; bj < 2; ++bj)
#pragma unroll
                    for (int n = 0; n < 2; ++n) { const f32x4 d = v[ai][bj][m][n] - mw; q += (d[0] * d[0] + d[1] * d[1]) + (d[2] * d[2] + d[3] * d[3]); }
                q += __shfl_xor(q, 16); q += __shfl_xor(q, 32);
                if (fq == 0) P[(ai * HALF + wr * 64 + m * 16 + fr) * 4 + wc] = (f32x2v){mw, q};
            }
        asm volatile("s_waitcnt lgkmcnt(0)" ::: "memory"); __builtin_amdgcn_s_barrier(); asm volatile("" ::: "memory");
#if defined(BROKEN_EXCHANGE_NO_WAIT)
#warning BROKEN CONTROL BUILD: the row-statistics exchange does not wait; results are wrong by design
        if (blockIdx.x >= 64) { const long long t0_ = clock64(); while (clock64() - t0_ < 60000) __builtin_amdgcn_s_sleep(8); }
#endif
        const int row = wid * 32 + (lane & 31);
        if (lane < 32) {
            const f32x2v a = P[row * 4 + 0], b = P[row * 4 + 1], c = P[row * 4 + 2], d = P[row * 4 + 3];
            const float mt = (a.x + b.x + c.x + d.x) * 0.25f;
            const float da = a.x - mt, db = b.x - mt, dc = c.x - mt, dd = d.x - mt;
            const float m2 = (a.y + b.y) + (c.y + d.y) + 64.0f * ((da * da + db * db) + (dc * dc + dd * dd));
            unsigned long long* slot = (unsigned long long*)xbuf + ((size_t)(u.pm * BM + row) * 4 + u.pn);
            __hip_atomic_store(slot, ((unsigned long long)__float_as_uint(m2) << 32) | __float_as_uint(mt), __ATOMIC_RELAXED, __HIP_MEMORY_SCOPE_AGENT);
        }
        asm volatile("s_waitcnt vmcnt(0)" ::: "memory");
        if (lane == 0) __hip_atomic_fetch_add(cnt + 64 * u.pm, 1u, __ATOMIC_RELAXED, __HIP_MEMORY_SCOPE_AGENT);
        if (wid == 0) {
            bool dead = false; const unsigned long long t0 = __builtin_amdgcn_s_memrealtime(); const unsigned want = 8u * (unsigned)ntn;
            for (;;) {
#if defined(BROKEN_EXCHANGE_NO_WAIT)
                break;
#endif
                if ((unsigned)__builtin_amdgcn_readfirstlane(__hip_atomic_load(cnt + 64 * u.pm, __ATOMIC_RELAXED, __HIP_MEMORY_SCOPE_AGENT)) >= want) break;
                if (__builtin_amdgcn_s_memrealtime() - t0 > 2000000ull) {
                    if (lane == 0) { unsigned expect = 0u; __hip_atomic_compare_exchange_strong(tmo + 1, &expect, code | (unsigned)(u.pm & 0xff), __ATOMIC_RELAXED, __ATOMIC_RELAXED, __HIP_MEMORY_SCOPE_AGENT);
                                     __hip_atomic_store(tmo, 1u, __ATOMIC_RELAXED, __HIP_MEMORY_SCOPE_AGENT); }
                    dead = true; break; }
                __builtin_amdgcn_s_sleep(2);
            }
            __builtin_amdgcn_fence(__ATOMIC_ACQUIRE, "agent");
            if (lane == 0) flag[0] = dead ? 1u : 0u;
        }
        asm volatile("s_waitcnt vmcnt(0) lgkmcnt(0)" ::: "memory"); __builtin_amdgcn_s_barrier(); asm volatile("" ::: "memory");
        const bool bad = flag[0] != 0u;
        if (lane < 32) {
            const unsigned long long* slot = (const unsigned long long*)xbuf + (size_t)(u.pm * BM + row) * 4; float mt[4], m2[4]; float ms = 0.f;
#pragma unroll
            for (int t = 0; t < 4; ++t) { if (t < ntn) { const unsigned long long w = __hip_atomic_load(slot + t, __ATOMIC_RELAXED, __HIP_MEMORY_SCOPE_AGENT); mt[t] = __uint_as_float((unsigned)w); m2[t] = __uint_as_float((unsigned)(w >> 32)); } else { mt[t] = 0.f; m2[t] = 0.f; } ms += mt[t]; }
            const float mean = ms / (float)ntn; float q = 0.f;
#pragma unroll
            for (int t = 0; t < 4; ++t) if (t < ntn) { const float dm = mt[t] - mean; q += m2[t] + 256.0f * dm * dm; }
            S[row] = (f32x2v){mean, 1.0f / sqrtf(q / (256.0f * (float)ntn) + eps)};
        }
        asm volatile("s_waitcnt lgkmcnt(0)" ::: "memory"); __builtin_amdgcn_s_barrier(); asm volatile("" ::: "memory");
        return bad;
    }
};
struct EpiLnRes {
    static constexpr bool PERM = false, AFTER_DRAIN = true;
    const float* base; float* out; int ldc; const float* bias; PanelStats st; unsigned poison;
    __device__ __forceinline__ void fused(f32x4 (&acc)[2][2][4][2], const Unit& u, int wr, int wc, int fr, int fq, PG8_LAS unsigned char* lds, int wid, int lane) const {
        typedef float f32x2v __attribute__((ext_vector_type(2)));
        const PG8_LAS f32x2v* S = (const PG8_LAS f32x2v*)(lds + 8192);
        const int col0 = u.pn * BM + wc * 32 + 4 * fq;
#pragma unroll
        for (int bj = 0; bj < 2; ++bj)
#pragma unroll
            for (int n = 0; n < 2; ++n) { const f32x4 bv = bias ? *(const f32x4*)(bias + col0 + bj * HALF + n * 16) : (f32x4){0.f, 0.f, 0.f, 0.f};
#pragma unroll
                for (int ai = 0; ai < 2; ++ai)
#pragma unroll
                    for (int m = 0; m < 4; ++m) acc[ai][bj][m][n] += bv; }
        f32x4 pre[4][2][2];
#pragma unroll
        for (int m = 0; m < 4; ++m) { const size_t off = (size_t)(u.pm * BM + wr * 64 + m * 16 + fr) * ldc + col0;
#pragma unroll
            for (int bj = 0; bj < 2; ++bj)
#pragma unroll
                for (int n = 0; n < 2; ++n) pre[m][bj][n] = *(const f32x4*)(base + off + bj * HALF + n * 16); }
        const bool bad = st.run(acc, u, wr, wc, fr, fq, lds, wid, lane) || poison != 0u;
        const float qnan = __builtin_nanf("");
#pragma unroll
        for (int ai = 0; ai < 2; ++ai)
#pragma unroll
            for (int m = 0; m < 4; ++m) { const int r = ai * HALF + wr * 64 + m * 16 + fr; const f32x2v sr = S[r]; const size_t off = (size_t)(u.pm * BM + r) * ldc + col0;
#pragma unroll
                for (int bj = 0; bj < 2; ++bj)
#pragma unroll
                    for (int n = 0; n < 2; ++n) { const f32x4 bs = ai == 0 ? pre[m][bj][n] : *(const f32x4*)(base + off + bj * HALF + n * 16); f32x4 o = bs + (acc[ai][bj][m][n] - sr.x) * sr.y;
                        if (bad) o = (f32x4){qnan, qnan, qnan, qnan}; *(f32x4*)(out + off + bj * HALF + n * 16) = o; }
                if (m & 1) asm volatile("" ::: "memory"); }
    }
};
struct EpiLnResLn {
    static constexpr bool PERM = false, AFTER_DRAIN = true;
    const float* base; float* out; bf16_t* xn; int ldc; const float* bias; PanelStats st1, st2; unsigned poison;
    __device__ __forceinline__ void fused(f32x4 (&acc)[2][2][4][2], const Unit& u, int wr, int wc, int fr, int fq, PG8_LAS unsigned char* lds, int wid, int lane) const {
        typedef float f32x2v __attribute__((ext_vector_type(2))); typedef unsigned u32x2v __attribute__((ext_vector_type(2)));
        const PG8_LAS f32x2v* S = (const PG8_LAS f32x2v*)(lds + 8192);
        const int col0 = u.pn * BM + wc * 32 + 4 * fq;
#pragma unroll
        for (int bj = 0; bj < 2; ++bj)
#pragma unroll
            for (int n = 0; n < 2; ++n) { const f32x4 bv = bias ? *(const f32x4*)(bias + col0 + bj * HALF + n * 16) : (f32x4){0.f, 0.f, 0.f, 0.f};
#pragma unroll
                for (int ai = 0; ai < 2; ++ai)
#pragma unroll
                    for (int m = 0; m < 4; ++m) acc[ai][bj][m][n] += bv; }
        bool bad = st1.run(acc, u, wr, wc, fr, fq, lds, wid, lane) || poison != 0u;
        const float qnan = __builtin_nanf("");
#pragma unroll
        for (int ai = 0; ai < 2; ++ai)
#pragma unroll
            for (int m = 0; m < 4; ++m) { const int r = ai * HALF + wr * 64 + m * 16 + fr; const f32x2v sr = S[r]; const size_t off = (size_t)(u.pm * BM + r) * ldc + col0;
#pragma unroll
                for (int bj = 0; bj < 2; ++bj)
#pragma unroll
                    for (int n = 0; n < 2; ++n) { const f32x4 bs = *(const f32x4*)(base + off + bj * HALF + n * 16); acc[ai][bj][m][n] = bs + (acc[ai][bj][m][n] - sr.x) * sr.y; }
                asm volatile("" : "+v"(acc[ai][0][m][0]), "+v"(acc[ai][0][m][1]), "+v"(acc[ai][1][m][0]), "+v"(acc[ai][1][m][1]));
                if (m & 1) asm volatile("" ::: "memory"); }
        const bool bad1 = bad;
        bad = st2.run(acc, u, wr, wc, fr, fq, lds, wid, lane) || bad;
#pragma unroll
        for (int ai = 0; ai < 2; ++ai)
#pragma unroll
            for (int m = 0; m < 4; ++m) { const int r = ai * HALF + wr * 64 + m * 16 + fr; const f32x2v sr = S[r]; const size_t off = (size_t)(u.pm * BM + r) * ldc + col0;
#pragma unroll
                for (int bj = 0; bj < 2; ++bj)
#pragma unroll
                    for (int n = 0; n < 2; ++n) { const f32x4 x1 = acc[ai][bj][m][n]; *(f32x4*)(out + off + bj * HALF + n * 16) = bad1 ? (f32x4){qnan, qnan, qnan, qnan} : x1;
                        const f32x4 o = (x1 - sr.x) * sr.y; u32x2v w; w.x = cvt_pk_bf16(o[0], o[1]); w.y = cvt_pk_bf16(o[2], o[3]);
                        if (bad) { w.x = 0x7fc07fc0u; w.y = 0x7fc07fc0u; } *(u32x2v*)(xn + off + bj * HALF + n * 16) = w; }
                asm volatile("" ::: "memory"); }
    }
};

template <class Epi, class Sched, bool ALIGN_EPI = false, bool SP2 = false>
__device__ __forceinline__ void gemm_phase(PG8_LAS unsigned char* lds, const Gemm g, const Sched& S, const Epi& E, int wv) {
    int tid_ = wv * 64 + lane_id_(); asm volatile("" : "+v"(tid_));
    const int tid = tid_, wid = __builtin_amdgcn_readfirstlane(tid >> 6), lane = tid & 63, wr = wid >> 2, wc = wid & 3, fr = lane & 15, fq = lane >> 4;
    const int K = g.K, nt = K / BK;
    unsigned voffA[2], voffB[2];
#pragma unroll
    for (int i = 0; i < 2; ++i) { int R, C; stage_rc(tid * 16 + i * 8192, R, C); const int Rb = Epi::PERM ? ((R & ~31) + perm32(R & 31)) : R;
        voffA[i] = (unsigned)(R * K + C) * 2u; voffB[i] = (unsigned)(Rb * K + C) * 2u; }
    const size_t kstep = (size_t)(BK * 2);
    const size_t hstep = (size_t)HALF * K * 2;
    const size_t tstep = 2 * hstep;
    const unsigned ldsw = (unsigned)wid * 1024u;
    const int aoff = lds_byte(wr * 64 + fr, fq * 8), boff = lds_byte(wc * 32 + fr, fq * 8);
#define PG8_SA(b, h) (((b) * 2 + (h)) * HTB)
#define PG8_SB(b, h) ((4 + (b) * 2 + (h)) * HTB)
#define PG8_STAGE(bufoff, gbase, voff) do { _Pragma("unroll") for (int _i = 0; _i < 2; ++_i) \
        __builtin_amdgcn_global_load_lds((const unsigned*)((const char*)(gbase) + (voff)[_i]), (PG8_LAS unsigned*)(lds + (bufoff) + ldsw + _i * 8192), 16, 0, 0); } while (0)
#define PG8_LDA(dst, b, h) do { _Pragma("unroll") for (int m = 0; m < 4; ++m) _Pragma("unroll") for (int k = 0; k < 2; ++k) dst[m][k] = *(const PG8_LAS bf16x8*)(lds + PG8_SA(b, h) + aoff + m * 2048 + k * 1024); } while (0)
#define PG8_LDB(dst, b, h) do { _Pragma("unroll") for (int n = 0; n < 2; ++n) _Pragma("unroll") for (int k = 0; k < 2; ++k) dst[n][k] = *(const PG8_LAS bf16x8*)(lds + PG8_SB(b, h) + boff + n * 2048 + k * 1024); } while (0)
#define PG8_MMA(ai, bj, At, Bt) do { __builtin_amdgcn_s_setprio(1); _Pragma("unroll") for (int m = 0; m < 4; ++m) _Pragma("unroll") for (int n = 0; n < 2; ++n) _Pragma("unroll") for (int k = 0; k < 2; ++k) \
        acc[ai][bj][m][n] = __builtin_amdgcn_mfma_f32_16x16x32_bf16(Bt[n][k], At[m][k], acc[ai][bj][m][n], 0, 0, 0); __builtin_amdgcn_s_setprio(0); } while (0)
#define PG8_WAIT_V(n) asm volatile("s_waitcnt vmcnt(" #n ")" ::: "memory")
#define PG8_WAIT_L(n) asm volatile("s_waitcnt lgkmcnt(" #n ")" ::: "memory")
#define PG8_BAR __builtin_amdgcn_s_barrier()
#define PG8_SCHED __builtin_amdgcn_sched_barrier(0)
    Unit cur, nxt; int ui = 0;
    if (!S.next(0, cur)) return;
    f32x4 acc[2][2][4][2];
#pragma unroll
    for (int a = 0; a < 2; ++a)
#pragma unroll
        for (int b = 0; b < 2; ++b)
#pragma unroll
            for (int m = 0; m < 4; ++m)
#pragma unroll
                for (int n = 0; n < 2; ++n) acc[a][b][m][n] = (f32x4){0.f, 0.f, 0.f, 0.f};
    bf16x8 At[4][2], B0[2][2], B1[2][2];
    const char* cA = (const char*)g.A + (size_t)cur.pm * tstep; const char* cB = (const char*)g.Bt + (size_t)cur.pn * tstep;
    S.a_ready(cur);
    if constexpr (SP2) {
        PG8_STAGE(PG8_SB(0, 0), cB, voffB); PG8_STAGE(PG8_SB(0, 1), cB + hstep, voffB); PG8_STAGE(PG8_SA(0, 0), cA, voffA); PG8_STAGE(PG8_SA(0, 1), cA + hstep, voffA);
        if (wr == 1) PG8_BAR;
        PG8_WAIT_V(2); PG8_BAR;
        PG8_STAGE(PG8_SB(1, 0), cB + kstep, voffB); PG8_STAGE(PG8_SA(1, 0), cA + kstep, voffA); PG8_STAGE(PG8_SB(1, 1), cB + hstep + kstep, voffB);
        PG8_WAIT_V(6); PG8_BAR;
    } else {
        PG8_STAGE(PG8_SB(0, 0), cB, voffB); PG8_STAGE(PG8_SA(0, 0), cA, voffA); PG8_STAGE(PG8_SB(0, 1), cB + hstep, voffB); PG8_STAGE(PG8_SA(0, 1), cA + hstep, voffA);
        if (wr == 1) PG8_BAR;
        PG8_WAIT_V(4); PG8_BAR;
        PG8_STAGE(PG8_SB(1, 0), cB + kstep, voffB); PG8_STAGE(PG8_SA(1, 0), cA + kstep, voffA); PG8_STAGE(PG8_SB(1, 1), cB + hstep + kstep, voffB);
        PG8_WAIT_V(6); PG8_BAR;
    }
    for (;;) {
        const bool has_next = S.next(ui + 1, nxt);
        const char* nA = has_next ? (const char*)g.A + (size_t)nxt.pm * tstep : cA; const char* nB = has_next ? (const char*)g.Bt + (size_t)nxt.pn * tstep : cB;
        for (int t = 0; t < nt; t += 2) {
            const bool last = (t == nt - 2);
            const char* a1 = cA + (size_t)(t + 1) * kstep;
            const char* a2 = last ? nA : cA + (size_t)(t + 2) * kstep; const char* b2 = last ? nB : cB + (size_t)(t + 2) * kstep;
            const char* a3 = a2 + kstep; const char* b3 = b2 + kstep;
            if (last && has_next) S.a_ready(nxt);
            if constexpr (SP2) {
            PG8_LDB(B0, 0, 0); PG8_LDB(B1, 0, 1); PG8_SCHED; PG8_LDA(At, 0, 0); PG8_STAGE(PG8_SA(1, 1), a1 + hstep, voffA);
            PG8_WAIT_V(8); PG8_WAIT_L(0); PG8_BAR; PG8_MMA(0, 0, At, B0); PG8_MMA(0, 1, At, B1); PG8_BAR; PG8_SCHED;
            PG8_LDA(At, 0, 1); PG8_STAGE(PG8_SB(0, 0), b2, voffB); PG8_STAGE(PG8_SB(0, 1), b2 + hstep, voffB); PG8_STAGE(PG8_SA(0, 0), a2, voffA);
            PG8_WAIT_V(8); PG8_WAIT_L(0); PG8_BAR; PG8_MMA(1, 0, At, B0); PG8_MMA(1, 1, At, B1); PG8_BAR; PG8_SCHED;
            PG8_LDB(B0, 1, 0); PG8_LDB(B1, 1, 1); PG8_SCHED; PG8_LDA(At, 1, 0); PG8_STAGE(PG8_SA(0, 1), a2 + hstep, voffA);
            PG8_WAIT_V(8); PG8_WAIT_L(0); PG8_BAR; PG8_MMA(0, 0, At, B0); PG8_MMA(0, 1, At, B1); PG8_BAR; PG8_SCHED;
            PG8_LDA(At, 1, 1); PG8_STAGE(PG8_SB(1, 0), b3, voffB); PG8_STAGE(PG8_SB(1, 1), b3 + hstep, voffB); PG8_STAGE(PG8_SA(1, 0), a3, voffA);
            PG8_WAIT_V(8); PG8_WAIT_L(0); PG8_BAR; PG8_MMA(1, 0, At, B0); PG8_MMA(1, 1, At, B1); PG8_BAR; PG8_SCHED;
            } else {
            PG8_LDB(B0, 0, 0); PG8_SCHED; PG8_LDA(At, 0, 0); PG8_STAGE(PG8_SA(1, 1), a1 + hstep, voffA);
            PG8_WAIT_L(8); PG8_BAR; PG8_WAIT_L(0); PG8_MMA(0, 0, At, B0); PG8_BAR; PG8_SCHED;
            PG8_LDB(B1, 0, 1); PG8_STAGE(PG8_SB(0, 0), b2, voffB);
            PG8_BAR; PG8_WAIT_L(0); PG8_MMA(0, 1, At, B1); PG8_BAR;
            PG8_LDA(At, 0, 1); PG8_STAGE(PG8_SA(0, 0), a2, voffA);
            PG8_BAR; PG8_WAIT_L(0); PG8_MMA(1, 0, At, B0); PG8_BAR; PG8_SCHED;
            PG8_STAGE(PG8_SB(0, 1), b2 + hstep, voffB);
            PG8_WAIT_V(6); PG8_BAR; PG8_MMA(1, 1, At, B1); PG8_BAR;
            PG8_LDB(B0, 1, 0); PG8_SCHED; PG8_LDA(At, 1, 0); PG8_STAGE(PG8_SA(0, 1), a2 + hstep, voffA);
            PG8_WAIT_L(8); PG8_BAR; PG8_WAIT_L(0); PG8_MMA(0, 0, At, B0); PG8_BAR; PG8_SCHED;
            PG8_LDB(B1, 1, 1); PG8_STAGE(PG8_SB(1, 0), b3, voffB);
            PG8_BAR; PG8_WAIT_L(0); PG8_MMA(0, 1, At, B1); PG8_BAR;
            PG8_LDA(At, 1, 1); PG8_STAGE(PG8_SA(1, 0), a3, voffA);
            PG8_BAR; PG8_WAIT_L(0); PG8_MMA(1, 0, At, B0); PG8_BAR; PG8_SCHED;
            PG8_STAGE(PG8_SB(1, 1), b3 + hstep, voffB);
            PG8_WAIT_V(6); PG8_BAR; PG8_MMA(1, 1, At, B1); PG8_BAR;
            }
        }
        if constexpr (ALIGN_EPI) { if (wr == 0) PG8_BAR; }
        if constexpr (!Epi::AFTER_DRAIN) { E(acc, cur, wr, wc, fr, fq); S.done(cur); }
        if (!has_next) break;
#pragma unroll
        for (int a = 0; a < 2; ++a)
#pragma unroll
            for (int b = 0; b < 2; ++b)
#pragma unroll
                for (int m = 0; m < 4; ++m)
#pragma unroll
                    for (int n = 0; n < 2; ++n) acc[a][b][m][n] = (f32x4){0.f, 0.f, 0.f, 0.f};
        cur = nxt; cA = nA; cB = nB; ++ui;
        if constexpr (ALIGN_EPI) { if (wr == 1) PG8_BAR; }
    }
    PG8_WAIT_V(0);
    if constexpr (!ALIGN_EPI) { if (wr == 0) PG8_BAR; }
    PG8_BAR;
    if constexpr (Epi::AFTER_DRAIN) { E.fused(acc, cur, wr, wc, fr, fq, lds, wid, lane); S.done(cur); }
#undef PG8_SA
#undef PG8_SB
#undef PG8_STAGE
#undef PG8_LDA
#undef PG8_LDB
#undef PG8_MMA
#undef PG8_WAIT_V
#undef PG8_WAIT_L
#undef PG8_BAR
#undef PG8_SCHED
}
}
constexpr int S_ = 16384, D_ = 1024, FF_ = 2816, NIN_ = 7448, NINP_ = 7680;
constexpr int NTHREADS = 512;
constexpr size_t MiB = 1u << 20;
constexpr size_t WS_CTL = 0;
constexpr size_t WS_MOD = 1 * MiB;
constexpr size_t WS_ROPE = 2 * MiB;
constexpr size_t WS_W = 6 * MiB;
constexpr size_t W_FFIN0 = 0, W_FFIN1 = 11 * MiB, W_FFOUT0 = 22 * MiB, W_FFOUT1 = 27 * MiB + MiB / 2, W_IN = 33 * MiB, W_BATT = 48 * MiB, W_BDN = 48 * MiB + MiB / 2, W_OUT = 50 * MiB;
constexpr size_t WS_H = 58 * MiB;
constexpr size_t WS_R = 90 * MiB;
constexpr size_t R_ACT = 0, R_Y = 88 * MiB;
constexpr size_t R_PA = 0, R_QKVD = 0, R_PG = 0, R_PD = 72 * MiB, R_TINV = 72 * MiB, R_ODIR1 = 120 * MiB, R_ODN = 72 * MiB, R_T1 = 96 * MiB, R_PZ = 144 * MiB, R_AB = 168 * MiB, R_GB = 170 * MiB,
                 R_OATT = 172 * MiB, R_ATTN = 180 * MiB, R_Y2 = 160 * MiB, R_OG = 228 * MiB, R_LSE = 252 * MiB, R_ODIR0 = 228 * MiB, R_VEC = 253 * MiB;
constexpr size_t WS_END = 352 * MiB;

typedef unsigned short bf16;
typedef unsigned v4u __attribute__((ext_vector_type(4)));
typedef unsigned v2u __attribute__((ext_vector_type(2)));
typedef float f32x4 __attribute__((ext_vector_type(4)));
typedef float f32x2 __attribute__((ext_vector_type(2)));
#define LAS __attribute__((address_space(3)))

__device__ __forceinline__ unsigned f2bf(float f) { unsigned u = __builtin_bit_cast(unsigned, f); return (u + 0x7fffu + ((u >> 16) & 1u)) >> 16; }
__device__ __forceinline__ unsigned pk2(float lo, float hi) { return f2bf(lo) | (f2bf(hi) << 16); }
__device__ __forceinline__ float bf2f(unsigned short b) { return __builtin_bit_cast(float, (unsigned)b << 16); }
__device__ __forceinline__ float bflo(unsigned w) { return __builtin_bit_cast(float, w << 16); }
__device__ __forceinline__ float bfhi(unsigned w) { return __builtin_bit_cast(float, w & 0xffff0000u); }
__device__ __forceinline__ float wave_sum(float v) {
#pragma unroll
    for (int o = 1; o < 64; o <<= 1) v += __shfl_xor(v, o);
    return v;
}
__device__ __forceinline__ float sigmoidf_(float x) { return 1.0f / (1.0f + __expf(-x)); }
__device__ __forceinline__ float siluf_(float x) { return x / (1.0f + __expf(-x)); }

namespace pg8 {
struct EpiSwiglu {
    static constexpr bool PERM = true, AFTER_DRAIN = false;
    bf16_t* O; int ldc; int pad_;
    __device__ __forceinline__ void operator()(const f32x4 (&acc)[2][2][4][2], const Unit& u, int wr, int wc, int fr, int fq) const {
        const int row0 = u.pm * BM + wr * 64 + fr, col0 = u.pn * 128 + wc * 32 + 8 * fq;
#pragma unroll
        for (int ai = 0; ai < 2; ++ai)
#pragma unroll
            for (int m = 0; m < 4; ++m) {
                bf16_t* rowp = O + (size_t)(row0 + ai * HALF + m * 16) * ldc + col0;
                float v[8];
#pragma unroll
                for (int n = 0; n < 2; ++n)
#pragma unroll
                    for (int e = 0; e < 4; ++e) { const float g = acc[ai][0][m][n][e], uu = acc[ai][1][m][n][e]; v[n * 4 + e] = g * __builtin_amdgcn_rcpf(1.0f + __expf(-g)) * uu; }
                u32x4 w; w.x = cvt_pk_bf16(v[0], v[1]); w.y = cvt_pk_bf16(v[2], v[3]); w.z = cvt_pk_bf16(v[4], v[5]); w.w = cvt_pk_bf16(v[6], v[7]);
                *(u32x4*)rowp = w;
            }
    }
};
struct EpiBf16P {
    static constexpr bool PERM = true, AFTER_DRAIN = false;
    bf16_t* O; int ldc; int pad_;
    __device__ __forceinline__ void operator()(const f32x4 (&acc)[2][2][4][2], const Unit& u, int wr, int wc, int fr, int fq) const {
        const int row0 = u.pm * BM + wr * 64 + fr, col0 = u.pn * BM + wc * 32 + 8 * fq;
#pragma unroll
        for (int ai = 0; ai < 2; ++ai)
#pragma unroll
            for (int m = 0; m < 4; ++m) {
                bf16_t* rowp = O + (size_t)(row0 + ai * HALF + m * 16) * ldc + col0;
#pragma unroll
                for (int bj = 0; bj < 2; ++bj) { const f32x4 v0 = acc[ai][bj][m][0], v1 = acc[ai][bj][m][1];
                    u32x4 w; w.x = cvt_pk_bf16(v0[0], v0[1]); w.y = cvt_pk_bf16(v0[2], v0[3]); w.z = cvt_pk_bf16(v1[0], v1[1]); w.w = cvt_pk_bf16(v1[2], v1[3]);
                    *(u32x4*)(rowp + bj * HALF) = w; }
            }
    }
};
struct EpiF32 {
    static constexpr bool PERM = false, AFTER_DRAIN = false;
    float* O; int ldc; int pad_;
    __device__ __forceinline__ void operator()(const f32x4 (&acc)[2][2][4][2], const Unit& u, int wr, int wc, int fr, int fq) const {
        const int row0 = u.pm * BM + wr * 64 + fr, col0 = u.pn * BM + wc * 32 + 4 * fq;
#pragma unroll
        for (int ai = 0; ai < 2; ++ai)
#pragma unroll
            for (int m = 0; m < 4; ++m) {
                float* rowp = O + (size_t)(row0 + ai * HALF + m * 16) * ldc + col0;
#pragma unroll
                for (int bj = 0; bj < 2; ++bj)
#pragma unroll
                    for (int n = 0; n < 2; ++n) *(f32x4*)(rowp + bj * HALF + n * 16) = acc[ai][bj][m][n];
            }
    }
};
struct EpiInProj {
    static constexpr bool PERM = true, AFTER_DRAIN = false;
    bf16_t* PA; bf16_t* PD; bf16_t* PZ; float* AB;
    __device__ __forceinline__ void operator()(const f32x4 (&acc)[2][2][4][2], const Unit& u, int wr, int wc, int fr, int fq) const {
        const int row0 = u.pm * BM + wr * 64 + fr;
        if (u.pn == 21) {
            if (wc == 0) {
#pragma unroll
                for (int ai = 0; ai < 2; ++ai)
#pragma unroll
                    for (int m = 0; m < 4; ++m) {
                        float* rowp = AB + (size_t)(row0 + ai * HALF + m * 16) * 32 + 8 * fq;
                        *(f32x4*)rowp = acc[ai][0][m][0]; *(f32x4*)(rowp + 4) = acc[ai][0][m][1];
                    }
            }
            return;
        }
        bf16_t* base; int ldc, ct;
        if (u.pn < 9) { base = PA; ldc = 2304; ct = u.pn; } else if (u.pn < 18) { base = PD; ldc = 2304; ct = u.pn - 9; } else { base = PZ; ldc = 768; ct = u.pn - 18; }
        const int col0 = ct * BM + wc * 32 + 8 * fq;
#pragma unroll
        for (int ai = 0; ai < 2; ++ai)
#pragma unroll
            for (int m = 0; m < 4; ++m) {
                bf16_t* rowp = base + (size_t)(row0 + ai * HALF + m * 16) * ldc + col0;
#pragma unroll
                for (int bj = 0; bj < 2; ++bj) { const f32x4 v0 = acc[ai][bj][m][0], v1 = acc[ai][bj][m][1];
                    u32x4 w; w.x = cvt_pk_bf16(v0[0], v0[1]); w.y = cvt_pk_bf16(v0[2], v0[3]); w.z = cvt_pk_bf16(v1[0], v1[1]); w.w = cvt_pk_bf16(v1[2], v1[3]);
                    *(u32x4*)(rowp + bj * HALF) = w; }
            }
    }
};
struct EpiGateF32 {
    static constexpr bool PERM = false, AFTER_DRAIN = false;
    float* O; const bf16_t* gate; int ldg; int pad_;
    __device__ __forceinline__ void operator()(const f32x4 (&acc)[2][2][4][2], const Unit& u, int wr, int wc, int fr, int fq) const {
        const int row0 = u.pm * BM + wr * 64 + fr, col0 = u.pn * BM + wc * 32 + 4 * fq;
#pragma unroll
        for (int ai = 0; ai < 2; ++ai)
#pragma unroll
            for (int m = 0; m < 4; ++m) {
                const size_t r = (size_t)(row0 + ai * HALF + m * 16);
#pragma unroll
                for (int bj = 0; bj < 2; ++bj)
#pragma unroll
                    for (int n = 0; n < 2; ++n) { const int c = col0 + bj * HALF + n * 16;
                        const v2u gw = *(const v2u*)(gate + r * ldg + c);
                        f32x4 a = acc[ai][bj][m][n];
                        a[0] *= sigmoidf_(bflo(gw.x)); a[1] *= sigmoidf_(bfhi(gw.x)); a[2] *= sigmoidf_(bflo(gw.y)); a[3] *= sigmoidf_(bfhi(gw.y));
                        *(f32x4*)(O + r * 1024 + c) = a; }
            }
    }
};
struct EpiGateAddBf16 {
    static constexpr bool PERM = false, AFTER_DRAIN = false;
    bf16_t* O; const float* T1; const bf16_t* gate; int ldg; int pad_;
    __device__ __forceinline__ void operator()(const f32x4 (&acc)[2][2][4][2], const Unit& u, int wr, int wc, int fr, int fq) const {
        const int row0 = u.pm * BM + wr * 64 + fr, col0 = u.pn * BM + wc * 32 + 4 * fq;
#pragma unroll
        for (int ai = 0; ai < 2; ++ai)
#pragma unroll
            for (int m = 0; m < 4; ++m) {
                const size_t r = (size_t)(row0 + ai * HALF + m * 16);
#pragma unroll
                for (int bj = 0; bj < 2; ++bj)
#pragma unroll
                    for (int n = 0; n < 2; ++n) { const int c = col0 + bj * HALF + n * 16;
                        const v2u gw = *(const v2u*)(gate + r * ldg + c);
                        const f32x4 t = *(const f32x4*)(T1 + r * 1024 + c);
                        f32x4 a = acc[ai][bj][m][n];
                        a[0] = t[0] + a[0] * sigmoidf_(bflo(gw.x)); a[1] = t[1] + a[1] * sigmoidf_(bfhi(gw.x)); a[2] = t[2] + a[2] * sigmoidf_(bflo(gw.y)); a[3] = t[3] + a[3] * sigmoidf_(bfhi(gw.y));
                        v2u w; w.x = cvt_pk_bf16(a[0], a[1]); w.y = cvt_pk_bf16(a[2], a[3]);
                        *(v2u*)(O + r * 1024 + c) = w; }
            }
    }
};
}


#define GAS __attribute__((address_space(1)))
struct Params { const float* in[17]; float* out; unsigned char* ws; };
#define XB_TMO      128
#define XB_XCNT(j)  (256  + 64 * (j))
#define XB_XSUB(j)  (1280 + 64 * (j))
#define XB_XGEN(j)  (2304 + 64 * (j))
#define XB_TOP      3328
#define XB_TOPGEN   3392
#define XCD_BAR_WORDS 3456
#define XB_SPIN_CAP (1u << 18)

__device__ __forceinline__ unsigned xb_ld(unsigned* p)              { return __hip_atomic_load(p, __ATOMIC_RELAXED, __HIP_MEMORY_SCOPE_AGENT); }
__device__ __forceinline__ unsigned xb_add(unsigned* p, unsigned v) { return __hip_atomic_fetch_add(p, v, __ATOMIC_RELAXED, __HIP_MEMORY_SCOPE_AGENT); }
__device__ __forceinline__ unsigned xb_xcc_id() { return (unsigned)__builtin_amdgcn_s_getreg((3 << 11) | 20) & 0xFu; }
#define XB_SPIN(cond, bar) do { unsigned _sp = 0; while (cond) { __builtin_amdgcn_s_sleep(1); \
    if ((++_sp & 255u) == 0u) { if (xb_ld(&(bar)[XB_TMO])) break; if (_sp > XB_SPIN_CAP) { atomicAdd(&(bar)[XB_TMO], 1u); break; } } } } while (0)

struct XcdBarrier {
    unsigned* bar; unsigned x;
    volatile LAS unsigned* st;
};

__device__ __forceinline__ XcdBarrier xcd_barrier_post(unsigned* bar, volatile LAS unsigned* st) {
    XcdBarrier b; b.bar = bar; b.x = xb_xcc_id(); b.st = st;
    if (threadIdx.x == 0) (void)xb_add(&bar[XB_XCNT(b.x)], 1u);
    return b;
}
__device__ __forceinline__ void xcd_barrier_complete(unsigned* bar, unsigned x, unsigned& nloc, unsigned& nx) {
    const unsigned G = gridDim.x * gridDim.y * gridDim.z;
    unsigned sum, cnt, mine, sp = 0u;
    for (;;) {
        sum = 0u; cnt = 0u; mine = 0u;
#pragma unroll
        for (unsigned j = 0; j < 16; ++j) { const unsigned c = xb_ld(&bar[XB_XCNT(j)]); sum += c; cnt += (c > 0u) ? 1u : 0u; mine = (j == x) ? c : mine; }
        if (sum == G) break;
        __builtin_amdgcn_s_sleep(1);
        if ((++sp & 255u) == 0u) { if (xb_ld(&bar[XB_TMO])) break; if (sp > XB_SPIN_CAP) { atomicAdd(&bar[XB_TMO], 1u); break; } }
    }
    nloc = mine > 0u ? mine : 1u; nx = cnt > 0u ? cnt : 1u;
}

__device__ __forceinline__ void xcd_barrier(const XcdBarrier& b, int wv) {
    const bool leader_thread = (wv == 0) && (lane_id_() == 0);
    asm volatile("s_waitcnt vmcnt(0)" ::: "memory");
    __syncthreads();
    if (leader_thread) {
        unsigned* bar = b.bar;
        __builtin_amdgcn_s_waitcnt(0);
        unsigned nloc = b.st[0], nx = b.st[1];
        if (nloc == 0u) { xcd_barrier_complete(bar, b.x, nloc, nx); b.st[0] = nloc; b.st[1] = nx; }
        const unsigned old = xb_add(&bar[XB_XSUB(b.x)], 1u);
        const unsigned gen = old / nloc;
        if (old + 1u == (gen + 1u) * nloc) {
            __builtin_amdgcn_fence(__ATOMIC_RELEASE, "agent");
            asm volatile("s_waitcnt vmcnt(0)" ::: "memory");
            const unsigned og = xb_add(&bar[XB_TOP], 1u);
            const unsigned tg = og / nx;
            if (og + 1u == (tg + 1u) * nx) xb_add(&bar[XB_TOPGEN], 1u);
            else XB_SPIN(xb_ld(&bar[XB_TOPGEN]) == tg, bar);
            __builtin_amdgcn_fence(__ATOMIC_ACQUIRE, "agent");
            xb_add(&bar[XB_XGEN(b.x)], 1u);
            asm volatile("s_waitcnt vmcnt(0)" ::: "memory");
        } else {
            XB_SPIN(xb_ld(&bar[XB_XGEN(b.x)]) == gen, bar);
            __builtin_amdgcn_fence(__ATOMIC_ACQUIRE, "agent");
            asm volatile("s_waitcnt vmcnt(0)" ::: "memory");
        }
    }
    __syncthreads();
}

typedef const __attribute__((address_space(4))) unsigned char* ka_t;
__device__ __forceinline__ ka_t ka_() { ka_t k = (ka_t)__builtin_amdgcn_kernarg_segment_ptr(); asm volatile("" : "+s"(k)); return k; }
#define PIN(i) ((const float*)(*(const __attribute__((address_space(4))) unsigned long long*)(ka_() + 8 * (i))))
#define POUT ((float*)(*(const __attribute__((address_space(4))) unsigned long long*)(ka_() + 136)))
#define PWS ((unsigned char*)(*(const __attribute__((address_space(4))) unsigned long long*)(ka_() + 144)))
#define BID ((int)blockIdx.x)
#define GSZ ((int)gridDim.x)
__device__ __forceinline__ int srcmap(int mode, int n) {
    if (mode == 0) return n;
    if (mode == 1) return (n >> 8) * 128 + (n & 127) + ((n >> 7) & 1) * 2816;
    if (n < 5400) return n;
    if (n < 5632) return -1;
    if (n < 6656) return 5400 + (n - 5632);
    return 6424 + (n - 6656);
}
__device__ __forceinline__ void conv_item(const float* W, bf16* WT, int K, int Nsrc, int Ndst, int mode, int item, float* scr, int lane) {
    const int nblk = Ndst / 32, kb = item / nblk, nb = item % nblk, k0 = 64 * kb, n0 = 32 * nb;
    const int sc = srcmap(mode, n0 + (lane & 31));
#pragma unroll 8
    for (int i = 0; i < 32; ++i) { const int kk = 2 * i + (lane >> 5); scr[kk * 33 + (lane & 31)] = sc >= 0 ? W[(size_t)(k0 + kk) * Nsrc + sc] : 0.f; }
    __builtin_amdgcn_s_waitcnt(0xc07f); __builtin_amdgcn_wave_barrier();
    const int c = lane & 7;
#pragma unroll
    for (int j = 0; j < 4; ++j) { const int n = (lane >> 3) + 8 * j; const float* s = scr + (8 * c) * 33 + n;
        v4u o; o.x = pk2(s[0 * 33], s[1 * 33]); o.y = pk2(s[2 * 33], s[3 * 33]); o.z = pk2(s[4 * 33], s[5 * 33]); o.w = pk2(s[6 * 33], s[7 * 33]);
        *(v4u*)(WT + (size_t)(n0 + n) * K + k0 + 8 * c) = o; }
    __builtin_amdgcn_s_waitcnt(0xc07f); __builtin_amdgcn_wave_barrier();
}
__device__ __forceinline__ void ph_convert(int l, unsigned char* lds, int wv) {
    int tid_ = wv * 64 + lane_id_(); asm volatile("" : "+v"(tid_)); const int lane = tid_ & 63, wave = tid_ >> 6;
    float* scr = (float*)lds + wave * (64 * 33);
    unsigned char* wb = PWS + WS_W;
    constexpr int I_FI = 16 * 176, I_FO = 44 * 32, I_IN = 16 * 240, I_BA = 4 * 32, I_BD = 12 * 32, I_O = 16 * 32;
    constexpr int NIT = 2 * I_FI + 2 * I_FO + I_IN + I_BA + I_BD + I_O;
    for (int it = BID * 8 + wave; it < NIT; it += GSZ * 8) {
        int r = it;
        if (r < 2 * I_FI) { const int f = r / I_FI; conv_item(PIN(7) + ((size_t)l * 2 + f) * 1024 * 5632, (bf16*)(wb + (f ? W_FFIN1 : W_FFIN0)), 1024, 5632, 5632, 1, r % I_FI, scr, lane); continue; } r -= 2 * I_FI;
        if (r < 2 * I_FO) { const int f = r / I_FO; conv_item(PIN(8) + ((size_t)l * 2 + f) * 2816 * 1024, (bf16*)(wb + (f ? W_FFOUT1 : W_FFOUT0)), 2816, 1024, 1024, 0, r % I_FO, scr, lane); continue; } r -= 2 * I_FO;
        if (r < I_IN) { conv_item(PIN(9) + (size_t)l * 1024 * NIN_, (bf16*)(wb + W_IN), 1024, NIN_, NINP_, 2, r, scr, lane); continue; } r -= I_IN;
        if (r < I_BA) { conv_item(PIN(14) + (size_t)l * 256 * 1024, (bf16*)(wb + W_BATT), 256, 1024, 1024, 0, r, scr, lane); continue; } r -= I_BA;
        if (r < I_BD) { conv_item(PIN(15) + (size_t)l * 768 * 1024, (bf16*)(wb + W_BDN), 768, 1024, 1024, 0, r, scr, lane); continue; } r -= I_BD;
        conv_item(PIN(16) + (size_t)l * 1024 * 1024, (bf16*)(wb + W_OUT), 1024, 1024, 1024, 0, r, scr, lane);
    }
}
__device__ __forceinline__ void ph_ada(unsigned char* lds, int wv) {
    float* red = (float*)(lds + 72 * 1024);
    int tid_ = wv * 64 + lane_id_(); asm volatile("" : "+v"(tid_)); const int lane = tid_ & 63, wave = tid_ >> 6;
    const float* c = PIN(1); const float* w_ada = PIN(3); const float* b_ada = PIN(4); float* mod = (float*)(PWS + WS_MOD);
    for (int u = BID; u < 2 * 144; u += GSZ) {
        const int l = u / 144, n = (u % 144) * 64 + lane;
        const float* W = w_ada + (size_t)l * 1024 * 9216 + n;
        float s = 0.f;
        for (int k = wave * 128; k < wave * 128 + 128; ++k) s += siluf_(c[k]) * W[(size_t)k * 9216];
        red[wave * 64 + lane] = s;
        __syncthreads();
        if (wave == 0) { float t = b_ada[l * 9216 + n];
#pragma unroll
            for (int w = 0; w < 8; ++w) t += red[w * 64 + lane];
            mod[l * 9216 + n] = t; }
        __syncthreads();
    }
}
__device__ const float ROPE_INV[32] = {1.000000000e+00f, 7.498942018e-01f, 5.623413324e-01f, 4.216965139e-01f, 3.162277639e-01f, 2.371373773e-01f, 1.778279394e-01f, 1.333521456e-01f, 1.000000015e-01f, 7.498942316e-02f, 5.623413250e-02f, 4.216964915e-02f, 3.162277490e-02f, 2.371373773e-02f, 1.778279431e-02f, 1.333521400e-02f, 9.999999776e-03f, 7.498942316e-03f, 5.623413250e-03f, 4.216964822e-03f, 3.162277630e-03f, 2.371373819e-03f, 1.778279431e-03f, 1.333521446e-03f, 1.000000047e-03f, 7.498941850e-04f, 5.623413017e-04f, 4.216965172e-04f, 3.162277571e-04f, 2.371373703e-04f, 1.778279402e-04f, 1.333521504e-04f};
__device__ __forceinline__ void ph_rope(int wv) {
    const int* pos = (const int*)PIN(2); float* tab = (float*)(PWS + WS_ROPE);
    int tid_ = wv * 64 + lane_id_(); asm volatile("" : "+v"(tid_));
    for (int idx = BID * NTHREADS + tid_; idx < S_ * 32; idx += GSZ * NTHREADS) {
        const int t = idx >> 5, i = idx & 31;
        const float inv = ROPE_INV[i];
        const float ang = (float)pos[t] * inv;
        float sn, cs; sincosf(ang, &sn, &cs);
        tab[idx] = cs; tab[S_ * 32 + idx] = sn;
    }
}
struct RowArgs { const float* xi; const float* y; float* xo; bf16* h; const float* wpost; const float* gate; const float* wpre; const float* shift; const float* scale; float coef; };
__device__ __forceinline__ void ph_rows(const RowArgs& a, int wv) {
    int tid_ = wv * 64 + lane_id_(); asm volatile("" : "+v"(tid_)); const int lane = tid_ & 63, wave = tid_ >> 6;
    for (int r = BID * 8 + wave; r < S_; r += GSZ * 8) {
        f32x4 x[4];
        const f32x4* xr = (const f32x4*)(a.xi + (size_t)r * D_) + lane;
#pragma unroll
        for (int j = 0; j < 4; ++j) x[j] = xr[64 * j];
        if (a.y) {
            f32x4 y[4]; float s = 0.f;
            const f32x4* yr = (const f32x4*)(a.y + (size_t)r * D_) + lane;
#pragma unroll
            for (int j = 0; j < 4; ++j) { y[j] = yr[64 * j]; s += (y[j].x * y[j].x + y[j].y * y[j].y) + (y[j].z * y[j].z + y[j].w * y[j].w); }
            const float rs = 1.0f / sqrtf(wave_sum(s) * (1.f / D_) + 1e-6f);
#pragma unroll
            for (int j = 0; j < 4; ++j) { const f32x4 wp = ((const f32x4*)a.wpost)[lane + 64 * j], g = ((const f32x4*)a.gate)[lane + 64 * j];
                x[j] = x[j] + a.coef * g * ((y[j] * rs) * wp); }
            f32x4* xw = (f32x4*)(a.xo + (size_t)r * D_) + lane;
#pragma unroll
            for (int j = 0; j < 4; ++j) xw[64 * j] = x[j];
        }
        if (a.h) {
            float s = 0.f;
#pragma unroll
            for (int j = 0; j < 4; ++j) s += (x[j].x * x[j].x + x[j].y * x[j].y) + (x[j].z * x[j].z + x[j].w * x[j].w);
            const float rs = 1.0f / sqrtf(wave_sum(s) * (1.f / D_) + 1e-6f);
            v2u* hw = (v2u*)(a.h + (size_t)r * D_) + lane;
#pragma unroll
            for (int j = 0; j < 4; ++j) { const f32x4 wp = ((const f32x4*)a.wpre)[lane + 64 * j], sc = ((const f32x4*)a.scale)[lane + 64 * j], sh = ((const f32x4*)a.shift)[lane + 64 * j];
                const f32x4 v = ((x[j] * rs) * wp) * (1.0f + sc) + sh;
                v2u w; w.x = pk2(v.x, v.y); w.y = pk2(v.z, v.w); hw[64 * j] = w; }
        }
    }
}
constexpr int ATT_PITCH = 68;
__device__ __forceinline__ void ph_attn_v1(const bf16* PA, const float* rope, bf16* OG, float* LSE, unsigned char* lds, int wv) {
    float* qs = (float*)lds; float* ks = qs + 64 * ATT_PITCH; float* vs = ks + 192 * ATT_PITCH;
    int tid_ = wv * 64 + lane_id_(); asm volatile("" : "+v"(tid_)); const int tid = tid_, lane = tid & 63, wave = tid >> 6;
    for (int u = BID; u < 3072; u += GSZ) {
        const int hg = u & 3, w = (u >> 2) & 255, gi = u >> 10;
        const int dil = 1 << (2 * gi), L = S_ / dil, r = w % dil, nb = w / dil, head = gi * 4 + hg;
        __syncthreads();
        for (int rr = wave; rr < 448; rr += 8) {
            int mm, colbase; float* dst; bool rot; float sc = 1.f;
            if (rr < 64) { mm = nb * 64 + rr; colbase = head * 64; dst = qs + rr * ATT_PITCH; rot = true; sc = 0.125f; }
            else if (rr < 256) { mm = nb * 64 - 64 + (rr - 64); colbase = 768 + head * 64; dst = ks + (rr - 64) * ATT_PITCH; rot = true; }
            else { mm = nb * 64 - 64 + (rr - 256); colbase = 1536 + head * 64; dst = vs + (rr - 256) * ATT_PITCH; rot = false; }
            float val = 0.f;
            if (mm >= 0 && mm < L) {
                const int tok = mm * dil + r;
                val = bf2f(PA[(size_t)tok * 2304 + colbase + lane]);
                if (rot) {
                    const float other = __shfl_xor(val, 32);
                    const float cs = rope[tok * 32 + (lane & 31)], sn = rope[S_ * 32 + tok * 32 + (lane & 31)];
                    val = (lane < 32) ? (val * cs - other * sn) : (val * cs + other * sn);
                }
            }
            dst[lane] = val * sc;
        }
        __syncthreads();
        const int i = tid >> 3, part = tid & 7;
        float q[64], acc[64];
#pragma unroll
        for (int d = 0; d < 64; d += 4) { const f32x4 t = *(const f32x4*)(qs + i * ATT_PITCH + d); q[d] = t.x; q[d + 1] = t.y; q[d + 2] = t.z; q[d + 3] = t.w; }
#pragma unroll
        for (int d = 0; d < 64; ++d) acc[d] = 0.f;
        float m = -1e30f, l = 0.f;
        for (int jj = 0; jj < 24; ++jj) {
            const int j = part + 8 * jj, mm = nb * 64 - 64 + j, dj = j - 64 - i;
            const bool ok = (dj <= 64) && (dj >= -64) && (mm >= 0) && (mm < L);
            if (ok) {
                const float* kr = ks + j * ATT_PITCH; float s = 0.f;
#pragma unroll
                for (int d = 0; d < 64; d += 4) { const f32x4 t = *(const f32x4*)(kr + d); s += q[d] * t.x + q[d + 1] * t.y + q[d + 2] * t.z + q[d + 3] * t.w; }
                const float mn = fmaxf(m, s), al = __expf(m - mn), p = __expf(s - mn);
                l = l * al + p; m = mn;
                const float* vr = vs + j * ATT_PITCH;
#pragma unroll
                for (int d = 0; d < 64; d += 4) { const f32x4 t = *(const f32x4*)(vr + d);
                    acc[d] = acc[d] * al + p * t.x; acc[d + 1] = acc[d + 1] * al + p * t.y; acc[d + 2] = acc[d + 2] * al + p * t.z; acc[d + 3] = acc[d + 3] * al + p * t.w; }
            }
        }
        float mt = fmaxf(m, __shfl_xor(m, 1)); mt = fmaxf(mt, __shfl_xor(mt, 2)); mt = fmaxf(mt, __shfl_xor(mt, 4));
        const float f = __expf(m - mt);
        l *= f; l += __shfl_xor(l, 1); l += __shfl_xor(l, 2); l += __shfl_xor(l, 4);
#pragma unroll
        for (int d = 0; d < 64; ++d) acc[d] *= f;
        const bool b2 = part & 4, b1 = part & 2, b0 = part & 1;
        float r32[32], r16[16], r8[8];
#pragma unroll
        for (int d = 0; d < 32; ++d) { const float keep = b2 ? acc[32 + d] : acc[d], send = b2 ? acc[d] : acc[32 + d]; r32[d] = keep + __shfl_xor(send, 4); }
#pragma unroll
        for (int d = 0; d < 16; ++d) { const float keep = b1 ? r32[16 + d] : r32[d], send = b1 ? r32[d] : r32[16 + d]; r16[d] = keep + __shfl_xor(send, 2); }
#pragma unroll
        for (int d = 0; d < 8; ++d) { const float keep = b0 ? r16[8 + d] : r16[d], send = b0 ? r16[d] : r16[8 + d]; r8[d] = keep + __shfl_xor(send, 1); }
        const float il = 1.0f / l;
        const int tok = (nb * 64 + i) * dil + r;
        v4u o; o.x = pk2(r8[0] * il, r8[1] * il); o.y = pk2(r8[2] * il, r8[3] * il); o.z = pk2(r8[4] * il, r8[5] * il); o.w = pk2(r8[6] * il, r8[7] * il);
        *(v4u*)(OG + ((size_t)gi * S_ + tok) * 256 + hg * 64 + part * 8) = o;
        if (part == 0) LSE[((size_t)gi * S_ + tok) * 4 + hg] = mt + logf(l);
    }
}

__device__ __forceinline__ void ph_dnprep(const bf16* PD, const float* AB, const float* convw, const float* a_log, const float* dt_bias, bf16* QKVd, float* GB, const bf16* OG, const float* LSE, bf16* OATT, int wv) {
    int tid_ = wv * 64 + lane_id_(); asm volatile("" : "+v"(tid_)); const int lane = tid_ & 63, wave = tid_ >> 6;
    const int gw = BID * 8 + wave, NGW = GSZ * 8;
    for (int t = gw; t < S_; t += NGW) {
        for (int seg = 0; seg < 18; ++seg) {
            const int c0 = seg * 128 + 2 * lane;
            float a0 = 0.f, a1 = 0.f;
#pragma unroll
            for (int j = 0; j < 5; ++j) { const int tt = t + j - 2;
                if (tt >= 0 && tt < S_) { const unsigned w = *(const unsigned*)(PD + (size_t)tt * 2304 + c0); const f32x2 cw = *(const f32x2*)(convw + j * 2304 + c0);
                    a0 += bflo(w) * cw.x; a1 += bfhi(w) * cw.y; } }
            a0 = siluf_(a0); a1 = siluf_(a1);
            if (seg < 12) { const float ss = wave_sum(a0 * a0 + a1 * a1); const float sc = (1.0f / sqrtf(ss + 1e-6f)) * (seg < 6 ? 0.08838834764831845f : 1.0f); a0 *= sc; a1 *= sc; }
            *(unsigned*)(QKVd + (size_t)t * 2304 + c0) = pk2(a0, a1);
        }
        if (lane < 12) {
            const float braw = AB[(size_t)t * 32 + lane], araw = AB[(size_t)t * 32 + 12 + lane];
            const float x = araw + dt_bias[lane];
            const float sp = fmaxf(x, 0.f) + log1pf(expf(-fabsf(x)));
            GB[(size_t)lane * S_ + t] = -expf(a_log[lane]) * sp;
            GB[(size_t)(12 + lane) * S_ + t] = 1.0f / (1.0f + expf(-braw));
        }
        {
            const int ch = 4 * lane, hg = lane >> 4;
            const float l0 = LSE[(size_t)t * 4 + hg], l1 = LSE[((size_t)S_ + t) * 4 + hg], l2 = LSE[((size_t)2 * S_ + t) * 4 + hg];
            const float mx = fmaxf(l0, fmaxf(l1, l2));
            float w0 = expf(l0 - mx), w1 = expf(l1 - mx), w2 = expf(l2 - mx);
            const float inv = 1.0f / (w0 + w1 + w2); w0 *= inv; w1 *= inv; w2 *= inv;
            const v2u a = *(const v2u*)(OG + (size_t)t * 256 + ch), b = *(const v2u*)(OG + ((size_t)S_ + t) * 256 + ch), cc = *(const v2u*)(OG + ((size_t)2 * S_ + t) * 256 + ch);
            v2u o;
            o.x = pk2(w0 * bflo(a.x) + w1 * bflo(b.x) + w2 * bflo(cc.x), w0 * bfhi(a.x) + w1 * bfhi(b.x) + w2 * bfhi(cc.x));
            o.y = pk2(w0 * bflo(a.y) + w1 * bflo(b.y) + w2 * bflo(cc.y), w0 * bfhi(a.y) + w1 * bfhi(b.y) + w2 * bfhi(cc.y));
            *(v2u*)(OATT + (size_t)t * 256 + ch) = o;
        }
    }
}

__device__ __forceinline__ void ph_final(const bf16* ODIR0, const bf16* ODIR1, const bf16* PZ, const float* dnw, bf16* ODN, int wv) {
    int tid_ = wv * 64 + lane_id_(); asm volatile("" : "+v"(tid_)); const int lane = tid_ & 63, wave = tid_ >> 6;
    for (int t = BID * 8 + wave; t < S_; t += GSZ * 8) {
#pragma unroll
        for (int h = 0; h < 6; ++h) {
            const int c = h * 128 + 2 * lane;
            const unsigned wf = *(const unsigned*)(ODIR0 + (size_t)t * 768 + c), wb = *(const unsigned*)(ODIR1 + (size_t)t * 768 + c);
            float o0 = bflo(wf) + bflo(wb), o1 = bfhi(wf) + bfhi(wb);
            const float ms = wave_sum(o0 * o0 + o1 * o1) * (1.0f / 128.0f);
            const float sc = 1.0f / sqrtf(ms + 1e-6f);
            const unsigned zw = *(const unsigned*)(PZ + (size_t)t * 768 + c);
            const f32x2 nw = *(const f32x2*)(dnw + 2 * lane);
            o0 = o0 * sc * nw.x * siluf_(bflo(zw)); o1 = o1 * sc * nw.y * siluf_(bfhi(zw));
            *(unsigned*)(ODN + (size_t)t * 768 + c) = pk2(o0, o1);
        }
    }
}
typedef short bf16x8_t __attribute__((ext_vector_type(8)));
typedef short s16x4_t __attribute__((ext_vector_type(4)));
#define MFMA16(a, b, c) __builtin_amdgcn_mfma_f32_16x16x32_bf16((a), (b), (c), 0, 0, 0)

__device__ __forceinline__ void ph_dn_pre(const bf16* QKVd, const float* GB, bf16* TINV, bf16* ATTN, float* VEC, unsigned char* lds, int wv) {
    int tid_ = wv * 64 + lane_id_(); asm volatile("" : "+v"(tid_));
    const int tid = tid_, lane = tid & 63, g = lane >> 4, m16 = lane & 15;
    float* GR = (float*)lds; float* Ms = GR + 2 * 64 * 65; float* Gs = Ms + 2 * 64 * 68; float* Bs = Gs + 128;
    for (int u = BID; u < 1536; u += GSZ) {
        const int n = u / 6, h = u % 6;
        __syncthreads();
        {
            const int kind = wv >> 2, mt = wv & 3;
            const bf16* arow = QKVd + (size_t)(64 * n + 16 * mt + m16) * 2304 + (kind ? 0 : 768) + h * 128 + 8 * g;
            bf16x8_t a[4];
#pragma unroll
            for (int ks = 0; ks < 4; ++ks) a[ks] = *(const bf16x8_t*)(arow + 32 * ks);
#pragma unroll
            for (int nt = 0; nt < 4; ++nt) {
                const bf16* brow = QKVd + (size_t)(64 * n + 16 * nt + m16) * 2304 + 768 + h * 128 + 8 * g;
                f32x4 acc = {0.f, 0.f, 0.f, 0.f};
#pragma unroll
                for (int ks = 0; ks < 4; ++ks) acc = MFMA16(a[ks], *(const bf16x8_t*)(brow + 32 * ks), acc);
#pragma unroll
                for (int rg = 0; rg < 4; ++rg) GR[kind * 64 * 65 + (16 * mt + 4 * g + rg) * 65 + 16 * nt + m16] = acc[rg];
            }
        }
        if ((wv & 3) == 0) {
            const int d = wv >> 2, tok = 64 * n + (d ? 63 - lane : lane);
            float gv = GB[(size_t)(d * 6 + h) * S_ + tok]; const float be = GB[(size_t)(12 + d * 6 + h) * S_ + tok];
#pragma unroll
            for (int o = 1; o < 64; o <<= 1) { const float t = __shfl_up(gv, o); if (lane >= o) gv += t; }
            const float gl = __shfl(gv, 63);
            Gs[d * 64 + lane] = gv; Bs[d * 64 + lane] = be;
            float* vec = VEC + (size_t)(u * 2 + d) * 256;
            vec[lane] = __expf(gv); vec[64 + lane] = be; vec[128 + lane] = __expf(gl - gv); vec[192 + lane] = __expf(gl);
        }
        __syncthreads();
        {
            const int d = wv >> 2, tl = tid & 255, i = tl >> 2, jq = tl & 3, ii = d ? 63 - i : i;
            const float Gi = Gs[d * 64 + i], bi = Bs[d * 64 + i];
            unsigned pk[8];
#pragma unroll
            for (int jj = 0; jj < 16; jj += 2) {
                float at[2];
#pragma unroll
                for (int e = 0; e < 2; ++e) {
                    const int j = 16 * jq + jj + e, jx = d ? 63 - j : j;
                    const float dec = (j <= i) ? __expf(Gi - Gs[d * 64 + j]) : 0.f;
                    const float kk = GR[ii * 65 + jx], qk = GR[64 * 65 + ii * 65 + jx];
                    Ms[d * 64 * 68 + i * 68 + j] = (j < i) ? bi * kk * dec : 0.f;
                    at[e] = (j <= i) ? qk * dec : 0.f;
                }
                pk[jj >> 1] = pk2(at[0], at[1]);
            }
            v4u* dst = (v4u*)(ATTN + ((size_t)(u * 2 + d) * 64 + i) * 64 + 16 * jq);
            v4u o0; o0.x = pk[0]; o0.y = pk[1]; o0.z = pk[2]; o0.w = pk[3]; v4u o1; o1.x = pk[4]; o1.y = pk[5]; o1.z = pk[6]; o1.w = pk[7];
            dst[0] = o0; dst[1] = o1;
        }
        __syncthreads();
        if ((wv & 3) == 0) {
            const int d = wv >> 2, c = lane; const float* Md = Ms + d * 64 * 68;
            float x[64];
#pragma unroll
            for (int i = 0; i < 64; ++i) {
                float s0 = (i == c) ? 1.f : 0.f, s1 = 0.f, s2 = 0.f, s3 = 0.f;
#pragma unroll
                for (int j0 = 0; j0 < i; j0 += 4) {
                    const f32x4 mv = *(const f32x4*)(Md + i * 68 + j0);
                    s0 -= mv.x * x[j0];
                    if (j0 + 1 < i) s1 -= mv.y * x[j0 + 1];
                    if (j0 + 2 < i) s2 -= mv.z * x[j0 + 2];
                    if (j0 + 3 < i) s3 -= mv.w * x[j0 + 3];
                }
                x[i] = (s0 + s1) + (s2 + s3);
            }
            bf16* outp = TINV + (size_t)(u * 2 + d) * 4096 + c;
#pragma unroll
            for (int i = 0; i < 64; ++i) outp[i * 64] = (bf16)f2bf(x[i]);
        }
    }
}

constexpr int SC_KT = 0, SC_QT = 17408, SC_TI = 34816, SC_AT = 44032, SC_VT = 53248, SC_VC = 55296, SC_BUF = 56320;
constexpr int SC_ST = 2 * SC_BUF, SC_RT = SC_ST + 4352, SC_VNT = SC_RT + 2304, SC_VST = SC_VNT + 2304, SC_END = SC_VST + 2304;
static_assert(SC_END <= 131072, "scan LDS");
__device__ __forceinline__ void ph_dn_scan(const bf16* QKVd, const bf16* TINV, const bf16* ATTN, const float* VEC, bf16* ODIR0, bf16* ODIR1, LAS unsigned char* lds, int wv) {
    const int bid = BID;
    if (bid >= 128) return;
    const int p = (bid & 7) + 8 * (bid >> 6), sl = (bid >> 3) & 7;
    if (p >= 12) return;
    const int d = p / 6, h = p % 6;
    int tid_ = wv * 64 + lane_id_(); asm volatile("" : "+v"(tid_));
    const int tid = tid_, lane = tid & 63, g = lane >> 4, m16 = lane & 15;
    bf16* ODIR = d ? ODIR1 : ODIR0;
    v4u pf[7];
#define SC_LOAD(step) do { const int n_ = d ? 255 - (step) : (step); const size_t cb_ = (size_t)((n_ * 6 + h) * 2 + d); \
        _Pragma("unroll") for (int k_ = 0; k_ < 7; ++k_) { const int q_ = tid + 512 * k_; const void* src_ = nullptr; \
            if (k_ < 4) { const int qq_ = q_ & 1023, row_ = qq_ >> 4, ch_ = qq_ & 15; const int tok_ = 64 * n_ + (d ? 63 - row_ : row_); src_ = QKVd + (size_t)tok_ * 2304 + (k_ < 2 ? 768 : 0) + h * 128 + ch_ * 8; } \
            else if (k_ < 6) { const int qq_ = q_ & 511, row_ = qq_ >> 3, ch_ = qq_ & 7; src_ = (k_ == 4 ? TINV : ATTN) + cb_ * 4096 + row_ * 64 + ch_ * 8; } \
            else { const int qq_ = q_ - 3072; if (qq_ < 128) { const int row_ = qq_ >> 1, ch_ = qq_ & 1; const int tok_ = 64 * n_ + (d ? 63 - row_ : row_); src_ = QKVd + (size_t)tok_ * 2304 + 1536 + h * 128 + sl * 16 + ch_ * 8; } \
                   else if (qq_ < 192) src_ = VEC + cb_ * 256 + (qq_ - 128) * 4; } \
            if (src_) pf[k_] = *(const v4u*)src_; } } while (0)
#define SC_WRITE(bufsel) do { LAS unsigned char* bb_ = lds + (bufsel) * SC_BUF; \
        _Pragma("unroll") for (int k_ = 0; k_ < 7; ++k_) { const int q_ = tid + 512 * k_; int off_ = -1; \
            if (k_ < 4) { const int qq_ = q_ & 1023, row_ = qq_ >> 4, ch_ = qq_ & 15; off_ = (k_ < 2 ? SC_KT : SC_QT) + row_ * 272 + ch_ * 16; } \
            else if (k_ < 6) { const int qq_ = q_ & 511, row_ = qq_ >> 3, ch_ = qq_ & 7; off_ = (k_ == 4 ? SC_TI : SC_AT) + row_ * 144 + ch_ * 16; } \
            else { const int qq_ = q_ - 3072; if (qq_ < 128) off_ = SC_VT + qq_ * 16; else if (qq_ < 192) off_ = SC_VC + (qq_ - 128) * 16; } \
            if (off_ >= 0) *(LAS v4u*)(bb_ + off_) = pf[k_]; } } while (0)
    f32x4 Sreg = {0.f, 0.f, 0.f, 0.f};
    for (int e = tid; e < 4352 / 4; e += NTHREADS) ((LAS unsigned*)(lds + SC_ST))[e] = 0u;
    SC_LOAD(0); SC_WRITE(0);
    __syncthreads();
#pragma unroll 1
    for (int s = 0; s < 256; ++s) {
        const int cur = s & 1, n = d ? 255 - s : s;
        LAS unsigned char* B = lds + cur * SC_BUF;
        if (s + 1 < 256) SC_LOAD(s + 1);
        const LAS float* VC = (const LAS float*)(B + SC_VC);
        bf16x8_t sb[4];
#pragma unroll
        for (int ks = 0; ks < 4; ++ks) sb[ks] = *(const LAS bf16x8_t*)(lds + SC_ST + m16 * 272 + (32 * ks + 8 * g) * 2);
        const int t4 = wv & 3;
        f32x4 acc1 = {0.f, 0.f, 0.f, 0.f};
        {
            const LAS unsigned char* ap = B + (wv < 4 ? SC_KT : SC_QT) + (16 * t4 + m16) * 272 + 16 * g;
#pragma unroll
            for (int ks = 0; ks < 4; ++ks) acc1 = MFMA16(*(const LAS bf16x8_t*)(ap + 64 * ks), sb[ks], acc1);
        }
        const f32x4 eG4 = *(const LAS f32x4*)(VC + 16 * t4 + 4 * g);
        if (wv < 4) {
            const f32x4 be4 = *(const LAS f32x4*)(VC + 64 + 16 * t4 + 4 * g);
            float r[4];
#pragma unroll
            for (int rg = 0; rg < 4; ++rg) { const float vv = bf2f(*(const LAS unsigned short*)(B + SC_VT + (16 * t4 + 4 * g + rg) * 32 + m16 * 2)); r[rg] = be4[rg] * (vv - eG4[rg] * acc1[rg]); }
            v2u w; w.x = pk2(r[0], r[1]); w.y = pk2(r[2], r[3]);
            *(LAS v2u*)(lds + SC_RT + m16 * 144 + (16 * t4 + 4 * g) * 2) = w;
        } else {
#pragma unroll
            for (int rg = 0; rg < 4; ++rg) acc1[rg] *= eG4[rg];
        }
        __syncthreads();
        if (wv < 4) {
            const LAS unsigned char* ap = B + SC_TI + (16 * t4 + m16) * 144 + 16 * g;
            f32x4 vn = {0.f, 0.f, 0.f, 0.f};
#pragma unroll
            for (int ks = 0; ks < 2; ++ks) vn = MFMA16(*(const LAS bf16x8_t*)(ap + 64 * ks), *(const LAS bf16x8_t*)(lds + SC_RT + m16 * 144 + (32 * ks + 8 * g) * 2), vn);
            const f32x4 eL4 = *(const LAS f32x4*)(VC + 128 + 16 * t4 + 4 * g);
            v2u w; w.x = pk2(vn[0], vn[1]); w.y = pk2(vn[2], vn[3]);
            *(LAS v2u*)(lds + SC_VNT + m16 * 144 + (16 * t4 + 4 * g) * 2) = w;
            v2u w2; w2.x = pk2(vn[0] * eL4[0], vn[1] * eL4[1]); w2.y = pk2(vn[2] * eL4[2], vn[3] * eL4[3]);
            *(LAS v2u*)(lds + SC_VST + m16 * 144 + (16 * t4 + 4 * g) * 2) = w2;
        }
        __syncthreads();
        {
            f32x4 acc3 = {0.f, 0.f, 0.f, 0.f};
#pragma unroll
            for (int ks = 0; ks < 2; ++ks) {
                const LAS unsigned char* tp = B + SC_KT + (32 * ks + 8 * g + (m16 >> 2)) * 272 + (16 * wv + 4 * (m16 & 3)) * 2;
                const s16x4_t lo = __builtin_amdgcn_ds_read_tr16_b64_v4i16((LAS s16x4_t*)tp);
                const s16x4_t hi = __builtin_amdgcn_ds_read_tr16_b64_v4i16((LAS s16x4_t*)(tp + 4 * 272));
                const bf16x8_t a = {lo[0], lo[1], lo[2], lo[3], hi[0], hi[1], hi[2], hi[3]};
                acc3 = MFMA16(a, *(const LAS bf16x8_t*)(lds + SC_VST + m16 * 144 + (32 * ks + 8 * g) * 2), acc3);
            }
            const float gl = VC[192];
#pragma unroll
            for (int rg = 0; rg < 4; ++rg) Sreg[rg] = gl * Sreg[rg] + acc3[rg];
            v2u w; w.x = pk2(Sreg[0], Sreg[1]); w.y = pk2(Sreg[2], Sreg[3]);
            *(LAS v2u*)(lds + SC_ST + m16 * 272 + (16 * wv + 4 * g) * 2) = w;
        }
        if (wv >= 4) {
            const LAS unsigned char* ap = B + SC_AT + (16 * t4 + m16) * 144 + 16 * g;
#pragma unroll
            for (int ks = 0; ks < 2; ++ks) acc1 = MFMA16(*(const LAS bf16x8_t*)(ap + 64 * ks), *(const LAS bf16x8_t*)(lds + SC_VNT + m16 * 144 + (32 * ks + 8 * g) * 2), acc1);
#pragma unroll
            for (int rg = 0; rg < 4; ++rg) { const int i = 16 * t4 + 4 * g + rg, tok = 64 * n + (d ? 63 - i : i);
                ODIR[(size_t)tok * 768 + h * 128 + sl * 16 + m16] = (bf16)f2bf(acc1[rg]); }
        }
        if (s + 1 < 256) SC_WRITE(cur ^ 1);
        __syncthreads();
    }
#undef SC_LOAD
#undef SC_WRITE
}
constexpr int LDS_RING = 131072, LDS_CTL_OFF = LDS_RING, LDS_BYTES = 147456;
constexpr int CW_BAR = 4096;
__device__ __forceinline__ unsigned char* wsp() { return PWS; }
template <class Epi> __device__ __forceinline__ void run_gemm(LAS unsigned char* lds, const bf16* A, const bf16* Bt, int N, int K, const Epi& E, int wv) {
    pg8::Gemm g{A, Bt, S_, N, K, 0};
    pg8::StaticOrder S; S.init(S_, N, GSZ, BID);
    pg8::gemm_phase<Epi, pg8::StaticOrder, true, true>(lds, g, S, E, wv);
}
template <int l, int f> __device__ __forceinline__ void sublayer(LAS unsigned char* lds, unsigned char* lds_raw, int wv) {
#define GRID_BAR() do { XcdBarrier b_; b_.bar = (unsigned*)(wsp() + WS_CTL) + CW_BAR; b_.st = (volatile LAS unsigned*)(lds + LDS_CTL_OFF + 320) + 8; b_.x = b_.st[2]; xcd_barrier(b_, wv); } while (0)
#define WSB() wsp()
            if (f == 1) {
                { unsigned char* ws = WSB(); unsigned char* R = ws + WS_R;
                  pg8::EpiInProj E; E.PA = (bf16*)(R + R_PA); E.PD = (bf16*)(R + R_PD); E.PZ = (bf16*)(R + R_PZ); E.AB = (float*)(R + R_AB);
                  run_gemm(lds, (const bf16*)(ws + WS_H), (const bf16*)(ws + WS_W + W_IN), 5632, 1024, E, wv); }
                GRID_BAR();
                { unsigned char* ws = WSB(); unsigned char* R = ws + WS_R;
                  ph_attn_v1((const bf16*)(R + R_PA), (const float*)(ws + WS_ROPE), (bf16*)(R + R_OG), (float*)(R + R_LSE), lds_raw, wv); }
                GRID_BAR();
                { unsigned char* ws = WSB(); unsigned char* R = ws + WS_R;
                  ph_dnprep((const bf16*)(R + R_PD), (const float*)(R + R_AB), PIN(10) + (size_t)l * 5 * 2304, PIN(11) + l * 12, PIN(12) + l * 12, (bf16*)(R + R_QKVD), (float*)(R + R_GB),
                            (const bf16*)(R + R_OG), (const float*)(R + R_LSE), (bf16*)(R + R_OATT), wv); }
                GRID_BAR();
                { unsigned char* ws = WSB(); unsigned char* R = ws + WS_R;
                  ph_dn_pre((const bf16*)(R + R_QKVD), (const float*)(R + R_GB), (bf16*)(R + R_TINV), (bf16*)(R + R_ATTN), (float*)(R + R_VEC), lds_raw, wv); }
                GRID_BAR();
                { unsigned char* ws = WSB(); unsigned char* R = ws + WS_R;
                  ph_dn_scan((const bf16*)(R + R_QKVD), (const bf16*)(R + R_TINV), (const bf16*)(R + R_ATTN), (const float*)(R + R_VEC), (bf16*)(R + R_ODIR0), (bf16*)(R + R_ODIR1), lds, wv); }
                GRID_BAR();
                { unsigned char* ws = WSB(); unsigned char* R = ws + WS_R;
                  pg8::EpiBf16P E; E.O = (bf16*)(R + R_PG); E.ldc = 2048; E.pad_ = 0;
                  run_gemm(lds, (const bf16*)(ws + WS_H), (const bf16*)(ws + WS_W + W_IN) + (size_t)5632 * 1024, 2048, 1024, E, wv); }
                { unsigned char* ws = WSB(); unsigned char* R = ws + WS_R;
                  ph_final((const bf16*)(R + R_ODIR0), (const bf16*)(R + R_ODIR1), (const bf16*)(R + R_PZ), PIN(13) + l * 128, (bf16*)(R + R_ODN), wv); }
                GRID_BAR();
                { unsigned char* ws = WSB(); unsigned char* R = ws + WS_R;
                  pg8::EpiGateF32 E; E.O = (float*)(R + R_T1); E.gate = (const bf16*)(R + R_PG); E.ldg = 2048; E.pad_ = 0;
                  run_gemm(lds, (const bf16*)(R + R_OATT), (const bf16*)(ws + WS_W + W_BATT), 1024, 256, E, wv); }
                { unsigned char* ws = WSB(); unsigned char* R = ws + WS_R;
                  pg8::EpiGateAddBf16 E; E.O = (bf16*)(ws + WS_H); E.T1 = (const float*)(R + R_T1); E.gate = (const bf16*)(R + R_PG) + 1024; E.ldg = 2048; E.pad_ = 0;
                  run_gemm(lds, (const bf16*)(R + R_ODN), (const bf16*)(ws + WS_W + W_BDN), 1024, 768, E, wv); }
                GRID_BAR();
                { unsigned char* ws = WSB(); unsigned char* R = ws + WS_R;
                  pg8::EpiF32 E; E.O = (float*)(R + R_Y2); E.ldc = 1024; E.pad_ = 0; run_gemm(lds, (const bf16*)(ws + WS_H), (const bf16*)(ws + WS_W + W_OUT), 1024, 1024, E, wv); }
                GRID_BAR();
                { unsigned char* ws = WSB(); unsigned char* R = ws + WS_R; const float* mod = (const float*)(ws + WS_MOD) + l * 9216;
                  RowArgs a; a.xi = POUT; a.y = (const float*)(R + R_Y2); a.xo = POUT; a.h = (bf16*)(ws + WS_H); a.wpost = PIN(6) + (l * 3 + 1) * 1024; a.gate = mod + (1 * 3 + 2) * 1024; a.coef = 1.0f;
                  a.wpre = PIN(5) + (l * 3 + 2) * 1024; a.shift = mod + (2 * 3 + 0) * 1024; a.scale = mod + (2 * 3 + 1) * 1024; ph_rows(a, wv); }
                GRID_BAR();
            }
            const int s = f * 2;
            { unsigned char* ws = WSB(); unsigned char* R = ws + WS_R;
              pg8::EpiSwiglu E; E.O = (bf16*)(R + R_ACT); E.ldc = FF_; E.pad_ = 0; run_gemm(lds, (const bf16*)(ws + WS_H), (const bf16*)(ws + WS_W + (f ? W_FFIN1 : W_FFIN0)), 2 * FF_, 1024, E, wv); }
            GRID_BAR();
            { unsigned char* ws = WSB(); unsigned char* R = ws + WS_R;
              pg8::EpiF32 E; E.O = (float*)(R + R_Y); E.ldc = 1024; E.pad_ = 0; run_gemm(lds, (const bf16*)(R + R_ACT), (const bf16*)(ws + WS_W + (f ? W_FFOUT1 : W_FFOUT0)), 1024, FF_, E, wv); }
            GRID_BAR();
            { unsigned char* ws = WSB(); unsigned char* R = ws + WS_R; const float* MOD = (const float*)(ws + WS_MOD); const float* mod = MOD + l * 9216;
              RowArgs a; a.xi = (l == 0 && f == 0) ? PIN(0) : POUT; a.y = (const float*)(R + R_Y); a.xo = POUT; a.wpost = PIN(6) + (l * 3 + s) * 1024; a.gate = mod + (s * 3 + 2) * 1024; a.coef = 0.5f;
              if (f == 0) { a.h = (bf16*)(ws + WS_H); a.wpre = PIN(5) + (l * 3 + 1) * 1024; a.shift = mod + (1 * 3 + 0) * 1024; a.scale = mod + (1 * 3 + 1) * 1024; }
              else if (l == 0) { a.h = (bf16*)(ws + WS_H); a.wpre = PIN(5) + (1 * 3 + 0) * 1024; a.shift = MOD + 9216; a.scale = MOD + 9216 + 1024; }
              else { a.h = nullptr; a.wpre = nullptr; a.shift = nullptr; a.scale = nullptr; }
              ph_rows(a, wv);
              if (f == 1 && l == 0) ph_convert(1, lds_raw, wv); }
            GRID_BAR();
}
__global__ void __launch_bounds__(NTHREADS, 2) mega_fwd(Params P) {
    extern __shared__ __attribute__((aligned(16))) unsigned char lds_raw[];
    LAS unsigned char* lds = (LAS unsigned char*)lds_raw;
    const int wv = __builtin_amdgcn_readfirstlane((int)threadIdx.x >> 6);
    { const int tid0 = threadIdx.x;
      for (int u = tid0; u < (LDS_BYTES - LDS_CTL_OFF) / 4; u += NTHREADS) ((LAS unsigned*)(lds + LDS_CTL_OFF))[u] = 0u;
      __syncthreads();
      XcdBarrier b0 = xcd_barrier_post((unsigned*)(PWS + WS_CTL) + CW_BAR, (volatile LAS unsigned*)(lds + LDS_CTL_OFF + 320) + 8);
      if (tid0 == 0) ((volatile LAS unsigned*)(lds + LDS_CTL_OFF + 320))[10] = b0.x;
      __syncthreads(); }
#define GRID_BAR() do { XcdBarrier b_; b_.bar = (unsigned*)(wsp() + WS_CTL) + CW_BAR; b_.st = (volatile LAS unsigned*)(lds + LDS_CTL_OFF + 320) + 8; b_.x = b_.st[2]; xcd_barrier(b_, wv); } while (0)
#define WSB() wsp()
#define LDSA() ({ LAS unsigned char* l_ = lds; asm volatile("" : "+s"(l_)); l_; })
#define LDSG() ({ unsigned char* l_ = lds_raw; asm volatile("" : "+s"(l_)); l_; })
    ph_ada(lds_raw, wv); ph_rope(wv); ph_convert(0, lds_raw, wv);
    GRID_BAR();
    { unsigned char* ws = WSB(); float* MOD = (float*)(ws + WS_MOD);
      RowArgs a; a.xi = PIN(0); a.y = nullptr; a.xo = nullptr; a.h = (bf16*)(ws + WS_H); a.wpost = nullptr; a.gate = nullptr; a.wpre = PIN(5); a.shift = MOD; a.scale = MOD + 1024; a.coef = 0.f; ph_rows(a, wv); }
    GRID_BAR();
    sublayer<0, 0>(lds, lds_raw, wv);
    sublayer<0, 1>(lds, lds_raw, wv);
    sublayer<1, 0>(lds, lds_raw, wv);
    sublayer<1, 1>(lds, lds_raw, wv);
}

extern "C" void kernel_launch(void* const* d_in, const int* in_sizes, int n_in, void* d_out, int out_size, void* d_ws, size_t ws_size, hipStream_t stream) {
    static int grid = 0;
    if (grid == 0) {
        if (n_in != 17 || ws_size < WS_END) { fprintf(stderr, "kernel_launch: unexpected n_in %d / ws_size %zu\n", n_in, ws_size); grid = -1; return; }
        int dev = 0, cus = 0, per_cu = 0;
        if (hipGetDevice(&dev) != hipSuccess || hipDeviceGetAttribute(&cus, hipDeviceAttributeMultiprocessorCount, dev) != hipSuccess) { grid = -1; return; }
        if (hipFuncSetAttribute((const void*)mega_fwd, hipFuncAttributeMaxDynamicSharedMemorySize, LDS_BYTES) != hipSuccess) { fprintf(stderr, "kernel_launch: hipFuncSetAttribute failed\n"); grid = -1; return; }
        if (hipOccupancyMaxActiveBlocksPerMultiprocessor(&per_cu, (const void*)mega_fwd, NTHREADS, LDS_BYTES) != hipSuccess || per_cu < 1) { fprintf(stderr, "kernel_launch: occupancy query says %d\n", per_cu); per_cu = 1; }
        (void)hipGetLastError();
        grid = cus;
        if (grid > 256) grid = 256;
    }
    if (grid < 0) return;
    (void)hipMemsetAsync((char*)d_ws + WS_CTL, 0, 1 * MiB, stream);
    Params p{};
    for (int i = 0; i < 17; ++i) p.in[i] = (const float*)d_in[i];
    p.out = (float*)d_out; p.ws = (unsigned char*)d_ws;
    hipLaunchKernelGGL(mega_fwd, dim3(grid), dim3(NTHREADS), LDS_BYTES, stream, p);
}
```

```cpp
#include <hip/hip_runtime.h>
#include <cstdio>
#include <cstdint>
__device__ __forceinline__ int lane_id_() { int l; asm volatile("v_mbcnt_lo_u32_b32 %0, -1, 0\n\tv_mbcnt_hi_u32_b32 %0, -1, %0" : "=v"(l)); return l; }
namespace pg8 {
#define PG8_LAS __attribute__((address_space(3)))
typedef unsigned short bf16_t;
typedef short bf16x8 __attribute__((ext_vector_type(8)));
typedef float f32x4 __attribute__((ext_vector_type(4)));
typedef unsigned u32x4 __attribute__((ext_vector_type(4)));
constexpr int BM = 256, BK = 64, HALF = 128, HTB = HALF * BK * 2  , STAGE_BYTES = 8 * HTB, NXCD = 8, WGM = 8;

__host__ __device__ __forceinline__ int lds_byte(int r, int c) { const int st = (r >> 4) * 2 + (c >> 5), rr = r & 15, cc = c & 31, ob = rr * 64 + cc * 2; return st * 1024 + (ob ^ (((ob >> 9) & 1) << 5)); }
__host__ __device__ __forceinline__ void stage_rc(int b, int& R, int& C) { const int st = b / 1024, sb = b % 1024, swz = sb ^ (((sb >> 9) & 1) << 5); R = (st >> 1) * 16 + swz / 64; C = (st & 1) * 32 + (swz % 64) / 2; }
__host__ __device__ __forceinline__ int perm32(int rho) { const int n = rho >> 4, i = rho & 15; return 8 * (i >> 2) + 4 * n + (i & 3); }

struct Unit { int pm, pn; };
struct Gemm { const bf16_t* A; const bf16_t* Bt; int M, N, K, pad_; };

struct StaticOrder {
    int nM, nN, nwg, G, c;
    __host__ __device__ void init(int M, int N, int G_, int c_) { nM = M / BM; nN = N / BM; nwg = nM * nN; G = G_; c = c_; }
    __host__ __device__ bool next(int i, Unit& u) const {
        const long L = (long)i * G + c; if (L >= nwg) return false;
        int wgid = (int)L; { const int q = nwg / NXCD, r = nwg % NXCD, xcd = wgid % NXCD, off = wgid / NXCD; wgid = (xcd < r ? xcd * (q + 1) : r * (q + 1) + (xcd - r) * q) + off; }
        const int nig = WGM * nN, gid = wgid / nig, fm = gid * WGM, gsz = (nM - fm) < WGM ? (nM - fm) : WGM;
        u.pm = fm + ((wgid % nig) % gsz); u.pn = (wgid % nig) / gsz; return true;
    }
    __device__ __forceinline__ void a_ready(const Unit&) const {}
    __device__ __forceinline__ void done(const Unit&) const {}
};

__device__ __forceinline__ unsigned cvt_pk_bf16(float lo, float hi) { unsigned r; asm volatile("v_cvt_pk_bf16_f32 %0, %1, %2" : "=v"(r) : "v"(lo), "v"(hi)); return r; }
typedef float f32x2 __attribute__((ext_vector_type(2)));
__device__ __forceinline__ f32x2 gelu_pk(f32x2 v) {
    const f32x2 av = __builtin_elementwise_abs(v), d = av * 0.2316418882f + 1.0f;
    f32x2 t; t.x = __builtin_amdgcn_rcpf(d.x); t.y = __builtin_amdgcn_rcpf(d.y);
    f32x2 q = t * 0.5307027145f + (-0.7265760135f); q = q * t + 0.7107068705f; q = q * t + (-0.142248368f); q = q * t + 0.127414796f; q = q * t;
    const f32x2 s = (v * v) * (-0.72134752044f);
    f32x2 e; e.x = __builtin_amdgcn_exp2f(s.x); e.y = __builtin_amdgcn_exp2f(s.y);
    const f32x2 m = v * (q * e), r = v - m;
    f32x2 o; o.x = v.x < 0.f ? m.x : r.x; o.y = v.y < 0.f ? m.y : r.y; return o;
}

template <int ACT  > struct EpiBf16 {
    static constexpr bool PERM = true, AFTER_DRAIN = false; static_assert(ACT == 0 || ACT == 1, "EpiBf16: ACT is 0 (none) or 1 (gelu_pk)");
    bf16_t* O; int ldc; const float* bias; int split_cols; size_t split_stride; float scale0;
    __device__ __forceinline__ void operator()(const f32x4 (&acc)[2][2][4][2], const Unit& u, int wr, int wc, int fr, int fq) const {
        const int row0 = u.pm * BM + wr * 64 + fr; int colt = u.pn * BM; bf16_t* base = O;
        float sc = 1.f; if (split_cols) { const int t = colt / split_cols; base += (size_t)t * split_stride; colt -= t * split_cols; if (t == 0) sc = scale0; }
        const int col0 = colt + wc * 32 + 8 * fq, bcol0 = u.pn * BM + wc * 32 + 8 * fq;
        f32x4 bv[2][2];
#pragma unroll
        for (int bj = 0; bj < 2; ++bj)
#pragma unroll
            for (int n = 0; n < 2; ++n) bv[bj][n] = bias ? *(const f32x4*)(bias + bcol0 + bj * HALF + 4 * n) : (f32x4){0.f, 0.f, 0.f, 0.f};
#pragma unroll
        for (int ai = 0; ai < 2; ++ai)
#pragma unroll
            for (int m = 0; m < 4; ++m) { bf16_t* rowp = base + (size_t)(row0 + ai * HALF + m * 16) * ldc + col0;
#pragma unroll
                for (int bj = 0; bj < 2; ++bj) { f32x4 v0 = acc[ai][bj][m][0] + bv[bj][0], v1 = acc[ai][bj][m][1] + bv[bj][1];
                    if (ACT == 1) { f32x2 a = gelu_pk((f32x2){v0[0], v0[1]}), b = gelu_pk((f32x2){v0[2], v0[3]}), c = gelu_pk((f32x2){v1[0], v1[1]}), d = gelu_pk((f32x2){v1[2], v1[3]});
                        v0 = (f32x4){a.x, a.y, b.x, b.y}; v1 = (f32x4){c.x, c.y, d.x, d.y}; }
                    v0 = v0 * sc; v1 = v1 * sc; u32x4 w; w.x = cvt_pk_bf16(v0[0], v0[1]); w.y = cvt_pk_bf16(v0[2], v0[3]); w.z = cvt_pk_bf16(v1[0], v1[1]); w.w = cvt_pk_bf16(v1[2], v1[3]);
                    *(u32x4*)(rowp + bj * HALF) = w; } }
    }
};

struct PanelStats {
    unsigned* xbuf;
    unsigned* cnt;
    unsigned* tmo;
    int ntn; float eps;
    unsigned code;
    __device__ __forceinline__ bool run(const f32x4 (&v)[2][2][4][2], const Unit& u, int wr, int wc, int fr, int fq, PG8_LAS unsigned char* lds, int wid, int lane) const {
        typedef float f32x2v __attribute__((ext_vector_type(2)));
        PG8_LAS f32x2v* P = (PG8_LAS f32x2v*)lds;
        PG8_LAS f32x2v* S = (PG8_LAS f32x2v*)(lds + 8192);
        PG8_LAS unsigned* flag = (PG8_LAS unsigned*)(lds + 8192 + 2048);
#pragma unroll
        for (int ai = 0; ai < 2; ++ai)
#pragma unroll
            for (int m = 0; m < 4; ++m) {
                float s = 0.f;
#pragma unroll
                for (int bj = 0; bj < 2; ++bj)
#pragma unroll
                    for (int n = 0; n < 2; ++n) { const f32x4 x = v[ai][bj][m][n]; s += (x[0] + x[1]) + (x[2] + x[3]); }
                s += __shfl_xor(s, 16); s += __shfl_xor(s, 32);
                const float mw = s * (1.0f / 64.0f); float q = 0.f;
#pragma unroll
                for (int bj = 0; bj < 2; ++bj)
#pragma unroll
                    for (int n = 0; n < 2; ++n) { const f32x4 d = v[ai][bj][m][n] - mw; q += (d[0] * d[0] + d[1] * d[1]) + (d[2] * d[2] + d[3] * d[3]); }
                q += __shfl_xor(q, 16); q += __shfl_xor(q, 32);
                if (fq == 0) P[(ai * HALF + wr * 64 + m * 16 + fr) * 4 + wc] = (f32x2v){mw, q};
            }
        asm volatile("s_waitcnt lgkmcnt(0)" ::: "memory"); __builtin_amdgcn_s_barrier(); asm volatile("" ::: "memory");
#if defined(BROKEN_EXCHANGE_NO_WAIT)
#warning BROKEN CONTROL BUILD: the row-statistics exchange does not wait; results are wrong by design
        if (blockIdx.x >= 64) { const long long t0_ = clock64(); while (clock64() - t0_ < 60000) __builtin_amdgcn_s_sleep(8); }
#endif
        const int row = wid * 32 + (lane & 31);
        if (lane < 32) {
            const f32x2v a = P[row * 4 + 0], b = P[row * 4 + 1], c = P[row * 4 + 2], d = P[row * 4 + 3];
            const float mt = (a.x + b.x + c.x + d.x) * 0.25f;
            const float da = a.x - mt, db = b.x - mt, dc = c.x - mt, dd = d.x - mt;
            const float m2 = (a.y + b.y) + (c.y + d.y) + 64.0f * ((da * da + db * db) + (dc * dc + dd * dd));
            unsigned long long* slot = (unsigned long long*)xbuf + ((size_t)(u.pm * BM + row) * 4 + u.pn);
            __hip_atomic_store(slot, ((unsigned long long)__float_as_uint(m2) << 32) | __float_as_uint(mt), __ATOMIC_RELAXED, __HIP_MEMORY_SCOPE_AGENT);
        }
        asm volatile("s_waitcnt vmcnt(0)" ::: "memory");
        if (lane == 0) __hip_atomic_fetch_add(cnt + 64 * u.pm, 1u, __ATOMIC_RELAXED, __HIP_MEMORY_SCOPE_AGENT);
        if (wid == 0) {
            bool dead = false; const unsigned long long t0 = __builtin_amdgcn_s_memrealtime(); const unsigned want = 8u * (unsigned)ntn;
            for (;;) {
#if defined(BROKEN_EXCHANGE_NO_WAIT)
                break;
#endif
                if ((unsigned)__builtin_amdgcn_readfirstlane(__hip_atomic_load(cnt + 64 * u.pm, __ATOMIC_RELAXED, __HIP_MEMORY_SCOPE_AGENT)) >= want) break;
                if (__builtin_amdgcn_s_memrealtime() - t0 > 2000000ull) {
                    if (lane == 0) { unsigned expect = 0u; __hip_atomic_compare_exchange_strong(tmo + 1, &expect, code | (unsigned)(u.pm & 0xff), __ATOMIC_RELAXED, __ATOMIC_RELAXED, __HIP_MEMORY_SCOPE_AGENT);
                                     __hip_atomic_store(tmo, 1u, __ATOMIC_RELAXED, __HIP_MEMORY_SCOPE_AGENT); }
                    dead = true; break; }
                __builtin_amdgcn_s_sleep(2);
            }
            __builtin_amdgcn_fence(__ATOMIC_ACQUIRE, "agent");
            if (lane == 0) flag[0] = dead ? 1u : 0u;
        }
        asm volatile("s_waitcnt vmcnt(0) lgkmcnt(0)" ::: "memory"); __builtin_amdgcn_s_barrier(); asm volatile("" ::: "memory");
        const bool bad = flag[0] != 0u;
        if (lane < 32) {
            const unsigned long long* slot = (const unsigned long long*)xbuf + (size_t)(u.pm * BM + row) * 4; float mt[4], m2[4]; float ms = 0.f;
#pragma unroll
            for (int t = 0; t < 4; ++t) { if (t < ntn) { const unsigned long long w = __hip_atomic_load(slot + t, __ATOMIC_RELAXED, __HIP_MEMORY_SCOPE_AGENT); mt[t] = __uint_as_float((unsigned)w); m2[t] = __uint_as_float((unsigned)(w >> 32)); } else { mt[t] = 0.f; m2[t] = 0.f; } ms += mt[t]; }
            const float mean = ms / (float)ntn; float q = 0.f;
#pragma unroll
            for (int t = 0; t < 4; ++t) if (t < ntn) { const float dm = mt[t] - mean; q += m2[t] + 256.0f * dm * dm; }
            S[row] = (f32x2v){mean, 1.0f / sqrtf(q / (256.0f * (float)ntn) + eps)};
        }
        asm volatile("s_waitcnt lgkmcnt(0)" ::: "memory"); __builtin_amdgcn_s_barrier(); asm volatile("" ::: "memory");
        return bad;
    }
};
struct EpiLnRes {
    static constexpr bool PERM = false, AFTER_DRAIN = true;
    const float* base; float* out; int ldc; const float* bias; PanelStats st; unsigned poison;
    __device__ __forceinline__ void fused(f32x4 (&acc)[2][2][4][2], const Unit& u, int wr, int wc, int fr, int fq, PG8_LAS unsigned char* lds, int wid, int lane) const {
        typedef float f32x2v __attribute__((ext_vector_type(2)));
        const PG8_LAS f32x2v* S = (const PG8_LAS f32x2v*)(lds + 8192);
        const int col0 = u.pn * BM + wc * 32 + 4 * fq;
#pragma unroll
        for (int bj = 0; bj < 2; ++bj)
#pragma unroll
            for (int n = 0; n < 2; ++n) { const f32x4 bv = bias ? *(const f32x4*)(bias + col0 + bj * HALF + n * 16) : (f32x4){0.f, 0.f, 0.f, 0.f};
#pragma unroll
                for (int ai = 0; ai < 2; ++ai)
#pragma unroll
                    for (int m = 0; m < 4; ++m) acc[ai][bj][m][n] += bv; }
        f32x4 pre[4][2][2];
#pragma unroll
        for (int m = 0; m < 4; ++m) { const size_t off = (size_t)(u.pm * BM + wr * 64 + m * 16 + fr) * ldc + col0;
#pragma unroll
            for (int bj = 0; bj < 2; ++bj)
#pragma unroll
                for (int n = 0; n < 2; ++n) pre[m][bj][n] = *(const f32x4*)(base + off + bj * HALF + n * 16); }
        const bool bad = st.run(acc, u, wr, wc, fr, fq, lds, wid, lane) || poison != 0u;
        const float qnan = __builtin_nanf("");
#pragma unroll
        for (int ai = 0; ai < 2; ++ai)
#pragma unroll
            for (int m = 0; m < 4; ++m) { const int r = ai * HALF + wr * 64 + m * 16 + fr; const f32x2v sr = S[r]; const size_t off = (size_t)(u.pm * BM + r) * ldc + col0;
#pragma unroll
                for (int bj = 0; bj < 2; ++bj)
#pragma unroll
                    for (int n = 0; n < 2; ++n) { const f32x4 bs = ai == 0 ? pre[m][bj][n] : *(const f32x4*)(base + off + bj * HALF + n * 16); f32x4 o = bs + (acc[ai][bj][m][n] - sr.x) * sr.y;
                        if (bad) o = (f32x4){qnan, qnan, qnan, qnan}; *(f32x4*)(out + off + bj * HALF + n * 16) = o; }
                if (m & 1) asm volatile("" ::: "memory"); }
    }
};
struct EpiLnResLn {
    static constexpr bool PERM = false, AFTER_DRAIN = true;
    const float* base; float* out; bf16_t* xn; int ldc; const float* bias; PanelStats st1, st2; unsigned poison;
    __device__ __forceinline__ void fused(f32x4 (&acc)[2][2][4][2], const Unit& u, int wr, int wc, int fr, int fq, PG8_LAS unsigned char* lds, int wid, int lane) const {
        typedef float f32x2v __attribute__((ext_vector_type(2))); typedef unsigned u32x2v __attribute__((ext_vector_type(2)));
        const PG8_LAS f32x2v* S = (const PG8_LAS f32x2v*)(lds + 8192);
        const int col0 = u.pn * BM + wc * 32 + 4 * fq;
#pragma unroll
        for (int bj = 0; bj < 2; ++bj)
#pragma unroll
            for (int n = 0; n < 2; ++n) { const f32x4 bv = bias ? *(const f32x4*)(bias + col0 + bj * HALF + n * 16) : (f32x4){0.f, 0.f, 0.f, 0.f};
#pragma unroll
                for (int ai = 0; ai < 2; ++ai)
#pragma unroll
                    for (int m = 0; m < 4; ++m) acc[ai][bj][m][n] += bv; }
        bool bad = st1.run(acc, u, wr, wc, fr, fq, lds, wid, lane) || poison != 0u;
        const float qnan = __builtin_nanf("");
#pragma unroll
        for (int ai = 0; ai < 2; ++ai)
#pragma unroll
            for (int m = 0; m < 4; ++m) { const int r = ai * HALF + wr * 64 + m * 16 + fr; const f32x2v sr = S[r]; const size_t off = (size_t)(u.pm * BM + r) * ldc + col0;
#pragma unroll
                for (int bj = 0; bj < 2; ++bj)
#pragma unroll
                    for (int n = 0; n < 2; ++n) { const f32x4 bs = *(const f32x4*)(base + off + bj * HALF + n * 16); acc[ai][bj][m][n] = bs + (acc[ai][bj][m][n] - sr.x) * sr.y; }
                asm volatile("" : "+v"(acc[ai][0][m][0]), "+v"(acc[ai][0][m][1]), "+v"(acc[ai][1][m][0]), "+v"(acc[ai][1][m][1]));
                if (m & 1) asm volatile("" ::: "memory"); }
        const bool bad1 = bad;
        bad = st2.run(acc, u, wr, wc, fr, fq, lds, wid, lane) || bad;
#pragma unroll
        for (int ai = 0; ai < 2; ++ai)
#pragma unroll
            for (int m = 0; m < 4; ++m) { const int r = ai * HALF + wr * 64 + m * 16 + fr; const f32x2v sr = S[r]; const size_t off = (size_t)(u.pm * BM + r) * ldc + col0;
#pragma unroll
                for (int bj = 0; bj < 2; ++bj)
#pragma unroll
                    for (int n = 0; n < 2; ++n) { const f32x4 x1 = acc[ai][bj][m][n]; *(f32x4*)(out + off + bj * HALF + n * 16) = bad1 ? (f32x4){qnan, qnan, qnan, qnan} : x1;
                        const f32x4 o = (x1 - sr.x) * sr.y; u32x2v w; w.x = cvt_pk_bf16(o[0], o[1]); w.y = cvt_pk_bf16(o[2], o[3]);
                        if (bad) { w.x = 0x7fc07fc0u; w.y = 0x7fc07fc0u; } *(u32x2v*)(xn + off + bj * HALF + n * 16) = w; }
                asm volatile("" ::: "memory"); }
    }
};

template <class Epi, class Sched, bool ALIGN_EPI = false, bool SP2 = false>
__device__ __forceinline__ void gemm_phase(PG8_LAS unsigned char* lds, const Gemm g, const Sched& S, const Epi& E, int wv) {
    int tid_ = wv * 64 + lane_id_(); asm volatile("" : "+v"(tid_));
    const int tid = tid_, wid = __builtin_amdgcn_readfirstlane(tid >> 6), lane = tid & 63, wr = wid >> 2, wc = wid & 3, fr = lane & 15, fq = lane >> 4;
    const int K = g.K, nt = K / BK;
    unsigned voffA[2], voffB[2];
#pragma unroll
    for (int i = 0; i < 2; ++i) { int R, C; stage_rc(tid * 16 + i * 8192, R, C); const int Rb = Epi::PERM ? ((R & ~31) + perm32(R & 31)) : R;
        voffA[i] = (unsigned)(R * K + C) * 2u; voffB[i] = (unsigned)(Rb * K + C) * 2u; }
    const size_t kstep = (size_t)(BK * 2);
    const size_t hstep = (size_t)HALF * K * 2;
    const size_t tstep = 2 * hstep;
    const unsigned ldsw = (unsigned)wid * 1024u;
    const int aoff = lds_byte(wr * 64 + fr, fq * 8), boff = lds_byte(wc * 32 + fr, fq * 8);
#define PG8_SA(b, h) (((b) * 2 + (h)) * HTB)
#define PG8_SB(b, h) ((4 + (b) * 2 + (h)) * HTB)
#define PG8_STAGE(bufoff, gbase, voff) do { _Pragma("unroll") for (int _i = 0; _i < 2; ++_i) \
        __builtin_amdgcn_global_load_lds((const unsigned*)((const char*)(gbase) + (voff)[_i]), (PG8_LAS unsigned*)(lds + (bufoff) + ldsw + _i * 8192), 16, 0, 0); } while (0)
#define PG8_LDA(dst, b, h) do { _Pragma("unroll") for (int m = 0; m < 4; ++m) _Pragma("unroll") for (int k = 0; k < 2; ++k) dst[m][k] = *(const PG8_LAS bf16x8*)(lds + PG8_SA(b, h) + aoff + m * 2048 + k * 1024); } while (0)
#define PG8_LDB(dst, b, h) do { _Pragma("unroll") for (int n = 0; n < 2; ++n) _Pragma("unroll") for (int k = 0; k < 2; ++k) dst[n][k] = *(const PG8_LAS bf16x8*)(lds + PG8_SB(b, h) + boff + n * 2048 + k * 1024); } while (0)
#define PG8_MMA(ai, bj, At, Bt) do { __builtin_amdgcn_s_setprio(1); _Pragma("unroll") for (int m = 0; m < 4; ++m) _Pragma("unroll") for (int n = 0; n < 2; ++n) _Pragma("unroll") for (int k = 0; k < 2; ++k) \
        acc[ai][bj][m][n] = __builtin_amdgcn_mfma_f32_16x16x32_bf16(Bt[n][k], At[m][k], acc[ai][bj][m][n], 0, 0, 0); __builtin_amdgcn_s_setprio(0); } while (0)
#define PG8_WAIT_V(n) asm volatile("s_waitcnt vmcnt(" #n ")" ::: "memory")
#define PG8_WAIT_L(n) asm volatile("s_waitcnt lgkmcnt(" #n ")" ::: "memory")
#define PG8_BAR __builtin_amdgcn_s_barrier()
#define PG8_SCHED __builtin_amdgcn_sched_barrier(0)
    Unit cur, nxt; int ui = 0;
    if (!S.next(0, cur)) return;
    f32x4 acc[2][2][4][2];
#pragma unroll
    for (int a = 0; a < 2; ++a)
#pragma unroll
        for (int b = 0; b < 2; ++b)
#pragma unroll
            for (int m = 0; m < 4; ++m)
#pragma unroll
                for (int n = 0; n < 2; ++n) acc[a][b][m][n] = (f32x4){0.f, 0.f, 0.f, 0.f};
    bf16x8 At[4][2], B0[2][2], B1[2][2];
    const char* cA = (const char*)g.A + (size_t)cur.pm * tstep; const char* cB = (const char*)g.Bt + (size_t)cur.pn * tstep;
    S.a_ready(cur);
    if constexpr (SP2) {
        PG8_STAGE(PG8_SB(0, 0), cB, voffB); PG8_STAGE(PG8_SB(0, 1), cB + hstep, voffB); PG8_STAGE(PG8_SA(0, 0), cA, voffA); PG8_STAGE(PG8_SA(0, 1), cA + hstep, voffA);
        if (wr == 1) PG8_BAR;
        PG8_WAIT_V(2); PG8_BAR;
        PG8_STAGE(PG8_SB(1, 0), cB + kstep, voffB); PG8_STAGE(PG8_SA(1, 0), cA + kstep, voffA); PG8_STAGE(PG8_SB(1, 1), cB + hstep + kstep, voffB);
        PG8_WAIT_V(6); PG8_BAR;
    } else {
        PG8_STAGE(PG8_SB(0, 0), cB, voffB); PG8_STAGE(PG8_SA(0, 0), cA, voffA); PG8_STAGE(PG8_SB(0, 1), cB + hstep, voffB); PG8_STAGE(PG8_SA(0, 1), cA + hstep, voffA);
        if (wr == 1) PG8_BAR;
        PG8_WAIT_V(4); PG8_BAR;
        PG8_STAGE(PG8_SB(1, 0), cB + kstep, voffB); PG8_STAGE(PG8_SA(1, 0), cA + kstep, voffA); PG8_STAGE(PG8_SB(1, 1), cB + hstep + kstep, voffB);
        PG8_WAIT_V(6); PG8_BAR;
    }
    for (;;) {
        const bool has_next = S.next(ui + 1, nxt);
        const char* nA = has_next ? (const char*)g.A + (size_t)nxt.pm * tstep : cA; const char* nB = has_next ? (const char*)g.Bt + (size_t)nxt.pn * tstep : cB;
        for (int t = 0; t < nt; t += 2) {
            const bool last = (t == nt - 2);
            const char* a1 = cA + (size_t)(t + 1) * kstep;
            const char* a2 = last ? nA : cA + (size_t)(t + 2) * kstep; const char* b2 = last ? nB : cB + (size_t)(t + 2) * kstep;
            const char* a3 = a2 + kstep; const char* b3 = b2 + kstep;
            if (last && has_next) S.a_ready(nxt);
            if constexpr (SP2) {
            PG8_LDB(B0, 0, 0); PG8_LDB(B1, 0, 1); PG8_SCHED; PG8_LDA(At, 0, 0); PG8_STAGE(PG8_SA(1, 1), a1 + hstep, voffA);
            PG8_WAIT_V(8); PG8_WAIT_L(0); PG8_BAR; PG8_MMA(0, 0, At, B0); PG8_MMA(0, 1, At, B1); PG8_BAR; PG8_SCHED;
            PG8_LDA(At, 0, 1); PG8_STAGE(PG8_SB(0, 0), b2, voffB); PG8_STAGE(PG8_SB(0, 1), b2 + hstep, voffB); PG8_STAGE(PG8_SA(0, 0), a2, voffA);
            PG8_WAIT_V(8); PG8_WAIT_L(0); PG8_BAR; PG8_MMA(1, 0, At, B0); PG8_MMA(1, 1, At, B1); PG8_BAR; PG8_SCHED;
            PG8_LDB(B0, 1, 0); PG8_LDB(B1, 1, 1); PG8_SCHED; PG8_LDA(At, 1, 0); PG8_STAGE(PG8_SA(0, 1), a2 + hstep, voffA);
            PG8_WAIT_V(8); PG8_WAIT_L(0); PG8_BAR; PG8_MMA(0, 0, At, B0); PG8_MMA(0, 1, At, B1); PG8_BAR; PG8_SCHED;
            PG8_LDA(At, 1, 1); PG8_STAGE(PG8_SB(1, 0), b3, voffB); PG8_STAGE(PG8_SB(1, 1), b3 + hstep, voffB); PG8_STAGE(PG8_SA(1, 0), a3, voffA);
            PG8_WAIT_V(8); PG8_WAIT_L(0); PG8_BAR; PG8_MMA(1, 0, At, B0); PG8_MMA(1, 1, At, B1); PG8_BAR; PG8_SCHED;
            } else {
            PG8_LDB(B0, 0, 0); PG8_SCHED; PG8_LDA(At, 0, 0); PG8_STAGE(PG8_SA(1, 1), a1 + hstep, voffA);
            PG8_WAIT_L(8); PG8_BAR; PG8_WAIT_L(0); PG8_MMA(0, 0, At, B0); PG8_BAR; PG8_SCHED;
            PG8_LDB(B1, 0, 1); PG8_STAGE(PG8_SB(0, 0), b2, voffB);
            PG8_BAR; PG8_WAIT_L(0); PG8_MMA(0, 1, At, B1); PG8_BAR;
            PG8_LDA(At, 0, 1); PG8_STAGE(PG8_SA(0, 0), a2, voffA);
            PG8_BAR; PG8_WAIT_L(0); PG8_MMA(1, 0, At, B0); PG8_BAR; PG8_SCHED;
            PG8_STAGE(PG8_SB(0, 1), b2 + hstep, voffB);
            PG8_WAIT_V(6); PG8_BAR; PG8_MMA(1, 1, At, B1); PG8_BAR;
            PG8_LDB(B0, 1, 0); PG8_SCHED; PG8_LDA(At, 1, 0); PG8_STAGE(PG8_SA(0, 1), a2 + hstep, voffA);
            PG8_WAIT_L(8); PG8_BAR; PG8_WAIT_L(0); PG8_MMA(0, 0, At, B0); PG8_BAR; PG8_SCHED;
            PG8_LDB(B1, 1, 1); PG8_STAGE(PG8_SB(1, 0), b3, voffB);
            PG8_BAR; PG8_WAIT_L(0); PG8_MMA(0, 1, At, B1); PG8_BAR;
            PG8_LDA(At, 1, 1); PG8_STAGE(PG8_SA(1, 0), a3, voffA);
            PG8_BAR; PG8_WAIT_L(0); PG8_MMA(1, 0, At, B0); PG8_BAR; PG8_SCHED;
            PG8_STAGE(PG8_SB(1, 1), b3 + hstep, voffB);
            PG8_WAIT_V(6); PG8_BAR; PG8_MMA(1, 1, At, B1); PG8_BAR;
            }
        }
        if constexpr (ALIGN_EPI) { if (wr == 0) PG8_BAR; }
        if constexpr (!Epi::AFTER_DRAIN) { E(acc, cur, wr, wc, fr, fq); S.done(cur); }
        if (!has_next) break;
#pragma unroll
        for (int a = 0; a < 2; ++a)
#pragma unroll
            for (int b = 0; b < 2; ++b)
#pragma unroll
                for (int m = 0; m < 4; ++m)
#pragma unroll
                    for (int n = 0; n < 2; ++n) acc[a][b][m][n] = (f32x4){0.f, 0.f, 0.f, 0.f};
        cur = nxt; cA = nA; cB = nB; ++ui;
        if constexpr (ALIGN_EPI) { if (wr == 1) PG8_BAR; }
    }
    PG8_WAIT_V(0);
    if constexpr (!ALIGN_EPI) { if (wr == 0) PG8_BAR; }
    PG8_BAR;
    if constexpr (Epi::AFTER_DRAIN) { E.fused(acc, cur, wr, wc, fr, fq, lds, wid, lane); S.done(cur); }
#undef PG8_SA
#undef PG8_SB
#undef PG8_STAGE
#undef PG8_LDA
#undef PG8_LDB
#undef PG8_MMA
#undef PG8_WAIT_V
#undef PG8_WAIT_L
#undef PG8_BAR
#undef PG8_SCHED
}
}
constexpr int S_ = 16384, D_ = 1024, FF_ = 2816, NIN_ = 7448, NINP_ = 7680;
constexpr int NTHREADS = 512;
constexpr size_t MiB = 1u << 20;
constexpr size_t WS_CTL = 0;
constexpr size_t WS_MOD = 1 * MiB;
constexpr size_t WS_ROPE = 2 * MiB;
constexpr size_t WS_W = 6 * MiB;
constexpr size_t W_FFIN0 = 0, W_FFIN1 = 11 * MiB, W_FFOUT0 = 22 * MiB, W_FFOUT1 = 27 * MiB + MiB / 2, W_IN = 33 * MiB, W_BATT = 48 * MiB, W_BDN = 48 * MiB + MiB / 2, W_OUT = 50 * MiB;
constexpr size_t WS_H = 58 * MiB;
constexpr size_t WS_R = 90 * MiB;
constexpr size_t R_ACT = 0, R_Y = 88 * MiB;
constexpr size_t R_PA = 0, R_QKVD = 0, R_PG = 0, R_PD = 72 * MiB, R_TINV = 72 * MiB, R_ODIR1 = 120 * MiB, R_ODN = 72 * MiB, R_T1 = 96 * MiB, R_PZ = 144 * MiB, R_AB = 168 * MiB, R_GB = 170 * MiB,
                 R_OATT = 172 * MiB, R_ATTN = 180 * MiB, R_Y2 = 160 * MiB, R_OG = 228 * MiB, R_LSE = 252 * MiB, R_ODIR0 = 228 * MiB, R_VEC = 253 * MiB;
constexpr size_t WS_END = 352 * MiB;

typedef unsigned short bf16;
typedef unsigned v4u __attribute__((ext_vector_type(4)));
typedef unsigned v2u __attribute__((ext_vector_type(2)));
typedef float f32x4 __attribute__((ext_vector_type(4)));
typedef float f32x2 __attribute__((ext_vector_type(2)));
#define LAS __attribute__((address_space(3)))

__device__ __forceinline__ unsigned f2bf(float f) { unsigned u = __builtin_bit_cast(unsigned, f); return (u + 0x7fffu + ((u >> 16) & 1u)) >> 16; }
__device__ __forceinline__ unsigned pk2(float lo, float hi) { return f2bf(lo) | (f2bf(hi) << 16); }
__device__ __forceinline__ float bf2f(unsigned short b) { return __builtin_bit_cast(float, (unsigned)b << 16); }
__device__ __forceinline__ float bflo(unsigned w) { return __builtin_bit_cast(float, w << 16); }
__device__ __forceinline__ float bfhi(unsigned w) { return __builtin_bit_cast(float, w & 0xffff0000u); }
__device__ __forceinline__ float wave_sum(float v) {
#pragma unroll
    for (int o = 1; o < 64; o <<= 1) v += __shfl_xor(v, o);
    return v;
}
__device__ __forceinline__ float sigmoidf_(float x) { return 1.0f / (1.0f + __expf(-x)); }
__device__ __forceinline__ float siluf_(float x) { return x / (1.0f + __expf(-x)); }

namespace pg8 {
struct EpiSwiglu {
    static constexpr bool PERM = true, AFTER_DRAIN = false;
    bf16_t* O; int ldc; int pad_;
    __device__ __forceinline__ void operator()(const f32x4 (&acc)[2][2][4][2], const Unit& u, int wr, int wc, int fr, int fq) const {
        const int row0 = u.pm * BM + wr * 64 + fr, col0 = u.pn * 128 + wc * 32 + 8 * fq;
#pragma unroll
        for (int ai = 0; ai < 2; ++ai)
#pragma unroll
            for (int m = 0; m < 4; ++m) {
                bf16_t* rowp = O + (size_t)(row0 + ai * HALF + m * 16) * ldc + col0;
                float v[8];
#pragma unroll
                for (int n = 0; n < 2; ++n)
#pragma unroll
                    for (int e = 0; e < 4; ++e) { const float g = acc[ai][0][m][n][e], uu = acc[ai][1][m][n][e]; v[n * 4 + e] = g * __builtin_amdgcn_rcpf(1.0f + __expf(-g)) * uu; }
                u32x4 w; w.x = cvt_pk_bf16(v[0], v[1]); w.y = cvt_pk_bf16(v[2], v[3]); w.z = cvt_pk_bf16(v[4], v[5]); w.w = cvt_pk_bf16(v[6], v[7]);
                *(u32x4*)rowp = w;
            }
    }
};
struct EpiBf16P {
    static constexpr bool PERM = true, AFTER_DRAIN = false;
    bf16_t* O; int ldc; int pad_;
    __device__ __forceinline__ void operator()(const f32x4 (&acc)[2][2][4][2], const Unit& u, int wr, int wc, int fr, int fq) const {
        const int row0 = u.pm * BM + wr * 64 + fr, col0 = u.pn * BM + wc * 32 + 8 * fq;
#pragma unroll
        for (int ai = 0; ai < 2; ++ai)
#pragma unroll
            for (int m = 0; m < 4; ++m) {
                bf16_t* rowp = O + (size_t)(row0 + ai * HALF + m * 16) * ldc + col0;
#pragma unroll
                for (int bj = 0; bj < 2; ++bj) { const f32x4 v0 = acc[ai][bj][m][0], v1 = acc[ai][bj][m][1];
                    u32x4 w; w.x = cvt_pk_bf16(v0[0], v0[1]); w.y = cvt_pk_bf16(v0[2], v0[3]); w.z = cvt_pk_bf16(v1[0], v1[1]); w.w = cvt_pk_bf16(v1[2], v1[3]);
                    *(u32x4*)(rowp + bj * HALF) = w; }
            }
    }
};
struct EpiF32 {
    static constexpr bool PERM = false, AFTER_DRAIN = false;
    float* O; int ldc; int pad_;
    __device__ __forceinline__ void operator()(const f32x4 (&acc)[2][2][4][2], const Unit& u, int wr, int wc, int fr, int fq) const {
        const int row0 = u.pm * BM + wr * 64 + fr, col0 = u.pn * BM + wc * 32 + 4 * fq;
#pragma unroll
        for (int ai = 0; ai < 2; ++ai)
#pragma unroll
            for (int m = 0; m < 4; ++m) {
                float* rowp = O + (size_t)(row0 + ai * HALF + m * 16) * ldc + col0;
#pragma unroll
                for (int bj = 0; bj < 2; ++bj)
#pragma unroll
                    for (int n = 0; n < 2; ++n) *(f32x4*)(rowp + bj * HALF + n * 16) = acc[ai][bj][m][n];
            }
    }
};
struct EpiInProj {
    static constexpr bool PERM = true, AFTER_DRAIN = false;
    bf16_t* PA; bf16_t* PD; bf16_t* PZ; float* AB;
    __device__ __forceinline__ void operator()(const f32x4 (&acc)[2][2][4][2], const Unit& u, int wr, int wc, int fr, int fq) const {
        const int row0 = u.pm * BM + wr * 64 + fr;
        if (u.pn == 21) {
            if (wc == 0) {
#pragma unroll
                for (int ai = 0; ai < 2; ++ai)
#pragma unroll
                    for (int m = 0; m < 4; ++m) {
                        float* rowp = AB + (size_t)(row0 + ai * HALF + m * 16) * 32 + 8 * fq;
                        *(f32x4*)rowp = acc[ai][0][m][0]; *(f32x4*)(rowp + 4) = acc[ai][0][m][1];
                    }
            }
            return;
        }
        bf16_t* base; int ldc, ct;
        if (u.pn < 9) { base = PA; ldc = 2304; ct = u.pn; } else if (u.pn < 18) { base = PD; ldc = 2304; ct = u.pn - 9; } else { base = PZ; ldc = 768; ct = u.pn - 18; }
        const int col0 = ct * BM + wc * 32 + 8 * fq;
#pragma unroll
        for (int ai = 0; ai < 2; ++ai)
#pragma unroll
            for (int m = 0; m < 4; ++m) {
                bf16_t* rowp = base + (size_t)(row0 + ai * HALF + m * 16) * ldc + col0;
#pragma unroll
                for (int bj = 0; bj < 2; ++bj) { const f32x4 v0 = acc[ai][bj][m][0], v1 = acc[ai][bj][m][1];
                    u32x4 w; w.x = cvt_pk_bf16(v0[0], v0[1]); w.y = cvt_pk_bf16(v0[2], v0[3]); w.z = cvt_pk_bf16(v1[0], v1[1]); w.w = cvt_pk_bf16(v1[2], v1[3]);
                    *(u32x4*)(rowp + bj * HALF) = w; }
            }
    }
};
struct EpiGateF32 {
    static constexpr bool PERM = false, AFTER_DRAIN = false;
    float* O; const bf16_t* gate; int ldg; int pad_;
    __device__ __forceinline__ void operator()(const f32x4 (&acc)[2][2][4][2], const Unit& u, int wr, int wc, int fr, int fq) const {
        const int row0 = u.pm * BM + wr * 64 + fr, col0 = u.pn * BM + wc * 32 + 4 * fq;
#pragma unroll
        for (int ai = 0; ai < 2; ++ai)
#pragma unroll
            for (int m = 0; m < 4; ++m) {
                const size_t r = (size_t)(row0 + ai * HALF + m * 16);
#pragma unroll
                for (int bj = 0; bj < 2; ++bj)
#pragma unroll
                    for (int n = 0; n < 2; ++n) { const int c = col0 + bj * HALF + n * 16;
                        const v2u gw = *(const v2u*)(gate + r * ldg + c);
                        f32x4 a = acc[ai][bj][m][n];
                        a[0] *= sigmoidf_(bflo(gw.x)); a[1] *= sigmoidf_(bfhi(gw.x)); a[2] *= sigmoidf_(bflo(gw.y)); a[3] *= sigmoidf_(bfhi(gw.y));
                        *(f32x4*)(O + r * 1024 + c) = a; }
            }
    }
};
struct EpiGateAddBf16 {
    static constexpr bool PERM = false, AFTER_DRAIN = false;
    bf16_t* O; const float* T1; const bf16_t* gate; int ldg; int pad_;
    __device__ __forceinline__ void operator()(const f32x4 (&acc)[2][2][4][2], const Unit& u, int wr, int wc, int fr, int fq) const {
        const int row0 = u.pm * BM + wr * 64 + fr, col0 = u.pn * BM + wc * 32 + 4 * fq;
#pragma unroll
        for (int ai = 0; ai < 2; ++ai)
#pragma unroll
            for (int m = 0; m < 4; ++m) {
                const size_t r = (size_t)(row0 + ai * HALF + m * 16);
#pragma unroll
                for (int bj = 0; bj < 2; ++bj)
#pragma unroll
                    for (int n = 0; n < 2; ++n) { const int c = col0 + bj * HALF + n * 16;
                        const v2u gw = *(const v2u*)(gate + r * ldg + c);
                        const f32x4 t = *(const f32x4*)(T1 + r * 1024 + c);
                        f32x4 a = acc[ai][bj][m][n];
                        a[0] = t[0] + a[0] * sigmoidf_(bflo(gw.x)); a[1] = t[1] + a[1] * sigmoidf_(bfhi(gw.x)); a[2] = t[2] + a[2] * sigmoidf_(bflo(gw.y)); a[3] = t[3] + a[3] * sigmoidf_(bfhi(gw.y));
                        v2u w; w.x = cvt_pk_bf16(a[0], a[1]); w.y = cvt_pk_bf16(a[2], a[3]);
                        *(v2u*)(O + r * 1024 + c) = w; }
            }
    }
};
}


#define GAS __attribute__((address_space(1)))
struct Params { const float* in[17]; float* out; unsigned char* ws; };
#define XB_TMO      128
#define XB_XCNT(j)  (256  + 64 * (j))
#define XB_XSUB(j)  (1280 + 64 * (j))
#define XB_XGEN(j)  (2304 + 64 * (j))
#define XB_TOP      3328
#define XB_TOPGEN   3392
#define XCD_BAR_WORDS 3456
#define XB_SPIN_CAP (1u << 18)

__device__ __forceinline__ unsigned xb_ld(unsigned* p)              { return __hip_atomic_load(p, __ATOMIC_RELAXED, __HIP_MEMORY_SCOPE_AGENT); }
__device__ __forceinline__ unsigned xb_add(unsigned* p, unsigned v) { return __hip_atomic_fetch_add(p, v, __ATOMIC_RELAXED, __HIP_MEMORY_SCOPE_AGENT); }
__device__ __forceinline__ unsigned xb_xcc_id() { return (unsigned)__builtin_amdgcn_s_getreg((3 << 11) | 20) & 0xFu; }
#define XB_SPIN(cond, bar) do { unsigned _sp = 0; while (cond) { __builtin_amdgcn_s_sleep(1); \
    if ((++_sp & 255u) == 0u) { if (xb_ld(&(bar)[XB_TMO])) break; if (_sp > XB_SPIN_CAP) { atomicAdd(&(bar)[XB_TMO], 1u); break; } } } } while (0)

struct XcdBarrier {
    unsigned* bar; unsigned x;
    volatile LAS unsigned* st;
};

__device__ __forceinline__ XcdBarrier xcd_barrier_post(unsigned* bar, volatile LAS unsigned* st) {
    XcdBarrier b; b.bar = bar; b.x = xb_xcc_id(); b.st = st;
    if (threadIdx.x == 0) (void)xb_add(&bar[XB_XCNT(b.x)], 1u);
    return b;
}
__device__ __forceinline__ void xcd_barrier_complete(unsigned* bar, unsigned x, unsigned& nloc, unsigned& nx) {
    const unsigned G = gridDim.x * gridDim.y * gridDim.z;
    unsigned sum, cnt, mine, sp = 0u;
    for (;;) {
        sum = 0u; cnt = 0u; mine = 0u;
#pragma unroll
        for (unsigned j = 0; j < 16; ++j) { const unsigned c = xb_ld(&bar[XB_XCNT(j)]); sum += c; cnt += (c > 0u) ? 1u : 0u; mine = (j == x) ? c : mine; }
        if (sum == G) break;
        __builtin_amdgcn_s_sleep(1);
        if ((++sp & 255u) == 0u) { if (xb_ld(&bar[XB_TMO])) break; if (sp > XB_SPIN_CAP) { atomicAdd(&bar[XB_TMO], 1u); break; } }
    }
    nloc = mine > 0u ? mine : 1u; nx = cnt > 0u ? cnt : 1u;
}

__device__ __forceinline__ void xcd_barrier(const XcdBarrier& b, int wv) {
    const bool leader_thread = (wv == 0) && (lane_id_() == 0);
    asm volatile("s_waitcnt vmcnt(0)" ::: "memory");
    __syncthreads();
    if (leader_thread) {
        unsigned* bar = b.bar;
        __builtin_amdgcn_s_waitcnt(0);
        unsigned nloc = b.st[0], nx = b.st[1];
        if (nloc == 0u) { xcd_barrier_complete(bar, b.x, nloc, nx); b.st[0] = nloc; b.st[1] = nx; }
        const unsigned old = xb_add(&bar[XB_XSUB(b.x)], 1u);
        const unsigned gen = old / nloc;
        if (old + 1u == (gen + 1u) * nloc) {
            __builtin_amdgcn_fence(__ATOMIC_RELEASE, "agent");
            asm volatile("s_waitcnt vmcnt(0)" ::: "memory");
            const unsigned og = xb_add(&bar[XB_TOP], 1u);
            const unsigned tg = og / nx;
            if (og + 1u == (tg + 1u) * nx) xb_add(&bar[XB_TOPGEN], 1u);
            else XB_SPIN(xb_ld(&bar[XB_TOPGEN]) == tg, bar);
            __builtin_amdgcn_fence(__ATOMIC_ACQUIRE, "agent");
            xb_add(&bar[XB_XGEN(b.x)], 1u);
            asm volatile("s_waitcnt vmcnt(0)" ::: "memory");
        } else {
            XB_SPIN(xb_ld(&bar[XB_XGEN(b.x)]) == gen, bar);
            __builtin_amdgcn_fence(__ATOMIC_ACQUIRE, "agent");
            asm volatile("s_waitcnt vmcnt(0)" ::: "memory");
        }
    }
    __syncthreads();
}

typedef const __attribute__((address_space(4))) unsigned char* ka_t;
__device__ __forceinline__ ka_t ka_() { ka_t k = (ka_t)__builtin_amdgcn_kernarg_segment_ptr(); asm volatile("" : "+s"(k)); return k; }
#define PIN(i) ((const float*)(*(const __attribute__((address_space(4))) unsigned long long*)(ka_() + 8 * (i))))
#define POUT ((float*)(*(const __attribute__((address_space(4))) unsigned long long*)(ka_() + 136)))
#define PWS ((unsigned char*)(*(const __attribute__((address_space(4))) unsigned long long*)(ka_() + 144)))
#define BID ((int)blockIdx.x)
#define GSZ ((int)gridDim.x)
__device__ __forceinline__ int srcmap(int mode, int n) {
    if (mode == 0) return n;
    if (mode == 1) return (n >> 8) * 128 + (n & 127) + ((n >> 7) & 1) * 2816;
    if (n < 5400) return n;
    if (n < 5632) return -1;
    if (n < 6656) return 5400 + (n - 5632);
    return 6424 + (n - 6656);
}
__device__ __forceinline__ void conv_item(const float* W, bf16* WT, int K, int Nsrc, int Ndst, int mode, int item, float* scr, int lane) {
    const int nblk = Ndst / 32, kb = item / nblk, nb = item % nblk, k0 = 64 * kb, n0 = 32 * nb;
    const int sc = srcmap(mode, n0 + (lane & 31));
#pragma unroll 8
    for (int i = 0; i < 32; ++i) { const int kk = 2 * i + (lane >> 5); scr[kk * 33 + (lane & 31)] = sc >= 0 ? W[(size_t)(k0 + kk) * Nsrc + sc] : 0.f; }
    __builtin_amdgcn_s_waitcnt(0xc07f); __builtin_amdgcn_wave_barrier();
    const int c = lane & 7;
#pragma unroll
    for (int j = 0; j < 4; ++j) { const int n = (lane >> 3) + 8 * j; const float* s = scr + (8 * c) * 33 + n;
        v4u o; o.x = pk2(s[0 * 33], s[1 * 33]); o.y = pk2(s[2 * 33], s[3 * 33]); o.z = pk2(s[4 * 33], s[5 * 33]); o.w = pk2(s[6 * 33], s[7 * 33]);
        *(v4u*)(WT + (size_t)(n0 + n) * K + k0 + 8 * c) = o; }
    __builtin_amdgcn_s_waitcnt(0xc07f); __builtin_amdgcn_wave_barrier();
}
__device__ __forceinline__ void ph_convert(int l, unsigned char* lds, int wv) {
    int tid_ = wv * 64 + lane_id_(); asm volatile("" : "+v"(tid_)); const int lane = tid_ & 63, wave = tid_ >> 6;
    float* scr = (float*)lds + wave * (64 * 33);
    unsigned char* wb = PWS + WS_W;
    constexpr int I_FI = 16 * 176, I_FO = 44 * 32, I_IN = 16 * 240, I_BA = 4 * 32, I_BD = 12 * 32, I_O = 16 * 32;
    constexpr int NIT = 2 * I_FI + 2 * I_FO + I_IN + I_BA + I_BD + I_O;
    for (int it = BID * 8 + wave; it < NIT; it += GSZ * 8) {
        int r = it;
        if (r < 2 * I_FI) { const int f = r / I_FI; conv_item(PIN(7) + ((size_t)l * 2 + f) * 1024 * 5632, (bf16*)(wb + (f ? W_FFIN1 : W_FFIN0)), 1024, 5632, 5632, 1, r % I_FI, scr, lane); continue; } r -= 2 * I_FI;
        if (r < 2 * I_FO) { const int f = r / I_FO; conv_item(PIN(8) + ((size_t)l * 2 + f) * 2816 * 1024, (bf16*)(wb + (f ? W_FFOUT1 : W_FFOUT0)), 2816, 1024, 1024, 0, r % I_FO, scr, lane); continue; } r -= 2 * I_FO;
        if (r < I_IN) { conv_item(PIN(9) + (size_t)l * 1024 * NIN_, (bf16*)(wb + W_IN), 1024, NIN_, NINP_, 2, r, scr, lane); continue; } r -= I_IN;
        if (r < I_BA) { conv_item(PIN(14) + (size_t)l * 256 * 1024, (bf16*)(wb + W_BATT), 256, 1024, 1024, 0, r, scr, lane); continue; } r -= I_BA;
        if (r < I_BD) { conv_item(PIN(15) + (size_t)l * 768 * 1024, (bf16*)(wb + W_BDN), 768, 1024, 1024, 0, r, scr, lane); continue; } r -= I_BD;
        conv_item(PIN(16) + (size_t)l * 1024 * 1024, (bf16*)(wb + W_OUT), 1024, 1024, 1024, 0, r, scr, lane);
    }
}
__device__ __forceinline__ void ph_ada(unsigned char* lds, int wv) {
    float* red = (float*)(lds + 72 * 1024);
    int tid_ = wv * 64 + lane_id_(); asm volatile("" : "+v"(tid_)); const int lane = tid_ & 63, wave = tid_ >> 6;
    const float* c = PIN(1); const float* w_ada = PIN(3); const float* b_ada = PIN(4); float* mod = (float*)(PWS + WS_MOD);
    for (int u = BID; u < 2 * 144; u += GSZ) {
        const int l = u / 144, n = (u % 144) * 64 + lane;
        const float* W = w_ada + (size_t)l * 1024 * 9216 + n;
        float s = 0.f;
        for (int k = wave * 128; k < wave * 128 + 128; ++k) s += siluf_(c[k]) * W[(size_t)k * 9216];
        red[wave * 64 + lane] = s;
        __syncthreads();
        if (wave == 0) { float t = b_ada[l * 9216 + n];
#pragma unroll
            for (int w = 0; w < 8; ++w) t += red[w * 64 + lane];
            mod[l * 9216 + n] = t; }
        __syncthreads();
    }
}
__device__ const float ROPE_INV[32] = {1.000000000e+00f, 7.498942018e-01f, 5.623413324e-01f, 4.216965139e-01f, 3.162277639e-01f, 2.371373773e-01f, 1.778279394e-01f, 1.333521456e-01f, 1.000000015e-01f, 7.498942316e-02f, 5.623413250e-02f, 4.216964915e-02f, 3.162277490e-02f, 2.371373773e-02f, 1.778279431e-02f, 1.333521400e-02f, 9.999999776e-03f, 7.498942316e-03f, 5.623413250e-03f, 4.216964822e-03f, 3.162277630e-03f, 2.371373819e-03f, 1.778279431e-03f, 1.333521446e-03f, 1.000000047e-03f, 7.498941850e-04f, 5.623413017e-04f, 4.216965172e-04f, 3.162277571e-04f, 2.371373703e-04f, 1.778279402e-04f, 1.333521504e-04f};
__device__ __forceinline__ void ph_rope(int wv) {
    const int* pos = (const int*)PIN(2); float* tab = (float*)(PWS + WS_ROPE);
    int tid_ = wv * 64 + lane_id_(); asm volatile("" : "+v"(tid_));
    for (int idx = BID * NTHREADS + tid_; idx < S_ * 32; idx += GSZ * NTHREADS) {
        const int t = idx >> 5, i = idx & 31;
        const float inv = ROPE_INV[i];
        const float ang = (float)pos[t] * inv;
        float sn, cs; sincosf(ang, &sn, &cs);
        tab[idx] = cs; tab[S_ * 32 + idx] = sn;
    }
}
struct RowArgs { const float* xi; const float* y; float* xo; bf16* h; const float* wpost; const float* gate; const float* wpre; const float* shift; const float* scale; float coef; };
__device__ __forceinline__ void ph_rows(const RowArgs& a, int wv) {
    int tid_ = wv * 64 + lane_id_(); asm volatile("" : "+v"(tid_)); const int lane = tid_ & 63, wave = tid_ >> 6;
    for (int r = BID * 8 + wave; r < S_; r += GSZ * 8) {
        f32x4 x[4];
        const f32x4* xr = (const f32x4*)(a.xi + (size_t)r * D_) + lane;
#pragma unroll
        for (int j = 0; j < 4; ++j) x[j] = xr[64 * j];
        if (a.y) {
            f32x4 y[4]; float s = 0.f;
            const f32x4* yr = (const f32x4*)(a.y + (size_t)r * D_) + lane;
#pragma unroll
            for (int j = 0; j < 4; ++j) { y[j] = yr[64 * j]; s += (y[j].x * y[j].x + y[j].y * y[j].y) + (y[j].z * y[j].z + y[j].w * y[j].w); }
            const float rs = 1.0f / sqrtf(wave_sum(s) * (1.f / D_) + 1e-6f);
#pragma unroll
            for (int j = 0; j < 4; ++j) { const f32x4 wp = ((const f32x4*)a.wpost)[lane + 64 * j], g = ((const f32x4*)a.gate)[lane + 64 * j];
                x[j] = x[j] + a.coef * g * ((y[j] * rs) * wp); }
            f32x4* xw = (f32x4*)(a.xo + (size_t)r * D_) + lane;
#pragma unroll
            for (int j = 0; j < 4; ++j) xw[64 * j] = x[j];
        }
        if (a.h) {
            float s = 0.f;
#pragma unroll
            for (int j = 0; j < 4; ++j) s += (x[j].x * x[j].x + x[j].y * x[j].y) + (x[j].z * x[j].z + x[j].w * x[j].w);
            const float rs = 1.0f / sqrtf(wave_sum(s) * (1.f / D_) + 1e-6f);
            v2u* hw = (v2u*)(a.h + (size_t)r * D_) + lane;
#pragma unroll
            for (int j = 0; j < 4; ++j) { const f32x4 wp = ((const f32x4*)a.wpre)[lane + 64 * j], sc = ((const f32x4*)a.scale)[lane + 64 * j], sh = ((const f32x4*)a.shift)[lane + 64 * j];
                const f32x4 v = ((x[j] * rs) * wp) * (1.0f + sc) + sh;
                v2u w; w.x = pk2(v.x, v.y); w.y = pk2(v.z, v.w); hw[64 * j] = w; }
        }
    }
}
constexpr int ATT_PITCH = 68;
__device__ __forceinline__ void ph_attn_v1(const bf16* PA, const float* rope, bf16* OG, float* LSE, unsigned char* lds, int wv) {
    float* qs = (float*)lds; float* ks = qs + 64 * ATT_PITCH; float* vs = ks + 192 * ATT_PITCH;
    int tid_ = wv * 64 + lane_id_(); asm volatile("" : "+v"(tid_)); const int tid = tid_, lane = tid & 63, wave = tid >> 6;
    for (int u = BID; u < 3072; u += GSZ) {
        const int hg = u & 3, w = (u >> 2) & 255, gi = u >> 10;
        const int dil = 1 << (2 * gi), L = S_ / dil, r = w % dil, nb = w / dil, head = gi * 4 + hg;
        __syncthreads();
        for (int rr = wave; rr < 448; rr += 8) {
            int mm, colbase; float* dst; bool rot; float sc = 1.f;
            if (rr < 64) { mm = nb * 64 + rr; colbase = head * 64; dst = qs + rr * ATT_PITCH; rot = true; sc = 0.125f; }
            else if (rr < 256) { mm = nb * 64 - 64 + (rr - 64); colbase = 768 + head * 64; dst = ks + (rr - 64) * ATT_PITCH; rot = true; }
            else { mm = nb * 64 - 64 + (rr - 256); colbase = 1536 + head * 64; dst = vs + (rr - 256) * ATT_PITCH; rot = false; }
            float val = 0.f;
            if (mm >= 0 && mm < L) {
                const int tok = mm * dil + r;
                val = bf2f(PA[(size_t)tok * 2304 + colbase + lane]);
                if (rot) {
                    const float other = __shfl_xor(val, 32);
                    const float cs = rope[tok * 32 + (lane & 31)], sn = rope[S_ * 32 + tok * 32 + (lane & 31)];
                    val = (lane < 32) ? (val * cs - other * sn) : (val * cs + other * sn);
                }
            }
            dst[lane] = val * sc;
        }
        __syncthreads();
        const int i = tid >> 3, part = tid & 7;
        float q[64], acc[64];
#pragma unroll
        for (int d = 0; d < 64; d += 4) { const f32x4 t = *(const f32x4*)(qs + i * ATT_PITCH + d); q[d] = t.x; q[d + 1] = t.y; q[d + 2] = t.z; q[d + 3] = t.w; }
#pragma unroll
        for (int d = 0; d < 64; ++d) acc[d] = 0.f;
        float m = -1e30f, l = 0.f;
        for (int jj = 0; jj < 24; ++jj) {
            const int j = part + 8 * jj, mm = nb * 64 - 64 + j, dj = j - 64 - i;
            const bool ok = (dj <= 64) && (dj >= -64) && (mm >= 0) && (mm < L);
            if (ok) {
                const float* kr = ks + j * ATT_PITCH; float s = 0.f;
#pragma unroll
                for (int d = 0; d < 64; d += 4) { const f32x4 t = *(const f32x4*)(kr + d); s += q[d] * t.x + q[d + 1] * t.y + q[d + 2] * t.z + q[d + 3] * t.w; }
                const float mn = fmaxf(m, s), al = __expf(m - mn), p = __expf(s - mn);
                l = l * al + p; m = mn;
                const float* vr = vs + j * ATT_PITCH;
#pragma unroll
                for (int d = 0; d < 64; d += 4) { const f32x4 t = *(const f32x4*)(vr + d);
                    acc[d] = acc[d] * al + p * t.x; acc[d + 1] = acc[d + 1] * al + p * t.y; acc[d + 2] = acc[d + 2] * al + p * t.z; acc[d + 3] = acc[d + 3] * al + p * t.w; }
            }
        }
        float mt = fmaxf(m, __shfl_xor(m, 1)); mt = fmaxf(mt, __shfl_xor(mt, 2)); mt = fmaxf(mt, __shfl_xor(mt, 4));
        const float f = __expf(m - mt);
        l *= f; l += __shfl_xor(l, 1); l += __shfl_xor(l, 2); l += __shfl_xor(l, 4);
#pragma unroll
        for (int d = 0; d < 64; ++d) acc[d] *= f;
        const bool b2 = part & 4, b1 = part & 2, b0 = part & 1;
        float r32[32], r16[16], r8[8];
#pragma unroll
        for (int d = 0; d < 32; ++d) { const float keep = b2 ? acc[32 + d] : acc[d], send = b2 ? acc[d] : acc[32 + d]; r32[d] = keep + __shfl_xor(send, 4); }
#pragma unroll
        for (int d = 0; d < 16; ++d) { const float keep = b1 ? r32[16 + d] : r32[d], send = b1 ? r32[d] : r32[16 + d]; r16[d] = keep + __shfl_xor(send, 2); }
#pragma unroll
        for (int d = 0; d < 8; ++d) { const float keep = b0 ? r16[8 + d] : r16[d], send = b0 ? r16[d] : r16[8 + d]; r8[d] = keep + __shfl_xor(send, 1); }
        const float il = 1.0f / l;
        const int tok = (nb * 64 + i) * dil + r;
        v4u o; o.x = pk2(r8[0] * il, r8[1] * il); o.y = pk2(r8[2] * il, r8[3] * il); o.z = pk2(r8[4] * il, r8[5] * il); o.w = pk2(r8[6] * il, r8[7] * il);
        *(v4u*)(OG + ((size_t)gi * S_ + tok) * 256 + hg * 64 + part * 8) = o;
        if (part == 0) LSE[((size_t)gi * S_ + tok) * 4 + hg] = mt + logf(l);
    }
}

__device__ __forceinline__ void ph_dnprep(const bf16* PD, const float* AB, const float* convw, const float* a_log, const float* dt_bias, bf16* QKVd, float* GB, const bf16* OG, const float* LSE, bf16* OATT, int wv) {
    int tid_ = wv * 64 + lane_id_(); asm volatile("" : "+v"(tid_)); const int lane = tid_ & 63, wave = tid_ >> 6;
    const int gw = BID * 8 + wave, NGW = GSZ * 8;
    for (int t = gw; t < S_; t += NGW) {
        for (int seg = 0; seg < 18; ++seg) {
            const int c0 = seg * 128 + 2 * lane;
            float a0 = 0.f, a1 = 0.f;
#pragma unroll
            for (int j = 0; j < 5; ++j) { const int tt = t + j - 2;
                if (tt >= 0 && tt < S_) { const unsigned w = *(const unsigned*)(PD + (size_t)tt * 2304 + c0); const f32x2 cw = *(const f32x2*)(convw + j * 2304 + c0);
                    a0 += bflo(w) * cw.x; a1 += bfhi(w) * cw.y; } }
            a0 = siluf_(a0); a1 = siluf_(a1);
            if (seg < 12) { const float ss = wave_sum(a0 * a0 + a1 * a1); const float sc = (1.0f / sqrtf(ss + 1e-6f)) * (seg < 6 ? 0.08838834764831845f : 1.0f); a0 *= sc; a1 *= sc; }
            *(unsigned*)(QKVd + (size_t)t * 2304 + c0) = pk2(a0, a1);
        }
        if (lane < 12) {
            const float braw = AB[(size_t)t * 32 + lane], araw = AB[(size_t)t * 32 + 12 + lane];
            const float x = araw + dt_bias[lane];
            const float sp = fmaxf(x, 0.f) + log1pf(expf(-fabsf(x)));
            GB[(size_t)lane * S_ + t] = -expf(a_log[lane]) * sp;
            GB[(size_t)(12 + lane) * S_ + t] = 1.0f / (1.0f + expf(-braw));
        }
        {
            const int ch = 4 * lane, hg = lane >> 4;
            const float l0 = LSE[(size_t)t * 4 + hg], l1 = LSE[((size_t)S_ + t) * 4 + hg], l2 = LSE[((size_t)2 * S_ + t) * 4 + hg];
            const float mx = fmaxf(l0, fmaxf(l1, l2));
            float w0 = expf(l0 - mx), w1 = expf(l1 - mx), w2 = expf(l2 - mx);
            const float inv = 1.0f / (w0 + w1 + w2); w0 *= inv; w1 *= inv; w2 *= inv;
            const v2u a = *(const v2u*)(OG + (size_t)t * 256 + ch), b = *(const v2u*)(OG + ((size_t)S_ + t) * 256 + ch), cc = *(const v2u*)(OG + ((size_t)2 * S_ + t) * 256 + ch);
            v2u o;
            o.x = pk2(w0 * bflo(a.x) + w1 * bflo(b.x) + w2 * bflo(cc.x), w0 * bfhi(a.x) + w1 * bfhi(b.x) + w2 * bfhi(cc.x));
            o.y = pk2(w0 * bflo(a.y) + w1 * bflo(b.y) + w2 * bflo(cc.y), w0 * bfhi(a.y) + w1 * bfhi(b.y) + w2 * bfhi(cc.y));
            *(v2u*)(OATT + (size_t)t * 256 + ch) = o;
        }
    }
}

__device__ __forceinline__ void ph_final(const bf16* ODIR0, const bf16* ODIR1, const bf16* PZ, const float* dnw, bf16* ODN, int wv) {
    int tid_ = wv * 64 + lane_id_(); asm volatile("" : "+v"(tid_)); const int lane = tid_ & 63, wave = tid_ >> 6;
    for (int t = BID * 8 + wave; t < S_; t += GSZ * 8) {
#pragma unroll
        for (int h = 0; h < 6; ++h) {
            const int c = h * 128 + 2 * lane;
            const unsigned wf = *(const unsigned*)(ODIR0 + (size_t)t * 768 + c), wb = *(const unsigned*)(ODIR1 + (size_t)t * 768 + c);
            float o0 = bflo(wf) + bflo(wb), o1 = bfhi(wf) + bfhi(wb);
            const float ms = wave_sum(o0 * o0 + o1 * o1) * (1.0f / 128.0f);
            const float sc = 1.0f / sqrtf(ms + 1e-6f);
            const unsigned zw = *(const unsigned*)(PZ + (size_t)t * 768 + c);
            const f32x2 nw = *(const f32x2*)(dnw + 2 * lane);
            o0 = o0 * sc * nw.x * siluf_(bflo(zw)); o1 = o1 * sc * nw.y * siluf_(bfhi(zw));
            *(unsigned*)(ODN + (size_t)t * 768 + c) = pk2(o0, o1);
        }
    }
}
typedef short bf16x8_t __attribute__((ext_vector_type(8)));
typedef short s16x4_t __attribute__((ext_vector_type(4)));
#define MFMA16(a, b, c) __builtin_amdgcn_mfma_f32_16x16x32_bf16((a), (b), (c), 0, 0, 0)

__device__ __forceinline__ void ph_dn_pre(const bf16* QKVd, const float* GB, bf16* TINV, bf16* ATTN, float* VEC, unsigned char* lds, int wv) {
    int tid_ = wv * 64 + lane_id_(); asm volatile("" : "+v"(tid_));
    const int tid = tid_, lane = tid & 63, g = lane >> 4, m16 = lane & 15;
    float* GR = (float*)lds; float* Ms = GR + 2 * 64 * 65; float* Gs = Ms + 2 * 64 * 68; float* Bs = Gs + 128;
    for (int u = BID; u < 1536; u += GSZ) {
        const int n = u / 6, h = u % 6;
        __syncthreads();
        {
            const int kind = wv >> 2, mt = wv & 3;
            const bf16* arow = QKVd + (size_t)(64 * n + 16 * mt + m16) * 2304 + (kind ? 0 : 768) + h * 128 + 8 * g;
            bf16x8_t a[4];
#pragma unroll
            for (int ks = 0; ks < 4; ++ks) a[ks] = *(const bf16x8_t*)(arow + 32 * ks);
#pragma unroll
            for (int nt = 0; nt < 4; ++nt) {
                const bf16* brow = QKVd + (size_t)(64 * n + 16 * nt + m16) * 2304 + 768 + h * 128 + 8 * g;
                f32x4 acc = {0.f, 0.f, 0.f, 0.f};
#pragma unroll
                for (int ks = 0; ks < 4; ++ks) acc = MFMA16(a[ks], *(const bf16x8_t*)(brow + 32 * ks), acc);
#pragma unroll
                for (int rg = 0; rg < 4; ++rg) GR[kind * 64 * 65 + (16 * mt + 4 * g + rg) * 65 + 16 * nt + m16] = acc[rg];
            }
        }
        if ((wv & 3) == 0) {
            const int d = wv >> 2, tok = 64 * n + (d ? 63 - lane : lane);
            float gv = GB[(size_t)(d * 6 + h) * S_ + tok]; const float be = GB[(size_t)(12 + d * 6 + h) * S_ + tok];
#pragma unroll
            for (int o = 1; o < 64; o <<= 1) { const float t = __shfl_up(gv, o); if (lane >= o) gv += t; }
            const float gl = __shfl(gv, 63);
            Gs[d * 64 + lane] = gv; Bs[d * 64 + lane] = be;
            float* vec = VEC + (size_t)(u * 2 + d) * 256;
            vec[lane] = __expf(gv); vec[64 + lane] = be; vec[128 + lane] = __expf(gl - gv); vec[192 + lane] = __expf(gl);
        }
        __syncthreads();
        {
            const int d = wv >> 2, tl = tid & 255, i = tl >> 2, jq = tl & 3, ii = d ? 63 - i : i;
            const float Gi = Gs[d * 64 + i], bi = Bs[d * 64 + i];
            unsigned pk[8];
#pragma unroll
            for (int jj = 0; jj < 16; jj += 2) {
                float at[2];
#pragma unroll
                for (int e = 0; e < 2; ++e) {
                    const int j = 16 * jq + jj + e, jx = d ? 63 - j : j;
                    const float dec = (j <= i) ? __expf(Gi - Gs[d * 64 + j]) : 0.f;
                    const float kk = GR[ii * 65 + jx], qk = GR[64 * 65 + ii * 65 + jx];
                    Ms[d * 64 * 68 + i * 68 + j] = (j < i) ? bi * kk * dec : 0.f;
                    at[e] = (j <= i) ? qk * dec : 0.f;
                }
                pk[jj >> 1] = pk2(at[0], at[1]);
            }
            v4u* dst = (v4u*)(ATTN + ((size_t)(u * 2 + d) * 64 + i) * 64 + 16 * jq);
            v4u o0; o0.x = pk[0]; o0.y = pk[1]; o0.z = pk[2]; o0.w = pk[3]; v4u o1; o1.x = pk[4]; o1.y = pk[5]; o1.z = pk[6]; o1.w = pk[7];
            dst[0] = o0; dst[1] = o1;
        }
        __syncthreads();
        if ((wv & 3) == 0) {
            const int d = wv >> 2, c = lane; const float* Md = Ms + d * 64 * 68;
            float x[64];
#pragma unroll
            for (int i = 0; i < 64; ++i) {
                float s0 = (i == c) ? 1.f : 0.f, s1 = 0.f, s2 = 0.f, s3 = 0.f;
#pragma unroll
                for (int j0 = 0; j0 < i; j0 += 4) {
                    const f32x4 mv = *(const f32x4*)(Md + i * 68 + j0);
                    s0 -= mv.x * x[j0];
                    if (j0 + 1 < i) s1 -= mv.y * x[j0 + 1];
                    if (j0 + 2 < i) s2 -= mv.z * x[j0 + 2];
                    if (j0 + 3 < i) s3 -= mv.w * x[j0 + 3];
                }
                x[i] = (s0 + s1) + (s2 + s3);
            }
            bf16* outp = TINV + (size_t)(u * 2 + d) * 4096 + c;
#pragma unroll
            for (int i = 0; i < 64; ++i) outp[i * 64] = (bf16)f2bf(x[i]);
        }
    }
}

constexpr int SC_KT = 0, SC_QT = 17408, SC_TI = 34816, SC_AT = 44032, SC_VT = 53248, SC_VC = 55296, SC_BUF = 56320;
constexpr int SC_ST = 2 * SC_BUF, SC_RT = SC_ST + 4352, SC_VNT = SC_RT + 2304, SC_VST = SC_VNT + 2304, SC_END = SC_VST + 2304;
static_assert(SC_END <= 131072, "scan LDS");
__device__ __forceinline__ void ph_dn_scan(const bf16* QKVd, const bf16* TINV, const bf16* ATTN, const float* VEC, bf16* ODIR0, bf16* ODIR1, LAS unsigned char* lds, int wv) {
    const int bid = BID;
    if (bid >= 128) return;
    const int p = (bid & 7) + 8 * (bid >> 6), sl = (bid >> 3) & 7;
    if (p >= 12) return;
    const int d = p / 6, h = p % 6;
    int tid_ = wv * 64 + lane_id_(); asm volatile("" : "+v"(tid_));
    const int tid = tid_, lane = tid & 63, g = lane >> 4, m16 = lane & 15;
    bf16* ODIR = d ? ODIR1 : ODIR0;
    v4u pf[7];
#define SC_LOAD(step) do { const int n_ = d ? 255 - (step) : (step); const size_t cb_ = (size_t)((n_ * 6 + h) * 2 + d); \
        _Pragma("unroll") for (int k_ = 0; k_ < 7; ++k_) { const int q_ = tid + 512 * k_; const void* src_ = nullptr; \
            if (k_ < 4) { const int qq_ = q_ & 1023, row_ = qq_ >> 4, ch_ = qq_ & 15; const int tok_ = 64 * n_ + (d ? 63 - row_ : row_); src_ = QKVd + (size_t)tok_ * 2304 + (k_ < 2 ? 768 : 0) + h * 128 + ch_ * 8; } \
            else if (k_ < 6) { const int qq_ = q_ & 511, row_ = qq_ >> 3, ch_ = qq_ & 7; src_ = (k_ == 4 ? TINV : ATTN) + cb_ * 4096 + row_ * 64 + ch_ * 8; } \
            else { const int qq_ = q_ - 3072; if (qq_ < 128) { const int row_ = qq_ >> 1, ch_ = qq_ & 1; const int tok_ = 64 * n_ + (d ? 63 - row_ : row_); src_ = QKVd + (size_t)tok_ * 2304 + 1536 + h * 128 + sl * 16 + ch_ * 8; } \
                   else if (qq_ < 192) src_ = VEC + cb_ * 256 + (qq_ - 128) * 4; } \
            if (src_) pf[k_] = *(const v4u*)src_; } } while (0)
#define SC_WRITE(bufsel) do { LAS unsigned char* bb_ = lds + (bufsel) * SC_BUF; \
        _Pragma("unroll") for (int k_ = 0; k_ < 7; ++k_) { const int q_ = tid + 512 * k_; int off_ = -1; \
            if (k_ < 4) { const int qq_ = q_ & 1023, row_ = qq_ >> 4, ch_ = qq_ & 15; off_ = (k_ < 2 ? SC_KT : SC_QT) + row_ * 272 + ch_ * 16; } \
            else if (k_ < 6) { const int qq_ = q_ & 511, row_ = qq_ >> 3, ch_ = qq_ & 7; off_ = (k_ == 4 ? SC_TI : SC_AT) + row_ * 144 + ch_ * 16; } \
            else { const int qq_ = q_ - 3072; if (qq_ < 128) off_ = SC_VT + qq_ * 16; else if (qq_ < 192) off_ = SC_VC + (qq_ - 128) * 16; } \
            if (off_ >= 0) *(LAS v4u*)(bb_ + off_) = pf[k_]; } } while (0)
    f32x4 Sreg = {0.f, 0.f, 0.f, 0.f};
    for (int e = tid; e < 4352 / 4; e += NTHREADS) ((LAS unsigned*)(lds + SC_ST))[e] = 0u;
    SC_LOAD(0); SC_WRITE(0);
    __syncthreads();
#pragma unroll 1
    for (int s = 0; s < 256; ++s) {
        const int cur = s & 1, n = d ? 255 - s : s;
        LAS unsigned char* B = lds + cur * SC_BUF;
        if (s + 1 < 256) SC_LOAD(s + 1);
        const LAS float* VC = (const LAS float*)(B + SC_VC);
        bf16x8_t sb[4];
#pragma unroll
        for (int ks = 0; ks < 4; ++ks) sb[ks] = *(const LAS bf16x8_t*)(lds + SC_ST + m16 * 272 + (32 * ks + 8 * g) * 2);
        const int t4 = wv & 3;
        f32x4 acc1 = {0.f, 0.f, 0.f, 0.f};
        {
            const LAS unsigned char* ap = B + (wv < 4 ? SC_KT : SC_QT) + (16 * t4 + m16) * 272 + 16 * g;
#pragma unroll
            for (int ks = 0; ks < 4; ++ks) acc1 = MFMA16(*(const LAS bf16x8_t*)(ap + 64 * ks), sb[ks], acc1);
        }
        const f32x4 eG4 = *(const LAS f32x4*)(VC + 16 * t4 + 4 * g);
        if (wv < 4) {
            const f32x4 be4 = *(const LAS f32x4*)(VC + 64 + 16 * t4 + 4 * g);
            float r[4];
#pragma unroll
            for (int rg = 0; rg < 4; ++rg) { const float vv = bf2f(*(const LAS unsigned short*)(B + SC_VT + (16 * t4 + 4 * g + rg) * 32 + m16 * 2)); r[rg] = be4[rg] * (vv - eG4[rg] * acc1[rg]); }
            v2u w; w.x = pk2(r[0], r[1]); w.y = pk2(r[2], r[3]);
            *(LAS v2u*)(lds + SC_RT + m16 * 144 + (16 * t4 + 4 * g) * 2) = w;
        } else {
#pragma unroll
            for (int rg = 0; rg < 4; ++rg) acc1[rg] *= eG4[rg];
        }
        __syncthreads();
        if (wv < 4) {
            const LAS unsigned char* ap = B + SC_TI + (16 * t4 + m16) * 144 + 16 * g;
            f32x4 vn = {0.f, 0.f, 0.f, 0.f};
#pragma unroll
            for (int ks = 0; ks < 2; ++ks) vn = MFMA16(*(const LAS bf16x8_t*)(ap + 64 * ks), *(const LAS bf16x8_t*)(lds + SC_RT + m16 * 144 + (32 * ks + 8 * g) * 2), vn);
            const f32x4 eL4 = *(const LAS f32x4*)(VC + 128 + 16 * t4 + 4 * g);
            v2u w; w.x = pk2(vn[0], vn[1]); w.y = pk2(vn[2], vn[3]);
            *(LAS v2u*)(lds + SC_VNT + m16 * 144 + (16 * t4 + 4 * g) * 2) = w;
            v2u w2; w2.x = pk2(vn[0] * eL4[0], vn[1] * eL4[1]); w2.y = pk2(vn[2] * eL4[2], vn[3] * eL4[3]);
            *(LAS v2u*)(lds + SC_VST + m16 * 144 + (16 * t4 + 4 * g) * 2) = w2;
        }
        __syncthreads();
        {
            f32x4 acc3 = {0.f, 0.f, 0.f, 0.f};
#pragma unroll
            for (int ks = 0; ks < 2; ++ks) {
                const LAS unsigned char* tp = B + SC_KT + (32 * ks + 8 * g + (m16 >> 2)) * 272 + (16 * wv + 4 * (m16 & 3)) * 2;
                const s16x4_t lo = __builtin_amdgcn_ds_read_tr16_b64_v4i16((LAS s16x4_t*)tp);
                const s16x4_t hi = __builtin_amdgcn_ds_read_tr16_b64_v4i16((LAS s16x4_t*)(tp + 4 * 272));
                const bf16x8_t a = {lo[0], lo[1], lo[2], lo[3], hi[0], hi[1], hi[2], hi[3]};
                acc3 = MFMA16(a, *(const LAS bf16x8_t*)(lds + SC_VST + m16 * 144 + (32 * ks + 8 * g) * 2), acc3);
            }
            const float gl = VC[192];
#pragma unroll
            for (int rg = 0; rg < 4; ++rg) Sreg[rg] = gl * Sreg[rg] + acc3[rg];
            v2u w; w.x = pk2(Sreg[0], Sreg[1]); w.y = pk2(Sreg[2], Sreg[3]);
            *(LAS v2u*)(lds + SC_ST + m16 * 272 + (16 * wv + 4 * g) * 2) = w;
        }
        if (wv >= 4) {
            const LAS unsigned char* ap = B + SC_AT + (16 * t4 + m16) * 144 + 16 * g;
#pragma unroll
            for (int ks = 0; ks < 2; ++ks) acc1 = MFMA16(*(const LAS bf16x8_t*)(ap + 64 * ks), *(const LAS bf16x8_t*)(lds + SC_VNT + m16 * 144 + (32 * ks + 8 * g) * 2), acc1);
#pragma unroll
            for (int rg = 0; rg < 4; ++rg) { const int i = 16 * t4 + 4 * g + rg, tok = 64 * n + (d ? 63 - i : i);
                ODIR[(size_t)tok * 768 + h * 128 + sl * 16 + m16] = (bf16)f2bf(acc1[rg]); }
        }
        if (s + 1 < 256) SC_WRITE(cur ^ 1);
        __syncthreads();
    }
#undef SC_LOAD
#undef SC_WRITE
}
constexpr int AT_PITCH = 144, AT_K = 0, AT_V = 192 * AT_PITCH, AT_GRP = 2 * 192 * AT_PITCH;
__device__ __forceinline__ void ph_attn(const bf16* PA, const float* rope, bf16* OG, float* LSE, LAS unsigned char* lds, int wv) {
    int tid_ = wv * 64 + lane_id_(); asm volatile("" : "+v"(tid_));
    const int tid = tid_, lane = tid & 63, g = lane >> 4, m16 = lane & 15, grp = wv >> 2, wq = wv & 3, tg = tid & 255;
    LAS unsigned char* Kl = lds + grp * AT_GRP + AT_K; LAS unsigned char* Vl = lds + grp * AT_GRP + AT_V;
#pragma unroll 1
    for (int pi = BID; pi < 1536; pi += GSZ) {
        const int u = 2 * pi + grp;
        const int hg = u & 3, w = (u >> 2) & 255, gi = u >> 10;
        const int dil = 1 << (2 * gi), L = S_ / dil, r = w & (dil - 1), nb = w >> (2 * gi), head = gi * 4 + hg;
#pragma unroll
        for (int k = 0; k < 3; ++k) {
            const int item = tg + 256 * k, row = item >> 2, c = item & 3, mm = nb * 64 - 64 + row;
            v4u o0 = {0u, 0u, 0u, 0u}, o1 = {0u, 0u, 0u, 0u};
            if (mm >= 0 && mm < L) {
                const int tok = mm * dil + r;
                const bf16* kp = PA + (size_t)tok * 2304 + 768 + head * 64 + 8 * c;
                const v4u x0 = *(const v4u*)kp, x1 = *(const v4u*)(kp + 32);
                const f32x4* cp = (const f32x4*)(rope + (size_t)tok * 32 + 8 * c); const f32x4* sp = (const f32x4*)(rope + (size_t)S_ * 32 + (size_t)tok * 32 + 8 * c);
                const f32x4 c0 = cp[0], c1 = cp[1], s0 = sp[0], s1 = sp[1];
                const float cs[8] = {c0.x, c0.y, c0.z, c0.w, c1.x, c1.y, c1.z, c1.w}, sn[8] = {s0.x, s0.y, s0.z, s0.w, s1.x, s1.y, s1.z, s1.w};
                const unsigned xa[4] = {x0.x, x0.y, x0.z, x0.w}, xb[4] = {x1.x, x1.y, x1.z, x1.w};
                unsigned ra[4], rb[4];
#pragma unroll
                for (int e = 0; e < 4; ++e) {
                    const float a0 = bflo(xa[e]), a1 = bfhi(xa[e]), b0 = bflo(xb[e]), b1 = bfhi(xb[e]);
                    ra[e] = pk2(a0 * cs[2 * e] - b0 * sn[2 * e], a1 * cs[2 * e + 1] - b1 * sn[2 * e + 1]);
                    rb[e] = pk2(b0 * cs[2 * e] + a0 * sn[2 * e], b1 * cs[2 * e + 1] + a1 * sn[2 * e + 1]);
                }
                o0.x = ra[0]; o0.y = ra[1]; o0.z = ra[2]; o0.w = ra[3]; o1.x = rb[0]; o1.y = rb[1]; o1.z = rb[2]; o1.w = rb[3];
            }
            *(LAS v4u*)(Kl + row * AT_PITCH + 16 * c) = o0; *(LAS v4u*)(Kl + row * AT_PITCH + 64 + 16 * c) = o1;
        }
#pragma unroll
        for (int k = 0; k < 6; ++k) {
            const int item = tg + 256 * k, row = item >> 3, c = item & 7, mm = nb * 64 - 64 + row;
            v4u o = {0u, 0u, 0u, 0u};
            if (mm >= 0 && mm < L) o = *(const v4u*)(PA + (size_t)(mm * dil + r) * 2304 + 1536 + head * 64 + 8 * c);
            *(LAS v4u*)(Vl + row * AT_PITCH + 16 * c) = o;
        }
        bf16x8_t bq0, bq1;
        const int qi = 16 * wq + m16, qtok = (nb * 64 + qi) * dil + r;
        {
            const bf16* qp = PA + (size_t)qtok * 2304 + head * 64 + 8 * g;
            const v4u x0 = *(const v4u*)qp, x1 = *(const v4u*)(qp + 32);
            const f32x4* cp = (const f32x4*)(rope + (size_t)qtok * 32 + 8 * g); const f32x4* sp = (const f32x4*)(rope + (size_t)S_ * 32 + (size_t)qtok * 32 + 8 * g);
            const f32x4 c0 = cp[0], c1 = cp[1], s0 = sp[0], s1 = sp[1];
            const float cs[8] = {c0.x, c0.y, c0.z, c0.w, c1.x, c1.y, c1.z, c1.w}, sn[8] = {s0.x, s0.y, s0.z, s0.w, s1.x, s1.y, s1.z, s1.w};
            const unsigned xa[4] = {x0.x, x0.y, x0.z, x0.w}, xb[4] = {x1.x, x1.y, x1.z, x1.w};
            v4u ra, rb; unsigned* rap = (unsigned*)&ra; unsigned* rbp = (unsigned*)&rb; (void)rap; (void)rbp;
            unsigned ta[4], tb[4];
#pragma unroll
            for (int e = 0; e < 4; ++e) {
                const float a0 = bflo(xa[e]), a1 = bfhi(xa[e]), b0 = bflo(xb[e]), b1 = bfhi(xb[e]);
                ta[e] = pk2(0.125f * (a0 * cs[2 * e] - b0 * sn[2 * e]), 0.125f * (a1 * cs[2 * e + 1] - b1 * sn[2 * e + 1]));
                tb[e] = pk2(0.125f * (b0 * cs[2 * e] + a0 * sn[2 * e]), 0.125f * (b1 * cs[2 * e + 1] + a1 * sn[2 * e + 1]));
            }
            ra.x = ta[0]; ra.y = ta[1]; ra.z = ta[2]; ra.w = ta[3]; rb.x = tb[0]; rb.y = tb[1]; rb.z = tb[2]; rb.w = tb[3];
            bq0 = __builtin_bit_cast(bf16x8_t, ra); bq1 = __builtin_bit_cast(bf16x8_t, rb);
        }
        __syncthreads();
        f32x4 st[12];
#pragma unroll
        for (int kt = 0; kt < 12; ++kt) {
            const LAS unsigned char* ap = Kl + (16 * kt + m16) * AT_PITCH + 16 * g;
            f32x4 z = {0.f, 0.f, 0.f, 0.f};
            z = MFMA16(*(const LAS bf16x8_t*)ap, bq0, z);
            st[kt] = MFMA16(*(const LAS bf16x8_t*)(ap + 64), bq1, z);
        }
        float mx = -1e30f;
#pragma unroll
        for (int kt = 0; kt < 12; ++kt)
#pragma unroll
            for (int rg = 0; rg < 4; ++rg) { const int j = 16 * kt + 4 * g + rg, dj = j - qi, mm = nb * 64 - 64 + j;
                const bool ok = (dj >= 0) && (dj <= 128) && (mm >= 0) && (mm < L);
                st[kt][rg] = ok ? st[kt][rg] : -1e30f; mx = fmaxf(mx, st[kt][rg]); }
        mx = fmaxf(mx, __shfl_xor(mx, 16)); mx = fmaxf(mx, __shfl_xor(mx, 32));
        float sum = 0.f;
#pragma unroll
        for (int kt = 0; kt < 12; ++kt)
#pragma unroll
            for (int rg = 0; rg < 4; ++rg) { const float p = __expf(st[kt][rg] - mx); st[kt][rg] = p; sum += p; }
        sum += __shfl_xor(sum, 16); sum += __shfl_xor(sum, 32);
        f32x4 o[4];
#pragma unroll
        for (int dt = 0; dt < 4; ++dt) o[dt] = (f32x4){0.f, 0.f, 0.f, 0.f};
#pragma unroll
        for (int kk = 0; kk < 6; ++kk) {
            v4u pb; pb.x = pk2(st[2 * kk][0], st[2 * kk][1]); pb.y = pk2(st[2 * kk][2], st[2 * kk][3]); pb.z = pk2(st[2 * kk + 1][0], st[2 * kk + 1][1]); pb.w = pk2(st[2 * kk + 1][2], st[2 * kk + 1][3]);
            const bf16x8_t b = __builtin_bit_cast(bf16x8_t, pb);
#pragma unroll
            for (int dt = 0; dt < 4; ++dt) {
                const LAS unsigned char* tp = Vl + (32 * kk + 4 * g + (m16 >> 2)) * AT_PITCH + (16 * dt + 4 * (m16 & 3)) * 2;
                const s16x4_t lo = __builtin_amdgcn_ds_read_tr16_b64_v4i16((LAS s16x4_t*)tp);
                const s16x4_t hi = __builtin_amdgcn_ds_read_tr16_b64_v4i16((LAS s16x4_t*)(tp + 16 * AT_PITCH));
                const bf16x8_t a = {lo[0], lo[1], lo[2], lo[3], hi[0], hi[1], hi[2], hi[3]};
                o[dt] = MFMA16(a, b, o[dt]);
            }
        }
        const float il = 1.0f / sum;
        bf16* op = OG + ((size_t)gi * S_ + qtok) * 256 + hg * 64 + 4 * g;
#pragma unroll
        for (int dt = 0; dt < 4; ++dt) { v2u wv2; wv2.x = pk2(o[dt][0] * il, o[dt][1] * il); wv2.y = pk2(o[dt][2] * il, o[dt][3] * il); *(v2u*)(op + 16 * dt) = wv2; }
        if (g == 0) LSE[((size_t)gi * S_ + qtok) * 4 + hg] = mx + logf(sum);
        __syncthreads();
    }
}
constexpr int LDS_RING = 131072, LDS_CTL_OFF = LDS_RING, LDS_BYTES = 147456;
constexpr int CW_BAR = 4096;
#ifndef PROBE_ID
#define PROBE_ID (-1)
#endif
__device__ __forceinline__ unsigned char* wsp() { return PWS; }
template <class Epi> __device__ __forceinline__ void run_gemm(LAS unsigned char* lds, const bf16* A, const bf16* Bt, int N, int K, const Epi& E, int wv) {
    pg8::Gemm g{A, Bt, S_, N, K, 0};
    pg8::StaticOrder S; S.init(S_, N, GSZ, BID);
    pg8::gemm_phase<Epi, pg8::StaticOrder, true, true>(lds, g, S, E, wv);
}
#define GRID_BAR() do { XcdBarrier b_; b_.bar = (unsigned*)(wsp() + WS_CTL) + CW_BAR; b_.st = (volatile LAS unsigned*)(lds + LDS_CTL_OFF + 320) + 8; b_.x = b_.st[2]; xcd_barrier(b_, wv); } while (0)
#define PHASE(id, ...) do { { __VA_ARGS__ } if (PROBE_ID == (id)) { GRID_BAR(); { __VA_ARGS__ } } } while (0)
#define WS_R_PTRS unsigned char* ws = wsp(); unsigned char* R = ws + WS_R; (void)R;

template <int l, int f> __device__ __forceinline__ void ffn_block(LAS unsigned char* lds, unsigned char* lds_raw, int wv) {
    constexpr int s = f * 2;
    PHASE(1, WS_R_PTRS
        pg8::EpiSwiglu E; E.O = (bf16*)(R + R_ACT); E.ldc = FF_; E.pad_ = 0; run_gemm(lds, (const bf16*)(ws + WS_H), (const bf16*)(ws + WS_W + (f ? W_FFIN1 : W_FFIN0)), 2 * FF_, 1024, E, wv); );
    GRID_BAR();
    PHASE(2, WS_R_PTRS
        pg8::EpiF32 E; E.O = (float*)(R + R_Y); E.ldc = 1024; E.pad_ = 0; run_gemm(lds, (const bf16*)(R + R_ACT), (const bf16*)(ws + WS_W + (f ? W_FFOUT1 : W_FFOUT0)), 1024, FF_, E, wv); );
    GRID_BAR();
    {   WS_R_PTRS const float* MOD = (const float*)(ws + WS_MOD); const float* mod = MOD + l * 9216;
        RowArgs a; a.xi = (l == 0 && f == 0) ? PIN(0) : POUT; a.y = (const float*)(R + R_Y); a.xo = POUT; a.wpost = PIN(6) + (l * 3 + s) * 1024; a.gate = mod + (s * 3 + 2) * 1024; a.coef = 0.5f;
        if (f == 0) { a.h = (bf16*)(ws + WS_H); a.wpre = PIN(5) + (l * 3 + 1) * 1024; a.shift = mod + (1 * 3 + 0) * 1024; a.scale = mod + (1 * 3 + 1) * 1024; }
        else if (l == 0) { a.h = (bf16*)(ws + WS_H); a.wpre = PIN(5) + (1 * 3 + 0) * 1024; a.shift = MOD + 9216; a.scale = MOD + 9216 + 1024; }
        else { a.h = nullptr; a.wpre = nullptr; a.shift = nullptr; a.scale = nullptr; }
        ph_rows(a, wv);
        if (f == 1 && l == 0) ph_convert(1, lds_raw, wv); }
    GRID_BAR();
}
template <int l> __device__ __forceinline__ void mixer_block(LAS unsigned char* lds, unsigned char* lds_raw, int wv) {
    PHASE(3, WS_R_PTRS
        pg8::EpiInProj E; E.PA = (bf16*)(R + R_PA); E.PD = (bf16*)(R + R_PD); E.PZ = (bf16*)(R + R_PZ); E.AB = (float*)(R + R_AB);
        run_gemm(lds, (const bf16*)(ws + WS_H), (const bf16*)(ws + WS_W + W_IN), 5632, 1024, E, wv); );
    GRID_BAR();
    PHASE(4, WS_R_PTRS
        ph_attn((const bf16*)(R + R_PA), (const float*)(ws + WS_ROPE), (bf16*)(R + R_OG), (float*)(R + R_LSE), lds, wv); );
    GRID_BAR();
    PHASE(5, WS_R_PTRS
        ph_dnprep((const bf16*)(R + R_PD), (const float*)(R + R_AB), PIN(10) + (size_t)l * 5 * 2304, PIN(11) + l * 12, PIN(12) + l * 12, (bf16*)(R + R_QKVD), (float*)(R + R_GB),
                  (const bf16*)(R + R_OG), (const float*)(R + R_LSE), (bf16*)(R + R_OATT), wv); );
    GRID_BAR();
    PHASE(6, WS_R_PTRS
        ph_dn_pre((const bf16*)(R + R_QKVD), (const float*)(R + R_GB), (bf16*)(R + R_TINV), (bf16*)(R + R_ATTN), (float*)(R + R_VEC), lds_raw, wv); );
    GRID_BAR();
    PHASE(7, WS_R_PTRS
        ph_dn_scan((const bf16*)(R + R_QKVD), (const bf16*)(R + R_TINV), (const bf16*)(R + R_ATTN), (const float*)(R + R_VEC), (bf16*)(R + R_ODIR0), (bf16*)(R + R_ODIR1), lds, wv); );
    GRID_BAR();
    PHASE(8, WS_R_PTRS
        pg8::EpiBf16P E; E.O = (bf16*)(R + R_PG); E.ldc = 2048; E.pad_ = 0;
        run_gemm(lds, (const bf16*)(ws + WS_H), (const bf16*)(ws + WS_W + W_IN) + (size_t)5632 * 1024, 2048, 1024, E, wv); );
    PHASE(9, WS_R_PTRS
        ph_final((const bf16*)(R + R_ODIR0), (const bf16*)(R + R_ODIR1), (const bf16*)(R + R_PZ), PIN(13) + l * 128, (bf16*)(R + R_ODN), wv); );
    GRID_BAR();
    PHASE(10, { WS_R_PTRS
        pg8::EpiGateF32 E; E.O = (float*)(R + R_T1); E.gate = (const bf16*)(R + R_PG); E.ldg = 2048; E.pad_ = 0;
        run_gemm(lds, (const bf16*)(R + R_OATT), (const bf16*)(ws + WS_W + W_BATT), 1024, 256, E, wv); }
        { WS_R_PTRS
        pg8::EpiGateAddBf16 E; E.O = (bf16*)(ws + WS_H); E.T1 = (const float*)(R + R_T1); E.gate = (const bf16*)(R + R_PG) + 1024; E.ldg = 2048; E.pad_ = 0;
        run_gemm(lds, (const bf16*)(R + R_ODN), (const bf16*)(ws + WS_W + W_BDN), 1024, 768, E, wv); } );
    GRID_BAR();
    PHASE(11, WS_R_PTRS
        pg8::EpiF32 E; E.O = (float*)(R + R_Y2); E.ldc = 1024; E.pad_ = 0; run_gemm(lds, (const bf16*)(ws + WS_H), (const bf16*)(ws + WS_W + W_OUT), 1024, 1024, E, wv); );
    GRID_BAR();
    {   WS_R_PTRS const float* mod = (const float*)(ws + WS_MOD) + l * 9216;
        RowArgs a; a.xi = POUT; a.y = (const float*)(R + R_Y2); a.xo = POUT; a.h = (bf16*)(ws + WS_H); a.wpost = PIN(6) + (l * 3 + 1) * 1024; a.gate = mod + (1 * 3 + 2) * 1024; a.coef = 1.0f;
        a.wpre = PIN(5) + (l * 3 + 2) * 1024; a.shift = mod + (2 * 3 + 0) * 1024; a.scale = mod + (2 * 3 + 1) * 1024; ph_rows(a, wv); }
    GRID_BAR();
}
__global__ void __launch_bounds__(NTHREADS, 2) mega_fwd(Params P) {
    extern __shared__ __attribute__((aligned(16))) unsigned char lds_raw[];
    LAS unsigned char* lds = (LAS unsigned char*)lds_raw;
    const int wv = __builtin_amdgcn_readfirstlane((int)threadIdx.x >> 6);
    { const int tid0 = threadIdx.x;
      for (int u = tid0; u < (LDS_BYTES - LDS_CTL_OFF) / 4; u += NTHREADS) ((LAS unsigned*)(lds + LDS_CTL_OFF))[u] = 0u;
      __syncthreads();
      XcdBarrier b0 = xcd_barrier_post((unsigned*)(PWS + WS_CTL) + CW_BAR, (volatile LAS unsigned*)(lds + LDS_CTL_OFF + 320) + 8);
      if (tid0 == 0) ((volatile LAS unsigned*)(lds + LDS_CTL_OFF + 320))[10] = b0.x;
      __syncthreads(); }
    PHASE(0, ph_ada(lds_raw, wv); ph_rope(wv); ph_convert(0, lds_raw, wv); );
    GRID_BAR();
    PHASE(12, WS_R_PTRS float* MOD = (float*)(ws + WS_MOD);
      RowArgs a; a.xi = PIN(0); a.y = nullptr; a.xo = nullptr; a.h = (bf16*)(ws + WS_H); a.wpost = nullptr; a.gate = nullptr; a.wpre = PIN(5); a.shift = MOD; a.scale = MOD + 1024; a.coef = 0.f; ph_rows(a, wv); );
    GRID_BAR();
    ffn_block<0, 0>(lds, lds_raw, wv); mixer_block<0>(lds, lds_raw, wv); ffn_block<0, 1>(lds, lds_raw, wv);
    ffn_block<1, 0>(lds, lds_raw, wv); mixer_block<1>(lds, lds_raw, wv); ffn_block<1, 1>(lds, lds_raw, wv);
}

extern "C" void kernel_launch(void* const* d_in, const int* in_sizes, int n_in, void* d_out, int out_size, void* d_ws, size_t ws_size, hipStream_t stream) {
    static int grid = 0;
    if (grid == 0) {
        if (n_in != 17 || ws_size < WS_END) { fprintf(stderr, "kernel_launch: unexpected n_in %d / ws_size %zu\n", n_in, ws_size); grid = -1; return; }
        int dev = 0, cus = 0, per_cu = 0;
        if (hipGetDevice(&dev) != hipSuccess || hipDeviceGetAttribute(&cus, hipDeviceAttributeMultiprocessorCount, dev) != hipSuccess) { grid = -1; return; }
        if (hipFuncSetAttribute((const void*)mega_fwd, hipFuncAttributeMaxDynamicSharedMemorySize, LDS_BYTES) != hipSuccess) { fprintf(stderr, "kernel_launch: hipFuncSetAttribute failed\n"); grid = -1; return; }
        if (hipOccupancyMaxActiveBlocksPerMultiprocessor(&per_cu, (const void*)mega_fwd, NTHREADS, LDS_BYTES) != hipSuccess || per_cu < 1) { fprintf(stderr, "kernel_launch: occupancy query says %d\n", per_cu); per_cu = 1; }
        (void)hipGetLastError();
        grid = cus;
        if (grid > 256) grid = 256;
    }
    if (grid < 0) return;
    (void)hipMemsetAsync((char*)d_ws + WS_CTL, 0, 1 * MiB, stream);
    Params p{};
    for (int i = 0; i < 17; ++i) p.in[i] = (const float*)d_in[i];
    p.out = (float*)d_out; p.ws = (unsigned char*)d_ws;
    hipLaunchKernelGGL(mega_fwd, dim3(grid), dim3(NTHREADS), LDS_BYTES, stream, p);
}
```

```cpp
#include <hip/hip_runtime.h>
#include <cstdio>
#include <cstdint>
__device__ __forceinline__ int lane_id_() { int l; asm volatile("v_mbcnt_lo_u32_b32 %0, -1, 0\n\tv_mbcnt_hi_u32_b32 %0, -1, %0" : "=v"(l)); return l; }
namespace pg8 {
#define PG8_LAS __attribute__((address_space(3)))
typedef unsigned short bf16_t;
typedef short bf16x8 __attribute__((ext_vector_type(8)));
typedef float f32x4 __attribute__((ext_vector_type(4)));
typedef unsigned u32x4 __attribute__((ext_vector_type(4)));
constexpr int BM = 256, BK = 64, HALF = 128, HTB = HALF * BK * 2  , STAGE_BYTES = 8 * HTB, NXCD = 8, WGM = 8;

__host__ __device__ __forceinline__ int lds_byte(int r, int c) { const int st = (r >> 4) * 2 + (c >> 5), rr = r & 15, cc = c & 31, ob = rr * 64 + cc * 2; return st * 1024 + (ob ^ (((ob >> 9) & 1) << 5)); }
__host__ __device__ __forceinline__ void stage_rc(int b, int& R, int& C) { const int st = b / 1024, sb = b % 1024, swz = sb ^ (((sb >> 9) & 1) << 5); R = (st >> 1) * 16 + swz / 64; C = (st & 1) * 32 + (swz % 64) / 2; }
__host__ __device__ __forceinline__ int perm32(int rho) { const int n = rho >> 4, i = rho & 15; return 8 * (i >> 2) + 4 * n + (i & 3); }

struct Unit { int pm, pn; };
struct Gemm { const bf16_t* A; const bf16_t* Bt; int M, N, K, pad_; };

struct StaticOrder {
    int nM, nN, nwg, G, c;
    __host__ __device__ void init(int M, int N, int G_, int c_) { nM = M / BM; nN = N / BM; nwg = nM * nN; G = G_; c = c_; }
    __host__ __device__ bool next(int i, Unit& u) const {
        const long L = (long)i * G + c; if (L >= nwg) return false;
        int wgid = (int)L; { const int q = nwg / NXCD, r = nwg % NXCD, xcd = wgid % NXCD, off = wgid / NXCD; wgid = (xcd < r ? xcd * (q + 1) : r * (q + 1) + (xcd - r) * q) + off; }
        const int nig = WGM * nN, gid = wgid / nig, fm = gid * WGM, gsz = (nM - fm) < WGM ? (nM - fm) : WGM;
        u.pm = fm + ((wgid % nig) % gsz); u.pn = (wgid % nig) / gsz; return true;
    }
    __device__ __forceinline__ void a_ready(const Unit&) const {}
    __device__ __forceinline__ void done(const Unit&) const {}
};

__device__ __forceinline__ unsigned cvt_pk_bf16(float lo, float hi) { unsigned r; asm volatile("v_cvt_pk_bf16_f32 %0, %1, %2" : "=v"(r) : "v"(lo), "v"(hi)); return r; }
typedef float f32x2 __attribute__((ext_vector_type(2)));
__device__ __forceinline__ f32x2 gelu_pk(f32x2 v) {
    const f32x2 av = __builtin_elementwise_abs(v), d = av * 0.2316418882f + 1.0f;
    f32x2 t; t.x = __builtin_amdgcn_rcpf(d.x); t.y = __builtin_amdgcn_rcpf(d.y);
    f32x2 q = t * 0.5307027145f + (-0.7265760135f); q = q * t + 0.7107068705f; q = q * t + (-0.142248368f); q = q * t + 0.127414796f; q = q * t;
    const f32x2 s = (v * v) * (-0.72134752044f);
    f32x2 e; e.x = __builtin_amdgcn_exp2f(s.x); e.y = __builtin_amdgcn_exp2f(s.y);
    const f32x2 m = v * (q * e), r = v - m;
    f32x2 o; o.x = v.x < 0.f ? m.x : r.x; o.y = v.y < 0.f ? m.y : r.y; return o;
}

template <int ACT  > struct EpiBf16 {
    static constexpr bool PERM = true, AFTER_DRAIN = false; static_assert(ACT == 0 || ACT == 1, "EpiBf16: ACT is 0 (none) or 1 (gelu_pk)");
    bf16_t* O; int ldc; const float* bias; int split_cols; size_t split_stride; float scale0;
    __device__ __forceinline__ void operator()(const f32x4 (&acc)[2][2][4][2], const Unit& u, int wr, int wc, int fr, int fq) const {
        const int row0 = u.pm * BM + wr * 64 + fr; int colt = u.pn * BM; bf16_t* base = O;
        float sc = 1.f; if (split_cols) { const int t = colt / split_cols; base += (size_t)t * split_stride; colt -= t * split_cols; if (t == 0) sc = scale0; }
        const int col0 = colt + wc * 32 + 8 * fq, bcol0 = u.pn * BM + wc * 32 + 8 * fq;
        f32x4 bv[2][2];
#pragma unroll
        for (int bj = 0; bj < 2; ++bj)
#pragma unroll
            for (int n = 0; n < 2; ++n) bv[bj][n] = bias ? *(const f32x4*)(bias + bcol0 + bj * HALF + 4 * n) : (f32x4){0.f, 0.f, 0.f, 0.f};
#pragma unroll
        for (int ai = 0; ai < 2; ++ai)
#pragma unroll
            for (int m = 0; m < 4; ++m) { bf16_t* rowp = base + (size_t)(row0 + ai * HALF + m * 16) * ldc + col0;
#pragma unroll
                for (int bj = 0; bj < 2; ++bj) { f32x4 v0 = acc[ai][bj][m][0] + bv[bj][0], v1 = acc[ai][bj][m][1] + bv[bj][1];
                    if (ACT == 1) { f32x2 a = gelu_pk((f32x2){v0[0], v0[1]}), b = gelu_pk((f32x2){v0[2], v0[3]}), c = gelu_pk((f32x2){v1[0], v1[1]}), d = gelu_pk((f32x2){v1[2], v1[3]});
                        v0 = (f32x4){a.x, a.y, b.x, b.y}; v1 = (f32x4){c.x, c.y, d.x, d.y}; }
                    v0 = v0 * sc; v1 = v1 * sc; u32x4 w; w.x = cvt_pk_bf16(v0[0], v0[1]); w.y = cvt_pk_bf16(v0[2], v0[3]); w.z = cvt_pk_bf16(v1[0], v1[1]); w.w = cvt_pk_bf16(v1[2], v1[3]);
                    *(u32x4*)(rowp + bj * HALF) = w; } }
    }
};

struct PanelStats {
    unsigned* xbuf;
    unsigned* cnt;
    unsigned* tmo;
    int ntn; float eps;
    unsigned code;
    __device__ __forceinline__ bool run(const f32x4 (&v)[2][2][4][2], const Unit& u, int wr, int wc, int fr, int fq, PG8_LAS unsigned char* lds, int wid, int lane) const {
        typedef float f32x2v __attribute__((ext_vector_type(2)));
        PG8_LAS f32x2v* P = (PG8_LAS f32x2v*)lds;
        PG8_LAS f32x2v* S = (PG8_LAS f32x2v*)(lds + 8192);
        PG8_LAS unsigned* flag = (PG8_LAS unsigned*)(lds + 8192 + 2048);
#pragma unroll
        for (int ai = 0; ai < 2; ++ai)
#pragma unroll
            for (int m = 0; m < 4; ++m) {
                float s = 0.f;
#pragma unroll
                for (int bj = 0; bj < 2; ++bj)
#pragma unroll
                    for (int n = 0; n < 2; ++n) { const f32x4 x = v[ai][bj][m][n]; s += (x[0] + x[1]) + (x[2] + x[3]); }
                s += __shfl_xor(s, 16); s += __shfl_xor(s, 32);
                const float mw = s * (1.0f / 64.0f); float q = 0.f;
#pragma unroll
                for (int bj = 0; bj < 2; ++bj)
#pragma unroll
                    for (int n = 0; n < 2; ++n) { const f32x4 d = v[ai][bj][m][n] - mw; q += (d[0] * d[0] + d[1] * d[1]) + (d[2] * d[2] + d[3] * d[3]); }
                q += __shfl_xor(q, 16); q += __shfl_xor(q, 32);
                if (fq == 0) P[(ai * HALF + wr * 64 + m * 16 + fr) * 4 + wc] = (f32x2v){mw, q};
            }
        asm volatile("s_waitcnt lgkmcnt(0)" ::: "memory"); __builtin_amdgcn_s_barrier(); asm volatile("" ::: "memory");
#if defined(BROKEN_EXCHANGE_NO_WAIT)
#warning BROKEN CONTROL BUILD: the row-statistics exchange does not wait; results are wrong by design
        if (blockIdx.x >= 64) { const long long t0_ = clock64(); while (clock64() - t0_ < 60000) __builtin_amdgcn_s_sleep(8); }
#endif
        const int row = wid * 32 + (lane & 31);
        if (lane < 32) {
            const f32x2v a = P[row * 4 + 0], b = P[row * 4 + 1], c = P[row * 4 + 2], d = P[row * 4 + 3];
            const float mt = (a.x + b.x + c.x + d.x) * 0.25f;
            const float da = a.x - mt, db = b.x - mt, dc = c.x - mt, dd = d.x - mt;
            const float m2 = (a.y + b.y) + (c.y + d.y) + 64.0f * ((da * da + db * db) + (dc * dc + dd * dd));
            unsigned long long* slot = (unsigned long long*)xbuf + ((size_t)(u.pm * BM + row) * 4 + u.pn);
            __hip_atomic_store(slot, ((unsigned long long)__float_as_uint(m2) << 32) | __float_as_uint(mt), __ATOMIC_RELAXED, __HIP_MEMORY_SCOPE_AGENT);
        }
        asm volatile("s_waitcnt vmcnt(0)" ::: "memory");
        if (lane == 0) __hip_atomic_fetch_add(cnt + 64 * u.pm, 1u, __ATOMIC_RELAXED, __HIP_MEMORY_SCOPE_AGENT);
        if (wid == 0) {
            bool dead = false; const unsigned long long t0 = __builtin_amdgcn_s_memrealtime(); const unsigned want = 8u * (unsigned)ntn;
            for (;;) {
#if defined(BROKEN_EXCHANGE_NO_WAIT)
                break;
#endif
                if ((unsigned)__builtin_amdgcn_readfirstlane(__hip_atomic_load(cnt + 64 * u.pm, __ATOMIC_RELAXED, __HIP_MEMORY_SCOPE_AGENT)) >= want) break;
                if (__builtin_amdgcn_s_memrealtime() - t0 > 2000000ull) {
                    if (lane == 0) { unsigned expect = 0u; __hip_atomic_compare_exchange_strong(tmo + 1, &expect, code | (unsigned)(u.pm & 0xff), __ATOMIC_RELAXED, __ATOMIC_RELAXED, __HIP_MEMORY_SCOPE_AGENT);
                                     __hip_atomic_store(tmo, 1u, __ATOMIC_RELAXED, __HIP_MEMORY_SCOPE_AGENT); }
                    dead = true; break; }
                __builtin_amdgcn_s_sleep(2);
            }
            __builtin_amdgcn_fence(__ATOMIC_ACQUIRE, "agent");
            if (lane == 0) flag[0] = dead ? 1u : 0u;
        }
        asm volatile("s_waitcnt vmcnt(0) lgkmcnt(0)" ::: "memory"); __builtin_amdgcn_s_barrier(); asm volatile("" ::: "memory");
        const bool bad = flag[0] != 0u;
        if (lane < 32) {
            const unsigned long long* slot = (const unsigned long long*)xbuf + (size_t)(u.pm * BM + row) * 4; float mt[4], m2[4]; float ms = 0.f;
#pragma unroll
            for (int t = 0; t < 4; ++t) { if (t < ntn) { const unsigned long long w = __hip_atomic_load(slot + t, __ATOMIC_RELAXED, __HIP_MEMORY_SCOPE_AGENT); mt[t] = __uint_as_float((unsigned)w); m2[t] = __uint_as_float((unsigned)(w >> 32)); } else { mt[t] = 0.f; m2[t] = 0.f; } ms += mt[t]; }
            const float mean = ms / (float)ntn; float q = 0.f;
#pragma unroll
            for (int t = 0; t < 4; ++t) if (t < ntn) { const float dm = mt[t] - mean; q += m2[t] + 256.0f * dm * dm; }
            S[row] = (f32x2v){mean, 1.0f / sqrtf(q / (256.0f * (float)ntn) + eps)};
        }
        asm volatile("s_waitcnt lgkmcnt(0)" ::: "memory"); __builtin_amdgcn_s_barrier(); asm volatile("" ::: "memory");
        return bad;
    }
};
struct EpiLnRes {
    static constexpr bool PERM = false, AFTER_DRAIN = true;
    const float* base; float* out; int ldc; const float* bias; PanelStats st; unsigned poison;
    __device__ __forceinline__ void fused(f32x4 (&acc)[2][2][4][2], const Unit& u, int wr, int wc, int fr, int fq, PG8_LAS unsigned char* lds, int wid, int lane) const {
        typedef float f32x2v __attribute__((ext_vector_type(2)));
        const PG8_LAS f32x2v* S = (const PG8_LAS f32x2v*)(lds + 8192);
        const int col0 = u.pn * BM + wc * 32 + 4 * fq;
#pragma unroll
        for (int bj = 0; bj < 2; ++bj)
#pragma unroll
            for (int n = 0; n < 2; ++n) { const f32x4 bv = bias ? *(const f32x4*)(bias + col0 + bj * HALF + n * 16) : (f32x4){0.f, 0.f, 0.f, 0.f};
#pragma unroll
                for (int ai = 0; ai < 2; ++ai)
#pragma unroll
                    for (int m = 0; m < 4; ++m) acc[ai][bj][m][n] += bv; }
        f32x4 pre[4][2][2];
#pragma unroll
        for (int m = 0; m < 4; ++m) { const size_t off = (size_t)(u.pm * BM + wr * 64 + m * 16 + fr) * ldc + col0;
#pragma unroll
            for (int bj = 0; bj < 2; ++bj)
#pragma unroll
                for (int n = 0; n < 2; ++n) pre[m][bj][n] = *(const f32x4*)(base + off + bj * HALF + n * 16); }
        const bool bad = st.run(acc, u, wr, wc, fr, fq, lds, wid, lane) || poison != 0u;
        const float qnan = __builtin_nanf("");
#pragma unroll
        for (int ai = 0; ai < 2; ++ai)
#pragma unroll
            for (int m = 0; m < 4; ++m) { const int r = ai * HALF + wr * 64 + m * 16 + fr; const f32x2v sr = S[r]; const size_t off = (size_t)(u.pm * BM + r) * ldc + col0;
#pragma unroll
                for (int bj = 0; bj < 2; ++bj)
#pragma unroll
                    for (int n = 0; n < 2; ++n) { const f32x4 bs = ai == 0 ? pre[m][bj][n] : *(const f32x4*)(base + off + bj * HALF + n * 16); f32x4 o = bs + (acc[ai][bj][m][n] - sr.x) * sr.y;
                        if (bad) o = (f32x4){qnan, qnan, qnan, qnan}; *(f32x4*)(out + off + bj * HALF + n * 16) = o; }
                if (m & 1) asm volatile("" ::: "memory"); }
    }
};
struct EpiLnResLn {
    static constexpr bool PERM = false, AFTER_DRAIN = true;
    const float* base; float* out; bf16_t* xn; int ldc; const float* bias; PanelStats st1, st2; unsigned poison;
    __device__ __forceinline__ void fused(f32x4 (&acc)[2][2][4][2], const Unit& u, int wr, int wc, int fr, int fq, PG8_LAS unsigned char* lds, int wid, int lane) const {
        typedef float f32x2v __attribute__((ext_vector_type(2))); typedef unsigned u32x2v __attribute__((ext_vector_type(2)));
        const PG8_LAS f32x2v* S = (const PG8_LAS f32x2v*)(lds + 8192);
        const int col0 = u.pn * BM + wc * 32 + 4 * fq;
#pragma unroll
        for (int bj = 0; bj < 2; ++bj)
#pragma unroll
            for (int n = 0; n < 2; ++n) { const f32x4 bv = bias ? *(const f32x4*)(bias + col0 + bj * HALF + n * 16) : (f32x4){0.f, 0.f, 0.f, 0.f};
#pragma unroll
                for (int ai = 0; ai < 2; ++ai)
#pragma unroll
                    for (int m = 0; m < 4; ++m) acc[ai][bj][m][n] += bv; }
        bool bad = st1.run(acc, u, wr, wc, fr, fq, lds, wid, lane) || poison != 0u;
        const float qnan = __builtin_nanf("");
#pragma unroll
        for (int ai = 0; ai < 2; ++ai)
#pragma unroll
            for (int m = 0; m < 4; ++m) { const int r = ai * HALF + wr * 64 + m * 16 + fr; const f32x2v sr = S[r]; const size_t off = (size_t)(u.pm * BM + r) * ldc + col0;
#pragma unroll
                for (int bj = 0; bj < 2; ++bj)
#pragma unroll
                    for (int n = 0; n < 2; ++n) { const f32x4 bs = *(const f32x4*)(base + off + bj * HALF + n * 16); acc[ai][bj][m][n] = bs + (acc[ai][bj][m][n] - sr.x) * sr.y; }
                asm volatile("" : "+v"(acc[ai][0][m][0]), "+v"(acc[ai][0][m][1]), "+v"(acc[ai][1][m][0]), "+v"(acc[ai][1][m][1]));
                if (m & 1) asm volatile("" ::: "memory"); }
        const bool bad1 = bad;
        bad = st2.run(acc, u, wr, wc, fr, fq, lds, wid, lane) || bad;
#pragma unroll
        for (int ai = 0; ai < 2; ++ai)
#pragma unroll
            for (int m = 0; m < 4; ++m) { const int r = ai * HALF + wr * 64 + m * 16 + fr; const f32x2v sr = S[r]; const size_t off = (size_t)(u.pm * BM + r) * ldc + col0;
#pragma unroll
                for (int bj = 0; bj < 2; ++bj)
#pragma unroll
                    for (int n = 0; n < 2; ++n) { const f32x4 x1 = acc[ai][bj][m][n]; *(f32x4*)(out + off + bj * HALF + n * 16) = bad1 ? (f32x4){qnan, qnan, qnan, qnan} : x1;
                        const f32x4 o = (x1 - sr.x) * sr.y; u32x2v w; w.x = cvt_pk_bf16(o[0], o[1]); w.y = cvt_pk_bf16(o[2], o[3]);
                        if (bad) { w.x = 0x7fc07fc0u; w.y = 0x7fc07fc0u; } *(u32x2v*)(xn + off + bj * HALF + n * 16) = w; }
                asm volatile("" ::: "memory"); }
    }
};

template <class Epi, class Sched, bool ALIGN_EPI = false, bool SP2 = false>
__device__ __forceinline__ void gemm_phase(PG8_LAS unsigned char* lds, const Gemm g, const Sched& S, const Epi& E, int wv) {
    int tid_ = wv * 64 + lane_id_(); asm volatile("" : "+v"(tid_));
    const int tid = tid_, wid = __builtin_amdgcn_readfirstlane(tid >> 6), lane = tid & 63, wr = wid >> 2, wc = wid & 3, fr = lane & 15, fq = lane >> 4;
    const int K = g.K, nt = K / BK;
    unsigned voffA[2], voffB[2];
#pragma unroll
    for (int i = 0; i < 2; ++i) { int R, C; stage_rc(tid * 16 + i * 8192, R, C); const int Rb = Epi::PERM ? ((R & ~31) + perm32(R & 31)) : R;
        voffA[i] = (unsigned)(R * K + C) * 2u; voffB[i] = (unsigned)(Rb * K + C) * 2u; }
    const size_t kstep = (size_t)(BK * 2);
    const size_t hstep = (size_t)HALF * K * 2;
    const size_t tstep = 2 * hstep;
    const unsigned ldsw = (unsigned)wid * 1024u;
    const int aoff = lds_byte(wr * 64 + fr, fq * 8), boff = lds_byte(wc * 32 + fr, fq * 8);
#define PG8_SA(b, h) (((b) * 2 + (h)) * HTB)
#define PG8_SB(b, h) ((4 + (b) * 2 + (h)) * HTB)
#define PG8_STAGE(bufoff, gbase, voff) do { _Pragma("unroll") for (int _i = 0; _i < 2; ++_i) \
        __builtin_amdgcn_global_load_lds((const unsigned*)((const char*)(gbase) + (voff)[_i]), (PG8_LAS unsigned*)(lds + (bufoff) + ldsw + _i * 8192), 16, 0, 0); } while (0)
#define PG8_LDA(dst, b, h) do { _Pragma("unroll") for (int m = 0; m < 4; ++m) _Pragma("unroll") for (int k = 0; k < 2; ++k) dst[m][k] = *(const PG8_LAS bf16x8*)(lds + PG8_SA(b, h) + aoff + m * 2048 + k * 1024); } while (0)
#define PG8_LDB(dst, b, h) do { _Pragma("unroll") for (int n = 0; n < 2; ++n) _Pragma("unroll") for (int k = 0; k < 2; ++k) dst[n][k] = *(const PG8_LAS bf16x8*)(lds + PG8_SB(b, h) + boff + n * 2048 + k * 1024); } while (0)
#define PG8_MMA(ai, bj, At, Bt) do { __builtin_amdgcn_s_setprio(1); _Pragma("unroll") for (int m = 0; m < 4; ++m) _Pragma("unroll") for (int n = 0; n < 2; ++n) _Pragma("unroll") for (int k = 0; k < 2; ++k) \
        acc[ai][bj][m][n] = __builtin_amdgcn_mfma_f32_16x16x32_bf16(Bt[n][k], At[m][k], acc[ai][bj][m][n], 0, 0, 0); __builtin_amdgcn_s_setprio(0); } while (0)
#define PG8_WAIT_V(n) asm volatile("s_waitcnt vmcnt(" #n ")" ::: "memory")
#define PG8_WAIT_L(n) asm volatile("s_waitcnt lgkmcnt(" #n ")" ::: "memory")
#define PG8_BAR __builtin_amdgcn_s_barrier()
#define PG8_SCHED __builtin_amdgcn_sched_barrier(0)
    Unit cur, nxt; int ui = 0;
    if (!S.next(0, cur)) return;
    f32x4 acc[2][2][4][2];
#pragma unroll
    for (int a = 0; a < 2; ++a)
#pragma unroll
        for (int b = 0; b < 2; ++b)
#pragma unroll
            for (int m = 0; m < 4; ++m)
#pragma unroll
                for (int n = 0; n < 2; ++n) acc[a][b][m][n] = (f32x4){0.f, 0.f, 0.f, 0.f};
    bf16x8 At[4][2], B0[2][2], B1[2][2];
    const char* cA = (const char*)g.A + (size_t)cur.pm * tstep; const char* cB = (const char*)g.Bt + (size_t)cur.pn * tstep;
    S.a_ready(cur);
    if constexpr (SP2) {
        PG8_STAGE(PG8_SB(0, 0), cB, voffB); PG8_STAGE(PG8_SB(0, 1), cB + hstep, voffB); PG8_STAGE(PG8_SA(0, 0), cA, voffA); PG8_STAGE(PG8_SA(0, 1), cA + hstep, voffA);
        if (wr == 1) PG8_BAR;
        PG8_WAIT_V(2); PG8_BAR;
        PG8_STAGE(PG8_SB(1, 0), cB + kstep, voffB); PG8_STAGE(PG8_SA(1, 0), cA + kstep, voffA); PG8_STAGE(PG8_SB(1, 1), cB + hstep + kstep, voffB);
        PG8_WAIT_V(6); PG8_BAR;
    } else {
        PG8_STAGE(PG8_SB(0, 0), cB, voffB); PG8_STAGE(PG8_SA(0, 0), cA, voffA); PG8_STAGE(PG8_SB(0, 1), cB + hstep, voffB); PG8_STAGE(PG8_SA(0, 1), cA + hstep, voffA);
        if (wr == 1) PG8_BAR;
        PG8_WAIT_V(4); PG8_BAR;
        PG8_STAGE(PG8_SB(1, 0), cB + kstep, voffB); PG8_STAGE(PG8_SA(1, 0), cA + kstep, voffA); PG8_STAGE(PG8_SB(1, 1), cB + hstep + kstep, voffB);
        PG8_WAIT_V(6); PG8_BAR;
    }
    for (;;) {
        const bool has_next = S.next(ui + 1, nxt);
        const char* nA = has_next ? (const char*)g.A + (size_t)nxt.pm * tstep : cA; const char* nB = has_next ? (const char*)g.Bt + (size_t)nxt.pn * tstep : cB;
        for (int t = 0; t < nt; t += 2) {
            const bool last = (t == nt - 2);
            const char* a1 = cA + (size_t)(t + 1) * kstep;
            const char* a2 = last ? nA : cA + (size_t)(t + 2) * kstep; const char* b2 = last ? nB : cB + (size_t)(t + 2) * kstep;
            const char* a3 = a2 + kstep; const char* b3 = b2 + kstep;
            if (last && has_next) S.a_ready(nxt);
            if constexpr (SP2) {
            PG8_LDB(B0, 0, 0); PG8_LDB(B1, 0, 1); PG8_SCHED; PG8_LDA(At, 0, 0); PG8_STAGE(PG8_SA(1, 1), a1 + hstep, voffA);
            PG8_WAIT_V(8); PG8_WAIT_L(0); PG8_BAR; PG8_MMA(0, 0, At, B0); PG8_MMA(0, 1, At, B1); PG8_BAR; PG8_SCHED;
            PG8_LDA(At, 0, 1); PG8_STAGE(PG8_SB(0, 0), b2, voffB); PG8_STAGE(PG8_SB(0, 1), b2 + hstep, voffB); PG8_STAGE(PG8_SA(0, 0), a2, voffA);
            PG8_WAIT_V(8); PG8_WAIT_L(0); PG8_BAR; PG8_MMA(1, 0, At, B0); PG8_MMA(1, 1, At, B1); PG8_BAR; PG8_SCHED;
            PG8_LDB(B0, 1, 0); PG8_LDB(B1, 1, 1); PG8_SCHED; PG8_LDA(At, 1, 0); PG8_STAGE(PG8_SA(0, 1), a2 + hstep, voffA);
            PG8_WAIT_V(8); PG8_WAIT_L(0); PG8_BAR; PG8_MMA(0, 0, At, B0); PG8_MMA(0, 1, At, B1); PG8_BAR; PG8_SCHED;
            PG8_LDA(At, 1, 1); PG8_STAGE(PG8_SB(1, 0), b3, voffB); PG8_STAGE(PG8_SB(1, 1), b3 + hstep, voffB); PG8_STAGE(PG8_SA(1, 0), a3, voffA);
            PG8_WAIT_V(8); PG8_WAIT_L(0); PG8_BAR; PG8_MMA(1, 0, At, B0); PG8_MMA(1, 1, At, B1); PG8_BAR; PG8_SCHED;
            } else {
            PG8_LDB(B0, 0, 0); PG8_SCHED; PG8_LDA(At, 0, 0); PG8_STAGE(PG8_SA(1, 1), a1 + hstep, voffA);
            PG8_WAIT_L(8); PG8_BAR; PG8_WAIT_L(0); PG8_MMA(0, 0, At, B0); PG8_BAR; PG8_SCHED;
            PG8_LDB(B1, 0, 1); PG8_STAGE(PG8_SB(0, 0), b2, voffB);
            PG8_BAR; PG8_WAIT_L(0); PG8_MMA(0, 1, At, B1); PG8_BAR;
            PG8_LDA(At, 0, 1); PG8_STAGE(PG8_SA(0, 0), a2, voffA);
            PG8_BAR; PG8_WAIT_L(0); PG8_MMA(1, 0, At, B0); PG8_BAR; PG8_SCHED;
            PG8_STAGE(PG8_SB(0, 1), b2 + hstep, voffB);
            PG8_WAIT_V(6); PG8_BAR; PG8_MMA(1, 1, At, B1); PG8_BAR;
            PG8_LDB(B0, 1, 0); PG8_SCHED; PG8_LDA(At, 1, 0); PG8_STAGE(PG8_SA(0, 1), a2 + hstep, voffA);
            PG8_WAIT_L(8); PG8_BAR; PG8_WAIT_L(0); PG8_MMA(0, 0, At, B0); PG8_BAR; PG8_SCHED;
            PG8_LDB(B1, 1, 1); PG8_STAGE(PG8_SB(1, 0), b3, voffB);
            PG8_BAR; PG8_WAIT_L(0); PG8_MMA(0, 1, At, B1); PG8_BAR;
            PG8_LDA(At, 1, 1); PG8_STAGE(PG8_SA(1, 0), a3, voffA);
            PG8_BAR; PG8_WAIT_L(0); PG8_MMA(1, 0, At, B0); PG8_BAR; PG8_SCHED;
            PG8_STAGE(PG8_SB(1, 1), b3 + hstep, voffB);
            PG8_WAIT_V(6); PG8_BAR; PG8_MMA(1, 1, At, B1); PG8_BAR;
            }
        }
        if constexpr (ALIGN_EPI) { if (wr == 0) PG8_BAR; }
        if constexpr (!Epi::AFTER_DRAIN) { E(acc, cur, wr, wc, fr, fq); S.done(cur); }
        if (!has_next) break;
#pragma unroll
        for (int a = 0; a < 2; ++a)
#pragma unroll
            for (int b = 0; b < 2; ++b)
#pragma unroll
                for (int m = 0; m < 4; ++m)
#pragma unroll
                    for (int n = 0; n < 2; ++n) acc[a][b][m][n] = (f32x4){0.f, 0.f, 0.f, 0.f};
        cur = nxt; cA = nA; cB = nB; ++ui;
        if constexpr (ALIGN_EPI) { if (wr == 1) PG8_BAR; }
    }
    PG8_WAIT_V(0);
    if constexpr (!ALIGN_EPI) { if (wr == 0) PG8_BAR; }
    PG8_BAR;
    if constexpr (Epi::AFTER_DRAIN) { E.fused(acc, cur, wr, wc, fr, fq, lds, wid, lane); S.done(cur); }
#undef PG8_SA
#undef PG8_SB
#undef PG8_STAGE
#undef PG8_LDA
#undef PG8_LDB
#undef PG8_MMA
#undef PG8_WAIT_V
#undef PG8_WAIT_L
#undef PG8_BAR
#undef PG8_SCHED
}
}
constexpr int S_ = 16384, D_ = 1024, FF_ = 2816, NIN_ = 7448, NINP_ = 7680;
constexpr int NTHREADS = 512;
constexpr size_t MiB = 1u << 20;
constexpr size_t WS_CTL = 0;
constexpr size_t WS_MOD = 1 * MiB;
constexpr size_t WS_ROPE = 2 * MiB;
constexpr size_t WS_W = 6 * MiB;
constexpr size_t W_FFIN0 = 0, W_FFIN1 = 11 * MiB, W_FFOUT0 = 22 * MiB, W_FFOUT1 = 27 * MiB + MiB / 2, W_IN = 33 * MiB, W_BATT = 48 * MiB, W_BDN = 48 * MiB + MiB / 2, W_OUT = 50 * MiB;
constexpr size_t WS_H = 58 * MiB;
constexpr size_t WS_R = 90 * MiB;
constexpr size_t R_ACT = 0, R_Y = 88 * MiB;
constexpr size_t R_PA = 0, R_QKVD = 0, R_PG = 0, R_PD = 72 * MiB, R_TINV = 72 * MiB, R_ODIR1 = 120 * MiB, R_ODN = 72 * MiB, R_T1 = 96 * MiB, R_PZ = 144 * MiB, R_AB = 168 * MiB, R_GB = 170 * MiB,
                 R_OATT = 172 * MiB, R_ATTN = 180 * MiB, R_Y2 = 160 * MiB, R_OG = 228 * MiB, R_LSE = 252 * MiB, R_ODIR0 = 228 * MiB, R_VEC = 253 * MiB;
constexpr size_t WS_END = 352 * MiB;

typedef unsigned short bf16;
typedef unsigned v4u __attribute__((ext_vector_type(4)));
typedef unsigned v2u __attribute__((ext_vector_type(2)));
typedef float f32x4 __attribute__((ext_vector_type(4)));
typedef float f32x2 __attribute__((ext_vector_type(2)));
#define LAS __attribute__((address_space(3)))

__device__ __forceinline__ unsigned f2bf(float f) { unsigned u = __builtin_bit_cast(unsigned, f); return (u + 0x7fffu + ((u >> 16) & 1u)) >> 16; }
__device__ __forceinline__ unsigned pk2(float lo, float hi) { return f2bf(lo) | (f2bf(hi) << 16); }
__device__ __forceinline__ float bf2f(unsigned short b) { return __builtin_bit_cast(float, (unsigned)b << 16); }
__device__ __forceinline__ float bflo(unsigned w) { return __builtin_bit_cast(float, w << 16); }
__device__ __forceinline__ float bfhi(unsigned w) { return __builtin_bit_cast(float, w & 0xffff0000u); }
__device__ __forceinline__ float wave_sum(float v) {
#pragma unroll
    for (int o = 1; o < 64; o <<= 1) v += __shfl_xor(v, o);
    return v;
}
__device__ __forceinline__ float sigmoidf_(float x) { return 1.0f / (1.0f + __expf(-x)); }
__device__ __forceinline__ float siluf_(float x) { return x / (1.0f + __expf(-x)); }

namespace pg8 {
struct EpiSwiglu {
    static constexpr bool PERM = true, AFTER_DRAIN = false;
    bf16_t* O; int ldc; int pad_;
    __device__ __forceinline__ void operator()(const f32x4 (&acc)[2][2][4][2], const Unit& u, int wr, int wc, int fr, int fq) const {
        const int row0 = u.pm * BM + wr * 64 + fr, col0 = u.pn * 128 + wc * 32 + 8 * fq;
#pragma unroll
        for (int ai = 0; ai < 2; ++ai)
#pragma unroll
            for (int m = 0; m < 4; ++m) {
                bf16_t* rowp = O + (size_t)(row0 + ai * HALF + m * 16) * ldc + col0;
                float v[8];
#pragma unroll
                for (int n = 0; n < 2; ++n)
#pragma unroll
                    for (int e = 0; e < 4; ++e) { const float g = acc[ai][0][m][n][e], uu = acc[ai][1][m][n][e]; v[n * 4 + e] = g * __builtin_amdgcn_rcpf(1.0f + __expf(-g)) * uu; }
                u32x4 w; w.x = cvt_pk_bf16(v[0], v[1]); w.y = cvt_pk_bf16(v[2], v[3]); w.z = cvt_pk_bf16(v[4], v[5]); w.w = cvt_pk_bf16(v[6], v[7]);
                *(u32x4*)rowp = w;
            }
    }
};
struct EpiBf16P {
    static constexpr bool PERM = true, AFTER_DRAIN = false;
    bf16_t* O; int ldc; int pad_;
    __device__ __forceinline__ void operator()(const f32x4 (&acc)[2][2][4][2], const Unit& u, int wr, int wc, int fr, int fq) const {
        const int row0 = u.pm * BM + wr * 64 + fr, col0 = u.pn * BM + wc * 32 + 8 * fq;
#pragma unroll
        for (int ai = 0; ai < 2; ++ai)
#pragma unroll
            for (int m = 0; m < 4; ++m) {
                bf16_t* rowp = O + (size_t)(row0 + ai * HALF + m * 16) * ldc + col0;
#pragma unroll
                for (int bj = 0; bj < 2; ++bj) { const f32x4 v0 = acc[ai][bj][m][0], v1 = acc[ai][bj][m][1];
                    u32x4 w; w.x = cvt_pk_bf16(v0[0], v0[1]); w.y = cvt_pk_bf16(v0[2], v0[3]); w.z = cvt_pk_bf16(v1[0], v1[1]); w.w = cvt_pk_bf16(v1[2], v1[3]);
                    *(u32x4*)(rowp + bj * HALF) = w; }
            }
    }
};
struct EpiF32 {
    static constexpr bool PERM = false, AFTER_DRAIN = false;
    float* O; int ldc; int pad_;
    __device__ __forceinline__ void operator()(const f32x4 (&acc)[2][2][4][2], const Unit& u, int wr, int wc, int fr, int fq) const {
        const int row0 = u.pm * BM + wr * 64 + fr, col0 = u.pn * BM + wc * 32 + 4 * fq;
#pragma unroll
        for (int ai = 0; ai < 2; ++ai)
#pragma unroll
            for (int m = 0; m < 4; ++m) {
                float* rowp = O + (size_t)(row0 + ai * HALF + m * 16) * ldc + col0;
#pragma unroll
                for (int bj = 0; bj < 2; ++bj)
#pragma unroll
                    for (int n = 0; n < 2; ++n) *(f32x4*)(rowp + bj * HALF + n * 16) = acc[ai][bj][m][n];
            }
    }
};
struct EpiInProj {
    static constexpr bool PERM = true, AFTER_DRAIN = false;
    bf16_t* PA; bf16_t* PD; bf16_t* PZ; float* AB;
    __device__ __forceinline__ void operator()(const f32x4 (&acc)[2][2][4][2], const Unit& u, int wr, int wc, int fr, int fq) const {
        const int row0 = u.pm * BM + wr * 64 + fr;
        if (u.pn == 21) {
            if (wc == 0) {
#pragma unroll
                for (int ai = 0; ai < 2; ++ai)
#pragma unroll
                    for (int m = 0; m < 4; ++m) {
                        float* rowp = AB + (size_t)(row0 + ai * HALF + m * 16) * 32 + 8 * fq;
                        *(f32x4*)rowp = acc[ai][0][m][0]; *(f32x4*)(rowp + 4) = acc[ai][0][m][1];
                    }
            }
            return;
        }
        bf16_t* base; int ldc, ct;
        if (u.pn < 9) { base = PA; ldc = 2304; ct = u.pn; } else if (u.pn < 18) { base = PD; ldc = 2304; ct = u.pn - 9; } else { base = PZ; ldc = 768; ct = u.pn - 18; }
        const int col0 = ct * BM + wc * 32 + 8 * fq;
#pragma unroll
        for (int ai = 0; ai < 2; ++ai)
#pragma unroll
            for (int m = 0; m < 4; ++m) {
                bf16_t* rowp = base + (size_t)(row0 + ai * HALF + m * 16) * ldc + col0;
#pragma unroll
                for (int bj = 0; bj < 2; ++bj) { const f32x4 v0 = acc[ai][bj][m][0], v1 = acc[ai][bj][m][1];
                    u32x4 w; w.x = cvt_pk_bf16(v0[0], v0[1]); w.y = cvt_pk_bf16(v0[2], v0[3]); w.z = cvt_pk_bf16(v1[0], v1[1]); w.w = cvt_pk_bf16(v1[2], v1[3]);
                    *(u32x4*)(rowp + bj * HALF) = w; }
            }
    }
};
struct EpiGateF32 {
    static constexpr bool PERM = false, AFTER_DRAIN = false;
    float* O; const bf16_t* gate; int ldg; int pad_;
    __device__ __forceinline__ void operator()(const f32x4 (&acc)[2][2][4][2], const Unit& u, int wr, int wc, int fr, int fq) const {
        const int row0 = u.pm * BM + wr * 64 + fr, col0 = u.pn * BM + wc * 32 + 4 * fq;
#pragma unroll
        for (int ai = 0; ai < 2; ++ai)
#pragma unroll
            for (int m = 0; m < 4; ++m) {
                const size_t r = (size_t)(row0 + ai * HALF + m * 16);
#pragma unroll
                for (int bj = 0; bj < 2; ++bj)
#pragma unroll
                    for (int n = 0; n < 2; ++n) { const int c = col0 + bj * HALF + n * 16;
                        const v2u gw = *(const v2u*)(gate + r * ldg + c);
                        f32x4 a = acc[ai][bj][m][n];
                        a[0] *= sigmoidf_(bflo(gw.x)); a[1] *= sigmoidf_(bfhi(gw.x)); a[2] *= sigmoidf_(bflo(gw.y)); a[3] *= sigmoidf_(bfhi(gw.y));
                        *(f32x4*)(O + r * 1024 + c) = a; }
            }
    }
};
struct EpiGateAddBf16 {
    static constexpr bool PERM = false, AFTER_DRAIN = false;
    bf16_t* O; const float* T1; const bf16_t* gate; int ldg; int pad_;
    __device__ __forceinline__ void operator()(const f32x4 (&acc)[2][2][4][2], const Unit& u, int wr, int wc, int fr, int fq) const {
        const int row0 = u.pm * BM + wr * 64 + fr, col0 = u.pn * BM + wc * 32 + 4 * fq;
#pragma unroll
        for (int ai = 0; ai < 2; ++ai)
#pragma unroll
            for (int m = 0; m < 4; ++m) {
                const size_t r = (size_t)(row0 + ai * HALF + m * 16);
#pragma unroll
                for (int bj = 0; bj < 2; ++bj)
#pragma unroll
                    for (int n = 0; n < 2; ++n) { const int c = col0 + bj * HALF + n * 16;
                        const v2u gw = *(const v2u*)(gate + r * ldg + c);
                        const f32x4 t = *(const f32x4*)(T1 + r * 1024 + c);
                        f32x4 a = acc[ai][bj][m][n];
                        a[0] = t[0] + a[0] * sigmoidf_(bflo(gw.x)); a[1] = t[1] + a[1] * sigmoidf_(bfhi(gw.x)); a[2] = t[2] + a[2] * sigmoidf_(bflo(gw.y)); a[3] = t[3] + a[3] * sigmoidf_(bfhi(gw.y));
                        v2u w; w.x = cvt_pk_bf16(a[0], a[1]); w.y = cvt_pk_bf16(a[2], a[3]);
                        *(v2u*)(O + r * 1024 + c) = w; }
            }
    }
};
}


#define GAS __attribute__((address_space(1)))
struct Params { const float* in[17]; float* out; unsigned char* ws; };
#define XB_TMO      128
#define XB_XCNT(j)  (256  + 64 * (j))
#define XB_XSUB(j)  (1280 + 64 * (j))
#define XB_XGEN(j)  (2304 + 64 * (j))
#define XB_TOP      3328
#define XB_TOPGEN   3392
#define XCD_BAR_WORDS 3456
#define XB_SPIN_CAP (1u << 18)

__device__ __forceinline__ unsigned xb_ld(unsigned* p)              { return __hip_atomic_load(p, __ATOMIC_RELAXED, __HIP_MEMORY_SCOPE_AGENT); }
__device__ __forceinline__ unsigned xb_add(unsigned* p, unsigned v) { return __hip_atomic_fetch_add(p, v, __ATOMIC_RELAXED, __HIP_MEMORY_SCOPE_AGENT); }
__device__ __forceinline__ unsigned xb_xcc_id() { return (unsigned)__builtin_amdgcn_s_getreg((3 << 11) | 20) & 0xFu; }
#define XB_SPIN(cond, bar) do { unsigned _sp = 0; while (cond) { __builtin_amdgcn_s_sleep(1); \
    if ((++_sp & 255u) == 0u) { if (xb_ld(&(bar)[XB_TMO])) break; if (_sp > XB_SPIN_CAP) { atomicAdd(&(bar)[XB_TMO], 1u); break; } } } } while (0)

struct XcdBarrier {
    unsigned* bar; unsigned x;
    volatile LAS unsigned* st;
};

__device__ __forceinline__ XcdBarrier xcd_barrier_post(unsigned* bar, volatile LAS unsigned* st) {
    XcdBarrier b; b.bar = bar; b.x = xb_xcc_id(); b.st = st;
    if (threadIdx.x == 0) (void)xb_add(&bar[XB_XCNT(b.x)], 1u);
    return b;
}
__device__ __forceinline__ void xcd_barrier_complete(unsigned* bar, unsigned x, unsigned& nloc, unsigned& nx) {
    const unsigned G = gridDim.x * gridDim.y * gridDim.z;
    unsigned sum, cnt, mine, sp = 0u;
    for (;;) {
        sum = 0u; cnt = 0u; mine = 0u;
#pragma unroll
        for (unsigned j = 0; j < 16; ++j) { const unsigned c = xb_ld(&bar[XB_XCNT(j)]); sum += c; cnt += (c > 0u) ? 1u : 0u; mine = (j == x) ? c : mine; }
        if (sum == G) break;
        __builtin_amdgcn_s_sleep(1);
        if ((++sp & 255u) == 0u) { if (xb_ld(&bar[XB_TMO])) break; if (sp > XB_SPIN_CAP) { atomicAdd(&bar[XB_TMO], 1u); break; } }
    }
    nloc = mine > 0u ? mine : 1u; nx = cnt > 0u ? cnt : 1u;
}

__device__ __forceinline__ void xcd_barrier(const XcdBarrier& b, int wv) {
    const bool leader_thread = (wv == 0) && (lane_id_() == 0);
    asm volatile("s_waitcnt vmcnt(0)" ::: "memory");
    __syncthreads();
    if (leader_thread) {
        unsigned* bar = b.bar;
        __builtin_amdgcn_s_waitcnt(0);
        unsigned nloc = b.st[0], nx = b.st[1];
        if (nloc == 0u) { xcd_barrier_complete(bar, b.x, nloc, nx); b.st[0] = nloc; b.st[1] = nx; }
        const unsigned old = xb_add(&bar[XB_XSUB(b.x)], 1u);
        const unsigned gen = old / nloc;
        if (old + 1u == (gen + 1u) * nloc) {
            __builtin_amdgcn_fence(__ATOMIC_RELEASE, "agent");
            asm volatile("s_waitcnt vmcnt(0)" ::: "memory");
            const unsigned og = xb_add(&bar[XB_TOP], 1u);
            const unsigned tg = og / nx;
            if (og + 1u == (tg + 1u) * nx) xb_add(&bar[XB_TOPGEN], 1u);
            else XB_SPIN(xb_ld(&bar[XB_TOPGEN]) == tg, bar);
            __builtin_amdgcn_fence(__ATOMIC_ACQUIRE, "agent");
            xb_add(&bar[XB_XGEN(b.x)], 1u);
            asm volatile("s_waitcnt vmcnt(0)" ::: "memory");
        } else {
            XB_SPIN(xb_ld(&bar[XB_XGEN(b.x)]) == gen, bar);
            __builtin_amdgcn_fence(__ATOMIC_ACQUIRE, "agent");
            asm volatile("s_waitcnt vmcnt(0)" ::: "memory");
        }
    }
    __syncthreads();
}

typedef const __attribute__((address_space(4))) unsigned char* ka_t;
__device__ __forceinline__ ka_t ka_() { ka_t k = (ka_t)__builtin_amdgcn_kernarg_segment_ptr(); asm volatile("" : "+s"(k)); return k; }
#define PIN(i) ((const float*)(*(const __attribute__((address_space(4))) unsigned long long*)(ka_() + 8 * (i))))
#define POUT ((float*)(*(const __attribute__((address_space(4))) unsigned long long*)(ka_() + 136)))
#define PWS ((unsigned char*)(*(const __attribute__((address_space(4))) unsigned long long*)(ka_() + 144)))
#define BID ((int)blockIdx.x)
#define GSZ ((int)gridDim.x)
__device__ __forceinline__ int srcmap(int mode, int n) {
    if (mode == 0) return n;
    if (mode == 1) return (n >> 8) * 128 + (n & 127) + ((n >> 7) & 1) * 2816;
    if (n < 5400) return n;
    if (n < 5632) return -1;
    if (n < 6656) return 5400 + (n - 5632);
    return 6424 + (n - 6656);
}
__device__ __forceinline__ void conv_item(const float* W, bf16* WT, int K, int Nsrc, int Ndst, int mode, int item, float* scr, int lane) {
    const int nblk = Ndst / 32, kb = item / nblk, nb = item % nblk, k0 = 64 * kb, n0 = 32 * nb;
    const int sc = srcmap(mode, n0 + (lane & 31));
#pragma unroll 8
    for (int i = 0; i < 32; ++i) { const int kk = 2 * i + (lane >> 5); scr[kk * 33 + (lane & 31)] = sc >= 0 ? W[(size_t)(k0 + kk) * Nsrc + sc] : 0.f; }
    __builtin_amdgcn_s_waitcnt(0xc07f); __builtin_amdgcn_wave_barrier();
    const int c = lane & 7;
#pragma unroll
    for (int j = 0; j < 4; ++j) { const int n = (lane >> 3) + 8 * j; const float* s = scr + (8 * c) * 33 + n;
        v4u o; o.x = pk2(s[0 * 33], s[1 * 33]); o.y = pk2(s[2 * 33], s[3 * 33]); o.z = pk2(s[4 * 33], s[5 * 33]); o.w = pk2(s[6 * 33], s[7 * 33]);
        *(v4u*)(WT + (size_t)(n0 + n) * K + k0 + 8 * c) = o; }
    __builtin_amdgcn_s_waitcnt(0xc07f); __builtin_amdgcn_wave_barrier();
}
__device__ __forceinline__ void ph_convert(int l, unsigned char* lds, int wv) {
    int tid_ = wv * 64 + lane_id_(); asm volatile("" : "+v"(tid_)); const int lane = tid_ & 63, wave = tid_ >> 6;
    float* scr = (float*)lds + wave * (64 * 33);
    unsigned char* wb = PWS + WS_W;
    constexpr int I_FI = 16 * 176, I_FO = 44 * 32, I_IN = 16 * 240, I_BA = 4 * 32, I_BD = 12 * 32, I_O = 16 * 32;
    constexpr int NIT = 2 * I_FI + 2 * I_FO + I_IN + I_BA + I_BD + I_O;
    for (int it = BID * 8 + wave; it < NIT; it += GSZ * 8) {
        int r = it;
        if (r < 2 * I_FI) { const int f = r / I_FI; conv_item(PIN(7) + ((size_t)l * 2 + f) * 1024 * 5632, (bf16*)(wb + (f ? W_FFIN1 : W_FFIN0)), 1024, 5632, 5632, 1, r % I_FI, scr, lane); continue; } r -= 2 * I_FI;
        if (r < 2 * I_FO) { const int f = r / I_FO; conv_item(PIN(8) + ((size_t)l * 2 + f) * 2816 * 1024, (bf16*)(wb + (f ? W_FFOUT1 : W_FFOUT0)), 2816, 1024, 1024, 0, r % I_FO, scr, lane); continue; } r -= 2 * I_FO;
        if (r < I_IN) { conv_item(PIN(9) + (size_t)l * 1024 * NIN_, (bf16*)(wb + W_IN), 1024, NIN_, NINP_, 2, r, scr, lane); continue; } r -= I_IN;
        if (r < I_BA) { conv_item(PIN(14) + (size_t)l * 256 * 1024, (bf16*)(wb + W_BATT), 256, 1024, 1024, 0, r, scr, lane); continue; } r -= I_BA;
        if (r < I_BD) { conv_item(PIN(15) + (size_t)l * 768 * 1024, (bf16*)(wb + W_BDN), 768, 1024, 1024, 0, r, scr, lane); continue; } r -= I_BD;
        conv_item(PIN(16) + (size_t)l * 1024 * 1024, (bf16*)(wb + W_OUT), 1024, 1024, 1024, 0, r, scr, lane);
    }
}
__device__ __forceinline__ void ph_ada(unsigned char* lds, int wv) {
    float* red = (float*)(lds + 72 * 1024);
    int tid_ = wv * 64 + lane_id_(); asm volatile("" : "+v"(tid_)); const int lane = tid_ & 63, wave = tid_ >> 6;
    const float* c = PIN(1); const float* w_ada = PIN(3); const float* b_ada = PIN(4); float* mod = (float*)(PWS + WS_MOD);
    for (int u = BID; u < 2 * 144; u += GSZ) {
        const int l = u / 144, n = (u % 144) * 64 + lane;
        const float* W = w_ada + (size_t)l * 1024 * 9216 + n;
        float s = 0.f;
        for (int k = wave * 128; k < wave * 128 + 128; ++k) s += siluf_(c[k]) * W[(size_t)k * 9216];
        red[wave * 64 + lane] = s;
        __syncthreads();
        if (wave == 0) { float t = b_ada[l * 9216 + n];
#pragma unroll
            for (int w = 0; w < 8; ++w) t += red[w * 64 + lane];
            mod[l * 9216 + n] = t; }
        __syncthreads();
    }
}
__device__ const float ROPE_INV[32] = {1.000000000e+00f, 7.498942018e-01f, 5.623413324e-01f, 4.216965139e-01f, 3.162277639e-01f, 2.371373773e-01f, 1.778279394e-01f, 1.333521456e-01f, 1.000000015e-01f, 7.498942316e-02f, 5.623413250e-02f, 4.216964915e-02f, 3.162277490e-02f, 2.371373773e-02f, 1.778279431e-02f, 1.333521400e-02f, 9.999999776e-03f, 7.498942316e-03f, 5.623413250e-03f, 4.216964822e-03f, 3.162277630e-03f, 2.371373819e-03f, 1.778279431e-03f, 1.333521446e-03f, 1.000000047e-03f, 7.498941850e-04f, 5.623413017e-04f, 4.216965172e-04f, 3.162277571e-04f, 2.371373703e-04f, 1.778279402e-04f, 1.333521504e-04f};
__device__ __forceinline__ void ph_rope(int wv) {
    const int* pos = (const int*)PIN(2); float* tab = (float*)(PWS + WS_ROPE);
    int tid_ = wv * 64 + lane_id_(); asm volatile("" : "+v"(tid_));
    for (int idx = BID * NTHREADS + tid_; idx < S_ * 32; idx += GSZ * NTHREADS) {
        const int t = idx >> 5, i = idx & 31;
        const float inv = ROPE_INV[i];
        const float ang = (float)pos[t] * inv;
        float sn, cs; sincosf(ang, &sn, &cs);
        tab[idx] = cs; tab[S_ * 32 + idx] = sn;
    }
}
struct RowArgs { const float* xi; const float* y; float* xo; bf16* h; const float* wpost; const float* gate; const float* wpre; const float* shift; const float* scale; float coef; };
__device__ __forceinline__ void ph_rows(const RowArgs& a, int wv) {
    int tid_ = wv * 64 + lane_id_(); asm volatile("" : "+v"(tid_)); const int lane = tid_ & 63, wave = tid_ >> 6;
    for (int r = BID * 8 + wave; r < S_; r += GSZ * 8) {
        f32x4 x[4];
        const f32x4* xr = (const f32x4*)(a.xi + (size_t)r * D_) + lane;
#pragma unroll
        for (int j = 0; j < 4; ++j) x[j] = xr[64 * j];
        if (a.y) {
            f32x4 y[4]; float s = 0.f;
            const f32x4* yr = (const f32x4*)(a.y + (size_t)r * D_) + lane;
#pragma unroll
            for (int j = 0; j < 4; ++j) { y[j] = yr[64 * j]; s += (y[j].x * y[j].x + y[j].y * y[j].y) + (y[j].z * y[j].z + y[j].w * y[j].w); }
            const float rs = 1.0f / sqrtf(wave_sum(s) * (1.f / D_) + 1e-6f);
#pragma unroll
            for (int j = 0; j < 4; ++j) { const f32x4 wp = ((const f32x4*)a.wpost)[lane + 64 * j], g = ((const f32x4*)a.gate)[lane + 64 * j];
                x[j] = x[j] + a.coef * g * ((y[j] * rs) * wp); }
            f32x4* xw = (f32x4*)(a.xo + (size_t)r * D_) + lane;
#pragma unroll
            for (int j = 0; j < 4; ++j) xw[64 * j] = x[j];
        }
        if (a.h) {
            float s = 0.f;
#pragma unroll
            for (int j = 0; j < 4; ++j) s += (x[j].x * x[j].x + x[j].y * x[j].y) + (x[j].z * x[j].z + x[j].w * x[j].w);
            const float rs = 1.0f / sqrtf(wave_sum(s) * (1.f / D_) + 1e-6f);
            v2u* hw = (v2u*)(a.h + (size_t)r * D_) + lane;
#pragma unroll
            for (int j = 0; j < 4; ++j) { const f32x4 wp = ((const f32x4*)a.wpre)[lane + 64 * j], sc = ((const f32x4*)a.scale)[lane + 64 * j], sh = ((const f32x4*)a.shift)[lane + 64 * j];
                const f32x4 v = ((x[j] * rs) * wp) * (1.0f + sc) + sh;
                v2u w; w.x = pk2(v.x, v.y); w.y = pk2(v.z, v.w); hw[64 * j] = w; }
        }
    }
}
constexpr int ATT_PITCH = 68;
__device__ __forceinline__ void ph_attn_v1(const bf16* PA, const float* rope, bf16* OG, float* LSE, unsigned char* lds, int wv) {
    float* qs = (float*)lds; float* ks = qs + 64 * ATT_PITCH; float* vs = ks + 192 * ATT_PITCH;
    int tid_ = wv * 64 + lane_id_(); asm volatile("" : "+v"(tid_)); const int tid = tid_, lane = tid & 63, wave = tid >> 6;
    for (int u = BID; u < 3072; u += GSZ) {
        const int hg = u & 3, w = (u >> 2) & 255, gi = u >> 10;
        const int dil = 1 << (2 * gi), L = S_ / dil, r = w % dil, nb = w / dil, head = gi * 4 + hg;
        __syncthreads();
        for (int rr = wave; rr < 448; rr += 8) {
            int mm, colbase; float* dst; bool rot; float sc = 1.f;
            if (rr < 64) { mm = nb * 64 + rr; colbase = head * 64; dst = qs + rr * ATT_PITCH; rot = true; sc = 0.125f; }
            else if (rr < 256) { mm = nb * 64 - 64 + (rr - 64); colbase = 768 + head * 64; dst = ks + (rr - 64) * ATT_PITCH; rot = true; }
            else { mm = nb * 64 - 64 + (rr - 256); colbase = 1536 + head * 64; dst = vs + (rr - 256) * ATT_PITCH; rot = false; }
            float val = 0.f;
            if (mm >= 0 && mm < L) {
                const int tok = mm * dil + r;
                val = bf2f(PA[(size_t)tok * 2304 + colbase + lane]);
                if (rot) {
                    const float other = __shfl_xor(val, 32);
                    const float cs = rope[tok * 32 + (lane & 31)], sn = rope[S_ * 32 + tok * 32 + (lane & 31)];
                    val = (lane < 32) ? (val * cs - other * sn) : (val * cs + other * sn);
                }
            }
            dst[lane] = val * sc;
        }
        __syncthreads();
        const int i = tid >> 3, part = tid & 7;
        float q[64], acc[64];
#pragma unroll
        for (int d = 0; d < 64; d += 4) { const f32x4 t = *(const f32x4*)(qs + i * ATT_PITCH + d); q[d] = t.x; q[d + 1] = t.y; q[d + 2] = t.z; q[d + 3] = t.w; }
#pragma unroll
        for (int d = 0; d < 64; ++d) acc[d] = 0.f;
        float m = -1e30f, l = 0.f;
        for (int jj = 0; jj < 24; ++jj) {
            const int j = part + 8 * jj, mm = nb * 64 - 64 + j, dj = j - 64 - i;
            const bool ok = (dj <= 64) && (dj >= -64) && (mm >= 0) && (mm < L);
            if (ok) {
                const float* kr = ks + j * ATT_PITCH; float s = 0.f;
#pragma unroll
                for (int d = 0; d < 64; d += 4) { const f32x4 t = *(const f32x4*)(kr + d); s += q[d] * t.x + q[d + 1] * t.y + q[d + 2] * t.z + q[d + 3] * t.w; }
                const float mn = fmaxf(m, s), al = __expf(m - mn), p = __expf(s - mn);
                l = l * al + p; m = mn;
                const float* vr = vs + j * ATT_PITCH;
#pragma unroll
                for (int d = 0; d < 64; d += 4) { const f32x4 t = *(const f32x4*)(vr + d);
                    acc[d] = acc[d] * al + p * t.x; acc[d + 1] = acc[d + 1] * al + p * t.y; acc[d + 2] = acc[d + 2] * al + p * t.z; acc[d + 3] = acc[d + 3] * al + p * t.w; }
            }
        }
        float mt = fmaxf(m, __shfl_xor(m, 1)); mt = fmaxf(mt, __shfl_xor(mt, 2)); mt = fmaxf(mt, __shfl_xor(mt, 4));
        const float f = __expf(m - mt);
        l *= f; l += __shfl_xor(l, 1); l += __shfl_xor(l, 2); l += __shfl_xor(l, 4);
#pragma unroll
        for (int d = 0; d < 64; ++d) acc[d] *= f;
        const bool b2 = part & 4, b1 = part & 2, b0 = part & 1;
        float r32[32], r16[16], r8[8];
#pragma unroll
        for (int d = 0; d < 32; ++d) { const float keep = b2 ? acc[32 + d] : acc[d], send = b2 ? acc[d] : acc[32 + d]; r32[d] = keep + __shfl_xor(send, 4); }
#pragma unroll
        for (int d = 0; d < 16; ++d) { const float keep = b1 ? r32[16 + d] : r32[d], send = b1 ? r32[d] : r32[16 + d]; r16[d] = keep + __shfl_xor(send, 2); }
#pragma unroll
        for (int d = 0; d < 8; ++d) { const float keep = b0 ? r16[8 + d] : r16[d], send = b0 ? r16[d] : r16[8 + d]; r8[d] = keep + __shfl_xor(send, 1); }
        const float il = 1.0f / l;
        const int tok = (nb * 64 + i) * dil + r;
        v4u o; o.x = pk2(r8[0] * il, r8[1] * il); o.y = pk2(r8[2] * il, r8[3] * il); o.z = pk2(r8[4] * il, r8[5] * il); o.w = pk2(r8[6] * il, r8[7] * il);
        *(v4u*)(OG + ((size_t)gi * S_ + tok) * 256 + hg * 64 + part * 8) = o;
        if (part == 0) LSE[((size_t)gi * S_ + tok) * 4 + hg] = mt + logf(l);
    }
}

__device__ __forceinline__ void ph_dnprep(const bf16* PD, const float* AB, const float* convw, const float* a_log, const float* dt_bias, bf16* QKVd, float* GB, const bf16* OG, const float* LSE, bf16* OATT, int wv) {
    int tid_ = wv * 64 + lane_id_(); asm volatile("" : "+v"(tid_)); const int tid = tid_, lane = tid_ & 63, wave = tid_ >> 6;
    for (int it = BID * 8 + wave; it < 1024 * 5; it += GSZ * 8) {
        const int tb = it / 5, sg = it % 5, c0 = sg * 512 + lane * 8, t0 = tb * 16;
        if (c0 < 2304) {
            const int seg = c0 >> 7;
            float cw[5][8];
#pragma unroll
            for (int j = 0; j < 5; ++j) { const f32x4 a = *(const f32x4*)(convw + j * 2304 + c0), b = *(const f32x4*)(convw + j * 2304 + c0 + 4);
                cw[j][0] = a.x; cw[j][1] = a.y; cw[j][2] = a.z; cw[j][3] = a.w; cw[j][4] = b.x; cw[j][5] = b.y; cw[j][6] = b.z; cw[j][7] = b.w; }
            v4u win[5];
#pragma unroll
            for (int j = 0; j < 4; ++j) { const int tt = t0 + j - 2; win[j + 1] = (tt >= 0) ? *(const v4u*)(PD + (size_t)tt * 2304 + c0) : (v4u){0u, 0u, 0u, 0u}; }
#pragma unroll
            for (int i = 0; i < 16; ++i) {
#pragma unroll
                for (int j = 0; j < 4; ++j) win[j] = win[j + 1];
                { const int tt = t0 + i + 2; win[4] = (tt < S_) ? *(const v4u*)(PD + (size_t)tt * 2304 + c0) : (v4u){0u, 0u, 0u, 0u}; }
                float a[8];
#pragma unroll
                for (int e = 0; e < 8; ++e) a[e] = 0.f;
#pragma unroll
                for (int j = 0; j < 5; ++j) { const unsigned wx[4] = {win[j].x, win[j].y, win[j].z, win[j].w};
#pragma unroll
                    for (int e = 0; e < 4; ++e) { a[2 * e] += bflo(wx[e]) * cw[j][2 * e]; a[2 * e + 1] += bfhi(wx[e]) * cw[j][2 * e + 1]; } }
                float ss = 0.f;
#pragma unroll
                for (int e = 0; e < 8; ++e) { a[e] = a[e] * __builtin_amdgcn_rcpf(1.0f + __expf(-a[e])); ss += a[e] * a[e]; }
                if (seg < 12) {
                    ss += __shfl_xor(ss, 1); ss += __shfl_xor(ss, 2); ss += __shfl_xor(ss, 4); ss += __shfl_xor(ss, 8);
                    const float sc = (1.0f / sqrtf(ss + 1e-6f)) * (seg < 6 ? 0.08838834764831845f : 1.0f);
#pragma unroll
                    for (int e = 0; e < 8; ++e) a[e] *= sc;
                }
                v4u o; o.x = pk2(a[0], a[1]); o.y = pk2(a[2], a[3]); o.z = pk2(a[4], a[5]); o.w = pk2(a[6], a[7]);
                *(v4u*)(QKVd + (size_t)(t0 + i) * 2304 + c0) = o;
            }
        }
    }
    for (int e = BID * NTHREADS + tid; e < S_ * 12; e += GSZ * NTHREADS) {
        const int t = e / 12, idx = e % 12;
        const float braw = AB[(size_t)t * 32 + idx], araw = AB[(size_t)t * 32 + 12 + idx];
        const float x = araw + dt_bias[idx];
        const float sp = fmaxf(x, 0.f) + log1pf(expf(-fabsf(x)));
        GB[(size_t)idx * S_ + t] = -expf(a_log[idx]) * sp;
        GB[(size_t)(12 + idx) * S_ + t] = 1.0f / (1.0f + expf(-braw));
    }
    for (int t = BID * 8 + wave; t < S_; t += GSZ * 8) {
        const int ch = 4 * lane, hg = lane >> 4;
        const float l0 = LSE[(size_t)t * 4 + hg], l1 = LSE[((size_t)S_ + t) * 4 + hg], l2 = LSE[((size_t)2 * S_ + t) * 4 + hg];
        const float mx = fmaxf(l0, fmaxf(l1, l2));
        float w0 = expf(l0 - mx), w1 = expf(l1 - mx), w2 = expf(l2 - mx);
        const float inv = 1.0f / (w0 + w1 + w2); w0 *= inv; w1 *= inv; w2 *= inv;
        const v2u a = *(const v2u*)(OG + (size_t)t * 256 + ch), b = *(const v2u*)(OG + ((size_t)S_ + t) * 256 + ch), cc = *(const v2u*)(OG + ((size_t)2 * S_ + t) * 256 + ch);
        v2u o;
        o.x = pk2(w0 * bflo(a.x) + w1 * bflo(b.x) + w2 * bflo(cc.x), w0 * bfhi(a.x) + w1 * bfhi(b.x) + w2 * bfhi(cc.x));
        o.y = pk2(w0 * bflo(a.y) + w1 * bflo(b.y) + w2 * bflo(cc.y), w0 * bfhi(a.y) + w1 * bfhi(b.y) + w2 * bfhi(cc.y));
        *(v2u*)(OATT + (size_t)t * 256 + ch) = o;
    }
}

__device__ __forceinline__ void ph_final(const bf16* ODIR0, const bf16* ODIR1, const bf16* PZ, const float* dnw, bf16* ODN, int wv) {
    int tid_ = wv * 64 + lane_id_(); asm volatile("" : "+v"(tid_)); const int lane = tid_ & 63, wave = tid_ >> 6;
    for (int t = BID * 8 + wave; t < S_; t += GSZ * 8) {
#pragma unroll
        for (int h = 0; h < 6; ++h) {
            const int c = h * 128 + 2 * lane;
            const unsigned wf = *(const unsigned*)(ODIR0 + (size_t)t * 768 + c), wb = *(const unsigned*)(ODIR1 + (size_t)t * 768 + c);
            float o0 = bflo(wf) + bflo(wb), o1 = bfhi(wf) + bfhi(wb);
            const float ms = wave_sum(o0 * o0 + o1 * o1) * (1.0f / 128.0f);
            const float sc = 1.0f / sqrtf(ms + 1e-6f);
            const unsigned zw = *(const unsigned*)(PZ + (size_t)t * 768 + c);
            const f32x2 nw = *(const f32x2*)(dnw + 2 * lane);
            o0 = o0 * sc * nw.x * siluf_(bflo(zw)); o1 = o1 * sc * nw.y * siluf_(bfhi(zw));
            *(unsigned*)(ODN + (size_t)t * 768 + c) = pk2(o0, o1);
        }
    }
}
typedef short bf16x8_t __attribute__((ext_vector_type(8)));
typedef short s16x4_t __attribute__((ext_vector_type(4)));
#define MFMA16(a, b, c) __builtin_amdgcn_mfma_f32_16x16x32_bf16((a), (b), (c), 0, 0, 0)

__device__ __forceinline__ void ph_dn_pre(const bf16* QKVd, const float* GB, bf16* TINV, bf16* ATTN, float* VEC, unsigned char* lds, int wv) {
    int tid_ = wv * 64 + lane_id_(); asm volatile("" : "+v"(tid_));
    const int tid = tid_, lane = tid & 63, g = lane >> 4, m16 = lane & 15;
    float* GR = (float*)lds; float* Ms = GR + 2 * 64 * 65; float* Gs = Ms + 2 * 64 * 68; float* Bs = Gs + 128;
    for (int u = BID; u < 1536; u += GSZ) {
        const int n = u / 6, h = u % 6;
        __syncthreads();
        {
            const int kind = wv >> 2, mt = wv & 3;
            const bf16* arow = QKVd + (size_t)(64 * n + 16 * mt + m16) * 2304 + (kind ? 0 : 768) + h * 128 + 8 * g;
            bf16x8_t a[4];
#pragma unroll
            for (int ks = 0; ks < 4; ++ks) a[ks] = *(const bf16x8_t*)(arow + 32 * ks);
#pragma unroll
            for (int nt = 0; nt < 4; ++nt) {
                const bf16* brow = QKVd + (size_t)(64 * n + 16 * nt + m16) * 2304 + 768 + h * 128 + 8 * g;
                f32x4 acc = {0.f, 0.f, 0.f, 0.f};
#pragma unroll
                for (int ks = 0; ks < 4; ++ks) acc = MFMA16(a[ks], *(const bf16x8_t*)(brow + 32 * ks), acc);
#pragma unroll
                for (int rg = 0; rg < 4; ++rg) GR[kind * 64 * 65 + (16 * mt + 4 * g + rg) * 65 + 16 * nt + m16] = acc[rg];
            }
        }
        if ((wv & 3) == 0) {
            const int d = wv >> 2, tok = 64 * n + (d ? 63 - lane : lane);
            float gv = GB[(size_t)(d * 6 + h) * S_ + tok]; const float be = GB[(size_t)(12 + d * 6 + h) * S_ + tok];
#pragma unroll
            for (int o = 1; o < 64; o <<= 1) { const float t = __shfl_up(gv, o); if (lane >= o) gv += t; }
            const float gl = __shfl(gv, 63);
            Gs[d * 64 + lane] = gv; Bs[d * 64 + lane] = be;
            float* vec = VEC + (size_t)(u * 2 + d) * 256;
            vec[lane] = __expf(gv); vec[64 + lane] = be; vec[128 + lane] = __expf(gl - gv); vec[192 + lane] = __expf(gl);
        }
        __syncthreads();
        {
            const int d = wv >> 2, tl = tid & 255, i = tl >> 2, jq = tl & 3, ii = d ? 63 - i : i;
            const float Gi = Gs[d * 64 + i], bi = Bs[d * 64 + i];
            unsigned pk[8];
#pragma unroll
            for (int jj = 0; jj < 16; jj += 2) {
                float at[2];
#pragma unroll
                for (int e = 0; e < 2; ++e) {
                    const int j = 16 * jq + jj + e, jx = d ? 63 - j : j;
                    const float dec = (j <= i) ? __expf(Gi - Gs[d * 64 + j]) : 0.f;
                    const float kk = GR[ii * 65 + jx], qk = GR[64 * 65 + ii * 65 + jx];
                    Ms[d * 64 * 68 + i * 68 + j] = (j < i) ? bi * kk * dec : 0.f;
                    at[e] = (j <= i) ? qk * dec : 0.f;
                }
                pk[jj >> 1] = pk2(at[0], at[1]);
            }
            v4u* dst = (v4u*)(ATTN + ((size_t)(u * 2 + d) * 64 + i) * 64 + 16 * jq);
            v4u o0; o0.x = pk[0]; o0.y = pk[1]; o0.z = pk[2]; o0.w = pk[3]; v4u o1; o1.x = pk[4]; o1.y = pk[5]; o1.z = pk[6]; o1.w = pk[7];
            dst[0] = o0; dst[1] = o1;
        }
        __syncthreads();
        if ((wv & 3) == 0) {
            const int d = wv >> 2, c = lane; const float* Md = Ms + d * 64 * 68;
            float x[64];
#pragma unroll
            for (int i = 0; i < 64; ++i) {
                float s0 = (i == c) ? 1.f : 0.f, s1 = 0.f, s2 = 0.f, s3 = 0.f;
#pragma unroll
                for (int j0 = 0; j0 < i; j0 += 4) {
                    const f32x4 mv = *(const f32x4*)(Md + i * 68 + j0);
                    s0 -= mv.x * x[j0];
                    if (j0 + 1 < i) s1 -= mv.y * x[j0 + 1];
                    if (j0 + 2 < i) s2 -= mv.z * x[j0 + 2];
                    if (j0 + 3 < i) s3 -= mv.w * x[j0 + 3];
                }
                x[i] = (s0 + s1) + (s2 + s3);
            }
            bf16* outp = TINV + (size_t)(u * 2 + d) * 4096 + c;
#pragma unroll
            for (int i = 0; i < 64; ++i) outp[i * 64] = (bf16)f2bf(x[i]);
        }
    }
}

constexpr int SC_KT = 0, SC_QT = 17408, SC_TI = 34816, SC_AT = 44032, SC_VT = 53248, SC_VC = 55296, SC_BUF = 56320;
constexpr int SC_ST = 2 * SC_BUF, SC_RT = SC_ST + 4352, SC_VNT = SC_RT + 2304, SC_VST = SC_VNT + 2304, SC_END = SC_VST + 2304;
static_assert(SC_END <= 131072, "scan LDS");
__device__ __forceinline__ void ph_dn_scan(const bf16* QKVd, const bf16* TINV, const bf16* ATTN, const float* VEC, bf16* ODIR0, bf16* ODIR1, LAS unsigned char* lds, int wv) {
    const int bid = BID;
    if (bid >= 128) return;
    const int p = (bid & 7) + 8 * (bid >> 6), sl = (bid >> 3) & 7;
    if (p >= 12) return;
    const int d = p / 6, h = p % 6;
    int tid_ = wv * 64 + lane_id_(); asm volatile("" : "+v"(tid_));
    const int tid = tid_, lane = tid & 63, g = lane >> 4, m16 = lane & 15;
    bf16* ODIR = d ? ODIR1 : ODIR0;
    v4u pf[7];
#define SC_LOAD(step) do { const int n_ = d ? 255 - (step) : (step); const size_t cb_ = (size_t)((n_ * 6 + h) * 2 + d); \
        _Pragma("unroll") for (int k_ = 0; k_ < 7; ++k_) { const int q_ = tid + 512 * k_; const void* src_ = nullptr; \
            if (k_ < 4) { const int qq_ = q_ & 1023, row_ = qq_ >> 4, ch_ = qq_ & 15; const int tok_ = 64 * n_ + (d ? 63 - row_ : row_); src_ = QKVd + (size_t)tok_ * 2304 + (k_ < 2 ? 768 : 0) + h * 128 + ch_ * 8; } \
            else if (k_ < 6) { const int qq_ = q_ & 511, row_ = qq_ >> 3, ch_ = qq_ & 7; src_ = (k_ == 4 ? TINV : ATTN) + cb_ * 4096 + row_ * 64 + ch_ * 8; } \
            else { const int qq_ = q_ - 3072; if (qq_ < 128) { const int row_ = qq_ >> 1, ch_ = qq_ & 1; const int tok_ = 64 * n_ + (d ? 63 - row_ : row_); src_ = QKVd + (size_t)tok_ * 2304 + 1536 + h * 128 + sl * 16 + ch_ * 8; } \
                   else if (qq_ < 192) src_ = VEC + cb_ * 256 + (qq_ - 128) * 4; } \
            if (src_) pf[k_] = *(const v4u*)src_; } } while (0)
#define SC_WRITE(bufsel) do { LAS unsigned char* bb_ = lds + (bufsel) * SC_BUF; \
        _Pragma("unroll") for (int k_ = 0; k_ < 7; ++k_) { const int q_ = tid + 512 * k_; int off_ = -1; \
            if (k_ < 4) { const int qq_ = q_ & 1023, row_ = qq_ >> 4, ch_ = qq_ & 15; off_ = (k_ < 2 ? SC_KT : SC_QT) + row_ * 272 + ch_ * 16; } \
            else if (k_ < 6) { const int qq_ = q_ & 511, row_ = qq_ >> 3, ch_ = qq_ & 7; off_ = (k_ == 4 ? SC_TI : SC_AT) + row_ * 144 + ch_ * 16; } \
            else { const int qq_ = q_ - 3072; if (qq_ < 128) off_ = SC_VT + qq_ * 16; else if (qq_ < 192) off_ = SC_VC + (qq_ - 128) * 16; } \
            if (off_ >= 0) *(LAS v4u*)(bb_ + off_) = pf[k_]; } } while (0)
    f32x4 Sreg = {0.f, 0.f, 0.f, 0.f};
    for (int e = tid; e < 4352 / 4; e += NTHREADS) ((LAS unsigned*)(lds + SC_ST))[e] = 0u;
    SC_LOAD(0); SC_WRITE(0);
    __syncthreads();
#define SC_BAR() do { asm volatile("s_waitcnt lgkmcnt(0)" ::: "memory"); __builtin_amdgcn_s_barrier(); asm volatile("" ::: "memory"); } while (0)
#pragma unroll 1
    for (int s = 0; s < 256; ++s) {
        const int cur = s & 1, n = d ? 255 - s : s;
        LAS unsigned char* B = lds + cur * SC_BUF;
        if (s + 1 < 256) SC_LOAD(s + 1);
        const LAS float* VC = (const LAS float*)(B + SC_VC);
        bf16x8_t sb[4];
#pragma unroll
        for (int ks = 0; ks < 4; ++ks) sb[ks] = *(const LAS bf16x8_t*)(lds + SC_ST + m16 * 272 + (32 * ks + 8 * g) * 2);
        const int t4 = wv & 3;
        f32x4 acc1 = {0.f, 0.f, 0.f, 0.f};
        {
            const LAS unsigned char* ap = B + (wv < 4 ? SC_KT : SC_QT) + (16 * t4 + m16) * 272 + 16 * g;
#pragma unroll
            for (int ks = 0; ks < 4; ++ks) acc1 = MFMA16(*(const LAS bf16x8_t*)(ap + 64 * ks), sb[ks], acc1);
        }
        const f32x4 eG4 = *(const LAS f32x4*)(VC + 16 * t4 + 4 * g);
        if (wv < 4) {
            const f32x4 be4 = *(const LAS f32x4*)(VC + 64 + 16 * t4 + 4 * g);
            float r[4];
#pragma unroll
            for (int rg = 0; rg < 4; ++rg) { const float vv = bf2f(*(const LAS unsigned short*)(B + SC_VT + (16 * t4 + 4 * g + rg) * 32 + m16 * 2)); r[rg] = be4[rg] * (vv - eG4[rg] * acc1[rg]); }
            v2u w; w.x = pk2(r[0], r[1]); w.y = pk2(r[2], r[3]);
            *(LAS v2u*)(lds + SC_RT + m16 * 144 + (16 * t4 + 4 * g) * 2) = w;
        } else {
#pragma unroll
            for (int rg = 0; rg < 4; ++rg) acc1[rg] *= eG4[rg];
        }
        SC_BAR();
        if (wv < 4) {
            const LAS unsigned char* ap = B + SC_TI + (16 * t4 + m16) * 144 + 16 * g;
            f32x4 vn = {0.f, 0.f, 0.f, 0.f};
#pragma unroll
            for (int ks = 0; ks < 2; ++ks) vn = MFMA16(*(const LAS bf16x8_t*)(ap + 64 * ks), *(const LAS bf16x8_t*)(lds + SC_RT + m16 * 144 + (32 * ks + 8 * g) * 2), vn);
            const f32x4 eL4 = *(const LAS f32x4*)(VC + 128 + 16 * t4 + 4 * g);
            v2u w; w.x = pk2(vn[0], vn[1]); w.y = pk2(vn[2], vn[3]);
            *(LAS v2u*)(lds + SC_VNT + m16 * 144 + (16 * t4 + 4 * g) * 2) = w;
            v2u w2; w2.x = pk2(vn[0] * eL4[0], vn[1] * eL4[1]); w2.y = pk2(vn[2] * eL4[2], vn[3] * eL4[3]);
            *(LAS v2u*)(lds + SC_VST + m16 * 144 + (16 * t4 + 4 * g) * 2) = w2;
        }
        SC_BAR();
        {
            f32x4 acc3 = {0.f, 0.f, 0.f, 0.f};
#pragma unroll
            for (int ks = 0; ks < 2; ++ks) {
                const LAS unsigned char* tp = B + SC_KT + (32 * ks + 8 * g + (m16 >> 2)) * 272 + (16 * wv + 4 * (m16 & 3)) * 2;
                const s16x4_t lo = __builtin_amdgcn_ds_read_tr16_b64_v4i16((LAS s16x4_t*)tp);
                const s16x4_t hi = __builtin_amdgcn_ds_read_tr16_b64_v4i16((LAS s16x4_t*)(tp + 4 * 272));
                const bf16x8_t a = {lo[0], lo[1], lo[2], lo[3], hi[0], hi[1], hi[2], hi[3]};
                acc3 = MFMA16(a, *(const LAS bf16x8_t*)(lds + SC_VST + m16 * 144 + (32 * ks + 8 * g) * 2), acc3);
            }
            const float gl = VC[192];
#pragma unroll
            for (int rg = 0; rg < 4; ++rg) Sreg[rg] = gl * Sreg[rg] + acc3[rg];
            v2u w; w.x = pk2(Sreg[0], Sreg[1]); w.y = pk2(Sreg[2], Sreg[3]);
            *(LAS v2u*)(lds + SC_ST + m16 * 272 + (16 * wv + 4 * g) * 2) = w;
        }
        if (wv >= 4) {
            const LAS unsigned char* ap = B + SC_AT + (16 * t4 + m16) * 144 + 16 * g;
#pragma unroll
            for (int ks = 0; ks < 2; ++ks) acc1 = MFMA16(*(const LAS bf16x8_t*)(ap + 64 * ks), *(const LAS bf16x8_t*)(lds + SC_VNT + m16 * 144 + (32 * ks + 8 * g) * 2), acc1);
#pragma unroll
            for (int rg = 0; rg < 4; ++rg) { const int i = 16 * t4 + 4 * g + rg, tok = 64 * n + (d ? 63 - i : i);
                ODIR[(size_t)tok * 768 + h * 128 + sl * 16 + m16] = (bf16)f2bf(acc1[rg]); }
        }
        if (s + 1 < 256) SC_WRITE(cur ^ 1);
        SC_BAR();
    }
#undef SC_BAR
#undef SC_LOAD
#undef SC_WRITE
}
constexpr int AT_PITCH = 144, AT_K = 0, AT_V = 192 * AT_PITCH, AT_GRP = 2 * 192 * AT_PITCH;
__device__ __forceinline__ void ph_attn(const bf16* PA, const float* rope, bf16* OG, float* LSE, LAS unsigned char* lds, int wv) {
    int tid_ = wv * 64 + lane_id_(); asm volatile("" : "+v"(tid_));
    const int tid = tid_, lane = tid & 63, g = lane >> 4, m16 = lane & 15, grp = wv >> 2, wq = wv & 3, tg = tid & 255;
    LAS unsigned char* Kl = lds + grp * AT_GRP + AT_K; LAS unsigned char* Vl = lds + grp * AT_GRP + AT_V;
#pragma unroll 1
    for (int pi = BID; pi < 1536; pi += GSZ) {
        const int u = 2 * pi + grp;
        const int hg = u & 3, w = (u >> 2) & 255, gi = u >> 10;
        const int dil = 1 << (2 * gi), L = S_ / dil, r = w & (dil - 1), nb = w >> (2 * gi), head = gi * 4 + hg;
#pragma unroll
        for (int k = 0; k < 3; ++k) {
            const int item = tg + 256 * k, row = item >> 2, c = item & 3, mm = nb * 64 - 64 + row;
            v4u o0 = {0u, 0u, 0u, 0u}, o1 = {0u, 0u, 0u, 0u};
            if (mm >= 0 && mm < L) {
                const int tok = mm * dil + r;
                const bf16* kp = PA + (size_t)tok * 2304 + 768 + head * 64 + 8 * c;
                const v4u x0 = *(const v4u*)kp, x1 = *(const v4u*)(kp + 32);
                const f32x4* cp = (const f32x4*)(rope + (size_t)tok * 32 + 8 * c); const f32x4* sp = (const f32x4*)(rope + (size_t)S_ * 32 + (size_t)tok * 32 + 8 * c);
                const f32x4 c0 = cp[0], c1 = cp[1], s0 = sp[0], s1 = sp[1];
                const float cs[8] = {c0.x, c0.y, c0.z, c0.w, c1.x, c1.y, c1.z, c1.w}, sn[8] = {s0.x, s0.y, s0.z, s0.w, s1.x, s1.y, s1.z, s1.w};
                const unsigned xa[4] = {x0.x, x0.y, x0.z, x0.w}, xb[4] = {x1.x, x1.y, x1.z, x1.w};
                unsigned ra[4], rb[4];
#pragma unroll
                for (int e = 0; e < 4; ++e) {
                    const float a0 = bflo(xa[e]), a1 = bfhi(xa[e]), b0 = bflo(xb[e]), b1 = bfhi(xb[e]);
                    ra[e] = pk2(a0 * cs[2 * e] - b0 * sn[2 * e], a1 * cs[2 * e + 1] - b1 * sn[2 * e + 1]);
                    rb[e] = pk2(b0 * cs[2 * e] + a0 * sn[2 * e], b1 * cs[2 * e + 1] + a1 * sn[2 * e + 1]);
                }
                o0.x = ra[0]; o0.y = ra[1]; o0.z = ra[2]; o0.w = ra[3]; o1.x = rb[0]; o1.y = rb[1]; o1.z = rb[2]; o1.w = rb[3];
            }
            *(LAS v4u*)(Kl + row * AT_PITCH + 16 * c) = o0; *(LAS v4u*)(Kl + row * AT_PITCH + 64 + 16 * c) = o1;
        }
#pragma unroll
        for (int k = 0; k < 6; ++k) {
            const int item = tg + 256 * k, row = item >> 3, c = item & 7, mm = nb * 64 - 64 + row;
            v4u o = {0u, 0u, 0u, 0u};
            if (mm >= 0 && mm < L) o = *(const v4u*)(PA + (size_t)(mm * dil + r) * 2304 + 1536 + head * 64 + 8 * c);
            *(LAS v4u*)(Vl + row * AT_PITCH + 16 * c) = o;
        }
        bf16x8_t bq0, bq1;
        const int qi = 16 * wq + m16, qtok = (nb * 64 + qi) * dil + r;
        {
            const bf16* qp = PA + (size_t)qtok * 2304 + head * 64 + 8 * g;
            const v4u x0 = *(const v4u*)qp, x1 = *(const v4u*)(qp + 32);
            const f32x4* cp = (const f32x4*)(rope + (size_t)qtok * 32 + 8 * g); const f32x4* sp = (const f32x4*)(rope + (size_t)S_ * 32 + (size_t)qtok * 32 + 8 * g);
            const f32x4 c0 = cp[0], c1 = cp[1], s0 = sp[0], s1 = sp[1];
            const float cs[8] = {c0.x, c0.y, c0.z, c0.w, c1.x, c1.y, c1.z, c1.w}, sn[8] = {s0.x, s0.y, s0.z, s0.w, s1.x, s1.y, s1.z, s1.w};
            const unsigned xa[4] = {x0.x, x0.y, x0.z, x0.w}, xb[4] = {x1.x, x1.y, x1.z, x1.w};
            v4u ra, rb; unsigned* rap = (unsigned*)&ra; unsigned* rbp = (unsigned*)&rb; (void)rap; (void)rbp;
            unsigned ta[4], tb[4];
#pragma unroll
            for (int e = 0; e < 4; ++e) {
                const float a0 = bflo(xa[e]), a1 = bfhi(xa[e]), b0 = bflo(xb[e]), b1 = bfhi(xb[e]);
                ta[e] = pk2(0.125f * (a0 * cs[2 * e] - b0 * sn[2 * e]), 0.125f * (a1 * cs[2 * e + 1] - b1 * sn[2 * e + 1]));
                tb[e] = pk2(0.125f * (b0 * cs[2 * e] + a0 * sn[2 * e]), 0.125f * (b1 * cs[2 * e + 1] + a1 * sn[2 * e + 1]));
            }
            ra.x = ta[0]; ra.y = ta[1]; ra.z = ta[2]; ra.w = ta[3]; rb.x = tb[0]; rb.y = tb[1]; rb.z = tb[2]; rb.w = tb[3];
            bq0 = __builtin_bit_cast(bf16x8_t, ra); bq1 = __builtin_bit_cast(bf16x8_t, rb);
        }
        __syncthreads();
        f32x4 st[12];
#pragma unroll
        for (int kt = 0; kt < 12; ++kt) {
            const LAS unsigned char* ap = Kl + (16 * kt + m16) * AT_PITCH + 16 * g;
            f32x4 z = {0.f, 0.f, 0.f, 0.f};
            z = MFMA16(*(const LAS bf16x8_t*)ap, bq0, z);
            st[kt] = MFMA16(*(const LAS bf16x8_t*)(ap + 64), bq1, z);
        }
        float mx = -1e30f;
#pragma unroll
        for (int kt = 0; kt < 12; ++kt)
#pragma unroll
            for (int rg = 0; rg < 4; ++rg) { const int j = 16 * kt + 4 * g + rg, dj = j - qi, mm = nb * 64 - 64 + j;
                const bool ok = (dj >= 0) && (dj <= 128) && (mm >= 0) && (mm < L);
                st[kt][rg] = ok ? st[kt][rg] : -1e30f; mx = fmaxf(mx, st[kt][rg]); }
        mx = fmaxf(mx, __shfl_xor(mx, 16)); mx = fmaxf(mx, __shfl_xor(mx, 32));
        float sum = 0.f;
#pragma unroll
        for (int kt = 0; kt < 12; ++kt)
#pragma unroll
            for (int rg = 0; rg < 4; ++rg) { const float p = __expf(st[kt][rg] - mx); st[kt][rg] = p; sum += p; }
        sum += __shfl_xor(sum, 16); sum += __shfl_xor(sum, 32);
        f32x4 o[4];
#pragma unroll
        for (int dt = 0; dt < 4; ++dt) o[dt] = (f32x4){0.f, 0.f, 0.f, 0.f};
#pragma unroll
        for (int kk = 0; kk < 6; ++kk) {
            v4u pb; pb.x = pk2(st[2 * kk][0], st[2 * kk][1]); pb.y = pk2(st[2 * kk][2], st[2 * kk][3]); pb.z = pk2(st[2 * kk + 1][0], st[2 * kk + 1][1]); pb.w = pk2(st[2 * kk + 1][2], st[2 * kk + 1][3]);
            const bf16x8_t b = __builtin_bit_cast(bf16x8_t, pb);
#pragma unroll
            for (int dt = 0; dt < 4; ++dt) {
                const LAS unsigned char* tp = Vl + (32 * kk + 4 * g + (m16 >> 2)) * AT_PITCH + (16 * dt + 4 * (m16 & 3)) * 2;
                const s16x4_t lo = __builtin_amdgcn_ds_read_tr16_b64_v4i16((LAS s16x4_t*)tp);
                const s16x4_t hi = __builtin_amdgcn_ds_read_tr16_b64_v4i16((LAS s16x4_t*)(tp + 16 * AT_PITCH));
                const bf16x8_t a = {lo[0], lo[1], lo[2], lo[3], hi[0], hi[1], hi[2], hi[3]};
                o[dt] = MFMA16(a, b, o[dt]);
            }
        }
        const float il = 1.0f / sum;
        bf16* op = OG + ((size_t)gi * S_ + qtok) * 256 + hg * 64 + 4 * g;
#pragma unroll
        for (int dt = 0; dt < 4; ++dt) { v2u wv2; wv2.x = pk2(o[dt][0] * il, o[dt][1] * il); wv2.y = pk2(o[dt][2] * il, o[dt][3] * il); *(v2u*)(op + 16 * dt) = wv2; }
        if (g == 0) LSE[((size_t)gi * S_ + qtok) * 4 + hg] = mx + logf(sum);
        __syncthreads();
    }
}
constexpr int LDS_RING = 131072, LDS_CTL_OFF = LDS_RING, LDS_BYTES = 147456;
constexpr int CW_BAR = 4096;
#ifndef PROBE_ID
#define PROBE_ID (-1)
#endif
__device__ __forceinline__ unsigned char* wsp() { return PWS; }
template <class Epi> __device__ __forceinline__ void run_gemm(LAS unsigned char* lds, const bf16* A, const bf16* Bt, int N, int K, const Epi& E, int wv) {
    pg8::Gemm g{A, Bt, S_, N, K, 0};
    pg8::StaticOrder S; S.init(S_, N, GSZ, BID);
    pg8::gemm_phase<Epi, pg8::StaticOrder, true, true>(lds, g, S, E, wv);
}
#define GRID_BAR() do { XcdBarrier b_; b_.bar = (unsigned*)(wsp() + WS_CTL) + CW_BAR; b_.st = (volatile LAS unsigned*)(lds + LDS_CTL_OFF + 320) + 8; b_.x = b_.st[2]; xcd_barrier(b_, wv); } while (0)
#define PHASE(id, ...) do { { __VA_ARGS__ } if (PROBE_ID == (id)) { GRID_BAR(); { __VA_ARGS__ } } } while (0)
#define WS_R_PTRS unsigned char* ws = wsp(); unsigned char* R = ws + WS_R; (void)R;

template <int l, int f> __device__ __forceinline__ void ffn_block(LAS unsigned char* lds, unsigned char* lds_raw, int wv) {
    constexpr int s = f * 2;
    PHASE(1, WS_R_PTRS
        pg8::EpiSwiglu E; E.O = (bf16*)(R + R_ACT); E.ldc = FF_; E.pad_ = 0; run_gemm(lds, (const bf16*)(ws + WS_H), (const bf16*)(ws + WS_W + (f ? W_FFIN1 : W_FFIN0)), 2 * FF_, 1024, E, wv); );
    GRID_BAR();
    PHASE(2, WS_R_PTRS
        pg8::EpiF32 E; E.O = (float*)(R + R_Y); E.ldc = 1024; E.pad_ = 0; run_gemm(lds, (const bf16*)(R + R_ACT), (const bf16*)(ws + WS_W + (f ? W_FFOUT1 : W_FFOUT0)), 1024, FF_, E, wv); );
    GRID_BAR();
    {   WS_R_PTRS const float* MOD = (const float*)(ws + WS_MOD); const float* mod = MOD + l * 9216;
        RowArgs a; a.xi = (l == 0 && f == 0) ? PIN(0) : POUT; a.y = (const float*)(R + R_Y); a.xo = POUT; a.wpost = PIN(6) + (l * 3 + s) * 1024; a.gate = mod + (s * 3 + 2) * 1024; a.coef = 0.5f;
        if (f == 0) { a.h = (bf16*)(ws + WS_H); a.wpre = PIN(5) + (l * 3 + 1) * 1024; a.shift = mod + (1 * 3 + 0) * 1024; a.scale = mod + (1 * 3 + 1) * 1024; }
        else if (l == 0) { a.h = (bf16*)(ws + WS_H); a.wpre = PIN(5) + (1 * 3 + 0) * 1024; a.shift = MOD + 9216; a.scale = MOD + 9216 + 1024; }
        else { a.h = nullptr; a.wpre = nullptr; a.shift = nullptr; a.scale = nullptr; }
        ph_rows(a, wv);
        if (f == 1 && l == 0) ph_convert(1, lds_raw, wv); }
    GRID_BAR();
}
template <int l> __device__ __forceinline__ void mixer_block(LAS unsigned char* lds, unsigned char* lds_raw, int wv) {
    PHASE(3, WS_R_PTRS
        pg8::EpiInProj E; E.PA = (bf16*)(R + R_PA); E.PD = (bf16*)(R + R_PD); E.PZ = (bf16*)(R + R_PZ); E.AB = (float*)(R + R_AB);
        run_gemm(lds, (const bf16*)(ws + WS_H), (const bf16*)(ws + WS_W + W_IN), 5632, 1024, E, wv); );
    GRID_BAR();
    PHASE(4, WS_R_PTRS
        ph_attn((const bf16*)(R + R_PA), (const float*)(ws + WS_ROPE), (bf16*)(R + R_OG), (float*)(R + R_LSE), lds, wv); );
    GRID_BAR();
    PHASE(5, WS_R_PTRS
        ph_dnprep((const bf16*)(R + R_PD), (const float*)(R + R_AB), PIN(10) + (size_t)l * 5 * 2304, PIN(11) + l * 12, PIN(12) + l * 12, (bf16*)(R + R_QKVD), (float*)(R + R_GB),
                  (const bf16*)(R + R_OG), (const float*)(R + R_LSE), (bf16*)(R + R_OATT), wv); );
    GRID_BAR();
    PHASE(6, WS_R_PTRS
        ph_dn_pre((const bf16*)(R + R_QKVD), (const float*)(R + R_GB), (bf16*)(R + R_TINV), (bf16*)(R + R_ATTN), (float*)(R + R_VEC), lds_raw, wv); );
    GRID_BAR();
    PHASE(7, WS_R_PTRS
        ph_dn_scan((const bf16*)(R + R_QKVD), (const bf16*)(R + R_TINV), (const bf16*)(R + R_ATTN), (const float*)(R + R_VEC), (bf16*)(R + R_ODIR0), (bf16*)(R + R_ODIR1), lds, wv); );
    GRID_BAR();
    PHASE(8, WS_R_PTRS
        pg8::EpiBf16P E; E.O = (bf16*)(R + R_PG); E.ldc = 2048; E.pad_ = 0;
        run_gemm(lds, (const bf16*)(ws + WS_H), (const bf16*)(ws + WS_W + W_IN) + (size_t)5632 * 1024, 2048, 1024, E, wv); );
    PHASE(9, WS_R_PTRS
        ph_final((const bf16*)(R + R_ODIR0), (const bf16*)(R + R_ODIR1), (const bf16*)(R + R_PZ), PIN(13) + l * 128, (bf16*)(R + R_ODN), wv); );
    GRID_BAR();
    PHASE(10, { WS_R_PTRS
        pg8::EpiGateF32 E; E.O = (float*)(R + R_T1); E.gate = (const bf16*)(R + R_PG); E.ldg = 2048; E.pad_ = 0;
        run_gemm(lds, (const bf16*)(R + R_OATT), (const bf16*)(ws + WS_W + W_BATT), 1024, 256, E, wv); }
        { WS_R_PTRS
        pg8::EpiGateAddBf16 E; E.O = (bf16*)(ws + WS_H); E.T1 = (const float*)(R + R_T1); E.gate = (const bf16*)(R + R_PG) + 1024; E.ldg = 2048; E.pad_ = 0;
        run_gemm(lds, (const bf16*)(R + R_ODN), (const bf16*)(ws + WS_W + W_BDN), 1024, 768, E, wv); } );
    GRID_BAR();
    PHASE(11, WS_R_PTRS
        pg8::EpiF32 E; E.O = (float*)(R + R_Y2); E.ldc = 1024; E.pad_ = 0; run_gemm(lds, (const bf16*)(ws + WS_H), (const bf16*)(ws + WS_W + W_OUT), 1024, 1024, E, wv); );
    GRID_BAR();
    {   WS_R_PTRS const float* mod = (const float*)(ws + WS_MOD) + l * 9216;
        RowArgs a; a.xi = POUT; a.y = (const float*)(R + R_Y2); a.xo = POUT; a.h = (bf16*)(ws + WS_H); a.wpost = PIN(6) + (l * 3 + 1) * 1024; a.gate = mod + (1 * 3 + 2) * 1024; a.coef = 1.0f;
        a.wpre = PIN(5) + (l * 3 + 2) * 1024; a.shift = mod + (2 * 3 + 0) * 1024; a.scale = mod + (2 * 3 + 1) * 1024; ph_rows(a, wv); }
    GRID_BAR();
}
__global__ void __launch_bounds__(NTHREADS, 2) mega_fwd(Params P) {
    extern __shared__ __attribute__((aligned(16))) unsigned char lds_raw[];
    LAS unsigned char* lds = (LAS unsigned char*)lds_raw;
    const int wv = __builtin_amdgcn_readfirstlane((int)threadIdx.x >> 6);
    { const int tid0 = threadIdx.x;
      for (int u = tid0; u < (LDS_BYTES - LDS_CTL_OFF) / 4; u += NTHREADS) ((LAS unsigned*)(lds + LDS_CTL_OFF))[u] = 0u;
      __syncthreads();
      XcdBarrier b0 = xcd_barrier_post((unsigned*)(PWS + WS_CTL) + CW_BAR, (volatile LAS unsigned*)(lds + LDS_CTL_OFF + 320) + 8);
      if (tid0 == 0) ((volatile LAS unsigned*)(lds + LDS_CTL_OFF + 320))[10] = b0.x;
      __syncthreads(); }
    PHASE(0, ph_ada(lds_raw, wv); ph_rope(wv); ph_convert(0, lds_raw, wv); );
    GRID_BAR();
    PHASE(12, WS_R_PTRS float* MOD = (float*)(ws + WS_MOD);
      RowArgs a; a.xi = PIN(0); a.y = nullptr; a.xo = nullptr; a.h = (bf16*)(ws + WS_H); a.wpost = nullptr; a.gate = nullptr; a.wpre = PIN(5); a.shift = MOD; a.scale = MOD + 1024; a.coef = 0.f; ph_rows(a, wv); );
    GRID_BAR();
    ffn_block<0, 0>(lds, lds_raw, wv); mixer_block<0>(lds, lds_raw, wv); ffn_block<0, 1>(lds, lds_raw, wv);
    ffn_block<1, 0>(lds, lds_raw, wv); mixer_block<1>(lds, lds_raw, wv); ffn_block<1, 1>(lds, lds_raw, wv);
}

extern "C" void kernel_launch(void* const* d_in, const int* in_sizes, int n_in, void* d_out, int out_size, void* d_ws, size_t ws_size, hipStream_t stream) {
    static int grid = 0;
    if (grid == 0) {
        if (n_in != 17 || ws_size < WS_END) { fprintf(stderr, "kernel_launch: unexpected n_in %d / ws_size %zu\n", n_in, ws_size); grid = -1; return; }
        int dev = 0, cus = 0, per_cu = 0;
        if (hipGetDevice(&dev) != hipSuccess || hipDeviceGetAttribute(&cus, hipDeviceAttributeMultiprocessorCount, dev) != hipSuccess) { grid = -1; return; }
        if (hipFuncSetAttribute((const void*)mega_fwd, hipFuncAttributeMaxDynamicSharedMemorySize, LDS_BYTES) != hipSuccess) { fprintf(stderr, "kernel_launch: hipFuncSetAttribute failed\n"); grid = -1; return; }
        if (hipOccupancyMaxActiveBlocksPerMultiprocessor(&per_cu, (const void*)mega_fwd, NTHREADS, LDS_BYTES) != hipSuccess || per_cu < 1) { fprintf(stderr, "kernel_launch: occupancy query says %d\n", per_cu); per_cu = 1; }
        (void)hipGetLastError();
        grid = cus;
        if (grid > 256) grid = 256;
    }
    if (grid < 0) return;
    (void)hipMemsetAsync((char*)d_ws + WS_CTL, 0, 1 * MiB, stream);
    Params p{};
    for (int i = 0; i < 17; ++i) p.in[i] = (const float*)d_in[i];
    p.out = (float*)d_out; p.ws = (unsigned char*)d_ws;
    hipLaunchKernelGGL(mega_fwd, dim3(grid), dim3(NTHREADS), LDS_BYTES, stream, p);
}
```

```cpp
#include <hip/hip_runtime.h>
#include <cstdio>
#include <cstdint>
__device__ __forceinline__ int lane_id_() { int l; asm volatile("v_mbcnt_lo_u32_b32 %0, -1, 0\n\tv_mbcnt_hi_u32_b32 %0, -1, %0" : "=v"(l)); return l; }
namespace pg8 {
#define PG8_LAS __attribute__((address_space(3)))
typedef unsigned short bf16_t;
typedef short bf16x8 __attribute__((ext_vector_type(8)));
typedef float f32x4 __attribute__((ext_vector_type(4)));
typedef unsigned u32x4 __attribute__((ext_vector_type(4)));
constexpr int BM = 256, BK = 64, HALF = 128, HTB = HALF * BK * 2  , STAGE_BYTES = 8 * HTB, NXCD = 8, WGM = 8;

__host__ __device__ __forceinline__ int lds_byte(int r, int c) { const int st = (r >> 4) * 2 + (c >> 5), rr = r & 15, cc = c & 31, ob = rr * 64 + cc * 2; return st * 1024 + (ob ^ (((ob >> 9) & 1) << 5)); }
__host__ __device__ __forceinline__ void stage_rc(int b, int& R, int& C) { const int st = b / 1024, sb = b % 1024, swz = sb ^ (((sb >> 9) & 1) << 5); R = (st >> 1) * 16 + swz / 64; C = (st & 1) * 32 + (swz % 64) / 2; }
__host__ __device__ __forceinline__ int perm32(int rho) { const int n = rho >> 4, i = rho & 15; return 8 * (i >> 2) + 4 * n + (i & 3); }

struct Unit { int pm, pn; };
struct Gemm { const bf16_t* A; const bf16_t* Bt; int M, N, K, pad_; };

struct StaticOrder {
    int nM, nN, nwg, G, c;
    __host__ __device__ void init(int M, int N, int G_, int c_) { nM = M / BM; nN = N / BM; nwg = nM * nN; G = G_; c = c_; }
    __host__ __device__ bool next(int i, Unit& u) const {
        const long L = (long)i * G + c; if (L >= nwg) return false;
        int wgid = (int)L; { const int q = nwg / NXCD, r = nwg % NXCD, xcd = wgid % NXCD, off = wgid / NXCD; wgid = (xcd < r ? xcd * (q + 1) : r * (q + 1) + (xcd - r) * q) + off; }
        const int nig = WGM * nN, gid = wgid / nig, fm = gid * WGM, gsz = (nM - fm) < WGM ? (nM - fm) : WGM;
        u.pm = fm + ((wgid % nig) % gsz); u.pn = (wgid % nig) / gsz; return true;
    }
    __device__ __forceinline__ void a_ready(const Unit&) const {}
    __device__ __forceinline__ void done(const Unit&) const {}
};

__device__ __forceinline__ unsigned cvt_pk_bf16(float lo, float hi) { unsigned r; asm volatile("v_cvt_pk_bf16_f32 %0, %1, %2" : "=v"(r) : "v"(lo), "v"(hi)); return r; }
typedef float f32x2 __attribute__((ext_vector_type(2)));
__device__ __forceinline__ f32x2 gelu_pk(f32x2 v) {
    const f32x2 av = __builtin_elementwise_abs(v), d = av * 0.2316418882f + 1.0f;
    f32x2 t; t.x = __builtin_amdgcn_rcpf(d.x); t.y = __builtin_amdgcn_rcpf(d.y);
    f32x2 q = t * 0.5307027145f + (-0.7265760135f); q = q * t + 0.7107068705f; q = q * t + (-0.142248368f); q = q * t + 0.127414796f; q = q * t;
    const f32x2 s = (v * v) * (-0.72134752044f);
    f32x2 e; e.x = __builtin_amdgcn_exp2f(s.x); e.y = __builtin_amdgcn_exp2f(s.y);
    const f32x2 m = v * (q * e), r = v - m;
    f32x2 o; o.x = v.x < 0.f ? m.x : r.x; o.y = v.y < 0.f ? m.y : r.y; return o;
}

template <int ACT  > struct EpiBf16 {
    static constexpr bool PERM = true, AFTER_DRAIN = false; static_assert(ACT == 0 || ACT == 1, "EpiBf16: ACT is 0 (none) or 1 (gelu_pk)");
    bf16_t* O; int ldc; const float* bias; int split_cols; size_t split_stride; float scale0;
    __device__ __forceinline__ void operator()(const f32x4 (&acc)[2][2][4][2], const Unit& u, int wr, int wc, int fr, int fq) const {
        const int row0 = u.pm * BM + wr * 64 + fr; int colt = u.pn * BM; bf16_t* base = O;
        float sc = 1.f; if (split_cols) { const int t = colt / split_cols; base += (size_t)t * split_stride; colt -= t * split_cols; if (t == 0) sc = scale0; }
        const int col0 = colt + wc * 32 + 8 * fq, bcol0 = u.pn * BM + wc * 32 + 8 * fq;
        f32x4 bv[2][2];
#pragma unroll
        for (int bj = 0; bj < 2; ++bj)
#pragma unroll
            for (int n = 0; n < 2; ++n) bv[bj][n] = bias ? *(const f32x4*)(bias + bcol0 + bj * HALF + 4 * n) : (f32x4){0.f, 0.f, 0.f, 0.f};
#pragma unroll
        for (int ai = 0; ai < 2; ++ai)
#pragma unroll
            for (int m = 0; m < 4; ++m) { bf16_t* rowp = base + (size_t)(row0 + ai * HALF + m * 16) * ldc + col0;
#pragma unroll
                for (int bj = 0; bj < 2; ++bj) { f32x4 v0 = acc[ai][bj][m][0] + bv[bj][0], v1 = acc[ai][bj][m][1] + bv[bj][1];
                    if (ACT == 1) { f32x2 a = gelu_pk((f32x2){v0[0], v0[1]}), b = gelu_pk((f32x2){v0[2], v0[3]}), c = gelu_pk((f32x2){v1[0], v1[1]}), d = gelu_pk((f32x2){v1[2], v1[3]});
                        v0 = (f32x4){a.x, a.y, b.x, b.y}; v1 = (f32x4){c.x, c.y, d.x, d.y}; }
                    v0 = v0 * sc; v1 = v1 * sc; u32x4 w; w.x = cvt_pk_bf16(v0[0], v0[1]); w.y = cvt_pk_bf16(v0[2], v0[3]); w.z = cvt_pk_bf16(v1[0], v1[1]); w.w = cvt_pk_bf16(v1[2], v1[3]);
                    *(u32x4*)(rowp + bj * HALF) = w; } }
    }
};

struct PanelStats {
    unsigned* xbuf;
    unsigned* cnt;
    unsigned* tmo;
    int ntn; float eps;
    unsigned code;
    __device__ __forceinline__ bool run(const f32x4 (&v)[2][2][4][2], const Unit& u, int wr, int wc, int fr, int fq, PG8_LAS unsigned char* lds, int wid, int lane) const {
        typedef float f32x2v __attribute__((ext_vector_type(2)));
        PG8_LAS f32x2v* P = (PG8_LAS f32x2v*)lds;
        PG8_LAS f32x2v* S = (PG8_LAS f32x2v*)(lds + 8192);
        PG8_LAS unsigned* flag = (PG8_LAS unsigned*)(lds + 8192 + 2048);
#pragma unroll
        for (int ai = 0; ai < 2; ++ai)
#pragma unroll
            for (int m = 0; m < 4; ++m) {
                float s = 0.f;
#pragma unroll
                for (int bj = 0; bj < 2; ++bj)
#pragma unroll
                    for (int n = 0; n < 2; ++n) { const f32x4 x = v[ai][bj][m][n]; s += (x[0] + x[1]) + (x[2] + x[3]); }
                s += __shfl_xor(s, 16); s += __shfl_xor(s, 32);
                const float mw = s * (1.0f / 64.0f); float q = 0.f;
#pragma unroll
                for (int bj = 0; bj < 2; ++bj)
#pragma unroll
                    for (int n = 0; n < 2; ++n) { const f32x4 d = v[ai][bj][m][n] - mw; q += (d[0] * d[0] + d[1] * d[1]) + (d[2] * d[2] + d[3] * d[3]); }
                q += __shfl_xor(q, 16); q += __shfl_xor(q, 32);
                if (fq == 0) P[(ai * HALF + wr * 64 + m * 16 + fr) * 4 + wc] = (f32x2v){mw, q};
            }
        asm volatile("s_waitcnt lgkmcnt(0)" ::: "memory"); __builtin_amdgcn_s_barrier(); asm volatile("" ::: "memory");
#if defined(BROKEN_EXCHANGE_NO_WAIT)
#warning BROKEN CONTROL BUILD: the row-statistics exchange does not wait; results are wrong by design
        if (blockIdx.x >= 64) { const long long t0_ = clock64(); while (clock64() - t0_ < 60000) __builtin_amdgcn_s_sleep(8); }
#endif
        const int row = wid * 32 + (lane & 31);
        if (lane < 32) {
            const f32x2v a = P[row * 4 + 0], b = P[row * 4 + 1], c = P[row * 4 + 2], d = P[row * 4 + 3];
            const float mt = (a.x + b.x + c.x + d.x) * 0.25f;
            const float da = a.x - mt, db = b.x - mt, dc = c.x - mt, dd = d.x - mt;
            const float m2 = (a.y + b.y) + (c.y + d.y) + 64.0f * ((da * da + db * db) + (dc * dc + dd * dd));
            unsigned long long* slot = (unsigned long long*)xbuf + ((size_t)(u.pm * BM + row) * 4 + u.pn);
            __hip_atomic_store(slot, ((unsigned long long)__float_as_uint(m2) << 32) | __float_as_uint(mt), __ATOMIC_RELAXED, __HIP_MEMORY_SCOPE_AGENT);
        }
        asm volatile("s_waitcnt vmcnt(0)" ::: "memory");
        if (lane == 0) __hip_atomic_fetch_add(cnt + 64 * u.pm, 1u, __ATOMIC_RELAXED, __HIP_MEMORY_SCOPE_AGENT);
        if (wid == 0) {
            bool dead = false; const unsigned long long t0 = __builtin_amdgcn_s_memrealtime(); const unsigned want = 8u * (unsigned)ntn;
            for (;;) {
#if defined(BROKEN_EXCHANGE_NO_WAIT)
                break;
#endif
                if ((unsigned)__builtin_amdgcn_readfirstlane(__hip_atomic_load(cnt + 64 * u.pm, __ATOMIC_RELAXED, __HIP_MEMORY_SCOPE_AGENT)) >= want) break;
                if (__builtin_amdgcn_s_memrealtime() - t0 > 2000000ull) {
                    if (lane == 0) { unsigned expect = 0u; __hip_atomic_compare_exchange_strong(tmo + 1, &expect, code | (unsigned)(u.pm & 0xff), __ATOMIC_RELAXED, __ATOMIC_RELAXED, __HIP_MEMORY_SCOPE_AGENT);
                                     __hip_atomic_store(tmo, 1u, __ATOMIC_RELAXED, __HIP_MEMORY_SCOPE_AGENT); }
                    dead = true; break; }
                __builtin_amdgcn_s_sleep(2);
            }
            __builtin_amdgcn_fence(__ATOMIC_ACQUIRE, "agent");
            if (lane == 0) flag[0] = dead ? 1u : 0u;
        }
        asm volatile("s_waitcnt vmcnt(0) lgkmcnt(0)" ::: "memory"); __builtin_amdgcn_s_barrier(); asm volatile("" ::: "memory");
        const bool bad = flag[0] != 0u;
        if (lane < 32) {
            const unsigned long long* slot = (const unsigned long long*)xbuf + (size_t)(u.pm * BM + row) * 4; float mt[4], m2[4]; float ms = 0.f;
#pragma unroll
            for (int t = 0; t < 4; ++t) { if (t < ntn) { const unsigned long long w = __hip_atomic_load(slot + t, __ATOMIC_RELAXED, __HIP_MEMORY_SCOPE_AGENT); mt[t] = __uint_as_float((unsigned)w); m2[t] = __uint_as_float((unsigned)(w >> 32)); } else { mt[t] = 0.f; m2[t] = 0.f; } ms += mt[t]; }
            const float mean = ms / (float)ntn; float q = 0.f;
#pragma unroll
            for (int t = 0; t < 4; ++t) if (t < ntn) { const float dm = mt[t] - mean; q += m2[t] + 256.0f * dm * dm; }
            S[row] = (f32x2v){mean, 1.0f / sqrtf(q / (256.0f * (float)ntn) + eps)};
        }
        asm volatile("s_waitcnt lgkmcnt(0)" ::: "memory"); __builtin_amdgcn_s_barrier(); asm volatile("" ::: "memory");
        return bad;
    }
};
struct EpiLnRes {
    static constexpr bool PERM = false, AFTER_DRAIN = true;
    const float* base; float* out; int ldc; const float* bias; PanelStats st; unsigned poison;
    __device__ __forceinline__ void fused(f32x4 (&acc)[2][2][4][2], const Unit& u, int wr, int wc, int fr, int fq, PG8_LAS unsigned char* lds, int wid, int lane) const {
        typedef float f32x2v __attribute__((ext_vector_type(2)));
        const PG8_LAS f32x2v* S = (const PG8_LAS f32x2v*)(lds + 8192);
        const int col0 = u.pn * BM + wc * 32 + 4 * fq;
#pragma unroll
        for (int bj = 0; bj < 2; ++bj)
#pragma unroll
            for (int n = 0; n < 2; ++n) { const f32x4 bv = bias ? *(const f32x4*)(bias + col0 + bj * HALF + n * 16) : (f32x4){0.f, 0.f, 0.f, 0.f};
#pragma unroll
                for (int ai = 0; ai < 2; ++ai)
#pragma unroll
                    for (int m = 0; m < 4; ++m) acc[ai][bj][m][n] += bv; }
        f32x4 pre[4][2][2];
#pragma unroll
        for (int m = 0; m < 4; ++m) { const size_t off = (size_t)(u.pm * BM + wr * 64 + m * 16 + fr) * ldc + col0;
#pragma unroll
            for (int bj = 0; bj < 2; ++bj)
#pragma unroll
                for (int n = 0; n < 2; ++n) pre[m][bj][n] = *(const f32x4*)(base + off + bj * HALF + n * 16); }
        const bool bad = st.run(acc, u, wr, wc, fr, fq, lds, wid, lane) || poison != 0u;
        const float qnan = __builtin_nanf("");
#pragma unroll
        for (int ai = 0; ai < 2; ++ai)
#pragma unroll
            for (int m = 0; m < 4; ++m) { const int r = ai * HALF + wr * 64 + m * 16 + fr; const f32x2v sr = S[r]; const size_t off = (size_t)(u.pm * BM + r) * ldc + col0;
#pragma unroll
                for (int bj = 0; bj < 2; ++bj)
#pragma unroll
                    for (int n = 0; n < 2; ++n) { const f32x4 bs = ai == 0 ? pre[m][bj][n] : *(const f32x4*)(base + off + bj * HALF + n * 16); f32x4 o = bs + (acc[ai][bj][m][n] - sr.x) * sr.y;
                        if (bad) o = (f32x4){qnan, qnan, qnan, qnan}; *(f32x4*)(out + off + bj * HALF + n * 16) = o; }
                if (m & 1) asm volatile("" ::: "memory"); }
    }
};
struct EpiLnResLn {
    static constexpr bool PERM = false, AFTER_DRAIN = true;
    const float* base; float* out; bf16_t* xn; int ldc; const float* bias; PanelStats st1, st2; unsigned poison;
    __device__ __forceinline__ void fused(f32x4 (&acc)[2][2][4][2], const Unit& u, int wr, int wc, int fr, int fq, PG8_LAS unsigned char* lds, int wid, int lane) const {
        typedef float f32x2v __attribute__((ext_vector_type(2))); typedef unsigned u32x2v __attribute__((ext_vector_type(2)));
        const PG8_LAS f32x2v* S = (const PG8_LAS f32x2v*)(lds + 8192);
        const int col0 = u.pn * BM + wc * 32 + 4 * fq;
#pragma unroll
        for (int bj = 0; bj < 2; ++bj)
#pragma unroll
            for (int n = 0; n < 2; ++n) { const f32x4 bv = bias ? *(const f32x4*)(bias + col0 + bj * HALF + n * 16) : (f32x4){0.f, 0.f, 0.f, 0.f};
#pragma unroll
                for (int ai = 0; ai < 2; ++ai)
#pragma unroll
                    for (int m = 0; m < 4; ++m) acc[ai][bj][m][n] += bv; }
        bool bad = st1.run(acc, u, wr, wc, fr, fq, lds, wid, lane) || poison != 0u;
        const float qnan = __builtin_nanf("");
#pragma unroll
        for (int ai = 0; ai < 2; ++ai)
#pragma unroll
            for (int m = 0; m < 4; ++m) { const int r = ai * HALF + wr * 64 + m * 16 + fr; const f32x2v sr = S[r]; const size_t off = (size_t)(u.pm * BM + r) * ldc + col0;
#pragma unroll
                for (int bj = 0; bj < 2; ++bj)
#pragma unroll
                    for (int n = 0; n < 2; ++n) { const f32x4 bs = *(const f32x4*)(base + off + bj * HALF + n * 16); acc[ai][bj][m][n] = bs + (acc[ai][bj][m][n] - sr.x) * sr.y; }
                asm volatile("" : "+v"(acc[ai][0][m][0]), "+v"(acc[ai][0][m][1]), "+v"(acc[ai][1][m][0]), "+v"(acc[ai][1][m][1]));
                if (m & 1) asm volatile("" ::: "memory"); }
        const bool bad1 = bad;
        bad = st2.run(acc, u, wr, wc, fr, fq, lds, wid, lane) || bad;
#pragma unroll
        for (int ai = 0; ai < 2; ++ai)
#pragma unroll
            for (int m = 0; m < 4; ++m) { const int r = ai * HALF + wr * 64 + m * 16 + fr; const f32x2v sr = S[r]; const size_t off = (size_t)(u.pm * BM + r) * ldc + col0;
#pragma unroll
                for (int bj = 0; bj < 2; ++bj)
#pragma unroll
                    for (int n = 0; n < 2; ++n) { const f32x4 x1 = acc[ai][bj][m][n]; *(f32x4*)(out + off + bj * HALF + n * 16) = bad1 ? (f32x4){qnan, qnan, qnan, qnan} : x1;
                        const f32x4 o = (x1 - sr.x) * sr.y; u32x2v w; w.x = cvt_pk_bf16(o[0], o[1]); w.y = cvt_pk_bf16(o[2], o[3]);
                        if (bad) { w.x = 0x7fc07fc0u; w.y = 0x7fc07fc0u; } *(u32x2v*)(xn + off + bj * HALF + n * 16) = w; }
                asm volatile("" ::: "memory"); }
    }
};

template <class Epi, class Sched, bool ALIGN_EPI = false, bool SP2 = false>
__device__ __forceinline__ void gemm_phase(PG8_LAS unsigned char* lds, const Gemm g, const Sched& S, const Epi& E, int wv) {
    int tid_ = wv * 64 + lane_id_(); asm volatile("" : "+v"(tid_));
    const int tid = tid_, wid = __builtin_amdgcn_readfirstlane(tid >> 6), lane = tid & 63, wr = wid >> 2, wc = wid & 3, fr = lane & 15, fq = lane >> 4;
    const int K = g.K, nt = K / BK;
    unsigned voffA[2], voffB[2];
#pragma unroll
    for (int i = 0; i < 2; ++i) { int R, C; stage_rc(tid * 16 + i * 8192, R, C); const int Rb = Epi::PERM ? ((R & ~31) + perm32(R & 31)) : R;
        voffA[i] = (unsigned)(R * K + C) * 2u; voffB[i] = (unsigned)(Rb * K + C) * 2u; }
    const size_t kstep = (size_t)(BK * 2);
    const size_t hstep = (size_t)HALF * K * 2;
    const size_t tstep = 2 * hstep;
    const unsigned ldsw = (unsigned)wid * 1024u;
    const int aoff = lds_byte(wr * 64 + fr, fq * 8), boff = lds_byte(wc * 32 + fr, fq * 8);
#define PG8_SA(b, h) (((b) * 2 + (h)) * HTB)
#define PG8_SB(b, h) ((4 + (b) * 2 + (h)) * HTB)
#define PG8_STAGE(bufoff, gbase, voff) do { _Pragma("unroll") for (int _i = 0; _i < 2; ++_i) \
        __builtin_amdgcn_global_load_lds((const unsigned*)((const char*)(gbase) + (voff)[_i]), (PG8_LAS unsigned*)(lds + (bufoff) + ldsw + _i * 8192), 16, 0, 0); } while (0)
#define PG8_LDA(dst, b, h) do { _Pragma("unroll") for (int m = 0; m < 4; ++m) _Pragma("unroll") for (int k = 0; k < 2; ++k) dst[m][k] = *(const PG8_LAS bf16x8*)(lds + PG8_SA(b, h) + aoff + m * 2048 + k * 1024); } while (0)
#define PG8_LDB(dst, b, h) do { _Pragma("unroll") for (int n = 0; n < 2; ++n) _Pragma("unroll") for (int k = 0; k < 2; ++k) dst[n][k] = *(const PG8_LAS bf16x8*)(lds + PG8_SB(b, h) + boff + n * 2048 + k * 1024); } while (0)
#define PG8_MMA(ai, bj, At, Bt) do { __builtin_amdgcn_s_setprio(1); _Pragma("unroll") for (int m = 0; m < 4; ++m) _Pragma("unroll") for (int n = 0; n < 2; ++n) _Pragma("unroll") for (int k = 0; k < 2; ++k) \
        acc[ai][bj][m][n] = __builtin_amdgcn_mfma_f32_16x16x32_bf16(Bt[n][k], At[m][k], acc[ai][bj][m][n], 0, 0, 0); __builtin_amdgcn_s_setprio(0); } while (0)
#define PG8_WAIT_V(n) asm volatile("s_waitcnt vmcnt(" #n ")" ::: "memory")
#define PG8_WAIT_L(n) asm volatile("s_waitcnt lgkmcnt(" #n ")" ::: "memory")
#define PG8_BAR __builtin_amdgcn_s_barrier()
#define PG8_SCHED __builtin_amdgcn_sched_barrier(0)
    Unit cur, nxt; int ui = 0;
    if (!S.next(0, cur)) return;
    f32x4 acc[2][2][4][2];
#pragma unroll
    for (int a = 0; a < 2; ++a)
#pragma unroll
        for (int b = 0; b < 2; ++b)
#pragma unroll
            for (int m = 0; m < 4; ++m)
#pragma unroll
                for (int n = 0; n < 2; ++n) acc[a][b][m][n] = (f32x4){0.f, 0.f, 0.f, 0.f};
    bf16x8 At[4][2], B0[2][2], B1[2][2];
    const char* cA = (const char*)g.A + (size_t)cur.pm * tstep; const char* cB = (const char*)g.Bt + (size_t)cur.pn * tstep;
    S.a_ready(cur);
    if constexpr (SP2) {
        PG8_STAGE(PG8_SB(0, 0), cB, voffB); PG8_STAGE(PG8_SB(0, 1), cB + hstep, voffB); PG8_STAGE(PG8_SA(0, 0), cA, voffA); PG8_STAGE(PG8_SA(0, 1), cA + hstep, voffA);
        if (wr == 1) PG8_BAR;
        PG8_WAIT_V(2); PG8_BAR;
        PG8_STAGE(PG8_SB(1, 0), cB + kstep, voffB); PG8_STAGE(PG8_SA(1, 0), cA + kstep, voffA); PG8_STAGE(PG8_SB(1, 1), cB + hstep + kstep, voffB);
        PG8_WAIT_V(6); PG8_BAR;
    } else {
        PG8_STAGE(PG8_SB(0, 0), cB, voffB); PG8_STAGE(PG8_SA(0, 0), cA, voffA); PG8_STAGE(PG8_SB(0, 1), cB + hstep, voffB); PG8_STAGE(PG8_SA(0, 1), cA + hstep, voffA);
        if (wr == 1) PG8_BAR;
        PG8_WAIT_V(4); PG8_BAR;
        PG8_STAGE(PG8_SB(1, 0), cB + kstep, voffB); PG8_STAGE(PG8_SA(1, 0), cA + kstep, voffA); PG8_STAGE(PG8_SB(1, 1), cB + hstep + kstep, voffB);
        PG8_WAIT_V(6); PG8_BAR;
    }
    for (;;) {
        const bool has_next = S.next(ui + 1, nxt);
        const char* nA = has_next ? (const char*)g.A + (size_t)nxt.pm * tstep : cA; const char* nB = has_next ? (const char*)g.Bt + (size_t)nxt.pn * tstep : cB;
        for (int t = 0; t < nt; t += 2) {
            const bool last = (t == nt - 2);
            const char* a1 = cA + (size_t)(t + 1) * kstep;
            const char* a2 = last ? nA : cA + (size_t)(t + 2) * kstep; const char* b2 = last ? nB : cB + (size_t)(t + 2) * kstep;
            const char* a3 = a2 + kstep; const char* b3 = b2 + kstep;
            if (last && has_next) S.a_ready(nxt);
            if constexpr (SP2) {
            PG8_LDB(B0, 0, 0); PG8_LDB(B1, 0, 1); PG8_SCHED; PG8_LDA(At, 0, 0); PG8_STAGE(PG8_SA(1, 1), a1 + hstep, voffA);
            PG8_WAIT_V(8); PG8_WAIT_L(0); PG8_BAR; PG8_MMA(0, 0, At, B0); PG8_MMA(0, 1, At, B1); PG8_BAR; PG8_SCHED;
            PG8_LDA(At, 0, 1); PG8_STAGE(PG8_SB(0, 0), b2, voffB); PG8_STAGE(PG8_SB(0, 1), b2 + hstep, voffB); PG8_STAGE(PG8_SA(0, 0), a2, voffA);
            PG8_WAIT_V(8); PG8_WAIT_L(0); PG8_BAR; PG8_MMA(1, 0, At, B0); PG8_MMA(1, 1, At, B1); PG8_BAR; PG8_SCHED;
            PG8_LDB(B0, 1, 0); PG8_LDB(B1, 1, 1); PG8_SCHED; PG8_LDA(At, 1, 0); PG8_STAGE(PG8_SA(0, 1), a2 + hstep, voffA);
            PG8_WAIT_V(8); PG8_WAIT_L(0); PG8_BAR; PG8_MMA(0, 0, At, B0); PG8_MMA(0, 1, At, B1); PG8_BAR; PG8_SCHED;
            PG8_LDA(At, 1, 1); PG8_STAGE(PG8_SB(1, 0), b3, voffB); PG8_STAGE(PG8_SB(1, 1), b3 + hstep, voffB); PG8_STAGE(PG8_SA(1, 0), a3, voffA);
            PG8_WAIT_V(8); PG8_WAIT_L(0); PG8_BAR; PG8_MMA(1, 0, At, B0); PG8_MMA(1, 1, At, B1); PG8_BAR; PG8_SCHED;
            } else {
            PG8_LDB(B0, 0, 0); PG8_SCHED; PG8_LDA(At, 0, 0); PG8_STAGE(PG8_SA(1, 1), a1 + hstep, voffA);
            PG8_WAIT_L(8); PG8_BAR; PG8_WAIT_L(0); PG8_MMA(0, 0, At, B0); PG8_BAR; PG8_SCHED;
            PG8_LDB(B1, 0, 1); PG8_STAGE(PG8_SB(0, 0), b2, voffB);
            PG8_BAR; PG8_WAIT_L(0); PG8_MMA(0, 1, At, B1); PG8_BAR;
            PG8_LDA(At, 0, 1); PG8_STAGE(PG8_SA(0, 0), a2, voffA);
            PG8_BAR; PG8_WAIT_L(0); PG8_MMA(1, 0, At, B0); PG8_BAR; PG8_SCHED;
            PG8_STAGE(PG8_SB(0, 1), b2 + hstep, voffB);
            PG8_WAIT_V(6); PG8_BAR; PG8_MMA(1, 1, At, B1); PG8_BAR;
            PG8_LDB(B0, 1, 0); PG8_SCHED; PG8_LDA(At, 1, 0); PG8_STAGE(PG8_SA(0, 1), a2 + hstep, voffA);
            PG8_WAIT_L(8); PG8_BAR; PG8_WAIT_L(0); PG8_MMA(0, 0, At, B0); PG8_BAR; PG8_SCHED;
            PG8_LDB(B1, 1, 1); PG8_STAGE(PG8_SB(1, 0), b3, voffB);
            PG8_BAR; PG8_WAIT_L(0); PG8_MMA(0, 1, At, B1); PG8_BAR;
            PG8_LDA(At, 1, 1); PG8_STAGE(PG8_SA(1, 0), a3, voffA);
            PG8_BAR; PG8_WAIT_L(0); PG8_MMA(1, 0, At, B0); PG8_BAR; PG8_SCHED;
            PG8_STAGE(PG8_SB(1, 1), b3 + hstep, voffB);
            PG8_WAIT_V(6); PG8_BAR; PG8_MMA(1, 1, At, B1); PG8_BAR;
            }
        }
        if constexpr (ALIGN_EPI) { if (wr == 0) PG8_BAR; }
        if constexpr (!Epi::AFTER_DRAIN) { E(acc, cur, wr, wc, fr, fq); S.done(cur); }
        if (!has_next) break;
#pragma unroll
        for (int a = 0; a < 2; ++a)
#pragma unroll
            for (int b = 0; b < 2; ++b)
#pragma unroll
                for (int m = 0; m < 4; ++m)
#pragma unroll
                    for (int n = 0; n < 2; ++n) acc[a][b][m][n] = (f32x4){0.f, 0.f, 0.f, 0.f};
        cur = nxt; cA = nA; cB = nB; ++ui;
        if constexpr (ALIGN_EPI) { if (wr == 1) PG8_BAR; }
    }
    PG8_WAIT_V(0);
    if constexpr (!ALIGN_EPI) { if (wr == 0) PG8_BAR; }
    PG8_BAR;
    if constexpr (Epi::AFTER_DRAIN) { E.fused(acc, cur, wr, wc, fr, fq, lds, wid, lane); S.done(cur); }
#undef PG8_SA
#undef PG8_SB
#undef PG8_STAGE
#undef PG8_LDA
#undef PG8_LDB
#undef PG8_MMA
#undef PG8_WAIT_V
#undef PG8_WAIT_L
#undef PG8_BAR
#undef PG8_SCHED
}
}
constexpr int S_ = 16384, D_ = 1024, FF_ = 2816, NIN_ = 7448, NINP_ = 7680;
constexpr int NTHREADS = 512;
constexpr size_t MiB = 1u << 20;
constexpr size_t WS_CTL = 0;
constexpr size_t WS_MOD = 1 * MiB;
constexpr size_t WS_ROPE = 2 * MiB;
constexpr size_t WS_W = 6 * MiB;
constexpr size_t W_FFIN0 = 0, W_FFIN1 = 11 * MiB, W_FFOUT0 = 22 * MiB, W_FFOUT1 = 27 * MiB + MiB / 2, W_IN = 33 * MiB, W_BATT = 48 * MiB, W_BDN = 48 * MiB + MiB / 2, W_OUT = 50 * MiB;
constexpr size_t WS_H = 58 * MiB;
constexpr size_t WS_R = 90 * MiB;
constexpr size_t R_ACT = 0, R_Y = 88 * MiB;
constexpr size_t R_PA = 0, R_QKVD = 0, R_PG = 0, R_PD = 72 * MiB, R_TINV = 72 * MiB, R_ODIR1 = 120 * MiB, R_ODN = 72 * MiB, R_T1 = 96 * MiB, R_PZ = 144 * MiB, R_AB = 168 * MiB, R_GB = 170 * MiB,
                 R_OATT = 172 * MiB, R_ATTN = 180 * MiB, R_Y2 = 160 * MiB, R_OG = 228 * MiB, R_LSE = 252 * MiB, R_ODIR0 = 228 * MiB, R_VEC = 253 * MiB;
constexpr size_t WS_END = 352 * MiB;

typedef unsigned short bf16;
typedef unsigned v4u __attribute__((ext_vector_type(4)));
typedef unsigned v2u __attribute__((ext_vector_type(2)));
typedef float f32x4 __attribute__((ext_vector_type(4)));
typedef float f32x2 __attribute__((ext_vector_type(2)));
#define LAS __attribute__((address_space(3)))

__device__ __forceinline__ unsigned f2bf(float f) { unsigned u = __builtin_bit_cast(unsigned, f); return (u + 0x7fffu + ((u >> 16) & 1u)) >> 16; }
__device__ __forceinline__ unsigned pk2(float lo, float hi) { return f2bf(lo) | (f2bf(hi) << 16); }
__device__ __forceinline__ float bf2f(unsigned short b) { return __builtin_bit_cast(float, (unsigned)b << 16); }
__device__ __forceinline__ float bflo(unsigned w) { return __builtin_bit_cast(float, w << 16); }
__device__ __forceinline__ float bfhi(unsigned w) { return __builtin_bit_cast(float, w & 0xffff0000u); }
__device__ __forceinline__ float wave_sum(float v) {
#pragma unroll
    for (int o = 1; o < 64; o <<= 1) v += __shfl_xor(v, o);
    return v;
}
__device__ __forceinline__ float sigmoidf_(float x) { return 1.0f / (1.0f + __expf(-x)); }
__device__ __forceinline__ float siluf_(float x) { return x / (1.0f + __expf(-x)); }

namespace pg8 {
struct EpiSwiglu {
    static constexpr bool PERM = true, AFTER_DRAIN = false;
    bf16_t* O; int ldc; int pad_;
    __device__ __forceinline__ void operator()(const f32x4 (&acc)[2][2][4][2], const Unit& u, int wr, int wc, int fr, int fq) const {
        const int row0 = u.pm * BM + wr * 64 + fr, col0 = u.pn * 128 + wc * 32 + 8 * fq;
#pragma unroll
        for (int ai = 0; ai < 2; ++ai)
#pragma unroll
            for (int m = 0; m < 4; ++m) {
                bf16_t* rowp = O + (size_t)(row0 + ai * HALF + m * 16) * ldc + col0;
                float v[8];
#pragma unroll
                for (int n = 0; n < 2; ++n)
#pragma unroll
                    for (int e = 0; e < 4; ++e) { const float g = acc[ai][0][m][n][e], uu = acc[ai][1][m][n][e]; v[n * 4 + e] = g * __builtin_amdgcn_rcpf(1.0f + __expf(-g)) * uu; }
                u32x4 w; w.x = cvt_pk_bf16(v[0], v[1]); w.y = cvt_pk_bf16(v[2], v[3]); w.z = cvt_pk_bf16(v[4], v[5]); w.w = cvt_pk_bf16(v[6], v[7]);
                *(u32x4*)rowp = w;
            }
    }
};
struct EpiBf16P {
    static constexpr bool PERM = true, AFTER_DRAIN = false;
    bf16_t* O; int ldc; int pad_;
    __device__ __forceinline__ void operator()(const f32x4 (&acc)[2][2][4][2], const Unit& u, int wr, int wc, int fr, int fq) const {
        const int row0 = u.pm * BM + wr * 64 + fr, col0 = u.pn * BM + wc * 32 + 8 * fq;
#pragma unroll
        for (int ai = 0; ai < 2; ++ai)
#pragma unroll
            for (int m = 0; m < 4; ++m) {
                bf16_t* rowp = O + (size_t)(row0 + ai * HALF + m * 16) * ldc + col0;
#pragma unroll
                for (int bj = 0; bj < 2; ++bj) { const f32x4 v0 = acc[ai][bj][m][0], v1 = acc[ai][bj][m][1];
                    u32x4 w; w.x = cvt_pk_bf16(v0[0], v0[1]); w.y = cvt_pk_bf16(v0[2], v0[3]); w.z = cvt_pk_bf16(v1[0], v1[1]); w.w = cvt_pk_bf16(v1[2], v1[3]);
                    *(u32x4*)(rowp + bj * HALF) = w; }
            }
    }
};
struct EpiF32 {
    static constexpr bool PERM = false, AFTER_DRAIN = false;
    float* O; int ldc; int pad_;
    __device__ __forceinline__ void operator()(const f32x4 (&acc)[2][2][4][2], const Unit& u, int wr, int wc, int fr, int fq) const {
        const int row0 = u.pm * BM + wr * 64 + fr, col0 = u.pn * BM + wc * 32 + 4 * fq;
#pragma unroll
        for (int ai = 0; ai < 2; ++ai)
#pragma unroll
            for (int m = 0; m < 4; ++m) {
                float* rowp = O + (size_t)(row0 + ai * HALF + m * 16) * ldc + col0;
#pragma unroll
                for (int bj = 0; bj < 2; ++bj)
#pragma unroll
                    for (int n = 0; n < 2; ++n) *(f32x4*)(rowp + bj * HALF + n * 16) = acc[ai][bj][m][n];
            }
    }
};
struct EpiInProj {
    static constexpr bool PERM = true, AFTER_DRAIN = false;
    bf16_t* PA; bf16_t* PD; bf16_t* PZ; float* AB;
    __device__ __forceinline__ void operator()(const f32x4 (&acc)[2][2][4][2], const Unit& u, int wr, int wc, int fr, int fq) const {
        const int row0 = u.pm * BM + wr * 64 + fr;
        if (u.pn == 21) {
            if (wc == 0) {
#pragma unroll
                for (int ai = 0; ai < 2; ++ai)
#pragma unroll
                    for (int m = 0; m < 4; ++m) {
                        float* rowp = AB + (size_t)(row0 + ai * HALF + m * 16) * 32 + 8 * fq;
                        *(f32x4*)rowp = acc[ai][0][m][0]; *(f32x4*)(rowp + 4) = acc[ai][0][m][1];
                    }
            }
            return;
        }
        bf16_t* base; int ldc, ct;
        if (u.pn < 9) { base = PA; ldc = 2304; ct = u.pn; } else if (u.pn < 18) { base = PD; ldc = 2304; ct = u.pn - 9; } else { base = PZ; ldc = 768; ct = u.pn - 18; }
        const int col0 = ct * BM + wc * 32 + 8 * fq;
#pragma unroll
        for (int ai = 0; ai < 2; ++ai)
#pragma unroll
            for (int m = 0; m < 4; ++m) {
                bf16_t* rowp = base + (size_t)(row0 + ai * HALF + m * 16) * ldc + col0;
#pragma unroll
                for (int bj = 0; bj < 2; ++bj) { const f32x4 v0 = acc[ai][bj][m][0], v1 = acc[ai][bj][m][1];
                    u32x4 w; w.x = cvt_pk_bf16(v0[0], v0[1]); w.y = cvt_pk_bf16(v0[2], v0[3]); w.z = cvt_pk_bf16(v1[0], v1[1]); w.w = cvt_pk_bf16(v1[2], v1[3]);
                    *(u32x4*)(rowp + bj * HALF) = w; }
            }
    }
};
struct EpiGateF32 {
    static constexpr bool PERM = false, AFTER_DRAIN = false;
    float* O; const bf16_t* gate; int ldg; int pad_;
    __device__ __forceinline__ void operator()(const f32x4 (&acc)[2][2][4][2], const Unit& u, int wr, int wc, int fr, int fq) const {
        const int row0 = u.pm * BM + wr * 64 + fr, col0 = u.pn * BM + wc * 32 + 4 * fq;
#pragma unroll
        for (int ai = 0; ai < 2; ++ai)
#pragma unroll
            for (int m = 0; m < 4; ++m) {
                const size_t r = (size_t)(row0 + ai * HALF + m * 16);
#pragma unroll
                for (int bj = 0; bj < 2; ++bj)
#pragma unroll
                    for (int n = 0; n < 2; ++n) { const int c = col0 + bj * HALF + n * 16;
                        const v2u gw = *(const v2u*)(gate + r * ldg + c);
                        f32x4 a = acc[ai][bj][m][n];
                        a[0] *= sigmoidf_(bflo(gw.x)); a[1] *= sigmoidf_(bfhi(gw.x)); a[2] *= sigmoidf_(bflo(gw.y)); a[3] *= sigmoidf_(bfhi(gw.y));
                        *(f32x4*)(O + r * 1024 + c) = a; }
            }
    }
};
struct EpiGateAddBf16 {
    static constexpr bool PERM = false, AFTER_DRAIN = false;
    bf16_t* O; const float* T1; const bf16_t* gate; int ldg; int pad_;
    __device__ __forceinline__ void operator()(const f32x4 (&acc)[2][2][4][2], const Unit& u, int wr, int wc, int fr, int fq) const {
        const int row0 = u.pm * BM + wr * 64 + fr, col0 = u.pn * BM + wc * 32 + 4 * fq;
#pragma unroll
        for (int ai = 0; ai < 2; ++ai)
#pragma unroll
            for (int m = 0; m < 4; ++m) {
                const size_t r = (size_t)(row0 + ai * HALF + m * 16);
#pragma unroll
                for (int bj = 0; bj < 2; ++bj)
#pragma unroll
                    for (int n = 0; n < 2; ++n) { const int c = col0 + bj * HALF + n * 16;
                        const v2u gw = *(const v2u*)(gate + r * ldg + c);
                        const f32x4 t = *(const f32x4*)(T1 + r * 1024 + c);
                        f32x4 a = acc[ai][bj][m][n];
                        a[0] = t[0] + a[0] * sigmoidf_(bflo(gw.x)); a[1] = t[1] + a[1] * sigmoidf_(bfhi(gw.x)); a[2] = t[2] + a[2] * sigmoidf_(bflo(gw.y)); a[3] = t[3] + a[3] * sigmoidf_(bfhi(gw.y));
                        v2u w; w.x = cvt_pk_bf16(a[0], a[1]); w.y = cvt_pk_bf16(a[2], a[3]);
                        *(v2u*)(O + r * 1024 + c) = w; }
            }
    }
};
}


#define GAS __attribute__((address_space(1)))
struct Params { const float* in[17]; float* out; unsigned char* ws; };
#define XB_TMO      128
#define XB_XCNT(j)  (256  + 64 * (j))
#define XB_XSUB(j)  (1280 + 64 * (j))
#define XB_XGEN(j)  (2304 + 64 * (j))
#define XB_TOP      3328
#define XB_TOPGEN   3392
#define XCD_BAR_WORDS 3456
#define XB_SPIN_CAP (1u << 18)

__device__ __forceinline__ unsigned xb_ld(unsigned* p)              { return __hip_atomic_load(p, __ATOMIC_RELAXED, __HIP_MEMORY_SCOPE_AGENT); }
__device__ __forceinline__ unsigned xb_add(unsigned* p, unsigned v) { return __hip_atomic_fetch_add(p, v, __ATOMIC_RELAXED, __HIP_MEMORY_SCOPE_AGENT); }
__device__ __forceinline__ unsigned xb_xcc_id() { return (unsigned)__builtin_amdgcn_s_getreg((3 << 11) | 20) & 0xFu; }
#define XB_SPIN(cond, bar) do { unsigned _sp = 0; while (cond) { __builtin_amdgcn_s_sleep(1); \
    if ((++_sp & 255u) == 0u) { if (xb_ld(&(bar)[XB_TMO])) break; if (_sp > XB_SPIN_CAP) { atomicAdd(&(bar)[XB_TMO], 1u); break; } } } } while (0)

struct XcdBarrier {
    unsigned* bar; unsigned x;
    volatile LAS unsigned* st;
};

__device__ __forceinline__ XcdBarrier xcd_barrier_post(unsigned* bar, volatile LAS unsigned* st) {
    XcdBarrier b; b.bar = bar; b.x = xb_xcc_id(); b.st = st;
    if (threadIdx.x == 0) (void)xb_add(&bar[XB_XCNT(b.x)], 1u);
    return b;
}
__device__ __forceinline__ void xcd_barrier_complete(unsigned* bar, unsigned x, unsigned& nloc, unsigned& nx) {
    const unsigned G = gridDim.x * gridDim.y * gridDim.z;
    unsigned sum, cnt, mine, sp = 0u;
    for (;;) {
        sum = 0u; cnt = 0u; mine = 0u;
#pragma unroll
        for (unsigned j = 0; j < 16; ++j) { const unsigned c = xb_ld(&bar[XB_XCNT(j)]); sum += c; cnt += (c > 0u) ? 1u : 0u; mine = (j == x) ? c : mine; }
        if (sum == G) break;
        __builtin_amdgcn_s_sleep(1);
        if ((++sp & 255u) == 0u) { if (xb_ld(&bar[XB_TMO])) break; if (sp > XB_SPIN_CAP) { atomicAdd(&bar[XB_TMO], 1u); break; } }
    }
    nloc = mine > 0u ? mine : 1u; nx = cnt > 0u ? cnt : 1u;
}

__device__ __forceinline__ void xcd_barrier(const XcdBarrier& b, int wv) {
    const bool leader_thread = (wv == 0) && (lane_id_() == 0);
    asm volatile("s_waitcnt vmcnt(0)" ::: "memory");
    __syncthreads();
    if (leader_thread) {
        unsigned* bar = b.bar;
        __builtin_amdgcn_s_waitcnt(0);
        unsigned nloc = b.st[0], nx = b.st[1];
        if (nloc == 0u) { xcd_barrier_complete(bar, b.x, nloc, nx); b.st[0] = nloc; b.st[1] = nx; }
        const unsigned old = xb_add(&bar[XB_XSUB(b.x)], 1u);
        const unsigned gen = old / nloc;
        if (old + 1u == (gen + 1u) * nloc) {
            __builtin_amdgcn_fence(__ATOMIC_RELEASE, "agent");
            asm volatile("s_waitcnt vmcnt(0)" ::: "memory");
            const unsigned og = xb_add(&bar[XB_TOP], 1u);
            const unsigned tg = og / nx;
            if (og + 1u == (tg + 1u) * nx) xb_add(&bar[XB_TOPGEN], 1u);
            else XB_SPIN(xb_ld(&bar[XB_TOPGEN]) == tg, bar);
            __builtin_amdgcn_fence(__ATOMIC_ACQUIRE, "agent");
            xb_add(&bar[XB_XGEN(b.x)], 1u);
            asm volatile("s_waitcnt vmcnt(0)" ::: "memory");
        } else {
            XB_SPIN(xb_ld(&bar[XB_XGEN(b.x)]) == gen, bar);
            __builtin_amdgcn_fence(__ATOMIC_ACQUIRE, "agent");
            asm volatile("s_waitcnt vmcnt(0)" ::: "memory");
        }
    }
    __syncthreads();
}

typedef const __attribute__((address_space(4))) unsigned char* ka_t;
__device__ __forceinline__ ka_t ka_() { ka_t k = (ka_t)__builtin_amdgcn_kernarg_segment_ptr(); asm volatile("" : "+s"(k)); return k; }
#define PIN(i) ((const float*)(*(const __attribute__((address_space(4))) unsigned long long*)(ka_() + 8 * (i))))
#define POUT ((float*)(*(const __attribute__((address_space(4))) unsigned long long*)(ka_() + 136)))
#define PWS ((unsigned char*)(*(const __attribute__((address_space(4))) unsigned long long*)(ka_() + 144)))
#define BID ((int)blockIdx.x)
#define GSZ ((int)gridDim.x)
__device__ __forceinline__ int srcmap(int mode, int n) {
    if (mode == 0) return n;
    if (mode == 1) return (n >> 8) * 128 + (n & 127) + ((n >> 7) & 1) * 2816;
    if (n < 5400) return n;
    if (n < 5632) return -1;
    if (n < 6656) return 5400 + (n - 5632);
    return 6424 + (n - 6656);
}
__device__ __forceinline__ void conv_item(const float* W, bf16* WT, int K, int Nsrc, int Ndst, int mode, int item, float* scr, int lane) {
    const int nblk = Ndst / 32, kb = item / nblk, nb = item % nblk, k0 = 64 * kb, n0 = 32 * nb;
    const int sc = srcmap(mode, n0 + (lane & 31));
#pragma unroll 8
    for (int i = 0; i < 32; ++i) { const int kk = 2 * i + (lane >> 5); scr[kk * 33 + (lane & 31)] = sc >= 0 ? W[(size_t)(k0 + kk) * Nsrc + sc] : 0.f; }
    __builtin_amdgcn_s_waitcnt(0xc07f); __builtin_amdgcn_wave_barrier();
    const int c = lane & 7;
#pragma unroll
    for (int j = 0; j < 4; ++j) { const int n = (lane >> 3) + 8 * j; const float* s = scr + (8 * c) * 33 + n;
        v4u o; o.x = pk2(s[0 * 33], s[1 * 33]); o.y = pk2(s[2 * 33], s[3 * 33]); o.z = pk2(s[4 * 33], s[5 * 33]); o.w = pk2(s[6 * 33], s[7 * 33]);
        *(v4u*)(WT + (size_t)(n0 + n) * K + k0 + 8 * c) = o; }
    __builtin_amdgcn_s_waitcnt(0xc07f); __builtin_amdgcn_wave_barrier();
}
__device__ __forceinline__ void ph_convert(int l, unsigned char* lds, int wv) {
    int tid_ = wv * 64 + lane_id_(); asm volatile("" : "+v"(tid_)); const int lane = tid_ & 63, wave = tid_ >> 6;
    float* scr = (float*)lds + wave * (64 * 33);
    unsigned char* wb = PWS + WS_W;
    constexpr int I_FI = 16 * 176, I_FO = 44 * 32, I_IN = 16 * 240, I_BA = 4 * 32, I_BD = 12 * 32, I_O = 16 * 32;
    constexpr int NIT = 2 * I_FI + 2 * I_FO + I_IN + I_BA + I_BD + I_O;
    for (int it = BID * 8 + wave; it < NIT; it += GSZ * 8) {
        int r = it;
        if (r < 2 * I_FI) { const int f = r / I_FI; conv_item(PIN(7) + ((size_t)l * 2 + f) * 1024 * 5632, (bf16*)(wb + (f ? W_FFIN1 : W_FFIN0)), 1024, 5632, 5632, 1, r % I_FI, scr, lane); continue; } r -= 2 * I_FI;
        if (r < 2 * I_FO) { const int f = r / I_FO; conv_item(PIN(8) + ((size_t)l * 2 + f) * 2816 * 1024, (bf16*)(wb + (f ? W_FFOUT1 : W_FFOUT0)), 2816, 1024, 1024, 0, r % I_FO, scr, lane); continue; } r -= 2 * I_FO;
        if (r < I_IN) { conv_item(PIN(9) + (size_t)l * 1024 * NIN_, (bf16*)(wb + W_IN), 1024, NIN_, NINP_, 2, r, scr, lane); continue; } r -= I_IN;
        if (r < I_BA) { conv_item(PIN(14) + (size_t)l * 256 * 1024, (bf16*)(wb + W_BATT), 256, 1024, 1024, 0, r, scr, lane); continue; } r -= I_BA;
        if (r < I_BD) { conv_item(PIN(15) + (size_t)l * 768 * 1024, (bf16*)(wb + W_BDN), 768, 1024, 1024, 0, r, scr, lane); continue; } r -= I_BD;
        conv_item(PIN(16) + (size_t)l * 1024 * 1024, (bf16*)(wb + W_OUT), 1024, 1024, 1024, 0, r, scr, lane);
    }
}
__device__ __forceinline__ void ph_ada(unsigned char* lds, int wv) {
    float* red = (float*)(lds + 72 * 1024);
    int tid_ = wv * 64 + lane_id_(); asm volatile("" : "+v"(tid_)); const int lane = tid_ & 63, wave = tid_ >> 6;
    const float* c = PIN(1); const float* w_ada = PIN(3); const float* b_ada = PIN(4); float* mod = (float*)(PWS + WS_MOD);
    for (int u = BID; u < 2 * 144; u += GSZ) {
        const int l = u / 144, n = (u % 144) * 64 + lane;
        const float* W = w_ada + (size_t)l * 1024 * 9216 + n;
        float s = 0.f;
        for (int k = wave * 128; k < wave * 128 + 128; ++k) s += siluf_(c[k]) * W[(size_t)k * 9216];
        red[wave * 64 + lane] = s;
        __syncthreads();
        if (wave == 0) { float t = b_ada[l * 9216 + n];
#pragma unroll
            for (int w = 0; w < 8; ++w) t += red[w * 64 + lane];
            mod[l * 9216 + n] = t; }
        __syncthreads();
    }
}
__device__ const float ROPE_INV[32] = {1.000000000e+00f, 7.498942018e-01f, 5.623413324e-01f, 4.216965139e-01f, 3.162277639e-01f, 2.371373773e-01f, 1.778279394e-01f, 1.333521456e-01f, 1.000000015e-01f, 7.498942316e-02f, 5.623413250e-02f, 4.216964915e-02f, 3.162277490e-02f, 2.371373773e-02f, 1.778279431e-02f, 1.333521400e-02f, 9.999999776e-03f, 7.498942316e-03f, 5.623413250e-03f, 4.216964822e-03f, 3.162277630e-03f, 2.371373819e-03f, 1.778279431e-03f, 1.333521446e-03f, 1.000000047e-03f, 7.498941850e-04f, 5.623413017e-04f, 4.216965172e-04f, 3.162277571e-04f, 2.371373703e-04f, 1.778279402e-04f, 1.333521504e-04f};
__device__ __forceinline__ void ph_rope(int wv) {
    const int* pos = (const int*)PIN(2); float* tab = (float*)(PWS + WS_ROPE);
    int tid_ = wv * 64 + lane_id_(); asm volatile("" : "+v"(tid_));
    for (int idx = BID * NTHREADS + tid_; idx < S_ * 32; idx += GSZ * NTHREADS) {
        const int t = idx >> 5, i = idx & 31;
        const float inv = ROPE_INV[i];
        const float ang = (float)pos[t] * inv;
        float sn, cs; sincosf(ang, &sn, &cs);
        tab[idx] = cs; tab[S_ * 32 + idx] = sn;
    }
}
struct RowArgs { const float* xi; const float* y; float* xo; bf16* h; const float* wpost; const float* gate; const float* wpre; const float* shift; const float* scale; float coef; };
__device__ __forceinline__ void ph_rows(const RowArgs& a, int wv) {
    int tid_ = wv * 64 + lane_id_(); asm volatile("" : "+v"(tid_)); const int lane = tid_ & 63, wave = tid_ >> 6;
    for (int r = BID * 8 + wave; r < S_; r += GSZ * 8) {
        f32x4 x[4];
        const f32x4* xr = (const f32x4*)(a.xi + (size_t)r * D_) + lane;
#pragma unroll
        for (int j = 0; j < 4; ++j) x[j] = xr[64 * j];
        if (a.y) {
            f32x4 y[4]; float s = 0.f;
            const f32x4* yr = (const f32x4*)(a.y + (size_t)r * D_) + lane;
#pragma unroll
            for (int j = 0; j < 4; ++j) { y[j] = yr[64 * j]; s += (y[j].x * y[j].x + y[j].y * y[j].y) + (y[j].z * y[j].z + y[j].w * y[j].w); }
            const float rs = 1.0f / sqrtf(wave_sum(s) * (1.f / D_) + 1e-6f);
#pragma unroll
            for (int j = 0; j < 4; ++j) { const f32x4 wp = ((const f32x4*)a.wpost)[lane + 64 * j], g = ((const f32x4*)a.gate)[lane + 64 * j];
                x[j] = x[j] + a.coef * g * ((y[j] * rs) * wp); }
            f32x4* xw = (f32x4*)(a.xo + (size_t)r * D_) + lane;
#pragma unroll
            for (int j = 0; j < 4; ++j) xw[64 * j] = x[j];
        }
        if (a.h) {
            float s = 0.f;
#pragma unroll
            for (int j = 0; j < 4; ++j) s += (x[j].x * x[j].x + x[j].y * x[j].y) + (x[j].z * x[j].z + x[j].w * x[j].w);
            const float rs = 1.0f / sqrtf(wave_sum(s) * (1.f / D_) + 1e-6f);
            v2u* hw = (v2u*)(a.h + (size_t)r * D_) + lane;
#pragma unroll
            for (int j = 0; j < 4; ++j) { const f32x4 wp = ((const f32x4*)a.wpre)[lane + 64 * j], sc = ((const f32x4*)a.scale)[lane + 64 * j], sh = ((const f32x4*)a.shift)[lane + 64 * j];
                const f32x4 v = ((x[j] * rs) * wp) * (1.0f + sc) + sh;
                v2u w; w.x = pk2(v.x, v.y); w.y = pk2(v.z, v.w); hw[64 * j] = w; }
        }
    }
}
constexpr int ATT_PITCH = 68;
__device__ __forceinline__ void ph_attn_v1(const bf16* PA, const float* rope, bf16* OG, float* LSE, unsigned char* lds, int wv) {
    float* qs = (float*)lds; float* ks = qs + 64 * ATT_PITCH; float* vs = ks + 192 * ATT_PITCH;
    int tid_ = wv * 64 + lane_id_(); asm volatile("" : "+v"(tid_)); const int tid = tid_, lane = tid & 63, wave = tid >> 6;
    for (int u = BID; u < 3072; u += GSZ) {
        const int hg = u & 3, w = (u >> 2) & 255, gi = u >> 10;
        const int dil = 1 << (2 * gi), L = S_ / dil, r = w % dil, nb = w / dil, head = gi * 4 + hg;
        __syncthreads();
        for (int rr = wave; rr < 448; rr += 8) {
            int mm, colbase; float* dst; bool rot; float sc = 1.f;
            if (rr < 64) { mm = nb * 64 + rr; colbase = head * 64; dst = qs + rr * ATT_PITCH; rot = true; sc = 0.125f; }
            else if (rr < 256) { mm = nb * 64 - 64 + (rr - 64); colbase = 768 + head * 64; dst = ks + (rr - 64) * ATT_PITCH; rot = true; }
            else { mm = nb * 64 - 64 + (rr - 256); colbase = 1536 + head * 64; dst = vs + (rr - 256) * ATT_PITCH; rot = false; }
            float val = 0.f;
            if (mm >= 0 && mm < L) {
                const int tok = mm * dil + r;
                val = bf2f(PA[(size_t)tok * 2304 + colbase + lane]);
                if (rot) {
                    const float other = __shfl_xor(val, 32);
                    const float cs = rope[tok * 32 + (lane & 31)], sn = rope[S_ * 32 + tok * 32 + (lane & 31)];
                    val = (lane < 32) ? (val * cs - other * sn) : (val * cs + other * sn);
                }
            }
            dst[lane] = val * sc;
        }
        __syncthreads();
        const int i = tid >> 3, part = tid & 7;
        float q[64], acc[64];
#pragma unroll
        for (int d = 0; d < 64; d += 4) { const f32x4 t = *(const f32x4*)(qs + i * ATT_PITCH + d); q[d] = t.x; q[d + 1] = t.y; q[d + 2] = t.z; q[d + 3] = t.w; }
#pragma unroll
        for (int d = 0; d < 64; ++d) acc[d] = 0.f;
        float m = -1e30f, l = 0.f;
        for (int jj = 0; jj < 24; ++jj) {
            const int j = part + 8 * jj, mm = nb * 64 - 64 + j, dj = j - 64 - i;
            const bool ok = (dj <= 64) && (dj >= -64) && (mm >= 0) && (mm < L);
            if (ok) {
                const float* kr = ks + j * ATT_PITCH; float s = 0.f;
#pragma unroll
                for (int d = 0; d < 64; d += 4) { const f32x4 t = *(const f32x4*)(kr + d); s += q[d] * t.x + q[d + 1] * t.y + q[d + 2] * t.z + q[d + 3] * t.w; }
                const float mn = fmaxf(m, s), al = __expf(m - mn), p = __expf(s - mn);
                l = l * al + p; m = mn;
                const float* vr = vs + j * ATT_PITCH;
#pragma unroll
                for (int d = 0; d < 64; d += 4) { const f32x4 t = *(const f32x4*)(vr + d);
                    acc[d] = acc[d] * al + p * t.x; acc[d + 1] = acc[d + 1] * al + p * t.y; acc[d + 2] = acc[d + 2] * al + p * t.z; acc[d + 3] = acc[d + 3] * al + p * t.w; }
            }
        }
        float mt = fmaxf(m, __shfl_xor(m, 1)); mt = fmaxf(mt, __shfl_xor(mt, 2)); mt = fmaxf(mt, __shfl_xor(mt, 4));
        const float f = __expf(m - mt);
        l *= f; l += __shfl_xor(l, 1); l += __shfl_xor(l, 2); l += __shfl_xor(l, 4);
#pragma unroll
        for (int d = 0; d < 64; ++d) acc[d] *= f;
        const bool b2 = part & 4, b1 = part & 2, b0 = part & 1;
        float r32[32], r16[16], r8[8];
#pragma unroll
        for (int d = 0; d < 32; ++d) { const float keep = b2 ? acc[32 + d] : acc[d], send = b2 ? acc[d] : acc[32 + d]; r32[d] = keep + __shfl_xor(send, 4); }
#pragma unroll
        for (int d = 0; d < 16; ++d) { const float keep = b1 ? r32[16 + d] : r32[d], send = b1 ? r32[d] : r32[16 + d]; r16[d] = keep + __shfl_xor(send, 2); }
#pragma unroll
        for (int d = 0; d < 8; ++d) { const float keep = b0 ? r16[8 + d] : r16[d], send = b0 ? r16[d] : r16[8 + d]; r8[d] = keep + __shfl_xor(send, 1); }
        const float il = 1.0f / l;
        const int tok = (nb * 64 + i) * dil + r;
        v4u o; o.x = pk2(r8[0] * il, r8[1] * il); o.y = pk2(r8[2] * il, r8[3] * il); o.z = pk2(r8[4] * il, r8[5] * il); o.w = pk2(r8[6] * il, r8[7] * il);
        *(v4u*)(OG + ((size_t)gi * S_ + tok) * 256 + hg * 64 + part * 8) = o;
        if (part == 0) LSE[((size_t)gi * S_ + tok) * 4 + hg] = mt + logf(l);
    }
}

__device__ __forceinline__ void ph_dnprep(const bf16* PD, const float* AB, const float* convw, const float* a_log, const float* dt_bias, bf16* QKVd, float* GB, const bf16* OG, const float* LSE, bf16* OATT, int wv) {
    int tid_ = wv * 64 + lane_id_(); asm volatile("" : "+v"(tid_)); const int tid = tid_, lane = tid_ & 63, wave = tid_ >> 6;
    for (int it = BID * 8 + wave; it < 1024 * 5; it += GSZ * 8) {
        const int tb = it / 5, sg = it % 5, c0 = sg * 512 + lane * 8, t0 = tb * 16;
        if (c0 < 2304) {
            const int seg = c0 >> 7;
            float cw[5][8];
#pragma unroll
            for (int j = 0; j < 5; ++j) { const f32x4 a = *(const f32x4*)(convw + j * 2304 + c0), b = *(const f32x4*)(convw + j * 2304 + c0 + 4);
                cw[j][0] = a.x; cw[j][1] = a.y; cw[j][2] = a.z; cw[j][3] = a.w; cw[j][4] = b.x; cw[j][5] = b.y; cw[j][6] = b.z; cw[j][7] = b.w; }
            v4u win[5];
#pragma unroll
            for (int j = 0; j < 4; ++j) { const int tt = t0 + j - 2; win[j + 1] = (tt >= 0) ? *(const v4u*)(PD + (size_t)tt * 2304 + c0) : (v4u){0u, 0u, 0u, 0u}; }
#pragma unroll
            for (int i = 0; i < 16; ++i) {
#pragma unroll
                for (int j = 0; j < 4; ++j) win[j] = win[j + 1];
                { const int tt = t0 + i + 2; win[4] = (tt < S_) ? *(const v4u*)(PD + (size_t)tt * 2304 + c0) : (v4u){0u, 0u, 0u, 0u}; }
                float a[8];
#pragma unroll
                for (int e = 0; e < 8; ++e) a[e] = 0.f;
#pragma unroll
                for (int j = 0; j < 5; ++j) { const unsigned wx[4] = {win[j].x, win[j].y, win[j].z, win[j].w};
#pragma unroll
                    for (int e = 0; e < 4; ++e) { a[2 * e] += bflo(wx[e]) * cw[j][2 * e]; a[2 * e + 1] += bfhi(wx[e]) * cw[j][2 * e + 1]; } }
                float ss = 0.f;
#pragma unroll
                for (int e = 0; e < 8; ++e) { a[e] = a[e] * __builtin_amdgcn_rcpf(1.0f + __expf(-a[e])); ss += a[e] * a[e]; }
                if (seg < 12) {
                    ss += __shfl_xor(ss, 1); ss += __shfl_xor(ss, 2); ss += __shfl_xor(ss, 4); ss += __shfl_xor(ss, 8);
                    const float sc = (1.0f / sqrtf(ss + 1e-6f)) * (seg < 6 ? 0.08838834764831845f : 1.0f);
#pragma unroll
                    for (int e = 0; e < 8; ++e) a[e] *= sc;
                }
                v4u o; o.x = pk2(a[0], a[1]); o.y = pk2(a[2], a[3]); o.z = pk2(a[4], a[5]); o.w = pk2(a[6], a[7]);
                *(v4u*)(QKVd + (size_t)(t0 + i) * 2304 + c0) = o;
            }
        }
    }
    for (int e = BID * NTHREADS + tid; e < S_ * 12; e += GSZ * NTHREADS) {
        const int t = e / 12, idx = e % 12;
        const float braw = AB[(size_t)t * 32 + idx], araw = AB[(size_t)t * 32 + 12 + idx];
        const float x = araw + dt_bias[idx];
        const float sp = fmaxf(x, 0.f) + log1pf(expf(-fabsf(x)));
        GB[(size_t)idx * S_ + t] = -expf(a_log[idx]) * sp;
        GB[(size_t)(12 + idx) * S_ + t] = 1.0f / (1.0f + expf(-braw));
    }
    for (int t = BID * 8 + wave; t < S_; t += GSZ * 8) {
        const int ch = 4 * lane, hg = lane >> 4;
        const float l0 = LSE[(size_t)t * 4 + hg], l1 = LSE[((size_t)S_ + t) * 4 + hg], l2 = LSE[((size_t)2 * S_ + t) * 4 + hg];
        const float mx = fmaxf(l0, fmaxf(l1, l2));
        float w0 = expf(l0 - mx), w1 = expf(l1 - mx), w2 = expf(l2 - mx);
        const float inv = 1.0f / (w0 + w1 + w2); w0 *= inv; w1 *= inv; w2 *= inv;
        const v2u a = *(const v2u*)(OG + (size_t)t * 256 + ch), b = *(const v2u*)(OG + ((size_t)S_ + t) * 256 + ch), cc = *(const v2u*)(OG + ((size_t)2 * S_ + t) * 256 + ch);
        v2u o;
        o.x = pk2(w0 * bflo(a.x) + w1 * bflo(b.x) + w2 * bflo(cc.x), w0 * bfhi(a.x) + w1 * bfhi(b.x) + w2 * bfhi(cc.x));
        o.y = pk2(w0 * bflo(a.y) + w1 * bflo(b.y) + w2 * bflo(cc.y), w0 * bfhi(a.y) + w1 * bfhi(b.y) + w2 * bfhi(cc.y));
        *(v2u*)(OATT + (size_t)t * 256 + ch) = o;
    }
}

__device__ __forceinline__ void ph_final(const bf16* ODIR0, const bf16* ODIR1, const bf16* PZ, const float* dnw, bf16* ODN, int wv) {
    int tid_ = wv * 64 + lane_id_(); asm volatile("" : "+v"(tid_)); const int lane = tid_ & 63, wave = tid_ >> 6;
    for (int t = BID * 8 + wave; t < S_; t += GSZ * 8) {
#pragma unroll
        for (int h = 0; h < 6; ++h) {
            const int c = h * 128 + 2 * lane;
            const unsigned wf = *(const unsigned*)(ODIR0 + (size_t)t * 768 + c), wb = *(const unsigned*)(ODIR1 + (size_t)t * 768 + c);
            float o0 = bflo(wf) + bflo(wb), o1 = bfhi(wf) + bfhi(wb);
            const float ms = wave_sum(o0 * o0 + o1 * o1) * (1.0f / 128.0f);
            const float sc = 1.0f / sqrtf(ms + 1e-6f);
            const unsigned zw = *(const unsigned*)(PZ + (size_t)t * 768 + c);
            const f32x2 nw = *(const f32x2*)(dnw + 2 * lane);
            o0 = o0 * sc * nw.x * siluf_(bflo(zw)); o1 = o1 * sc * nw.y * siluf_(bfhi(zw));
            *(unsigned*)(ODN + (size_t)t * 768 + c) = pk2(o0, o1);
        }
    }
}
typedef short bf16x8_t __attribute__((ext_vector_type(8)));
typedef short s16x4_t __attribute__((ext_vector_type(4)));
#define MFMA16(a, b, c) __builtin_amdgcn_mfma_f32_16x16x32_bf16((a), (b), (c), 0, 0, 0)

__device__ __forceinline__ void ph_dn_pre(const bf16* QKVd, const float* GB, bf16* TINV, bf16* ATTN, float* VEC, unsigned char* lds, int wv) {
    int tid_ = wv * 64 + lane_id_(); asm volatile("" : "+v"(tid_));
    const int tid = tid_, lane = tid & 63, g = lane >> 4, m16 = lane & 15;
    float* GR = (float*)lds; float* Ms = GR + 2 * 64 * 65; float* Gs = Ms + 2 * 64 * 68; float* Bs = Gs + 128;
    for (int u = BID; u < 1536; u += GSZ) {
        const int n = u / 6, h = u % 6;
        __syncthreads();
        {
            const int kind = wv >> 2, mt = wv & 3;
            const bf16* arow = QKVd + (size_t)(64 * n + 16 * mt + m16) * 2304 + (kind ? 0 : 768) + h * 128 + 8 * g;
            bf16x8_t a[4];
#pragma unroll
            for (int ks = 0; ks < 4; ++ks) a[ks] = *(const bf16x8_t*)(arow + 32 * ks);
#pragma unroll
            for (int nt = 0; nt < 4; ++nt) {
                const bf16* brow = QKVd + (size_t)(64 * n + 16 * nt + m16) * 2304 + 768 + h * 128 + 8 * g;
                f32x4 acc = {0.f, 0.f, 0.f, 0.f};
#pragma unroll
                for (int ks = 0; ks < 4; ++ks) acc = MFMA16(a[ks], *(const bf16x8_t*)(brow + 32 * ks), acc);
#pragma unroll
                for (int rg = 0; rg < 4; ++rg) GR[kind * 64 * 65 + (16 * mt + 4 * g + rg) * 65 + 16 * nt + m16] = acc[rg];
            }
        }
        if ((wv & 3) == 0) {
            const int d = wv >> 2, tok = 64 * n + (d ? 63 - lane : lane);
            float gv = GB[(size_t)(d * 6 + h) * S_ + tok]; const float be = GB[(size_t)(12 + d * 6 + h) * S_ + tok];
#pragma unroll
            for (int o = 1; o < 64; o <<= 1) { const float t = __shfl_up(gv, o); if (lane >= o) gv += t; }
            const float gl = __shfl(gv, 63);
            Gs[d * 64 + lane] = gv; Bs[d * 64 + lane] = be;
            float* vec = VEC + (size_t)(u * 2 + d) * 256;
            vec[lane] = __expf(gv); vec[64 + lane] = be; vec[128 + lane] = __expf(gl - gv); vec[192 + lane] = __expf(gl);
        }
        __syncthreads();
        {
            const int d = wv >> 2, tl = tid & 255, i = tl >> 2, jq = tl & 3, ii = d ? 63 - i : i;
            const float Gi = Gs[d * 64 + i], bi = Bs[d * 64 + i];
            unsigned pk[8];
#pragma unroll
            for (int jj = 0; jj < 16; jj += 2) {
                float at[2];
#pragma unroll
                for (int e = 0; e < 2; ++e) {
                    const int j = 16 * jq + jj + e, jx = d ? 63 - j : j;
                    const float dec = (j <= i) ? __expf(Gi - Gs[d * 64 + j]) : 0.f;
                    const float kk = GR[ii * 65 + jx], qk = GR[64 * 65 + ii * 65 + jx];
                    Ms[d * 64 * 68 + i * 68 + j] = (j < i) ? bi * kk * dec : 0.f;
                    at[e] = (j <= i) ? qk * dec : 0.f;
                }
                pk[jj >> 1] = pk2(at[0], at[1]);
            }
            v4u* dst = (v4u*)(ATTN + ((size_t)(u * 2 + d) * 64 + i) * 64 + 16 * jq);
            v4u o0; o0.x = pk[0]; o0.y = pk[1]; o0.z = pk[2]; o0.w = pk[3]; v4u o1; o1.x = pk[4]; o1.y = pk[5]; o1.z = pk[6]; o1.w = pk[7];
            dst[0] = o0; dst[1] = o1;
        }
        __syncthreads();
        if ((wv & 3) == 0) {
            const int d = wv >> 2, c = lane; const float* Md = Ms + d * 64 * 68;
            float x[64];
            x[0] = (c == 0) ? 1.f : 0.f;
#pragma unroll
            for (int i = 1; i < 64; ++i) {
                f32x4 mr[16];
#pragma unroll
                for (int j0 = 0; j0 < i; j0 += 4) mr[j0 >> 2] = *(const f32x4*)(Md + i * 68 + j0);
                float s0 = (i == c) ? 1.f : 0.f, s1 = 0.f, s2 = 0.f, s3 = 0.f;
#pragma unroll
                for (int j0 = 0; j0 < i; j0 += 4) { const f32x4 mv = mr[j0 >> 2];
                    s0 -= mv.x * x[j0]; if (j0 + 1 < i) s1 -= mv.y * x[j0 + 1]; if (j0 + 2 < i) s2 -= mv.z * x[j0 + 2]; if (j0 + 3 < i) s3 -= mv.w * x[j0 + 3]; }
                x[i] = (s0 + s1) + (s2 + s3);
            }
            bf16* outp = TINV + (size_t)(u * 2 + d) * 4096 + c;
#pragma unroll
            for (int i = 0; i < 64; ++i) outp[i * 64] = (bf16)f2bf(x[i]);
        }
    }
}

constexpr int SC_KT = 0, SC_QT = 17408, SC_TI = 34816, SC_AT = 44032, SC_VT = 53248, SC_VC = 55296, SC_BUF = 56320;
constexpr int SC_ST = 2 * SC_BUF, SC_RT = SC_ST + 4352, SC_VNT = SC_RT + 2304, SC_VST = SC_VNT + 2304, SC_END = SC_VST + 2304;
static_assert(SC_END <= 131072, "scan LDS");
constexpr int SC_AHEAD = 10;
__device__ __forceinline__ void ph_dn_scan(const bf16* QKVd, const bf16* TINV, const bf16* ATTN, const float* VEC, bf16* ODIR0, bf16* ODIR1, unsigned* prog, LAS unsigned char* lds, int wv) {
    const int bid = BID;
    int tid_ = wv * 64 + lane_id_(); asm volatile("" : "+v"(tid_));
    const int tid = tid_, lane = tid & 63, g = lane >> 4, m16 = lane & 15;
    if (bid >= 128) {
        if (bid < 136) {
            const int x = bid - 128;
#pragma unroll 1
            for (int s = 0; s < 256; ++s) {
#pragma unroll 1
                for (int pp = x; pp < 12; pp += 8) {
                    unsigned spins = 0;
                    while (s > (int)__hip_atomic_load(prog + 64 * pp, __ATOMIC_RELAXED, __HIP_MEMORY_SCOPE_AGENT) + SC_AHEAD) { __builtin_amdgcn_s_sleep(16); if (++spins > (1u << 20)) break; }
                    const int dd = pp / 6, hh = pp % 6, n = dd ? 255 - s : s; const size_t cb = (size_t)((n * 6 + hh) * 2 + dd);
                    const bf16* src;
                    if (tid < 128) src = (tid < 64 ? TINV : ATTN) + cb * 4096 + (tid & 63) * 64;
                    else { const int q = tid - 128, kind = q >> 7, row = (q & 127) >> 1, half = q & 1; src = QKVd + (size_t)(64 * n + row) * 2304 + (kind == 0 ? 768 : (kind == 1 ? 0 : 1536)) + hh * 128 + half * 64; }
                    unsigned dummy; asm volatile("global_load_dword %0, %1, off" : "=v"(dummy) : "v"(src) : "memory");
                }
            }
            asm volatile("s_waitcnt vmcnt(0)" ::: "memory");
        }
        return;
    }
    const int p = (bid & 7) + 8 * (bid >> 6), sl = (bid >> 3) & 7;
    if (p >= 12) return;
    const int d = p / 6, h = p % 6;
    bf16* ODIR = d ? ODIR1 : ODIR0;
    v4u pf[7];
#define SC_LOAD(step) do { const int n_ = d ? 255 - (step) : (step); const size_t cb_ = (size_t)((n_ * 6 + h) * 2 + d); \
        _Pragma("unroll") for (int k_ = 0; k_ < 7; ++k_) { const int q_ = tid + 512 * k_; const void* src_ = nullptr; \
            if (k_ < 4) { const int qq_ = q_ & 1023, row_ = qq_ >> 4, ch_ = qq_ & 15; const int tok_ = 64 * n_ + (d ? 63 - row_ : row_); src_ = QKVd + (size_t)tok_ * 2304 + (k_ < 2 ? 768 : 0) + h * 128 + ch_ * 8; } \
            else if (k_ < 6) { const int qq_ = q_ & 511, row_ = qq_ >> 3, ch_ = qq_ & 7; src_ = (k_ == 4 ? TINV : ATTN) + cb_ * 4096 + row_ * 64 + ch_ * 8; } \
            else { const int qq_ = q_ - 3072; if (qq_ < 128) { const int row_ = qq_ >> 1, ch_ = qq_ & 1; const int tok_ = 64 * n_ + (d ? 63 - row_ : row_); src_ = QKVd + (size_t)tok_ * 2304 + 1536 + h * 128 + sl * 16 + ch_ * 8; } \
                   else if (qq_ < 192) src_ = VEC + cb_ * 256 + (qq_ - 128) * 4; } \
            if (src_) pf[k_] = *(const v4u*)src_; } } while (0)
#define SC_WRITE(bufsel) do { LAS unsigned char* bb_ = lds + (bufsel) * SC_BUF; \
        _Pragma("unroll") for (int k_ = 0; k_ < 7; ++k_) { const int q_ = tid + 512 * k_; int off_ = -1; \
            if (k_ < 4) { const int qq_ = q_ & 1023, row_ = qq_ >> 4, ch_ = qq_ & 15; off_ = (k_ < 2 ? SC_KT : SC_QT) + row_ * 272 + ch_ * 16; } \
            else if (k_ < 6) { const int qq_ = q_ & 511, row_ = qq_ >> 3, ch_ = qq_ & 7; off_ = (k_ == 4 ? SC_TI : SC_AT) + row_ * 144 + ch_ * 16; } \
            else { const int qq_ = q_ - 3072; if (qq_ < 128) off_ = SC_VT + qq_ * 16; else if (qq_ < 192) off_ = SC_VC + (qq_ - 128) * 16; } \
            if (off_ >= 0) *(LAS v4u*)(bb_ + off_) = pf[k_]; } } while (0)
    f32x4 Sreg = {0.f, 0.f, 0.f, 0.f};
    f32x4 oprev = {0.f, 0.f, 0.f, 0.f};
    for (int e = tid; e < 4352 / 4; e += NTHREADS) ((LAS unsigned*)(lds + SC_ST))[e] = 0u;
    SC_LOAD(0); SC_WRITE(0);
    __syncthreads();
#define SC_BAR() do { asm volatile("s_waitcnt lgkmcnt(0)" ::: "memory"); __builtin_amdgcn_s_barrier(); asm volatile("" ::: "memory"); } while (0)
#pragma unroll 1
    for (int s = 0; s < 256; ++s) {
        const int cur = s & 1, n = d ? 255 - s : s;
        if (sl == 0 && tid == 0) __hip_atomic_store(prog + 64 * p, (unsigned)(s + 1), __ATOMIC_RELAXED, __HIP_MEMORY_SCOPE_AGENT);
        LAS unsigned char* B = lds + cur * SC_BUF;
        if (s + 1 < 256) SC_LOAD(s + 1);
        if (wv >= 4 && s > 0) { const int np = d ? 256 - s : s - 1;
#pragma unroll
            for (int rg = 0; rg < 4; ++rg) { const int i = 16 * (wv & 3) + 4 * g + rg, tok = 64 * np + (d ? 63 - i : i);
                ODIR[(size_t)tok * 768 + h * 128 + sl * 16 + m16] = (bf16)f2bf(oprev[rg]); } }
        const LAS float* VC = (const LAS float*)(B + SC_VC);
        bf16x8_t sb[4];
#pragma unroll
        for (int ks = 0; ks < 4; ++ks) sb[ks] = *(const LAS bf16x8_t*)(lds + SC_ST + m16 * 272 + (32 * ks + 8 * g) * 2);
        const int t4 = wv & 3;
        f32x4 acc1 = {0.f, 0.f, 0.f, 0.f};
        {
            const LAS unsigned char* ap = B + (wv < 4 ? SC_KT : SC_QT) + (16 * t4 + m16) * 272 + 16 * g;
#pragma unroll
            for (int ks = 0; ks < 4; ++ks) acc1 = MFMA16(*(const LAS bf16x8_t*)(ap + 64 * ks), sb[ks], acc1);
        }
        const f32x4 eG4 = *(const LAS f32x4*)(VC + 16 * t4 + 4 * g);
        if (wv < 4) {
            const f32x4 be4 = *(const LAS f32x4*)(VC + 64 + 16 * t4 + 4 * g);
            float r[4];
#pragma unroll
            for (int rg = 0; rg < 4; ++rg) { const float vv = bf2f(*(const LAS unsigned short*)(B + SC_VT + (16 * t4 + 4 * g + rg) * 32 + m16 * 2)); r[rg] = be4[rg] * (vv - eG4[rg] * acc1[rg]); }
            v2u w; w.x = pk2(r[0], r[1]); w.y = pk2(r[2], r[3]);
            *(LAS v2u*)(lds + SC_RT + m16 * 144 + (16 * t4 + 4 * g) * 2) = w;
        } else {
#pragma unroll
            for (int rg = 0; rg < 4; ++rg) acc1[rg] *= eG4[rg];
        }
        SC_BAR();
        if (wv < 4) {
            const LAS unsigned char* ap = B + SC_TI + (16 * t4 + m16) * 144 + 16 * g;
            f32x4 vn = {0.f, 0.f, 0.f, 0.f};
#pragma unroll
            for (int ks = 0; ks < 2; ++ks) vn = MFMA16(*(const LAS bf16x8_t*)(ap + 64 * ks), *(const LAS bf16x8_t*)(lds + SC_RT + m16 * 144 + (32 * ks + 8 * g) * 2), vn);
            const f32x4 eL4 = *(const LAS f32x4*)(VC + 128 + 16 * t4 + 4 * g);
            v2u w; w.x = pk2(vn[0], vn[1]); w.y = pk2(vn[2], vn[3]);
            *(LAS v2u*)(lds + SC_VNT + m16 * 144 + (16 * t4 + 4 * g) * 2) = w;
            v2u w2; w2.x = pk2(vn[0] * eL4[0], vn[1] * eL4[1]); w2.y = pk2(vn[2] * eL4[2], vn[3] * eL4[3]);
            *(LAS v2u*)(lds + SC_VST + m16 * 144 + (16 * t4 + 4 * g) * 2) = w2;
        }
        SC_BAR();
        {
            f32x4 acc3 = {0.f, 0.f, 0.f, 0.f};
#pragma unroll
            for (int ks = 0; ks < 2; ++ks) {
                const LAS unsigned char* tp = B + SC_KT + (32 * ks + 8 * g + (m16 >> 2)) * 272 + (16 * wv + 4 * (m16 & 3)) * 2;
                const s16x4_t lo = __builtin_amdgcn_ds_read_tr16_b64_v4i16((LAS s16x4_t*)tp);
                const s16x4_t hi = __builtin_amdgcn_ds_read_tr16_b64_v4i16((LAS s16x4_t*)(tp + 4 * 272));
                const bf16x8_t a = {lo[0], lo[1], lo[2], lo[3], hi[0], hi[1], hi[2], hi[3]};
                acc3 = MFMA16(a, *(const LAS bf16x8_t*)(lds + SC_VST + m16 * 144 + (32 * ks + 8 * g) * 2), acc3);
            }
            const float gl = VC[192];
#pragma unroll
            for (int rg = 0; rg < 4; ++rg) Sreg[rg] = gl * Sreg[rg] + acc3[rg];
            v2u w; w.x = pk2(Sreg[0], Sreg[1]); w.y = pk2(Sreg[2], Sreg[3]);
            *(LAS v2u*)(lds + SC_ST + m16 * 272 + (16 * wv + 4 * g) * 2) = w;
        }
        if (wv >= 4) {
            const LAS unsigned char* ap = B + SC_AT + (16 * t4 + m16) * 144 + 16 * g;
#pragma unroll
            for (int ks = 0; ks < 2; ++ks) acc1 = MFMA16(*(const LAS bf16x8_t*)(ap + 64 * ks), *(const LAS bf16x8_t*)(lds + SC_VNT + m16 * 144 + (32 * ks + 8 * g) * 2), acc1);
            oprev = acc1;
        }
        if (s + 1 < 256) SC_WRITE(cur ^ 1);
        SC_BAR();
    }
    if (wv >= 4) { const int np = d ? 0 : 255;
#pragma unroll
        for (int rg = 0; rg < 4; ++rg) { const int i = 16 * (wv & 3) + 4 * g + rg, tok = 64 * np + (d ? 63 - i : i);
            ODIR[(size_t)tok * 768 + h * 128 + sl * 16 + m16] = (bf16)f2bf(oprev[rg]); } }
#undef SC_BAR
#undef SC_LOAD
#undef SC_WRITE
}
constexpr int AT_PITCH = 144, AT_K = 0, AT_V = 192 * AT_PITCH, AT_GRP = 2 * 192 * AT_PITCH;
__device__ __forceinline__ void ph_attn(const bf16* PA, const float* rope, bf16* OG, float* LSE, LAS unsigned char* lds, int wv) {
    int tid_ = wv * 64 + lane_id_(); asm volatile("" : "+v"(tid_));
    const int tid = tid_, lane = tid & 63, g = lane >> 4, m16 = lane & 15, grp = wv >> 2, wq = wv & 3, tg = tid & 255;
    LAS unsigned char* Kl = lds + grp * AT_GRP + AT_K; LAS unsigned char* Vl = lds + grp * AT_GRP + AT_V;
#pragma unroll 1
    for (int pi = BID; pi < 1536; pi += GSZ) {
        const int u = 2 * pi + grp;
        const int hg = u & 3, w = (u >> 2) & 255, gi = u >> 10;
        const int dil = 1 << (2 * gi), L = S_ / dil, r = w & (dil - 1), nb = w >> (2 * gi), head = gi * 4 + hg;
#pragma unroll
        for (int k = 0; k < 3; ++k) {
            const int item = tg + 256 * k, row = item >> 2, c = item & 3, mm = nb * 64 - 64 + row;
            v4u o0 = {0u, 0u, 0u, 0u}, o1 = {0u, 0u, 0u, 0u};
            if (mm >= 0 && mm < L) {
                const int tok = mm * dil + r;
                const bf16* kp = PA + (size_t)tok * 2304 + 768 + head * 64 + 8 * c;
                const v4u x0 = *(const v4u*)kp, x1 = *(const v4u*)(kp + 32);
                const f32x4* cp = (const f32x4*)(rope + (size_t)tok * 32 + 8 * c); const f32x4* sp = (const f32x4*)(rope + (size_t)S_ * 32 + (size_t)tok * 32 + 8 * c);
                const f32x4 c0 = cp[0], c1 = cp[1], s0 = sp[0], s1 = sp[1];
                const float cs[8] = {c0.x, c0.y, c0.z, c0.w, c1.x, c1.y, c1.z, c1.w}, sn[8] = {s0.x, s0.y, s0.z, s0.w, s1.x, s1.y, s1.z, s1.w};
                const unsigned xa[4] = {x0.x, x0.y, x0.z, x0.w}, xb[4] = {x1.x, x1.y, x1.z, x1.w};
                unsigned ra[4], rb[4];
#pragma unroll
                for (int e = 0; e < 4; ++e) {
                    const float a0 = bflo(xa[e]), a1 = bfhi(xa[e]), b0 = bflo(xb[e]), b1 = bfhi(xb[e]);
                    ra[e] = pk2(a0 * cs[2 * e] - b0 * sn[2 * e], a1 * cs[2 * e + 1] - b1 * sn[2 * e + 1]);
                    rb[e] = pk2(b0 * cs[2 * e] + a0 * sn[2 * e], b1 * cs[2 * e + 1] + a1 * sn[2 * e + 1]);
                }
                o0.x = ra[0]; o0.y = ra[1]; o0.z = ra[2]; o0.w = ra[3]; o1.x = rb[0]; o1.y = rb[1]; o1.z = rb[2]; o1.w = rb[3];
            }
            *(LAS v4u*)(Kl + row * AT_PITCH + 16 * c) = o0; *(LAS v4u*)(Kl + row * AT_PITCH + 64 + 16 * c) = o1;
        }
#pragma unroll
        for (int k = 0; k < 6; ++k) {
            const int item = tg + 256 * k, row = item >> 3, c = item & 7, mm = nb * 64 - 64 + row;
            v4u o = {0u, 0u, 0u, 0u};
            if (mm >= 0 && mm < L) o = *(const v4u*)(PA + (size_t)(mm * dil + r) * 2304 + 1536 + head * 64 + 8 * c);
            *(LAS v4u*)(Vl + row * AT_PITCH + 16 * c) = o;
        }
        bf16x8_t bq0, bq1;
        const int qi = 16 * wq + m16, qtok = (nb * 64 + qi) * dil + r;
        {
            const bf16* qp = PA + (size_t)qtok * 2304 + head * 64 + 8 * g;
            const v4u x0 = *(const v4u*)qp, x1 = *(const v4u*)(qp + 32);
            const f32x4* cp = (const f32x4*)(rope + (size_t)qtok * 32 + 8 * g); const f32x4* sp = (const f32x4*)(rope + (size_t)S_ * 32 + (size_t)qtok * 32 + 8 * g);
            const f32x4 c0 = cp[0], c1 = cp[1], s0 = sp[0], s1 = sp[1];
            const float cs[8] = {c0.x, c0.y, c0.z, c0.w, c1.x, c1.y, c1.z, c1.w}, sn[8] = {s0.x, s0.y, s0.z, s0.w, s1.x, s1.y, s1.z, s1.w};
            const unsigned xa[4] = {x0.x, x0.y, x0.z, x0.w}, xb[4] = {x1.x, x1.y, x1.z, x1.w};
            v4u ra, rb; unsigned* rap = (unsigned*)&ra; unsigned* rbp = (unsigned*)&rb; (void)rap; (void)rbp;
            unsigned ta[4], tb[4];
#pragma unroll
            for (int e = 0; e < 4; ++e) {
                const float a0 = bflo(xa[e]), a1 = bfhi(xa[e]), b0 = bflo(xb[e]), b1 = bfhi(xb[e]);
                ta[e] = pk2(0.125f * (a0 * cs[2 * e] - b0 * sn[2 * e]), 0.125f * (a1 * cs[2 * e + 1] - b1 * sn[2 * e + 1]));
                tb[e] = pk2(0.125f * (b0 * cs[2 * e] + a0 * sn[2 * e]), 0.125f * (b1 * cs[2 * e + 1] + a1 * sn[2 * e + 1]));
            }
            ra.x = ta[0]; ra.y = ta[1]; ra.z = ta[2]; ra.w = ta[3]; rb.x = tb[0]; rb.y = tb[1]; rb.z = tb[2]; rb.w = tb[3];
            bq0 = __builtin_bit_cast(bf16x8_t, ra); bq1 = __builtin_bit_cast(bf16x8_t, rb);
        }
        __syncthreads();
        f32x4 st[12];
#pragma unroll
        for (int kt = 0; kt < 12; ++kt) {
            const LAS unsigned char* ap = Kl + (16 * kt + m16) * AT_PITCH + 16 * g;
            f32x4 z = {0.f, 0.f, 0.f, 0.f};
            z = MFMA16(*(const LAS bf16x8_t*)ap, bq0, z);
            st[kt] = MFMA16(*(const LAS bf16x8_t*)(ap + 64), bq1, z);
        }
        float mx = -1e30f;
#pragma unroll
        for (int kt = 0; kt < 12; ++kt)
#pragma unroll
            for (int rg = 0; rg < 4; ++rg) { const int j = 16 * kt + 4 * g + rg, dj = j - qi, mm = nb * 64 - 64 + j;
                const bool ok = (dj >= 0) && (dj <= 128) && (mm >= 0) && (mm < L);
                st[kt][rg] = ok ? st[kt][rg] : -1e30f; mx = fmaxf(mx, st[kt][rg]); }
        mx = fmaxf(mx, __shfl_xor(mx, 16)); mx = fmaxf(mx, __shfl_xor(mx, 32));
        float sum = 0.f;
#pragma unroll
        for (int kt = 0; kt < 12; ++kt)
#pragma unroll
            for (int rg = 0; rg < 4; ++rg) { const float p = __expf(st[kt][rg] - mx); st[kt][rg] = p; sum += p; }
        sum += __shfl_xor(sum, 16); sum += __shfl_xor(sum, 32);
        f32x4 o[4];
#pragma unroll
        for (int dt = 0; dt < 4; ++dt) o[dt] = (f32x4){0.f, 0.f, 0.f, 0.f};
#pragma unroll
        for (int kk = 0; kk < 6; ++kk) {
            v4u pb; pb.x = pk2(st[2 * kk][0], st[2 * kk][1]); pb.y = pk2(st[2 * kk][2], st[2 * kk][3]); pb.z = pk2(st[2 * kk + 1][0], st[2 * kk + 1][1]); pb.w = pk2(st[2 * kk + 1][2], st[2 * kk + 1][3]);
            const bf16x8_t b = __builtin_bit_cast(bf16x8_t, pb);
#pragma unroll
            for (int dt = 0; dt < 4; ++dt) {
                const LAS unsigned char* tp = Vl + (32 * kk + 4 * g + (m16 >> 2)) * AT_PITCH + (16 * dt + 4 * (m16 & 3)) * 2;
                const s16x4_t lo = __builtin_amdgcn_ds_read_tr16_b64_v4i16((LAS s16x4_t*)tp);
                const s16x4_t hi = __builtin_amdgcn_ds_read_tr16_b64_v4i16((LAS s16x4_t*)(tp + 16 * AT_PITCH));
                const bf16x8_t a = {lo[0], lo[1], lo[2], lo[3], hi[0], hi[1], hi[2], hi[3]};
                o[dt] = MFMA16(a, b, o[dt]);
            }
        }
        const float il = 1.0f / sum;
        bf16* op = OG + ((size_t)gi * S_ + qtok) * 256 + hg * 64 + 4 * g;
#pragma unroll
        for (int dt = 0; dt < 4; ++dt) { v2u wv2; wv2.x = pk2(o[dt][0] * il, o[dt][1] * il); wv2.y = pk2(o[dt][2] * il, o[dt][3] * il); *(v2u*)(op + 16 * dt) = wv2; }
        if (g == 0) LSE[((size_t)gi * S_ + qtok) * 4 + hg] = mx + logf(sum);
        __syncthreads();
    }
}
constexpr int LDS_RING = 131072, LDS_CTL_OFF = LDS_RING, LDS_BYTES = 147456;
constexpr int CW_BAR = 4096;
#ifndef PROBE_ID
#define PROBE_ID (-1)
#endif
__device__ __forceinline__ unsigned char* wsp() { return PWS; }
template <class Epi> __device__ __forceinline__ void run_gemm(LAS unsigned char* lds, const bf16* A, const bf16* Bt, int N, int K, const Epi& E, int wv) {
    pg8::Gemm g{A, Bt, S_, N, K, 0};
    pg8::StaticOrder S; S.init(S_, N, GSZ, BID);
    pg8::gemm_phase<Epi, pg8::StaticOrder, true, true>(lds, g, S, E, wv);
}
#define GRID_BAR() do { XcdBarrier b_; b_.bar = (unsigned*)(wsp() + WS_CTL) + CW_BAR; b_.st = (volatile LAS unsigned*)(lds + LDS_CTL_OFF + 320) + 8; b_.x = b_.st[2]; xcd_barrier(b_, wv); } while (0)
#define PHASE(id, ...) do { { __VA_ARGS__ } if (PROBE_ID == (id)) { GRID_BAR(); { __VA_ARGS__ } } } while (0)
#define WS_R_PTRS unsigned char* ws = wsp(); unsigned char* R = ws + WS_R; (void)R;

template <int l, int f> __device__ __forceinline__ void ffn_block(LAS unsigned char* lds, unsigned char* lds_raw, int wv) {
    constexpr int s = f * 2;
    PHASE(1, WS_R_PTRS
        pg8::EpiSwiglu E; E.O = (bf16*)(R + R_ACT); E.ldc = FF_; E.pad_ = 0; run_gemm(lds, (const bf16*)(ws + WS_H), (const bf16*)(ws + WS_W + (f ? W_FFIN1 : W_FFIN0)), 2 * FF_, 1024, E, wv); );
    GRID_BAR();
    PHASE(2, WS_R_PTRS
        pg8::EpiF32 E; E.O = (float*)(R + R_Y); E.ldc = 1024; E.pad_ = 0; run_gemm(lds, (const bf16*)(R + R_ACT), (const bf16*)(ws + WS_W + (f ? W_FFOUT1 : W_FFOUT0)), 1024, FF_, E, wv); );
    GRID_BAR();
    {   WS_R_PTRS const float* MOD = (const float*)(ws + WS_MOD); const float* mod = MOD + l * 9216;
        RowArgs a; a.xi = (l == 0 && f == 0) ? PIN(0) : POUT; a.y = (const float*)(R + R_Y); a.xo = POUT; a.wpost = PIN(6) + (l * 3 + s) * 1024; a.gate = mod + (s * 3 + 2) * 1024; a.coef = 0.5f;
        if (f == 0) { a.h = (bf16*)(ws + WS_H); a.wpre = PIN(5) + (l * 3 + 1) * 1024; a.shift = mod + (1 * 3 + 0) * 1024; a.scale = mod + (1 * 3 + 1) * 1024; }
        else if (l == 0) { a.h = (bf16*)(ws + WS_H); a.wpre = PIN(5) + (1 * 3 + 0) * 1024; a.shift = MOD + 9216; a.scale = MOD + 9216 + 1024; }
        else { a.h = nullptr; a.wpre = nullptr; a.shift = nullptr; a.scale = nullptr; }
        ph_rows(a, wv);
        if (f == 1 && l == 0) ph_convert(1, lds_raw, wv); }
    GRID_BAR();
}
template <int l> __device__ __forceinline__ void mixer_block(LAS unsigned char* lds, unsigned char* lds_raw, int wv) {
    PHASE(3, WS_R_PTRS
        pg8::EpiInProj E; E.PA = (bf16*)(R + R_PA); E.PD = (bf16*)(R + R_PD); E.PZ = (bf16*)(R + R_PZ); E.AB = (float*)(R + R_AB);
        run_gemm(lds, (const bf16*)(ws + WS_H), (const bf16*)(ws + WS_W + W_IN), 5632, 1024, E, wv); );
    GRID_BAR();
    PHASE(4, WS_R_PTRS
        ph_attn((const bf16*)(R + R_PA), (const float*)(ws + WS_ROPE), (bf16*)(R + R_OG), (float*)(R + R_LSE), lds, wv); );
    GRID_BAR();
    PHASE(5, WS_R_PTRS
        ph_dnprep((const bf16*)(R + R_PD), (const float*)(R + R_AB), PIN(10) + (size_t)l * 5 * 2304, PIN(11) + l * 12, PIN(12) + l * 12, (bf16*)(R + R_QKVD), (float*)(R + R_GB),
                  (const bf16*)(R + R_OG), (const float*)(R + R_LSE), (bf16*)(R + R_OATT), wv); );
    GRID_BAR();
    PHASE(6, WS_R_PTRS
        ph_dn_pre((const bf16*)(R + R_QKVD), (const float*)(R + R_GB), (bf16*)(R + R_TINV), (bf16*)(R + R_ATTN), (float*)(R + R_VEC), lds_raw, wv); );
    GRID_BAR();
    PHASE(7, WS_R_PTRS
        ph_dn_scan((const bf16*)(R + R_QKVD), (const bf16*)(R + R_TINV), (const bf16*)(R + R_ATTN), (const float*)(R + R_VEC), (bf16*)(R + R_ODIR0), (bf16*)(R + R_ODIR1), (unsigned*)(ws + WS_CTL) + 1024 + l * 1024, lds, wv); );
    GRID_BAR();
    PHASE(8, WS_R_PTRS
        pg8::EpiBf16P E; E.O = (bf16*)(R + R_PG); E.ldc = 2048; E.pad_ = 0;
        run_gemm(lds, (const bf16*)(ws + WS_H), (const bf16*)(ws + WS_W + W_IN) + (size_t)5632 * 1024, 2048, 1024, E, wv); );
    PHASE(9, WS_R_PTRS
        ph_final((const bf16*)(R + R_ODIR0), (const bf16*)(R + R_ODIR1), (const bf16*)(R + R_PZ), PIN(13) + l * 128, (bf16*)(R + R_ODN), wv); );
    GRID_BAR();
    PHASE(10, { WS_R_PTRS
        pg8::EpiGateF32 E; E.O = (float*)(R + R_T1); E.gate = (const bf16*)(R + R_PG); E.ldg = 2048; E.pad_ = 0;
        run_gemm(lds, (const bf16*)(R + R_OATT), (const bf16*)(ws + WS_W + W_BATT), 1024, 256, E, wv); }
        { WS_R_PTRS
        pg8::EpiGateAddBf16 E; E.O = (bf16*)(ws + WS_H); E.T1 = (const float*)(R + R_T1); E.gate = (const bf16*)(R + R_PG) + 1024; E.ldg = 2048; E.pad_ = 0;
        run_gemm(lds, (const bf16*)(R + R_ODN), (const bf16*)(ws + WS_W + W_BDN), 1024, 768, E, wv); } );
    GRID_BAR();
    PHASE(11, WS_R_PTRS
        pg8::EpiF32 E; E.O = (float*)(R + R_Y2); E.ldc = 1024; E.pad_ = 0; run_gemm(lds, (const bf16*)(ws + WS_H), (const bf16*)(ws + WS_W + W_OUT), 1024, 1024, E, wv); );
    GRID_BAR();
    {   WS_R_PTRS const float* mod = (const float*)(ws + WS_MOD) + l * 9216;
        RowArgs a; a.xi = POUT; a.y = (const float*)(R + R_Y2); a.xo = POUT; a.h = (bf16*)(ws + WS_H); a.wpost = PIN(6) + (l * 3 + 1) * 1024; a.gate = mod + (1 * 3 + 2) * 1024; a.coef = 1.0f;
        a.wpre = PIN(5) + (l * 3 + 2) * 1024; a.shift = mod + (2 * 3 + 0) * 1024; a.scale = mod + (2 * 3 + 1) * 1024; ph_rows(a, wv); }
    GRID_BAR();
}
__global__ void __launch_bounds__(NTHREADS, 2) mega_fwd(Params P) {
    extern __shared__ __attribute__((aligned(16))) unsigned char lds_raw[];
    LAS unsigned char* lds = (LAS unsigned char*)lds_raw;
    const int wv = __builtin_amdgcn_readfirstlane((int)threadIdx.x >> 6);
    { const int tid0 = threadIdx.x;
      for (int u = tid0; u < (LDS_BYTES - LDS_CTL_OFF) / 4; u += NTHREADS) ((LAS unsigned*)(lds + LDS_CTL_OFF))[u] = 0u;
      __syncthreads();
      XcdBarrier b0 = xcd_barrier_post((unsigned*)(PWS + WS_CTL) + CW_BAR, (volatile LAS unsigned*)(lds + LDS_CTL_OFF + 320) + 8);
      if (tid0 == 0) ((volatile LAS unsigned*)(lds + LDS_CTL_OFF + 320))[10] = b0.x;
      __syncthreads(); }
    PHASE(0, ph_ada(lds_raw, wv); ph_rope(wv); ph_convert(0, lds_raw, wv); );
    GRID_BAR();
    PHASE(12, WS_R_PTRS float* MOD = (float*)(ws + WS_MOD);
      RowArgs a; a.xi = PIN(0); a.y = nullptr; a.xo = nullptr; a.h = (bf16*)(ws + WS_H); a.wpost = nullptr; a.gate = nullptr; a.wpre = PIN(5); a.shift = MOD; a.scale = MOD + 1024; a.coef = 0.f; ph_rows(a, wv); );
    GRID_BAR();
    ffn_block<0, 0>(lds, lds_raw, wv); mixer_block<0>(lds, lds_raw, wv); ffn_block<0, 1>(lds, lds_raw, wv);
    ffn_block<1, 0>(lds, lds_raw, wv); mixer_block<1>(lds, lds_raw, wv); ffn_block<1, 1>(lds, lds_raw, wv);
}

extern "C" void kernel_launch(void* const* d_in, const int* in_sizes, int n_in, void* d_out, int out_size, void* d_ws, size_t ws_size, hipStream_t stream) {
    static int grid = 0;
    if (grid == 0) {
        if (n_in != 17 || ws_size < WS_END) { fprintf(stderr, "kernel_launch: unexpected n_in %d / ws_size %zu\n", n_in, ws_size); grid = -1; return; }
        int dev = 0, cus = 0, per_cu = 0;
        if (hipGetDevice(&dev) != hipSuccess || hipDeviceGetAttribute(&cus, hipDeviceAttributeMultiprocessorCount, dev) != hipSuccess) { grid = -1; return; }
        if (hipFuncSetAttribute((const void*)mega_fwd, hipFuncAttributeMaxDynamicSharedMemorySize, LDS_BYTES) != hipSuccess) { fprintf(stderr, "kernel_launch: hipFuncSetAttribute failed\n"); grid = -1; return; }
        if (hipOccupancyMaxActiveBlocksPerMultiprocessor(&per_cu, (const void*)mega_fwd, NTHREADS, LDS_BYTES) != hipSuccess || per_cu < 1) { fprintf(stderr, "kernel_launch: occupancy query says %d\n", per_cu); per_cu = 1; }
        (void)hipGetLastError();
        grid = cus;
        if (grid > 256) grid = 256;
    }
    if (grid < 0) return;
    (void)hipMemsetAsync((char*)d_ws + WS_CTL, 0, 1 * MiB, stream);
    Params p{};
    for (int i = 0; i < 17; ++i) p.in[i] = (const float*)d_in[i];
    p.out = (float*)d_out; p.ws = (unsigned char*)d_ws;
    hipLaunchKernelGGL(mega_fwd, dim3(grid), dim3(NTHREADS), LDS_BYTES, stream, p);
}
```

```cpp
#include <hip/hip_runtime.h>
#include <cstdio>
#include <cstdint>
__device__ __forceinline__ int lane_id_() { int l; asm volatile("v_mbcnt_lo_u32_b32 %0, -1, 0\n\tv_mbcnt_hi_u32_b32 %0, -1, %0" : "=v"(l)); return l; }
namespace pg8 {
#define PG8_LAS __attribute__((address_space(3)))
typedef unsigned short bf16_t;
typedef short bf16x8 __attribute__((ext_vector_type(8)));
typedef float f32x4 __attribute__((ext_vector_type(4)));
typedef unsigned u32x4 __attribute__((ext_vector_type(4)));
constexpr int BM = 256, BK = 64, HALF = 128, HTB = HALF * BK * 2  , STAGE_BYTES = 8 * HTB, NXCD = 8, WGM = 8;

__host__ __device__ __forceinline__ int lds_byte(int r, int c) { const int st = (r >> 4) * 2 + (c >> 5), rr = r & 15, cc = c & 31, ob = rr * 64 + cc * 2; return st * 1024 + (ob ^ (((ob >> 9) & 1) << 5)); }
__host__ __device__ __forceinline__ void stage_rc(int b, int& R, int& C) { const int st = b / 1024, sb = b % 1024, swz = sb ^ (((sb >> 9) & 1) << 5); R = (st >> 1) * 16 + swz / 64; C = (st & 1) * 32 + (swz % 64) / 2; }
__host__ __device__ __forceinline__ int perm32(int rho) { const int n = rho >> 4, i = rho & 15; return 8 * (i >> 2) + 4 * n + (i & 3); }

struct Unit { int pm, pn; };
struct Gemm { const bf16_t* A; const bf16_t* Bt; int M, N, K, pad_; };

struct StaticOrder {
    int nM, nN, nwg, G, c;
    __host__ __device__ void init(int M, int N, int G_, int c_) { nM = M / BM; nN = N / BM; nwg = nM * nN; G = G_; c = c_; }
    __host__ __device__ bool next(int i, Unit& u) const {
        const long L = (long)i * G + c; if (L >= nwg) return false;
        int wgid = (int)L; { const int q = nwg / NXCD, r = nwg % NXCD, xcd = wgid % NXCD, off = wgid / NXCD; wgid = (xcd < r ? xcd * (q + 1) : r * (q + 1) + (xcd - r) * q) + off; }
        const int nig = WGM * nN, gid = wgid / nig, fm = gid * WGM, gsz = (nM - fm) < WGM ? (nM - fm) : WGM;
        u.pm = fm + ((wgid % nig) % gsz); u.pn = (wgid % nig) / gsz; return true;
    }
    __device__ __forceinline__ void a_ready(const Unit&) const {}
    __device__ __forceinline__ void done(const Unit&) const {}
};

__device__ __forceinline__ unsigned cvt_pk_bf16(float lo, float hi) { unsigned r; asm volatile("v_cvt_pk_bf16_f32 %0, %1, %2" : "=v"(r) : "v"(lo), "v"(hi)); return r; }
typedef float f32x2 __attribute__((ext_vector_type(2)));
__device__ __forceinline__ f32x2 gelu_pk(f32x2 v) {
    const f32x2 av = __builtin_elementwise_abs(v), d = av * 0.2316418882f + 1.0f;
    f32x2 t; t.x = __builtin_amdgcn_rcpf(d.x); t.y = __builtin_amdgcn_rcpf(d.y);
    f32x2 q = t * 0.5307027145f + (-0.7265760135f); q = q * t + 0.7107068705f; q = q * t + (-0.142248368f); q = q * t + 0.127414796f; q = q * t;
    const f32x2 s = (v * v) * (-0.72134752044f);
    f32x2 e; e.x = __builtin_amdgcn_exp2f(s.x); e.y = __builtin_amdgcn_exp2f(s.y);
    const f32x2 m = v * (q * e), r = v - m;
    f32x2 o; o.x = v.x < 0.f ? m.x : r.x; o.y = v.y < 0.f ? m.y : r.y; return o;
}

template <int ACT  > struct EpiBf16 {
    static constexpr bool PERM = true, AFTER_DRAIN = false; static_assert(ACT == 0 || ACT == 1, "EpiBf16: ACT is 0 (none) or 1 (gelu_pk)");
    bf16_t* O; int ldc; const float* bias; int split_cols; size_t split_stride; float scale0;
    __device__ __forceinline__ void operator()(const f32x4 (&acc)[2][2][4][2], const Unit& u, int wr, int wc, int fr, int fq) const {
        const int row0 = u.pm * BM + wr * 64 + fr; int colt = u.pn * BM; bf16_t* base = O;
        float sc = 1.f; if (split_cols) { const int t = colt / split_cols; base += (size_t)t * split_stride; colt -= t * split_cols; if (t == 0) sc = scale0; }
        const int col0 = colt + wc * 32 + 8 * fq, bcol0 = u.pn * BM + wc * 32 + 8 * fq;
        f32x4 bv[2][2];
#pragma unroll
        for (int bj = 0; bj < 2; ++bj)
#pragma unroll
            for (int n = 0; n < 2; ++n) bv[bj][n] = bias ? *(const f32x4*)(bias + bcol0 + bj * HALF + 4 * n) : (f32x4){0.f, 0.f, 0.f, 0.f};
#pragma unroll
        for (int ai = 0; ai < 2; ++ai)
#pragma unroll
            for (int m = 0; m < 4; ++m) { bf16_t* rowp = base + (size_t)(row0 + ai * HALF + m * 16) * ldc + col0;
#pragma unroll
                for (int bj = 0; bj < 2; ++bj) { f32x4 v0 = acc[ai][bj][m][0] + bv[bj][0], v1 = acc[ai][bj][m][1] + bv[bj][1];
                    if (ACT == 1) { f32x2 a = gelu_pk((f32x2){v0[0], v0[1]}), b = gelu_pk((f32x2){v0[2], v0[3]}), c = gelu_pk((f32x2){v1[0], v1[1]}), d = gelu_pk((f32x2){v1[2], v1[3]});
                        v0 = (f32x4){a.x, a.y, b.x, b.y}; v1 = (f32x4){c.x, c.y, d.x, d.y}; }
                    v0 = v0 * sc; v1 = v1 * sc; u32x4 w; w.x = cvt_pk_bf16(v0[0], v0[1]); w.y = cvt_pk_bf16(v0[2], v0[3]); w.z = cvt_pk_bf16(v1[0], v1[1]); w.w = cvt_pk_bf16(v1[2], v1[3]);
                    *(u32x4*)(rowp + bj * HALF) = w; } }
    }
};

struct PanelStats {
    unsigned* xbuf;
    unsigned* cnt;
    unsigned* tmo;
    int ntn; float eps;
    unsigned code;
    __device__ __forceinline__ bool run(const f32x4 (&v)[2][2][4][2], const Unit& u, int wr, int wc, int fr, int fq, PG8_LAS unsigned char* lds, int wid, int lane) const {
        typedef float f32x2v __attribute__((ext_vector_type(2)));
        PG8_LAS f32x2v* P = (PG8_LAS f32x2v*)lds;
        PG8_LAS f32x2v* S = (PG8_LAS f32x2v*)(lds + 8192);
        PG8_LAS unsigned* flag = (PG8_LAS unsigned*)(lds + 8192 + 2048);
#pragma unroll
        for (int ai = 0; ai < 2; ++ai)
#pragma unroll
            for (int m = 0; m < 4; ++m) {
                float s = 0.f;
#pragma unroll
                for (int bj = 0; bj < 2; ++bj)
#pragma unroll
                    for (int n = 0; n < 2; ++n) { const f32x4 x = v[ai][bj][m][n]; s += (x[0] + x[1]) + (x[2] + x[3]); }
                s += __shfl_xor(s, 16); s += __shfl_xor(s, 32);
                const float mw = s * (1.0f / 64.0f); float q = 0.f;
#pragma unroll
                for (int bj = 0; bj < 2; ++bj)
#pragma unroll
                    for (int n = 0; n < 2; ++n) { const f32x4 d = v[ai][bj][m][n] - mw; q += (d[0] * d[0] + d[1] * d[1]) + (d[2] * d[2] + d[3] * d[3]); }
                q += __shfl_xor(q, 16); q += __shfl_xor(q, 32);
                if (fq == 0) P[(ai * HALF + wr * 64 + m * 16 + fr) * 4 + wc] = (f32x2v){mw, q};
            }
        asm volatile("s_waitcnt lgkmcnt(0)" ::: "memory"); __builtin_amdgcn_s_barrier(); asm volatile("" ::: "memory");
#if defined(BROKEN_EXCHANGE_NO_WAIT)
#warning BROKEN CONTROL BUILD: the row-statistics exchange does not wait; results are wrong by design
        if (blockIdx.x >= 64) { const long long t0_ = clock64(); while (clock64() - t0_ < 60000) __builtin_amdgcn_s_sleep(8); }
#endif
        const int row = wid * 32 + (lane & 31);
        if (lane < 32) {
            const f32x2v a = P[row * 4 + 0], b = P[row * 4 + 1], c = P[row * 4 + 2], d = P[row * 4 + 3];
            const float mt = (a.x + b.x + c.x + d.x) * 0.25f;
            const float da = a.x - mt, db = b.x - mt, dc = c.x - mt, dd = d.x - mt;
            const float m2 = (a.y + b.y) + (c.y + d.y) + 64.0f * ((da * da + db * db) + (dc * dc + dd * dd));
            unsigned long long* slot = (unsigned long long*)xbuf + ((size_t)(u.pm * BM + row) * 4 + u.pn);
            __hip_atomic_store(slot, ((unsigned long long)__float_as_uint(m2) << 32) | __float_as_uint(mt), __ATOMIC_RELAXED, __HIP_MEMORY_SCOPE_AGENT);
        }
        asm volatile("s_waitcnt vmcnt(0)" ::: "memory");
        if (lane == 0) __hip_atomic_fetch_add(cnt + 64 * u.pm, 1u, __ATOMIC_RELAXED, __HIP_MEMORY_SCOPE_AGENT);
        if (wid == 0) {
            bool dead = false; const unsigned long long t0 = __builtin_amdgcn_s_memrealtime(); const unsigned want = 8u * (unsigned)ntn;
            for (;;) {
#if defined(BROKEN_EXCHANGE_NO_WAIT)
                break;
#endif
                if ((unsigned)__builtin_amdgcn_readfirstlane(__hip_atomic_load(cnt + 64 * u.pm, __ATOMIC_RELAXED, __HIP_MEMORY_SCOPE_AGENT)) >= want) break;
                if (__builtin_amdgcn_s_memrealtime() - t0 > 2000000ull) {
                    if (lane == 0) { unsigned expect = 0u; __hip_atomic_compare_exchange_strong(tmo + 1, &expect, code | (unsigned)(u.pm & 0xff), __ATOMIC_RELAXED, __ATOMIC_RELAXED, __HIP_MEMORY_SCOPE_AGENT);
                                     __hip_atomic_store(tmo, 1u, __ATOMIC_RELAXED, __HIP_MEMORY_SCOPE_AGENT); }
                    dead = true; break; }
                __builtin_amdgcn_s_sleep(2);
            }
            __builtin_amdgcn_fence(__ATOMIC_ACQUIRE, "agent");
            if (lane == 0) flag[0] = dead ? 1u : 0u;
        }
        asm volatile("s_waitcnt vmcnt(0) lgkmcnt(0)" ::: "memory"); __builtin_amdgcn_s_barrier(); asm volatile("" ::: "memory");
        const bool bad = flag[0] != 0u;
        if (lane < 32) {
            const unsigned long long* slot = (const unsigned long long*)xbuf + (size_t)(u.pm * BM + row) * 4; float mt[4], m2[4]; float ms = 0.f;
#pragma unroll
            for (int t = 0; t < 4; ++t) { if (t < ntn) { const unsigned long long w = __hip_atomic_load(slot + t, __ATOMIC_RELAXED, __HIP_MEMORY_SCOPE_AGENT); mt[t] = __uint_as_float((unsigned)w); m2[t] = __uint_as_float((unsigned)(w >> 32)); } else { mt[t] = 0.f; m2[t] = 0.f; } ms += mt[t]; }
            const float mean = ms / (float)ntn; float q = 0.f;
#pragma unroll
            for (int t = 0; t < 4; ++t) if (t < ntn) { const float dm = mt[t] - mean; q += m2[t] + 256.0f * dm * dm; }
            S[row] = (f32x2v){mean, 1.0f / sqrtf(q / (256.0f * (float)ntn) + eps)};
        }
        asm volatile("s_waitcnt lgkmcnt(0)" ::: "memory"); __builtin_amdgcn_s_barrier(); asm volatile("" ::: "memory");
        return bad;
    }
};
struct EpiLnRes {
    static constexpr bool PERM = false, AFTER_DRAIN = true;
    const float* base; float* out; int ldc; const float* bias; PanelStats st; unsigned poison;
    __device__ __forceinline__ void fused(f32x4 (&acc)[2][2][4][2], const Unit& u, int wr, int wc, int fr, int fq, PG8_LAS unsigned char* lds, int wid, int lane) const {
        typedef float f32x2v __attribute__((ext_vector_type(2)));
        const PG8_LAS f32x2v* S = (const PG8_LAS f32x2v*)(lds + 8192);
        const int col0 = u.pn * BM + wc * 32 + 4 * fq;
#pragma unroll
        for (int bj = 0; bj < 2; ++bj)
#pragma unroll
            for (int n = 0; n < 2; ++n) { const f32x4 bv = bias ? *(const f32x4*)(bias + col0 + bj * HALF + n * 16) : (f32x4){0.f, 0.f, 0.f, 0.f};
#pragma unroll
                for (int ai = 0; ai < 2; ++ai)
#pragma unroll
                    for (int m = 0; m < 4; ++m) acc[ai][bj][m][n] += bv; }
        f32x4 pre[4][2][2];
#pragma unroll
        for (int m = 0; m < 4; ++m) { const size_t off = (size_t)(u.pm * BM + wr * 64 + m * 16 + fr) * ldc + col0;
#pragma unroll
            for (int bj = 0; bj < 2; ++bj)
#pragma unroll
                for (int n = 0; n < 2; ++n) pre[m][bj][n] = *(const f32x4*)(base + off + bj * HALF + n * 16); }
        const bool bad = st.run(acc, u, wr, wc, fr, fq, lds, wid, lane) || poison != 0u;
        const float qnan = __builtin_nanf("");
#pragma unroll
        for (int ai = 0; ai < 2; ++ai)
#pragma unroll
            for (int m = 0; m < 4; ++m) { const int r = ai * HALF + wr * 64 + m * 16 + fr; const f32x2v sr = S[r]; const size_t off = (size_t)(u.pm * BM + r) * ldc + col0;
#pragma unroll
                for (int bj = 0; bj < 2; ++bj)
#pragma unroll
                    for (int n = 0; n < 2; ++n) { const f32x4 bs = ai == 0 ? pre[m][bj][n] : *(const f32x4*)(base + off + bj * HALF + n * 16); f32x4 o = bs + (acc[ai][bj][m][n] - sr.x) * sr.y;
                        if (bad) o = (f32x4){qnan, qnan, qnan, qnan}; *(f32x4*)(out + off + bj * HALF + n * 16) = o; }
                if (m & 1) asm volatile("" ::: "memory"); }
    }
};
struct EpiLnResLn {
    static constexpr bool PERM = false, AFTER_DRAIN = true;
    const float* base; float* out; bf16_t* xn; int ldc; const float* bias; PanelStats st1, st2; unsigned poison;
    __device__ __forceinline__ void fused(f32x4 (&acc)[2][2][4][2], const Unit& u, int wr, int wc, int fr, int fq, PG8_LAS unsigned char* lds, int wid, int lane) const {
        typedef float f32x2v __attribute__((ext_vector_type(2))); typedef unsigned u32x2v __attribute__((ext_vector_type(2)));
        const PG8_LAS f32x2v* S = (const PG8_LAS f32x2v*)(lds + 8192);
        const int col0 = u.pn * BM + wc * 32 + 4 * fq;
#pragma unroll
        for (int bj = 0; bj < 2; ++bj)
#pragma unroll
            for (int n = 0; n < 2; ++n) { const f32x4 bv = bias ? *(const f32x4*)(bias + col0 + bj * HALF + n * 16) : (f32x4){0.f, 0.f, 0.f, 0.f};
#pragma unroll
                for (int ai = 0; ai < 2; ++ai)
#pragma unroll
                    for (int m = 0; m < 4; ++m) acc[ai][bj][m][n] += bv; }
        bool bad = st1.run(acc, u, wr, wc, fr, fq, lds, wid, lane) || poison != 0u;
        const float qnan = __builtin_nanf("");
#pragma unroll
        for (int ai = 0; ai < 2; ++ai)
#pragma unroll
            for (int m = 0; m < 4; ++m) { const int r = ai * HALF + wr * 64 + m * 16 + fr; const f32x2v sr = S[r]; const size_t off = (size_t)(u.pm * BM + r) * ldc + col0;
#pragma unroll
                for (int bj = 0; bj < 2; ++bj)
#pragma unroll
                    for (int n = 0; n < 2; ++n) { const f32x4 bs = *(const f32x4*)(base + off + bj * HALF + n * 16); acc[ai][bj][m][n] = bs + (acc[ai][bj][m][n] - sr.x) * sr.y; }
                asm volatile("" : "+v"(acc[ai][0][m][0]), "+v"(acc[ai][0][m][1]), "+v"(acc[ai][1][m][0]), "+v"(acc[ai][1][m][1]));
                if (m & 1) asm volatile("" ::: "memory"); }
        const bool bad1 = bad;
        bad = st2.run(acc, u, wr, wc, fr, fq, lds, wid, lane) || bad;
#pragma unroll
        for (int ai = 0; ai < 2; ++ai)
#pragma unroll
            for (int m = 0; m < 4; ++m) { const int r = ai * HALF + wr * 64 + m * 16 + fr; const f32x2v sr = S[r]; const size_t off = (size_t)(u.pm * BM + r) * ldc + col0;
#pragma unroll
                for (int bj = 0; bj < 2; ++bj)
#pragma unroll
                    for (int n = 0; n < 2; ++n) { const f32x4 x1 = acc[ai][bj][m][n]; *(f32x4*)(out + off + bj * HALF + n * 16) = bad1 ? (f32x4){qnan, qnan, qnan, qnan} : x1;
                        const f32x4 o = (x1 - sr.x) * sr.y; u32x2v w; w.x = cvt_pk_bf16(o[0], o[1]); w.y = cvt_pk_bf16(o[2], o[3]);
                        if (bad) { w.x = 0x7fc07fc0u; w.y = 0x7fc07fc0u; } *(u32x2v*)(xn + off + bj * HALF + n * 16) = w; }
                asm volatile("" ::: "memory"); }
    }
};

template <class Epi, class Sched, bool ALIGN_EPI = false, bool SP2 = false>
__device__ __forceinline__ void gemm_phase(PG8_LAS unsigned char* lds, const Gemm g, const Sched& S, const Epi& E, int wv) {
    int tid_ = wv * 64 + lane_id_(); asm volatile("" : "+v"(tid_));
    const int tid = tid_, wid = __builtin_amdgcn_readfirstlane(tid >> 6), lane = tid & 63, wr = wid >> 2, wc = wid & 3, fr = lane & 15, fq = lane >> 4;
    const int K = g.K, nt = K / BK;
    unsigned voffA[2], voffB[2];
#pragma unroll
    for (int i = 0; i < 2; ++i) { int R, C; stage_rc(tid * 16 + i * 8192, R, C); const int Rb = Epi::PERM ? ((R & ~31) + perm32(R & 31)) : R;
        voffA[i] = (unsigned)(R * K + C) * 2u; voffB[i] = (unsigned)(Rb * K + C) * 2u; }
    const size_t kstep = (size_t)(BK * 2);
    const size_t hstep = (size_t)HALF * K * 2;
    const size_t tstep = 2 * hstep;
    const unsigned ldsw = (unsigned)wid * 1024u;
    const int aoff = lds_byte(wr * 64 + fr, fq * 8), boff = lds_byte(wc * 32 + fr, fq * 8);
#define PG8_SA(b, h) (((b) * 2 + (h)) * HTB)
#define PG8_SB(b, h) ((4 + (b) * 2 + (h)) * HTB)
#define PG8_STAGE(bufoff, gbase, voff) do { _Pragma("unroll") for (int _i = 0; _i < 2; ++_i) \
        __builtin_amdgcn_global_load_lds((const unsigned*)((const char*)(gbase) + (voff)[_i]), (PG8_LAS unsigned*)(lds + (bufoff) + ldsw + _i * 8192), 16, 0, 0); } while (0)
#define PG8_LDA(dst, b, h) do { _Pragma("unroll") for (int m = 0; m < 4; ++m) _Pragma("unroll") for (int k = 0; k < 2; ++k) dst[m][k] = *(const PG8_LAS bf16x8*)(lds + PG8_SA(b, h) + aoff + m * 2048 + k * 1024); } while (0)
#define PG8_LDB(dst, b, h) do { _Pragma("unroll") for (int n = 0; n < 2; ++n) _Pragma("unroll") for (int k = 0; k < 2; ++k) dst[n][k] = *(const PG8_LAS bf16x8*)(lds + PG8_SB(b, h) + boff + n * 2048 + k * 1024); } while (0)
#define PG8_MMA(ai, bj, At, Bt) do { __builtin_amdgcn_s_setprio(1); _Pragma("unroll") for (int m = 0; m < 4; ++m) _Pragma("unroll") for (int n = 0; n < 2; ++n) _Pragma("unroll") for (int k = 0; k < 2; ++k) \
        acc[ai][bj][m][n] = __builtin_amdgcn_mfma_f32_16x16x32_bf16(Bt[n][k], At[m][k], acc[ai][bj][m][n], 0, 0, 0); __builtin_amdgcn_s_setprio(0); } while (0)
#define PG8_WAIT_V(n) asm volatile("s_waitcnt vmcnt(" #n ")" ::: "memory")
#define PG8_WAIT_L(n) asm volatile("s_waitcnt lgkmcnt(" #n ")" ::: "memory")
#define PG8_BAR __builtin_amdgcn_s_barrier()
#define PG8_SCHED __builtin_amdgcn_sched_barrier(0)
    Unit cur, nxt; int ui = 0;
    if (!S.next(0, cur)) return;
    f32x4 acc[2][2][4][2];
#pragma unroll
    for (int a = 0; a < 2; ++a)
#pragma unroll
        for (int b = 0; b < 2; ++b)
#pragma unroll
            for (int m = 0; m < 4; ++m)
#pragma unroll
                for (int n = 0; n < 2; ++n) acc[a][b][m][n] = (f32x4){0.f, 0.f, 0.f, 0.f};
    bf16x8 At[4][2], B0[2][2], B1[2][2];
    const char* cA = (const char*)g.A + (size_t)cur.pm * tstep; const char* cB = (const char*)g.Bt + (size_t)cur.pn * tstep;
    S.a_ready(cur);
    if constexpr (SP2) {
        PG8_STAGE(PG8_SB(0, 0), cB, voffB); PG8_STAGE(PG8_SB(0, 1), cB + hstep, voffB); PG8_STAGE(PG8_SA(0, 0), cA, voffA); PG8_STAGE(PG8_SA(0, 1), cA + hstep, voffA);
        if (wr == 1) PG8_BAR;
        PG8_WAIT_V(2); PG8_BAR;
        PG8_STAGE(PG8_SB(1, 0), cB + kstep, voffB); PG8_STAGE(PG8_SA(1, 0), cA + kstep, voffA); PG8_STAGE(PG8_SB(1, 1), cB + hstep + kstep, voffB);
        PG8_WAIT_V(6); PG8_BAR;
    } else {
        PG8_STAGE(PG8_SB(0, 0), cB, voffB); PG8_STAGE(PG8_SA(0, 0), cA, voffA); PG8_STAGE(PG8_SB(0, 1), cB + hstep, voffB); PG8_STAGE(PG8_SA(0, 1), cA + hstep, voffA);
        if (wr == 1) PG8_BAR;
        PG8_WAIT_V(4); PG8_BAR;
        PG8_STAGE(PG8_SB(1, 0), cB + kstep, voffB); PG8_STAGE(PG8_SA(1, 0), cA + kstep, voffA); PG8_STAGE(PG8_SB(1, 1), cB + hstep + kstep, voffB);
        PG8_WAIT_V(6); PG8_BAR;
    }
    for (;;) {
        const bool has_next = S.next(ui + 1, nxt);
        const char* nA = has_next ? (const char*)g.A + (size_t)nxt.pm * tstep : cA; const char* nB = has_next ? (const char*)g.Bt + (size_t)nxt.pn * tstep : cB;
        for (int t = 0; t < nt; t += 2) {
            const bool last = (t == nt - 2);
            const char* a1 = cA + (size_t)(t + 1) * kstep;
            const char* a2 = last ? nA : cA + (size_t)(t + 2) * kstep; const char* b2 = last ? nB : cB + (size_t)(t + 2) * kstep;
            const char* a3 = a2 + kstep; const char* b3 = b2 + kstep;
            if (last && has_next) S.a_ready(nxt);
            if constexpr (SP2) {
            PG8_LDB(B0, 0, 0); PG8_LDB(B1, 0, 1); PG8_SCHED; PG8_LDA(At, 0, 0); PG8_STAGE(PG8_SA(1, 1), a1 + hstep, voffA);
            PG8_WAIT_V(8); PG8_WAIT_L(0); PG8_BAR; PG8_MMA(0, 0, At, B0); PG8_MMA(0, 1, At, B1); PG8_BAR; PG8_SCHED;
            PG8_LDA(At, 0, 1); PG8_STAGE(PG8_SB(0, 0), b2, voffB); PG8_STAGE(PG8_SB(0, 1), b2 + hstep, voffB); PG8_STAGE(PG8_SA(0, 0), a2, voffA);
            PG8_WAIT_V(8); PG8_WAIT_L(0); PG8_BAR; PG8_MMA(1, 0, At, B0); PG8_MMA(1, 1, At, B1); PG8_BAR; PG8_SCHED;
            PG8_LDB(B0, 1, 0); PG8_LDB(B1, 1, 1); PG8_SCHED; PG8_LDA(At, 1, 0); PG8_STAGE(PG8_SA(0, 1), a2 + hstep, voffA);
            PG8_WAIT_V(8); PG8_WAIT_L(0); PG8_BAR; PG8_MMA(0, 0, At, B0); PG8_MMA(0, 1, At, B1); PG8_BAR; PG8_SCHED;
            PG8_LDA(At, 1, 1); PG8_STAGE(PG8_SB(1, 0), b3, voffB); PG8_STAGE(PG8_SB(1, 1), b3 + hstep, voffB); PG8_STAGE(PG8_SA(1, 0), a3, voffA);
            PG8_WAIT_V(8); PG8_WAIT_L(0); PG8_BAR; PG8_MMA(1, 0, At, B0); PG8_MMA(1, 1, At, B1); PG8_BAR; PG8_SCHED;
            } else {
            PG8_LDB(B0, 0, 0); PG8_SCHED; PG8_LDA(At, 0, 0); PG8_STAGE(PG8_SA(1, 1), a1 + hstep, voffA);
            PG8_WAIT_L(8); PG8_BAR; PG8_WAIT_L(0); PG8_MMA(0, 0, At, B0); PG8_BAR; PG8_SCHED;
            PG8_LDB(B1, 0, 1); PG8_STAGE(PG8_SB(0, 0), b2, voffB);
            PG8_BAR; PG8_WAIT_L(0); PG8_MMA(0, 1, At, B1); PG8_BAR;
            PG8_LDA(At, 0, 1); PG8_STAGE(PG8_SA(0, 0), a2, voffA);
            PG8_BAR; PG8_WAIT_L(0); PG8_MMA(1, 0, At, B0); PG8_BAR; PG8_SCHED;
            PG8_STAGE(PG8_SB(0, 1), b2 + hstep, voffB);
            PG8_WAIT_V(6); PG8_BAR; PG8_MMA(1, 1, At, B1); PG8_BAR;
            PG8_LDB(B0, 1, 0); PG8_SCHED; PG8_LDA(At, 1, 0); PG8_STAGE(PG8_SA(0, 1), a2 + hstep, voffA);
            PG8_WAIT_L(8); PG8_BAR; PG8_WAIT_L(0); PG8_MMA(0, 0, At, B0); PG8_BAR; PG8_SCHED;
            PG8_LDB(B1, 1, 1); PG8_STAGE(PG8_SB(1, 0), b3, voffB);
            PG8_BAR; PG8_WAIT_L(0); PG8_MMA(0, 1, At, B1); PG8_BAR;
            PG8_LDA(At, 1, 1); PG8_STAGE(PG8_SA(1, 0), a3, voffA);
            PG8_BAR; PG8_WAIT_L(0); PG8_MMA(1, 0, At, B0); PG8_BAR; PG8_SCHED;
            PG8_STAGE(PG8_SB(1, 1), b3 + hstep, voffB);
            PG8_WAIT_V(6); PG8_BAR; PG8_MMA(1, 1, At, B1); PG8_BAR;
            }
        }
        if constexpr (ALIGN_EPI) { if (wr == 0) PG8_BAR; }
        if constexpr (!Epi::AFTER_DRAIN) { E(acc, cur, wr, wc, fr, fq); S.done(cur); }
        if (!has_next) break;
#pragma unroll
        for (int a = 0; a < 2; ++a)
#pragma unroll
            for (int b = 0; b < 2; ++b)
#pragma unroll
                for (int m = 0; m < 4; ++m)
#pragma unroll
                    for (int n = 0; n < 2; ++n) acc[a][b][m][n] = (f32x4){0.f, 0.f, 0.f, 0.f};
        cur = nxt; cA = nA; cB = nB; ++ui;
        if constexpr (ALIGN_EPI) { if (wr == 1) PG8_BAR; }
    }
    PG8_WAIT_V(0);
    if constexpr (!ALIGN_EPI) { if (wr == 0) PG8_BAR; }
    PG8_BAR;
    if constexpr (Epi::AFTER_DRAIN) { E.fused(acc, cur, wr, wc, fr, fq, lds, wid, lane); S.done(cur); }
#undef PG8_SA
#undef PG8_SB
#undef PG8_STAGE
#undef PG8_LDA
#undef PG8_LDB
#undef PG8_MMA
#undef PG8_WAIT_V
#undef PG8_WAIT_L
#undef PG8_BAR
#undef PG8_SCHED
}
}
constexpr int S_ = 16384, D_ = 1024, FF_ = 2816, NIN_ = 7448, NINP_ = 7680;
constexpr int NTHREADS = 512;
constexpr size_t MiB = 1u << 20;
constexpr size_t WS_CTL = 0;
constexpr size_t WS_MOD = 1 * MiB;
constexpr size_t WS_ROPE = 2 * MiB;
constexpr size_t WS_W = 6 * MiB;
constexpr size_t W_FFIN0 = 0, W_FFIN1 = 11 * MiB, W_FFOUT0 = 22 * MiB, W_FFOUT1 = 27 * MiB + MiB / 2, W_IN = 33 * MiB, W_BATT = 48 * MiB, W_BDN = 48 * MiB + MiB / 2, W_OUT = 50 * MiB;
constexpr size_t WS_H = 58 * MiB;
constexpr size_t WS_R = 90 * MiB;
constexpr size_t R_ACT = 0, R_Y = 88 * MiB;
constexpr size_t R_PA = 0, R_QKVD = 0, R_PG = 0, R_PD = 72 * MiB, R_TINV = 72 * MiB, R_ODIR1 = 120 * MiB, R_ODN = 72 * MiB, R_T1 = 96 * MiB, R_PZ = 144 * MiB, R_AB = 168 * MiB, R_GB = 170 * MiB,
                 R_OATT = 172 * MiB, R_ATTN = 180 * MiB, R_Y2 = 160 * MiB, R_OG = 228 * MiB, R_LSE = 252 * MiB, R_ODIR0 = 228 * MiB, R_VEC = 253 * MiB;
constexpr size_t WS_END = 352 * MiB;

typedef unsigned short bf16;
typedef unsigned v4u __attribute__((ext_vector_type(4)));
typedef unsigned v2u __attribute__((ext_vector_type(2)));
typedef float f32x4 __attribute__((ext_vector_type(4)));
typedef float f32x2 __attribute__((ext_vector_type(2)));
#define LAS __attribute__((address_space(3)))

__device__ __forceinline__ unsigned f2bf(float f) { unsigned u = __builtin_bit_cast(unsigned, f); return (u + 0x7fffu + ((u >> 16) & 1u)) >> 16; }
__device__ __forceinline__ unsigned pk2(float lo, float hi) { return f2bf(lo) | (f2bf(hi) << 16); }
__device__ __forceinline__ float bf2f(unsigned short b) { return __builtin_bit_cast(float, (unsigned)b << 16); }
__device__ __forceinline__ float bflo(unsigned w) { return __builtin_bit_cast(float, w << 16); }
__device__ __forceinline__ float bfhi(unsigned w) { return __builtin_bit_cast(float, w & 0xffff0000u); }
__device__ __forceinline__ float wave_sum(float v) {
#pragma unroll
    for (int o = 1; o < 64; o <<= 1) v += __shfl_xor(v, o);
    return v;
}
__device__ __forceinline__ float sigmoidf_(float x) { return 1.0f / (1.0f + __expf(-x)); }
__device__ __forceinline__ float siluf_(float x) { return x / (1.0f + __expf(-x)); }

namespace pg8 {
struct EpiSwiglu {
    static constexpr bool PERM = true, AFTER_DRAIN = false;
    bf16_t* O; int ldc; int pad_;
    __device__ __forceinline__ void operator()(const f32x4 (&acc)[2][2][4][2], const Unit& u, int wr, int wc, int fr, int fq) const {
        const int row0 = u.pm * BM + wr * 64 + fr, col0 = u.pn * 128 + wc * 32 + 8 * fq;
#pragma unroll
        for (int ai = 0; ai < 2; ++ai)
#pragma unroll
            for (int m = 0; m < 4; ++m) {
                bf16_t* rowp = O + (size_t)(row0 + ai * HALF + m * 16) * ldc + col0;
                float v[8];
#pragma unroll
                for (int n = 0; n < 2; ++n)
#pragma unroll
                    for (int e = 0; e < 4; ++e) { const float g = acc[ai][0][m][n][e], uu = acc[ai][1][m][n][e]; v[n * 4 + e] = g * __builtin_amdgcn_rcpf(1.0f + __expf(-g)) * uu; }
                u32x4 w; w.x = cvt_pk_bf16(v[0], v[1]); w.y = cvt_pk_bf16(v[2], v[3]); w.z = cvt_pk_bf16(v[4], v[5]); w.w = cvt_pk_bf16(v[6], v[7]);
                *(u32x4*)rowp = w;
            }
    }
};
struct EpiBf16P {
    static constexpr bool PERM = true, AFTER_DRAIN = false;
    bf16_t* O; int ldc; int pad_;
    __device__ __forceinline__ void operator()(const f32x4 (&acc)[2][2][4][2], const Unit& u, int wr, int wc, int fr, int fq) const {
        const int row0 = u.pm * BM + wr * 64 + fr, col0 = u.pn * BM + wc * 32 + 8 * fq;
#pragma unroll
        for (int ai = 0; ai < 2; ++ai)
#pragma unroll
            for (int m = 0; m < 4; ++m) {
                bf16_t* rowp = O + (size_t)(row0 + ai * HALF + m * 16) * ldc + col0;
#pragma unroll
                for (int bj = 0; bj < 2; ++bj) { const f32x4 v0 = acc[ai][bj][m][0], v1 = acc[ai][bj][m][1];
                    u32x4 w; w.x = cvt_pk_bf16(v0[0], v0[1]); w.y = cvt_pk_bf16(v0[2], v0[3]); w.z = cvt_pk_bf16(v1[0], v1[1]); w.w = cvt_pk_bf16(v1[2], v1[3]);
                    *(u32x4*)(rowp + bj * HALF) = w; }
            }
    }
};
struct EpiF32 {
    static constexpr bool PERM = false, AFTER_DRAIN = false;
    float* O; int ldc; int pad_;
    __device__ __forceinline__ void operator()(const f32x4 (&acc)[2][2][4][2], const Unit& u, int wr, int wc, int fr, int fq) const {
        const int row0 = u.pm * BM + wr * 64 + fr, col0 = u.pn * BM + wc * 32 + 4 * fq;
#pragma unroll
        for (int ai = 0; ai < 2; ++ai)
#pragma unroll
            for (int m = 0; m < 4; ++m) {
                float* rowp = O + (size_t)(row0 + ai * HALF + m * 16) * ldc + col0;
#pragma unroll
                for (int bj = 0; bj < 2; ++bj)
#pragma unroll
                    for (int n = 0; n < 2; ++n) *(f32x4*)(rowp + bj * HALF + n * 16) = acc[ai][bj][m][n];
            }
    }
};
struct EpiInProj {
    static constexpr bool PERM = true, AFTER_DRAIN = false;
    bf16_t* PA; bf16_t* PD; bf16_t* PZ; float* AB;
    __device__ __forceinline__ void operator()(const f32x4 (&acc)[2][2][4][2], const Unit& u, int wr, int wc, int fr, int fq) const {
        const int row0 = u.pm * BM + wr * 64 + fr;
        if (u.pn == 21) {
            if (wc == 0) {
#pragma unroll
                for (int ai = 0; ai < 2; ++ai)
#pragma unroll
                    for (int m = 0; m < 4; ++m) {
                        float* rowp = AB + (size_t)(row0 + ai * HALF + m * 16) * 32 + 8 * fq;
                        *(f32x4*)rowp = acc[ai][0][m][0]; *(f32x4*)(rowp + 4) = acc[ai][0][m][1];
                    }
            }
            return;
        }
        bf16_t* base; int ldc, ct;
        if (u.pn < 9) { base = PA; ldc = 2304; ct = u.pn; } else if (u.pn < 18) { base = PD; ldc = 2304; ct = u.pn - 9; } else { base = PZ; ldc = 768; ct = u.pn - 18; }
        const int col0 = ct * BM + wc * 32 + 8 * fq;
#pragma unroll
        for (int ai = 0; ai < 2; ++ai)
#pragma unroll
            for (int m = 0; m < 4; ++m) {
                bf16_t* rowp = base + (size_t)(row0 + ai * HALF + m * 16) * ldc + col0;
#pragma unroll
                for (int bj = 0; bj < 2; ++bj) { const f32x4 v0 = acc[ai][bj][m][0], v1 = acc[ai][bj][m][1];
                    u32x4 w; w.x = cvt_pk_bf16(v0[0], v0[1]); w.y = cvt_pk_bf16(v0[2], v0[3]); w.z = cvt_pk_bf16(v1[0], v1[1]); w.w = cvt_pk_bf16(v1[2], v1[3]);
                    *(u32x4*)(rowp + bj * HALF) = w; }
            }
    }
};
struct EpiGateF32 {
    static constexpr bool PERM = false, AFTER_DRAIN = false;
    float* O; const bf16_t* gate; int ldg; int pad_;
    __device__ __forceinline__ void operator()(const f32x4 (&acc)[2][2][4][2], const Unit& u, int wr, int wc, int fr, int fq) const {
        const int row0 = u.pm * BM + wr * 64 + fr, col0 = u.pn * BM + wc * 32 + 4 * fq;
#pragma unroll
        for (int ai = 0; ai < 2; ++ai)
#pragma unroll
            for (int m = 0; m < 4; ++m) {
                const size_t r = (size_t)(row0 + ai * HALF + m * 16);
#pragma unroll
                for (int bj = 0; bj < 2; ++bj)
#pragma unroll
                    for (int n = 0; n < 2; ++n) { const int c = col0 + bj * HALF + n * 16;
                        const v2u gw = *(const v2u*)(gate + r * ldg + c);
                        f32x4 a = acc[ai][bj][m][n];
                        a[0] *= sigmoidf_(bflo(gw.x)); a[1] *= sigmoidf_(bfhi(gw.x)); a[2] *= sigmoidf_(bflo(gw.y)); a[3] *= sigmoidf_(bfhi(gw.y));
                        *(f32x4*)(O + r * 1024 + c) = a; }
            }
    }
};
struct EpiGateAddBf16 {
    static constexpr bool PERM = false, AFTER_DRAIN = false;
    bf16_t* O; const float* T1; const bf16_t* gate; int ldg; int pad_;
    __device__ __forceinline__ void operator()(const f32x4 (&acc)[2][2][4][2], const Unit& u, int wr, int wc, int fr, int fq) const {
        const int row0 = u.pm * BM + wr * 64 + fr, col0 = u.pn * BM + wc * 32 + 4 * fq;
#pragma unroll
        for (int ai = 0; ai < 2; ++ai)
#pragma unroll
            for (int m = 0; m < 4; ++m) {
                const size_t r = (size_t)(row0 + ai * HALF + m * 16);
#pragma unroll
                for (int bj = 0; bj < 2; ++bj)
#pragma unroll
                    for (int n = 0; n < 2; ++n) { const int c = col0 + bj * HALF + n * 16;
                        const v2u gw = *(const v2u*)(gate + r * ldg + c);
                        const f32x4 t = *(const f32x4*)(T1 + r * 1024 + c);
                        f32x4 a = acc[ai][bj][m][n];
                        a[0] = t[0] + a[0] * sigmoidf_(bflo(gw.x)); a[1] = t[1] + a[1] * sigmoidf_(bfhi(gw.x)); a[2] = t[2] + a[2] * sigmoidf_(bflo(gw.y)); a[3] = t[3] + a[3] * sigmoidf_(bfhi(gw.y));
                        v2u w; w.x = cvt_pk_bf16(a[0], a[1]); w.y = cvt_pk_bf16(a[2], a[3]);
                        *(v2u*)(O + r * 1024 + c) = w; }
            }
    }
};
}


#define GAS __attribute__((address_space(1)))
struct Params { const float* in[17]; float* out; unsigned char* ws; };
#define XB_TMO      128
#define XB_XCNT(j)  (256  + 64 * (j))
#define XB_XSUB(j)  (1280 + 64 * (j))
#define XB_XGEN(j)  (2304 + 64 * (j))
#define XB_TOP      3328
#define XB_TOPGEN   3392
#define XCD_BAR_WORDS 3456
#define XB_SPIN_CAP (1u << 18)

__device__ __forceinline__ unsigned xb_ld(unsigned* p)              { return __hip_atomic_load(p, __ATOMIC_RELAXED, __HIP_MEMORY_SCOPE_AGENT); }
__device__ __forceinline__ unsigned xb_add(unsigned* p, unsigned v) { return __hip_atomic_fetch_add(p, v, __ATOMIC_RELAXED, __HIP_MEMORY_SCOPE_AGENT); }
__device__ __forceinline__ unsigned xb_xcc_id() { return (unsigned)__builtin_amdgcn_s_getreg((3 << 11) | 20) & 0xFu; }
#define XB_SPIN(cond, bar) do { unsigned _sp = 0; while (cond) { __builtin_amdgcn_s_sleep(1); \
    if ((++_sp & 255u) == 0u) { if (xb_ld(&(bar)[XB_TMO])) break; if (_sp > XB_SPIN_CAP) { atomicAdd(&(bar)[XB_TMO], 1u); break; } } } } while (0)

struct XcdBarrier {
    unsigned* bar; unsigned x;
    volatile LAS unsigned* st;
};

__device__ __forceinline__ XcdBarrier xcd_barrier_post(unsigned* bar, volatile LAS unsigned* st) {
    XcdBarrier b; b.bar = bar; b.x = xb_xcc_id(); b.st = st;
    if (threadIdx.x == 0) (void)xb_add(&bar[XB_XCNT(b.x)], 1u);
    return b;
}
__device__ __forceinline__ void xcd_barrier_complete(unsigned* bar, unsigned x, unsigned& nloc, unsigned& nx) {
    const unsigned G = gridDim.x * gridDim.y * gridDim.z;
    unsigned sum, cnt, mine, sp = 0u;
    for (;;) {
        sum = 0u; cnt = 0u; mine = 0u;
#pragma unroll
        for (unsigned j = 0; j < 16; ++j) { const unsigned c = xb_ld(&bar[XB_XCNT(j)]); sum += c; cnt += (c > 0u) ? 1u : 0u; mine = (j == x) ? c : mine; }
        if (sum == G) break;
        __builtin_amdgcn_s_sleep(1);
        if ((++sp & 255u) == 0u) { if (xb_ld(&bar[XB_TMO])) break; if (sp > XB_SPIN_CAP) { atomicAdd(&bar[XB_TMO], 1u); break; } }
    }
    nloc = mine > 0u ? mine : 1u; nx = cnt > 0u ? cnt : 1u;
}

__device__ __forceinline__ void xcd_barrier(const XcdBarrier& b, int wv) {
    const bool leader_thread = (wv == 0) && (lane_id_() == 0);
    asm volatile("s_waitcnt vmcnt(0)" ::: "memory");
    __syncthreads();
    if (leader_thread) {
        unsigned* bar = b.bar;
        __builtin_amdgcn_s_waitcnt(0);
        unsigned nloc = b.st[0], nx = b.st[1];
        if (nloc == 0u) { xcd_barrier_complete(bar, b.x, nloc, nx); b.st[0] = nloc; b.st[1] = nx; }
        const unsigned old = xb_add(&bar[XB_XSUB(b.x)], 1u);
        const unsigned gen = old / nloc;
        if (old + 1u == (gen + 1u) * nloc) {
            __builtin_amdgcn_fence(__ATOMIC_RELEASE, "agent");
            asm volatile("s_waitcnt vmcnt(0)" ::: "memory");
            const unsigned og = xb_add(&bar[XB_TOP], 1u);
            const unsigned tg = og / nx;
            if (og + 1u == (tg + 1u) * nx) xb_add(&bar[XB_TOPGEN], 1u);
            else XB_SPIN(xb_ld(&bar[XB_TOPGEN]) == tg, bar);
            __builtin_amdgcn_fence(__ATOMIC_ACQUIRE, "agent");
            xb_add(&bar[XB_XGEN(b.x)], 1u);
            asm volatile("s_waitcnt vmcnt(0)" ::: "memory");
        } else {
            XB_SPIN(xb_ld(&bar[XB_XGEN(b.x)]) == gen, bar);
            __builtin_amdgcn_fence(__ATOMIC_ACQUIRE, "agent");
            asm volatile("s_waitcnt vmcnt(0)" ::: "memory");
        }
    }
    __syncthreads();
}

typedef const __attribute__((address_space(4))) unsigned char* ka_t;
__device__ __forceinline__ ka_t ka_() { ka_t k = (ka_t)__builtin_amdgcn_kernarg_segment_ptr(); asm volatile("" : "+s"(k)); return k; }
#define PIN(i) ((const float*)(*(const __attribute__((address_space(4))) unsigned long long*)(ka_() + 8 * (i))))
#define POUT ((float*)(*(const __attribute__((address_space(4))) unsigned long long*)(ka_() + 136)))
#define PWS ((unsigned char*)(*(const __attribute__((address_space(4))) unsigned long long*)(ka_() + 144)))
#define BID ((int)blockIdx.x)
#define GSZ ((int)gridDim.x)
__device__ __forceinline__ int srcmap(int mode, int n) {
    if (mode == 0) return n;
    if (mode == 1) return (n >> 8) * 128 + (n & 127) + ((n >> 7) & 1) * 2816;
    if (n < 5400) return n;
    if (n < 5632) return -1;
    if (n < 6656) return 5400 + (n - 5632);
    return 6424 + (n - 6656);
}
__device__ __forceinline__ void conv_item(const float* W, bf16* WT, int K, int Nsrc, int Ndst, int mode, int item, float* scr, int lane) {
    const int nblk = Ndst / 32, kb = item / nblk, nb = item % nblk, k0 = 64 * kb, n0 = 32 * nb;
    const int sc = srcmap(mode, n0 + (lane & 31));
#pragma unroll
    for (int i = 0; i < 32; ++i) { const int kk = 2 * i + (lane >> 5); scr[kk * 33 + (lane & 31)] = sc >= 0 ? W[(size_t)(k0 + kk) * Nsrc + sc] : 0.f; }
    __builtin_amdgcn_s_waitcnt(0xc07f); __builtin_amdgcn_wave_barrier();
    const int c = lane & 7;
#pragma unroll
    for (int j = 0; j < 4; ++j) { const int n = (lane >> 3) + 8 * j; const float* s = scr + (8 * c) * 33 + n;
        v4u o; o.x = pk2(s[0 * 33], s[1 * 33]); o.y = pk2(s[2 * 33], s[3 * 33]); o.z = pk2(s[4 * 33], s[5 * 33]); o.w = pk2(s[6 * 33], s[7 * 33]);
        *(v4u*)(WT + (size_t)(n0 + n) * K + k0 + 8 * c) = o; }
    __builtin_amdgcn_s_waitcnt(0xc07f); __builtin_amdgcn_wave_barrier();
}
__device__ __forceinline__ void ph_convert(int l, unsigned char* lds, int wv) {
    int tid_ = wv * 64 + lane_id_(); asm volatile("" : "+v"(tid_)); const int lane = tid_ & 63, wave = tid_ >> 6;
    float* scr = (float*)lds + wave * (64 * 33);
    unsigned char* wb = PWS + WS_W;
    constexpr int I_FI = 16 * 176, I_FO = 44 * 32, I_IN = 16 * 240, I_BA = 4 * 32, I_BD = 12 * 32, I_O = 16 * 32;
    constexpr int NIT = 2 * I_FI + 2 * I_FO + I_IN + I_BA + I_BD + I_O;
    for (int it = BID * 8 + wave; it < NIT; it += GSZ * 8) {
        int r = it;
        if (r < 2 * I_FI) { const int f = r / I_FI; conv_item(PIN(7) + ((size_t)l * 2 + f) * 1024 * 5632, (bf16*)(wb + (f ? W_FFIN1 : W_FFIN0)), 1024, 5632, 5632, 1, r % I_FI, scr, lane); continue; } r -= 2 * I_FI;
        if (r < 2 * I_FO) { const int f = r / I_FO; conv_item(PIN(8) + ((size_t)l * 2 + f) * 2816 * 1024, (bf16*)(wb + (f ? W_FFOUT1 : W_FFOUT0)), 2816, 1024, 1024, 0, r % I_FO, scr, lane); continue; } r -= 2 * I_FO;
        if (r < I_IN) { conv_item(PIN(9) + (size_t)l * 1024 * NIN_, (bf16*)(wb + W_IN), 1024, NIN_, NINP_, 2, r, scr, lane); continue; } r -= I_IN;
        if (r < I_BA) { conv_item(PIN(14) + (size_t)l * 256 * 1024, (bf16*)(wb + W_BATT), 256, 1024, 1024, 0, r, scr, lane); continue; } r -= I_BA;
        if (r < I_BD) { conv_item(PIN(15) + (size_t)l * 768 * 1024, (bf16*)(wb + W_BDN), 768, 1024, 1024, 0, r, scr, lane); continue; } r -= I_BD;
        conv_item(PIN(16) + (size_t)l * 1024 * 1024, (bf16*)(wb + W_OUT), 1024, 1024, 1024, 0, r, scr, lane);
    }
}
__device__ __forceinline__ void ph_ada(unsigned char* lds, int wv) {
    float* red = (float*)(lds + 72 * 1024);
    int tid_ = wv * 64 + lane_id_(); asm volatile("" : "+v"(tid_)); const int tid = tid_, lane = tid_ & 63, wave = tid_ >> 6;
    const float* c = PIN(1); const float* w_ada = PIN(3); const float* b_ada = PIN(4); float* mod = (float*)(PWS + WS_MOD);
    for (int u = BID; u < 72; u += GSZ) {
        const int l = u / 36, n0 = (u % 36) * 256;
        const float* W = w_ada + (size_t)l * 1024 * 9216 + (size_t)(wave * 128) * 9216 + n0 + 4 * lane;
        f32x4 acc = {0.f, 0.f, 0.f, 0.f};
#pragma unroll 1
        for (int k0 = 0; k0 < 128; k0 += 16) {
            f32x4 wv4[16];
#pragma unroll
            for (int kk = 0; kk < 16; ++kk) wv4[kk] = *(const f32x4*)(W + (size_t)(k0 + kk) * 9216);
#pragma unroll
            for (int kk = 0; kk < 16; ++kk) { const float cv = c[wave * 128 + k0 + kk]; const float sv = cv / (1.0f + __expf(-cv)); acc += sv * wv4[kk]; }
        }
        *(f32x4*)(red + wave * 256 + 4 * lane) = acc;
        __syncthreads();
        if (tid < 256) { float t = b_ada[l * 9216 + n0 + tid];
#pragma unroll
            for (int w = 0; w < 8; ++w) t += red[w * 256 + tid];
            mod[l * 9216 + n0 + tid] = t; }
        __syncthreads();
    }
}
__device__ const float ROPE_INV[32] = {1.000000000e+00f, 7.498942018e-01f, 5.623413324e-01f, 4.216965139e-01f, 3.162277639e-01f, 2.371373773e-01f, 1.778279394e-01f, 1.333521456e-01f, 1.000000015e-01f, 7.498942316e-02f, 5.623413250e-02f, 4.216964915e-02f, 3.162277490e-02f, 2.371373773e-02f, 1.778279431e-02f, 1.333521400e-02f, 9.999999776e-03f, 7.498942316e-03f, 5.623413250e-03f, 4.216964822e-03f, 3.162277630e-03f, 2.371373819e-03f, 1.778279431e-03f, 1.333521446e-03f, 1.000000047e-03f, 7.498941850e-04f, 5.623413017e-04f, 4.216965172e-04f, 3.162277571e-04f, 2.371373703e-04f, 1.778279402e-04f, 1.333521504e-04f};
__device__ __forceinline__ void ph_rope(int wv) {
    const int* pos = (const int*)PIN(2); float* tab = (float*)(PWS + WS_ROPE);
    int tid_ = wv * 64 + lane_id_(); asm volatile("" : "+v"(tid_));
    for (int idx = BID * NTHREADS + tid_; idx < S_ * 32; idx += GSZ * NTHREADS) {
        const int t = idx >> 5, i = idx & 31;
        const float inv = ROPE_INV[i];
        const float ang = (float)pos[t] * inv;
        float sn, cs; sincosf(ang, &sn, &cs);
        tab[idx] = cs; tab[S_ * 32 + idx] = sn;
    }
}
struct RowArgs { const float* xi; const float* y; float* xo; bf16* h; const float* wpost; const float* gate; const float* wpre; const float* shift; const float* scale; float coef; };
__device__ __forceinline__ void ph_rows(const RowArgs& a, int wv) {
    int tid_ = wv * 64 + lane_id_(); asm volatile("" : "+v"(tid_)); const int lane = tid_ & 63, wave = tid_ >> 6;
    for (int r = BID * 8 + wave; r < S_; r += GSZ * 8) {
        f32x4 x[4];
        const f32x4* xr = (const f32x4*)(a.xi + (size_t)r * D_) + lane;
#pragma unroll
        for (int j = 0; j < 4; ++j) x[j] = xr[64 * j];
        if (a.y) {
            f32x4 y[4]; float s = 0.f;
            const f32x4* yr = (const f32x4*)(a.y + (size_t)r * D_) + lane;
#pragma unroll
            for (int j = 0; j < 4; ++j) { y[j] = yr[64 * j]; s += (y[j].x * y[j].x + y[j].y * y[j].y) + (y[j].z * y[j].z + y[j].w * y[j].w); }
            const float rs = 1.0f / sqrtf(wave_sum(s) * (1.f / D_) + 1e-6f);
#pragma unroll
            for (int j = 0; j < 4; ++j) { const f32x4 wp = ((const f32x4*)a.wpost)[lane + 64 * j], g = ((const f32x4*)a.gate)[lane + 64 * j];
                x[j] = x[j] + a.coef * g * ((y[j] * rs) * wp); }
            f32x4* xw = (f32x4*)(a.xo + (size_t)r * D_) + lane;
#pragma unroll
            for (int j = 0; j < 4; ++j) xw[64 * j] = x[j];
        }
        if (a.h) {
            float s = 0.f;
#pragma unroll
            for (int j = 0; j < 4; ++j) s += (x[j].x * x[j].x + x[j].y * x[j].y) + (x[j].z * x[j].z + x[j].w * x[j].w);
            const float rs = 1.0f / sqrtf(wave_sum(s) * (1.f / D_) + 1e-6f);
            v2u* hw = (v2u*)(a.h + (size_t)r * D_) + lane;
#pragma unroll
            for (int j = 0; j < 4; ++j) { const f32x4 wp = ((const f32x4*)a.wpre)[lane + 64 * j], sc = ((const f32x4*)a.scale)[lane + 64 * j], sh = ((const f32x4*)a.shift)[lane + 64 * j];
                const f32x4 v = ((x[j] * rs) * wp) * (1.0f + sc) + sh;
                v2u w; w.x = pk2(v.x, v.y); w.y = pk2(v.z, v.w); hw[64 * j] = w; }
        }
    }
}
constexpr int ATT_PITCH = 68;
__device__ __forceinline__ void ph_attn_v1(const bf16* PA, const float* rope, bf16* OG, float* LSE, unsigned char* lds, int wv) {
    float* qs = (float*)lds; float* ks = qs + 64 * ATT_PITCH; float* vs = ks + 192 * ATT_PITCH;
    int tid_ = wv * 64 + lane_id_(); asm volatile("" : "+v"(tid_)); const int tid = tid_, lane = tid & 63, wave = tid >> 6;
    for (int u = BID; u < 3072; u += GSZ) {
        const int hg = u & 3, w = (u >> 2) & 255, gi = u >> 10;
        const int dil = 1 << (2 * gi), L = S_ / dil, r = w % dil, nb = w / dil, head = gi * 4 + hg;
        __syncthreads();
        for (int rr = wave; rr < 448; rr += 8) {
            int mm, colbase; float* dst; bool rot; float sc = 1.f;
            if (rr < 64) { mm = nb * 64 + rr; colbase = head * 64; dst = qs + rr * ATT_PITCH; rot = true; sc = 0.125f; }
            else if (rr < 256) { mm = nb * 64 - 64 + (rr - 64); colbase = 768 + head * 64; dst = ks + (rr - 64) * ATT_PITCH; rot = true; }
            else { mm = nb * 64 - 64 + (rr - 256); colbase = 1536 + head * 64; dst = vs + (rr - 256) * ATT_PITCH; rot = false; }
            float val = 0.f;
            if (mm >= 0 && mm < L) {
                const int tok = mm * dil + r;
                val = bf2f(PA[(size_t)tok * 2304 + colbase + lane]);
                if (rot) {
                    const float other = __shfl_xor(val, 32);
                    const float cs = rope[tok * 32 + (lane & 31)], sn = rope[S_ * 32 + tok * 32 + (lane & 31)];
                    val = (lane < 32) ? (val * cs - other * sn) : (val * cs + other * sn);
                }
            }
            dst[lane] = val * sc;
        }
        __syncthreads();
        const int i = tid >> 3, part = tid & 7;
        float q[64], acc[64];
#pragma unroll
        for (int d = 0; d < 64; d += 4) { const f32x4 t = *(const f32x4*)(qs + i * ATT_PITCH + d); q[d] = t.x; q[d + 1] = t.y; q[d + 2] = t.z; q[d + 3] = t.w; }
#pragma unroll
        for (int d = 0; d < 64; ++d) acc[d] = 0.f;
        float m = -1e30f, l = 0.f;
        for (int jj = 0; jj < 24; ++jj) {
            const int j = part + 8 * jj, mm = nb * 64 - 64 + j, dj = j - 64 - i;
            const bool ok = (dj <= 64) && (dj >= -64) && (mm >= 0) && (mm < L);
            if (ok) {
                const float* kr = ks + j * ATT_PITCH; float s = 0.f;
#pragma unroll
                for (int d = 0; d < 64; d += 4) { const f32x4 t = *(const f32x4*)(kr + d); s += q[d] * t.x + q[d + 1] * t.y + q[d + 2] * t.z + q[d + 3] * t.w; }
                const float mn = fmaxf(m, s), al = __expf(m - mn), p = __expf(s - mn);
                l = l * al + p; m = mn;
                const float* vr = vs + j * ATT_PITCH;
#pragma unroll
                for (int d = 0; d < 64; d += 4) { const f32x4 t = *(const f32x4*)(vr + d);
                    acc[d] = acc[d] * al + p * t.x; acc[d + 1] = acc[d + 1] * al + p * t.y; acc[d + 2] = acc[d + 2] * al + p * t.z; acc[d + 3] = acc[d + 3] * al + p * t.w; }
            }
        }
        float mt = fmaxf(m, __shfl_xor(m, 1)); mt = fmaxf(mt, __shfl_xor(mt, 2)); mt = fmaxf(mt, __shfl_xor(mt, 4));
        const float f = __expf(m - mt);
        l *= f; l += __shfl_xor(l, 1); l += __shfl_xor(l, 2); l += __shfl_xor(l, 4);
#pragma unroll
        for (int d = 0; d < 64; ++d) acc[d] *= f;
        const bool b2 = part & 4, b1 = part & 2, b0 = part & 1;
        float r32[32], r16[16], r8[8];
#pragma unroll
        for (int d = 0; d < 32; ++d) { const float keep = b2 ? acc[32 + d] : acc[d], send = b2 ? acc[d] : acc[32 + d]; r32[d] = keep + __shfl_xor(send, 4); }
#pragma unroll
        for (int d = 0; d < 16; ++d) { const float keep = b1 ? r32[16 + d] : r32[d], send = b1 ? r32[d] : r32[16 + d]; r16[d] = keep + __shfl_xor(send, 2); }
#pragma unroll
        for (int d = 0; d < 8; ++d) { const float keep = b0 ? r16[8 + d] : r16[d], send = b0 ? r16[d] : r16[8 + d]; r8[d] = keep + __shfl_xor(send, 1); }
        const float il = 1.0f / l;
        const int tok = (nb * 64 + i) * dil + r;
        v4u o; o.x = pk2(r8[0] * il, r8[1] * il); o.y = pk2(r8[2] * il, r8[3] * il); o.z = pk2(r8[4] * il, r8[5] * il); o.w = pk2(r8[6] * il, r8[7] * il);
        *(v4u*)(OG + ((size_t)gi * S_ + tok) * 256 + hg * 64 + part * 8) = o;
        if (part == 0) LSE[((size_t)gi * S_ + tok) * 4 + hg] = mt + logf(l);
    }
}

__device__ __forceinline__ void ph_dnprep(const bf16* PD, const float* AB, const float* convw, const float* a_log, const float* dt_bias, bf16* QKVd, float* GB, const bf16* OG, const float* LSE, bf16* OATT, int wv) {
    int tid_ = wv * 64 + lane_id_(); asm volatile("" : "+v"(tid_)); const int tid = tid_, lane = tid_ & 63, wave = tid_ >> 6;
    for (int it = BID * 8 + wave; it < 1024 * 5; it += GSZ * 8) {
        const int tb = it / 5, sg = it % 5, c0 = sg * 512 + lane * 8, t0 = tb * 16;
        if (c0 < 2304) {
            const int seg = c0 >> 7;
            float cw[5][8];
#pragma unroll
            for (int j = 0; j < 5; ++j) { const f32x4 a = *(const f32x4*)(convw + j * 2304 + c0), b = *(const f32x4*)(convw + j * 2304 + c0 + 4);
                cw[j][0] = a.x; cw[j][1] = a.y; cw[j][2] = a.z; cw[j][3] = a.w; cw[j][4] = b.x; cw[j][5] = b.y; cw[j][6] = b.z; cw[j][7] = b.w; }
            v4u win[5];
#pragma unroll
            for (int j = 0; j < 4; ++j) { const int tt = t0 + j - 2; win[j + 1] = (tt >= 0) ? *(const v4u*)(PD + (size_t)tt * 2304 + c0) : (v4u){0u, 0u, 0u, 0u}; }
#pragma unroll
            for (int i = 0; i < 16; ++i) {
#pragma unroll
                for (int j = 0; j < 4; ++j) win[j] = win[j + 1];
                { const int tt = t0 + i + 2; win[4] = (tt < S_) ? *(const v4u*)(PD + (size_t)tt * 2304 + c0) : (v4u){0u, 0u, 0u, 0u}; }
                float a[8];
#pragma unroll
                for (int e = 0; e < 8; ++e) a[e] = 0.f;
#pragma unroll
                for (int j = 0; j < 5; ++j) { const unsigned wx[4] = {win[j].x, win[j].y, win[j].z, win[j].w};
#pragma unroll
                    for (int e = 0; e < 4; ++e) { a[2 * e] += bflo(wx[e]) * cw[j][2 * e]; a[2 * e + 1] += bfhi(wx[e]) * cw[j][2 * e + 1]; } }
                float ss = 0.f;
#pragma unroll
                for (int e = 0; e < 8; ++e) { a[e] = a[e] * __builtin_amdgcn_rcpf(1.0f + __expf(-a[e])); ss += a[e] * a[e]; }
                if (seg < 12) {
                    ss += __shfl_xor(ss, 1); ss += __shfl_xor(ss, 2); ss += __shfl_xor(ss, 4); ss += __shfl_xor(ss, 8);
                    const float sc = (1.0f / sqrtf(ss + 1e-6f)) * (seg < 6 ? 0.08838834764831845f : 1.0f);
#pragma unroll
                    for (int e = 0; e < 8; ++e) a[e] *= sc;
                }
                v4u o; o.x = pk2(a[0], a[1]); o.y = pk2(a[2], a[3]); o.z = pk2(a[4], a[5]); o.w = pk2(a[6], a[7]);
                *(v4u*)(QKVd + (size_t)(t0 + i) * 2304 + c0) = o;
            }
        }
    }
    for (int e = BID * NTHREADS + tid; e < S_ * 12; e += GSZ * NTHREADS) {
        const int t = e / 12, idx = e % 12;
        const float braw = AB[(size_t)t * 32 + idx], araw = AB[(size_t)t * 32 + 12 + idx];
        const float x = araw + dt_bias[idx];
        const float sp = fmaxf(x, 0.f) + log1pf(expf(-fabsf(x)));
        GB[(size_t)idx * S_ + t] = -expf(a_log[idx]) * sp;
        GB[(size_t)(12 + idx) * S_ + t] = 1.0f / (1.0f + expf(-braw));
    }
    for (int t = BID * 8 + wave; t < S_; t += GSZ * 8) {
        const int ch = 4 * lane, hg = lane >> 4;
        const float l0 = LSE[(size_t)t * 4 + hg], l1 = LSE[((size_t)S_ + t) * 4 + hg], l2 = LSE[((size_t)2 * S_ + t) * 4 + hg];
        const float mx = fmaxf(l0, fmaxf(l1, l2));
        float w0 = expf(l0 - mx), w1 = expf(l1 - mx), w2 = expf(l2 - mx);
        const float inv = 1.0f / (w0 + w1 + w2); w0 *= inv; w1 *= inv; w2 *= inv;
        const v2u a = *(const v2u*)(OG + (size_t)t * 256 + ch), b = *(const v2u*)(OG + ((size_t)S_ + t) * 256 + ch), cc = *(const v2u*)(OG + ((size_t)2 * S_ + t) * 256 + ch);
        v2u o;
        o.x = pk2(w0 * bflo(a.x) + w1 * bflo(b.x) + w2 * bflo(cc.x), w0 * bfhi(a.x) + w1 * bfhi(b.x) + w2 * bfhi(cc.x));
        o.y = pk2(w0 * bflo(a.y) + w1 * bflo(b.y) + w2 * bflo(cc.y), w0 * bfhi(a.y) + w1 * bfhi(b.y) + w2 * bfhi(cc.y));
        *(v2u*)(OATT + (size_t)t * 256 + ch) = o;
    }
}

__device__ __forceinline__ void ph_final(const bf16* ODIR0, const bf16* ODIR1, const bf16* PZ, const float* dnw, bf16* ODN, int wv) {
    int tid_ = wv * 64 + lane_id_(); asm volatile("" : "+v"(tid_)); const int lane = tid_ & 63, wave = tid_ >> 6;
    for (int t = BID * 8 + wave; t < S_; t += GSZ * 8) {
#pragma unroll
        for (int h = 0; h < 6; ++h) {
            const int c = h * 128 + 2 * lane;
            const unsigned wf = *(const unsigned*)(ODIR0 + (size_t)t * 768 + c), wb = *(const unsigned*)(ODIR1 + (size_t)t * 768 + c);
            float o0 = bflo(wf) + bflo(wb), o1 = bfhi(wf) + bfhi(wb);
            const float ms = wave_sum(o0 * o0 + o1 * o1) * (1.0f / 128.0f);
            const float sc = 1.0f / sqrtf(ms + 1e-6f);
            const unsigned zw = *(const unsigned*)(PZ + (size_t)t * 768 + c);
            const f32x2 nw = *(const f32x2*)(dnw + 2 * lane);
            o0 = o0 * sc * nw.x * siluf_(bflo(zw)); o1 = o1 * sc * nw.y * siluf_(bfhi(zw));
            *(unsigned*)(ODN + (size_t)t * 768 + c) = pk2(o0, o1);
        }
    }
}
typedef short bf16x8_t __attribute__((ext_vector_type(8)));
typedef short s16x4_t __attribute__((ext_vector_type(4)));
#define MFMA16(a, b, c) __builtin_amdgcn_mfma_f32_16x16x32_bf16((a), (b), (c), 0, 0, 0)

__device__ __forceinline__ void ph_dn_pre(const bf16* QKVd, const float* GB, bf16* TINV, bf16* ATTN, float* VEC, unsigned char* lds, int wv) {
    int tid_ = wv * 64 + lane_id_(); asm volatile("" : "+v"(tid_));
    const int tid = tid_, lane = tid & 63, g = lane >> 4, m16 = lane & 15;
    float* GR = (float*)lds; float* Ms = GR + 2 * 64 * 65; float* Gs = Ms + 2 * 64 * 68; float* Bs = Gs + 128;
    for (int u = BID; u < 1536; u += GSZ) {
        const int n = u / 6, h = u % 6;
        __syncthreads();
        {
            const int kind = wv >> 2, mt = wv & 3;
            const bf16* arow = QKVd + (size_t)(64 * n + 16 * mt + m16) * 2304 + (kind ? 0 : 768) + h * 128 + 8 * g;
            bf16x8_t a[4];
#pragma unroll
            for (int ks = 0; ks < 4; ++ks) a[ks] = *(const bf16x8_t*)(arow + 32 * ks);
#pragma unroll
            for (int nt = 0; nt < 4; ++nt) {
                const bf16* brow = QKVd + (size_t)(64 * n + 16 * nt + m16) * 2304 + 768 + h * 128 + 8 * g;
                f32x4 acc = {0.f, 0.f, 0.f, 0.f};
#pragma unroll
                for (int ks = 0; ks < 4; ++ks) acc = MFMA16(a[ks], *(const bf16x8_t*)(brow + 32 * ks), acc);
#pragma unroll
                for (int rg = 0; rg < 4; ++rg) GR[kind * 64 * 65 + (16 * mt + 4 * g + rg) * 65 + 16 * nt + m16] = acc[rg];
            }
        }
        if ((wv & 3) == 0) {
            const int d = wv >> 2, tok = 64 * n + (d ? 63 - lane : lane);
            float gv = GB[(size_t)(d * 6 + h) * S_ + tok]; const float be = GB[(size_t)(12 + d * 6 + h) * S_ + tok];
#pragma unroll
            for (int o = 1; o < 64; o <<= 1) { const float t = __shfl_up(gv, o); if (lane >= o) gv += t; }
            const float gl = __shfl(gv, 63);
            Gs[d * 64 + lane] = gv; Bs[d * 64 + lane] = be;
            float* vec = VEC + (size_t)(u * 2 + d) * 256;
            vec[lane] = __expf(gv); vec[64 + lane] = be; vec[128 + lane] = __expf(gl - gv); vec[192 + lane] = __expf(gl);
        }
        __syncthreads();
        {
            const int d = wv >> 2, tl = tid & 255, i = tl >> 2, jq = tl & 3, ii = d ? 63 - i : i;
            const float Gi = Gs[d * 64 + i], bi = Bs[d * 64 + i];
            unsigned pk[8];
#pragma unroll
            for (int jj = 0; jj < 16; jj += 2) {
                float at[2];
#pragma unroll
                for (int e = 0; e < 2; ++e) {
                    const int j = 16 * jq + jj + e, jx = d ? 63 - j : j;
                    const float dec = (j <= i) ? __expf(Gi - Gs[d * 64 + j]) : 0.f;
                    const float kk = GR[ii * 65 + jx], qk = GR[64 * 65 + ii * 65 + jx];
                    Ms[d * 64 * 68 + i * 68 + j] = (j < i) ? bi * kk * dec : 0.f;
                    at[e] = (j <= i) ? qk * dec : 0.f;
                }
                pk[jj >> 1] = pk2(at[0], at[1]);
            }
            v4u* dst = (v4u*)(ATTN + ((size_t)(u * 2 + d) * 64 + i) * 64 + 16 * jq);
            v4u o0; o0.x = pk[0]; o0.y = pk[1]; o0.z = pk[2]; o0.w = pk[3]; v4u o1; o1.x = pk[4]; o1.y = pk[5]; o1.z = pk[6]; o1.w = pk[7];
            dst[0] = o0; dst[1] = o1;
        }
        __syncthreads();
        if ((wv & 3) == 0) {
            const int d = wv >> 2, c = lane; const float* Md = Ms + d * 64 * 68;
            float x[64];
            x[0] = (c == 0) ? 1.f : 0.f;
#pragma unroll
            for (int i = 1; i < 64; ++i) {
                f32x4 mr[16];
#pragma unroll
                for (int j0 = 0; j0 < i; j0 += 4) mr[j0 >> 2] = *(const f32x4*)(Md + i * 68 + j0);
                float s0 = (i == c) ? 1.f : 0.f, s1 = 0.f, s2 = 0.f, s3 = 0.f;
#pragma unroll
                for (int j0 = 0; j0 < i; j0 += 4) { const f32x4 mv = mr[j0 >> 2];
                    s0 -= mv.x * x[j0]; if (j0 + 1 < i) s1 -= mv.y * x[j0 + 1]; if (j0 + 2 < i) s2 -= mv.z * x[j0 + 2]; if (j0 + 3 < i) s3 -= mv.w * x[j0 + 3]; }
                x[i] = (s0 + s1) + (s2 + s3);
            }
            bf16* outp = TINV + (size_t)(u * 2 + d) * 4096 + c;
#pragma unroll
            for (int i = 0; i < 64; ++i) outp[i * 64] = (bf16)f2bf(x[i]);
        }
    }
}

constexpr int SC_KT = 0, SC_QT = 17408, SC_TI = 34816, SC_AT = 44032, SC_VT = 53248, SC_VC = 55296, SC_BUF = 56320;
constexpr int SC_ST = 2 * SC_BUF, SC_RT = SC_ST + 4352, SC_VNT = SC_RT + 2304, SC_VST = SC_VNT + 2304, SC_END = SC_VST + 2304;
static_assert(SC_END <= 131072, "scan LDS");
constexpr int SC_AHEAD = 10;
__device__ __forceinline__ void ph_dn_scan(const bf16* QKVd, const bf16* TINV, const bf16* ATTN, const float* VEC, bf16* ODIR0, bf16* ODIR1, unsigned* prog, LAS unsigned char* lds, int wv) {
    const int bid = BID;
    int tid_ = wv * 64 + lane_id_(); asm volatile("" : "+v"(tid_));
    const int tid = tid_, lane = tid & 63, g = lane >> 4, m16 = lane & 15;
    if (bid >= 128) {
        if (bid < 136) {
            const int x = bid - 128;
#pragma unroll 1
            for (int s = 0; s < 256; ++s) {
#pragma unroll 1
                for (int pp = x; pp < 12; pp += 8) {
                    unsigned spins = 0;
                    while (s > (int)__hip_atomic_load(prog + 64 * pp, __ATOMIC_RELAXED, __HIP_MEMORY_SCOPE_AGENT) + SC_AHEAD) { __builtin_amdgcn_s_sleep(16); if (++spins > (1u << 20)) break; }
                    const int dd = pp / 6, hh = pp % 6, n = dd ? 255 - s : s; const size_t cb = (size_t)((n * 6 + hh) * 2 + dd);
                    const bf16* src;
                    if (tid < 128) src = (tid < 64 ? TINV : ATTN) + cb * 4096 + (tid & 63) * 64;
                    else { const int q = tid - 128, kind = q >> 7, row = (q & 127) >> 1, half = q & 1; src = QKVd + (size_t)(64 * n + row) * 2304 + (kind == 0 ? 768 : (kind == 1 ? 0 : 1536)) + hh * 128 + half * 64; }
                    unsigned dummy; asm volatile("global_load_dword %0, %1, off" : "=v"(dummy) : "v"(src) : "memory");
                }
            }
            asm volatile("s_waitcnt vmcnt(0)" ::: "memory");
        }
        return;
    }
    const int p = (bid & 7) + 8 * (bid >> 6), sl = (bid >> 3) & 7;
    if (p >= 12) return;
    const int d = p / 6, h = p % 6;
    bf16* ODIR = d ? ODIR1 : ODIR0;
    v4u pfA[7], pfB[7];
#define SC_LOAD(pf, step) do { const int n_ = d ? 255 - (step) : (step); const size_t cb_ = (size_t)((n_ * 6 + h) * 2 + d); \
        _Pragma("unroll") for (int k_ = 0; k_ < 7; ++k_) { int q_ = tid + 512 * k_; if (k_ == 6 && q_ > 3263) q_ = 3263; const void* src_; \
            if (k_ < 4) { const int qq_ = q_ & 1023, row_ = qq_ >> 4, ch_ = qq_ & 15; const int tok_ = 64 * n_ + (d ? 63 - row_ : row_); src_ = QKVd + (size_t)tok_ * 2304 + (k_ < 2 ? 768 : 0) + h * 128 + ch_ * 8; } \
            else if (k_ < 6) { const int qq_ = q_ & 511, row_ = qq_ >> 3, ch_ = qq_ & 7; src_ = (k_ == 4 ? TINV : ATTN) + cb_ * 4096 + row_ * 64 + ch_ * 8; } \
            else { const int qq_ = q_ - 3072; const int row_ = (qq_ & 127) >> 1, ch_ = qq_ & 1; const int tok_ = 64 * n_ + (d ? 63 - row_ : row_); \
                   const void* sv_ = QKVd + (size_t)tok_ * 2304 + 1536 + h * 128 + sl * 16 + ch_ * 8; const void* sc_ = VEC + cb_ * 256 + ((qq_ - 128) & 63) * 4; src_ = (qq_ < 128) ? sv_ : sc_; } \
            asm volatile("global_load_dwordx4 %0, %1, off" : "=v"(pf[k_]) : "v"(src_) : "memory"); } } while (0)
#define SC_WRITE(pf, bufsel) do { LAS unsigned char* bb_ = lds + (bufsel) * SC_BUF; \
        _Pragma("unroll") for (int k_ = 0; k_ < 7; ++k_) { const int q_ = tid + 512 * k_; int off_ = -1; \
            if (k_ < 4) { const int qq_ = q_ & 1023, row_ = qq_ >> 4, ch_ = qq_ & 15; off_ = (k_ < 2 ? SC_KT : SC_QT) + row_ * 272 + ch_ * 16; } \
            else if (k_ < 6) { const int qq_ = q_ & 511, row_ = qq_ >> 3, ch_ = qq_ & 7; off_ = (k_ == 4 ? SC_TI : SC_AT) + row_ * 144 + ch_ * 16; } \
            else { const int qq_ = q_ - 3072; if (qq_ < 128) off_ = SC_VT + qq_ * 16; else if (qq_ < 192) off_ = SC_VC + (qq_ - 128) * 16; } \
            if (off_ >= 0) *(LAS v4u*)(bb_ + off_) = pf[k_]; } } while (0)
#define SC_BAR() do { asm volatile("s_waitcnt lgkmcnt(0)" ::: "memory"); __builtin_amdgcn_s_barrier(); asm volatile("" ::: "memory"); } while (0)
#define SC_WAIT(pf, N) asm volatile("s_waitcnt vmcnt(" #N ")" : "+v"(pf[0]), "+v"(pf[1]), "+v"(pf[2]), "+v"(pf[3]), "+v"(pf[4]), "+v"(pf[5]), "+v"(pf[6]) :: "memory")
#define SC_OSTORE(np) do { if (wv >= 4) { \
        _Pragma("unroll") for (int rg = 0; rg < 4; ++rg) { const int i_ = 16 * (wv & 3) + 4 * g + rg, tok_ = 64 * (np) + (d ? 63 - i_ : i_); \
            ODIR[(size_t)tok_ * 768 + h * 128 + sl * 16 + m16] = (bf16)f2bf(oprev[rg]); } } } while (0)
#define SC_STEP(s, PFW, PFL) do { const int s_ = (s); const int cur = s_ & 1; \
        LAS unsigned char* B = lds + cur * SC_BUF; \
        if (sl == 0 && tid == 0) __hip_atomic_store(prog + 64 * p, (unsigned)(s_ + 1), __ATOMIC_RELAXED, __HIP_MEMORY_SCOPE_AGENT); \
        if (s_ + 2 < 256) SC_LOAD(PFL, s_ + 2); \
        if (s_ > 0) SC_OSTORE(d ? 256 - s_ : s_ - 1); \
        const LAS float* VC = (const LAS float*)(B + SC_VC); \
        bf16x8_t sb[4]; \
        _Pragma("unroll") for (int ks = 0; ks < 4; ++ks) sb[ks] = *(const LAS bf16x8_t*)(lds + SC_ST + m16 * 272 + (32 * ks + 8 * g) * 2); \
        const int t4 = wv & 3; \
        f32x4 acc1 = {0.f, 0.f, 0.f, 0.f}; \
        { const LAS unsigned char* ap = B + (wv < 4 ? SC_KT : SC_QT) + (16 * t4 + m16) * 272 + 16 * g; \
          _Pragma("unroll") for (int ks = 0; ks < 4; ++ks) acc1 = MFMA16(*(const LAS bf16x8_t*)(ap + 64 * ks), sb[ks], acc1); } \
        const f32x4 eG4 = *(const LAS f32x4*)(VC + 16 * t4 + 4 * g); \
        if (wv < 4) { const f32x4 be4 = *(const LAS f32x4*)(VC + 64 + 16 * t4 + 4 * g); float r[4]; \
            _Pragma("unroll") for (int rg = 0; rg < 4; ++rg) { const float vv = bf2f(*(const LAS unsigned short*)(B + SC_VT + (16 * t4 + 4 * g + rg) * 32 + m16 * 2)); r[rg] = be4[rg] * (vv - eG4[rg] * acc1[rg]); } \
            v2u w; w.x = pk2(r[0], r[1]); w.y = pk2(r[2], r[3]); *(LAS v2u*)(lds + SC_RT + m16 * 144 + (16 * t4 + 4 * g) * 2) = w; \
        } else { _Pragma("unroll") for (int rg = 0; rg < 4; ++rg) acc1[rg] *= eG4[rg]; } \
        SC_BAR(); \
        if (wv < 4) { const LAS unsigned char* ap = B + SC_TI + (16 * t4 + m16) * 144 + 16 * g; f32x4 vn = {0.f, 0.f, 0.f, 0.f}; \
            _Pragma("unroll") for (int ks = 0; ks < 2; ++ks) vn = MFMA16(*(const LAS bf16x8_t*)(ap + 64 * ks), *(const LAS bf16x8_t*)(lds + SC_RT + m16 * 144 + (32 * ks + 8 * g) * 2), vn); \
            const f32x4 eL4 = *(const LAS f32x4*)(VC + 128 + 16 * t4 + 4 * g); \
            v2u w; w.x = pk2(vn[0], vn[1]); w.y = pk2(vn[2], vn[3]); *(LAS v2u*)(lds + SC_VNT + m16 * 144 + (16 * t4 + 4 * g) * 2) = w; \
            v2u w2; w2.x = pk2(vn[0] * eL4[0], vn[1] * eL4[1]); w2.y = pk2(vn[2] * eL4[2], vn[3] * eL4[3]); *(LAS v2u*)(lds + SC_VST + m16 * 144 + (16 * t4 + 4 * g) * 2) = w2; } \
        SC_BAR(); \
        { f32x4 acc3 = {0.f, 0.f, 0.f, 0.f}; \
          _Pragma("unroll") for (int ks = 0; ks < 2; ++ks) { \
              const LAS unsigned char* tp = B + SC_KT + (32 * ks + 8 * g + (m16 >> 2)) * 272 + (16 * wv + 4 * (m16 & 3)) * 2; \
              const s16x4_t lo = __builtin_amdgcn_ds_read_tr16_b64_v4i16((LAS s16x4_t*)tp); \
              const s16x4_t hi = __builtin_amdgcn_ds_read_tr16_b64_v4i16((LAS s16x4_t*)(tp + 4 * 272)); \
              const bf16x8_t a = {lo[0], lo[1], lo[2], lo[3], hi[0], hi[1], hi[2], hi[3]}; \
              acc3 = MFMA16(a, *(const LAS bf16x8_t*)(lds + SC_VST + m16 * 144 + (32 * ks + 8 * g) * 2), acc3); } \
          const float gl = VC[192]; \
          _Pragma("unroll") for (int rg = 0; rg < 4; ++rg) Sreg[rg] = gl * Sreg[rg] + acc3[rg]; \
          v2u w; w.x = pk2(Sreg[0], Sreg[1]); w.y = pk2(Sreg[2], Sreg[3]); *(LAS v2u*)(lds + SC_ST + m16 * 272 + (16 * wv + 4 * g) * 2) = w; } \
        if (wv >= 4) { const LAS unsigned char* ap = B + SC_AT + (16 * t4 + m16) * 144 + 16 * g; \
            _Pragma("unroll") for (int ks = 0; ks < 2; ++ks) acc1 = MFMA16(*(const LAS bf16x8_t*)(ap + 64 * ks), *(const LAS bf16x8_t*)(lds + SC_VNT + m16 * 144 + (32 * ks + 8 * g) * 2), acc1); \
            oprev = acc1; } \
        if (s_ + 1 < 256) { SC_WAIT(PFW, 7); SC_WRITE(PFW, cur ^ 1); } \
        SC_BAR(); } while (0)
    f32x4 Sreg = {0.f, 0.f, 0.f, 0.f};
    f32x4 oprev = {0.f, 0.f, 0.f, 0.f};
    for (int e = tid; e < 4352 / 4; e += NTHREADS) ((LAS unsigned*)(lds + SC_ST))[e] = 0u;
    SC_LOAD(pfA, 0); SC_WAIT(pfA, 0); SC_WRITE(pfA, 0);
    SC_LOAD(pfB, 1);
    __syncthreads();
#pragma unroll 1
    for (int s2 = 0; s2 < 256; s2 += 2) {
        SC_STEP(s2, pfB, pfA);
        SC_STEP(s2 + 1, pfA, pfB);
    }
    SC_OSTORE(d ? 0 : 255);
#undef SC_STEP
#undef SC_OSTORE
#undef SC_WAIT
#undef SC_BAR
#undef SC_LOAD
#undef SC_WRITE
}
constexpr int AT_PITCH = 144, AT_K = 0, AT_V = 192 * AT_PITCH, AT_GRP = 2 * 192 * AT_PITCH;
__device__ __forceinline__ void ph_attn(const bf16* PA, const float* rope, bf16* OG, float* LSE, LAS unsigned char* lds, int wv) {
    int tid_ = wv * 64 + lane_id_(); asm volatile("" : "+v"(tid_));
    const int tid = tid_, lane = tid & 63, g = lane >> 4, m16 = lane & 15, grp = wv >> 2, wq = wv & 3, tg = tid & 255;
    LAS unsigned char* Kl = lds + grp * AT_GRP + AT_K; LAS unsigned char* Vl = lds + grp * AT_GRP + AT_V;
#pragma unroll 1
    for (int pi = BID; pi < 1536; pi += GSZ) {
        const int u = 2 * pi + grp;
        const int hg = u & 3, w = (u >> 2) & 255, gi = u >> 10;
        const int dil = 1 << (2 * gi), L = S_ / dil, r = w & (dil - 1), nb = w >> (2 * gi), head = gi * 4 + hg;
#pragma unroll
        for (int k = 0; k < 3; ++k) {
            const int item = tg + 256 * k, row = item >> 2, c = item & 3, mm = nb * 64 - 64 + row;
            v4u o0 = {0u, 0u, 0u, 0u}, o1 = {0u, 0u, 0u, 0u};
            if (mm >= 0 && mm < L) {
                const int tok = mm * dil + r;
                const bf16* kp = PA + (size_t)tok * 2304 + 768 + head * 64 + 8 * c;
                const v4u x0 = *(const v4u*)kp, x1 = *(const v4u*)(kp + 32);
                const f32x4* cp = (const f32x4*)(rope + (size_t)tok * 32 + 8 * c); const f32x4* sp = (const f32x4*)(rope + (size_t)S_ * 32 + (size_t)tok * 32 + 8 * c);
                const f32x4 c0 = cp[0], c1 = cp[1], s0 = sp[0], s1 = sp[1];
                const float cs[8] = {c0.x, c0.y, c0.z, c0.w, c1.x, c1.y, c1.z, c1.w}, sn[8] = {s0.x, s0.y, s0.z, s0.w, s1.x, s1.y, s1.z, s1.w};
                const unsigned xa[4] = {x0.x, x0.y, x0.z, x0.w}, xb[4] = {x1.x, x1.y, x1.z, x1.w};
                unsigned ra[4], rb[4];
#pragma unroll
                for (int e = 0; e < 4; ++e) {
                    const float a0 = bflo(xa[e]), a1 = bfhi(xa[e]), b0 = bflo(xb[e]), b1 = bfhi(xb[e]);
                    ra[e] = pk2(a0 * cs[2 * e] - b0 * sn[2 * e], a1 * cs[2 * e + 1] - b1 * sn[2 * e + 1]);
                    rb[e] = pk2(b0 * cs[2 * e] + a0 * sn[2 * e], b1 * cs[2 * e + 1] + a1 * sn[2 * e + 1]);
                }
                o0.x = ra[0]; o0.y = ra[1]; o0.z = ra[2]; o0.w = ra[3]; o1.x = rb[0]; o1.y = rb[1]; o1.z = rb[2]; o1.w = rb[3];
            }
            *(LAS v4u*)(Kl + row * AT_PITCH + 16 * c) = o0; *(LAS v4u*)(Kl + row * AT_PITCH + 64 + 16 * c) = o1;
        }
#pragma unroll
        for (int k = 0; k < 6; ++k) {
            const int item = tg + 256 * k, row = item >> 3, c = item & 7, mm = nb * 64 - 64 + row;
            v4u o = {0u, 0u, 0u, 0u};
            if (mm >= 0 && mm < L) o = *(const v4u*)(PA + (size_t)(mm * dil + r) * 2304 + 1536 + head * 64 + 8 * c);
            *(LAS v4u*)(Vl + row * AT_PITCH + 16 * c) = o;
        }
        bf16x8_t bq0, bq1;
        const int qi = 16 * wq + m16, qtok = (nb * 64 + qi) * dil + r;
        {
            const bf16* qp = PA + (size_t)qtok * 2304 + head * 64 + 8 * g;
            const v4u x0 = *(const v4u*)qp, x1 = *(const v4u*)(qp + 32);
            const f32x4* cp = (const f32x4*)(rope + (size_t)qtok * 32 + 8 * g); const f32x4* sp = (const f32x4*)(rope + (size_t)S_ * 32 + (size_t)qtok * 32 + 8 * g);
            const f32x4 c0 = cp[0], c1 = cp[1], s0 = sp[0], s1 = sp[1];
            const float cs[8] = {c0.x, c0.y, c0.z, c0.w, c1.x, c1.y, c1.z, c1.w}, sn[8] = {s0.x, s0.y, s0.z, s0.w, s1.x, s1.y, s1.z, s1.w};
            const unsigned xa[4] = {x0.x, x0.y, x0.z, x0.w}, xb[4] = {x1.x, x1.y, x1.z, x1.w};
            v4u ra, rb; unsigned* rap = (unsigned*)&ra; unsigned* rbp = (unsigned*)&rb; (void)rap; (void)rbp;
            unsigned ta[4], tb[4];
#pragma unroll
            for (int e = 0; e < 4; ++e) {
                const float a0 = bflo(xa[e]), a1 = bfhi(xa[e]), b0 = bflo(xb[e]), b1 = bfhi(xb[e]);
                ta[e] = pk2(0.125f * (a0 * cs[2 * e] - b0 * sn[2 * e]), 0.125f * (a1 * cs[2 * e + 1] - b1 * sn[2 * e + 1]));
                tb[e] = pk2(0.125f * (b0 * cs[2 * e] + a0 * sn[2 * e]), 0.125f * (b1 * cs[2 * e + 1] + a1 * sn[2 * e + 1]));
            }
            ra.x = ta[0]; ra.y = ta[1]; ra.z = ta[2]; ra.w = ta[3]; rb.x = tb[0]; rb.y = tb[1]; rb.z = tb[2]; rb.w = tb[3];
            bq0 = __builtin_bit_cast(bf16x8_t, ra); bq1 = __builtin_bit_cast(bf16x8_t, rb);
        }
        __syncthreads();
        f32x4 st[12];
#pragma unroll
        for (int kt = 0; kt < 12; ++kt) {
            const LAS unsigned char* ap = Kl + (16 * kt + m16) * AT_PITCH + 16 * g;
            f32x4 z = {0.f, 0.f, 0.f, 0.f};
            z = MFMA16(*(const LAS bf16x8_t*)ap, bq0, z);
            st[kt] = MFMA16(*(const LAS bf16x8_t*)(ap + 64), bq1, z);
        }
        float mx = -1e30f;
#pragma unroll
        for (int kt = 0; kt < 12; ++kt)
#pragma unroll
            for (int rg = 0; rg < 4; ++rg) { const int j = 16 * kt + 4 * g + rg, dj = j - qi, mm = nb * 64 - 64 + j;
                const bool ok = (dj >= 0) && (dj <= 128) && (mm >= 0) && (mm < L);
                st[kt][rg] = ok ? st[kt][rg] : -1e30f; mx = fmaxf(mx, st[kt][rg]); }
        mx = fmaxf(mx, __shfl_xor(mx, 16)); mx = fmaxf(mx, __shfl_xor(mx, 32));
        float sum = 0.f;
#pragma unroll
        for (int kt = 0; kt < 12; ++kt)
#pragma unroll
            for (int rg = 0; rg < 4; ++rg) { const float p = __expf(st[kt][rg] - mx); st[kt][rg] = p; sum += p; }
        sum += __shfl_xor(sum, 16); sum += __shfl_xor(sum, 32);
        f32x4 o[4];
#pragma unroll
        for (int dt = 0; dt < 4; ++dt) o[dt] = (f32x4){0.f, 0.f, 0.f, 0.f};
#pragma unroll
        for (int kk = 0; kk < 6; ++kk) {
            v4u pb; pb.x = pk2(st[2 * kk][0], st[2 * kk][1]); pb.y = pk2(st[2 * kk][2], st[2 * kk][3]); pb.z = pk2(st[2 * kk + 1][0], st[2 * kk + 1][1]); pb.w = pk2(st[2 * kk + 1][2], st[2 * kk + 1][3]);
            const bf16x8_t b = __builtin_bit_cast(bf16x8_t, pb);
#pragma unroll
            for (int dt = 0; dt < 4; ++dt) {
                const LAS unsigned char* tp = Vl + (32 * kk + 4 * g + (m16 >> 2)) * AT_PITCH + (16 * dt + 4 * (m16 & 3)) * 2;
                const s16x4_t lo = __builtin_amdgcn_ds_read_tr16_b64_v4i16((LAS s16x4_t*)tp);
                const s16x4_t hi = __builtin_amdgcn_ds_read_tr16_b64_v4i16((LAS s16x4_t*)(tp + 16 * AT_PITCH));
                const bf16x8_t a = {lo[0], lo[1], lo[2], lo[3], hi[0], hi[1], hi[2], hi[3]};
                o[dt] = MFMA16(a, b, o[dt]);
            }
        }
        const float il = 1.0f / sum;
        bf16* op = OG + ((size_t)gi * S_ + qtok) * 256 + hg * 64 + 4 * g;
#pragma unroll
        for (int dt = 0; dt < 4; ++dt) { v2u wv2; wv2.x = pk2(o[dt][0] * il, o[dt][1] * il); wv2.y = pk2(o[dt][2] * il, o[dt][3] * il); *(v2u*)(op + 16 * dt) = wv2; }
        if (g == 0) LSE[((size_t)gi * S_ + qtok) * 4 + hg] = mx + logf(sum);
        __syncthreads();
    }
}
constexpr int LDS_RING = 131072, LDS_CTL_OFF = LDS_RING, LDS_BYTES = 147456;
constexpr int CW_BAR = 4096;
#ifndef PROBE_ID
#define PROBE_ID (-1)
#endif
__device__ __forceinline__ unsigned char* wsp() { return PWS; }
template <class Epi> __device__ __forceinline__ void run_gemm(LAS unsigned char* lds, const bf16* A, const bf16* Bt, int N, int K, const Epi& E, int wv) {
    pg8::Gemm g{A, Bt, S_, N, K, 0};
    pg8::StaticOrder S; S.init(S_, N, GSZ, BID);
    pg8::gemm_phase<Epi, pg8::StaticOrder, true, true>(lds, g, S, E, wv);
}
#define GRID_BAR() do { XcdBarrier b_; b_.bar = (unsigned*)(wsp() + WS_CTL) + CW_BAR; b_.st = (volatile LAS unsigned*)(lds + LDS_CTL_OFF + 320) + 8; b_.x = b_.st[2]; xcd_barrier(b_, wv); } while (0)
#define PHASE(id, ...) do { { __VA_ARGS__ } if (PROBE_ID == (id)) { GRID_BAR(); { __VA_ARGS__ } } } while (0)
#define WS_R_PTRS unsigned char* ws = wsp(); unsigned char* R = ws + WS_R; (void)R;

template <int l, int f> __device__ __forceinline__ void ffn_block(LAS unsigned char* lds, unsigned char* lds_raw, int wv) {
    constexpr int s = f * 2;
    PHASE(1, WS_R_PTRS
        pg8::EpiSwiglu E; E.O = (bf16*)(R + R_ACT); E.ldc = FF_; E.pad_ = 0; run_gemm(lds, (const bf16*)(ws + WS_H), (const bf16*)(ws + WS_W + (f ? W_FFIN1 : W_FFIN0)), 2 * FF_, 1024, E, wv); );
    GRID_BAR();
    PHASE(2, WS_R_PTRS
        pg8::EpiF32 E; E.O = (float*)(R + R_Y); E.ldc = 1024; E.pad_ = 0; run_gemm(lds, (const bf16*)(R + R_ACT), (const bf16*)(ws + WS_W + (f ? W_FFOUT1 : W_FFOUT0)), 1024, FF_, E, wv); );
    GRID_BAR();
    {   WS_R_PTRS const float* MOD = (const float*)(ws + WS_MOD); const float* mod = MOD + l * 9216;
        RowArgs a; a.xi = (l == 0 && f == 0) ? PIN(0) : POUT; a.y = (const float*)(R + R_Y); a.xo = POUT; a.wpost = PIN(6) + (l * 3 + s) * 1024; a.gate = mod + (s * 3 + 2) * 1024; a.coef = 0.5f;
        if (f == 0) { a.h = (bf16*)(ws + WS_H); a.wpre = PIN(5) + (l * 3 + 1) * 1024; a.shift = mod + (1 * 3 + 0) * 1024; a.scale = mod + (1 * 3 + 1) * 1024; }
        else if (l == 0) { a.h = (bf16*)(ws + WS_H); a.wpre = PIN(5) + (1 * 3 + 0) * 1024; a.shift = MOD + 9216; a.scale = MOD + 9216 + 1024; }
        else { a.h = nullptr; a.wpre = nullptr; a.shift = nullptr; a.scale = nullptr; }
        ph_rows(a, wv);
        if (f == 1 && l == 0) ph_convert(1, lds_raw, wv); }
    GRID_BAR();
}
template <int l> __device__ __forceinline__ void mixer_block(LAS unsigned char* lds, unsigned char* lds_raw, int wv) {
    PHASE(3, WS_R_PTRS
        pg8::EpiInProj E; E.PA = (bf16*)(R + R_PA); E.PD = (bf16*)(R + R_PD); E.PZ = (bf16*)(R + R_PZ); E.AB = (float*)(R + R_AB);
        run_gemm(lds, (const bf16*)(ws + WS_H), (const bf16*)(ws + WS_W + W_IN), 5632, 1024, E, wv); );
    GRID_BAR();
    PHASE(4, WS_R_PTRS
        ph_attn((const bf16*)(R + R_PA), (const float*)(ws + WS_ROPE), (bf16*)(R + R_OG), (float*)(R + R_LSE), lds, wv); );
    GRID_BAR();
    PHASE(5, WS_R_PTRS
        ph_dnprep((const bf16*)(R + R_PD), (const float*)(R + R_AB), PIN(10) + (size_t)l * 5 * 2304, PIN(11) + l * 12, PIN(12) + l * 12, (bf16*)(R + R_QKVD), (float*)(R + R_GB),
                  (const bf16*)(R + R_OG), (const float*)(R + R_LSE), (bf16*)(R + R_OATT), wv); );
    GRID_BAR();
    PHASE(6, WS_R_PTRS
        ph_dn_pre((const bf16*)(R + R_QKVD), (const float*)(R + R_GB), (bf16*)(R + R_TINV), (bf16*)(R + R_ATTN), (float*)(R + R_VEC), lds_raw, wv); );
    GRID_BAR();
    PHASE(7, WS_R_PTRS
        ph_dn_scan((const bf16*)(R + R_QKVD), (const bf16*)(R + R_TINV), (const bf16*)(R + R_ATTN), (const float*)(R + R_VEC), (bf16*)(R + R_ODIR0), (bf16*)(R + R_ODIR1), (unsigned*)(ws + WS_CTL) + 1024 + l * 1024, lds, wv); );
    GRID_BAR();
    PHASE(8, WS_R_PTRS
        pg8::EpiBf16P E; E.O = (bf16*)(R + R_PG); E.ldc = 2048; E.pad_ = 0;
        run_gemm(lds, (const bf16*)(ws + WS_H), (const bf16*)(ws + WS_W + W_IN) + (size_t)5632 * 1024, 2048, 1024, E, wv); );
    PHASE(9, WS_R_PTRS
        ph_final((const bf16*)(R + R_ODIR0), (const bf16*)(R + R_ODIR1), (const bf16*)(R + R_PZ), PIN(13) + l * 128, (bf16*)(R + R_ODN), wv); );
    GRID_BAR();
    PHASE(10, { WS_R_PTRS
        pg8::EpiGateF32 E; E.O = (float*)(R + R_T1); E.gate = (const bf16*)(R + R_PG); E.ldg = 2048; E.pad_ = 0;
        run_gemm(lds, (const bf16*)(R + R_OATT), (const bf16*)(ws + WS_W + W_BATT), 1024, 256, E, wv); }
        { WS_R_PTRS
        pg8::EpiGateAddBf16 E; E.O = (bf16*)(ws + WS_H); E.T1 = (const float*)(R + R_T1); E.gate = (const bf16*)(R + R_PG) + 1024; E.ldg = 2048; E.pad_ = 0;
        run_gemm(lds, (const bf16*)(R + R_ODN), (const bf16*)(ws + WS_W + W_BDN), 1024, 768, E, wv); } );
    GRID_BAR();
    PHASE(11, WS_R_PTRS
        pg8::EpiF32 E; E.O = (float*)(R + R_Y2); E.ldc = 1024; E.pad_ = 0; run_gemm(lds, (const bf16*)(ws + WS_H), (const bf16*)(ws + WS_W + W_OUT), 1024, 1024, E, wv); );
    GRID_BAR();
    {   WS_R_PTRS const float* mod = (const float*)(ws + WS_MOD) + l * 9216;
        RowArgs a; a.xi = POUT; a.y = (const float*)(R + R_Y2); a.xo = POUT; a.h = (bf16*)(ws + WS_H); a.wpost = PIN(6) + (l * 3 + 1) * 1024; a.gate = mod + (1 * 3 + 2) * 1024; a.coef = 1.0f;
        a.wpre = PIN(5) + (l * 3 + 2) * 1024; a.shift = mod + (2 * 3 + 0) * 1024; a.scale = mod + (2 * 3 + 1) * 1024; ph_rows(a, wv); }
    GRID_BAR();
}
__global__ void __launch_bounds__(NTHREADS, 2) mega_fwd(Params P) {
    extern __shared__ __attribute__((aligned(16))) unsigned char lds_raw[];
    LAS unsigned char* lds = (LAS unsigned char*)lds_raw;
    const int wv = __builtin_amdgcn_readfirstlane((int)threadIdx.x >> 6);
    { const int tid0 = threadIdx.x;
      for (int u = tid0; u < (LDS_BYTES - LDS_CTL_OFF) / 4; u += NTHREADS) ((LAS unsigned*)(lds + LDS_CTL_OFF))[u] = 0u;
      __syncthreads();
      XcdBarrier b0 = xcd_barrier_post((unsigned*)(PWS + WS_CTL) + CW_BAR, (volatile LAS unsigned*)(lds + LDS_CTL_OFF + 320) + 8);
      if (tid0 == 0) ((volatile LAS unsigned*)(lds + LDS_CTL_OFF + 320))[10] = b0.x;
      __syncthreads(); }
    PHASE(0, ph_ada(lds_raw, wv); ph_rope(wv); ph_convert(0, lds_raw, wv); );
    GRID_BAR();
    PHASE(12, WS_R_PTRS float* MOD = (float*)(ws + WS_MOD);
      RowArgs a; a.xi = PIN(0); a.y = nullptr; a.xo = nullptr; a.h = (bf16*)(ws + WS_H); a.wpost = nullptr; a.gate = nullptr; a.wpre = PIN(5); a.shift = MOD; a.scale = MOD + 1024; a.coef = 0.f; ph_rows(a, wv); );
    GRID_BAR();
    ffn_block<0, 0>(lds, lds_raw, wv); mixer_block<0>(lds, lds_raw, wv); ffn_block<0, 1>(lds, lds_raw, wv);
    ffn_block<1, 0>(lds, lds_raw, wv); mixer_block<1>(lds, lds_raw, wv); ffn_block<1, 1>(lds, lds_raw, wv);
}

extern "C" void kernel_launch(void* const* d_in, const int* in_sizes, int n_in, void* d_out, int out_size, void* d_ws, size_t ws_size, hipStream_t stream) {
    static int grid = 0;
    if (grid == 0) {
        if (n_in != 17 || ws_size < WS_END) { fprintf(stderr, "kernel_launch: unexpected n_in %d / ws_size %zu\n", n_in, ws_size); grid = -1; return; }
        int dev = 0, cus = 0, per_cu = 0;
        if (hipGetDevice(&dev) != hipSuccess || hipDeviceGetAttribute(&cus, hipDeviceAttributeMultiprocessorCount, dev) != hipSuccess) { grid = -1; return; }
        if (hipFuncSetAttribute((const void*)mega_fwd, hipFuncAttributeMaxDynamicSharedMemorySize, LDS_BYTES) != hipSuccess) { fprintf(stderr, "kernel_launch: hipFuncSetAttribute failed\n"); grid = -1; return; }
        if (hipOccupancyMaxActiveBlocksPerMultiprocessor(&per_cu, (const void*)mega_fwd, NTHREADS, LDS_BYTES) != hipSuccess || per_cu < 1) { fprintf(stderr, "kernel_launch: occupancy query says %d\n", per_cu); per_cu = 1; }
        (void)hipGetLastError();
        grid = cus;
        if (grid > 256) grid = 256;
    }
    if (grid < 0) return;
    (void)hipMemsetAsync((char*)d_ws + WS_CTL, 0, 1 * MiB, stream);
    Params p{};
    for (int i = 0; i < 17; ++i) p.in[i] = (const float*)d_in[i];
    p.out = (float*)d_out; p.ws = (unsigned char*)d_ws;
    hipLaunchKernelGGL(mega_fwd, dim3(grid), dim3(NTHREADS), LDS_BYTES, stream, p);
}
```

```cpp
#include <hip/hip_runtime.h>
#include <cstdio>
#include <cstdint>
__device__ __forceinline__ int lane_id_() { int l; asm volatile("v_mbcnt_lo_u32_b32 %0, -1, 0\n\tv_mbcnt_hi_u32_b32 %0, -1, %0" : "=v"(l)); return l; }
namespace pg8 {
#define PG8_LAS __attribute__((address_space(3)))
typedef unsigned short bf16_t;
typedef short bf16x8 __attribute__((ext_vector_type(8)));
typedef float f32x4 __attribute__((ext_vector_type(4)));
typedef unsigned u32x4 __attribute__((ext_vector_type(4)));
constexpr int BM = 256, BK = 64, HALF = 128, HTB = HALF * BK * 2  , STAGE_BYTES = 8 * HTB, NXCD = 8, WGM = 8;

__host__ __device__ __forceinline__ int lds_byte(int r, int c) { const int st = (r >> 4) * 2 + (c >> 5), rr = r & 15, cc = c & 31, ob = rr * 64 + cc * 2; return st * 1024 + (ob ^ (((ob >> 9) & 1) << 5)); }
__host__ __device__ __forceinline__ void stage_rc(int b, int& R, int& C) { const int st = b / 1024, sb = b % 1024, swz = sb ^ (((sb >> 9) & 1) << 5); R = (st >> 1) * 16 + swz / 64; C = (st & 1) * 32 + (swz % 64) / 2; }
__host__ __device__ __forceinline__ int perm32(int rho) { const int n = rho >> 4, i = rho & 15; return 8 * (i >> 2) + 4 * n + (i & 3); }

struct Unit { int pm, pn; };
struct Gemm { const bf16_t* A; const bf16_t* Bt; int M, N, K, pad_; };

struct StaticOrder {
    int nM, nN, nwg, G, c;
    __host__ __device__ void init(int M, int N, int G_, int c_) { nM = M / BM; nN = N / BM; nwg = nM * nN; G = G_; c = c_; }
    __host__ __device__ bool next(int i, Unit& u) const {
        const long L = (long)i * G + c; if (L >= nwg) return false;
        int wgid = (int)L; { const int q = nwg / NXCD, r = nwg % NXCD, xcd = wgid % NXCD, off = wgid / NXCD; wgid = (xcd < r ? xcd * (q + 1) : r * (q + 1) + (xcd - r) * q) + off; }
        const int nig = WGM * nN, gid = wgid / nig, fm = gid * WGM, gsz = (nM - fm) < WGM ? (nM - fm) : WGM;
        u.pm = fm + ((wgid % nig) % gsz); u.pn = (wgid % nig) / gsz; return true;
    }
    __device__ __forceinline__ void a_ready(const Unit&) const {}
    __device__ __forceinline__ void done(const Unit&) const {}
};

__device__ __forceinline__ unsigned cvt_pk_bf16(float lo, float hi) { unsigned r; asm volatile("v_cvt_pk_bf16_f32 %0, %1, %2" : "=v"(r) : "v"(lo), "v"(hi)); return r; }
typedef float f32x2 __attribute__((ext_vector_type(2)));
__device__ __forceinline__ f32x2 gelu_pk(f32x2 v) {
    const f32x2 av = __builtin_elementwise_abs(v), d = av * 0.2316418882f + 1.0f;
    f32x2 t; t.x = __builtin_amdgcn_rcpf(d.x); t.y = __builtin_amdgcn_rcpf(d.y);
    f32x2 q = t * 0.5307027145f + (-0.7265760135f); q = q * t + 0.7107068705f; q = q * t + (-0.142248368f); q = q * t + 0.127414796f; q = q * t;
    const f32x2 s = (v * v) * (-0.72134752044f);
    f32x2 e; e.x = __builtin_amdgcn_exp2f(s.x); e.y = __builtin_amdgcn_exp2f(s.y);
    const f32x2 m = v * (q * e), r = v - m;
    f32x2 o; o.x = v.x < 0.f ? m.x : r.x; o.y = v.y < 0.f ? m.y : r.y; return o;
}

template <int ACT  > struct EpiBf16 {
    static constexpr bool PERM = true, AFTER_DRAIN = false; static_assert(ACT == 0 || ACT == 1, "EpiBf16: ACT is 0 (none) or 1 (gelu_pk)");
    bf16_t* O; int ldc; const float* bias; int split_cols; size_t split_stride; float scale0;
    __device__ __forceinline__ void operator()(const f32x4 (&acc)[2][2][4][2], const Unit& u, int wr, int wc, int fr, int fq) const {
        const int row0 = u.pm * BM + wr * 64 + fr; int colt = u.pn * BM; bf16_t* base = O;
        float sc = 1.f; if (split_cols) { const int t = colt / split_cols; base += (size_t)t * split_stride; colt -= t * split_cols; if (t == 0) sc = scale0; }
        const int col0 = colt + wc * 32 + 8 * fq, bcol0 = u.pn * BM + wc * 32 + 8 * fq;
        f32x4 bv[2][2];
#pragma unroll
        for (int bj = 0; bj < 2; ++bj)
#pragma unroll
            for (int n = 0; n < 2; ++n) bv[bj][n] = bias ? *(const f32x4*)(bias + bcol0 + bj * HALF + 4 * n) : (f32x4){0.f, 0.f, 0.f, 0.f};
#pragma unroll
        for (int ai = 0; ai < 2; ++ai)
#pragma unroll
            for (int m = 0; m < 4; ++m) { bf16_t* rowp = base + (size_t)(row0 + ai * HALF + m * 16) * ldc + col0;
#pragma unroll
                for (int bj = 0; bj < 2; ++bj) { f32x4 v0 = acc[ai][bj][m][0] + bv[bj][0], v1 = acc[ai][bj][m][1] + bv[bj][1];
                    if (ACT == 1) { f32x2 a = gelu_pk((f32x2){v0[0], v0[1]}), b = gelu_pk((f32x2){v0[2], v0[3]}), c = gelu_pk((f32x2){v1[0], v1[1]}), d = gelu_pk((f32x2){v1[2], v1[3]});
                        v0 = (f32x4){a.x, a.y, b.x, b.y}; v1 = (f32x4){c.x, c.y, d.x, d.y}; }
                    v0 = v0 * sc; v1 = v1 * sc; u32x4 w; w.x = cvt_pk_bf16(v0[0], v0[1]); w.y = cvt_pk_bf16(v0[2], v0[3]); w.z = cvt_pk_bf16(v1[0], v1[1]); w.w = cvt_pk_bf16(v1[2], v1[3]);
                    *(u32x4*)(rowp + bj * HALF) = w; } }
    }
};

struct PanelStats {
    unsigned* xbuf;
    unsigned* cnt;
    unsigned* tmo;
    int ntn; float eps;
    unsigned code;
    __device__ __forceinline__ bool run(const f32x4 (&v)[2][2][4][2], const Unit& u, int wr, int wc, int fr, int fq, PG8_LAS unsigned char* lds, int wid, int lane) const {
        typedef float f32x2v __attribute__((ext_vector_type(2)));
        PG8_LAS f32x2v* P = (PG8_LAS f32x2v*)lds;
        PG8_LAS f32x2v* S = (PG8_LAS f32x2v*)(lds + 8192);
        PG8_LAS unsigned* flag = (PG8_LAS unsigned*)(lds + 8192 + 2048);
#pragma unroll
        for (int ai = 0; ai < 2; ++ai)
#pragma unroll
            for (int m = 0; m < 4; ++m) {
                float s = 0.f;
#pragma unroll
                for (int bj = 0; bj < 2; ++bj)
#pragma unroll
                    for (int n = 0; n < 2; ++n) { const f32x4 x = v[ai][bj][m][n]; s += (x[0] + x[1]) + (x[2] + x[3]); }
                s += __shfl_xor(s, 16); s += __shfl_xor(s, 32);
                const float mw = s * (1.0f / 64.0f); float q = 0.f;
#pragma unroll
                for (int bj = 0; bj < 2; ++bj)
#pragma unroll
                    for (int n = 0; n < 2; ++n) { const f32x4 d = v[ai][bj][m][n] - mw; q += (d[0] * d[0] + d[1] * d[1]) + (d[2] * d[2] + d[3] * d[3]); }
                q += __shfl_xor(q, 16); q += __shfl_xor(q, 32);
                if (fq == 0) P[(ai * HALF + wr * 64 + m * 16 + fr) * 4 + wc] = (f32x2v){mw, q};
            }
        asm volatile("s_waitcnt lgkmcnt(0)" ::: "memory"); __builtin_amdgcn_s_barrier(); asm volatile("" ::: "memory");
#if defined(BROKEN_EXCHANGE_NO_WAIT)
#warning BROKEN CONTROL BUILD: the row-statistics exchange does not wait; results are wrong by design
        if (blockIdx.x >= 64) { const long long t0_ = clock64(); while (clock64() - t0_ < 60000) __builtin_amdgcn_s_sleep(8); }
#endif
        const int row = wid * 32 + (lane & 31);
        if (lane < 32) {
            const f32x2v a = P[row * 4 + 0], b = P[row * 4 + 1], c = P[row * 4 + 2], d = P[row * 4 + 3];
            const float mt = (a.x + b.x + c.x + d.x) * 0.25f;
            const float da = a.x - mt, db = b.x - mt, dc = c.x - mt, dd = d.x - mt;
            const float m2 = (a.y + b.y) + (c.y + d.y) + 64.0f * ((da * da + db * db) + (dc * dc + dd * dd));
            unsigned long long* slot = (unsigned long long*)xbuf + ((size_t)(u.pm * BM + row) * 4 + u.pn);
            __hip_atomic_store(slot, ((unsigned long long)__float_as_uint(m2) << 32) | __float_as_uint(mt), __ATOMIC_RELAXED, __HIP_MEMORY_SCOPE_AGENT);
        }
        asm volatile("s_waitcnt vmcnt(0)" ::: "memory");
        if (lane == 0) __hip_atomic_fetch_add(cnt + 64 * u.pm, 1u, __ATOMIC_RELAXED, __HIP_MEMORY_SCOPE_AGENT);
        if (wid == 0) {
            bool dead = false; const unsigned long long t0 = __builtin_amdgcn_s_memrealtime(); const unsigned want = 8u * (unsigned)ntn;
            for (;;) {
#if defined(BROKEN_EXCHANGE_NO_WAIT)
                break;
#endif
                if ((unsigned)__builtin_amdgcn_readfirstlane(__hip_atomic_load(cnt + 64 * u.pm, __ATOMIC_RELAXED, __HIP_MEMORY_SCOPE_AGENT)) >= want) break;
                if (__builtin_amdgcn_s_memrealtime() - t0 > 2000000ull) {
                    if (lane == 0) { unsigned expect = 0u; __hip_atomic_compare_exchange_strong(tmo + 1, &expect, code | (unsigned)(u.pm & 0xff), __ATOMIC_RELAXED, __ATOMIC_RELAXED, __HIP_MEMORY_SCOPE_AGENT);
                                     __hip_atomic_store(tmo, 1u, __ATOMIC_RELAXED, __HIP_MEMORY_SCOPE_AGENT); }
                    dead = true; break; }
                __builtin_amdgcn_s_sleep(2);
            }
            __builtin_amdgcn_fence(__ATOMIC_ACQUIRE, "agent");
            if (lane == 0) flag[0] = dead ? 1u : 0u;
        }
        asm volatile("s_waitcnt vmcnt(0) lgkmcnt(0)" ::: "memory"); __builtin_amdgcn_s_barrier(); asm volatile("" ::: "memory");
        const bool bad = flag[0] != 0u;
        if (lane < 32) {
            const unsigned long long* slot = (const unsigned long long*)xbuf + (size_t)(u.pm * BM + row) * 4; float mt[4], m2[4]; float ms = 0.f;
#pragma unroll
            for (int t = 0; t < 4; ++t) { if (t < ntn) { const unsigned long long w = __hip_atomic_load(slot + t, __ATOMIC_RELAXED, __HIP_MEMORY_SCOPE_AGENT); mt[t] = __uint_as_float((unsigned)w); m2[t] = __uint_as_float((unsigned)(w >> 32)); } else { mt[t] = 0.f; m2[t] = 0.f; } ms += mt[t]; }
            const float mean = ms / (float)ntn; float q = 0.f;
#pragma unroll
            for (int t = 0; t < 4; ++t) if (t < ntn) { const float dm = mt[t] - mean; q += m2[t] + 256.0f * dm * dm; }
            S[row] = (f32x2v){mean, 1.0f / sqrtf(q / (256.0f * (float)ntn) + eps)};
        }
        asm volatile("s_waitcnt lgkmcnt(0)" ::: "memory"); __builtin_amdgcn_s_barrier(); asm volatile("" ::: "memory");
        return bad;
    }
};
struct EpiLnRes {
    static constexpr bool PERM = false, AFTER_DRAIN = true;
    const float* base; float* out; int ldc; const float* bias; PanelStats st; unsigned poison;
    __device__ __forceinline__ void fused(f32x4 (&acc)[2][2][4][2], const Unit& u, int wr, int wc, int fr, int fq, PG8_LAS unsigned char* lds, int wid, int lane) const {
        typedef float f32x2v __attribute__((ext_vector_type(2)));
        const PG8_LAS f32x2v* S = (const PG8_LAS f32x2v*)(lds + 8192);
        const int col0 = u.pn * BM + wc * 32 + 4 * fq;
#pragma unroll
        for (int bj = 0; bj < 2; ++bj)
#pragma unroll
            for (int n = 0; n < 2; ++n) { const f32x4 bv = bias ? *(const f32x4*)(bias + col0 + bj * HALF + n * 16) : (f32x4){0.f, 0.f, 0.f, 0.f};
#pragma unroll
                for (int ai = 0; ai < 2; ++ai)
#pragma unroll
                    for (int m = 0; m < 4; ++m) acc[ai][bj][m][n] += bv; }
        f32x4 pre[4][2][2];
#pragma unroll
        for (int m = 0; m < 4; ++m) { const size_t off = (size_t)(u.pm * BM + wr * 64 + m * 16 + fr) * ldc + col0;
#pragma unroll
            for (int bj = 0; bj < 2; ++bj)
#pragma unroll
                for (int n = 0; n < 2; ++n) pre[m][bj][n] = *(const f32x4*)(base + off + bj * HALF + n * 16); }
        const bool bad = st.run(acc, u, wr, wc, fr, fq, lds, wid, lane) || poison != 0u;
        const float qnan = __builtin_nanf("");
#pragma unroll
        for (int ai = 0; ai < 2; ++ai)
#pragma unroll
            for (int m = 0; m < 4; ++m) { const int r = ai * HALF + wr * 64 + m * 16 + fr; const f32x2v sr = S[r]; const size_t off = (size_t)(u.pm * BM + r) * ldc + col0;
#pragma unroll
                for (int bj = 0; bj < 2; ++bj)
#pragma unroll
                    for (int n = 0; n < 2; ++n) { const f32x4 bs = ai == 0 ? pre[m][bj][n] : *(const f32x4*)(base + off + bj * HALF + n * 16); f32x4 o = bs + (acc[ai][bj][m][n] - sr.x) * sr.y;
                        if (bad) o = (f32x4){qnan, qnan, qnan, qnan}; *(f32x4*)(out + off + bj * HALF + n * 16) = o; }
                if (m & 1) asm volatile("" ::: "memory"); }
    }
};
struct EpiLnResLn {
    static constexpr bool PERM = false, AFTER_DRAIN = true;
    const float* base; float* out; bf16_t* xn; int ldc; const float* bias; PanelStats st1, st2; unsigned poison;
    __device__ __forceinline__ void fused(f32x4 (&acc)[2][2][4][2], const Unit& u, int wr, int wc, int fr, int fq, PG8_LAS unsigned char* lds, int wid, int lane) const {
        typedef float f32x2v __attribute__((ext_vector_type(2))); typedef unsigned u32x2v __attribute__((ext_vector_type(2)));
        const PG8_LAS f32x2v* S = (const PG8_LAS f32x2v*)(lds + 8192);
        const int col0 = u.pn * BM + wc * 32 + 4 * fq;
#pragma unroll
        for (int bj = 0; bj < 2; ++bj)
#pragma unroll
            for (int n = 0; n < 2; ++n) { const f32x4 bv = bias ? *(const f32x4*)(bias + col0 + bj * HALF + n * 16) : (f32x4){0.f, 0.f, 0.f, 0.f};
#pragma unroll
                for (int ai = 0; ai < 2; ++ai)
#pragma unroll
                    for (int m = 0; m < 4; ++m) acc[ai][bj][m][n] += bv; }
        bool bad = st1.run(acc, u, wr, wc, fr, fq, lds, wid, lane) || poison != 0u;
        const float qnan = __builtin_nanf("");
#pragma unroll
        for (int ai = 0; ai < 2; ++ai)
#pragma unroll
            for (int m = 0; m < 4; ++m) { const int r = ai * HALF + wr * 64 + m * 16 + fr; const f32x2v sr = S[r]; const size_t off = (size_t)(u.pm * BM + r) * ldc + col0;
#pragma unroll
                for (int bj = 0; bj < 2; ++bj)
#pragma unroll
                    for (int n = 0; n < 2; ++n) { const f32x4 bs = *(const f32x4*)(base + off + bj * HALF + n * 16); acc[ai][bj][m][n] = bs + (acc[ai][bj][m][n] - sr.x) * sr.y; }
                asm volatile("" : "+v"(acc[ai][0][m][0]), "+v"(acc[ai][0][m][1]), "+v"(acc[ai][1][m][0]), "+v"(acc[ai][1][m][1]));
                if (m & 1) asm volatile("" ::: "memory"); }
        const bool bad1 = bad;
        bad = st2.run(acc, u, wr, wc, fr, fq, lds, wid, lane) || bad;
#pragma unroll
        for (int ai = 0; ai < 2; ++ai)
#pragma unroll
            for (int m = 0; m < 4; ++m) { const int r = ai * HALF + wr * 64 + m * 16 + fr; const f32x2v sr = S[r]; const size_t off = (size_t)(u.pm * BM + r) * ldc + col0;
#pragma unroll
                for (int bj = 0; bj < 2; ++bj)
#pragma unroll
                    for (int n = 0; n < 2; ++n) { const f32x4 x1 = acc[ai][bj][m][n]; *(f32x4*)(out + off + bj * HALF + n * 16) = bad1 ? (f32x4){qnan, qnan, qnan, qnan} : x1;
                        const f32x4 o = (x1 - sr.x) * sr.y; u32x2v w; w.x = cvt_pk_bf16(o[0], o[1]); w.y = cvt_pk_bf16(o[2], o[3]);
                        if (bad) { w.x = 0x7fc07fc0u; w.y = 0x7fc07fc0u; } *(u32x2v*)(xn + off + bj * HALF + n * 16) = w; }
                asm volatile("" ::: "memory"); }
    }
};

template <class Epi, class Sched, bool ALIGN_EPI = false, bool SP2 = false>
__device__ __forceinline__ void gemm_phase(PG8_LAS unsigned char* lds, const Gemm g, const Sched& S, const Epi& E, int wv) {
    int tid_ = wv * 64 + lane_id_(); asm volatile("" : "+v"(tid_));
    const int tid = tid_, wid = __builtin_amdgcn_readfirstlane(tid >> 6), lane = tid & 63, wr = wid >> 2, wc = wid & 3, fr = lane & 15, fq = lane >> 4;
    const int K = g.K, nt = K / BK;
    unsigned voffA[2], voffB[2];
#pragma unroll
    for (int i = 0; i < 2; ++i) { int R, C; stage_rc(tid * 16 + i * 8192, R, C); const int Rb = Epi::PERM ? ((R & ~31) + perm32(R & 31)) : R;
        voffA[i] = (unsigned)(R * K + C) * 2u; voffB[i] = (unsigned)(Rb * K + C) * 2u; }
    const size_t kstep = (size_t)(BK * 2);
    const size_t hstep = (size_t)HALF * K * 2;
    const size_t tstep = 2 * hstep;
    const unsigned ldsw = (unsigned)wid * 1024u;
    const int aoff = lds_byte(wr * 64 + fr, fq * 8), boff = lds_byte(wc * 32 + fr, fq * 8);
#define PG8_SA(b, h) (((b) * 2 + (h)) * HTB)
#define PG8_SB(b, h) ((4 + (b) * 2 + (h)) * HTB)
#define PG8_STAGE(bufoff, gbase, voff) do { _Pragma("unroll") for (int _i = 0; _i < 2; ++_i) \
        __builtin_amdgcn_global_load_lds((const unsigned*)((const char*)(gbase) + (voff)[_i]), (PG8_LAS unsigned*)(lds + (bufoff) + ldsw + _i * 8192), 16, 0, 0); } while (0)
#define PG8_LDA(dst, b, h) do { _Pragma("unroll") for (int m = 0; m < 4; ++m) _Pragma("unroll") for (int k = 0; k < 2; ++k) dst[m][k] = *(const PG8_LAS bf16x8*)(lds + PG8_SA(b, h) + aoff + m * 2048 + k * 1024); } while (0)
#define PG8_LDB(dst, b, h) do { _Pragma("unroll") for (int n = 0; n < 2; ++n) _Pragma("unroll") for (int k = 0; k < 2; ++k) dst[n][k] = *(const PG8_LAS bf16x8*)(lds + PG8_SB(b, h) + boff + n * 2048 + k * 1024); } while (0)
#define PG8_MMA(ai, bj, At, Bt) do { __builtin_amdgcn_s_setprio(1); _Pragma("unroll") for (int m = 0; m < 4; ++m) _Pragma("unroll") for (int n = 0; n < 2; ++n) _Pragma("unroll") for (int k = 0; k < 2; ++k) \
        acc[ai][bj][m][n] = __builtin_amdgcn_mfma_f32_16x16x32_bf16(Bt[n][k], At[m][k], acc[ai][bj][m][n], 0, 0, 0); __builtin_amdgcn_s_setprio(0); } while (0)
#define PG8_WAIT_V(n) asm volatile("s_waitcnt vmcnt(" #n ")" ::: "memory")
#define PG8_WAIT_L(n) asm volatile("s_waitcnt lgkmcnt(" #n ")" ::: "memory")
#define PG8_BAR __builtin_amdgcn_s_barrier()
#define PG8_SCHED __builtin_amdgcn_sched_barrier(0)
    Unit cur, nxt; int ui = 0;
    if (!S.next(0, cur)) return;
    f32x4 acc[2][2][4][2];
#pragma unroll
    for (int a = 0; a < 2; ++a)
#pragma unroll
        for (int b = 0; b < 2; ++b)
#pragma unroll
            for (int m = 0; m < 4; ++m)
#pragma unroll
                for (int n = 0; n < 2; ++n) acc[a][b][m][n] = (f32x4){0.f, 0.f, 0.f, 0.f};
    bf16x8 At[4][2], B0[2][2], B1[2][2];
    const char* cA = (const char*)g.A + (size_t)cur.pm * tstep; const char* cB = (const char*)g.Bt + (size_t)cur.pn * tstep;
    S.a_ready(cur);
    if constexpr (SP2) {
        PG8_STAGE(PG8_SB(0, 0), cB, voffB); PG8_STAGE(PG8_SB(0, 1), cB + hstep, voffB); PG8_STAGE(PG8_SA(0, 0), cA, voffA); PG8_STAGE(PG8_SA(0, 1), cA + hstep, voffA);
        if (wr == 1) PG8_BAR;
        PG8_WAIT_V(2); PG8_BAR;
        PG8_STAGE(PG8_SB(1, 0), cB + kstep, voffB); PG8_STAGE(PG8_SA(1, 0), cA + kstep, voffA); PG8_STAGE(PG8_SB(1, 1), cB + hstep + kstep, voffB);
        PG8_WAIT_V(6); PG8_BAR;
    } else {
        PG8_STAGE(PG8_SB(0, 0), cB, voffB); PG8_STAGE(PG8_SA(0, 0), cA, voffA); PG8_STAGE(PG8_SB(0, 1), cB + hstep, voffB); PG8_STAGE(PG8_SA(0, 1), cA + hstep, voffA);
        if (wr == 1) PG8_BAR;
        PG8_WAIT_V(4); PG8_BAR;
        PG8_STAGE(PG8_SB(1, 0), cB + kstep, voffB); PG8_STAGE(PG8_SA(1, 0), cA + kstep, voffA); PG8_STAGE(PG8_SB(1, 1), cB + hstep + kstep, voffB);
        PG8_WAIT_V(6); PG8_BAR;
    }
    for (;;) {
        const bool has_next = S.next(ui + 1, nxt);
        const char* nA = has_next ? (const char*)g.A + (size_t)nxt.pm * tstep : cA; const char* nB = has_next ? (const char*)g.Bt + (size_t)nxt.pn * tstep : cB;
        for (int t = 0; t < nt; t += 2) {
            const bool last = (t == nt - 2);
            const char* a1 = cA + (size_t)(t + 1) * kstep;
            const char* a2 = last ? nA : cA + (size_t)(t + 2) * kstep; const char* b2 = last ? nB : cB + (size_t)(t + 2) * kstep;
            const char* a3 = a2 + kstep; const char* b3 = b2 + kstep;
            if (last && has_next) S.a_ready(nxt);
            if constexpr (SP2) {
            PG8_LDB(B0, 0, 0); PG8_LDB(B1, 0, 1); PG8_SCHED; PG8_LDA(At, 0, 0); PG8_STAGE(PG8_SA(1, 1), a1 + hstep, voffA);
            PG8_WAIT_V(8); PG8_WAIT_L(0); PG8_BAR; PG8_MMA(0, 0, At, B0); PG8_MMA(0, 1, At, B1); PG8_BAR; PG8_SCHED;
            PG8_LDA(At, 0, 1); PG8_STAGE(PG8_SB(0, 0), b2, voffB); PG8_STAGE(PG8_SB(0, 1), b2 + hstep, voffB); PG8_STAGE(PG8_SA(0, 0), a2, voffA);
            PG8_WAIT_V(8); PG8_WAIT_L(0); PG8_BAR; PG8_MMA(1, 0, At, B0); PG8_MMA(1, 1, At, B1); PG8_BAR; PG8_SCHED;
            PG8_LDB(B0, 1, 0); PG8_LDB(B1, 1, 1); PG8_SCHED; PG8_LDA(At, 1, 0); PG8_STAGE(PG8_SA(0, 1), a2 + hstep, voffA);
            PG8_WAIT_V(8); PG8_WAIT_L(0); PG8_BAR; PG8_MMA(0, 0, At, B0); PG8_MMA(0, 1, At, B1); PG8_BAR; PG8_SCHED;
            PG8_LDA(At, 1, 1); PG8_STAGE(PG8_SB(1, 0), b3, voffB); PG8_STAGE(PG8_SB(1, 1), b3 + hstep, voffB); PG8_STAGE(PG8_SA(1, 0), a3, voffA);
            PG8_WAIT_V(8); PG8_WAIT_L(0); PG8_BAR; PG8_MMA(1, 0, At, B0); PG8_MMA(1, 1, At, B1); PG8_BAR; PG8_SCHED;
            } else {
            PG8_LDB(B0, 0, 0); PG8_SCHED; PG8_LDA(At, 0, 0); PG8_STAGE(PG8_SA(1, 1), a1 + hstep, voffA);
            PG8_WAIT_L(8); PG8_BAR; PG8_WAIT_L(0); PG8_MMA(0, 0, At, B0); PG8_BAR; PG8_SCHED;
            PG8_LDB(B1, 0, 1); PG8_STAGE(PG8_SB(0, 0), b2, voffB);
            PG8_BAR; PG8_WAIT_L(0); PG8_MMA(0, 1, At, B1); PG8_BAR;
            PG8_LDA(At, 0, 1); PG8_STAGE(PG8_SA(0, 0), a2, voffA);
            PG8_BAR; PG8_WAIT_L(0); PG8_MMA(1, 0, At, B0); PG8_BAR; PG8_SCHED;
            PG8_STAGE(PG8_SB(0, 1), b2 + hstep, voffB);
            PG8_WAIT_V(6); PG8_BAR; PG8_MMA(1, 1, At, B1); PG8_BAR;
            PG8_LDB(B0, 1, 0); PG8_SCHED; PG8_LDA(At, 1, 0); PG8_STAGE(PG8_SA(0, 1), a2 + hstep, voffA);
            PG8_WAIT_L(8); PG8_BAR; PG8_WAIT_L(0); PG8_MMA(0, 0, At, B0); PG8_BAR; PG8_SCHED;
            PG8_LDB(B1, 1, 1); PG8_STAGE(PG8_SB(1, 0), b3, voffB);
            PG8_BAR; PG8_WAIT_L(0); PG8_MMA(0, 1, At, B1); PG8_BAR;
            PG8_LDA(At, 1, 1); PG8_STAGE(PG8_SA(1, 0), a3, voffA);
            PG8_BAR; PG8_WAIT_L(0); PG8_MMA(1, 0, At, B0); PG8_BAR; PG8_SCHED;
            PG8_STAGE(PG8_SB(1, 1), b3 + hstep, voffB);
            PG8_WAIT_V(6); PG8_BAR; PG8_MMA(1, 1, At, B1); PG8_BAR;
            }
        }
        if constexpr (ALIGN_EPI) { if (wr == 0) PG8_BAR; }
        if constexpr (!Epi::AFTER_DRAIN) { E(acc, cur, wr, wc, fr, fq); S.done(cur); }
        if (!has_next) break;
#pragma unroll
        for (int a = 0; a < 2; ++a)
#pragma unroll
            for (int b = 0; b < 2; ++b)
#pragma unroll
                for (int m = 0; m < 4; ++m)
#pragma unroll
                    for (int n = 0; n < 2; ++n) acc[a][b][m][n] = (f32x4){0.f, 0.f, 0.f, 0.f};
        cur = nxt; cA = nA; cB = nB; ++ui;
        if constexpr (ALIGN_EPI) { if (wr == 1) PG8_BAR; }
    }
    PG8_WAIT_V(0);
    if constexpr (!ALIGN_EPI) { if (wr == 0) PG8_BAR; }
    PG8_BAR;
    if constexpr (Epi::AFTER_DRAIN) { E.fused(acc, cur, wr, wc, fr, fq, lds, wid, lane); S.done(cur); }
#undef PG8_SA
#undef PG8_SB
#undef PG8_STAGE
#undef PG8_LDA
#undef PG8_LDB
#undef PG8_MMA
#undef PG8_WAIT_V
#undef PG8_WAIT_L
#undef PG8_BAR
#undef PG8_SCHED
}
}
constexpr int S_ = 16384, D_ = 1024, FF_ = 2816, NIN_ = 7448, NINP_ = 7680;
constexpr int NTHREADS = 512;
constexpr size_t MiB = 1u << 20;
constexpr size_t WS_CTL = 0;
constexpr size_t WS_MOD = 1 * MiB;
constexpr size_t WS_ROPE = 2 * MiB;
constexpr size_t WS_W = 6 * MiB;
constexpr size_t W_FFIN0 = 0, W_FFIN1 = 11 * MiB, W_FFOUT0 = 22 * MiB, W_FFOUT1 = 27 * MiB + MiB / 2, W_IN = 33 * MiB, W_BATT = 48 * MiB, W_BDN = 48 * MiB + MiB / 2, W_OUT = 50 * MiB;
constexpr size_t WS_H = 58 * MiB;
constexpr size_t WS_R = 90 * MiB;
constexpr size_t R_ACT = 0, R_Y = 88 * MiB;
constexpr size_t R_PA = 0, R_QKVD = 0, R_PG = 0, R_PD = 72 * MiB, R_TINV = 72 * MiB, R_ODIR1 = 120 * MiB, R_ODN = 72 * MiB, R_T1 = 96 * MiB, R_PZ = 144 * MiB, R_AB = 168 * MiB, R_GB = 170 * MiB,
                 R_OATT = 172 * MiB, R_ATTN = 180 * MiB, R_Y2 = 160 * MiB, R_OG = 228 * MiB, R_LSE = 252 * MiB, R_ODIR0 = 228 * MiB, R_VEC = 253 * MiB;
constexpr size_t WS_END = 352 * MiB;

typedef unsigned short bf16;
typedef unsigned v4u __attribute__((ext_vector_type(4)));
typedef unsigned v2u __attribute__((ext_vector_type(2)));
typedef float f32x4 __attribute__((ext_vector_type(4)));
typedef float f32x2 __attribute__((ext_vector_type(2)));
#define LAS __attribute__((address_space(3)))

__device__ __forceinline__ unsigned f2bf(float f) { unsigned u = __builtin_bit_cast(unsigned, f); return (u + 0x7fffu + ((u >> 16) & 1u)) >> 16; }
__device__ __forceinline__ unsigned pk2(float lo, float hi) { return f2bf(lo) | (f2bf(hi) << 16); }
__device__ __forceinline__ float bf2f(unsigned short b) { return __builtin_bit_cast(float, (unsigned)b << 16); }
__device__ __forceinline__ float bflo(unsigned w) { return __builtin_bit_cast(float, w << 16); }
__device__ __forceinline__ float bfhi(unsigned w) { return __builtin_bit_cast(float, w & 0xffff0000u); }
__device__ __forceinline__ float wave_sum(float v) {
#pragma unroll
    for (int o = 1; o < 64; o <<= 1) v += __shfl_xor(v, o);
    return v;
}
__device__ __forceinline__ float sigmoidf_(float x) { return 1.0f / (1.0f + __expf(-x)); }
__device__ __forceinline__ float siluf_(float x) { return x / (1.0f + __expf(-x)); }

namespace pg8 {
struct EpiSwiglu {
    static constexpr bool PERM = true, AFTER_DRAIN = false;
    bf16_t* O; int ldc; int pad_;
    __device__ __forceinline__ void operator()(const f32x4 (&acc)[2][2][4][2], const Unit& u, int wr, int wc, int fr, int fq) const {
        const int row0 = u.pm * BM + wr * 64 + fr, col0 = u.pn * 128 + wc * 32 + 8 * fq;
#pragma unroll
        for (int ai = 0; ai < 2; ++ai)
#pragma unroll
            for (int m = 0; m < 4; ++m) {
                bf16_t* rowp = O + (size_t)(row0 + ai * HALF + m * 16) * ldc + col0;
                float v[8];
#pragma unroll
                for (int n = 0; n < 2; ++n)
#pragma unroll
                    for (int e = 0; e < 4; ++e) { const float g = acc[ai][0][m][n][e], uu = acc[ai][1][m][n][e]; v[n * 4 + e] = g * __builtin_amdgcn_rcpf(1.0f + __expf(-g)) * uu; }
                u32x4 w; w.x = cvt_pk_bf16(v[0], v[1]); w.y = cvt_pk_bf16(v[2], v[3]); w.z = cvt_pk_bf16(v[4], v[5]); w.w = cvt_pk_bf16(v[6], v[7]);
                *(u32x4*)rowp = w;
            }
    }
};
struct EpiBf16P {
    static constexpr bool PERM = true, AFTER_DRAIN = false;
    bf16_t* O; int ldc; int pad_;
    __device__ __forceinline__ void operator()(const f32x4 (&acc)[2][2][4][2], const Unit& u, int wr, int wc, int fr, int fq) const {
        const int row0 = u.pm * BM + wr * 64 + fr, col0 = u.pn * BM + wc * 32 + 8 * fq;
#pragma unroll
        for (int ai = 0; ai < 2; ++ai)
#pragma unroll
            for (int m = 0; m < 4; ++m) {
                bf16_t* rowp = O + (size_t)(row0 + ai * HALF + m * 16) * ldc + col0;
#pragma unroll
                for (int bj = 0; bj < 2; ++bj) { const f32x4 v0 = acc[ai][bj][m][0], v1 = acc[ai][bj][m][1];
                    u32x4 w; w.x = cvt_pk_bf16(v0[0], v0[1]); w.y = cvt_pk_bf16(v0[2], v0[3]); w.z = cvt_pk_bf16(v1[0], v1[1]); w.w = cvt_pk_bf16(v1[2], v1[3]);
                    *(u32x4*)(rowp + bj * HALF) = w; }
            }
    }
};
struct EpiF32 {
    static constexpr bool PERM = false, AFTER_DRAIN = false;
    float* O; int ldc; int pad_;
    __device__ __forceinline__ void operator()(const f32x4 (&acc)[2][2][4][2], const Unit& u, int wr, int wc, int fr, int fq) const {
        const int row0 = u.pm * BM + wr * 64 + fr, col0 = u.pn * BM + wc * 32 + 4 * fq;
#pragma unroll
        for (int ai = 0; ai < 2; ++ai)
#pragma unroll
            for (int m = 0; m < 4; ++m) {
                float* rowp = O + (size_t)(row0 + ai * HALF + m * 16) * ldc + col0;
#pragma unroll
                for (int bj = 0; bj < 2; ++bj)
#pragma unroll
                    for (int n = 0; n < 2; ++n) *(f32x4*)(rowp + bj * HALF + n * 16) = acc[ai][bj][m][n];
            }
    }
};
struct EpiInProj {
    static constexpr bool PERM = true, AFTER_DRAIN = false;
    bf16_t* PA; bf16_t* PD; bf16_t* PZ; float* AB;
    __device__ __forceinline__ void operator()(const f32x4 (&acc)[2][2][4][2], const Unit& u, int wr, int wc, int fr, int fq) const {
        const int row0 = u.pm * BM + wr * 64 + fr;
        if (u.pn == 21) {
            if (wc == 0) {
#pragma unroll
                for (int ai = 0; ai < 2; ++ai)
#pragma unroll
                    for (int m = 0; m < 4; ++m) {
                        float* rowp = AB + (size_t)(row0 + ai * HALF + m * 16) * 32 + 8 * fq;
                        *(f32x4*)rowp = acc[ai][0][m][0]; *(f32x4*)(rowp + 4) = acc[ai][0][m][1];
                    }
            }
            return;
        }
        bf16_t* base; int ldc, ct;
        if (u.pn < 9) { base = PA; ldc = 2304; ct = u.pn; } else if (u.pn < 18) { base = PD; ldc = 2304; ct = u.pn - 9; } else { base = PZ; ldc = 768; ct = u.pn - 18; }
        const int col0 = ct * BM + wc * 32 + 8 * fq;
#pragma unroll
        for (int ai = 0; ai < 2; ++ai)
#pragma unroll
            for (int m = 0; m < 4; ++m) {
                bf16_t* rowp = base + (size_t)(row0 + ai * HALF + m * 16) * ldc + col0;
#pragma unroll
                for (int bj = 0; bj < 2; ++bj) { const f32x4 v0 = acc[ai][bj][m][0], v1 = acc[ai][bj][m][1];
                    u32x4 w; w.x = cvt_pk_bf16(v0[0], v0[1]); w.y = cvt_pk_bf16(v0[2], v0[3]); w.z = cvt_pk_bf16(v1[0], v1[1]); w.w = cvt_pk_bf16(v1[2], v1[3]);
                    *(u32x4*)(rowp + bj * HALF) = w; }
            }
    }
};
struct EpiGateF32 {
    static constexpr bool PERM = false, AFTER_DRAIN = false;
    float* O; const bf16_t* gate; int ldg; int pad_;
    __device__ __forceinline__ void operator()(const f32x4 (&acc)[2][2][4][2], const Unit& u, int wr, int wc, int fr, int fq) const {
        const int row0 = u.pm * BM + wr * 64 + fr, col0 = u.pn * BM + wc * 32 + 4 * fq;
#pragma unroll
        for (int ai = 0; ai < 2; ++ai)
#pragma unroll
            for (int m = 0; m < 4; ++m) {
                const size_t r = (size_t)(row0 + ai * HALF + m * 16);
#pragma unroll
                for (int bj = 0; bj < 2; ++bj)
#pragma unroll
                    for (int n = 0; n < 2; ++n) { const int c = col0 + bj * HALF + n * 16;
                        const v2u gw = *(const v2u*)(gate + r * ldg + c);
                        f32x4 a = acc[ai][bj][m][n];
                        a[0] *= sigmoidf_(bflo(gw.x)); a[1] *= sigmoidf_(bfhi(gw.x)); a[2] *= sigmoidf_(bflo(gw.y)); a[3] *= sigmoidf_(bfhi(gw.y));
                        *(f32x4*)(O + r * 1024 + c) = a; }
            }
    }
};
struct EpiGateAddBf16 {
    static constexpr bool PERM = false, AFTER_DRAIN = false;
    bf16_t* O; const float* T1; const bf16_t* gate; int ldg; int pad_;
    __device__ __forceinline__ void operator()(const f32x4 (&acc)[2][2][4][2], const Unit& u, int wr, int wc, int fr, int fq) const {
        const int row0 = u.pm * BM + wr * 64 + fr, col0 = u.pn * BM + wc * 32 + 4 * fq;
#pragma unroll
        for (int ai = 0; ai < 2; ++ai)
#pragma unroll
            for (int m = 0; m < 4; ++m) {
                const size_t r = (size_t)(row0 + ai * HALF + m * 16);
#pragma unroll
                for (int bj = 0; bj < 2; ++bj)
#pragma unroll
                    for (int n = 0; n < 2; ++n) { const int c = col0 + bj * HALF + n * 16;
                        const v2u gw = *(const v2u*)(gate + r * ldg + c);
                        const f32x4 t = *(const f32x4*)(T1 + r * 1024 + c);
                        f32x4 a = acc[ai][bj][m][n];
                        a[0] = t[0] + a[0] * sigmoidf_(bflo(gw.x)); a[1] = t[1] + a[1] * sigmoidf_(bfhi(gw.x)); a[2] = t[2] + a[2] * sigmoidf_(bflo(gw.y)); a[3] = t[3] + a[3] * sigmoidf_(bfhi(gw.y));
                        v2u w; w.x = cvt_pk_bf16(a[0], a[1]); w.y = cvt_pk_bf16(a[2], a[3]);
                        *(v2u*)(O + r * 1024 + c) = w; }
            }
    }
};
}


#define GAS __attribute__((address_space(1)))
struct Params { const float* in[17]; float* out; unsigned char* ws; };
#define XB_TMO      128
#define XB_XCNT(j)  (256  + 64 * (j))
#define XB_XSUB(j)  (1280 + 64 * (j))
#define XB_XGEN(j)  (2304 + 64 * (j))
#define XB_TOP      3328
#define XB_TOPGEN   3392
#define XCD_BAR_WORDS 3456
#define XB_SPIN_CAP (1u << 18)

__device__ __forceinline__ unsigned xb_ld(unsigned* p)              { return __hip_atomic_load(p, __ATOMIC_RELAXED, __HIP_MEMORY_SCOPE_AGENT); }
__device__ __forceinline__ unsigned xb_add(unsigned* p, unsigned v) { return __hip_atomic_fetch_add(p, v, __ATOMIC_RELAXED, __HIP_MEMORY_SCOPE_AGENT); }
__device__ __forceinline__ unsigned xb_xcc_id() { return (unsigned)__builtin_amdgcn_s_getreg((3 << 11) | 20) & 0xFu; }
#define XB_SPIN(cond, bar) do { unsigned _sp = 0; while (cond) { __builtin_amdgcn_s_sleep(1); \
    if ((++_sp & 255u) == 0u) { if (xb_ld(&(bar)[XB_TMO])) break; if (_sp > XB_SPIN_CAP) { atomicAdd(&(bar)[XB_TMO], 1u); break; } } } } while (0)

struct XcdBarrier {
    unsigned* bar; unsigned x;
    volatile LAS unsigned* st;
};

__device__ __forceinline__ XcdBarrier xcd_barrier_post(unsigned* bar, volatile LAS unsigned* st) {
    XcdBarrier b; b.bar = bar; b.x = xb_xcc_id(); b.st = st;
    if (threadIdx.x == 0) (void)xb_add(&bar[XB_XCNT(b.x)], 1u);
    return b;
}
__device__ __forceinline__ void xcd_barrier_complete(unsigned* bar, unsigned x, unsigned& nloc, unsigned& nx) {
    const unsigned G = gridDim.x * gridDim.y * gridDim.z;
    unsigned sum, cnt, mine, sp = 0u;
    for (;;) {
        sum = 0u; cnt = 0u; mine = 0u;
#pragma unroll
        for (unsigned j = 0; j < 16; ++j) { const unsigned c = xb_ld(&bar[XB_XCNT(j)]); sum += c; cnt += (c > 0u) ? 1u : 0u; mine = (j == x) ? c : mine; }
        if (sum == G) break;
        __builtin_amdgcn_s_sleep(1);
        if ((++sp & 255u) == 0u) { if (xb_ld(&bar[XB_TMO])) break; if (sp > XB_SPIN_CAP) { atomicAdd(&bar[XB_TMO], 1u); break; } }
    }
    nloc = mine > 0u ? mine : 1u; nx = cnt > 0u ? cnt : 1u;
}

__device__ __forceinline__ void xcd_barrier(const XcdBarrier& b, int wv) {
    const bool leader_thread = (wv == 0) && (lane_id_() == 0);
    asm volatile("s_waitcnt vmcnt(0)" ::: "memory");
    __syncthreads();
    if (leader_thread) {
        unsigned* bar = b.bar;
        __builtin_amdgcn_s_waitcnt(0);
        unsigned nloc = b.st[0], nx = b.st[1];
        if (nloc == 0u) { xcd_barrier_complete(bar, b.x, nloc, nx); b.st[0] = nloc; b.st[1] = nx; }
        const unsigned old = xb_add(&bar[XB_XSUB(b.x)], 1u);
        const unsigned gen = old / nloc;
        if (old + 1u == (gen + 1u) * nloc) {
            __builtin_amdgcn_fence(__ATOMIC_RELEASE, "agent");
            asm volatile("s_waitcnt vmcnt(0)" ::: "memory");
            const unsigned og = xb_add(&bar[XB_TOP], 1u);
            const unsigned tg = og / nx;
            if (og + 1u == (tg + 1u) * nx) xb_add(&bar[XB_TOPGEN], 1u);
            else XB_SPIN(xb_ld(&bar[XB_TOPGEN]) == tg, bar);
            __builtin_amdgcn_fence(__ATOMIC_ACQUIRE, "agent");
            xb_add(&bar[XB_XGEN(b.x)], 1u);
            asm volatile("s_waitcnt vmcnt(0)" ::: "memory");
        } else {
            XB_SPIN(xb_ld(&bar[XB_XGEN(b.x)]) == gen, bar);
            __builtin_amdgcn_fence(__ATOMIC_ACQUIRE, "agent");
            asm volatile("s_waitcnt vmcnt(0)" ::: "memory");
        }
    }
    __syncthreads();
}

typedef const __attribute__((address_space(4))) unsigned char* ka_t;
__device__ __forceinline__ ka_t ka_() { ka_t k = (ka_t)__builtin_amdgcn_kernarg_segment_ptr(); asm volatile("" : "+s"(k)); return k; }
#define PIN(i) ((const float*)(*(const __attribute__((address_space(4))) unsigned long long*)(ka_() + 8 * (i))))
#define POUT ((float*)(*(const __attribute__((address_space(4))) unsigned long long*)(ka_() + 136)))
#define PWS ((unsigned char*)(*(const __attribute__((address_space(4))) unsigned long long*)(ka_() + 144)))
#define BID ((int)blockIdx.x)
#define GSZ ((int)gridDim.x)
__device__ __forceinline__ int srcmap(int mode, int n) {
    if (mode == 0) return n;
    if (mode == 1) return (n >> 8) * 128 + (n & 127) + ((n >> 7) & 1) * 2816;
    if (n < 5400) return n;
    if (n < 5632) return -1;
    if (n < 6656) return 5400 + (n - 5632);
    return 6424 + (n - 6656);
}
__device__ __forceinline__ void conv_item(const float* W, bf16* WT, int K, int Nsrc, int Ndst, int mode, int item, float* scr, int lane) {
    const int nblk = Ndst / 32, kb = item / nblk, nb = item % nblk, k0 = 64 * kb, n0 = 32 * nb;
    const int sc = srcmap(mode, n0 + (lane & 31));
#pragma unroll
    for (int i = 0; i < 32; ++i) { const int kk = 2 * i + (lane >> 5); scr[kk * 33 + (lane & 31)] = sc >= 0 ? W[(size_t)(k0 + kk) * Nsrc + sc] : 0.f; }
    __builtin_amdgcn_s_waitcnt(0xc07f); __builtin_amdgcn_wave_barrier();
    const int c = lane & 7;
#pragma unroll
    for (int j = 0; j < 4; ++j) { const int n = (lane >> 3) + 8 * j; const float* s = scr + (8 * c) * 33 + n;
        v4u o; o.x = pk2(s[0 * 33], s[1 * 33]); o.y = pk2(s[2 * 33], s[3 * 33]); o.z = pk2(s[4 * 33], s[5 * 33]); o.w = pk2(s[6 * 33], s[7 * 33]);
        *(v4u*)(WT + (size_t)(n0 + n) * K + k0 + 8 * c) = o; }
    __builtin_amdgcn_s_waitcnt(0xc07f); __builtin_amdgcn_wave_barrier();
}
__device__ __forceinline__ void ph_convert(int l, unsigned char* lds, int wv) {
    int tid_ = wv * 64 + lane_id_(); asm volatile("" : "+v"(tid_)); const int lane = tid_ & 63, wave = tid_ >> 6;
    float* scr = (float*)lds + wave * (64 * 33);
    unsigned char* wb = PWS + WS_W;
    constexpr int I_FI = 16 * 176, I_FO = 44 * 32, I_IN = 16 * 240, I_BA = 4 * 32, I_BD = 12 * 32, I_O = 16 * 32;
    constexpr int NIT = 2 * I_FI + 2 * I_FO + I_IN + I_BA + I_BD + I_O;
    for (int it = BID * 8 + wave; it < NIT; it += GSZ * 8) {
        int r = it;
        if (r < 2 * I_FI) { const int f = r / I_FI; conv_item(PIN(7) + ((size_t)l * 2 + f) * 1024 * 5632, (bf16*)(wb + (f ? W_FFIN1 : W_FFIN0)), 1024, 5632, 5632, 1, r % I_FI, scr, lane); continue; } r -= 2 * I_FI;
        if (r < 2 * I_FO) { const int f = r / I_FO; conv_item(PIN(8) + ((size_t)l * 2 + f) * 2816 * 1024, (bf16*)(wb + (f ? W_FFOUT1 : W_FFOUT0)), 2816, 1024, 1024, 0, r % I_FO, scr, lane); continue; } r -= 2 * I_FO;
        if (r < I_IN) { conv_item(PIN(9) + (size_t)l * 1024 * NIN_, (bf16*)(wb + W_IN), 1024, NIN_, NINP_, 2, r, scr, lane); continue; } r -= I_IN;
        if (r < I_BA) { conv_item(PIN(14) + (size_t)l * 256 * 1024, (bf16*)(wb + W_BATT), 256, 1024, 1024, 0, r, scr, lane); continue; } r -= I_BA;
        if (r < I_BD) { conv_item(PIN(15) + (size_t)l * 768 * 1024, (bf16*)(wb + W_BDN), 768, 1024, 1024, 0, r, scr, lane); continue; } r -= I_BD;
        conv_item(PIN(16) + (size_t)l * 1024 * 1024, (bf16*)(wb + W_OUT), 1024, 1024, 1024, 0, r, scr, lane);
    }
}
__device__ __forceinline__ void ph_ada(unsigned char* lds, int wv) {
    float* red = (float*)(lds + 72 * 1024);
    int tid_ = wv * 64 + lane_id_(); asm volatile("" : "+v"(tid_)); const int tid = tid_, lane = tid_ & 63, wave = tid_ >> 6;
    const float* c = PIN(1); const float* w_ada = PIN(3); const float* b_ada = PIN(4); float* mod = (float*)(PWS + WS_MOD);
    for (int u = BID; u < 72; u += GSZ) {
        const int l = u / 36, n0 = (u % 36) * 256;
        const float* W = w_ada + (size_t)l * 1024 * 9216 + (size_t)(wave * 128) * 9216 + n0 + 4 * lane;
        f32x4 acc = {0.f, 0.f, 0.f, 0.f};
#pragma unroll 1
        for (int k0 = 0; k0 < 128; k0 += 16) {
            f32x4 wv4[16];
#pragma unroll
            for (int kk = 0; kk < 16; ++kk) wv4[kk] = *(const f32x4*)(W + (size_t)(k0 + kk) * 9216);
#pragma unroll
            for (int kk = 0; kk < 16; ++kk) { const float cv = c[wave * 128 + k0 + kk]; const float sv = cv / (1.0f + __expf(-cv)); acc += sv * wv4[kk]; }
        }
        *(f32x4*)(red + wave * 256 + 4 * lane) = acc;
        __syncthreads();
        if (tid < 256) { float t = b_ada[l * 9216 + n0 + tid];
#pragma unroll
            for (int w = 0; w < 8; ++w) t += red[w * 256 + tid];
            mod[l * 9216 + n0 + tid] = t; }
        __syncthreads();
    }
}
__device__ const float ROPE_INV[32] = {1.000000000e+00f, 7.498942018e-01f, 5.623413324e-01f, 4.216965139e-01f, 3.162277639e-01f, 2.371373773e-01f, 1.778279394e-01f, 1.333521456e-01f, 1.000000015e-01f, 7.498942316e-02f, 5.623413250e-02f, 4.216964915e-02f, 3.162277490e-02f, 2.371373773e-02f, 1.778279431e-02f, 1.333521400e-02f, 9.999999776e-03f, 7.498942316e-03f, 5.623413250e-03f, 4.216964822e-03f, 3.162277630e-03f, 2.371373819e-03f, 1.778279431e-03f, 1.333521446e-03f, 1.000000047e-03f, 7.498941850e-04f, 5.623413017e-04f, 4.216965172e-04f, 3.162277571e-04f, 2.371373703e-04f, 1.778279402e-04f, 1.333521504e-04f};
__device__ __forceinline__ void ph_rope(int wv) {
    const int* pos = (const int*)PIN(2); float* tab = (float*)(PWS + WS_ROPE);
    int tid_ = wv * 64 + lane_id_(); asm volatile("" : "+v"(tid_));
    for (int idx = BID * NTHREADS + tid_; idx < S_ * 32; idx += GSZ * NTHREADS) {
        const int t = idx >> 5, i = idx & 31;
        const float inv = ROPE_INV[i];
        const float ang = (float)pos[t] * inv;
        float sn, cs; sincosf(ang, &sn, &cs);
        tab[idx] = cs; tab[S_ * 32 + idx] = sn;
    }
}
struct RowArgs { const float* xi; const bf16* y; float* xo; bf16* h; const float* wpost; const float* gate; const float* wpre; const float* shift; const float* scale; float coef; };
__device__ __forceinline__ void ph_rows(const RowArgs& a, int wv) {
    int tid_ = wv * 64 + lane_id_(); asm volatile("" : "+v"(tid_)); const int lane = tid_ & 63, wave = tid_ >> 6;
    for (int r = BID * 8 + wave; r < S_; r += GSZ * 8) {
        f32x4 x[4];
        const f32x4* xr = (const f32x4*)(a.xi + (size_t)r * D_) + lane;
#pragma unroll
        for (int j = 0; j < 4; ++j) x[j] = xr[64 * j];
        if (a.y) {
            f32x4 y[4]; float s = 0.f;
            const v2u* yr = (const v2u*)(a.y + (size_t)r * D_) + lane;
#pragma unroll
            for (int j = 0; j < 4; ++j) { const v2u yw = yr[64 * j]; y[j] = (f32x4){bflo(yw.x), bfhi(yw.x), bflo(yw.y), bfhi(yw.y)}; s += (y[j].x * y[j].x + y[j].y * y[j].y) + (y[j].z * y[j].z + y[j].w * y[j].w); }
            const float rs = 1.0f / sqrtf(wave_sum(s) * (1.f / D_) + 1e-6f);
#pragma unroll
            for (int j = 0; j < 4; ++j) { const f32x4 wp = ((const f32x4*)a.wpost)[lane + 64 * j], g = ((const f32x4*)a.gate)[lane + 64 * j];
                x[j] = x[j] + a.coef * g * ((y[j] * rs) * wp); }
            f32x4* xw = (f32x4*)(a.xo + (size_t)r * D_) + lane;
#pragma unroll
            for (int j = 0; j < 4; ++j) xw[64 * j] = x[j];
        }
        if (a.h) {
            float s = 0.f;
#pragma unroll
            for (int j = 0; j < 4; ++j) s += (x[j].x * x[j].x + x[j].y * x[j].y) + (x[j].z * x[j].z + x[j].w * x[j].w);
            const float rs = 1.0f / sqrtf(wave_sum(s) * (1.f / D_) + 1e-6f);
            v2u* hw = (v2u*)(a.h + (size_t)r * D_) + lane;
#pragma unroll
            for (int j = 0; j < 4; ++j) { const f32x4 wp = ((const f32x4*)a.wpre)[lane + 64 * j], sc = ((const f32x4*)a.scale)[lane + 64 * j], sh = ((const f32x4*)a.shift)[lane + 64 * j];
                const f32x4 v = ((x[j] * rs) * wp) * (1.0f + sc) + sh;
                v2u w; w.x = pk2(v.x, v.y); w.y = pk2(v.z, v.w); hw[64 * j] = w; }
        }
    }
}
constexpr int ATT_PITCH = 68;
__device__ __forceinline__ void ph_attn_v1(const bf16* PA, const float* rope, bf16* OG, float* LSE, unsigned char* lds, int wv) {
    float* qs = (float*)lds; float* ks = qs + 64 * ATT_PITCH; float* vs = ks + 192 * ATT_PITCH;
    int tid_ = wv * 64 + lane_id_(); asm volatile("" : "+v"(tid_)); const int tid = tid_, lane = tid & 63, wave = tid >> 6;
    for (int u = BID; u < 3072; u += GSZ) {
        const int hg = u & 3, w = (u >> 2) & 255, gi = u >> 10;
        const int dil = 1 << (2 * gi), L = S_ / dil, r = w % dil, nb = w / dil, head = gi * 4 + hg;
        __syncthreads();
        for (int rr = wave; rr < 448; rr += 8) {
            int mm, colbase; float* dst; bool rot; float sc = 1.f;
            if (rr < 64) { mm = nb * 64 + rr; colbase = head * 64; dst = qs + rr * ATT_PITCH; rot = true; sc = 0.125f; }
            else if (rr < 256) { mm = nb * 64 - 64 + (rr - 64); colbase = 768 + head * 64; dst = ks + (rr - 64) * ATT_PITCH; rot = true; }
            else { mm = nb * 64 - 64 + (rr - 256); colbase = 1536 + head * 64; dst = vs + (rr - 256) * ATT_PITCH; rot = false; }
            float val = 0.f;
            if (mm >= 0 && mm < L) {
                const int tok = mm * dil + r;
                val = bf2f(PA[(size_t)tok * 2304 + colbase + lane]);
                if (rot) {
                    const float other = __shfl_xor(val, 32);
                    const float cs = rope[tok * 32 + (lane & 31)], sn = rope[S_ * 32 + tok * 32 + (lane & 31)];
                    val = (lane < 32) ? (val * cs - other * sn) : (val * cs + other * sn);
                }
            }
            dst[lane] = val * sc;
        }
        __syncthreads();
        const int i = tid >> 3, part = tid & 7;
        float q[64], acc[64];
#pragma unroll
        for (int d = 0; d < 64; d += 4) { const f32x4 t = *(const f32x4*)(qs + i * ATT_PITCH + d); q[d] = t.x; q[d + 1] = t.y; q[d + 2] = t.z; q[d + 3] = t.w; }
#pragma unroll
        for (int d = 0; d < 64; ++d) acc[d] = 0.f;
        float m = -1e30f, l = 0.f;
        for (int jj = 0; jj < 24; ++jj) {
            const int j = part + 8 * jj, mm = nb * 64 - 64 + j, dj = j - 64 - i;
            const bool ok = (dj <= 64) && (dj >= -64) && (mm >= 0) && (mm < L);
            if (ok) {
                const float* kr = ks + j * ATT_PITCH; float s = 0.f;
#pragma unroll
                for (int d = 0; d < 64; d += 4) { const f32x4 t = *(const f32x4*)(kr + d); s += q[d] * t.x + q[d + 1] * t.y + q[d + 2] * t.z + q[d + 3] * t.w; }
                const float mn = fmaxf(m, s), al = __expf(m - mn), p = __expf(s - mn);
                l = l * al + p; m = mn;
                const float* vr = vs + j * ATT_PITCH;
#pragma unroll
                for (int d = 0; d < 64; d += 4) { const f32x4 t = *(const f32x4*)(vr + d);
                    acc[d] = acc[d] * al + p * t.x; acc[d + 1] = acc[d + 1] * al + p * t.y; acc[d + 2] = acc[d + 2] * al + p * t.z; acc[d + 3] = acc[d + 3] * al + p * t.w; }
            }
        }
        float mt = fmaxf(m, __shfl_xor(m, 1)); mt = fmaxf(mt, __shfl_xor(mt, 2)); mt = fmaxf(mt, __shfl_xor(mt, 4));
        const float f = __expf(m - mt);
        l *= f; l += __shfl_xor(l, 1); l += __shfl_xor(l, 2); l += __shfl_xor(l, 4);
#pragma unroll
        for (int d = 0; d < 64; ++d) acc[d] *= f;
        const bool b2 = part & 4, b1 = part & 2, b0 = part & 1;
        float r32[32], r16[16], r8[8];
#pragma unroll
        for (int d = 0; d < 32; ++d) { const float keep = b2 ? acc[32 + d] : acc[d], send = b2 ? acc[d] : acc[32 + d]; r32[d] = keep + __shfl_xor(send, 4); }
#pragma unroll
        for (int d = 0; d < 16; ++d) { const float keep = b1 ? r32[16 + d] : r32[d], send = b1 ? r32[d] : r32[16 + d]; r16[d] = keep + __shfl_xor(send, 2); }
#pragma unroll
        for (int d = 0; d < 8; ++d) { const float keep = b0 ? r16[8 + d] : r16[d], send = b0 ? r16[d] : r16[8 + d]; r8[d] = keep + __shfl_xor(send, 1); }
        const float il = 1.0f / l;
        const int tok = (nb * 64 + i) * dil + r;
        v4u o; o.x = pk2(r8[0] * il, r8[1] * il); o.y = pk2(r8[2] * il, r8[3] * il); o.z = pk2(r8[4] * il, r8[5] * il); o.w = pk2(r8[6] * il, r8[7] * il);
        *(v4u*)(OG + ((size_t)gi * S_ + tok) * 256 + hg * 64 + part * 8) = o;
        if (part == 0) LSE[((size_t)gi * S_ + tok) * 4 + hg] = mt + logf(l);
    }
}

__device__ __forceinline__ void ph_dnprep(const bf16* PD, const float* AB, const float* convw, const float* a_log, const float* dt_bias, bf16* QKVd, float* GB, const bf16* OG, const float* LSE, bf16* OATT, int wv) {
    int tid_ = wv * 64 + lane_id_(); asm volatile("" : "+v"(tid_)); const int tid = tid_, lane = tid_ & 63, wave = tid_ >> 6;
    for (int it = BID * 8 + wave; it < 1024 * 5; it += GSZ * 8) {
        const int tb = it / 5, sg = it % 5, c0 = sg * 512 + lane * 8, t0 = tb * 16;
        if (c0 < 2304) {
            const int seg = c0 >> 7;
            float cw[5][8];
#pragma unroll
            for (int j = 0; j < 5; ++j) { const f32x4 a = *(const f32x4*)(convw + j * 2304 + c0), b = *(const f32x4*)(convw + j * 2304 + c0 + 4);
                cw[j][0] = a.x; cw[j][1] = a.y; cw[j][2] = a.z; cw[j][3] = a.w; cw[j][4] = b.x; cw[j][5] = b.y; cw[j][6] = b.z; cw[j][7] = b.w; }
            v4u win[5];
#pragma unroll
            for (int j = 0; j < 4; ++j) { const int tt = t0 + j - 2; win[j + 1] = (tt >= 0) ? *(const v4u*)(PD + (size_t)tt * 2304 + c0) : (v4u){0u, 0u, 0u, 0u}; }
#pragma unroll
            for (int i = 0; i < 16; ++i) {
#pragma unroll
                for (int j = 0; j < 4; ++j) win[j] = win[j + 1];
                { const int tt = t0 + i + 2; win[4] = (tt < S_) ? *(const v4u*)(PD + (size_t)tt * 2304 + c0) : (v4u){0u, 0u, 0u, 0u}; }
                float a[8];
#pragma unroll
                for (int e = 0; e < 8; ++e) a[e] = 0.f;
#pragma unroll
                for (int j = 0; j < 5; ++j) { const unsigned wx[4] = {win[j].x, win[j].y, win[j].z, win[j].w};
#pragma unroll
                    for (int e = 0; e < 4; ++e) { a[2 * e] += bflo(wx[e]) * cw[j][2 * e]; a[2 * e + 1] += bfhi(wx[e]) * cw[j][2 * e + 1]; } }
                float ss = 0.f;
#pragma unroll
                for (int e = 0; e < 8; ++e) { a[e] = a[e] * __builtin_amdgcn_rcpf(1.0f + __expf(-a[e])); ss += a[e] * a[e]; }
                if (seg < 12) {
                    ss += __shfl_xor(ss, 1); ss += __shfl_xor(ss, 2); ss += __shfl_xor(ss, 4); ss += __shfl_xor(ss, 8);
                    const float sc = (1.0f / sqrtf(ss + 1e-6f)) * (seg < 6 ? 0.08838834764831845f : 1.0f);
#pragma unroll
                    for (int e = 0; e < 8; ++e) a[e] *= sc;
                }
                v4u o; o.x = pk2(a[0], a[1]); o.y = pk2(a[2], a[3]); o.z = pk2(a[4], a[5]); o.w = pk2(a[6], a[7]);
                *(v4u*)(QKVd + (size_t)(t0 + i) * 2304 + c0) = o;
            }
        }
    }
    for (int e = BID * NTHREADS + tid; e < S_ * 12; e += GSZ * NTHREADS) {
        const int t = e / 12, idx = e % 12;
        const float braw = AB[(size_t)t * 32 + idx], araw = AB[(size_t)t * 32 + 12 + idx];
        const float x = araw + dt_bias[idx];
        const float sp = fmaxf(x, 0.f) + log1pf(expf(-fabsf(x)));
        GB[(size_t)idx * S_ + t] = -expf(a_log[idx]) * sp;
        GB[(size_t)(12 + idx) * S_ + t] = 1.0f / (1.0f + expf(-braw));
    }
    for (int t = BID * 8 + wave; t < S_; t += GSZ * 8) {
        const int ch = 4 * lane, hg = lane >> 4;
        const float l0 = LSE[(size_t)t * 4 + hg], l1 = LSE[((size_t)S_ + t) * 4 + hg], l2 = LSE[((size_t)2 * S_ + t) * 4 + hg];
        const float mx = fmaxf(l0, fmaxf(l1, l2));
        float w0 = expf(l0 - mx), w1 = expf(l1 - mx), w2 = expf(l2 - mx);
        const float inv = 1.0f / (w0 + w1 + w2); w0 *= inv; w1 *= inv; w2 *= inv;
        const v2u a = *(const v2u*)(OG + (size_t)t * 256 + ch), b = *(const v2u*)(OG + ((size_t)S_ + t) * 256 + ch), cc = *(const v2u*)(OG + ((size_t)2 * S_ + t) * 256 + ch);
        v2u o;
        o.x = pk2(w0 * bflo(a.x) + w1 * bflo(b.x) + w2 * bflo(cc.x), w0 * bfhi(a.x) + w1 * bfhi(b.x) + w2 * bfhi(cc.x));
        o.y = pk2(w0 * bflo(a.y) + w1 * bflo(b.y) + w2 * bflo(cc.y), w0 * bfhi(a.y) + w1 * bfhi(b.y) + w2 * bfhi(cc.y));
        *(v2u*)(OATT + (size_t)t * 256 + ch) = o;
    }
}

__device__ __forceinline__ void ph_final(const bf16* ODIR0, const bf16* ODIR1, const bf16* PZ, const float* dnw, bf16* ODN, int wv) {
    int tid_ = wv * 64 + lane_id_(); asm volatile("" : "+v"(tid_)); const int lane = tid_ & 63, wave = tid_ >> 6;
    for (int t = BID * 8 + wave; t < S_; t += GSZ * 8) {
#pragma unroll
        for (int h = 0; h < 6; ++h) {
            const int c = h * 128 + 2 * lane;
            const unsigned wf = *(const unsigned*)(ODIR0 + (size_t)t * 768 + c), wb = *(const unsigned*)(ODIR1 + (size_t)t * 768 + c);
            float o0 = bflo(wf) + bflo(wb), o1 = bfhi(wf) + bfhi(wb);
            const float ms = wave_sum(o0 * o0 + o1 * o1) * (1.0f / 128.0f);
            const float sc = 1.0f / sqrtf(ms + 1e-6f);
            const unsigned zw = *(const unsigned*)(PZ + (size_t)t * 768 + c);
            const f32x2 nw = *(const f32x2*)(dnw + 2 * lane);
            o0 = o0 * sc * nw.x * siluf_(bflo(zw)); o1 = o1 * sc * nw.y * siluf_(bfhi(zw));
            *(unsigned*)(ODN + (size_t)t * 768 + c) = pk2(o0, o1);
        }
    }
}
typedef short bf16x8_t __attribute__((ext_vector_type(8)));
typedef short s16x4_t __attribute__((ext_vector_type(4)));
#define MFMA16(a, b, c) __builtin_amdgcn_mfma_f32_16x16x32_bf16((a), (b), (c), 0, 0, 0)

__device__ __forceinline__ void ph_dn_pre(const bf16* QKVd, const float* GB, bf16* TINV, bf16* ATTN, float* VEC, unsigned char* lds, int wv) {
    int tid_ = wv * 64 + lane_id_(); asm volatile("" : "+v"(tid_));
    const int tid = tid_, lane = tid & 63, g = lane >> 4, m16 = lane & 15;
    float* GR = (float*)lds; float* Ms = GR + 2 * 64 * 65; float* Gs = Ms + 2 * 64 * 68; float* Bs = Gs + 128;
    for (int u = BID; u < 1536; u += GSZ) {
        const int n = u / 6, h = u % 6;
        __syncthreads();
        {
            const int kind = wv >> 2, mt = wv & 3;
            const bf16* arow = QKVd + (size_t)(64 * n + 16 * mt + m16) * 2304 + (kind ? 0 : 768) + h * 128 + 8 * g;
            bf16x8_t a[4];
#pragma unroll
            for (int ks = 0; ks < 4; ++ks) a[ks] = *(const bf16x8_t*)(arow + 32 * ks);
#pragma unroll
            for (int nt = 0; nt < 4; ++nt) {
                const bf16* brow = QKVd + (size_t)(64 * n + 16 * nt + m16) * 2304 + 768 + h * 128 + 8 * g;
                f32x4 acc = {0.f, 0.f, 0.f, 0.f};
#pragma unroll
                for (int ks = 0; ks < 4; ++ks) acc = MFMA16(a[ks], *(const bf16x8_t*)(brow + 32 * ks), acc);
#pragma unroll
                for (int rg = 0; rg < 4; ++rg) GR[kind * 64 * 65 + (16 * mt + 4 * g + rg) * 65 + 16 * nt + m16] = acc[rg];
            }
        }
        if ((wv & 3) == 0) {
            const int d = wv >> 2, tok = 64 * n + (d ? 63 - lane : lane);
            float gv = GB[(size_t)(d * 6 + h) * S_ + tok]; const float be = GB[(size_t)(12 + d * 6 + h) * S_ + tok];
#pragma unroll
            for (int o = 1; o < 64; o <<= 1) { const float t = __shfl_up(gv, o); if (lane >= o) gv += t; }
            const float gl = __shfl(gv, 63);
            Gs[d * 64 + lane] = gv; Bs[d * 64 + lane] = be;
            float* vec = VEC + (size_t)(u * 2 + d) * 256;
            vec[lane] = __expf(gv); vec[64 + lane] = be; vec[128 + lane] = __expf(gl - gv); vec[192 + lane] = __expf(gl);
        }
        __syncthreads();
        {
            const int d = wv >> 2, tl = tid & 255, i = tl >> 2, jq = tl & 3, ii = d ? 63 - i : i;
            const float Gi = Gs[d * 64 + i], bi = Bs[d * 64 + i];
            unsigned pk[8];
#pragma unroll
            for (int jj = 0; jj < 16; jj += 2) {
                float at[2];
#pragma unroll
                for (int e = 0; e < 2; ++e) {
                    const int j = 16 * jq + jj + e, jx = d ? 63 - j : j;
                    const float dec = (j <= i) ? __expf(Gi - Gs[d * 64 + j]) : 0.f;
                    const float kk = GR[ii * 65 + jx], qk = GR[64 * 65 + ii * 65 + jx];
                    Ms[d * 64 * 68 + i * 68 + j] = (j < i) ? bi * kk * dec : 0.f;
                    at[e] = (j <= i) ? qk * dec : 0.f;
                }
                pk[jj >> 1] = pk2(at[0], at[1]);
            }
            v4u* dst = (v4u*)(ATTN + ((size_t)(u * 2 + d) * 64 + i) * 64 + 16 * jq);
            v4u o0; o0.x = pk[0]; o0.y = pk[1]; o0.z = pk[2]; o0.w = pk[3]; v4u o1; o1.x = pk[4]; o1.y = pk[5]; o1.z = pk[6]; o1.w = pk[7];
            dst[0] = o0; dst[1] = o1;
        }
        __syncthreads();
        if ((wv & 3) == 0) {
            const int d = wv >> 2, c = lane; const float* Md = Ms + d * 64 * 68;
            float x[64];
            x[0] = (c == 0) ? 1.f : 0.f;
#pragma unroll
            for (int i = 1; i < 64; ++i) {
                f32x4 mr[16];
#pragma unroll
                for (int j0 = 0; j0 < i; j0 += 4) mr[j0 >> 2] = *(const f32x4*)(Md + i * 68 + j0);
                float s0 = (i == c) ? 1.f : 0.f, s1 = 0.f, s2 = 0.f, s3 = 0.f;
#pragma unroll
                for (int j0 = 0; j0 < i; j0 += 4) { const f32x4 mv = mr[j0 >> 2];
                    s0 -= mv.x * x[j0]; if (j0 + 1 < i) s1 -= mv.y * x[j0 + 1]; if (j0 + 2 < i) s2 -= mv.z * x[j0 + 2]; if (j0 + 3 < i) s3 -= mv.w * x[j0 + 3]; }
                x[i] = (s0 + s1) + (s2 + s3);
            }
            bf16* outp = TINV + (size_t)(u * 2 + d) * 4096 + c;
#pragma unroll
            for (int i = 0; i < 64; ++i) outp[i * 64] = (bf16)f2bf(x[i]);
        }
    }
}

constexpr int SC_NC = 2;
constexpr int SC_KT = 0, SC_QT = 17408, SC_TI = 34816, SC_AT = 44032, SC_VT = 53248, SC_VC = SC_VT + 4096, SC_BUF = SC_VC + 1024;
constexpr int SC_ST = 2 * SC_BUF, SC_RT = SC_ST + 16 * SC_NC * 272, SC_VNT = SC_RT + 16 * SC_NC * 144, SC_VST = SC_VNT + 16 * SC_NC * 144, SC_END = SC_VST + 16 * SC_NC * 144;
static_assert(SC_END <= 146432, "scan LDS");
constexpr size_t SCS_MAT = 128 * 128;
__device__ __forceinline__ float* scs_B(float* base, int p, int j) { return base + (size_t)(p * 3 + j) * SCS_MAT; }
__device__ __forceinline__ float* scs_A(float* base, int p, int j) { return base + (size_t)(36 + p * 2 + (j - 1)) * SCS_MAT; }
template <int PASS>
__device__ __forceinline__ void ph_dn_scan(const bf16* QKVd, const bf16* TINV, const bf16* ATTN, const float* VEC, bf16* ODIR0, bf16* ODIR1, float* SCS, LAS unsigned char* lds, int wv) {
    const int xl = BID & 7, slot = BID >> 3;
    int p, j, cs; bool has_out, v_zero;
    if (PASS == 1) {
        if (slot < 24) { const int grp = xl * 3 + (slot >> 3), within = slot & 7; p = grp >> 1; j = 1 + (grp & 1); v_zero = (within >> 2) != 0; cs = within & 3; has_out = false; }
        else { const int s4 = slot - 24; int gi; if (xl < 4) gi = xl * 2 + (s4 >> 2); else { if (s4 >= 4) return; gi = 8 + (xl - 4); } p = gi; j = 0; cs = s4 & 3; has_out = true; v_zero = false; }
    } else {
        if (slot >= 20) return; const int v = xl * 20 + slot; if (v >= 144) return;
        const int grp = v >> 2; p = grp / 3; j = 1 + grp % 3; cs = v & 3; has_out = true; v_zero = false;
    }
    const int d = p / 6, h = p % 6;
    int tid_ = wv * 64 + lane_id_(); asm volatile("" : "+v"(tid_));
    const int tid = tid_, lane = tid & 63, g = lane >> 4, m16 = lane & 15, t4 = wv & 3;
    bf16* ODIR = d ? ODIR1 : ODIR0;
    v4u pfA[7], pfB[7];
#define SC_LOAD(pf, step) do { const int n_ = d ? 255 - (step) : (step); const size_t cb_ = (size_t)((n_ * 6 + h) * 2 + d); \
        _Pragma("unroll") for (int k_ = 0; k_ < 7; ++k_) { int q_ = tid + 512 * k_; if (k_ == 6 && q_ > 3391) q_ = 3391; const void* src_; \
            if (k_ < 4) { const int qq_ = q_ & 1023, row_ = qq_ >> 4, ch_ = qq_ & 15; const int tok_ = 64 * n_ + (d ? 63 - row_ : row_); src_ = QKVd + (size_t)tok_ * 2304 + (k_ < 2 ? 768 : 0) + h * 128 + ch_ * 8; } \
            else if (k_ < 6) { const int qq_ = q_ & 511, row_ = qq_ >> 3, ch_ = qq_ & 7; src_ = (k_ == 4 ? TINV : ATTN) + cb_ * 4096 + row_ * 64 + ch_ * 8; } \
            else { const int qq_ = q_ - 3072; const int row_ = (qq_ & 255) >> 2, ch_ = qq_ & 3; const int tok_ = 64 * n_ + (d ? 63 - row_ : row_); \
                   const void* sv_ = QKVd + (size_t)tok_ * 2304 + 1536 + h * 128 + cs * 32 + ch_ * 8; const void* sc_ = VEC + cb_ * 256 + ((qq_ - 256) & 63) * 4; src_ = (qq_ < 256) ? sv_ : sc_; } \
            if (!has_out && (k_ == 2 || k_ == 3 || k_ == 5)) src_ = TINV + cb_ * 4096;        \
            asm volatile("global_load_dwordx4 %0, %1, off" : "=v"(pf[k_]) : "v"(src_) : "memory"); } } while (0)
#define SC_WRITE(pf, bufsel) do { LAS unsigned char* bb_ = lds + (bufsel) * SC_BUF; \
        _Pragma("unroll") for (int k_ = 0; k_ < 7; ++k_) { const int q_ = tid + 512 * k_; int off_ = -1; \
            if (k_ < 4) { const int qq_ = q_ & 1023, row_ = qq_ >> 4, ch_ = qq_ & 15; off_ = (k_ < 2 ? SC_KT : SC_QT) + row_ * 272 + ch_ * 16; } \
            else if (k_ < 6) { const int qq_ = q_ & 511, row_ = qq_ >> 3, ch_ = qq_ & 7; off_ = (k_ == 4 ? SC_TI : SC_AT) + row_ * 144 + ch_ * 16; } \
            else { const int qq_ = q_ - 3072; if (qq_ < 256) off_ = SC_VT + qq_ * 16; else if (qq_ < 320) off_ = SC_VC + (qq_ - 256) * 16; } \
            if (off_ >= 0) *(LAS v4u*)(bb_ + off_) = pf[k_]; } } while (0)
#define SC_BAR() do { asm volatile("s_waitcnt lgkmcnt(0)" ::: "memory"); __builtin_amdgcn_s_barrier(); asm volatile("" ::: "memory"); } while (0)
#define SC_WAIT(pf, N) asm volatile("s_waitcnt vmcnt(" #N ")" : "+v"(pf[0]), "+v"(pf[1]), "+v"(pf[2]), "+v"(pf[3]), "+v"(pf[4]), "+v"(pf[5]), "+v"(pf[6]) :: "memory")
#define SC_WAIT4(pf, N) asm volatile("s_waitcnt vmcnt(" #N ")" : "+v"(pf[0]), "+v"(pf[1]), "+v"(pf[4]), "+v"(pf[6]) :: "memory")
#define SC_OSTORE(stepo) do { if (has_out && wv >= 4) { const int no_ = d ? 255 - (stepo) : (stepo); \
        _Pragma("unroll") for (int ct = 0; ct < SC_NC; ++ct) _Pragma("unroll") for (int rg = 0; rg < 4; ++rg) { const int i_ = 16 * t4 + 4 * g + rg, tok_ = 64 * no_ + (d ? 63 - i_ : i_); \
            ODIR[(size_t)tok_ * 768 + h * 128 + cs * 32 + ct * 16 + m16] = (bf16)f2bf(oprev[ct][rg]); } } } while (0)
#define SC_STEP(s, PFW, PFL) do { const int s_ = (s); const int cur = s_ & 1; \
        LAS unsigned char* B = lds + cur * SC_BUF; \
        SC_LOAD(PFL, (s_ + 2 < s_end ? s_ + 2 : s_end - 1)); \
        if (s_ > s_beg) SC_OSTORE(s_ - 1); \
        const LAS float* VC = (const LAS float*)(B + SC_VC); \
        bf16x8_t sb[SC_NC][4]; \
        _Pragma("unroll") for (int ct = 0; ct < SC_NC; ++ct) _Pragma("unroll") for (int ks = 0; ks < 4; ++ks) sb[ct][ks] = *(const LAS bf16x8_t*)(lds + SC_ST + (16 * ct + m16) * 272 + (32 * ks + 8 * g) * 2); \
        f32x4 acc1[SC_NC]; \
        _Pragma("unroll") for (int ct = 0; ct < SC_NC; ++ct) acc1[ct] = (f32x4){0.f, 0.f, 0.f, 0.f}; \
        const f32x4 eG4 = *(const LAS f32x4*)(VC + 16 * t4 + 4 * g); \
        if (wv < 4 || has_out) { const LAS unsigned char* ap = B + (wv < 4 ? SC_KT : SC_QT) + (16 * t4 + m16) * 272 + 16 * g; \
          _Pragma("unroll") for (int ks = 0; ks < 4; ++ks) { const bf16x8_t a_ = *(const LAS bf16x8_t*)(ap + 64 * ks); \
              _Pragma("unroll") for (int ct = 0; ct < SC_NC; ++ct) acc1[ct] = MFMA16(a_, sb[ct][ks], acc1[ct]); } } \
        if (wv < 4) { const f32x4 be4 = *(const LAS f32x4*)(VC + 64 + 16 * t4 + 4 * g); \
            _Pragma("unroll") for (int ct = 0; ct < SC_NC; ++ct) { float r[4]; \
                _Pragma("unroll") for (int rg = 0; rg < 4; ++rg) { const float vv = v_zero ? 0.f : bf2f(*(const LAS unsigned short*)(B + SC_VT + (16 * t4 + 4 * g + rg) * 64 + (16 * ct + m16) * 2)); r[rg] = be4[rg] * (vv - eG4[rg] * acc1[ct][rg]); } \
                v2u w; w.x = pk2(r[0], r[1]); w.y = pk2(r[2], r[3]); *(LAS v2u*)(lds + SC_RT + (16 * ct + m16) * 144 + (16 * t4 + 4 * g) * 2) = w; } \
        } else { _Pragma("unroll") for (int ct = 0; ct < SC_NC; ++ct) _Pragma("unroll") for (int rg = 0; rg < 4; ++rg) acc1[ct][rg] *= eG4[rg]; } \
        SC_BAR(); \
        if (wv < 4) { const LAS unsigned char* ap = B + SC_TI + (16 * t4 + m16) * 144 + 16 * g; \
            const bf16x8_t a0_ = *(const LAS bf16x8_t*)ap, a1_ = *(const LAS bf16x8_t*)(ap + 64); \
            const f32x4 eL4 = *(const LAS f32x4*)(VC + 128 + 16 * t4 + 4 * g); \
            _Pragma("unroll") for (int ct = 0; ct < SC_NC; ++ct) { f32x4 vn = {0.f, 0.f, 0.f, 0.f}; \
                vn = MFMA16(a0_, *(const LAS bf16x8_t*)(lds + SC_RT + (16 * ct + m16) * 144 + (8 * g) * 2), vn); \
                vn = MFMA16(a1_, *(const LAS bf16x8_t*)(lds + SC_RT + (16 * ct + m16) * 144 + (32 + 8 * g) * 2), vn); \
                v2u w; w.x = pk2(vn[0], vn[1]); w.y = pk2(vn[2], vn[3]); *(LAS v2u*)(lds + SC_VNT + (16 * ct + m16) * 144 + (16 * t4 + 4 * g) * 2) = w; \
                v2u w2; w2.x = pk2(vn[0] * eL4[0], vn[1] * eL4[1]); w2.y = pk2(vn[2] * eL4[2], vn[3] * eL4[3]); *(LAS v2u*)(lds + SC_VST + (16 * ct + m16) * 144 + (16 * t4 + 4 * g) * 2) = w2; } } \
        SC_BAR(); \
        { bf16x8_t ka[2]; \
          _Pragma("unroll") for (int ks = 0; ks < 2; ++ks) { \
              const LAS unsigned char* tp = B + SC_KT + (32 * ks + 8 * g + (m16 >> 2)) * 272 + (16 * wv + 4 * (m16 & 3)) * 2; \
              const s16x4_t lo = __builtin_amdgcn_ds_read_tr16_b64_v4i16((LAS s16x4_t*)tp); \
              const s16x4_t hi = __builtin_amdgcn_ds_read_tr16_b64_v4i16((LAS s16x4_t*)(tp + 4 * 272)); \
              ka[ks] = (bf16x8_t){lo[0], lo[1], lo[2], lo[3], hi[0], hi[1], hi[2], hi[3]}; } \
          const float gl = VC[192]; \
          _Pragma("unroll") for (int ct = 0; ct < SC_NC; ++ct) { f32x4 acc3 = {0.f, 0.f, 0.f, 0.f}; \
              _Pragma("unroll") for (int ks = 0; ks < 2; ++ks) acc3 = MFMA16(ka[ks], *(const LAS bf16x8_t*)(lds + SC_VST + (16 * ct + m16) * 144 + (32 * ks + 8 * g) * 2), acc3); \
              _Pragma("unroll") for (int rg = 0; rg < 4; ++rg) Sreg[ct][rg] = gl * Sreg[ct][rg] + acc3[rg]; \
              v2u w; w.x = pk2(Sreg[ct][0], Sreg[ct][1]); w.y = pk2(Sreg[ct][2], Sreg[ct][3]); *(LAS v2u*)(lds + SC_ST + (16 * ct + m16) * 272 + (16 * wv + 4 * g) * 2) = w; } } \
        if (has_out && wv >= 4) { const LAS unsigned char* ap = B + SC_AT + (16 * t4 + m16) * 144 + 16 * g; \
            const bf16x8_t a0_ = *(const LAS bf16x8_t*)ap, a1_ = *(const LAS bf16x8_t*)(ap + 64); \
            _Pragma("unroll") for (int ct = 0; ct < SC_NC; ++ct) { \
                acc1[ct] = MFMA16(a0_, *(const LAS bf16x8_t*)(lds + SC_VNT + (16 * ct + m16) * 144 + (8 * g) * 2), acc1[ct]); \
                acc1[ct] = MFMA16(a1_, *(const LAS bf16x8_t*)(lds + SC_VNT + (16 * ct + m16) * 144 + (32 + 8 * g) * 2), acc1[ct]); \
                oprev[ct] = acc1[ct]; } } \
        SC_WAIT(PFW, 7); SC_WRITE(PFW, cur ^ 1); \
        SC_BAR(); } while (0)
    const int s_beg = 64 * j, s_end = s_beg + 64;
    SC_LOAD(pfA, s_beg);
    f32x4 Sreg[SC_NC], oprev[SC_NC];
#pragma unroll
    for (int ct = 0; ct < SC_NC; ++ct) { Sreg[ct] = (f32x4){0.f, 0.f, 0.f, 0.f}; oprev[ct] = (f32x4){0.f, 0.f, 0.f, 0.f}; }
    if (PASS == 1) {
        if (v_zero) {
#pragma unroll
            for (int ct = 0; ct < SC_NC; ++ct)
#pragma unroll
                for (int rg = 0; rg < 4; ++rg) Sreg[ct][rg] = (16 * wv + 4 * g + rg == 32 * cs + 16 * ct + m16) ? 1.f : 0.f;
        }
    } else {
        LAS float* blk0 = (LAS float*)(lds + SC_ST); LAS float* blk1 = blk0 + 128 * 33;
        blk0 = (LAS float*)(lds + SC_BUF); blk1 = blk0 + 128 * 33;
        const int a = tid >> 2, cq = tid & 3;
        float accv[8];
        { const float* bp = scs_B(SCS, p, 0) + (size_t)a * 128 + 32 * cs + 8 * cq; const f32x4 x0 = *(const f32x4*)bp, x1 = *(const f32x4*)(bp + 4);
          accv[0] = x0.x; accv[1] = x0.y; accv[2] = x0.z; accv[3] = x0.w; accv[4] = x1.x; accv[5] = x1.y; accv[6] = x1.z; accv[7] = x1.w; }
#pragma unroll 1
        for (int jj = 1; jj < j; ++jj) {
            LAS float* src = (jj & 1) ? blk0 : blk1;
#pragma unroll
            for (int e = 0; e < 8; ++e) src[a * 33 + 8 * cq + e] = accv[e];
            __syncthreads();
            { const float* bp = scs_B(SCS, p, jj) + (size_t)a * 128 + 32 * cs + 8 * cq; const f32x4 x0 = *(const f32x4*)bp, x1 = *(const f32x4*)(bp + 4);
              accv[0] = x0.x; accv[1] = x0.y; accv[2] = x0.z; accv[3] = x0.w; accv[4] = x1.x; accv[5] = x1.y; accv[6] = x1.z; accv[7] = x1.w; }
            const float* ar = scs_A(SCS, p, jj) + (size_t)a * 128;
#pragma unroll 4
            for (int b4 = 0; b4 < 128; b4 += 4) { const f32x4 av = *(const f32x4*)(ar + b4);
#pragma unroll
                for (int e = 0; e < 8; ++e) accv[e] += av.x * src[(b4 + 0) * 33 + 8 * cq + e] + av.y * src[(b4 + 1) * 33 + 8 * cq + e] + av.z * src[(b4 + 2) * 33 + 8 * cq + e] + av.w * src[(b4 + 3) * 33 + 8 * cq + e]; }
        }
        LAS float* fin = (j & 1) ? blk0 : blk1;
        __syncthreads();
#pragma unroll
        for (int e = 0; e < 8; ++e) fin[a * 33 + 8 * cq + e] = accv[e];
        __syncthreads();
#pragma unroll
        for (int ct = 0; ct < SC_NC; ++ct)
#pragma unroll
            for (int rg = 0; rg < 4; ++rg) Sreg[ct][rg] = fin[(16 * wv + 4 * g + rg) * 33 + 16 * ct + m16];
        __syncthreads();
    }
#pragma unroll
    for (int ct = 0; ct < SC_NC; ++ct) { v2u w; w.x = pk2(Sreg[ct][0], Sreg[ct][1]); w.y = pk2(Sreg[ct][2], Sreg[ct][3]); *(LAS v2u*)(lds + SC_ST + (16 * ct + m16) * 272 + (16 * wv + 4 * g) * 2) = w; }
    SC_WAIT(pfA, 0); SC_WRITE(pfA, s_beg & 1);
    SC_LOAD(pfB, s_beg + 1);
    __syncthreads();
#pragma unroll 1
    for (int s2 = s_beg; s2 < s_end; s2 += 2) {
        SC_STEP(s2, pfB, pfA);
        SC_STEP(s2 + 1, pfA, pfB);
    }
    asm volatile("s_waitcnt vmcnt(0)" : "+v"(pfA[0]), "+v"(pfA[1]), "+v"(pfA[2]), "+v"(pfA[3]), "+v"(pfA[4]), "+v"(pfA[5]), "+v"(pfA[6]),
                                        "+v"(pfB[0]), "+v"(pfB[1]), "+v"(pfB[2]), "+v"(pfB[3]), "+v"(pfB[4]), "+v"(pfB[5]), "+v"(pfB[6]) :: "memory");
    SC_OSTORE(s_end - 1);
    if (PASS == 1) {
        float* dst = (v_zero ? scs_A(SCS, p, j) : scs_B(SCS, p, j));
        if (j < 3) {
#pragma unroll
            for (int ct = 0; ct < SC_NC; ++ct)
#pragma unroll
                for (int rg = 0; rg < 4; ++rg) dst[(size_t)(16 * wv + 4 * g + rg) * 128 + 32 * cs + 16 * ct + m16] = Sreg[ct][rg];
        }
    }
    asm volatile("s_waitcnt vmcnt(0)" ::: "memory");
#undef SC_STEP
#undef SC_OSTORE
#undef SC_WAIT
#undef SC_WAIT4
#undef SC_BAR
#undef SC_LOAD
#undef SC_WRITE
}
constexpr int AT_PITCH = 144, AT_K = 0, AT_V = 192 * AT_PITCH, AT_GRP = 2 * 192 * AT_PITCH;
__device__ __forceinline__ void ph_attn(const bf16* PA, const float* rope, bf16* OG, float* LSE, LAS unsigned char* lds, int wv) {
    int tid_ = wv * 64 + lane_id_(); asm volatile("" : "+v"(tid_));
    const int tid = tid_, lane = tid & 63, g = lane >> 4, m16 = lane & 15, grp = wv >> 2, wq = wv & 3, tg = tid & 255;
    LAS unsigned char* Kl = lds + grp * AT_GRP + AT_K; LAS unsigned char* Vl = lds + grp * AT_GRP + AT_V;
#pragma unroll 1
    for (int pi = BID; pi < 1536; pi += GSZ) {
        const int u = 2 * pi + grp;
        const int hg = u & 3, w = (u >> 2) & 255, gi = u >> 10;
        const int dil = 1 << (2 * gi), L = S_ / dil, r = w & (dil - 1), nb = w >> (2 * gi), head = gi * 4 + hg;
#pragma unroll
        for (int k = 0; k < 3; ++k) {
            const int item = tg + 256 * k, row = item >> 2, c = item & 3, mm = nb * 64 - 64 + row;
            v4u o0 = {0u, 0u, 0u, 0u}, o1 = {0u, 0u, 0u, 0u};
            if (mm >= 0 && mm < L) {
                const int tok = mm * dil + r;
                const bf16* kp = PA + (size_t)tok * 2304 + 768 + head * 64 + 8 * c;
                const v4u x0 = *(const v4u*)kp, x1 = *(const v4u*)(kp + 32);
                const f32x4* cp = (const f32x4*)(rope + (size_t)tok * 32 + 8 * c); const f32x4* sp = (const f32x4*)(rope + (size_t)S_ * 32 + (size_t)tok * 32 + 8 * c);
                const f32x4 c0 = cp[0], c1 = cp[1], s0 = sp[0], s1 = sp[1];
                const float cs[8] = {c0.x, c0.y, c0.z, c0.w, c1.x, c1.y, c1.z, c1.w}, sn[8] = {s0.x, s0.y, s0.z, s0.w, s1.x, s1.y, s1.z, s1.w};
                const unsigned xa[4] = {x0.x, x0.y, x0.z, x0.w}, xb[4] = {x1.x, x1.y, x1.z, x1.w};
                unsigned ra[4], rb[4];
#pragma unroll
                for (int e = 0; e < 4; ++e) {
                    const float a0 = bflo(xa[e]), a1 = bfhi(xa[e]), b0 = bflo(xb[e]), b1 = bfhi(xb[e]);
                    ra[e] = pk2(a0 * cs[2 * e] - b0 * sn[2 * e], a1 * cs[2 * e + 1] - b1 * sn[2 * e + 1]);
                    rb[e] = pk2(b0 * cs[2 * e] + a0 * sn[2 * e], b1 * cs[2 * e + 1] + a1 * sn[2 * e + 1]);
                }
                o0.x = ra[0]; o0.y = ra[1]; o0.z = ra[2]; o0.w = ra[3]; o1.x = rb[0]; o1.y = rb[1]; o1.z = rb[2]; o1.w = rb[3];
            }
            *(LAS v4u*)(Kl + row * AT_PITCH + 16 * c) = o0; *(LAS v4u*)(Kl + row * AT_PITCH + 64 + 16 * c) = o1;
        }
#pragma unroll
        for (int k = 0; k < 6; ++k) {
            const int item = tg + 256 * k, row = item >> 3, c = item & 7, mm = nb * 64 - 64 + row;
            v4u o = {0u, 0u, 0u, 0u};
            if (mm >= 0 && mm < L) o = *(const v4u*)(PA + (size_t)(mm * dil + r) * 2304 + 1536 + head * 64 + 8 * c);
            *(LAS v4u*)(Vl + row * AT_PITCH + 16 * c) = o;
        }
        bf16x8_t bq0, bq1;
        const int qi = 16 * wq + m16, qtok = (nb * 64 + qi) * dil + r;
        {
            const bf16* qp = PA + (size_t)qtok * 2304 + head * 64 + 8 * g;
            const v4u x0 = *(const v4u*)qp, x1 = *(const v4u*)(qp + 32);
            const f32x4* cp = (const f32x4*)(rope + (size_t)qtok * 32 + 8 * g); const f32x4* sp = (const f32x4*)(rope + (size_t)S_ * 32 + (size_t)qtok * 32 + 8 * g);
            const f32x4 c0 = cp[0], c1 = cp[1], s0 = sp[0], s1 = sp[1];
            const float cs[8] = {c0.x, c0.y, c0.z, c0.w, c1.x, c1.y, c1.z, c1.w}, sn[8] = {s0.x, s0.y, s0.z, s0.w, s1.x, s1.y, s1.z, s1.w};
            const unsigned xa[4] = {x0.x, x0.y, x0.z, x0.w}, xb[4] = {x1.x, x1.y, x1.z, x1.w};
            v4u ra, rb; unsigned* rap = (unsigned*)&ra; unsigned* rbp = (unsigned*)&rb; (void)rap; (void)rbp;
            unsigned ta[4], tb[4];
#pragma unroll
            for (int e = 0; e < 4; ++e) {
                const float a0 = bflo(xa[e]), a1 = bfhi(xa[e]), b0 = bflo(xb[e]), b1 = bfhi(xb[e]);
                ta[e] = pk2(0.125f * (a0 * cs[2 * e] - b0 * sn[2 * e]), 0.125f * (a1 * cs[2 * e + 1] - b1 * sn[2 * e + 1]));
                tb[e] = pk2(0.125f * (b0 * cs[2 * e] + a0 * sn[2 * e]), 0.125f * (b1 * cs[2 * e + 1] + a1 * sn[2 * e + 1]));
            }
            ra.x = ta[0]; ra.y = ta[1]; ra.z = ta[2]; ra.w = ta[3]; rb.x = tb[0]; rb.y = tb[1]; rb.z = tb[2]; rb.w = tb[3];
            bq0 = __builtin_bit_cast(bf16x8_t, ra); bq1 = __builtin_bit_cast(bf16x8_t, rb);
        }
        __syncthreads();
        f32x4 st[12];
#pragma unroll
        for (int kt = 0; kt < 12; ++kt) {
            const LAS unsigned char* ap = Kl + (16 * kt + m16) * AT_PITCH + 16 * g;
            f32x4 z = {0.f, 0.f, 0.f, 0.f};
            z = MFMA16(*(const LAS bf16x8_t*)ap, bq0, z);
            st[kt] = MFMA16(*(const LAS bf16x8_t*)(ap + 64), bq1, z);
        }
        float mx = -1e30f;
#pragma unroll
        for (int kt = 0; kt < 12; ++kt)
#pragma unroll
            for (int rg = 0; rg < 4; ++rg) { const int j = 16 * kt + 4 * g + rg, dj = j - qi, mm = nb * 64 - 64 + j;
                const bool ok = (dj >= 0) && (dj <= 128) && (mm >= 0) && (mm < L);
                st[kt][rg] = ok ? st[kt][rg] : -1e30f; mx = fmaxf(mx, st[kt][rg]); }
        mx = fmaxf(mx, __shfl_xor(mx, 16)); mx = fmaxf(mx, __shfl_xor(mx, 32));
        float sum = 0.f;
#pragma unroll
        for (int kt = 0; kt < 12; ++kt)
#pragma unroll
            for (int rg = 0; rg < 4; ++rg) { const float p = __expf(st[kt][rg] - mx); st[kt][rg] = p; sum += p; }
        sum += __shfl_xor(sum, 16); sum += __shfl_xor(sum, 32);
        f32x4 o[4];
#pragma unroll
        for (int dt = 0; dt < 4; ++dt) o[dt] = (f32x4){0.f, 0.f, 0.f, 0.f};
#pragma unroll
        for (int kk = 0; kk < 6; ++kk) {
            v4u pb; pb.x = pk2(st[2 * kk][0], st[2 * kk][1]); pb.y = pk2(st[2 * kk][2], st[2 * kk][3]); pb.z = pk2(st[2 * kk + 1][0], st[2 * kk + 1][1]); pb.w = pk2(st[2 * kk + 1][2], st[2 * kk + 1][3]);
            const bf16x8_t b = __builtin_bit_cast(bf16x8_t, pb);
#pragma unroll
            for (int dt = 0; dt < 4; ++dt) {
                const LAS unsigned char* tp = Vl + (32 * kk + 4 * g + (m16 >> 2)) * AT_PITCH + (16 * dt + 4 * (m16 & 3)) * 2;
                const s16x4_t lo = __builtin_amdgcn_ds_read_tr16_b64_v4i16((LAS s16x4_t*)tp);
                const s16x4_t hi = __builtin_amdgcn_ds_read_tr16_b64_v4i16((LAS s16x4_t*)(tp + 16 * AT_PITCH));
                const bf16x8_t a = {lo[0], lo[1], lo[2], lo[3], hi[0], hi[1], hi[2], hi[3]};
                o[dt] = MFMA16(a, b, o[dt]);
            }
        }
        const float il = 1.0f / sum;
        bf16* op = OG + ((size_t)gi * S_ + qtok) * 256 + hg * 64 + 4 * g;
#pragma unroll
        for (int dt = 0; dt < 4; ++dt) { v2u wv2; wv2.x = pk2(o[dt][0] * il, o[dt][1] * il); wv2.y = pk2(o[dt][2] * il, o[dt][3] * il); *(v2u*)(op + 16 * dt) = wv2; }
        if (g == 0) LSE[((size_t)gi * S_ + qtok) * 4 + hg] = mx + logf(sum);
        __syncthreads();
    }
}
constexpr int LDS_RING = 146432, LDS_CTL_OFF = LDS_RING, LDS_BYTES = 147456;
constexpr int CW_BAR = 4096;
#ifndef PROBE_ID
#define PROBE_ID (-1)
#endif
__device__ __forceinline__ unsigned char* wsp() { return PWS; }
template <class Epi> __device__ __forceinline__ void run_gemm(LAS unsigned char* lds, const bf16* A, const bf16* Bt, int N, int K, const Epi& E, int wv) {
    pg8::Gemm g{A, Bt, S_, N, K, 0};
    pg8::StaticOrder S; S.init(S_, N, GSZ, BID);
    pg8::gemm_phase<Epi, pg8::StaticOrder, true, true>(lds, g, S, E, wv);
}
#define GRID_BAR() do { XcdBarrier b_; b_.bar = (unsigned*)(wsp() + WS_CTL) + CW_BAR; b_.st = (volatile LAS unsigned*)(lds + LDS_CTL_OFF + 320) + 8; b_.x = b_.st[2]; xcd_barrier(b_, wv); } while (0)
#define PHASE(id, ...) do { { __VA_ARGS__ } if (PROBE_ID == (id)) { GRID_BAR(); { __VA_ARGS__ } } } while (0)
#define WS_R_PTRS unsigned char* ws = wsp(); unsigned char* R = ws + WS_R; (void)R;

template <int l, int f> __device__ __forceinline__ void ffn_block(LAS unsigned char* lds, unsigned char* lds_raw, int wv) {
    constexpr int s = f * 2;
    PHASE(1, WS_R_PTRS
        pg8::EpiSwiglu E; E.O = (bf16*)(R + R_ACT); E.ldc = FF_; E.pad_ = 0; run_gemm(lds, (const bf16*)(ws + WS_H), (const bf16*)(ws + WS_W + (f ? W_FFIN1 : W_FFIN0)), 2 * FF_, 1024, E, wv); );
    GRID_BAR();
    PHASE(2, WS_R_PTRS
        pg8::EpiBf16P E; E.O = (bf16*)(R + R_Y); E.ldc = 1024; E.pad_ = 0; run_gemm(lds, (const bf16*)(R + R_ACT), (const bf16*)(ws + WS_W + (f ? W_FFOUT1 : W_FFOUT0)), 1024, FF_, E, wv); );
    GRID_BAR();
    {   WS_R_PTRS const float* MOD = (const float*)(ws + WS_MOD); const float* mod = MOD + l * 9216;
        RowArgs a; a.xi = (l == 0 && f == 0) ? PIN(0) : POUT; a.y = (const bf16*)(R + R_Y); a.xo = POUT; a.wpost = PIN(6) + (l * 3 + s) * 1024; a.gate = mod + (s * 3 + 2) * 1024; a.coef = 0.5f;
        if (f == 0) { a.h = (bf16*)(ws + WS_H); a.wpre = PIN(5) + (l * 3 + 1) * 1024; a.shift = mod + (1 * 3 + 0) * 1024; a.scale = mod + (1 * 3 + 1) * 1024; }
        else if (l == 0) { a.h = (bf16*)(ws + WS_H); a.wpre = PIN(5) + (1 * 3 + 0) * 1024; a.shift = MOD + 9216; a.scale = MOD + 9216 + 1024; }
        else { a.h = nullptr; a.wpre = nullptr; a.shift = nullptr; a.scale = nullptr; }
        ph_rows(a, wv);
        if (f == 1 && l == 0) ph_convert(1, lds_raw, wv); }
    GRID_BAR();
}
template <int l> __device__ __forceinline__ void mixer_block(LAS unsigned char* lds, unsigned char* lds_raw, int wv) {
    PHASE(3, WS_R_PTRS
        pg8::EpiInProj E; E.PA = (bf16*)(R + R_PA); E.PD = (bf16*)(R + R_PD); E.PZ = (bf16*)(R + R_PZ); E.AB = (float*)(R + R_AB);
        run_gemm(lds, (const bf16*)(ws + WS_H), (const bf16*)(ws + WS_W + W_IN), 5632, 1024, E, wv); );
    GRID_BAR();
    PHASE(4, WS_R_PTRS
        ph_attn((const bf16*)(R + R_PA), (const float*)(ws + WS_ROPE), (bf16*)(R + R_OG), (float*)(R + R_LSE), lds, wv); );
    GRID_BAR();
    PHASE(5, WS_R_PTRS
        ph_dnprep((const bf16*)(R + R_PD), (const float*)(R + R_AB), PIN(10) + (size_t)l * 5 * 2304, PIN(11) + l * 12, PIN(12) + l * 12, (bf16*)(R + R_QKVD), (float*)(R + R_GB),
                  (const bf16*)(R + R_OG), (const float*)(R + R_LSE), (bf16*)(R + R_OATT), wv); );
    GRID_BAR();
    PHASE(6, WS_R_PTRS
        ph_dn_pre((const bf16*)(R + R_QKVD), (const float*)(R + R_GB), (bf16*)(R + R_TINV), (bf16*)(R + R_ATTN), (float*)(R + R_VEC), lds_raw, wv); );
    GRID_BAR();
    PHASE(7, WS_R_PTRS
        ph_dn_scan<1>((const bf16*)(R + R_QKVD), (const bf16*)(R + R_TINV), (const bf16*)(R + R_ATTN), (const float*)(R + R_VEC), (bf16*)(R + R_ODIR0), (bf16*)(R + R_ODIR1), (float*)(ws + WS_W + W_FFIN0), lds, wv); );
    GRID_BAR();
    PHASE(13, WS_R_PTRS
        ph_dn_scan<2>((const bf16*)(R + R_QKVD), (const bf16*)(R + R_TINV), (const bf16*)(R + R_ATTN), (const float*)(R + R_VEC), (bf16*)(R + R_ODIR0), (bf16*)(R + R_ODIR1), (float*)(ws + WS_W + W_FFIN0), lds, wv); );
    GRID_BAR();
    PHASE(8, WS_R_PTRS
        pg8::EpiBf16P E; E.O = (bf16*)(R + R_PG); E.ldc = 2048; E.pad_ = 0;
        run_gemm(lds, (const bf16*)(ws + WS_H), (const bf16*)(ws + WS_W + W_IN) + (size_t)5632 * 1024, 2048, 1024, E, wv); );
    PHASE(9, WS_R_PTRS
        ph_final((const bf16*)(R + R_ODIR0), (const bf16*)(R + R_ODIR1), (const bf16*)(R + R_PZ), PIN(13) + l * 128, (bf16*)(R + R_ODN), wv); );
    GRID_BAR();
    PHASE(10, { WS_R_PTRS
        pg8::EpiGateF32 E; E.O = (float*)(R + R_T1); E.gate = (const bf16*)(R + R_PG); E.ldg = 2048; E.pad_ = 0;
        run_gemm(lds, (const bf16*)(R + R_OATT), (const bf16*)(ws + WS_W + W_BATT), 1024, 256, E, wv); }
        { WS_R_PTRS
        pg8::EpiGateAddBf16 E; E.O = (bf16*)(ws + WS_H); E.T1 = (const float*)(R + R_T1); E.gate = (const bf16*)(R + R_PG) + 1024; E.ldg = 2048; E.pad_ = 0;
        run_gemm(lds, (const bf16*)(R + R_ODN), (const bf16*)(ws + WS_W + W_BDN), 1024, 768, E, wv); } );
    GRID_BAR();
    PHASE(11, WS_R_PTRS
        pg8::EpiBf16P E; E.O = (bf16*)(R + R_Y2); E.ldc = 1024; E.pad_ = 0; run_gemm(lds, (const bf16*)(ws + WS_H), (const bf16*)(ws + WS_W + W_OUT), 1024, 1024, E, wv); );
    GRID_BAR();
    {   WS_R_PTRS const float* mod = (const float*)(ws + WS_MOD) + l * 9216;
        RowArgs a; a.xi = POUT; a.y = (const bf16*)(R + R_Y2); a.xo = POUT; a.h = (bf16*)(ws + WS_H); a.wpost = PIN(6) + (l * 3 + 1) * 1024; a.gate = mod + (1 * 3 + 2) * 1024; a.coef = 1.0f;
        a.wpre = PIN(5) + (l * 3 + 2) * 1024; a.shift = mod + (2 * 3 + 0) * 1024; a.scale = mod + (2 * 3 + 1) * 1024; ph_rows(a, wv); }
    GRID_BAR();
}
__global__ void __launch_bounds__(NTHREADS, 2) mega_fwd(Params P) {
    extern __shared__ __attribute__((aligned(16))) unsigned char lds_raw[];
    LAS unsigned char* lds = (LAS unsigned char*)lds_raw;
    const int wv = __builtin_amdgcn_readfirstlane((int)threadIdx.x >> 6);
    { const int tid0 = threadIdx.x;
      for (int u = tid0; u < (LDS_BYTES - LDS_CTL_OFF) / 4; u += NTHREADS) ((LAS unsigned*)(lds + LDS_CTL_OFF))[u] = 0u;
      __syncthreads();
      XcdBarrier b0 = xcd_barrier_post((unsigned*)(PWS + WS_CTL) + CW_BAR, (volatile LAS unsigned*)(lds + LDS_CTL_OFF + 320) + 8);
      if (tid0 == 0) ((volatile LAS unsigned*)(lds + LDS_CTL_OFF + 320))[10] = b0.x;
      __syncthreads(); }
    PHASE(0, ph_ada(lds_raw, wv); ph_rope(wv); ph_convert(0, lds_raw, wv); );
    GRID_BAR();
    PHASE(12, WS_R_PTRS float* MOD = (float*)(ws + WS_MOD);
      RowArgs a; a.xi = PIN(0); a.y = nullptr; a.xo = nullptr; a.h = (bf16*)(ws + WS_H); a.wpost = nullptr; a.gate = nullptr; a.wpre = PIN(5); a.shift = MOD; a.scale = MOD + 1024; a.coef = 0.f; ph_rows(a, wv); );
    GRID_BAR();
    ffn_block<0, 0>(lds, lds_raw, wv); mixer_block<0>(lds, lds_raw, wv); ffn_block<0, 1>(lds, lds_raw, wv);
    ffn_block<1, 0>(lds, lds_raw, wv); mixer_block<1>(lds, lds_raw, wv); ffn_block<1, 1>(lds, lds_raw, wv);
}

extern "C" void kernel_launch(void* const* d_in, const int* in_sizes, int n_in, void* d_out, int out_size, void* d_ws, size_t ws_size, hipStream_t stream) {
    static int grid = 0;
    if (grid == 0) {
        if (n_in != 17 || ws_size < WS_END) { fprintf(stderr, "kernel_launch: unexpected n_in %d / ws_size %zu\n", n_in, ws_size); grid = -1; return; }
        int dev = 0, cus = 0, per_cu = 0;
        if (hipGetDevice(&dev) != hipSuccess || hipDeviceGetAttribute(&cus, hipDeviceAttributeMultiprocessorCount, dev) != hipSuccess) { grid = -1; return; }
        if (hipFuncSetAttribute((const void*)mega_fwd, hipFuncAttributeMaxDynamicSharedMemorySize, LDS_BYTES) != hipSuccess) { fprintf(stderr, "kernel_launch: hipFuncSetAttribute failed\n"); grid = -1; return; }
        if (hipOccupancyMaxActiveBlocksPerMultiprocessor(&per_cu, (const void*)mega_fwd, NTHREADS, LDS_BYTES) != hipSuccess || per_cu < 1) { fprintf(stderr, "kernel_launch: occupancy query says %d\n", per_cu); per_cu = 1; }
        (void)hipGetLastError();
        grid = cus;
        if (grid > 256) grid = 256;
    }
    if (grid < 0) return;
    (void)hipMemsetAsync((char*)d_ws + WS_CTL, 0, 1 * MiB, stream);
    Params p{};
    for (int i = 0; i < 17; ++i) p.in[i] = (const float*)d_in[i];
    p.out = (float*)d_out; p.ws = (unsigned char*)d_ws;
    hipLaunchKernelGGL(mega_fwd, dim3(grid), dim3(NTHREADS), LDS_BYTES, stream, p);
}
```

```cpp
#include <hip/hip_runtime.h>
#include <cstdio>
#include <cstdint>
__device__ __forceinline__ int lane_id_() { int l; asm volatile("v_mbcnt_lo_u32_b32 %0, -1, 0\n\tv_mbcnt_hi_u32_b32 %0, -1, %0" : "=v"(l)); return l; }
namespace pg8 {
#define PG8_LAS __attribute__((address_space(3)))
typedef unsigned short bf16_t;
typedef short bf16x8 __attribute__((ext_vector_type(8)));
typedef float f32x4 __attribute__((ext_vector_type(4)));
typedef unsigned u32x4 __attribute__((ext_vector_type(4)));
constexpr int BM = 256, BK = 64, HALF = 128, HTB = HALF * BK * 2  , STAGE_BYTES = 8 * HTB, NXCD = 8, WGM = 8;

__host__ __device__ __forceinline__ int lds_byte(int r, int c) { const int st = (r >> 4) * 2 + (c >> 5), rr = r & 15, cc = c & 31, ob = rr * 64 + cc * 2; return st * 1024 + (ob ^ (((ob >> 9) & 1) << 5)); }
__host__ __device__ __forceinline__ void stage_rc(int b, int& R, int& C) { const int st = b / 1024, sb = b % 1024, swz = sb ^ (((sb >> 9) & 1) << 5); R = (st >> 1) * 16 + swz / 64; C = (st & 1) * 32 + (swz % 64) / 2; }
__host__ __device__ __forceinline__ int perm32(int rho) { const int n = rho >> 4, i = rho & 15; return 8 * (i >> 2) + 4 * n + (i & 3); }

struct Unit { int pm, pn; };
struct Gemm { const bf16_t* A; const bf16_t* Bt; int M, N, K, pad_; };

struct StaticOrder {
    int nM, nN, nwg, G, c;
    __host__ __device__ void init(int M, int N, int G_, int c_) { nM = M / BM; nN = N / BM; nwg = nM * nN; G = G_; c = c_; }
    __host__ __device__ bool next(int i, Unit& u) const {
        const long L = (long)i * G + c; if (L >= nwg) return false;
        int wgid = (int)L; { const int q = nwg / NXCD, r = nwg % NXCD, xcd = wgid % NXCD, off = wgid / NXCD; wgid = (xcd < r ? xcd * (q + 1) : r * (q + 1) + (xcd - r) * q) + off; }
        const int nig = WGM * nN, gid = wgid / nig, fm = gid * WGM, gsz = (nM - fm) < WGM ? (nM - fm) : WGM;
        u.pm = fm + ((wgid % nig) % gsz); u.pn = (wgid % nig) / gsz; return true;
    }
    __device__ __forceinline__ void a_ready(const Unit&) const {}
    __device__ __forceinline__ void done(const Unit&) const {}
};

__device__ __forceinline__ unsigned cvt_pk_bf16(float lo, float hi) { unsigned r; asm volatile("v_cvt_pk_bf16_f32 %0, %1, %2" : "=v"(r) : "v"(lo), "v"(hi)); return r; }
typedef float f32x2 __attribute__((ext_vector_type(2)));
__device__ __forceinline__ f32x2 gelu_pk(f32x2 v) {
    const f32x2 av = __builtin_elementwise_abs(v), d = av * 0.2316418882f + 1.0f;
    f32x2 t; t.x = __builtin_amdgcn_rcpf(d.x); t.y = __builtin_amdgcn_rcpf(d.y);
    f32x2 q = t * 0.5307027145f + (-0.7265760135f); q = q * t + 0.7107068705f; q = q * t + (-0.142248368f); q = q * t + 0.127414796f; q = q * t;
    const f32x2 s = (v * v) * (-0.72134752044f);
    f32x2 e; e.x = __builtin_amdgcn_exp2f(s.x); e.y = __builtin_amdgcn_exp2f(s.y);
    const f32x2 m = v * (q * e), r = v - m;
    f32x2 o; o.x = v.x < 0.f ? m.x : r.x; o.y = v.y < 0.f ? m.y : r.y; return o;
}

template <int ACT  > struct EpiBf16 {
    static constexpr bool PERM = true, AFTER_DRAIN = false; static_assert(ACT == 0 || ACT == 1, "EpiBf16: ACT is 0 (none) or 1 (gelu_pk)");
    bf16_t* O; int ldc; const float* bias; int split_cols; size_t split_stride; float scale0;
    __device__ __forceinline__ void operator()(const f32x4 (&acc)[2][2][4][2], const Unit& u, int wr, int wc, int fr, int fq) const {
        const int row0 = u.pm * BM + wr * 64 + fr; int colt = u.pn * BM; bf16_t* base = O;
        float sc = 1.f; if (split_cols) { const int t = colt / split_cols; base += (size_t)t * split_stride; colt -= t * split_cols; if (t == 0) sc = scale0; }
        const int col0 = colt + wc * 32 + 8 * fq, bcol0 = u.pn * BM + wc * 32 + 8 * fq;
        f32x4 bv[2][2];
#pragma unroll
        for (int bj = 0; bj < 2; ++bj)
#pragma unroll
            for (int n = 0; n < 2; ++n) bv[bj][n] = bias ? *(const f32x4*)(bias + bcol0 + bj * HALF + 4 * n) : (f32x4){0.f, 0.f, 0.f, 0.f};
#pragma unroll
        for (int ai = 0; ai < 2; ++ai)
#pragma unroll
            for (int m = 0; m < 4; ++m) { bf16_t* rowp = base + (size_t)(row0 + ai * HALF + m * 16) * ldc + col0;
#pragma unroll
                for (int bj = 0; bj < 2; ++bj) { f32x4 v0 = acc[ai][bj][m][0] + bv[bj][0], v1 = acc[ai][bj][m][1] + bv[bj][1];
                    if (ACT == 1) { f32x2 a = gelu_pk((f32x2){v0[0], v0[1]}), b = gelu_pk((f32x2){v0[2], v0[3]}), c = gelu_pk((f32x2){v1[0], v1[1]}), d = gelu_pk((f32x2){v1[2], v1[3]});
                        v0 = (f32x4){a.x, a.y, b.x, b.y}; v1 = (f32x4){c.x, c.y, d.x, d.y}; }
                    v0 = v0 * sc; v1 = v1 * sc; u32x4 w; w.x = cvt_pk_bf16(v0[0], v0[1]); w.y = cvt_pk_bf16(v0[2], v0[3]); w.z = cvt_pk_bf16(v1[0], v1[1]); w.w = cvt_pk_bf16(v1[2], v1[3]);
                    *(u32x4*)(rowp + bj * HALF) = w; } }
    }
};

struct PanelStats {
    unsigned* xbuf;
    unsigned* cnt;
    unsigned* tmo;
    int ntn; float eps;
    unsigned code;
    __device__ __forceinline__ bool run(const f32x4 (&v)[2][2][4][2], const Unit& u, int wr, int wc, int fr, int fq, PG8_LAS unsigned char* lds, int wid, int lane) const {
        typedef float f32x2v __attribute__((ext_vector_type(2)));
        PG8_LAS f32x2v* P = (PG8_LAS f32x2v*)lds;
        PG8_LAS f32x2v* S = (PG8_LAS f32x2v*)(lds + 8192);
        PG8_LAS unsigned* flag = (PG8_LAS unsigned*)(lds + 8192 + 2048);
#pragma unroll
        for (int ai = 0; ai < 2; ++ai)
#pragma unroll
            for (int m = 0; m < 4; ++m) {
                float s = 0.f;
#pragma unroll
                for (int bj = 0; bj < 2; ++bj)
#pragma unroll
                    for (int n = 0; n < 2; ++n) { const f32x4 x = v[ai][bj][m][n]; s += (x[0] + x[1]) + (x[2] + x[3]); }
                s += __shfl_xor(s, 16); s += __shfl_xor(s, 32);
                const float mw = s * (1.0f / 64.0f); float q = 0.f;
#pragma unroll
                for (int bj = 0; bj < 2; ++bj)
#pragma unroll
                    for (int n = 0; n < 2; ++n) { const f32x4 d = v[ai][bj][m][n] - mw; q += (d[0] * d[0] + d[1] * d[1]) + (d[2] * d[2] + d[3] * d[3]); }
                q += __shfl_xor(q, 16); q += __shfl_xor(q, 32);
                if (fq == 0) P[(ai * HALF + wr * 64 + m * 16 + fr) * 4 + wc] = (f32x2v){mw, q};
            }
        asm volatile("s_waitcnt lgkmcnt(0)" ::: "memory"); __builtin_amdgcn_s_barrier(); asm volatile("" ::: "memory");
#if defined(BROKEN_EXCHANGE_NO_WAIT)
#warning BROKEN CONTROL BUILD: the row-statistics exchange does not wait; results are wrong by design
        if (blockIdx.x >= 64) { const long long t0_ = clock64(); while (clock64() - t0_ < 60000) __builtin_amdgcn_s_sleep(8); }
#endif
        const int row = wid * 32 + (lane & 31);
        if (lane < 32) {
            const f32x2v a = P[row * 4 + 0], b = P[row * 4 + 1], c = P[row * 4 + 2], d = P[row * 4 + 3];
            const float mt = (a.x + b.x + c.x + d.x) * 0.25f;
            const float da = a.x - mt, db = b.x - mt, dc = c.x - mt, dd = d.x - mt;
            const float m2 = (a.y + b.y) + (c.y + d.y) + 64.0f * ((da * da + db * db) + (dc * dc + dd * dd));
            unsigned long long* slot = (unsigned long long*)xbuf + ((size_t)(u.pm * BM + row) * 4 + u.pn);
            __hip_atomic_store(slot, ((unsigned long long)__float_as_uint(m2) << 32) | __float_as_uint(mt), __ATOMIC_RELAXED, __HIP_MEMORY_SCOPE_AGENT);
        }
        asm volatile("s_waitcnt vmcnt(0)" ::: "memory");
        if (lane == 0) __hip_atomic_fetch_add(cnt + 64 * u.pm, 1u, __ATOMIC_RELAXED, __HIP_MEMORY_SCOPE_AGENT);
        if (wid == 0) {
            bool dead = false; const unsigned long long t0 = __builtin_amdgcn_s_memrealtime(); const unsigned want = 8u * (unsigned)ntn;
            for (;;) {
#if defined(BROKEN_EXCHANGE_NO_WAIT)
                break;
#endif
                if ((unsigned)__builtin_amdgcn_readfirstlane(__hip_atomic_load(cnt + 64 * u.pm, __ATOMIC_RELAXED, __HIP_MEMORY_SCOPE_AGENT)) >= want) break;
                if (__builtin_amdgcn_s_memrealtime() - t0 > 2000000ull) {
                    if (lane == 0) { unsigned expect = 0u; __hip_atomic_compare_exchange_strong(tmo + 1, &expect, code | (unsigned)(u.pm & 0xff), __ATOMIC_RELAXED, __ATOMIC_RELAXED, __HIP_MEMORY_SCOPE_AGENT);
                                     __hip_atomic_store(tmo, 1u, __ATOMIC_RELAXED, __HIP_MEMORY_SCOPE_AGENT); }
                    dead = true; break; }
                __builtin_amdgcn_s_sleep(2);
            }
            __builtin_amdgcn_fence(__ATOMIC_ACQUIRE, "agent");
            if (lane == 0) flag[0] = dead ? 1u : 0u;
        }
        asm volatile("s_waitcnt vmcnt(0) lgkmcnt(0)" ::: "memory"); __builtin_amdgcn_s_barrier(); asm volatile("" ::: "memory");
        const bool bad = flag[0] != 0u;
        if (lane < 32) {
            const unsigned long long* slot = (const unsigned long long*)xbuf + (size_t)(u.pm * BM + row) * 4; float mt[4], m2[4]; float ms = 0.f;
#pragma unroll
            for (int t = 0; t < 4; ++t) { if (t < ntn) { const unsigned long long w = __hip_atomic_load(slot + t, __ATOMIC_RELAXED, __HIP_MEMORY_SCOPE_AGENT); mt[t] = __uint_as_float((unsigned)w); m2[t] = __uint_as_float((unsigned)(w >> 32)); } else { mt[t] = 0.f; m2[t] = 0.f; } ms += mt[t]; }
            const float mean = ms / (float)ntn; float q = 0.f;
#pragma unroll
            for (int t = 0; t < 4; ++t) if (t < ntn) { const float dm = mt[t] - mean; q += m2[t] + 256.0f * dm * dm; }
            S[row] = (f32x2v){mean, 1.0f / sqrtf(q / (256.0f * (float)ntn) + eps)};
        }
        asm volatile("s_waitcnt lgkmcnt(0)" ::: "memory"); __builtin_amdgcn_s_barrier(); asm volatile("" ::: "memory");
        return bad;
    }
};
struct EpiLnRes {
    static constexpr bool PERM = false, AFTER_DRAIN = true;
    const float* base; float* out; int ldc; const float* bias; PanelStats st; unsigned poison;
    __device__ __forceinline__ void fused(f32x4 (&acc)[2][2][4][2], const Unit& u, int wr, int wc, int fr, int fq, PG8_LAS unsigned char* lds, int wid, int lane) const {
        typedef float f32x2v __attribute__((ext_vector_type(2)));
        const PG8_LAS f32x2v* S = (const PG8_LAS f32x2v*)(lds + 8192);
        const int col0 = u.pn * BM + wc * 32 + 4 * fq;
#pragma unroll
        for (int bj = 0; bj < 2; ++bj)
#pragma unroll
            for (int n = 0; n < 2; ++n) { const f32x4 bv = bias ? *(const f32x4*)(bias + col0 + bj * HALF + n * 16) : (f32x4){0.f, 0.f, 0.f, 0.f};
#pragma unroll
                for (int ai = 0; ai < 2; ++ai)
#pragma unroll
                    for (int m = 0; m < 4; ++m) acc[ai][bj][m][n] += bv; }
        f32x4 pre[4][2][2];
#pragma unroll
        for (int m = 0; m < 4; ++m) { const size_t off = (size_t)(u.pm * BM + wr * 64 + m * 16 + fr) * ldc + col0;
#pragma unroll
            for (int bj = 0; bj < 2; ++bj)
#pragma unroll
                for (int n = 0; n < 2; ++n) pre[m][bj][n] = *(const f32x4*)(base + off + bj * HALF + n * 16); }
        const bool bad = st.run(acc, u, wr, wc, fr, fq, lds, wid, lane) || poison != 0u;
        const float qnan = __builtin_nanf("");
#pragma unroll
        for (int ai = 0; ai < 2; ++ai)
#pragma unroll
            for (int m = 0; m < 4; ++m) { const int r = ai * HALF + wr * 64 + m * 16 + fr; const f32x2v sr = S[r]; const size_t off = (size_t)(u.pm * BM + r) * ldc + col0;
#pragma unroll
                for (int bj = 0; bj < 2; ++bj)
#pragma unroll
                    for (int n = 0; n < 2; ++n) { const f32x4 bs = ai == 0 ? pre[m][bj][n] : *(const f32x4*)(base + off + bj * HALF + n * 16); f32x4 o = bs + (acc[ai][bj][m][n] - sr.x) * sr.y;
                        if (bad) o = (f32x4){qnan, qnan, qnan, qnan}; *(f32x4*)(out + off + bj * HALF + n * 16) = o; }
                if (m & 1) asm volatile("" ::: "memory"); }
    }
};
struct EpiLnResLn {
    static constexpr bool PERM = false, AFTER_DRAIN = true;
    const float* base; float* out; bf16_t* xn; int ldc; const float* bias; PanelStats st1, st2; unsigned poison;
    __device__ __forceinline__ void fused(f32x4 (&acc)[2][2][4][2], const Unit& u, int wr, int wc, int fr, int fq, PG8_LAS unsigned char* lds, int wid, int lane) const {
        typedef float f32x2v __attribute__((ext_vector_type(2))); typedef unsigned u32x2v __attribute__((ext_vector_type(2)));
        const PG8_LAS f32x2v* S = (const PG8_LAS f32x2v*)(lds + 8192);
        const int col0 = u.pn * BM + wc * 32 + 4 * fq;
#pragma unroll
        for (int bj = 0; bj < 2; ++bj)
#pragma unroll
            for (int n = 0; n < 2; ++n) { const f32x4 bv = bias ? *(const f32x4*)(bias + col0 + bj * HALF + n * 16) : (f32x4){0.f, 0.f, 0.f, 0.f};
#pragma unroll
                for (int ai = 0; ai < 2; ++ai)
#pragma unroll
                    for (int m = 0; m < 4; ++m) acc[ai][bj][m][n] += bv; }
        bool bad = st1.run(acc, u, wr, wc, fr, fq, lds, wid, lane) || poison != 0u;
        const float qnan = __builtin_nanf("");
#pragma unroll
        for (int ai = 0; ai < 2; ++ai)
#pragma unroll
            for (int m = 0; m < 4; ++m) { const int r = ai * HALF + wr * 64 + m * 16 + fr; const f32x2v sr = S[r]; const size_t off = (size_t)(u.pm * BM + r) * ldc + col0;
#pragma unroll
                for (int bj = 0; bj < 2; ++bj)
#pragma unroll
                    for (int n = 0; n < 2; ++n) { const f32x4 bs = *(const f32x4*)(base + off + bj * HALF + n * 16); acc[ai][bj][m][n] = bs + (acc[ai][bj][m][n] - sr.x) * sr.y; }
                asm volatile("" : "+v"(acc[ai][0][m][0]), "+v"(acc[ai][0][m][1]), "+v"(acc[ai][1][m][0]), "+v"(acc[ai][1][m][1]));
                if (m & 1) asm volatile("" ::: "memory"); }
        const bool bad1 = bad;
        bad = st2.run(acc, u, wr, wc, fr, fq, lds, wid, lane) || bad;
#pragma unroll
        for (int ai = 0; ai < 2; ++ai)
#pragma unroll
            for (int m = 0; m < 4; ++m) { const int r = ai * HALF + wr * 64 + m * 16 + fr; const f32x2v sr = S[r]; const size_t off = (size_t)(u.pm * BM + r) * ldc + col0;
#pragma unroll
                for (int bj = 0; bj < 2; ++bj)
#pragma unroll
                    for (int n = 0; n < 2; ++n) { const f32x4 x1 = acc[ai][bj][m][n]; *(f32x4*)(out + off + bj * HALF + n * 16) = bad1 ? (f32x4){qnan, qnan, qnan, qnan} : x1;
                        const f32x4 o = (x1 - sr.x) * sr.y; u32x2v w; w.x = cvt_pk_bf16(o[0], o[1]); w.y = cvt_pk_bf16(o[2], o[3]);
                        if (bad) { w.x = 0x7fc07fc0u; w.y = 0x7fc07fc0u; } *(u32x2v*)(xn + off + bj * HALF + n * 16) = w; }
                asm volatile("" ::: "memory"); }
    }
};

template <class Epi, class Sched, bool ALIGN_EPI = false, bool SP2 = false>
__device__ __forceinline__ void gemm_phase(PG8_LAS unsigned char* lds, const Gemm g, const Sched& S, const Epi& E, int wv) {
    int tid_ = wv * 64 + lane_id_(); asm volatile("" : "+v"(tid_));
    const int tid = tid_, wid = __builtin_amdgcn_readfirstlane(tid >> 6), lane = tid & 63, wr = wid >> 2, wc = wid & 3, fr = lane & 15, fq = lane >> 4;
    const int K = g.K, nt = K / BK;
    unsigned voffA[2], voffB[2];
#pragma unroll
    for (int i = 0; i < 2; ++i) { int R, C; stage_rc(tid * 16 + i * 8192, R, C); const int Rb = Epi::PERM ? ((R & ~31) + perm32(R & 31)) : R;
        voffA[i] = (unsigned)(R * K + C) * 2u; voffB[i] = (unsigned)(Rb * K + C) * 2u; }
    const size_t kstep = (size_t)(BK * 2);
    const size_t hstep = (size_t)HALF * K * 2;
    const size_t tstep = 2 * hstep;
    const unsigned ldsw = (unsigned)wid * 1024u;
    const int aoff = lds_byte(wr * 64 + fr, fq * 8), boff = lds_byte(wc * 32 + fr, fq * 8);
#define PG8_SA(b, h) (((b) * 2 + (h)) * HTB)
#define PG8_SB(b, h) ((4 + (b) * 2 + (h)) * HTB)
#define PG8_STAGE(bufoff, gbase, voff) do { _Pragma("unroll") for (int _i = 0; _i < 2; ++_i) \
        __builtin_amdgcn_global_load_lds((const unsigned*)((const char*)(gbase) + (voff)[_i]), (PG8_LAS unsigned*)(lds + (bufoff) + ldsw + _i * 8192), 16, 0, 0); } while (0)
#define PG8_LDA(dst, b, h) do { _Pragma("unroll") for (int m = 0; m < 4; ++m) _Pragma("unroll") for (int k = 0; k < 2; ++k) dst[m][k] = *(const PG8_LAS bf16x8*)(lds + PG8_SA(b, h) + aoff + m * 2048 + k * 1024); } while (0)
#define PG8_LDB(dst, b, h) do { _Pragma("unroll") for (int n = 0; n < 2; ++n) _Pragma("unroll") for (int k = 0; k < 2; ++k) dst[n][k] = *(const PG8_LAS bf16x8*)(lds + PG8_SB(b, h) + boff + n * 2048 + k * 1024); } while (0)
#define PG8_MMA(ai, bj, At, Bt) do { __builtin_amdgcn_s_setprio(1); _Pragma("unroll") for (int m = 0; m < 4; ++m) _Pragma("unroll") for (int n = 0; n < 2; ++n) _Pragma("unroll") for (int k = 0; k < 2; ++k) \
        acc[ai][bj][m][n] = __builtin_amdgcn_mfma_f32_16x16x32_bf16(Bt[n][k], At[m][k], acc[ai][bj][m][n], 0, 0, 0); __builtin_amdgcn_s_setprio(0); } while (0)
#define PG8_WAIT_V(n) asm volatile("s_waitcnt vmcnt(" #n ")" ::: "memory")
#define PG8_WAIT_L(n) asm volatile("s_waitcnt lgkmcnt(" #n ")" ::: "memory")
#define PG8_BAR __builtin_amdgcn_s_barrier()
#define PG8_SCHED __builtin_amdgcn_sched_barrier(0)
    Unit cur, nxt; int ui = 0;
    if (!S.next(0, cur)) return;
    f32x4 acc[2][2][4][2];
#pragma unroll
    for (int a = 0; a < 2; ++a)
#pragma unroll
        for (int b = 0; b < 2; ++b)
#pragma unroll
            for (int m = 0; m < 4; ++m)
#pragma unroll
                for (int n = 0; n < 2; ++n) acc[a][b][m][n] = (f32x4){0.f, 0.f, 0.f, 0.f};
    bf16x8 At[4][2], B0[2][2], B1[2][2];
    const char* cA = (const char*)g.A + (size_t)cur.pm * tstep; const char* cB = (const char*)g.Bt + (size_t)cur.pn * tstep;
    S.a_ready(cur);
    if constexpr (SP2) {
        PG8_STAGE(PG8_SB(0, 0), cB, voffB); PG8_STAGE(PG8_SB(0, 1), cB + hstep, voffB); PG8_STAGE(PG8_SA(0, 0), cA, voffA); PG8_STAGE(PG8_SA(0, 1), cA + hstep, voffA);
        if (wr == 1) PG8_BAR;
        PG8_WAIT_V(2); PG8_BAR;
        PG8_STAGE(PG8_SB(1, 0), cB + kstep, voffB); PG8_STAGE(PG8_SA(1, 0), cA + kstep, voffA); PG8_STAGE(PG8_SB(1, 1), cB + hstep + kstep, voffB);
        PG8_WAIT_V(6); PG8_BAR;
    } else {
        PG8_STAGE(PG8_SB(0, 0), cB, voffB); PG8_STAGE(PG8_SA(0, 0), cA, voffA); PG8_STAGE(PG8_SB(0, 1), cB + hstep, voffB); PG8_STAGE(PG8_SA(0, 1), cA + hstep, voffA);
        if (wr == 1) PG8_BAR;
        PG8_WAIT_V(4); PG8_BAR;
        PG8_STAGE(PG8_SB(1, 0), cB + kstep, voffB); PG8_STAGE(PG8_SA(1, 0), cA + kstep, voffA); PG8_STAGE(PG8_SB(1, 1), cB + hstep + kstep, voffB);
        PG8_WAIT_V(6); PG8_BAR;
    }
    for (;;) {
        const bool has_next = S.next(ui + 1, nxt);
        const char* nA = has_next ? (const char*)g.A + (size_t)nxt.pm * tstep : cA; const char* nB = has_next ? (const char*)g.Bt + (size_t)nxt.pn * tstep : cB;
        for (int t = 0; t < nt; t += 2) {
            const bool last = (t == nt - 2);
            const char* a1 = cA + (size_t)(t + 1) * kstep;
            const char* a2 = last ? nA : cA + (size_t)(t + 2) * kstep; const char* b2 = last ? nB : cB + (size_t)(t + 2) * kstep;
            const char* a3 = a2 + kstep; const char* b3 = b2 + kstep;
            if (last && has_next) S.a_ready(nxt);
            if constexpr (SP2) {
            PG8_LDB(B0, 0, 0); PG8_LDB(B1, 0, 1); PG8_SCHED; PG8_LDA(At, 0, 0); PG8_STAGE(PG8_SA(1, 1), a1 + hstep, voffA);
            PG8_WAIT_V(8); PG8_WAIT_L(0); PG8_BAR; PG8_MMA(0, 0, At, B0); PG8_MMA(0, 1, At, B1); PG8_BAR; PG8_SCHED;
            PG8_LDA(At, 0, 1); PG8_STAGE(PG8_SB(0, 0), b2, voffB); PG8_STAGE(PG8_SB(0, 1), b2 + hstep, voffB); PG8_STAGE(PG8_SA(0, 0), a2, voffA);
            PG8_WAIT_V(8); PG8_WAIT_L(0); PG8_BAR; PG8_MMA(1, 0, At, B0); PG8_MMA(1, 1, At, B1); PG8_BAR; PG8_SCHED;
            PG8_LDB(B0, 1, 0); PG8_LDB(B1, 1, 1); PG8_SCHED; PG8_LDA(At, 1, 0); PG8_STAGE(PG8_SA(0, 1), a2 + hstep, voffA);
            PG8_WAIT_V(8); PG8_WAIT_L(0); PG8_BAR; PG8_MMA(0, 0, At, B0); PG8_MMA(0, 1, At, B1); PG8_BAR; PG8_SCHED;
            PG8_LDA(At, 1, 1); PG8_STAGE(PG8_SB(1, 0), b3, voffB); PG8_STAGE(PG8_SB(1, 1), b3 + hstep, voffB); PG8_STAGE(PG8_SA(1, 0), a3, voffA);
            PG8_WAIT_V(8); PG8_WAIT_L(0); PG8_BAR; PG8_MMA(1, 0, At, B0); PG8_MMA(1, 1, At, B1); PG8_BAR; PG8_SCHED;
            } else {
            PG8_LDB(B0, 0, 0); PG8_SCHED; PG8_LDA(At, 0, 0); PG8_STAGE(PG8_SA(1, 1), a1 + hstep, voffA);
            PG8_WAIT_L(8); PG8_BAR; PG8_WAIT_L(0); PG8_MMA(0, 0, At, B0); PG8_BAR; PG8_SCHED;
            PG8_LDB(B1, 0, 1); PG8_STAGE(PG8_SB(0, 0), b2, voffB);
            PG8_BAR; PG8_WAIT_L(0); PG8_MMA(0, 1, At, B1); PG8_BAR;
            PG8_LDA(At, 0, 1); PG8_STAGE(PG8_SA(0, 0), a2, voffA);
            PG8_BAR; PG8_WAIT_L(0); PG8_MMA(1, 0, At, B0); PG8_BAR; PG8_SCHED;
            PG8_STAGE(PG8_SB(0, 1), b2 + hstep, voffB);
            PG8_WAIT_V(6); PG8_BAR; PG8_MMA(1, 1, At, B1); PG8_BAR;
            PG8_LDB(B0, 1, 0); PG8_SCHED; PG8_LDA(At, 1, 0); PG8_STAGE(PG8_SA(0, 1), a2 + hstep, voffA);
            PG8_WAIT_L(8); PG8_BAR; PG8_WAIT_L(0); PG8_MMA(0, 0, At, B0); PG8_BAR; PG8_SCHED;
            PG8_LDB(B1, 1, 1); PG8_STAGE(PG8_SB(1, 0), b3, voffB);
            PG8_BAR; PG8_WAIT_L(0); PG8_MMA(0, 1, At, B1); PG8_BAR;
            PG8_LDA(At, 1, 1); PG8_STAGE(PG8_SA(1, 0), a3, voffA);
            PG8_BAR; PG8_WAIT_L(0); PG8_MMA(1, 0, At, B0); PG8_BAR; PG8_SCHED;
            PG8_STAGE(PG8_SB(1, 1), b3 + hstep, voffB);
            PG8_WAIT_V(6); PG8_BAR; PG8_MMA(1, 1, At, B1); PG8_BAR;
            }
        }
        if constexpr (ALIGN_EPI) { if (wr == 0) PG8_BAR; }
        if constexpr (!Epi::AFTER_DRAIN) { E(acc, cur, wr, wc, fr, fq); S.done(cur); }
        if (!has_next) break;
#pragma unroll
        for (int a = 0; a < 2; ++a)
#pragma unroll
            for (int b = 0; b < 2; ++b)
#pragma unroll
                for (int m = 0; m < 4; ++m)
#pragma unroll
                    for (int n = 0; n < 2; ++n) acc[a][b][m][n] = (f32x4){0.f, 0.f, 0.f, 0.f};
        cur = nxt; cA = nA; cB = nB; ++ui;
        if constexpr (ALIGN_EPI) { if (wr == 1) PG8_BAR; }
    }
    PG8_WAIT_V(0);
    if constexpr (!ALIGN_EPI) { if (wr == 0) PG8_BAR; }
    PG8_BAR;
    if constexpr (Epi::AFTER_DRAIN) { E.fused(acc, cur, wr, wc, fr, fq, lds, wid, lane); S.done(cur); }
#undef PG8_SA
#undef PG8_SB
#undef PG8_STAGE
#undef PG8_LDA
#undef PG8_LDB
#undef PG8_MMA
#undef PG8_WAIT_V
#undef PG8_WAIT_L
#undef PG8_BAR
#undef PG8_SCHED
}
}
constexpr int S_ = 16384, D_ = 1024, FF_ = 2816, NIN_ = 7448, NINP_ = 7680;
constexpr int NTHREADS = 512;
constexpr size_t MiB = 1u << 20;
constexpr size_t WS_CTL = 0;
constexpr size_t WS_MOD = 1 * MiB;
constexpr size_t WS_ROPE = 2 * MiB;
constexpr size_t WS_W = 6 * MiB;
constexpr size_t W_FFIN0 = 0, W_FFIN1 = 11 * MiB, W_FFOUT0 = 22 * MiB, W_FFOUT1 = 27 * MiB + MiB / 2, W_IN = 33 * MiB, W_BATT = 48 * MiB, W_BDN = 48 * MiB + MiB / 2, W_OUT = 50 * MiB;
constexpr size_t WS_H = 58 * MiB;
constexpr size_t WS_R = 90 * MiB;
constexpr size_t R_ACT = 0, R_Y = 88 * MiB;
constexpr size_t R_PA = 0, R_QKVD = 0, R_PG = 0, R_PD = 72 * MiB, R_TINV = 72 * MiB, R_ODIR1 = 120 * MiB, R_ODN = 72 * MiB, R_T1 = 96 * MiB, R_PZ = 144 * MiB, R_AB = 168 * MiB, R_GB = 170 * MiB,
                 R_OATT = 172 * MiB, R_ATTN = 180 * MiB, R_Y2 = 160 * MiB, R_OG = 228 * MiB, R_LSE = 252 * MiB, R_ODIR0 = 228 * MiB, R_VEC = 253 * MiB;
constexpr size_t WS_END = 352 * MiB;

typedef unsigned short bf16;
typedef unsigned v4u __attribute__((ext_vector_type(4)));
typedef unsigned v2u __attribute__((ext_vector_type(2)));
typedef float f32x4 __attribute__((ext_vector_type(4)));
typedef float f32x2 __attribute__((ext_vector_type(2)));
#define LAS __attribute__((address_space(3)))

__device__ __forceinline__ unsigned f2bf(float f) { unsigned u = __builtin_bit_cast(unsigned, f); return (u + 0x7fffu + ((u >> 16) & 1u)) >> 16; }
__device__ __forceinline__ unsigned pk2(float lo, float hi) { return f2bf(lo) | (f2bf(hi) << 16); }
__device__ __forceinline__ float bf2f(unsigned short b) { return __builtin_bit_cast(float, (unsigned)b << 16); }
__device__ __forceinline__ float bflo(unsigned w) { return __builtin_bit_cast(float, w << 16); }
__device__ __forceinline__ float bfhi(unsigned w) { return __builtin_bit_cast(float, w & 0xffff0000u); }
__device__ __forceinline__ float wave_sum(float v) {
#pragma unroll
    for (int o = 1; o < 64; o <<= 1) v += __shfl_xor(v, o);
    return v;
}
__device__ __forceinline__ float sigmoidf_(float x) { return 1.0f / (1.0f + __expf(-x)); }
__device__ __forceinline__ float siluf_(float x) { return x / (1.0f + __expf(-x)); }

namespace pg8 {
struct EpiSwiglu {
    static constexpr bool PERM = true, AFTER_DRAIN = false;
    bf16_t* O; int ldc; int pad_;
    __device__ __forceinline__ void operator()(const f32x4 (&acc)[2][2][4][2], const Unit& u, int wr, int wc, int fr, int fq) const {
        const int row0 = u.pm * BM + wr * 64 + fr, col0 = u.pn * 128 + wc * 32 + 8 * fq;
#pragma unroll
        for (int ai = 0; ai < 2; ++ai)
#pragma unroll
            for (int m = 0; m < 4; ++m) {
                bf16_t* rowp = O + (size_t)(row0 + ai * HALF + m * 16) * ldc + col0;
                float v[8];
#pragma unroll
                for (int n = 0; n < 2; ++n)
#pragma unroll
                    for (int e = 0; e < 4; ++e) { const float g = acc[ai][0][m][n][e], uu = acc[ai][1][m][n][e]; v[n * 4 + e] = g * __builtin_amdgcn_rcpf(1.0f + __expf(-g)) * uu; }
                u32x4 w; w.x = cvt_pk_bf16(v[0], v[1]); w.y = cvt_pk_bf16(v[2], v[3]); w.z = cvt_pk_bf16(v[4], v[5]); w.w = cvt_pk_bf16(v[6], v[7]);
                *(u32x4*)rowp = w;
            }
    }
};
struct EpiBf16P {
    static constexpr bool PERM = true, AFTER_DRAIN = false;
    bf16_t* O; int ldc; int pad_;
    __device__ __forceinline__ void operator()(const f32x4 (&acc)[2][2][4][2], const Unit& u, int wr, int wc, int fr, int fq) const {
        const int row0 = u.pm * BM + wr * 64 + fr, col0 = u.pn * BM + wc * 32 + 8 * fq;
#pragma unroll
        for (int ai = 0; ai < 2; ++ai)
#pragma unroll
            for (int m = 0; m < 4; ++m) {
                bf16_t* rowp = O + (size_t)(row0 + ai * HALF + m * 16) * ldc + col0;
#pragma unroll
                for (int bj = 0; bj < 2; ++bj) { const f32x4 v0 = acc[ai][bj][m][0], v1 = acc[ai][bj][m][1];
                    u32x4 w; w.x = cvt_pk_bf16(v0[0], v0[1]); w.y = cvt_pk_bf16(v0[2], v0[3]); w.z = cvt_pk_bf16(v1[0], v1[1]); w.w = cvt_pk_bf16(v1[2], v1[3]);
                    *(u32x4*)(rowp + bj * HALF) = w; }
            }
    }
};
struct EpiF32 {
    static constexpr bool PERM = false, AFTER_DRAIN = false;
    float* O; int ldc; int pad_;
    __device__ __forceinline__ void operator()(const f32x4 (&acc)[2][2][4][2], const Unit& u, int wr, int wc, int fr, int fq) const {
        const int row0 = u.pm * BM + wr * 64 + fr, col0 = u.pn * BM + wc * 32 + 4 * fq;
#pragma unroll
        for (int ai = 0; ai < 2; ++ai)
#pragma unroll
            for (int m = 0; m < 4; ++m) {
                float* rowp = O + (size_t)(row0 + ai * HALF + m * 16) * ldc + col0;
#pragma unroll
                for (int bj = 0; bj < 2; ++bj)
#pragma unroll
                    for (int n = 0; n < 2; ++n) *(f32x4*)(rowp + bj * HALF + n * 16) = acc[ai][bj][m][n];
            }
    }
};
struct EpiInProj {
    static constexpr bool PERM = true, AFTER_DRAIN = false;
    bf16_t* PA; bf16_t* PD; bf16_t* PZ; float* AB;
    __device__ __forceinline__ void operator()(const f32x4 (&acc)[2][2][4][2], const Unit& u, int wr, int wc, int fr, int fq) const {
        const int row0 = u.pm * BM + wr * 64 + fr;
        if (u.pn == 21) {
            if (wc == 0) {
#pragma unroll
                for (int ai = 0; ai < 2; ++ai)
#pragma unroll
                    for (int m = 0; m < 4; ++m) {
                        float* rowp = AB + (size_t)(row0 + ai * HALF + m * 16) * 32 + 8 * fq;
                        *(f32x4*)rowp = acc[ai][0][m][0]; *(f32x4*)(rowp + 4) = acc[ai][0][m][1];
                    }
            }
            return;
        }
        bf16_t* base; int ldc, ct;
        if (u.pn < 9) { base = PA; ldc = 2304; ct = u.pn; } else if (u.pn < 18) { base = PD; ldc = 2304; ct = u.pn - 9; } else { base = PZ; ldc = 768; ct = u.pn - 18; }
        const int col0 = ct * BM + wc * 32 + 8 * fq;
#pragma unroll
        for (int ai = 0; ai < 2; ++ai)
#pragma unroll
            for (int m = 0; m < 4; ++m) {
                bf16_t* rowp = base + (size_t)(row0 + ai * HALF + m * 16) * ldc + col0;
#pragma unroll
                for (int bj = 0; bj < 2; ++bj) { const f32x4 v0 = acc[ai][bj][m][0], v1 = acc[ai][bj][m][1];
                    u32x4 w; w.x = cvt_pk_bf16(v0[0], v0[1]); w.y = cvt_pk_bf16(v0[2], v0[3]); w.z = cvt_pk_bf16(v1[0], v1[1]); w.w = cvt_pk_bf16(v1[2], v1[3]);
                    *(u32x4*)(rowp + bj * HALF) = w; }
            }
    }
};
struct EpiGateF32 {
    static constexpr bool PERM = false, AFTER_DRAIN = false;
    float* O; const bf16_t* gate; int ldg; int pad_;
    __device__ __forceinline__ void operator()(const f32x4 (&acc)[2][2][4][2], const Unit& u, int wr, int wc, int fr, int fq) const {
        const int row0 = u.pm * BM + wr * 64 + fr, col0 = u.pn * BM + wc * 32 + 4 * fq;
#pragma unroll
        for (int ai = 0; ai < 2; ++ai)
#pragma unroll
            for (int m = 0; m < 4; ++m) {
                const size_t r = (size_t)(row0 + ai * HALF + m * 16);
#pragma unroll
                for (int bj = 0; bj < 2; ++bj)
#pragma unroll
                    for (int n = 0; n < 2; ++n) { const int c = col0 + bj * HALF + n * 16;
                        const v2u gw = *(const v2u*)(gate + r * ldg + c);
                        f32x4 a = acc[ai][bj][m][n];
                        a[0] *= sigmoidf_(bflo(gw.x)); a[1] *= sigmoidf_(bfhi(gw.x)); a[2] *= sigmoidf_(bflo(gw.y)); a[3] *= sigmoidf_(bfhi(gw.y));
                        *(f32x4*)(O + r * 1024 + c) = a; }
            }
    }
};
struct EpiGateAddBf16 {
    static constexpr bool PERM = false, AFTER_DRAIN = false;
    bf16_t* O; const float* T1; const bf16_t* gate; int ldg; int pad_;
    __device__ __forceinline__ void operator()(const f32x4 (&acc)[2][2][4][2], const Unit& u, int wr, int wc, int fr, int fq) const {
        const int row0 = u.pm * BM + wr * 64 + fr, col0 = u.pn * BM + wc * 32 + 4 * fq;
#pragma unroll
        for (int ai = 0; ai < 2; ++ai)
#pragma unroll
            for (int m = 0; m < 4; ++m) {
                const size_t r = (size_t)(row0 + ai * HALF + m * 16);
#pragma unroll
                for (int bj = 0; bj < 2; ++bj)
#pragma unroll
                    for (int n = 0; n < 2; ++n) { const int c = col0 + bj * HALF + n * 16;
                        const v2u gw = *(const v2u*)(gate + r * ldg + c);
                        const f32x4 t = *(const f32x4*)(T1 + r * 1024 + c);
                        f32x4 a = acc[ai][bj][m][n];
                        a[0] = t[0] + a[0] * sigmoidf_(bflo(gw.x)); a[1] = t[1] + a[1] * sigmoidf_(bfhi(gw.x)); a[2] = t[2] + a[2] * sigmoidf_(bflo(gw.y)); a[3] = t[3] + a[3] * sigmoidf_(bfhi(gw.y));
                        v2u w; w.x = cvt_pk_bf16(a[0], a[1]); w.y = cvt_pk_bf16(a[2], a[3]);
                        *(v2u*)(O + r * 1024 + c) = w; }
            }
    }
};
}


#define GAS __attribute__((address_space(1)))
struct Params { const float* in[17]; float* out; unsigned char* ws; };
#define XB_TMO      128
#define XB_XCNT(j)  (256  + 64 * (j))
#define XB_XSUB(j)  (1280 + 64 * (j))
#define XB_XGEN(j)  (2304 + 64 * (j))
#define XB_TOP      3328
#define XB_TOPGEN   3392
#define XCD_BAR_WORDS 3456
#define XB_SPIN_CAP (1u << 18)

__device__ __forceinline__ unsigned xb_ld(unsigned* p)              { return __hip_atomic_load(p, __ATOMIC_RELAXED, __HIP_MEMORY_SCOPE_AGENT); }
__device__ __forceinline__ unsigned xb_add(unsigned* p, unsigned v) { return __hip_atomic_fetch_add(p, v, __ATOMIC_RELAXED, __HIP_MEMORY_SCOPE_AGENT); }
__device__ __forceinline__ unsigned xb_xcc_id() { return (unsigned)__builtin_amdgcn_s_getreg((3 << 11) | 20) & 0xFu; }
#define XB_SPIN(cond, bar) do { unsigned _sp = 0; while (cond) { __builtin_amdgcn_s_sleep(1); \
    if ((++_sp & 255u) == 0u) { if (xb_ld(&(bar)[XB_TMO])) break; if (_sp > XB_SPIN_CAP) { atomicAdd(&(bar)[XB_TMO], 1u); break; } } } } while (0)

struct XcdBarrier {
    unsigned* bar; unsigned x;
    volatile LAS unsigned* st;
};

__device__ __forceinline__ XcdBarrier xcd_barrier_post(unsigned* bar, volatile LAS unsigned* st) {
    XcdBarrier b; b.bar = bar; b.x = xb_xcc_id(); b.st = st;
    if (threadIdx.x == 0) (void)xb_add(&bar[XB_XCNT(b.x)], 1u);
    return b;
}
__device__ __forceinline__ void xcd_barrier_complete(unsigned* bar, unsigned x, unsigned& nloc, unsigned& nx) {
    const unsigned G = gridDim.x * gridDim.y * gridDim.z;
    unsigned sum, cnt, mine, sp = 0u;
    for (;;) {
        sum = 0u; cnt = 0u; mine = 0u;
#pragma unroll
        for (unsigned j = 0; j < 16; ++j) { const unsigned c = xb_ld(&bar[XB_XCNT(j)]); sum += c; cnt += (c > 0u) ? 1u : 0u; mine = (j == x) ? c : mine; }
        if (sum == G) break;
        __builtin_amdgcn_s_sleep(1);
        if ((++sp & 255u) == 0u) { if (xb_ld(&bar[XB_TMO])) break; if (sp > XB_SPIN_CAP) { atomicAdd(&bar[XB_TMO], 1u); break; } }
    }
    nloc = mine > 0u ? mine : 1u; nx = cnt > 0u ? cnt : 1u;
}

__device__ __forceinline__ void xcd_barrier(const XcdBarrier& b, int wv) {
    const bool leader_thread = (wv == 0) && (lane_id_() == 0);
    asm volatile("s_waitcnt vmcnt(0)" ::: "memory");
    __syncthreads();
    if (leader_thread) {
        unsigned* bar = b.bar;
        __builtin_amdgcn_s_waitcnt(0);
        unsigned nloc = b.st[0], nx = b.st[1];
        if (nloc == 0u) { xcd_barrier_complete(bar, b.x, nloc, nx); b.st[0] = nloc; b.st[1] = nx; }
        const unsigned old = xb_add(&bar[XB_XSUB(b.x)], 1u);
        const unsigned gen = old / nloc;
        if (old + 1u == (gen + 1u) * nloc) {
            __builtin_amdgcn_fence(__ATOMIC_RELEASE, "agent");
            asm volatile("s_waitcnt vmcnt(0)" ::: "memory");
            const unsigned og = xb_add(&bar[XB_TOP], 1u);
            const unsigned tg = og / nx;
            if (og + 1u == (tg + 1u) * nx) xb_add(&bar[XB_TOPGEN], 1u);
            else XB_SPIN(xb_ld(&bar[XB_TOPGEN]) == tg, bar);
            __builtin_amdgcn_fence(__ATOMIC_ACQUIRE, "agent");
            xb_add(&bar[XB_XGEN(b.x)], 1u);
            asm volatile("s_waitcnt vmcnt(0)" ::: "memory");
        } else {
            XB_SPIN(xb_ld(&bar[XB_XGEN(b.x)]) == gen, bar);
            __builtin_amdgcn_fence(__ATOMIC_ACQUIRE, "agent");
            asm volatile("s_waitcnt vmcnt(0)" ::: "memory");
        }
    }
    __syncthreads();
}

typedef const __attribute__((address_space(4))) unsigned char* ka_t;
__device__ __forceinline__ ka_t ka_() { ka_t k = (ka_t)__builtin_amdgcn_kernarg_segment_ptr(); asm volatile("" : "+s"(k)); return k; }
#define PIN(i) ((const float*)(const __attribute__((address_space(1))) float*)(*(const __attribute__((address_space(4))) unsigned long long*)(ka_() + 8 * (i))))
#define POUT ((float*)(__attribute__((address_space(1))) float*)(*(const __attribute__((address_space(4))) unsigned long long*)(ka_() + 136)))
#define PWS ((unsigned char*)(__attribute__((address_space(1))) unsigned char*)(*(const __attribute__((address_space(4))) unsigned long long*)(ka_() + 144)))
#define BID ((int)blockIdx.x)
#define GSZ ((int)gridDim.x)
__device__ __forceinline__ int srcmap(int mode, int n) {
    if (mode == 0) return n;
    if (mode == 1) return (n >> 8) * 128 + (n & 127) + ((n >> 7) & 1) * 2816;
    if (n < 5400) return n;
    if (n < 5632) return -1;
    if (n < 6656) return 5400 + (n - 5632);
    return 6424 + (n - 6656);
}
__device__ __forceinline__ void conv_item(const float* W, bf16* WT, int K, int Nsrc, int Ndst, int mode, int item, float* scr, int lane) {
    const int nblk = Ndst / 32, kb = item / nblk, nb = item % nblk, k0 = 64 * kb, n0 = 32 * nb;
    const int sc = srcmap(mode, n0 + (lane & 31));
#pragma unroll
    for (int i = 0; i < 32; ++i) { const int kk = 2 * i + (lane >> 5); scr[kk * 33 + (lane & 31)] = sc >= 0 ? W[(size_t)(k0 + kk) * Nsrc + sc] : 0.f; }
    __builtin_amdgcn_s_waitcnt(0xc07f); __builtin_amdgcn_wave_barrier();
    const int c = lane & 7;
#pragma unroll
    for (int j = 0; j < 4; ++j) { const int n = (lane >> 3) + 8 * j; const float* s = scr + (8 * c) * 33 + n;
        v4u o; o.x = pk2(s[0 * 33], s[1 * 33]); o.y = pk2(s[2 * 33], s[3 * 33]); o.z = pk2(s[4 * 33], s[5 * 33]); o.w = pk2(s[6 * 33], s[7 * 33]);
        *(v4u*)(WT + (size_t)(n0 + n) * K + k0 + 8 * c) = o; }
    __builtin_amdgcn_s_waitcnt(0xc07f); __builtin_amdgcn_wave_barrier();
}
__device__ __forceinline__ void ph_convert(int l, unsigned char* lds, int wv) {
    int tid_ = wv * 64 + lane_id_(); asm volatile("" : "+v"(tid_)); const int lane = tid_ & 63, wave = tid_ >> 6;
    float* scr = (float*)lds + wave * (64 * 33);
    unsigned char* wb = PWS + WS_W;
    constexpr int I_FI = 16 * 176, I_FO = 44 * 32, I_IN = 16 * 240, I_BA = 4 * 32, I_BD = 12 * 32, I_O = 16 * 32;
    constexpr int NIT = 2 * I_FI + 2 * I_FO + I_IN + I_BA + I_BD + I_O;
    for (int it = BID * 8 + wave; it < NIT; it += GSZ * 8) {
        int r = it;
        if (r < 2 * I_FI) { const int f = r / I_FI; conv_item(PIN(7) + ((size_t)l * 2 + f) * 1024 * 5632, (bf16*)(wb + (f ? W_FFIN1 : W_FFIN0)), 1024, 5632, 5632, 1, r % I_FI, scr, lane); continue; } r -= 2 * I_FI;
        if (r < 2 * I_FO) { const int f = r / I_FO; conv_item(PIN(8) + ((size_t)l * 2 + f) * 2816 * 1024, (bf16*)(wb + (f ? W_FFOUT1 : W_FFOUT0)), 2816, 1024, 1024, 0, r % I_FO, scr, lane); continue; } r -= 2 * I_FO;
        if (r < I_IN) { conv_item(PIN(9) + (size_t)l * 1024 * NIN_, (bf16*)(wb + W_IN), 1024, NIN_, NINP_, 2, r, scr, lane); continue; } r -= I_IN;
        if (r < I_BA) { conv_item(PIN(14) + (size_t)l * 256 * 1024, (bf16*)(wb + W_BATT), 256, 1024, 1024, 0, r, scr, lane); continue; } r -= I_BA;
        if (r < I_BD) { conv_item(PIN(15) + (size_t)l * 768 * 1024, (bf16*)(wb + W_BDN), 768, 1024, 1024, 0, r, scr, lane); continue; } r -= I_BD;
        conv_item(PIN(16) + (size_t)l * 1024 * 1024, (bf16*)(wb + W_OUT), 1024, 1024, 1024, 0, r, scr, lane);
    }
}
__device__ __forceinline__ void ph_ada(unsigned char* lds, int wv) {
    float* red = (float*)(lds + 72 * 1024);
    int tid_ = wv * 64 + lane_id_(); asm volatile("" : "+v"(tid_)); const int tid = tid_, lane = tid_ & 63, wave = tid_ >> 6;
    const float* c = PIN(1); const float* w_ada = PIN(3); const float* b_ada = PIN(4); float* mod = (float*)(PWS + WS_MOD);
    for (int u = BID; u < 72; u += GSZ) {
        const int l = u / 36, n0 = (u % 36) * 256;
        const float* W = w_ada + (size_t)l * 1024 * 9216 + (size_t)(wave * 128) * 9216 + n0 + 4 * lane;
        f32x4 acc = {0.f, 0.f, 0.f, 0.f};
#pragma unroll 1
        for (int k0 = 0; k0 < 128; k0 += 16) {
            f32x4 wv4[16];
#pragma unroll
            for (int kk = 0; kk < 16; ++kk) wv4[kk] = *(const f32x4*)(W + (size_t)(k0 + kk) * 9216);
#pragma unroll
            for (int kk = 0; kk < 16; ++kk) { const float cv = c[wave * 128 + k0 + kk]; const float sv = cv / (1.0f + __expf(-cv)); acc += sv * wv4[kk]; }
        }
        *(f32x4*)(red + wave * 256 + 4 * lane) = acc;
        __syncthreads();
        if (tid < 256) { float t = b_ada[l * 9216 + n0 + tid];
#pragma unroll
            for (int w = 0; w < 8; ++w) t += red[w * 256 + tid];
            mod[l * 9216 + n0 + tid] = t; }
        __syncthreads();
    }
}
__device__ const float ROPE_INV[32] = {1.000000000e+00f, 7.498942018e-01f, 5.623413324e-01f, 4.216965139e-01f, 3.162277639e-01f, 2.371373773e-01f, 1.778279394e-01f, 1.333521456e-01f, 1.000000015e-01f, 7.498942316e-02f, 5.623413250e-02f, 4.216964915e-02f, 3.162277490e-02f, 2.371373773e-02f, 1.778279431e-02f, 1.333521400e-02f, 9.999999776e-03f, 7.498942316e-03f, 5.623413250e-03f, 4.216964822e-03f, 3.162277630e-03f, 2.371373819e-03f, 1.778279431e-03f, 1.333521446e-03f, 1.000000047e-03f, 7.498941850e-04f, 5.623413017e-04f, 4.216965172e-04f, 3.162277571e-04f, 2.371373703e-04f, 1.778279402e-04f, 1.333521504e-04f};
__device__ __forceinline__ void ph_rope(int wv) {
    const int* pos = (const int*)PIN(2); float* tab = (float*)(PWS + WS_ROPE);
    int tid_ = wv * 64 + lane_id_(); asm volatile("" : "+v"(tid_));
    for (int idx = BID * NTHREADS + tid_; idx < S_ * 32; idx += GSZ * NTHREADS) {
        const int t = idx >> 5, i = idx & 31;
        const float inv = ROPE_INV[i];
        const float ang = (float)pos[t] * inv;
        float sn, cs; sincosf(ang, &sn, &cs);
        tab[idx] = cs; tab[S_ * 32 + idx] = sn;
    }
}
struct RowArgs { const float* xi; const bf16* y; float* xo; bf16* h; const float* wpost; const float* gate; const float* wpre; const float* shift; const float* scale; float coef; };
__device__ __forceinline__ void ph_rows(const RowArgs& a, int wv) {
    int tid_ = wv * 64 + lane_id_(); asm volatile("" : "+v"(tid_)); const int lane = tid_ & 63, wave = tid_ >> 6;
    for (int r = BID * 8 + wave; r < S_; r += GSZ * 8) {
        f32x4 x[4];
        const f32x4* xr = (const f32x4*)(a.xi + (size_t)r * D_) + lane;
#pragma unroll
        for (int j = 0; j < 4; ++j) x[j] = xr[64 * j];
        if (a.y) {
            f32x4 y[4]; float s = 0.f;
            const v2u* yr = (const v2u*)(a.y + (size_t)r * D_) + lane;
#pragma unroll
            for (int j = 0; j < 4; ++j) { const v2u yw = yr[64 * j]; y[j] = (f32x4){bflo(yw.x), bfhi(yw.x), bflo(yw.y), bfhi(yw.y)}; s += (y[j].x * y[j].x + y[j].y * y[j].y) + (y[j].z * y[j].z + y[j].w * y[j].w); }
            const float rs = 1.0f / sqrtf(wave_sum(s) * (1.f / D_) + 1e-6f);
#pragma unroll
            for (int j = 0; j < 4; ++j) { const f32x4 wp = ((const f32x4*)a.wpost)[lane + 64 * j], g = ((const f32x4*)a.gate)[lane + 64 * j];
                x[j] = x[j] + a.coef * g * ((y[j] * rs) * wp); }
            f32x4* xw = (f32x4*)(a.xo + (size_t)r * D_) + lane;
#pragma unroll
            for (int j = 0; j < 4; ++j) xw[64 * j] = x[j];
        }
        if (a.h) {
            float s = 0.f;
#pragma unroll
            for (int j = 0; j < 4; ++j) s += (x[j].x * x[j].x + x[j].y * x[j].y) + (x[j].z * x[j].z + x[j].w * x[j].w);
            const float rs = 1.0f / sqrtf(wave_sum(s) * (1.f / D_) + 1e-6f);
            v2u* hw = (v2u*)(a.h + (size_t)r * D_) + lane;
#pragma unroll
            for (int j = 0; j < 4; ++j) { const f32x4 wp = ((const f32x4*)a.wpre)[lane + 64 * j], sc = ((const f32x4*)a.scale)[lane + 64 * j], sh = ((const f32x4*)a.shift)[lane + 64 * j];
                const f32x4 v = ((x[j] * rs) * wp) * (1.0f + sc) + sh;
                v2u w; w.x = pk2(v.x, v.y); w.y = pk2(v.z, v.w); hw[64 * j] = w; }
        }
    }
}
constexpr int ATT_PITCH = 68;
__device__ __forceinline__ void ph_attn_v1(const bf16* PA, const float* rope, bf16* OG, float* LSE, unsigned char* lds, int wv) {
    float* qs = (float*)lds; float* ks = qs + 64 * ATT_PITCH; float* vs = ks + 192 * ATT_PITCH;
    int tid_ = wv * 64 + lane_id_(); asm volatile("" : "+v"(tid_)); const int tid = tid_, lane = tid & 63, wave = tid >> 6;
    for (int u = BID; u < 3072; u += GSZ) {
        const int hg = u & 3, w = (u >> 2) & 255, gi = u >> 10;
        const int dil = 1 << (2 * gi), L = S_ / dil, r = w % dil, nb = w / dil, head = gi * 4 + hg;
        __syncthreads();
        for (int rr = wave; rr < 448; rr += 8) {
            int mm, colbase; float* dst; bool rot; float sc = 1.f;
            if (rr < 64) { mm = nb * 64 + rr; colbase = head * 64; dst = qs + rr * ATT_PITCH; rot = true; sc = 0.125f; }
            else if (rr < 256) { mm = nb * 64 - 64 + (rr - 64); colbase = 768 + head * 64; dst = ks + (rr - 64) * ATT_PITCH; rot = true; }
            else { mm = nb * 64 - 64 + (rr - 256); colbase = 1536 + head * 64; dst = vs + (rr - 256) * ATT_PITCH; rot = false; }
            float val = 0.f;
            if (mm >= 0 && mm < L) {
                const int tok = mm * dil + r;
                val = bf2f(PA[(size_t)tok * 2304 + colbase + lane]);
                if (rot) {
                    const float other = __shfl_xor(val, 32);
                    const float cs = rope[tok * 32 + (lane & 31)], sn = rope[S_ * 32 + tok * 32 + (lane & 31)];
                    val = (lane < 32) ? (val * cs - other * sn) : (val * cs + other * sn);
                }
            }
            dst[lane] = val * sc;
        }
        __syncthreads();
        const int i = tid >> 3, part = tid & 7;
        float q[64], acc[64];
#pragma unroll
        for (int d = 0; d < 64; d += 4) { const f32x4 t = *(const f32x4*)(qs + i * ATT_PITCH + d); q[d] = t.x; q[d + 1] = t.y; q[d + 2] = t.z; q[d + 3] = t.w; }
#pragma unroll
        for (int d = 0; d < 64; ++d) acc[d] = 0.f;
        float m = -1e30f, l = 0.f;
        for (int jj = 0; jj < 24; ++jj) {
            const int j = part + 8 * jj, mm = nb * 64 - 64 + j, dj = j - 64 - i;
            const bool ok = (dj <= 64) && (dj >= -64) && (mm >= 0) && (mm < L);
            if (ok) {
                const float* kr = ks + j * ATT_PITCH; float s = 0.f;
#pragma unroll
                for (int d = 0; d < 64; d += 4) { const f32x4 t = *(const f32x4*)(kr + d); s += q[d] * t.x + q[d + 1] * t.y + q[d + 2] * t.z + q[d + 3] * t.w; }
                const float mn = fmaxf(m, s), al = __expf(m - mn), p = __expf(s - mn);
                l = l * al + p; m = mn;
                const float* vr = vs + j * ATT_PITCH;
#pragma unroll
                for (int d = 0; d < 64; d += 4) { const f32x4 t = *(const f32x4*)(vr + d);
                    acc[d] = acc[d] * al + p * t.x; acc[d + 1] = acc[d + 1] * al + p * t.y; acc[d + 2] = acc[d + 2] * al + p * t.z; acc[d + 3] = acc[d + 3] * al + p * t.w; }
            }
        }
        float mt = fmaxf(m, __shfl_xor(m, 1)); mt = fmaxf(mt, __shfl_xor(mt, 2)); mt = fmaxf(mt, __shfl_xor(mt, 4));
        const float f = __expf(m - mt);
        l *= f; l += __shfl_xor(l, 1); l += __shfl_xor(l, 2); l += __shfl_xor(l, 4);
#pragma unroll
        for (int d = 0; d < 64; ++d) acc[d] *= f;
        const bool b2 = part & 4, b1 = part & 2, b0 = part & 1;
        float r32[32], r16[16], r8[8];
#pragma unroll
        for (int d = 0; d < 32; ++d) { const float keep = b2 ? acc[32 + d] : acc[d], send = b2 ? acc[d] : acc[32 + d]; r32[d] = keep + __shfl_xor(send, 4); }
#pragma unroll
        for (int d = 0; d < 16; ++d) { const float keep = b1 ? r32[16 + d] : r32[d], send = b1 ? r32[d] : r32[16 + d]; r16[d] = keep + __shfl_xor(send, 2); }
#pragma unroll
        for (int d = 0; d < 8; ++d) { const float keep = b0 ? r16[8 + d] : r16[d], send = b0 ? r16[d] : r16[8 + d]; r8[d] = keep + __shfl_xor(send, 1); }
        const float il = 1.0f / l;
        const int tok = (nb * 64 + i) * dil + r;
        v4u o; o.x = pk2(r8[0] * il, r8[1] * il); o.y = pk2(r8[2] * il, r8[3] * il); o.z = pk2(r8[4] * il, r8[5] * il); o.w = pk2(r8[6] * il, r8[7] * il);
        *(v4u*)(OG + ((size_t)gi * S_ + tok) * 256 + hg * 64 + part * 8) = o;
        if (part == 0) LSE[((size_t)gi * S_ + tok) * 4 + hg] = mt + logf(l);
    }
}

__device__ __forceinline__ void ph_dnprep(const bf16* PD, const float* AB, const float* convw, const float* a_log, const float* dt_bias, bf16* QKVd, float* GB, const bf16* OG, const float* LSE, bf16* OATT, int wv) {
    int tid_ = wv * 64 + lane_id_(); asm volatile("" : "+v"(tid_)); const int tid = tid_, lane = tid_ & 63, wave = tid_ >> 6;
    for (int it = BID * 8 + wave; it < 1024 * 5; it += GSZ * 8) {
        const int tb = it / 5, sg = it % 5, c0 = sg * 512 + lane * 8, t0 = tb * 16;
        if (c0 < 2304) {
            const int seg = c0 >> 7;
            float cw[5][8];
#pragma unroll
            for (int j = 0; j < 5; ++j) { const f32x4 a = *(const f32x4*)(convw + j * 2304 + c0), b = *(const f32x4*)(convw + j * 2304 + c0 + 4);
                cw[j][0] = a.x; cw[j][1] = a.y; cw[j][2] = a.z; cw[j][3] = a.w; cw[j][4] = b.x; cw[j][5] = b.y; cw[j][6] = b.z; cw[j][7] = b.w; }
            v4u win[5];
#pragma unroll
            for (int j = 0; j < 4; ++j) { const int tt = t0 + j - 2; win[j + 1] = (tt >= 0) ? *(const v4u*)(PD + (size_t)tt * 2304 + c0) : (v4u){0u, 0u, 0u, 0u}; }
#pragma unroll
            for (int i = 0; i < 16; ++i) {
#pragma unroll
                for (int j = 0; j < 4; ++j) win[j] = win[j + 1];
                { const int tt = t0 + i + 2; win[4] = (tt < S_) ? *(const v4u*)(PD + (size_t)tt * 2304 + c0) : (v4u){0u, 0u, 0u, 0u}; }
                float a[8];
#pragma unroll
                for (int e = 0; e < 8; ++e) a[e] = 0.f;
#pragma unroll
                for (int j = 0; j < 5; ++j) { const unsigned wx[4] = {win[j].x, win[j].y, win[j].z, win[j].w};
#pragma unroll
                    for (int e = 0; e < 4; ++e) { a[2 * e] += bflo(wx[e]) * cw[j][2 * e]; a[2 * e + 1] += bfhi(wx[e]) * cw[j][2 * e + 1]; } }
                float ss = 0.f;
#pragma unroll
                for (int e = 0; e < 8; ++e) { a[e] = a[e] * __builtin_amdgcn_rcpf(1.0f + __expf(-a[e])); ss += a[e] * a[e]; }
                if (seg < 12) {
                    ss += __shfl_xor(ss, 1); ss += __shfl_xor(ss, 2); ss += __shfl_xor(ss, 4); ss += __shfl_xor(ss, 8);
                    const float sc = (1.0f / sqrtf(ss + 1e-6f)) * (seg < 6 ? 0.08838834764831845f : 1.0f);
#pragma unroll
                    for (int e = 0; e < 8; ++e) a[e] *= sc;
                }
                v4u o; o.x = pk2(a[0], a[1]); o.y = pk2(a[2], a[3]); o.z = pk2(a[4], a[5]); o.w = pk2(a[6], a[7]);
                *(v4u*)(QKVd + (size_t)(t0 + i) * 2304 + c0) = o;
            }
        }
    }
    for (int e = BID * NTHREADS + tid; e < S_ * 12; e += GSZ * NTHREADS) {
        const int t = e / 12, idx = e % 12;
        const float braw = AB[(size_t)t * 32 + idx], araw = AB[(size_t)t * 32 + 12 + idx];
        const float x = araw + dt_bias[idx];
        const float sp = fmaxf(x, 0.f) + log1pf(expf(-fabsf(x)));
        GB[(size_t)idx * S_ + t] = -expf(a_log[idx]) * sp;
        GB[(size_t)(12 + idx) * S_ + t] = 1.0f / (1.0f + expf(-braw));
    }
    for (int t = BID * 8 + wave; t < S_; t += GSZ * 8) {
        const int ch = 4 * lane, hg = lane >> 4;
        const float l0 = LSE[(size_t)t * 4 + hg], l1 = LSE[((size_t)S_ + t) * 4 + hg], l2 = LSE[((size_t)2 * S_ + t) * 4 + hg];
        const float mx = fmaxf(l0, fmaxf(l1, l2));
        float w0 = expf(l0 - mx), w1 = expf(l1 - mx), w2 = expf(l2 - mx);
        const float inv = 1.0f / (w0 + w1 + w2); w0 *= inv; w1 *= inv; w2 *= inv;
        const v2u a = *(const v2u*)(OG + (size_t)t * 256 + ch), b = *(const v2u*)(OG + ((size_t)S_ + t) * 256 + ch), cc = *(const v2u*)(OG + ((size_t)2 * S_ + t) * 256 + ch);
        v2u o;
        o.x = pk2(w0 * bflo(a.x) + w1 * bflo(b.x) + w2 * bflo(cc.x), w0 * bfhi(a.x) + w1 * bfhi(b.x) + w2 * bfhi(cc.x));
        o.y = pk2(w0 * bflo(a.y) + w1 * bflo(b.y) + w2 * bflo(cc.y), w0 * bfhi(a.y) + w1 * bfhi(b.y) + w2 * bfhi(cc.y));
        *(v2u*)(OATT + (size_t)t * 256 + ch) = o;
    }
}

__device__ __forceinline__ void ph_final(const bf16* ODIR0, const bf16* ODIR1, const bf16* PZ, const float* dnw, bf16* ODN, int wv) {
    int tid_ = wv * 64 + lane_id_(); asm volatile("" : "+v"(tid_)); const int lane = tid_ & 63, wave = tid_ >> 6;
    for (int t = BID * 8 + wave; t < S_; t += GSZ * 8) {
#pragma unroll
        for (int h = 0; h < 6; ++h) {
            const int c = h * 128 + 2 * lane;
            const unsigned wf = *(const unsigned*)(ODIR0 + (size_t)t * 768 + c), wb = *(const unsigned*)(ODIR1 + (size_t)t * 768 + c);
            float o0 = bflo(wf) + bflo(wb), o1 = bfhi(wf) + bfhi(wb);
            const float ms = wave_sum(o0 * o0 + o1 * o1) * (1.0f / 128.0f);
            const float sc = 1.0f / sqrtf(ms + 1e-6f);
            const unsigned zw = *(const unsigned*)(PZ + (size_t)t * 768 + c);
            const f32x2 nw = *(const f32x2*)(dnw + 2 * lane);
            o0 = o0 * sc * nw.x * siluf_(bflo(zw)); o1 = o1 * sc * nw.y * siluf_(bfhi(zw));
            *(unsigned*)(ODN + (size_t)t * 768 + c) = pk2(o0, o1);
        }
    }
}
typedef short bf16x8_t __attribute__((ext_vector_type(8)));
typedef short s16x4_t __attribute__((ext_vector_type(4)));
#define MFMA16(a, b, c) __builtin_amdgcn_mfma_f32_16x16x32_bf16((a), (b), (c), 0, 0, 0)

__device__ __forceinline__ void ph_dn_pre(const bf16* QKVd, const float* GB, bf16* TINV, bf16* ATTN, float* VEC, unsigned char* lds, int wv) {
    int tid_ = wv * 64 + lane_id_(); asm volatile("" : "+v"(tid_));
    const int tid = tid_, lane = tid & 63, g = lane >> 4, m16 = lane & 15;
    float* GR = (float*)lds; float* Ms = GR + 2 * 64 * 65; float* Gs = Ms + 2 * 64 * 68; float* Bs = Gs + 128;
    for (int u = BID; u < 1536; u += GSZ) {
        const int n = u / 6, h = u % 6;
        __syncthreads();
        {
            const int kind = wv >> 2, mt = wv & 3;
            const bf16* arow = QKVd + (size_t)(64 * n + 16 * mt + m16) * 2304 + (kind ? 0 : 768) + h * 128 + 8 * g;
            bf16x8_t a[4];
#pragma unroll
            for (int ks = 0; ks < 4; ++ks) a[ks] = *(const bf16x8_t*)(arow + 32 * ks);
#pragma unroll
            for (int nt = 0; nt < 4; ++nt) {
                const bf16* brow = QKVd + (size_t)(64 * n + 16 * nt + m16) * 2304 + 768 + h * 128 + 8 * g;
                f32x4 acc = {0.f, 0.f, 0.f, 0.f};
#pragma unroll
                for (int ks = 0; ks < 4; ++ks) acc = MFMA16(a[ks], *(const bf16x8_t*)(brow + 32 * ks), acc);
#pragma unroll
                for (int rg = 0; rg < 4; ++rg) GR[kind * 64 * 65 + (16 * mt + 4 * g + rg) * 65 + 16 * nt + m16] = acc[rg];
            }
        }
        if ((wv & 3) == 0) {
            const int d = wv >> 2, tok = 64 * n + (d ? 63 - lane : lane);
            float gv = GB[(size_t)(d * 6 + h) * S_ + tok]; const float be = GB[(size_t)(12 + d * 6 + h) * S_ + tok];
#pragma unroll
            for (int o = 1; o < 64; o <<= 1) { const float t = __shfl_up(gv, o); if (lane >= o) gv += t; }
            const float gl = __shfl(gv, 63);
            Gs[d * 64 + lane] = gv; Bs[d * 64 + lane] = be;
            float* vec = VEC + (size_t)(u * 2 + d) * 256;
            vec[lane] = __expf(gv); vec[64 + lane] = be; vec[128 + lane] = __expf(gl - gv); vec[192 + lane] = __expf(gl);
        }
        __syncthreads();
        {
            const int d = wv >> 2, tl = tid & 255, i = tl >> 2, jq = tl & 3, ii = d ? 63 - i : i;
            const float Gi = Gs[d * 64 + i], bi = Bs[d * 64 + i];
            unsigned pk[8];
#pragma unroll
            for (int jj = 0; jj < 16; jj += 2) {
                float at[2];
#pragma unroll
                for (int e = 0; e < 2; ++e) {
                    const int j = 16 * jq + jj + e, jx = d ? 63 - j : j;
                    const float dec = (j <= i) ? __expf(Gi - Gs[d * 64 + j]) : 0.f;
                    const float kk = GR[ii * 65 + jx], qk = GR[64 * 65 + ii * 65 + jx];
                    Ms[d * 64 * 68 + i * 68 + j] = (j < i) ? bi * kk * dec : 0.f;
                    at[e] = (j <= i) ? qk * dec : 0.f;
                }
                pk[jj >> 1] = pk2(at[0], at[1]);
            }
            v4u* dst = (v4u*)(ATTN + ((size_t)(u * 2 + d) * 64 + i) * 64 + 16 * jq);
            v4u o0; o0.x = pk[0]; o0.y = pk[1]; o0.z = pk[2]; o0.w = pk[3]; v4u o1; o1.x = pk[4]; o1.y = pk[5]; o1.z = pk[6]; o1.w = pk[7];
            dst[0] = o0; dst[1] = o1;
        }
        __syncthreads();
        if ((wv & 3) == 0) {
            const int d = wv >> 2, c = lane; const float* Md = Ms + d * 64 * 68;
            float x[64];
            x[0] = (c == 0) ? 1.f : 0.f;
#pragma unroll
            for (int i = 1; i < 64; ++i) {
                f32x4 mr[16];
#pragma unroll
                for (int j0 = 0; j0 < i; j0 += 4) mr[j0 >> 2] = *(const f32x4*)(Md + i * 68 + j0);
                float s0 = (i == c) ? 1.f : 0.f, s1 = 0.f, s2 = 0.f, s3 = 0.f;
#pragma unroll
                for (int j0 = 0; j0 < i; j0 += 4) { const f32x4 mv = mr[j0 >> 2];
                    s0 -= mv.x * x[j0]; if (j0 + 1 < i) s1 -= mv.y * x[j0 + 1]; if (j0 + 2 < i) s2 -= mv.z * x[j0 + 2]; if (j0 + 3 < i) s3 -= mv.w * x[j0 + 3]; }
                x[i] = (s0 + s1) + (s2 + s3);
            }
            bf16* outp = TINV + (size_t)(u * 2 + d) * 4096 + c;
#pragma unroll
            for (int i = 0; i < 64; ++i) outp[i * 64] = (bf16)f2bf(x[i]);
        }
    }
}

constexpr int SC_NC = 2;
constexpr int SC_KT = 0, SC_QT = 17408, SC_TI = 34816, SC_AT = 44032, SC_VT = 53248, SC_VC = SC_VT + 4096, SC_BUF = SC_VC + 1024;
constexpr int SC_ST = 2 * SC_BUF, SC_RT = SC_ST + 16 * SC_NC * 272, SC_VNT = SC_RT + 16 * SC_NC * 144, SC_VST = SC_VNT + 16 * SC_NC * 144, SC_END = SC_VST + 16 * SC_NC * 144;
static_assert(SC_END <= 146432, "scan LDS");
constexpr size_t SCS_MAT = 128 * 128;
__device__ __forceinline__ float* scs_B(float* base, int p, int j) { return base + (size_t)(p * 3 + j) * SCS_MAT; }
__device__ __forceinline__ float* scs_A(float* base, int p, int j) { return base + (size_t)(36 + p * 2 + (j - 1)) * SCS_MAT; }
template <int PASS>
__device__ __forceinline__ void ph_dn_scan(const bf16* QKVd, const bf16* TINV, const bf16* ATTN, const float* VEC, bf16* ODIR0, bf16* ODIR1, float* SCS, LAS unsigned char* lds, int wv) {
    const int xl = BID & 7, slot = BID >> 3;
    int p, j, cs; bool has_out, v_zero;
    if (PASS == 1) {
        if (slot < 24) { const int grp = xl * 3 + (slot >> 3), within = slot & 7; p = grp >> 1; j = 1 + (grp & 1); v_zero = (within >> 2) != 0; cs = within & 3; has_out = false; }
        else { const int s4 = slot - 24; int gi; if (xl < 4) gi = xl * 2 + (s4 >> 2); else { if (s4 >= 4) return; gi = 8 + (xl - 4); } p = gi; j = 0; cs = s4 & 3; has_out = true; v_zero = false; }
    } else {
        if (slot >= 20) return; const int v = xl * 20 + slot; if (v >= 144) return;
        const int grp = v >> 2; p = grp / 3; j = 1 + grp % 3; cs = v & 3; has_out = true; v_zero = false;
    }
    const int d = p / 6, h = p % 6;
    int tid_ = wv * 64 + lane_id_(); asm volatile("" : "+v"(tid_));
    const int tid = tid_, lane = tid & 63, g = lane >> 4, m16 = lane & 15, t4 = wv & 3;
    bf16* ODIR = d ? ODIR1 : ODIR0;
    v4u pfA[7], pfB[7];
#define SC_LOAD(pf, step) do { const int n_ = d ? 255 - (step) : (step); const size_t cb_ = (size_t)((n_ * 6 + h) * 2 + d); \
        _Pragma("unroll") for (int k_ = 0; k_ < 7; ++k_) { int q_ = tid + 512 * k_; if (k_ == 6 && q_ > 3391) q_ = 3391; const void* src_; \
            if (k_ < 4) { const int qq_ = q_ & 1023, row_ = qq_ >> 4, ch_ = qq_ & 15; const int tok_ = 64 * n_ + (d ? 63 - row_ : row_); src_ = QKVd + (size_t)tok_ * 2304 + (k_ < 2 ? 768 : 0) + h * 128 + ch_ * 8; } \
            else if (k_ < 6) { const int qq_ = q_ & 511, row_ = qq_ >> 3, ch_ = qq_ & 7; src_ = (k_ == 4 ? TINV : ATTN) + cb_ * 4096 + row_ * 64 + ch_ * 8; } \
            else { const int qq_ = q_ - 3072; const int row_ = (qq_ & 255) >> 2, ch_ = qq_ & 3; const int tok_ = 64 * n_ + (d ? 63 - row_ : row_); \
                   const void* sv_ = QKVd + (size_t)tok_ * 2304 + 1536 + h * 128 + cs * 32 + ch_ * 8; const void* sc_ = VEC + cb_ * 256 + ((qq_ - 256) & 63) * 4; src_ = (qq_ < 256) ? sv_ : sc_; } \
            if (!has_out && (k_ == 2 || k_ == 3 || k_ == 5)) src_ = TINV + cb_ * 4096;        \
            asm volatile("global_load_dwordx4 %0, %1, off" : "=v"(pf[k_]) : "v"(src_) : "memory"); } } while (0)
#define SC_WRITE(pf, bufsel) do { LAS unsigned char* bb_ = lds + (bufsel) * SC_BUF; \
        _Pragma("unroll") for (int k_ = 0; k_ < 7; ++k_) { const int q_ = tid + 512 * k_; int off_ = -1; \
            if (k_ < 4) { const int qq_ = q_ & 1023, row_ = qq_ >> 4, ch_ = qq_ & 15; off_ = (k_ < 2 ? SC_KT : SC_QT) + row_ * 272 + ch_ * 16; } \
            else if (k_ < 6) { const int qq_ = q_ & 511, row_ = qq_ >> 3, ch_ = qq_ & 7; off_ = (k_ == 4 ? SC_TI : SC_AT) + row_ * 144 + ch_ * 16; } \
            else { const int qq_ = q_ - 3072; if (qq_ < 256) off_ = SC_VT + qq_ * 16; else if (qq_ < 320) off_ = SC_VC + (qq_ - 256) * 16; } \
            if (off_ >= 0) *(LAS v4u*)(bb_ + off_) = pf[k_]; } } while (0)
#define SC_BAR() do { asm volatile("s_waitcnt lgkmcnt(0)" ::: "memory"); __builtin_amdgcn_s_barrier(); asm volatile("" ::: "memory"); } while (0)
#define SC_WAIT(pf, N) asm volatile("s_waitcnt vmcnt(" #N ")" : "+v"(pf[0]), "+v"(pf[1]), "+v"(pf[2]), "+v"(pf[3]), "+v"(pf[4]), "+v"(pf[5]), "+v"(pf[6]) :: "memory")
#define SC_WAIT4(pf, N) asm volatile("s_waitcnt vmcnt(" #N ")" : "+v"(pf[0]), "+v"(pf[1]), "+v"(pf[4]), "+v"(pf[6]) :: "memory")
#define SC_OSTORE(stepo) do { if (has_out && wv >= 4) { const int no_ = d ? 255 - (stepo) : (stepo); \
        _Pragma("unroll") for (int ct = 0; ct < SC_NC; ++ct) _Pragma("unroll") for (int rg = 0; rg < 4; ++rg) { const int i_ = 16 * t4 + 4 * g + rg, tok_ = 64 * no_ + (d ? 63 - i_ : i_); \
            ODIR[(size_t)tok_ * 768 + h * 128 + cs * 32 + ct * 16 + m16] = (bf16)f2bf(oprev[ct][rg]); } } } while (0)
#define SC_STEP(s, PFW, PFL) do { const int s_ = (s); const int cur = s_ & 1; \
        LAS unsigned char* B = lds + cur * SC_BUF; \
        SC_LOAD(PFL, (s_ + 2 < s_end ? s_ + 2 : s_end - 1)); \
        if (s_ > s_beg) SC_OSTORE(s_ - 1); \
        const LAS float* VC = (const LAS float*)(B + SC_VC); \
        bf16x8_t sb[SC_NC][4]; \
        _Pragma("unroll") for (int ct = 0; ct < SC_NC; ++ct) _Pragma("unroll") for (int ks = 0; ks < 4; ++ks) sb[ct][ks] = *(const LAS bf16x8_t*)(lds + SC_ST + (16 * ct + m16) * 272 + (32 * ks + 8 * g) * 2); \
        f32x4 acc1[SC_NC]; \
        _Pragma("unroll") for (int ct = 0; ct < SC_NC; ++ct) acc1[ct] = (f32x4){0.f, 0.f, 0.f, 0.f}; \
        const f32x4 eG4 = *(const LAS f32x4*)(VC + 16 * t4 + 4 * g); \
        if (wv < 4 || has_out) { const LAS unsigned char* ap = B + (wv < 4 ? SC_KT : SC_QT) + (16 * t4 + m16) * 272 + 16 * g; \
          _Pragma("unroll") for (int ks = 0; ks < 4; ++ks) { const bf16x8_t a_ = *(const LAS bf16x8_t*)(ap + 64 * ks); \
              _Pragma("unroll") for (int ct = 0; ct < SC_NC; ++ct) acc1[ct] = MFMA16(a_, sb[ct][ks], acc1[ct]); } } \
        if (wv < 4) { const f32x4 be4 = *(const LAS f32x4*)(VC + 64 + 16 * t4 + 4 * g); \
            _Pragma("unroll") for (int ct = 0; ct < SC_NC; ++ct) { float r[4]; \
                _Pragma("unroll") for (int rg = 0; rg < 4; ++rg) { const float vv = v_zero ? 0.f : bf2f(*(const LAS unsigned short*)(B + SC_VT + (16 * t4 + 4 * g + rg) * 64 + (16 * ct + m16) * 2)); r[rg] = be4[rg] * (vv - eG4[rg] * acc1[ct][rg]); } \
                v2u w; w.x = pk2(r[0], r[1]); w.y = pk2(r[2], r[3]); *(LAS v2u*)(lds + SC_RT + (16 * ct + m16) * 144 + (16 * t4 + 4 * g) * 2) = w; } \
        } else { _Pragma("unroll") for (int ct = 0; ct < SC_NC; ++ct) _Pragma("unroll") for (int rg = 0; rg < 4; ++rg) acc1[ct][rg] *= eG4[rg]; } \
        SC_BAR(); \
        if (wv < 4) { const LAS unsigned char* ap = B + SC_TI + (16 * t4 + m16) * 144 + 16 * g; \
            const bf16x8_t a0_ = *(const LAS bf16x8_t*)ap, a1_ = *(const LAS bf16x8_t*)(ap + 64); \
            const f32x4 eL4 = *(const LAS f32x4*)(VC + 128 + 16 * t4 + 4 * g); \
            _Pragma("unroll") for (int ct = 0; ct < SC_NC; ++ct) { f32x4 vn = {0.f, 0.f, 0.f, 0.f}; \
                vn = MFMA16(a0_, *(const LAS bf16x8_t*)(lds + SC_RT + (16 * ct + m16) * 144 + (8 * g) * 2), vn); \
                vn = MFMA16(a1_, *(const LAS bf16x8_t*)(lds + SC_RT + (16 * ct + m16) * 144 + (32 + 8 * g) * 2), vn); \
                v2u w; w.x = pk2(vn[0], vn[1]); w.y = pk2(vn[2], vn[3]); *(LAS v2u*)(lds + SC_VNT + (16 * ct + m16) * 144 + (16 * t4 + 4 * g) * 2) = w; \
                v2u w2; w2.x = pk2(vn[0] * eL4[0], vn[1] * eL4[1]); w2.y = pk2(vn[2] * eL4[2], vn[3] * eL4[3]); *(LAS v2u*)(lds + SC_VST + (16 * ct + m16) * 144 + (16 * t4 + 4 * g) * 2) = w2; } } \
        SC_BAR(); \
        { bf16x8_t ka[2]; \
          _Pragma("unroll") for (int ks = 0; ks < 2; ++ks) { \
              const LAS unsigned char* tp = B + SC_KT + (32 * ks + 8 * g + (m16 >> 2)) * 272 + (16 * wv + 4 * (m16 & 3)) * 2; \
              const s16x4_t lo = __builtin_amdgcn_ds_read_tr16_b64_v4i16((LAS s16x4_t*)tp); \
              const s16x4_t hi = __builtin_amdgcn_ds_read_tr16_b64_v4i16((LAS s16x4_t*)(tp + 4 * 272)); \
              ka[ks] = (bf16x8_t){lo[0], lo[1], lo[2], lo[3], hi[0], hi[1], hi[2], hi[3]}; } \
          const float gl = VC[192]; \
          _Pragma("unroll") for (int ct = 0; ct < SC_NC; ++ct) { f32x4 acc3 = {0.f, 0.f, 0.f, 0.f}; \
              _Pragma("unroll") for (int ks = 0; ks < 2; ++ks) acc3 = MFMA16(ka[ks], *(const LAS bf16x8_t*)(lds + SC_VST + (16 * ct + m16) * 144 + (32 * ks + 8 * g) * 2), acc3); \
              _Pragma("unroll") for (int rg = 0; rg < 4; ++rg) Sreg[ct][rg] = gl * Sreg[ct][rg] + acc3[rg]; \
              v2u w; w.x = pk2(Sreg[ct][0], Sreg[ct][1]); w.y = pk2(Sreg[ct][2], Sreg[ct][3]); *(LAS v2u*)(lds + SC_ST + (16 * ct + m16) * 272 + (16 * wv + 4 * g) * 2) = w; } } \
        if (has_out && wv >= 4) { const LAS unsigned char* ap = B + SC_AT + (16 * t4 + m16) * 144 + 16 * g; \
            const bf16x8_t a0_ = *(const LAS bf16x8_t*)ap, a1_ = *(const LAS bf16x8_t*)(ap + 64); \
            _Pragma("unroll") for (int ct = 0; ct < SC_NC; ++ct) { \
                acc1[ct] = MFMA16(a0_, *(const LAS bf16x8_t*)(lds + SC_VNT + (16 * ct + m16) * 144 + (8 * g) * 2), acc1[ct]); \
                acc1[ct] = MFMA16(a1_, *(const LAS bf16x8_t*)(lds + SC_VNT + (16 * ct + m16) * 144 + (32 + 8 * g) * 2), acc1[ct]); \
                oprev[ct] = acc1[ct]; } } \
        SC_WAIT(PFW, 7); SC_WRITE(PFW, cur ^ 1); \
        SC_BAR(); } while (0)
    const int s_beg = 64 * j, s_end = s_beg + 64;
    SC_LOAD(pfA, s_beg);
    f32x4 Sreg[SC_NC], oprev[SC_NC];
#pragma unroll
    for (int ct = 0; ct < SC_NC; ++ct) { Sreg[ct] = (f32x4){0.f, 0.f, 0.f, 0.f}; oprev[ct] = (f32x4){0.f, 0.f, 0.f, 0.f}; }
    if (PASS == 1) {
        if (v_zero) {
#pragma unroll
            for (int ct = 0; ct < SC_NC; ++ct)
#pragma unroll
                for (int rg = 0; rg < 4; ++rg) Sreg[ct][rg] = (16 * wv + 4 * g + rg == 32 * cs + 16 * ct + m16) ? 1.f : 0.f;
        }
    } else {
        LAS float* blk0 = (LAS float*)(lds + SC_ST); LAS float* blk1 = blk0 + 128 * 33;
        blk0 = (LAS float*)(lds + SC_BUF); blk1 = blk0 + 128 * 33;
        const int a = tid >> 2, cq = tid & 3;
        float accv[8];
        { const float* bp = scs_B(SCS, p, 0) + (size_t)a * 128 + 32 * cs + 8 * cq; const f32x4 x0 = *(const f32x4*)bp, x1 = *(const f32x4*)(bp + 4);
          accv[0] = x0.x; accv[1] = x0.y; accv[2] = x0.z; accv[3] = x0.w; accv[4] = x1.x; accv[5] = x1.y; accv[6] = x1.z; accv[7] = x1.w; }
#pragma unroll 1
        for (int jj = 1; jj < j; ++jj) {
            LAS float* src = (jj & 1) ? blk0 : blk1;
#pragma unroll
            for (int e = 0; e < 8; ++e) src[a * 33 + 8 * cq + e] = accv[e];
            __syncthreads();
            { const float* bp = scs_B(SCS, p, jj) + (size_t)a * 128 + 32 * cs + 8 * cq; const f32x4 x0 = *(const f32x4*)bp, x1 = *(const f32x4*)(bp + 4);
              accv[0] = x0.x; accv[1] = x0.y; accv[2] = x0.z; accv[3] = x0.w; accv[4] = x1.x; accv[5] = x1.y; accv[6] = x1.z; accv[7] = x1.w; }
            const float* ar = scs_A(SCS, p, jj) + (size_t)a * 128;
#pragma unroll 4
            for (int b4 = 0; b4 < 128; b4 += 4) { const f32x4 av = *(const f32x4*)(ar + b4);
#pragma unroll
                for (int e = 0; e < 8; ++e) accv[e] += av.x * src[(b4 + 0) * 33 + 8 * cq + e] + av.y * src[(b4 + 1) * 33 + 8 * cq + e] + av.z * src[(b4 + 2) * 33 + 8 * cq + e] + av.w * src[(b4 + 3) * 33 + 8 * cq + e]; }
        }
        LAS float* fin = (j & 1) ? blk0 : blk1;
        __syncthreads();
#pragma unroll
        for (int e = 0; e < 8; ++e) fin[a * 33 + 8 * cq + e] = accv[e];
        __syncthreads();
#pragma unroll
        for (int ct = 0; ct < SC_NC; ++ct)
#pragma unroll
            for (int rg = 0; rg < 4; ++rg) Sreg[ct][rg] = fin[(16 * wv + 4 * g + rg) * 33 + 16 * ct + m16];
        __syncthreads();
    }
#pragma unroll
    for (int ct = 0; ct < SC_NC; ++ct) { v2u w; w.x = pk2(Sreg[ct][0], Sreg[ct][1]); w.y = pk2(Sreg[ct][2], Sreg[ct][3]); *(LAS v2u*)(lds + SC_ST + (16 * ct + m16) * 272 + (16 * wv + 4 * g) * 2) = w; }
    SC_WAIT(pfA, 0); SC_WRITE(pfA, s_beg & 1);
    SC_LOAD(pfB, s_beg + 1);
    __syncthreads();
#pragma unroll 1
    for (int s2 = s_beg; s2 < s_end; s2 += 2) {
        SC_STEP(s2, pfB, pfA);
        SC_STEP(s2 + 1, pfA, pfB);
    }
    asm volatile("s_waitcnt vmcnt(0)" : "+v"(pfA[0]), "+v"(pfA[1]), "+v"(pfA[2]), "+v"(pfA[3]), "+v"(pfA[4]), "+v"(pfA[5]), "+v"(pfA[6]),
                                        "+v"(pfB[0]), "+v"(pfB[1]), "+v"(pfB[2]), "+v"(pfB[3]), "+v"(pfB[4]), "+v"(pfB[5]), "+v"(pfB[6]) :: "memory");
    SC_OSTORE(s_end - 1);
    if (PASS == 1) {
        float* dst = (v_zero ? scs_A(SCS, p, j) : scs_B(SCS, p, j));
        if (j < 3) {
#pragma unroll
            for (int ct = 0; ct < SC_NC; ++ct)
#pragma unroll
                for (int rg = 0; rg < 4; ++rg) dst[(size_t)(16 * wv + 4 * g + rg) * 128 + 32 * cs + 16 * ct + m16] = Sreg[ct][rg];
        }
    }
    asm volatile("s_waitcnt vmcnt(0)" ::: "memory");
#undef SC_STEP
#undef SC_OSTORE
#undef SC_WAIT
#undef SC_WAIT4
#undef SC_BAR
#undef SC_LOAD
#undef SC_WRITE
}
constexpr int AT_PITCH = 144, AT_K = 0, AT_V = 192 * AT_PITCH, AT_GRP = 2 * 192 * AT_PITCH;
__device__ __forceinline__ void ph_attn(const bf16* PA, const float* rope, bf16* OG, float* LSE, LAS unsigned char* lds, int wv) {
    int tid_ = wv * 64 + lane_id_(); asm volatile("" : "+v"(tid_));
    const int tid = tid_, lane = tid & 63, g = lane >> 4, m16 = lane & 15, grp = wv >> 2, wq = wv & 3, tg = tid & 255;
    LAS unsigned char* Kl = lds + grp * AT_GRP + AT_K; LAS unsigned char* Vl = lds + grp * AT_GRP + AT_V;
#pragma unroll 1
    for (int pi = BID; pi < 1536; pi += GSZ) {
        const int u = 2 * pi + grp;
        const int hg = u & 3, w = (u >> 2) & 255, gi = u >> 10;
        const int dil = 1 << (2 * gi), L = S_ / dil, r = w & (dil - 1), nb = w >> (2 * gi), head = gi * 4 + hg;
#pragma unroll
        for (int k = 0; k < 3; ++k) {
            const int item = tg + 256 * k, row = item >> 2, c = item & 3, mm = nb * 64 - 64 + row;
            v4u o0 = {0u, 0u, 0u, 0u}, o1 = {0u, 0u, 0u, 0u};
            if (mm >= 0 && mm < L) {
                const int tok = mm * dil + r;
                const bf16* kp = PA + (size_t)tok * 2304 + 768 + head * 64 + 8 * c;
                const v4u x0 = *(const v4u*)kp, x1 = *(const v4u*)(kp + 32);
                const f32x4* cp = (const f32x4*)(rope + (size_t)tok * 32 + 8 * c); const f32x4* sp = (const f32x4*)(rope + (size_t)S_ * 32 + (size_t)tok * 32 + 8 * c);
                const f32x4 c0 = cp[0], c1 = cp[1], s0 = sp[0], s1 = sp[1];
                const float cs[8] = {c0.x, c0.y, c0.z, c0.w, c1.x, c1.y, c1.z, c1.w}, sn[8] = {s0.x, s0.y, s0.z, s0.w, s1.x, s1.y, s1.z, s1.w};
                const unsigned xa[4] = {x0.x, x0.y, x0.z, x0.w}, xb[4] = {x1.x, x1.y, x1.z, x1.w};
                unsigned ra[4], rb[4];
#pragma unroll
                for (int e = 0; e < 4; ++e) {
                    const float a0 = bflo(xa[e]), a1 = bfhi(xa[e]), b0 = bflo(xb[e]), b1 = bfhi(xb[e]);
                    ra[e] = pk2(a0 * cs[2 * e] - b0 * sn[2 * e], a1 * cs[2 * e + 1] - b1 * sn[2 * e + 1]);
                    rb[e] = pk2(b0 * cs[2 * e] + a0 * sn[2 * e], b1 * cs[2 * e + 1] + a1 * sn[2 * e + 1]);
                }
                o0.x = ra[0]; o0.y = ra[1]; o0.z = ra[2]; o0.w = ra[3]; o1.x = rb[0]; o1.y = rb[1]; o1.z = rb[2]; o1.w = rb[3];
            }
            *(LAS v4u*)(Kl + row * AT_PITCH + 16 * c) = o0; *(LAS v4u*)(Kl + row * AT_PITCH + 64 + 16 * c) = o1;
        }
#pragma unroll
        for (int k = 0; k < 6; ++k) {
            const int item = tg + 256 * k, row = item >> 3, c = item & 7, mm = nb * 64 - 64 + row;
            v4u o = {0u, 0u, 0u, 0u};
            if (mm >= 0 && mm < L) o = *(const v4u*)(PA + (size_t)(mm * dil + r) * 2304 + 1536 + head * 64 + 8 * c);
            *(LAS v4u*)(Vl + row * AT_PITCH + 16 * c) = o;
        }
        bf16x8_t bq0, bq1;
        const int qi = 16 * wq + m16, qtok = (nb * 64 + qi) * dil + r;
        {
            const bf16* qp = PA + (size_t)qtok * 2304 + head * 64 + 8 * g;
            const v4u x0 = *(const v4u*)qp, x1 = *(const v4u*)(qp + 32);
            const f32x4* cp = (const f32x4*)(rope + (size_t)qtok * 32 + 8 * g); const f32x4* sp = (const f32x4*)(rope + (size_t)S_ * 32 + (size_t)qtok * 32 + 8 * g);
            const f32x4 c0 = cp[0], c1 = cp[1], s0 = sp[0], s1 = sp[1];
            const float cs[8] = {c0.x, c0.y, c0.z, c0.w, c1.x, c1.y, c1.z, c1.w}, sn[8] = {s0.x, s0.y, s0.z, s0.w, s1.x, s1.y, s1.z, s1.w};
            const unsigned xa[4] = {x0.x, x0.y, x0.z, x0.w}, xb[4] = {x1.x, x1.y, x1.z, x1.w};
            v4u ra, rb; unsigned* rap = (unsigned*)&ra; unsigned* rbp = (unsigned*)&rb; (void)rap; (void)rbp;
            unsigned ta[4], tb[4];
#pragma unroll
            for (int e = 0; e < 4; ++e) {
                const float a0 = bflo(xa[e]), a1 = bfhi(xa[e]), b0 = bflo(xb[e]), b1 = bfhi(xb[e]);
                ta[e] = pk2(0.125f * (a0 * cs[2 * e] - b0 * sn[2 * e]), 0.125f * (a1 * cs[2 * e + 1] - b1 * sn[2 * e + 1]));
                tb[e] = pk2(0.125f * (b0 * cs[2 * e] + a0 * sn[2 * e]), 0.125f * (b1 * cs[2 * e + 1] + a1 * sn[2 * e + 1]));
            }
            ra.x = ta[0]; ra.y = ta[1]; ra.z = ta[2]; ra.w = ta[3]; rb.x = tb[0]; rb.y = tb[1]; rb.z = tb[2]; rb.w = tb[3];
            bq0 = __builtin_bit_cast(bf16x8_t, ra); bq1 = __builtin_bit_cast(bf16x8_t, rb);
        }
        __syncthreads();
        f32x4 st[12];
#pragma unroll
        for (int kt = 0; kt < 12; ++kt) {
            const LAS unsigned char* ap = Kl + (16 * kt + m16) * AT_PITCH + 16 * g;
            f32x4 z = {0.f, 0.f, 0.f, 0.f};
            z = MFMA16(*(const LAS bf16x8_t*)ap, bq0, z);
            st[kt] = MFMA16(*(const LAS bf16x8_t*)(ap + 64), bq1, z);
        }
        float mx = -1e30f;
#pragma unroll
        for (int kt = 0; kt < 12; ++kt)
#pragma unroll
            for (int rg = 0; rg < 4; ++rg) { const int j = 16 * kt + 4 * g + rg, dj = j - qi, mm = nb * 64 - 64 + j;
                const bool ok = (dj >= 0) && (dj <= 128) && (mm >= 0) && (mm < L);
                st[kt][rg] = ok ? st[kt][rg] : -1e30f; mx = fmaxf(mx, st[kt][rg]); }
        mx = fmaxf(mx, __shfl_xor(mx, 16)); mx = fmaxf(mx, __shfl_xor(mx, 32));
        float sum = 0.f;
#pragma unroll
        for (int kt = 0; kt < 12; ++kt)
#pragma unroll
            for (int rg = 0; rg < 4; ++rg) { const float p = __expf(st[kt][rg] - mx); st[kt][rg] = p; sum += p; }
        sum += __shfl_xor(sum, 16); sum += __shfl_xor(sum, 32);
        f32x4 o[4];
#pragma unroll
        for (int dt = 0; dt < 4; ++dt) o[dt] = (f32x4){0.f, 0.f, 0.f, 0.f};
#pragma unroll
        for (int kk = 0; kk < 6; ++kk) {
            v4u pb; pb.x = pk2(st[2 * kk][0], st[2 * kk][1]); pb.y = pk2(st[2 * kk][2], st[2 * kk][3]); pb.z = pk2(st[2 * kk + 1][0], st[2 * kk + 1][1]); pb.w = pk2(st[2 * kk + 1][2], st[2 * kk + 1][3]);
            const bf16x8_t b = __builtin_bit_cast(bf16x8_t, pb);
#pragma unroll
            for (int dt = 0; dt < 4; ++dt) {
                const LAS unsigned char* tp = Vl + (32 * kk + 4 * g + (m16 >> 2)) * AT_PITCH + (16 * dt + 4 * (m16 & 3)) * 2;
                const s16x4_t lo = __builtin_amdgcn_ds_read_tr16_b64_v4i16((LAS s16x4_t*)tp);
                const s16x4_t hi = __builtin_amdgcn_ds_read_tr16_b64_v4i16((LAS s16x4_t*)(tp + 16 * AT_PITCH));
                const bf16x8_t a = {lo[0], lo[1], lo[2], lo[3], hi[0], hi[1], hi[2], hi[3]};
                o[dt] = MFMA16(a, b, o[dt]);
            }
        }
        const float il = 1.0f / sum;
        bf16* op = OG + ((size_t)gi * S_ + qtok) * 256 + hg * 64 + 4 * g;
#pragma unroll
        for (int dt = 0; dt < 4; ++dt) { v2u wv2; wv2.x = pk2(o[dt][0] * il, o[dt][1] * il); wv2.y = pk2(o[dt][2] * il, o[dt][3] * il); *(v2u*)(op + 16 * dt) = wv2; }
        if (g == 0) LSE[((size_t)gi * S_ + qtok) * 4 + hg] = mx + logf(sum);
        __syncthreads();
    }
}
constexpr int LDS_RING = 146432, LDS_CTL_OFF = LDS_RING, LDS_BYTES = 147456;
constexpr int CW_BAR = 4096;
#ifndef PROBE_ID
#define PROBE_ID (-1)
#endif
__device__ __forceinline__ unsigned char* wsp() { return PWS; }
template <class Epi> __device__ __forceinline__ void run_gemm(LAS unsigned char* lds, const bf16* A, const bf16* Bt, int N, int K, const Epi& E, int wv) {
    pg8::Gemm g{A, Bt, S_, N, K, 0};
    pg8::StaticOrder S; S.init(S_, N, GSZ, BID);
    pg8::gemm_phase<Epi, pg8::StaticOrder, true, true>(lds, g, S, E, wv);
}
#define GRID_BAR() do { XcdBarrier b_; b_.bar = (unsigned*)(wsp() + WS_CTL) + CW_BAR; b_.st = (volatile LAS unsigned*)(lds + LDS_CTL_OFF + 320) + 8; b_.x = b_.st[2]; xcd_barrier(b_, wv); } while (0)
#define PHASE(id, ...) do { { __VA_ARGS__ } if (PROBE_ID == (id)) { GRID_BAR(); { __VA_ARGS__ } } } while (0)
#define WS_R_PTRS unsigned char* ws = wsp(); unsigned char* R = ws + WS_R; (void)R;

template <int l, int f> __device__ __forceinline__ void ffn_block(LAS unsigned char* lds, unsigned char* lds_raw, int wv) {
    constexpr int s = f * 2;
    PHASE(1, WS_R_PTRS
        pg8::EpiSwiglu E; E.O = (bf16*)(R + R_ACT); E.ldc = FF_; E.pad_ = 0; run_gemm(lds, (const bf16*)(ws + WS_H), (const bf16*)(ws + WS_W + (f ? W_FFIN1 : W_FFIN0)), 2 * FF_, 1024, E, wv); );
    GRID_BAR();
    PHASE(2, WS_R_PTRS
        pg8::EpiBf16P E; E.O = (bf16*)(R + R_Y); E.ldc = 1024; E.pad_ = 0; run_gemm(lds, (const bf16*)(R + R_ACT), (const bf16*)(ws + WS_W + (f ? W_FFOUT1 : W_FFOUT0)), 1024, FF_, E, wv); );
    GRID_BAR();
    {   WS_R_PTRS const float* MOD = (const float*)(ws + WS_MOD); const float* mod = MOD + l * 9216;
        RowArgs a; a.xi = (l == 0 && f == 0) ? PIN(0) : POUT; a.y = (const bf16*)(R + R_Y); a.xo = POUT; a.wpost = PIN(6) + (l * 3 + s) * 1024; a.gate = mod + (s * 3 + 2) * 1024; a.coef = 0.5f;
        if (f == 0) { a.h = (bf16*)(ws + WS_H); a.wpre = PIN(5) + (l * 3 + 1) * 1024; a.shift = mod + (1 * 3 + 0) * 1024; a.scale = mod + (1 * 3 + 1) * 1024; }
        else if (l == 0) { a.h = (bf16*)(ws + WS_H); a.wpre = PIN(5) + (1 * 3 + 0) * 1024; a.shift = MOD + 9216; a.scale = MOD + 9216 + 1024; }
        else { a.h = nullptr; a.wpre = nullptr; a.shift = nullptr; a.scale = nullptr; }
        ph_rows(a, wv);
        if (f == 1 && l == 0) ph_convert(1, lds_raw, wv); }
    GRID_BAR();
}
template <int l> __device__ __forceinline__ void mixer_block(LAS unsigned char* lds, unsigned char* lds_raw, int wv) {
    PHASE(3, WS_R_PTRS
        pg8::EpiInProj E; E.PA = (bf16*)(R + R_PA); E.PD = (bf16*)(R + R_PD); E.PZ = (bf16*)(R + R_PZ); E.AB = (float*)(R + R_AB);
        run_gemm(lds, (const bf16*)(ws + WS_H), (const bf16*)(ws + WS_W + W_IN), 5632, 1024, E, wv); );
    GRID_BAR();
    PHASE(4, WS_R_PTRS
        ph_attn((const bf16*)(R + R_PA), (const float*)(ws + WS_ROPE), (bf16*)(R + R_OG), (float*)(R + R_LSE), lds, wv); );
    GRID_BAR();
    PHASE(5, WS_R_PTRS
        ph_dnprep((const bf16*)(R + R_PD), (const float*)(R + R_AB), PIN(10) + (size_t)l * 5 * 2304, PIN(11) + l * 12, PIN(12) + l * 12, (bf16*)(R + R_QKVD), (float*)(R + R_GB),
                  (const bf16*)(R + R_OG), (const float*)(R + R_LSE), (bf16*)(R + R_OATT), wv); );
    GRID_BAR();
    PHASE(6, WS_R_PTRS
        ph_dn_pre((const bf16*)(R + R_QKVD), (const float*)(R + R_GB), (bf16*)(R + R_TINV), (bf16*)(R + R_ATTN), (float*)(R + R_VEC), lds_raw, wv); );
    GRID_BAR();
    PHASE(7, WS_R_PTRS
        ph_dn_scan<1>((const bf16*)(R + R_QKVD), (const bf16*)(R + R_TINV), (const bf16*)(R + R_ATTN), (const float*)(R + R_VEC), (bf16*)(R + R_ODIR0), (bf16*)(R + R_ODIR1), (float*)(ws + WS_W + W_FFIN0), lds, wv); );
    GRID_BAR();
    PHASE(13, WS_R_PTRS
        ph_dn_scan<2>((const bf16*)(R + R_QKVD), (const bf16*)(R + R_TINV), (const bf16*)(R + R_ATTN), (const float*)(R + R_VEC), (bf16*)(R + R_ODIR0), (bf16*)(R + R_ODIR1), (float*)(ws + WS_W + W_FFIN0), lds, wv); );
    GRID_BAR();
    PHASE(8, WS_R_PTRS
        pg8::EpiBf16P E; E.O = (bf16*)(R + R_PG); E.ldc = 2048; E.pad_ = 0;
        run_gemm(lds, (const bf16*)(ws + WS_H), (const bf16*)(ws + WS_W + W_IN) + (size_t)5632 * 1024, 2048, 1024, E, wv); );
    PHASE(9, WS_R_PTRS
        ph_final((const bf16*)(R + R_ODIR0), (const bf16*)(R + R_ODIR1), (const bf16*)(R + R_PZ), PIN(13) + l * 128, (bf16*)(R + R_ODN), wv); );
    GRID_BAR();
    PHASE(10, { WS_R_PTRS
        pg8::EpiGateF32 E; E.O = (float*)(R + R_T1); E.gate = (const bf16*)(R + R_PG); E.ldg = 2048; E.pad_ = 0;
        run_gemm(lds, (const bf16*)(R + R_OATT), (const bf16*)(ws + WS_W + W_BATT), 1024, 256, E, wv); }
        { WS_R_PTRS
        pg8::EpiGateAddBf16 E; E.O = (bf16*)(ws + WS_H); E.T1 = (const float*)(R + R_T1); E.gate = (const bf16*)(R + R_PG) + 1024; E.ldg = 2048; E.pad_ = 0;
        run_gemm(lds, (const bf16*)(R + R_ODN), (const bf16*)(ws + WS_W + W_BDN), 1024, 768, E, wv); } );
    GRID_BAR();
    PHASE(11, WS_R_PTRS
        pg8::EpiBf16P E; E.O = (bf16*)(R + R_Y2); E.ldc = 1024; E.pad_ = 0; run_gemm(lds, (const bf16*)(ws + WS_H), (const bf16*)(ws + WS_W + W_OUT), 1024, 1024, E, wv); );
    GRID_BAR();
    {   WS_R_PTRS const float* mod = (const float*)(ws + WS_MOD) + l * 9216;
        RowArgs a; a.xi = POUT; a.y = (const bf16*)(R + R_Y2); a.xo = POUT; a.h = (bf16*)(ws + WS_H); a.wpost = PIN(6) + (l * 3 + 1) * 1024; a.gate = mod + (1 * 3 + 2) * 1024; a.coef = 1.0f;
        a.wpre = PIN(5) + (l * 3 + 2) * 1024; a.shift = mod + (2 * 3 + 0) * 1024; a.scale = mod + (2 * 3 + 1) * 1024; ph_rows(a, wv); }
    GRID_BAR();
}
__global__ void __launch_bounds__(NTHREADS, 2) mega_fwd(Params P) {
    extern __shared__ __attribute__((aligned(16))) unsigned char lds_raw[];
    LAS unsigned char* lds = (LAS unsigned char*)lds_raw;
    const int wv = __builtin_amdgcn_readfirstlane((int)threadIdx.x >> 6);
    { const int tid0 = threadIdx.x;
      for (int u = tid0; u < (LDS_BYTES - LDS_CTL_OFF) / 4; u += NTHREADS) ((LAS unsigned*)(lds + LDS_CTL_OFF))[u] = 0u;
      __syncthreads();
      XcdBarrier b0 = xcd_barrier_post((unsigned*)(PWS + WS_CTL) + CW_BAR, (volatile LAS unsigned*)(lds + LDS_CTL_OFF + 320) + 8);
      if (tid0 == 0) ((volatile LAS unsigned*)(lds + LDS_CTL_OFF + 320))[10] = b0.x;
      __syncthreads(); }
    PHASE(0, ph_ada(lds_raw, wv); ph_rope(wv); ph_convert(0, lds_raw, wv); );
    GRID_BAR();
    PHASE(12, WS_R_PTRS float* MOD = (float*)(ws + WS_MOD);
      RowArgs a; a.xi = PIN(0); a.y = nullptr; a.xo = nullptr; a.h = (bf16*)(ws + WS_H); a.wpost = nullptr; a.gate = nullptr; a.wpre = PIN(5); a.shift = MOD; a.scale = MOD + 1024; a.coef = 0.f; ph_rows(a, wv); );
    GRID_BAR();
    ffn_block<0, 0>(lds, lds_raw, wv); mixer_block<0>(lds, lds_raw, wv); ffn_block<0, 1>(lds, lds_raw, wv);
    ffn_block<1, 0>(lds, lds_raw, wv); mixer_block<1>(lds, lds_raw, wv); ffn_block<1, 1>(lds, lds_raw, wv);
}

extern "C" void kernel_launch(void* const* d_in, const int* in_sizes, int n_in, void* d_out, int out_size, void* d_ws, size_t ws_size, hipStream_t stream) {
    static int grid = 0;
    if (grid == 0) {
        if (n_in != 17 || ws_size < WS_END) { fprintf(stderr, "kernel_launch: unexpected n_in %d / ws_size %zu\n", n_in, ws_size); grid = -1; return; }
        int dev = 0, cus = 0, per_cu = 0;
        if (hipGetDevice(&dev) != hipSuccess || hipDeviceGetAttribute(&cus, hipDeviceAttributeMultiprocessorCount, dev) != hipSuccess) { grid = -1; return; }
        if (hipFuncSetAttribute((const void*)mega_fwd, hipFuncAttributeMaxDynamicSharedMemorySize, LDS_BYTES) != hipSuccess) { fprintf(stderr, "kernel_launch: hipFuncSetAttribute failed\n"); grid = -1; return; }
        if (hipOccupancyMaxActiveBlocksPerMultiprocessor(&per_cu, (const void*)mega_fwd, NTHREADS, LDS_BYTES) != hipSuccess || per_cu < 1) { fprintf(stderr, "kernel_launch: occupancy query says %d\n", per_cu); per_cu = 1; }
        (void)hipGetLastError();
        grid = cus;
        if (grid > 256) grid = 256;
    }
    if (grid < 0) return;
    (void)hipMemsetAsync((char*)d_ws + WS_CTL, 0, 1 * MiB, stream);
    Params p{};
    for (int i = 0; i < 17; ++i) p.in[i] = (const float*)d_in[i];
    p.out = (float*)d_out; p.ws = (unsigned char*)d_ws;
    hipLaunchKernelGGL(mega_fwd, dim3(grid), dim3(NTHREADS), LDS_BYTES, stream, p);
}
```

```cpp
#include <hip/hip_runtime.h>
#include <cstdio>
#include <cstdint>
__device__ __forceinline__ int lane_id_() { int l; asm volatile("v_mbcnt_lo_u32_b32 %0, -1, 0\n\tv_mbcnt_hi_u32_b32 %0, -1, %0" : "=v"(l)); return l; }
namespace pg8 {
#define PG8_LAS __attribute__((address_space(3)))
typedef unsigned short bf16_t;
typedef short bf16x8 __attribute__((ext_vector_type(8)));
typedef float f32x4 __attribute__((ext_vector_type(4)));
typedef unsigned u32x4 __attribute__((ext_vector_type(4)));
constexpr int BM = 256, BK = 64, HALF = 128, HTB = HALF * BK * 2  , STAGE_BYTES = 8 * HTB, NXCD = 8, WGM = 8;

__host__ __device__ __forceinline__ int lds_byte(int r, int c) { const int st = (r >> 4) * 2 + (c >> 5), rr = r & 15, cc = c & 31, ob = rr * 64 + cc * 2; return st * 1024 + (ob ^ (((ob >> 9) & 1) << 5)); }
__host__ __device__ __forceinline__ void stage_rc(int b, int& R, int& C) { const int st = b / 1024, sb = b % 1024, swz = sb ^ (((sb >> 9) & 1) << 5); R = (st >> 1) * 16 + swz / 64; C = (st & 1) * 32 + (swz % 64) / 2; }
__host__ __device__ __forceinline__ int perm32(int rho) { const int n = rho >> 4, i = rho & 15; return 8 * (i >> 2) + 4 * n + (i & 3); }

struct Unit { int pm, pn; };
struct Gemm { const bf16_t* A; const bf16_t* Bt; int M, N, K, pad_; };

struct StaticOrder {
    int nM, nN, nwg, G, c;
    __host__ __device__ void init(int M, int N, int G_, int c_) { nM = M / BM; nN = N / BM; nwg = nM * nN; G = G_; c = c_; }
    __host__ __device__ bool next(int i, Unit& u) const {
        const long L = (long)i * G + c; if (L >= nwg) return false;
        int wgid = (int)L; { const int q = nwg / NXCD, r = nwg % NXCD, xcd = wgid % NXCD, off = wgid / NXCD; wgid = (xcd < r ? xcd * (q + 1) : r * (q + 1) + (xcd - r) * q) + off; }
        const int nig = WGM * nN, gid = wgid / nig, fm = gid * WGM, gsz = (nM - fm) < WGM ? (nM - fm) : WGM;
        u.pm = fm + ((wgid % nig) % gsz); u.pn = (wgid % nig) / gsz; return true;
    }
    __device__ __forceinline__ void a_ready(const Unit&) const {}
    __device__ __forceinline__ void done(const Unit&) const {}
};

__device__ __forceinline__ unsigned cvt_pk_bf16(float lo, float hi) { unsigned r; asm volatile("v_cvt_pk_bf16_f32 %0, %1, %2" : "=v"(r) : "v"(lo), "v"(hi)); return r; }
typedef float f32x2 __attribute__((ext_vector_type(2)));
__device__ __forceinline__ f32x2 gelu_pk(f32x2 v) {
    const f32x2 av = __builtin_elementwise_abs(v), d = av * 0.2316418882f + 1.0f;
    f32x2 t; t.x = __builtin_amdgcn_rcpf(d.x); t.y = __builtin_amdgcn_rcpf(d.y);
    f32x2 q = t * 0.5307027145f + (-0.7265760135f); q = q * t + 0.7107068705f; q = q * t + (-0.142248368f); q = q * t + 0.127414796f; q = q * t;
    const f32x2 s = (v * v) * (-0.72134752044f);
    f32x2 e; e.x = __builtin_amdgcn_exp2f(s.x); e.y = __builtin_amdgcn_exp2f(s.y);
    const f32x2 m = v * (q * e), r = v - m;
    f32x2 o; o.x = v.x < 0.f ? m.x : r.x; o.y = v.y < 0.f ? m.y : r.y; return o;
}

template <int ACT  > struct EpiBf16 {
    static constexpr bool PERM = true, AFTER_DRAIN = false; static_assert(ACT == 0 || ACT == 1, "EpiBf16: ACT is 0 (none) or 1 (gelu_pk)");
    bf16_t* O; int ldc; const float* bias; int split_cols; size_t split_stride; float scale0;
    __device__ __forceinline__ void operator()(const f32x4 (&acc)[2][2][4][2], const Unit& u, int wr, int wc, int fr, int fq) const {
        const int row0 = u.pm * BM + wr * 64 + fr; int colt = u.pn * BM; bf16_t* base = O;
        float sc = 1.f; if (split_cols) { const int t = colt / split_cols; base += (size_t)t * split_stride; colt -= t * split_cols; if (t == 0) sc = scale0; }
        const int col0 = colt + wc * 32 + 8 * fq, bcol0 = u.pn * BM + wc * 32 + 8 * fq;
        f32x4 bv[2][2];
#pragma unroll
        for (int bj = 0; bj < 2; ++bj)
#pragma unroll
            for (int n = 0; n < 2; ++n) bv[bj][n] = bias ? *(const f32x4*)(bias + bcol0 + bj * HALF + 4 * n) : (f32x4){0.f, 0.f, 0.f, 0.f};
#pragma unroll
        for (int ai = 0; ai < 2; ++ai)
#pragma unroll
            for (int m = 0; m < 4; ++m) { bf16_t* rowp = base + (size_t)(row0 + ai * HALF + m * 16) * ldc + col0;
#pragma unroll
                for (int bj = 0; bj < 2; ++bj) { f32x4 v0 = acc[ai][bj][m][0] + bv[bj][0], v1 = acc[ai][bj][m][1] + bv[bj][1];
                    if (ACT == 1) { f32x2 a = gelu_pk((f32x2){v0[0], v0[1]}), b = gelu_pk((f32x2){v0[2], v0[3]}), c = gelu_pk((f32x2){v1[0], v1[1]}), d = gelu_pk((f32x2){v1[2], v1[3]});
                        v0 = (f32x4){a.x, a.y, b.x, b.y}; v1 = (f32x4){c.x, c.y, d.x, d.y}; }
                    v0 = v0 * sc; v1 = v1 * sc; u32x4 w; w.x = cvt_pk_bf16(v0[0], v0[1]); w.y = cvt_pk_bf16(v0[2], v0[3]); w.z = cvt_pk_bf16(v1[0], v1[1]); w.w = cvt_pk_bf16(v1[2], v1[3]);
                    *(u32x4*)(rowp + bj * HALF) = w; } }
    }
};

struct PanelStats {
    unsigned* xbuf;
    unsigned* cnt;
    unsigned* tmo;
    int ntn; float eps;
    unsigned code;
    __device__ __forceinline__ bool run(const f32x4 (&v)[2][2][4][2], const Unit& u, int wr, int wc, int fr, int fq, PG8_LAS unsigned char* lds, int wid, int lane) const {
        typedef float f32x2v __attribute__((ext_vector_type(2)));
        PG8_LAS f32x2v* P = (PG8_LAS f32x2v*)lds;
        PG8_LAS f32x2v* S = (PG8_LAS f32x2v*)(lds + 8192);
        PG8_LAS unsigned* flag = (PG8_LAS unsigned*)(lds + 8192 + 2048);
#pragma unroll
        for (int ai = 0; ai < 2; ++ai)
#pragma unroll
            for (int m = 0; m < 4; ++m) {
                float s = 0.f;
#pragma unroll
                for (int bj = 0; bj < 2; ++bj)
#pragma unroll
                    for (int n = 0; n < 2; ++n) { const f32x4 x = v[ai][bj][m][n]; s += (x[0] + x[1]) + (x[2] + x[3]); }
                s += __shfl_xor(s, 16); s += __shfl_xor(s, 32);
                const float mw = s * (1.0f / 64.0f); float q = 0.f;
#pragma unroll
                for (int bj = 0; bj < 2; ++bj)
#pragma unroll
                    for (int n = 0; n < 2; ++n) { const f32x4 d = v[ai][bj][m][n] - mw; q += (d[0] * d[0] + d[1] * d[1]) + (d[2] * d[2] + d[3] * d[3]); }
                q += __shfl_xor(q, 16); q += __shfl_xor(q, 32);
                if (fq == 0) P[(ai * HALF + wr * 64 + m * 16 + fr) * 4 + wc] = (f32x2v){mw, q};
            }
        asm volatile("s_waitcnt lgkmcnt(0)" ::: "memory"); __builtin_amdgcn_s_barrier(); asm volatile("" ::: "memory");
#if defined(BROKEN_EXCHANGE_NO_WAIT)
#warning BROKEN CONTROL BUILD: the row-statistics exchange does not wait; results are wrong by design
        if (blockIdx.x >= 64) { const long long t0_ = clock64(); while (clock64() - t0_ < 60000) __builtin_amdgcn_s_sleep(8); }
#endif
        const int row = wid * 32 + (lane & 31);
        if (lane < 32) {
            const f32x2v a = P[row * 4 + 0], b = P[row * 4 + 1], c = P[row * 4 + 2], d = P[row * 4 + 3];
            const float mt = (a.x + b.x + c.x + d.x) * 0.25f;
            const float da = a.x - mt, db = b.x - mt, dc = c.x - mt, dd = d.x - mt;
            const float m2 = (a.y + b.y) + (c.y + d.y) + 64.0f * ((da * da + db * db) + (dc * dc + dd * dd));
            unsigned long long* slot = (unsigned long long*)xbuf + ((size_t)(u.pm * BM + row) * 4 + u.pn);
            __hip_atomic_store(slot, ((unsigned long long)__float_as_uint(m2) << 32) | __float_as_uint(mt), __ATOMIC_RELAXED, __HIP_MEMORY_SCOPE_AGENT);
        }
        asm volatile("s_waitcnt vmcnt(0)" ::: "memory");
        if (lane == 0) __hip_atomic_fetch_add(cnt + 64 * u.pm, 1u, __ATOMIC_RELAXED, __HIP_MEMORY_SCOPE_AGENT);
        if (wid == 0) {
            bool dead = false; const unsigned long long t0 = __builtin_amdgcn_s_memrealtime(); const unsigned want = 8u * (unsigned)ntn;
            for (;;) {
#if defined(BROKEN_EXCHANGE_NO_WAIT)
                break;
#endif
                if ((unsigned)__builtin_amdgcn_readfirstlane(__hip_atomic_load(cnt + 64 * u.pm, __ATOMIC_RELAXED, __HIP_MEMORY_SCOPE_AGENT)) >= want) break;
                if (__builtin_amdgcn_s_memrealtime() - t0 > 2000000ull) {
                    if (lane == 0) { unsigned expect = 0u; __hip_atomic_compare_exchange_strong(tmo + 1, &expect, code | (unsigned)(u.pm & 0xff), __ATOMIC_RELAXED, __ATOMIC_RELAXED, __HIP_MEMORY_SCOPE_AGENT);
                                     __hip_atomic_store(tmo, 1u, __ATOMIC_RELAXED, __HIP_MEMORY_SCOPE_AGENT); }
                    dead = true; break; }
                __builtin_amdgcn_s_sleep(2);
            }
            __builtin_amdgcn_fence(__ATOMIC_ACQUIRE, "agent");
            if (lane == 0) flag[0] = dead ? 1u : 0u;
        }
        asm volatile("s_waitcnt vmcnt(0) lgkmcnt(0)" ::: "memory"); __builtin_amdgcn_s_barrier(); asm volatile("" ::: "memory");
        const bool bad = flag[0] != 0u;
        if (lane < 32) {
            const unsigned long long* slot = (const unsigned long long*)xbuf + (size_t)(u.pm * BM + row) * 4; float mt[4], m2[4]; float ms = 0.f;
#pragma unroll
            for (int t = 0; t < 4; ++t) { if (t < ntn) { const unsigned long long w = __hip_atomic_load(slot + t, __ATOMIC_RELAXED, __HIP_MEMORY_SCOPE_AGENT); mt[t] = __uint_as_float((unsigned)w); m2[t] = __uint_as_float((unsigned)(w >> 32)); } else { mt[t] = 0.f; m2[t] = 0.f; } ms += mt[t]; }
            const float mean = ms / (float)ntn; float q = 0.f;
#pragma unroll
            for (int t = 0; t < 4; ++t) if (t < ntn) { const float dm = mt[t] - mean; q += m2[t] + 256.0f * dm * dm; }
            S[row] = (f32x2v){mean, 1.0f / sqrtf(q / (256.0f * (float)ntn) + eps)};
        }
        asm volatile("s_waitcnt lgkmcnt(0)" ::: "memory"); __builtin_amdgcn_s_barrier(); asm volatile("" ::: "memory");
        return bad;
    }
};
struct EpiLnRes {
    static constexpr bool PERM = false, AFTER_DRAIN = true;
    const float* base; float* out; int ldc; const float* bias; PanelStats st; unsigned poison;
    __device__ __forceinline__ void fused(f32x4 (&acc)[2][2][4][2], const Unit& u, int wr, int wc, int fr, int fq, PG8_LAS unsigned char* lds, int wid, int lane) const {
        typedef float f32x2v __attribute__((ext_vector_type(2)));
        const PG8_LAS f32x2v* S = (const PG8_LAS f32x2v*)(lds + 8192);
        const int col0 = u.pn * BM + wc * 32 + 4 * fq;
#pragma unroll
        for (int bj = 0; bj < 2; ++bj)
#pragma unroll
            for (int n = 0; n < 2; ++n) { const f32x4 bv = bias ? *(const f32x4*)(bias + col0 + bj * HALF + n * 16) : (f32x4){0.f, 0.f, 0.f, 0.f};
#pragma unroll
                for (int ai = 0; ai < 2; ++ai)
#pragma unroll
                    for (int m = 0; m < 4; ++m) acc[ai][bj][m][n] += bv; }
        f32x4 pre[4][2][2];
#pragma unroll
        for (int m = 0; m < 4; ++m) { const size_t off = (size_t)(u.pm * BM + wr * 64 + m * 16 + fr) * ldc + col0;
#pragma unroll
            for (int bj = 0; bj < 2; ++bj)
#pragma unroll
                for (int n = 0; n < 2; ++n) pre[m][bj][n] = *(const f32x4*)(base + off + bj * HALF + n * 16); }
        const bool bad = st.run(acc, u, wr, wc, fr, fq, lds, wid, lane) || poison != 0u;
        const float qnan = __builtin_nanf("");
#pragma unroll
        for (int ai = 0; ai < 2; ++ai)
#pragma unroll
            for (int m = 0; m < 4; ++m) { const int r = ai * HALF + wr * 64 + m * 16 + fr; const f32x2v sr = S[r]; const size_t off = (size_t)(u.pm * BM + r) * ldc + col0;
#pragma unroll
                for (int bj = 0; bj < 2; ++bj)
#pragma unroll
                    for (int n = 0; n < 2; ++n) { const f32x4 bs = ai == 0 ? pre[m][bj][n] : *(const f32x4*)(base + off + bj * HALF + n * 16); f32x4 o = bs + (acc[ai][bj][m][n] - sr.x) * sr.y;
                        if (bad) o = (f32x4){qnan, qnan, qnan, qnan}; *(f32x4*)(out + off + bj * HALF + n * 16) = o; }
                if (m & 1) asm volatile("" ::: "memory"); }
    }
};
struct EpiLnResLn {
    static constexpr bool PERM = false, AFTER_DRAIN = true;
    const float* base; float* out; bf16_t* xn; int ldc; const float* bias; PanelStats st1, st2; unsigned poison;
    __device__ __forceinline__ void fused(f32x4 (&acc)[2][2][4][2], const Unit& u, int wr, int wc, int fr, int fq, PG8_LAS unsigned char* lds, int wid, int lane) const {
        typedef float f32x2v __attribute__((ext_vector_type(2))); typedef unsigned u32x2v __attribute__((ext_vector_type(2)));
        const PG8_LAS f32x2v* S = (const PG8_LAS f32x2v*)(lds + 8192);
        const int col0 = u.pn * BM + wc * 32 + 4 * fq;
#pragma unroll
        for (int bj = 0; bj < 2; ++bj)
#pragma unroll
            for (int n = 0; n < 2; ++n) { const f32x4 bv = bias ? *(const f32x4*)(bias + col0 + bj * HALF + n * 16) : (f32x4){0.f, 0.f, 0.f, 0.f};
#pragma unroll
                for (int ai = 0; ai < 2; ++ai)
#pragma unroll
                    for (int m = 0; m < 4; ++m) acc[ai][bj][m][n] += bv; }
        bool bad = st1.run(acc, u, wr, wc, fr, fq, lds, wid, lane) || poison != 0u;
        const float qnan = __builtin_nanf("");
#pragma unroll
        for (int ai = 0; ai < 2; ++ai)
#pragma unroll
            for (int m = 0; m < 4; ++m) { const int r = ai * HALF + wr * 64 + m * 16 + fr; const f32x2v sr = S[r]; const size_t off = (size_t)(u.pm * BM + r) * ldc + col0;
#pragma unroll
                for (int bj = 0; bj < 2; ++bj)
#pragma unroll
                    for (int n = 0; n < 2; ++n) { const f32x4 bs = *(const f32x4*)(base + off + bj * HALF + n * 16); acc[ai][bj][m][n] = bs + (acc[ai][bj][m][n] - sr.x) * sr.y; }
                asm volatile("" : "+v"(acc[ai][0][m][0]), "+v"(acc[ai][0][m][1]), "+v"(acc[ai][1][m][0]), "+v"(acc[ai][1][m][1]));
                if (m & 1) asm volatile("" ::: "memory"); }
        const bool bad1 = bad;
        bad = st2.run(acc, u, wr, wc, fr, fq, lds, wid, lane) || bad;
#pragma unroll
        for (int ai = 0; ai < 2; ++ai)
#pragma unroll
            for (int m = 0; m < 4; ++m) { const int r = ai * HALF + wr * 64 + m * 16 + fr; const f32x2v sr = S[r]; const size_t off = (size_t)(u.pm * BM + r) * ldc + col0;
#pragma unroll
                for (int bj = 0; bj < 2; ++bj)
#pragma unroll
                    for (int n = 0; n < 2; ++n) { const f32x4 x1 = acc[ai][bj][m][n]; *(f32x4*)(out + off + bj * HALF + n * 16) = bad1 ? (f32x4){qnan, qnan, qnan, qnan} : x1;
                        const f32x4 o = (x1 - sr.x) * sr.y; u32x2v w; w.x = cvt_pk_bf16(o[0], o[1]); w.y = cvt_pk_bf16(o[2], o[3]);
                        if (bad) { w.x = 0x7fc07fc0u; w.y = 0x7fc07fc0u; } *(u32x2v*)(xn + off + bj * HALF + n * 16) = w; }
                asm volatile("" ::: "memory"); }
    }
};

template <class Epi, class Sched, bool ALIGN_EPI = false, bool SP2 = false>
__device__ __forceinline__ void gemm_phase(PG8_LAS unsigned char* lds, const Gemm g, const Sched& S, const Epi& E, int wv) {
    int tid_ = wv * 64 + lane_id_(); asm volatile("" : "+v"(tid_));
    const int tid = tid_, wid = __builtin_amdgcn_readfirstlane(tid >> 6), lane = tid & 63, wr = wid >> 2, wc = wid & 3, fr = lane & 15, fq = lane >> 4;
    const int K = g.K, nt = K / BK;
    unsigned voffA[2], voffB[2];
#pragma unroll
    for (int i = 0; i < 2; ++i) { int R, C; stage_rc(tid * 16 + i * 8192, R, C); const int Rb = Epi::PERM ? ((R & ~31) + perm32(R & 31)) : R;
        voffA[i] = (unsigned)(R * K + C) * 2u; voffB[i] = (unsigned)(Rb * K + C) * 2u; }
    const size_t kstep = (size_t)(BK * 2);
    const size_t hstep = (size_t)HALF * K * 2;
    const size_t tstep = 2 * hstep;
    const unsigned ldsw = (unsigned)wid * 1024u;
    const int aoff = lds_byte(wr * 64 + fr, fq * 8), boff = lds_byte(wc * 32 + fr, fq * 8);
#define PG8_SA(b, h) (((b) * 2 + (h)) * HTB)
#define PG8_SB(b, h) ((4 + (b) * 2 + (h)) * HTB)
#define PG8_STAGE(bufoff, gbase, voff) do { _Pragma("unroll") for (int _i = 0; _i < 2; ++_i) \
        __builtin_amdgcn_global_load_lds((const unsigned*)((const char*)(gbase) + (voff)[_i]), (PG8_LAS unsigned*)(lds + (bufoff) + ldsw + _i * 8192), 16, 0, 0); } while (0)
#define PG8_LDA(dst, b, h) do { _Pragma("unroll") for (int m = 0; m < 4; ++m) _Pragma("unroll") for (int k = 0; k < 2; ++k) dst[m][k] = *(const PG8_LAS bf16x8*)(lds + PG8_SA(b, h) + aoff + m * 2048 + k * 1024); } while (0)
#define PG8_LDB(dst, b, h) do { _Pragma("unroll") for (int n = 0; n < 2; ++n) _Pragma("unroll") for (int k = 0; k < 2; ++k) dst[n][k] = *(const PG8_LAS bf16x8*)(lds + PG8_SB(b, h) + boff + n * 2048 + k * 1024); } while (0)
#define PG8_MMA(ai, bj, At, Bt) do { __builtin_amdgcn_s_setprio(1); _Pragma("unroll") for (int m = 0; m < 4; ++m) _Pragma("unroll") for (int n = 0; n < 2; ++n) _Pragma("unroll") for (int k = 0; k < 2; ++k) \
        acc[ai][bj][m][n] = __builtin_amdgcn_mfma_f32_16x16x32_bf16(Bt[n][k], At[m][k], acc[ai][bj][m][n], 0, 0, 0); __builtin_amdgcn_s_setprio(0); } while (0)
#define PG8_WAIT_V(n) asm volatile("s_waitcnt vmcnt(" #n ")" ::: "memory")
#define PG8_WAIT_L(n) asm volatile("s_waitcnt lgkmcnt(" #n ")" ::: "memory")
#define PG8_BAR __builtin_amdgcn_s_barrier()
#define PG8_SCHED __builtin_amdgcn_sched_barrier(0)
    Unit cur, nxt; int ui = 0;
    if (!S.next(0, cur)) return;
    f32x4 acc[2][2][4][2];
#pragma unroll
    for (int a = 0; a < 2; ++a)
#pragma unroll
        for (int b = 0; b < 2; ++b)
#pragma unroll
            for (int m = 0; m < 4; ++m)
#pragma unroll
                for (int n = 0; n < 2; ++n) acc[a][b][m][n] = (f32x4){0.f, 0.f, 0.f, 0.f};
    bf16x8 At[4][2], B0[2][2], B1[2][2];
    const char* cA = (const char*)g.A + (size_t)cur.pm * tstep; const char* cB = (const char*)g.Bt + (size_t)cur.pn * tstep;
    S.a_ready(cur);
    if constexpr (SP2) {
        PG8_STAGE(PG8_SB(0, 0), cB, voffB); PG8_STAGE(PG8_SB(0, 1), cB + hstep, voffB); PG8_STAGE(PG8_SA(0, 0), cA, voffA); PG8_STAGE(PG8_SA(0, 1), cA + hstep, voffA);
        if (wr == 1) PG8_BAR;
        PG8_WAIT_V(2); PG8_BAR;
        PG8_STAGE(PG8_SB(1, 0), cB + kstep, voffB); PG8_STAGE(PG8_SA(1, 0), cA + kstep, voffA); PG8_STAGE(PG8_SB(1, 1), cB + hstep + kstep, voffB);
        PG8_WAIT_V(6); PG8_BAR;
    } else {
        PG8_STAGE(PG8_SB(0, 0), cB, voffB); PG8_STAGE(PG8_SA(0, 0), cA, voffA); PG8_STAGE(PG8_SB(0, 1), cB + hstep, voffB); PG8_STAGE(PG8_SA(0, 1), cA + hstep, voffA);
        if (wr == 1) PG8_BAR;
        PG8_WAIT_V(4); PG8_BAR;
        PG8_STAGE(PG8_SB(1, 0), cB + kstep, voffB); PG8_STAGE(PG8_SA(1, 0), cA + kstep, voffA); PG8_STAGE(PG8_SB(1, 1), cB + hstep + kstep, voffB);
        PG8_WAIT_V(6); PG8_BAR;
    }
    for (;;) {
        const bool has_next = S.next(ui + 1, nxt);
        const char* nA = has_next ? (const char*)g.A + (size_t)nxt.pm * tstep : cA; const char* nB = has_next ? (const char*)g.Bt + (size_t)nxt.pn * tstep : cB;
        for (int t = 0; t < nt; t += 2) {
            const bool last = (t == nt - 2);
            const char* a1 = cA + (size_t)(t + 1) * kstep;
            const char* a2 = last ? nA : cA + (size_t)(t + 2) * kstep; const char* b2 = last ? nB : cB + (size_t)(t + 2) * kstep;
            const char* a3 = a2 + kstep; const char* b3 = b2 + kstep;
            if (last && has_next) S.a_ready(nxt);
            if constexpr (SP2) {
            PG8_LDB(B0, 0, 0); PG8_LDB(B1, 0, 1); PG8_SCHED; PG8_LDA(At, 0, 0); PG8_STAGE(PG8_SA(1, 1), a1 + hstep, voffA);
            PG8_WAIT_V(8); PG8_WAIT_L(0); PG8_BAR; PG8_MMA(0, 0, At, B0); PG8_MMA(0, 1, At, B1); PG8_BAR; PG8_SCHED;
            PG8_LDA(At, 0, 1); PG8_STAGE(PG8_SB(0, 0), b2, voffB); PG8_STAGE(PG8_SB(0, 1), b2 + hstep, voffB); PG8_STAGE(PG8_SA(0, 0), a2, voffA);
            PG8_WAIT_V(8); PG8_WAIT_L(0); PG8_BAR; PG8_MMA(1, 0, At, B0); PG8_MMA(1, 1, At, B1); PG8_BAR; PG8_SCHED;
            PG8_LDB(B0, 1, 0); PG8_LDB(B1, 1, 1); PG8_SCHED; PG8_LDA(At, 1, 0); PG8_STAGE(PG8_SA(0, 1), a2 + hstep, voffA);
            PG8_WAIT_V(8); PG8_WAIT_L(0); PG8_BAR; PG8_MMA(0, 0, At, B0); PG8_MMA(0, 1, At, B1); PG8_BAR; PG8_SCHED;
            PG8_LDA(At, 1, 1); PG8_STAGE(PG8_SB(1, 0), b3, voffB); PG8_STAGE(PG8_SB(1, 1), b3 + hstep, voffB); PG8_STAGE(PG8_SA(1, 0), a3, voffA);
            PG8_WAIT_V(8); PG8_WAIT_L(0); PG8_BAR; PG8_MMA(1, 0, At, B0); PG8_MMA(1, 1, At, B1); PG8_BAR; PG8_SCHED;
            } else {
            PG8_LDB(B0, 0, 0); PG8_SCHED; PG8_LDA(At, 0, 0); PG8_STAGE(PG8_SA(1, 1), a1 + hstep, voffA);
            PG8_WAIT_L(8); PG8_BAR; PG8_WAIT_L(0); PG8_MMA(0, 0, At, B0); PG8_BAR; PG8_SCHED;
            PG8_LDB(B1, 0, 1); PG8_STAGE(PG8_SB(0, 0), b2, voffB);
            PG8_BAR; PG8_WAIT_L(0); PG8_MMA(0, 1, At, B1); PG8_BAR;
            PG8_LDA(At, 0, 1); PG8_STAGE(PG8_SA(0, 0), a2, voffA);
            PG8_BAR; PG8_WAIT_L(0); PG8_MMA(1, 0, At, B0); PG8_BAR; PG8_SCHED;
            PG8_STAGE(PG8_SB(0, 1), b2 + hstep, voffB);
            PG8_WAIT_V(6); PG8_BAR; PG8_MMA(1, 1, At, B1); PG8_BAR;
            PG8_LDB(B0, 1, 0); PG8_SCHED; PG8_LDA(At, 1, 0); PG8_STAGE(PG8_SA(0, 1), a2 + hstep, voffA);
            PG8_WAIT_L(8); PG8_BAR; PG8_WAIT_L(0); PG8_MMA(0, 0, At, B0); PG8_BAR; PG8_SCHED;
            PG8_LDB(B1, 1, 1); PG8_STAGE(PG8_SB(1, 0), b3, voffB);
            PG8_BAR; PG8_WAIT_L(0); PG8_MMA(0, 1, At, B1); PG8_BAR;
            PG8_LDA(At, 1, 1); PG8_STAGE(PG8_SA(1, 0), a3, voffA);
            PG8_BAR; PG8_WAIT_L(0); PG8_MMA(1, 0, At, B0); PG8_BAR; PG8_SCHED;
            PG8_STAGE(PG8_SB(1, 1), b3 + hstep, voffB);
            PG8_WAIT_V(6); PG8_BAR; PG8_MMA(1, 1, At, B1); PG8_BAR;
            }
        }
        if constexpr (ALIGN_EPI) { if (wr == 0) PG8_BAR; }
        if constexpr (!Epi::AFTER_DRAIN) { E(acc, cur, wr, wc, fr, fq); S.done(cur); }
        if (!has_next) break;
#pragma unroll
        for (int a = 0; a < 2; ++a)
#pragma unroll
            for (int b = 0; b < 2; ++b)
#pragma unroll
                for (int m = 0; m < 4; ++m)
#pragma unroll
                    for (int n = 0; n < 2; ++n) acc[a][b][m][n] = (f32x4){0.f, 0.f, 0.f, 0.f};
        cur = nxt; cA = nA; cB = nB; ++ui;
        if constexpr (ALIGN_EPI) { if (wr == 1) PG8_BAR; }
    }
    PG8_WAIT_V(0);
    if constexpr (!ALIGN_EPI) { if (wr == 0) PG8_BAR; }
    PG8_BAR;
    if constexpr (Epi::AFTER_DRAIN) { E.fused(acc, cur, wr, wc, fr, fq, lds, wid, lane); S.done(cur); }
#undef PG8_SA
#undef PG8_SB
#undef PG8_STAGE
#undef PG8_LDA
#undef PG8_LDB
#undef PG8_MMA
#undef PG8_WAIT_V
#undef PG8_WAIT_L
#undef PG8_BAR
#undef PG8_SCHED
}
}
constexpr int S_ = 16384, D_ = 1024, FF_ = 2816, NIN_ = 7448, NINP_ = 7680;
constexpr int NTHREADS = 512;
constexpr size_t MiB = 1u << 20;
constexpr size_t WS_CTL = 0;
constexpr size_t WS_MOD = 1 * MiB;
constexpr size_t WS_ROPE = 2 * MiB;
constexpr size_t WS_W = 6 * MiB;
constexpr size_t W_FFIN0 = 0, W_FFIN1 = 11 * MiB, W_FFOUT0 = 22 * MiB, W_FFOUT1 = 27 * MiB + MiB / 2, W_IN = 33 * MiB, W_BATT = 48 * MiB, W_BDN = 48 * MiB + MiB / 2, W_OUT = 50 * MiB;
constexpr size_t WS_H = 58 * MiB;
constexpr size_t WS_R = 90 * MiB;
constexpr size_t R_ACT = 0, R_Y = 88 * MiB;
constexpr size_t R_PA = 0, R_QKVD = 0, R_PG = 0, R_PD = 72 * MiB, R_TINV = 72 * MiB, R_ODIR1 = 120 * MiB, R_ODN = 72 * MiB, R_T1 = 96 * MiB, R_PZ = 144 * MiB, R_AB = 168 * MiB, R_GB = 170 * MiB,
                 R_OATT = 172 * MiB, R_ATTN = 180 * MiB, R_Y2 = 160 * MiB, R_OG = 228 * MiB, R_LSE = 252 * MiB, R_ODIR0 = 228 * MiB, R_VEC = 253 * MiB;
constexpr size_t WS_END = 352 * MiB;

typedef unsigned short bf16;
typedef unsigned v4u __attribute__((ext_vector_type(4)));
typedef unsigned v2u __attribute__((ext_vector_type(2)));
typedef float f32x4 __attribute__((ext_vector_type(4)));
typedef float f32x2 __attribute__((ext_vector_type(2)));
#define LAS __attribute__((address_space(3)))

typedef __bf16 bf16x2_hw __attribute__((ext_vector_type(2)));
__device__ __forceinline__ unsigned pk2(float lo, float hi) { f32x2 v = {lo, hi}; return __builtin_bit_cast(unsigned, __builtin_convertvector(v, bf16x2_hw)); }
__device__ __forceinline__ unsigned f2bf(float f) { return pk2(f, f) & 0xffffu; }
__device__ __forceinline__ float bf2f(unsigned short b) { return __builtin_bit_cast(float, (unsigned)b << 16); }
__device__ __forceinline__ float bflo(unsigned w) { return __builtin_bit_cast(float, w << 16); }
__device__ __forceinline__ float bfhi(unsigned w) { return __builtin_bit_cast(float, w & 0xffff0000u); }
__device__ __forceinline__ float wave_sum(float v) {
#pragma unroll
    for (int o = 1; o < 64; o <<= 1) v += __shfl_xor(v, o);
    return v;
}
__device__ __forceinline__ float sigmoidf_(float x) { return 1.0f / (1.0f + __expf(-x)); }
__device__ __forceinline__ float siluf_(float x) { return x / (1.0f + __expf(-x)); }

namespace pg8 {
struct EpiSwiglu {
    static constexpr bool PERM = true, AFTER_DRAIN = false;
    bf16_t* O; int ldc; int pad_;
    __device__ __forceinline__ void operator()(const f32x4 (&acc)[2][2][4][2], const Unit& u, int wr, int wc, int fr, int fq) const {
        const int row0 = u.pm * BM + wr * 64 + fr, col0 = u.pn * 128 + wc * 32 + 8 * fq;
#pragma unroll
        for (int ai = 0; ai < 2; ++ai)
#pragma unroll
            for (int m = 0; m < 4; ++m) {
                bf16_t* rowp = O + (size_t)(row0 + ai * HALF + m * 16) * ldc + col0;
                float v[8];
#pragma unroll
                for (int n = 0; n < 2; ++n)
#pragma unroll
                    for (int e = 0; e < 4; ++e) { const float g = acc[ai][0][m][n][e], uu = acc[ai][1][m][n][e]; v[n * 4 + e] = g * __builtin_amdgcn_rcpf(1.0f + __expf(-g)) * uu; }
                u32x4 w; w.x = cvt_pk_bf16(v[0], v[1]); w.y = cvt_pk_bf16(v[2], v[3]); w.z = cvt_pk_bf16(v[4], v[5]); w.w = cvt_pk_bf16(v[6], v[7]);
                *(u32x4*)rowp = w;
            }
    }
};
struct EpiBf16P {
    static constexpr bool PERM = true, AFTER_DRAIN = false;
    bf16_t* O; int ldc; int pad_;
    __device__ __forceinline__ void operator()(const f32x4 (&acc)[2][2][4][2], const Unit& u, int wr, int wc, int fr, int fq) const {
        const int row0 = u.pm * BM + wr * 64 + fr, col0 = u.pn * BM + wc * 32 + 8 * fq;
#pragma unroll
        for (int ai = 0; ai < 2; ++ai)
#pragma unroll
            for (int m = 0; m < 4; ++m) {
                bf16_t* rowp = O + (size_t)(row0 + ai * HALF + m * 16) * ldc + col0;
#pragma unroll
                for (int bj = 0; bj < 2; ++bj) { const f32x4 v0 = acc[ai][bj][m][0], v1 = acc[ai][bj][m][1];
                    u32x4 w; w.x = cvt_pk_bf16(v0[0], v0[1]); w.y = cvt_pk_bf16(v0[2], v0[3]); w.z = cvt_pk_bf16(v1[0], v1[1]); w.w = cvt_pk_bf16(v1[2], v1[3]);
                    *(u32x4*)(rowp + bj * HALF) = w; }
            }
    }
};
struct EpiF32 {
    static constexpr bool PERM = false, AFTER_DRAIN = false;
    float* O; int ldc; int pad_;
    __device__ __forceinline__ void operator()(const f32x4 (&acc)[2][2][4][2], const Unit& u, int wr, int wc, int fr, int fq) const {
        const int row0 = u.pm * BM + wr * 64 + fr, col0 = u.pn * BM + wc * 32 + 4 * fq;
#pragma unroll
        for (int ai = 0; ai < 2; ++ai)
#pragma unroll
            for (int m = 0; m < 4; ++m) {
                float* rowp = O + (size_t)(row0 + ai * HALF + m * 16) * ldc + col0;
#pragma unroll
                for (int bj = 0; bj < 2; ++bj)
#pragma unroll
                    for (int n = 0; n < 2; ++n) *(f32x4*)(rowp + bj * HALF + n * 16) = acc[ai][bj][m][n];
            }
    }
};
struct EpiInProj {
    static constexpr bool PERM = true, AFTER_DRAIN = false;
    bf16_t* PA; bf16_t* PD; bf16_t* PZ; float* AB;
    __device__ __forceinline__ void operator()(const f32x4 (&acc)[2][2][4][2], const Unit& u, int wr, int wc, int fr, int fq) const {
        const int row0 = u.pm * BM + wr * 64 + fr;
        if (u.pn == 21) {
            if (wc == 0) {
#pragma unroll
                for (int ai = 0; ai < 2; ++ai)
#pragma unroll
                    for (int m = 0; m < 4; ++m) {
                        float* rowp = AB + (size_t)(row0 + ai * HALF + m * 16) * 32 + 8 * fq;
                        *(f32x4*)rowp = acc[ai][0][m][0]; *(f32x4*)(rowp + 4) = acc[ai][0][m][1];
                    }
            }
            return;
        }
        bf16_t* base; int ldc, ct;
        if (u.pn < 9) { base = PA; ldc = 2304; ct = u.pn; } else if (u.pn < 18) { base = PD; ldc = 2304; ct = u.pn - 9; } else { base = PZ; ldc = 768; ct = u.pn - 18; }
        const int col0 = ct * BM + wc * 32 + 8 * fq;
#pragma unroll
        for (int ai = 0; ai < 2; ++ai)
#pragma unroll
            for (int m = 0; m < 4; ++m) {
                bf16_t* rowp = base + (size_t)(row0 + ai * HALF + m * 16) * ldc + col0;
#pragma unroll
                for (int bj = 0; bj < 2; ++bj) { const f32x4 v0 = acc[ai][bj][m][0], v1 = acc[ai][bj][m][1];
                    u32x4 w; w.x = cvt_pk_bf16(v0[0], v0[1]); w.y = cvt_pk_bf16(v0[2], v0[3]); w.z = cvt_pk_bf16(v1[0], v1[1]); w.w = cvt_pk_bf16(v1[2], v1[3]);
                    *(u32x4*)(rowp + bj * HALF) = w; }
            }
    }
};
struct EpiGateF32 {
    static constexpr bool PERM = false, AFTER_DRAIN = false;
    float* O; const bf16_t* gate; int ldg; int pad_;
    __device__ __forceinline__ void operator()(const f32x4 (&acc)[2][2][4][2], const Unit& u, int wr, int wc, int fr, int fq) const {
        const int row0 = u.pm * BM + wr * 64 + fr, col0 = u.pn * BM + wc * 32 + 4 * fq;
#pragma unroll
        for (int ai = 0; ai < 2; ++ai)
#pragma unroll
            for (int m = 0; m < 4; ++m) {
                const size_t r = (size_t)(row0 + ai * HALF + m * 16);
#pragma unroll
                for (int bj = 0; bj < 2; ++bj)
#pragma unroll
                    for (int n = 0; n < 2; ++n) { const int c = col0 + bj * HALF + n * 16;
                        const v2u gw = *(const v2u*)(gate + r * ldg + c);
                        f32x4 a = acc[ai][bj][m][n];
                        a[0] *= sigmoidf_(bflo(gw.x)); a[1] *= sigmoidf_(bfhi(gw.x)); a[2] *= sigmoidf_(bflo(gw.y)); a[3] *= sigmoidf_(bfhi(gw.y));
                        *(f32x4*)(O + r * 1024 + c) = a; }
            }
    }
};
struct EpiGateAddBf16 {
    static constexpr bool PERM = false, AFTER_DRAIN = false;
    bf16_t* O; const float* T1; const bf16_t* gate; int ldg; int pad_;
    __device__ __forceinline__ void operator()(const f32x4 (&acc)[2][2][4][2], const Unit& u, int wr, int wc, int fr, int fq) const {
        const int row0 = u.pm * BM + wr * 64 + fr, col0 = u.pn * BM + wc * 32 + 4 * fq;
#pragma unroll
        for (int ai = 0; ai < 2; ++ai)
#pragma unroll
            for (int m = 0; m < 4; ++m) {
                const size_t r = (size_t)(row0 + ai * HALF + m * 16);
#pragma unroll
                for (int bj = 0; bj < 2; ++bj)
#pragma unroll
                    for (int n = 0; n < 2; ++n) { const int c = col0 + bj * HALF + n * 16;
                        const v2u gw = *(const v2u*)(gate + r * ldg + c);
                        const f32x4 t = *(const f32x4*)(T1 + r * 1024 + c);
                        f32x4 a = acc[ai][bj][m][n];
                        a[0] = t[0] + a[0] * sigmoidf_(bflo(gw.x)); a[1] = t[1] + a[1] * sigmoidf_(bfhi(gw.x)); a[2] = t[2] + a[2] * sigmoidf_(bflo(gw.y)); a[3] = t[3] + a[3] * sigmoidf_(bfhi(gw.y));
                        v2u w; w.x = cvt_pk_bf16(a[0], a[1]); w.y = cvt_pk_bf16(a[2], a[3]);
                        *(v2u*)(O + r * 1024 + c) = w; }
            }
    }
};
}


#define GAS __attribute__((address_space(1)))
struct Params { const float* in[17]; float* out; unsigned char* ws; };
#define XB_TMO      128
#define XB_XCNT(j)  (256  + 64 * (j))
#define XB_XSUB(j)  (1280 + 64 * (j))
#define XB_XGEN(j)  (2304 + 64 * (j))
#define XB_TOP      3328
#define XB_TOPGEN   3392
#define XCD_BAR_WORDS 3456
#define XB_SPIN_CAP (1u << 18)

__device__ __forceinline__ unsigned xb_ld(unsigned* p)              { return __hip_atomic_load(p, __ATOMIC_RELAXED, __HIP_MEMORY_SCOPE_AGENT); }
__device__ __forceinline__ unsigned xb_add(unsigned* p, unsigned v) { return __hip_atomic_fetch_add(p, v, __ATOMIC_RELAXED, __HIP_MEMORY_SCOPE_AGENT); }
__device__ __forceinline__ unsigned xb_xcc_id() { return (unsigned)__builtin_amdgcn_s_getreg((3 << 11) | 20) & 0xFu; }
#define XB_SPIN(cond, bar) do { unsigned _sp = 0; while (cond) { __builtin_amdgcn_s_sleep(1); \
    if ((++_sp & 255u) == 0u) { if (xb_ld(&(bar)[XB_TMO])) break; if (_sp > XB_SPIN_CAP) { atomicAdd(&(bar)[XB_TMO], 1u); break; } } } } while (0)

struct XcdBarrier {
    unsigned* bar; unsigned x;
    volatile LAS unsigned* st;
};

__device__ __forceinline__ XcdBarrier xcd_barrier_post(unsigned* bar, volatile LAS unsigned* st) {
    XcdBarrier b; b.bar = bar; b.x = xb_xcc_id(); b.st = st;
    if (threadIdx.x == 0) (void)xb_add(&bar[XB_XCNT(b.x)], 1u);
    return b;
}
__device__ __forceinline__ void xcd_barrier_complete(unsigned* bar, unsigned x, unsigned& nloc, unsigned& nx) {
    const unsigned G = gridDim.x * gridDim.y * gridDim.z;
    unsigned sum, cnt, mine, sp = 0u;
    for (;;) {
        sum = 0u; cnt = 0u; mine = 0u;
#pragma unroll
        for (unsigned j = 0; j < 16; ++j) { const unsigned c = xb_ld(&bar[XB_XCNT(j)]); sum += c; cnt += (c > 0u) ? 1u : 0u; mine = (j == x) ? c : mine; }
        if (sum == G) break;
        __builtin_amdgcn_s_sleep(1);
        if ((++sp & 255u) == 0u) { if (xb_ld(&bar[XB_TMO])) break; if (sp > XB_SPIN_CAP) { atomicAdd(&bar[XB_TMO], 1u); break; } }
    }
    nloc = mine > 0u ? mine : 1u; nx = cnt > 0u ? cnt : 1u;
}

__device__ __forceinline__ void xcd_barrier(const XcdBarrier& b, int wv) {
    const bool leader_thread = (wv == 0) && (lane_id_() == 0);
    asm volatile("s_waitcnt vmcnt(0)" ::: "memory");
    __syncthreads();
    if (leader_thread) {
        unsigned* bar = b.bar;
        __builtin_amdgcn_s_waitcnt(0);
        unsigned nloc = b.st[0], nx = b.st[1];
        if (nloc == 0u) { xcd_barrier_complete(bar, b.x, nloc, nx); b.st[0] = nloc; b.st[1] = nx; }
        const unsigned old = xb_add(&bar[XB_XSUB(b.x)], 1u);
        const unsigned gen = old / nloc;
        if (old + 1u == (gen + 1u) * nloc) {
            __builtin_amdgcn_fence(__ATOMIC_RELEASE, "agent");
            asm volatile("s_waitcnt vmcnt(0)" ::: "memory");
            const unsigned og = xb_add(&bar[XB_TOP], 1u);
            const unsigned tg = og / nx;
            if (og + 1u == (tg + 1u) * nx) xb_add(&bar[XB_TOPGEN], 1u);
            else XB_SPIN(xb_ld(&bar[XB_TOPGEN]) == tg, bar);
            __builtin_amdgcn_fence(__ATOMIC_ACQUIRE, "agent");
            xb_add(&bar[XB_XGEN(b.x)], 1u);
            asm volatile("s_waitcnt vmcnt(0)" ::: "memory");
        } else {
            XB_SPIN(xb_ld(&bar[XB_XGEN(b.x)]) == gen, bar);
            __builtin_amdgcn_fence(__ATOMIC_ACQUIRE, "agent");
            asm volatile("s_waitcnt vmcnt(0)" ::: "memory");
        }
    }
    __syncthreads();
}

typedef const __attribute__((address_space(4))) unsigned char* ka_t;
__device__ __forceinline__ ka_t ka_() { ka_t k = (ka_t)__builtin_amdgcn_kernarg_segment_ptr(); asm volatile("" : "+s"(k)); return k; }
#define PIN(i) ((const float*)(const __attribute__((address_space(1))) float*)(*(const __attribute__((address_space(4))) unsigned long long*)(ka_() + 8 * (i))))
#define POUT ((float*)(__attribute__((address_space(1))) float*)(*(const __attribute__((address_space(4))) unsigned long long*)(ka_() + 136)))
#define PWS ((unsigned char*)(__attribute__((address_space(1))) unsigned char*)(*(const __attribute__((address_space(4))) unsigned long long*)(ka_() + 144)))
#define BID ((int)blockIdx.x)
#define GSZ ((int)gridDim.x)
__device__ __forceinline__ int srcmap(int mode, int n) {
    if (mode == 0) return n;
    if (mode == 1) return (n >> 8) * 128 + (n & 127) + ((n >> 7) & 1) * 2816;
    if (n < 5400) return n;
    if (n < 5632) return -1;
    if (n < 6656) return 5400 + (n - 5632);
    return 6424 + (n - 6656);
}
__device__ __forceinline__ void conv_item(const float* W, bf16* WT, int K, int Nsrc, int Ndst, int mode, int item, float* scr, int lane) {
    const int nblk = Ndst / 32, kb = item / nblk, nb = item % nblk, k0 = 64 * kb, n0 = 32 * nb;
    const int sc = srcmap(mode, n0 + (lane & 31));
#pragma unroll
    for (int i = 0; i < 32; ++i) { const int kk = 2 * i + (lane >> 5); scr[kk * 33 + (lane & 31)] = sc >= 0 ? W[(size_t)(k0 + kk) * Nsrc + sc] : 0.f; }
    __builtin_amdgcn_s_waitcnt(0xc07f); __builtin_amdgcn_wave_barrier();
    const int c = lane & 7;
#pragma unroll
    for (int j = 0; j < 4; ++j) { const int n = (lane >> 3) + 8 * j; const float* s = scr + (8 * c) * 33 + n;
        v4u o; o.x = pk2(s[0 * 33], s[1 * 33]); o.y = pk2(s[2 * 33], s[3 * 33]); o.z = pk2(s[4 * 33], s[5 * 33]); o.w = pk2(s[6 * 33], s[7 * 33]);
        *(v4u*)(WT + (size_t)(n0 + n) * K + k0 + 8 * c) = o; }
    __builtin_amdgcn_s_waitcnt(0xc07f); __builtin_amdgcn_wave_barrier();
}
__device__ __forceinline__ void ph_convert(int l, unsigned char* lds, int wv) {
    int tid_ = wv * 64 + lane_id_(); asm volatile("" : "+v"(tid_)); const int lane = tid_ & 63, wave = tid_ >> 6;
    float* scr = (float*)lds + wave * (64 * 33);
    unsigned char* wb = PWS + WS_W;
    constexpr int I_FI = 16 * 176, I_FO = 44 * 32, I_IN = 16 * 240, I_BA = 4 * 32, I_BD = 12 * 32, I_O = 16 * 32;
    constexpr int NIT = 2 * I_FI + 2 * I_FO + I_IN + I_BA + I_BD + I_O;
    for (int it = BID * 8 + wave; it < NIT; it += GSZ * 8) {
        int r = it;
        if (r < 2 * I_FI) { const int f = r / I_FI; conv_item(PIN(7) + ((size_t)l * 2 + f) * 1024 * 5632, (bf16*)(wb + (f ? W_FFIN1 : W_FFIN0)), 1024, 5632, 5632, 1, r % I_FI, scr, lane); continue; } r -= 2 * I_FI;
        if (r < 2 * I_FO) { const int f = r / I_FO; conv_item(PIN(8) + ((size_t)l * 2 + f) * 2816 * 1024, (bf16*)(wb + (f ? W_FFOUT1 : W_FFOUT0)), 2816, 1024, 1024, 0, r % I_FO, scr, lane); continue; } r -= 2 * I_FO;
        if (r < I_IN) { conv_item(PIN(9) + (size_t)l * 1024 * NIN_, (bf16*)(wb + W_IN), 1024, NIN_, NINP_, 2, r, scr, lane); continue; } r -= I_IN;
        if (r < I_BA) { conv_item(PIN(14) + (size_t)l * 256 * 1024, (bf16*)(wb + W_BATT), 256, 1024, 1024, 0, r, scr, lane); continue; } r -= I_BA;
        if (r < I_BD) { conv_item(PIN(15) + (size_t)l * 768 * 1024, (bf16*)(wb + W_BDN), 768, 1024, 1024, 0, r, scr, lane); continue; } r -= I_BD;
        conv_item(PIN(16) + (size_t)l * 1024 * 1024, (bf16*)(wb + W_OUT), 1024, 1024, 1024, 0, r, scr, lane);
    }
}
__device__ __forceinline__ void ph_ada(unsigned char* lds, int wv) {
    float* red = (float*)(lds + 72 * 1024);
    int tid_ = wv * 64 + lane_id_(); asm volatile("" : "+v"(tid_)); const int tid = tid_, lane = tid_ & 63, wave = tid_ >> 6;
    const float* c = PIN(1); const float* w_ada = PIN(3); const float* b_ada = PIN(4); float* mod = (float*)(PWS + WS_MOD);
    for (int u = BID; u < 72; u += GSZ) {
        const int l = u / 36, n0 = (u % 36) * 256;
        const float* W = w_ada + (size_t)l * 1024 * 9216 + (size_t)(wave * 128) * 9216 + n0 + 4 * lane;
        f32x4 acc = {0.f, 0.f, 0.f, 0.f};
#pragma unroll 1
        for (int k0 = 0; k0 < 128; k0 += 16) {
            f32x4 wv4[16];
#pragma unroll
            for (int kk = 0; kk < 16; ++kk) wv4[kk] = *(const f32x4*)(W + (size_t)(k0 + kk) * 9216);
#pragma unroll
            for (int kk = 0; kk < 16; ++kk) { const float cv = c[wave * 128 + k0 + kk]; const float sv = cv / (1.0f + __expf(-cv)); acc += sv * wv4[kk]; }
        }
        *(f32x4*)(red + wave * 256 + 4 * lane) = acc;
        __syncthreads();
        if (tid < 256) { float t = b_ada[l * 9216 + n0 + tid];
#pragma unroll
            for (int w = 0; w < 8; ++w) t += red[w * 256 + tid];
            mod[l * 9216 + n0 + tid] = t; }
        __syncthreads();
    }
}
__device__ const float ROPE_INV[32] = {1.000000000e+00f, 7.498942018e-01f, 5.623413324e-01f, 4.216965139e-01f, 3.162277639e-01f, 2.371373773e-01f, 1.778279394e-01f, 1.333521456e-01f, 1.000000015e-01f, 7.498942316e-02f, 5.623413250e-02f, 4.216964915e-02f, 3.162277490e-02f, 2.371373773e-02f, 1.778279431e-02f, 1.333521400e-02f, 9.999999776e-03f, 7.498942316e-03f, 5.623413250e-03f, 4.216964822e-03f, 3.162277630e-03f, 2.371373819e-03f, 1.778279431e-03f, 1.333521446e-03f, 1.000000047e-03f, 7.498941850e-04f, 5.623413017e-04f, 4.216965172e-04f, 3.162277571e-04f, 2.371373703e-04f, 1.778279402e-04f, 1.333521504e-04f};
__device__ __forceinline__ void ph_rope(int wv) {
    const int* pos = (const int*)PIN(2); float* tab = (float*)(PWS + WS_ROPE);
    int tid_ = wv * 64 + lane_id_(); asm volatile("" : "+v"(tid_));
    for (int idx = BID * NTHREADS + tid_; idx < S_ * 32; idx += GSZ * NTHREADS) {
        const int t = idx >> 5, i = idx & 31;
        const float inv = ROPE_INV[i];
        const float ang = (float)pos[t] * inv;
        float sn, cs; sincosf(ang, &sn, &cs);
        tab[idx] = cs; tab[S_ * 32 + idx] = sn;
    }
}
struct RowArgs { const float* xi; const bf16* y; float* xo; bf16* h; const float* wpost; const float* gate; const float* wpre; const float* shift; const float* scale; float coef; };
__device__ __forceinline__ void ph_rows(const RowArgs& a, int wv) {
    int tid_ = wv * 64 + lane_id_(); asm volatile("" : "+v"(tid_)); const int lane = tid_ & 63, wave = tid_ >> 6;
    for (int r = BID * 8 + wave; r < S_; r += GSZ * 8) {
        f32x4 x[4];
        const f32x4* xr = (const f32x4*)(a.xi + (size_t)r * D_) + lane;
#pragma unroll
        for (int j = 0; j < 4; ++j) x[j] = xr[64 * j];
        if (a.y) {
            f32x4 y[4]; float s = 0.f;
            const v2u* yr = (const v2u*)(a.y + (size_t)r * D_) + lane;
#pragma unroll
            for (int j = 0; j < 4; ++j) { const v2u yw = yr[64 * j]; y[j] = (f32x4){bflo(yw.x), bfhi(yw.x), bflo(yw.y), bfhi(yw.y)}; s += (y[j].x * y[j].x + y[j].y * y[j].y) + (y[j].z * y[j].z + y[j].w * y[j].w); }
            const float rs = 1.0f / sqrtf(wave_sum(s) * (1.f / D_) + 1e-6f);
#pragma unroll
            for (int j = 0; j < 4; ++j) { const f32x4 wp = ((const f32x4*)a.wpost)[lane + 64 * j], g = ((const f32x4*)a.gate)[lane + 64 * j];
                x[j] = x[j] + a.coef * g * ((y[j] * rs) * wp); }
            f32x4* xw = (f32x4*)(a.xo + (size_t)r * D_) + lane;
#pragma unroll
            for (int j = 0; j < 4; ++j) xw[64 * j] = x[j];
        }
        if (a.h) {
            float s = 0.f;
#pragma unroll
            for (int j = 0; j < 4; ++j) s += (x[j].x * x[j].x + x[j].y * x[j].y) + (x[j].z * x[j].z + x[j].w * x[j].w);
            const float rs = 1.0f / sqrtf(wave_sum(s) * (1.f / D_) + 1e-6f);
            v2u* hw = (v2u*)(a.h + (size_t)r * D_) + lane;
#pragma unroll
            for (int j = 0; j < 4; ++j) { const f32x4 wp = ((const f32x4*)a.wpre)[lane + 64 * j], sc = ((const f32x4*)a.scale)[lane + 64 * j], sh = ((const f32x4*)a.shift)[lane + 64 * j];
                const f32x4 v = ((x[j] * rs) * wp) * (1.0f + sc) + sh;
                v2u w; w.x = pk2(v.x, v.y); w.y = pk2(v.z, v.w); hw[64 * j] = w; }
        }
    }
}
constexpr int ATT_PITCH = 68;
__device__ __forceinline__ void ph_attn_v1(const bf16* PA, const float* rope, bf16* OG, float* LSE, unsigned char* lds, int wv) {
    float* qs = (float*)lds; float* ks = qs + 64 * ATT_PITCH; float* vs = ks + 192 * ATT_PITCH;
    int tid_ = wv * 64 + lane_id_(); asm volatile("" : "+v"(tid_)); const int tid = tid_, lane = tid & 63, wave = tid >> 6;
    for (int u = BID; u < 3072; u += GSZ) {
        const int hg = u & 3, w = (u >> 2) & 255, gi = u >> 10;
        const int dil = 1 << (2 * gi), L = S_ / dil, r = w % dil, nb = w / dil, head = gi * 4 + hg;
        __syncthreads();
        for (int rr = wave; rr < 448; rr += 8) {
            int mm, colbase; float* dst; bool rot; float sc = 1.f;
            if (rr < 64) { mm = nb * 64 + rr; colbase = head * 64; dst = qs + rr * ATT_PITCH; rot = true; sc = 0.125f; }
            else if (rr < 256) { mm = nb * 64 - 64 + (rr - 64); colbase = 768 + head * 64; dst = ks + (rr - 64) * ATT_PITCH; rot = true; }
            else { mm = nb * 64 - 64 + (rr - 256); colbase = 1536 + head * 64; dst = vs + (rr - 256) * ATT_PITCH; rot = false; }
            float val = 0.f;
            if (mm >= 0 && mm < L) {
                const int tok = mm * dil + r;
                val = bf2f(PA[(size_t)tok * 2304 + colbase + lane]);
                if (rot) {
                    const float other = __shfl_xor(val, 32);
                    const float cs = rope[tok * 32 + (lane & 31)], sn = rope[S_ * 32 + tok * 32 + (lane & 31)];
                    val = (lane < 32) ? (val * cs - other * sn) : (val * cs + other * sn);
                }
            }
            dst[lane] = val * sc;
        }
        __syncthreads();
        const int i = tid >> 3, part = tid & 7;
        float q[64], acc[64];
#pragma unroll
        for (int d = 0; d < 64; d += 4) { const f32x4 t = *(const f32x4*)(qs + i * ATT_PITCH + d); q[d] = t.x; q[d + 1] = t.y; q[d + 2] = t.z; q[d + 3] = t.w; }
#pragma unroll
        for (int d = 0; d < 64; ++d) acc[d] = 0.f;
        float m = -1e30f, l = 0.f;
        for (int jj = 0; jj < 24; ++jj) {
            const int j = part + 8 * jj, mm = nb * 64 - 64 + j, dj = j - 64 - i;
            const bool ok = (dj <= 64) && (dj >= -64) && (mm >= 0) && (mm < L);
            if (ok) {
                const float* kr = ks + j * ATT_PITCH; float s = 0.f;
#pragma unroll
                for (int d = 0; d < 64; d += 4) { const f32x4 t = *(const f32x4*)(kr + d); s += q[d] * t.x + q[d + 1] * t.y + q[d + 2] * t.z + q[d + 3] * t.w; }
                const float mn = fmaxf(m, s), al = __expf(m - mn), p = __expf(s - mn);
                l = l * al + p; m = mn;
                const float* vr = vs + j * ATT_PITCH;
#pragma unroll
                for (int d = 0; d < 64; d += 4) { const f32x4 t = *(const f32x4*)(vr + d);
                    acc[d] = acc[d] * al + p * t.x; acc[d + 1] = acc[d + 1] * al + p * t.y; acc[d + 2] = acc[d + 2] * al + p * t.z; acc[d + 3] = acc[d + 3] * al + p * t.w; }
            }
        }
        float mt = fmaxf(m, __shfl_xor(m, 1)); mt = fmaxf(mt, __shfl_xor(mt, 2)); mt = fmaxf(mt, __shfl_xor(mt, 4));
        const float f = __expf(m - mt);
        l *= f; l += __shfl_xor(l, 1); l += __shfl_xor(l, 2); l += __shfl_xor(l, 4);
#pragma unroll
        for (int d = 0; d < 64; ++d) acc[d] *= f;
        const bool b2 = part & 4, b1 = part & 2, b0 = part & 1;
        float r32[32], r16[16], r8[8];
#pragma unroll
        for (int d = 0; d < 32; ++d) { const float keep = b2 ? acc[32 + d] : acc[d], send = b2 ? acc[d] : acc[32 + d]; r32[d] = keep + __shfl_xor(send, 4); }
#pragma unroll
        for (int d = 0; d < 16; ++d) { const float keep = b1 ? r32[16 + d] : r32[d], send = b1 ? r32[d] : r32[16 + d]; r16[d] = keep + __shfl_xor(send, 2); }
#pragma unroll
        for (int d = 0; d < 8; ++d) { const float keep = b0 ? r16[8 + d] : r16[d], send = b0 ? r16[d] : r16[8 + d]; r8[d] = keep + __shfl_xor(send, 1); }
        const float il = 1.0f / l;
        const int tok = (nb * 64 + i) * dil + r;
        v4u o; o.x = pk2(r8[0] * il, r8[1] * il); o.y = pk2(r8[2] * il, r8[3] * il); o.z = pk2(r8[4] * il, r8[5] * il); o.w = pk2(r8[6] * il, r8[7] * il);
        *(v4u*)(OG + ((size_t)gi * S_ + tok) * 256 + hg * 64 + part * 8) = o;
        if (part == 0) LSE[((size_t)gi * S_ + tok) * 4 + hg] = mt + logf(l);
    }
}

__device__ __forceinline__ void ph_dnprep(const bf16* PD, const float* AB, const float* convw, const float* a_log, const float* dt_bias, bf16* QKVd, float* GB, const bf16* OG, const float* LSE, bf16* OATT, int wv) {
    int tid_ = wv * 64 + lane_id_(); asm volatile("" : "+v"(tid_)); const int tid = tid_, lane = tid_ & 63, wave = tid_ >> 6;
    for (int it = BID * 8 + wave; it < 1024 * 5; it += GSZ * 8) {
        const int tb = it / 5, sg = it % 5, c0 = sg * 512 + lane * 8, t0 = tb * 16;
        if (c0 < 2304) {
            const int seg = c0 >> 7;
            float cw[5][8];
#pragma unroll
            for (int j = 0; j < 5; ++j) { const f32x4 a = *(const f32x4*)(convw + j * 2304 + c0), b = *(const f32x4*)(convw + j * 2304 + c0 + 4);
                cw[j][0] = a.x; cw[j][1] = a.y; cw[j][2] = a.z; cw[j][3] = a.w; cw[j][4] = b.x; cw[j][5] = b.y; cw[j][6] = b.z; cw[j][7] = b.w; }
            v4u win[5];
#pragma unroll
            for (int j = 0; j < 4; ++j) { const int tt = t0 + j - 2; win[j + 1] = (tt >= 0) ? *(const v4u*)(PD + (size_t)tt * 2304 + c0) : (v4u){0u, 0u, 0u, 0u}; }
#pragma unroll
            for (int i = 0; i < 16; ++i) {
#pragma unroll
                for (int j = 0; j < 4; ++j) win[j] = win[j + 1];
                { const int tt = t0 + i + 2; win[4] = (tt < S_) ? *(const v4u*)(PD + (size_t)tt * 2304 + c0) : (v4u){0u, 0u, 0u, 0u}; }
                float a[8];
#pragma unroll
                for (int e = 0; e < 8; ++e) a[e] = 0.f;
#pragma unroll
                for (int j = 0; j < 5; ++j) { const unsigned wx[4] = {win[j].x, win[j].y, win[j].z, win[j].w};
#pragma unroll
                    for (int e = 0; e < 4; ++e) { a[2 * e] += bflo(wx[e]) * cw[j][2 * e]; a[2 * e + 1] += bfhi(wx[e]) * cw[j][2 * e + 1]; } }
                float ss = 0.f;
#pragma unroll
                for (int e = 0; e < 8; ++e) { a[e] = a[e] * __builtin_amdgcn_rcpf(1.0f + __expf(-a[e])); ss += a[e] * a[e]; }
                if (seg < 12) {
                    ss += __shfl_xor(ss, 1); ss += __shfl_xor(ss, 2); ss += __shfl_xor(ss, 4); ss += __shfl_xor(ss, 8);
                    const float sc = (1.0f / sqrtf(ss + 1e-6f)) * (seg < 6 ? 0.08838834764831845f : 1.0f);
#pragma unroll
                    for (int e = 0; e < 8; ++e) a[e] *= sc;
                }
                v4u o; o.x = pk2(a[0], a[1]); o.y = pk2(a[2], a[3]); o.z = pk2(a[4], a[5]); o.w = pk2(a[6], a[7]);
                *(v4u*)(QKVd + (size_t)(t0 + i) * 2304 + c0) = o;
            }
        }
    }
    for (int e = BID * NTHREADS + tid; e < S_ * 12; e += GSZ * NTHREADS) {
        const int t = e / 12, idx = e % 12;
        const float braw = AB[(size_t)t * 32 + idx], araw = AB[(size_t)t * 32 + 12 + idx];
        const float x = araw + dt_bias[idx];
        const float sp = fmaxf(x, 0.f) + log1pf(expf(-fabsf(x)));
        GB[(size_t)idx * S_ + t] = -expf(a_log[idx]) * sp;
        GB[(size_t)(12 + idx) * S_ + t] = 1.0f / (1.0f + expf(-braw));
    }
    for (int t = BID * 8 + wave; t < S_; t += GSZ * 8) {
        const int ch = 4 * lane, hg = lane >> 4;
        const float l0 = LSE[(size_t)t * 4 + hg], l1 = LSE[((size_t)S_ + t) * 4 + hg], l2 = LSE[((size_t)2 * S_ + t) * 4 + hg];
        const float mx = fmaxf(l0, fmaxf(l1, l2));
        float w0 = expf(l0 - mx), w1 = expf(l1 - mx), w2 = expf(l2 - mx);
        const float inv = 1.0f / (w0 + w1 + w2); w0 *= inv; w1 *= inv; w2 *= inv;
        const v2u a = *(const v2u*)(OG + (size_t)t * 256 + ch), b = *(const v2u*)(OG + ((size_t)S_ + t) * 256 + ch), cc = *(const v2u*)(OG + ((size_t)2 * S_ + t) * 256 + ch);
        v2u o;
        o.x = pk2(w0 * bflo(a.x) + w1 * bflo(b.x) + w2 * bflo(cc.x), w0 * bfhi(a.x) + w1 * bfhi(b.x) + w2 * bfhi(cc.x));
        o.y = pk2(w0 * bflo(a.y) + w1 * bflo(b.y) + w2 * bflo(cc.y), w0 * bfhi(a.y) + w1 * bfhi(b.y) + w2 * bfhi(cc.y));
        *(v2u*)(OATT + (size_t)t * 256 + ch) = o;
    }
}

__device__ __forceinline__ void ph_final(const bf16* ODIR0, const bf16* ODIR1, const bf16* PZ, const float* dnw, bf16* ODN, int wv) {
    int tid_ = wv * 64 + lane_id_(); asm volatile("" : "+v"(tid_)); const int lane = tid_ & 63, wave = tid_ >> 6;
    for (int t = BID * 8 + wave; t < S_; t += GSZ * 8) {
#pragma unroll
        for (int h = 0; h < 6; ++h) {
            const int c = h * 128 + 2 * lane;
            const unsigned wf = *(const unsigned*)(ODIR0 + (size_t)t * 768 + c), wb = *(const unsigned*)(ODIR1 + (size_t)t * 768 + c);
            float o0 = bflo(wf) + bflo(wb), o1 = bfhi(wf) + bfhi(wb);
            const float ms = wave_sum(o0 * o0 + o1 * o1) * (1.0f / 128.0f);
            const float sc = 1.0f / sqrtf(ms + 1e-6f);
            const unsigned zw = *(const unsigned*)(PZ + (size_t)t * 768 + c);
            const f32x2 nw = *(const f32x2*)(dnw + 2 * lane);
            o0 = o0 * sc * nw.x * siluf_(bflo(zw)); o1 = o1 * sc * nw.y * siluf_(bfhi(zw));
            *(unsigned*)(ODN + (size_t)t * 768 + c) = pk2(o0, o1);
        }
    }
}
typedef short bf16x8_t __attribute__((ext_vector_type(8)));
typedef short s16x4_t __attribute__((ext_vector_type(4)));
#define MFMA16(a, b, c) __builtin_amdgcn_mfma_f32_16x16x32_bf16((a), (b), (c), 0, 0, 0)

__device__ __forceinline__ void ph_dn_pre(const bf16* QKVd, const float* GB, bf16* TINV, bf16* ATTN, float* VEC, unsigned char* lds, int wv) {
    int tid_ = wv * 64 + lane_id_(); asm volatile("" : "+v"(tid_));
    const int tid = tid_, lane = tid & 63, g = lane >> 4, m16 = lane & 15;
    float* GR = (float*)lds; float* Ms = GR + 2 * 64 * 65; float* Gs = Ms + 2 * 64 * 68; float* Bs = Gs + 128;
    for (int u = BID; u < 1536; u += GSZ) {
        const int n = u / 6, h = u % 6;
        __syncthreads();
        {
            const int kind = wv >> 2, mt = wv & 3;
            const bf16* arow = QKVd + (size_t)(64 * n + 16 * mt + m16) * 2304 + (kind ? 0 : 768) + h * 128 + 8 * g;
            bf16x8_t a[4];
#pragma unroll
            for (int ks = 0; ks < 4; ++ks) a[ks] = *(const bf16x8_t*)(arow + 32 * ks);
#pragma unroll
            for (int nt = 0; nt < 4; ++nt) {
                const bf16* brow = QKVd + (size_t)(64 * n + 16 * nt + m16) * 2304 + 768 + h * 128 + 8 * g;
                f32x4 acc = {0.f, 0.f, 0.f, 0.f};
#pragma unroll
                for (int ks = 0; ks < 4; ++ks) acc = MFMA16(a[ks], *(const bf16x8_t*)(brow + 32 * ks), acc);
#pragma unroll
                for (int rg = 0; rg < 4; ++rg) GR[kind * 64 * 65 + (16 * mt + 4 * g + rg) * 65 + 16 * nt + m16] = acc[rg];
            }
        }
        if ((wv & 3) == 0) {
            const int d = wv >> 2, tok = 64 * n + (d ? 63 - lane : lane);
            float gv = GB[(size_t)(d * 6 + h) * S_ + tok]; const float be = GB[(size_t)(12 + d * 6 + h) * S_ + tok];
#pragma unroll
            for (int o = 1; o < 64; o <<= 1) { const float t = __shfl_up(gv, o); if (lane >= o) gv += t; }
            const float gl = __shfl(gv, 63);
            Gs[d * 64 + lane] = gv; Bs[d * 64 + lane] = be;
            float* vec = VEC + (size_t)(u * 2 + d) * 256;
            vec[lane] = __expf(gv); vec[64 + lane] = be; vec[128 + lane] = __expf(gl - gv); vec[192 + lane] = __expf(gl);
        }
        __syncthreads();
        {
            const int d = wv >> 2, tl = tid & 255, i = tl >> 2, jq = tl & 3, ii = d ? 63 - i : i;
            const float Gi = Gs[d * 64 + i], bi = Bs[d * 64 + i];
            unsigned pk[8];
#pragma unroll
            for (int jj = 0; jj < 16; jj += 2) {
                float at[2];
#pragma unroll
                for (int e = 0; e < 2; ++e) {
                    const int j = 16 * jq + jj + e, jx = d ? 63 - j : j;
                    const float dec = (j <= i) ? __expf(Gi - Gs[d * 64 + j]) : 0.f;
                    const float kk = GR[ii * 65 + jx], qk = GR[64 * 65 + ii * 65 + jx];
                    Ms[d * 64 * 68 + i * 68 + j] = (j < i) ? bi * kk * dec : 0.f;
                    at[e] = (j <= i) ? qk * dec : 0.f;
                }
                pk[jj >> 1] = pk2(at[0], at[1]);
            }
            v4u* dst = (v4u*)(ATTN + ((size_t)(u * 2 + d) * 64 + i) * 64 + 16 * jq);
            v4u o0; o0.x = pk[0]; o0.y = pk[1]; o0.z = pk[2]; o0.w = pk[3]; v4u o1; o1.x = pk[4]; o1.y = pk[5]; o1.z = pk[6]; o1.w = pk[7];
            dst[0] = o0; dst[1] = o1;
        }
        __syncthreads();
        if ((wv & 3) == 0) {
            const int d = wv >> 2, c = lane; const float* Md = Ms + d * 64 * 68;
            float x[64];
            x[0] = (c == 0) ? 1.f : 0.f;
#pragma unroll
            for (int i = 1; i < 64; ++i) {
                f32x4 mr[16];
#pragma unroll
                for (int j0 = 0; j0 < i; j0 += 4) mr[j0 >> 2] = *(const f32x4*)(Md + i * 68 + j0);
                float s0 = (i == c) ? 1.f : 0.f, s1 = 0.f, s2 = 0.f, s3 = 0.f;
#pragma unroll
                for (int j0 = 0; j0 < i; j0 += 4) { const f32x4 mv = mr[j0 >> 2];
                    s0 -= mv.x * x[j0]; if (j0 + 1 < i) s1 -= mv.y * x[j0 + 1]; if (j0 + 2 < i) s2 -= mv.z * x[j0 + 2]; if (j0 + 3 < i) s3 -= mv.w * x[j0 + 3]; }
                x[i] = (s0 + s1) + (s2 + s3);
            }
            bf16* outp = TINV + (size_t)(u * 2 + d) * 4096 + c;
#pragma unroll
            for (int i = 0; i < 64; ++i) outp[i * 64] = (bf16)f2bf(x[i]);
        }
    }
}

constexpr int SC_NC = 2;
constexpr int SC_KT = 0, SC_QT = 17408, SC_TI = 34816, SC_AT = 44032, SC_VT = 53248, SC_VC = SC_VT + 4096, SC_BUF = SC_VC + 1024;
constexpr int SC_ST = 2 * SC_BUF, SC_RT = SC_ST + 16 * SC_NC * 272, SC_VNT = SC_RT + 16 * SC_NC * 144, SC_VST = SC_VNT + 16 * SC_NC * 144, SC_END = SC_VST + 16 * SC_NC * 144;
static_assert(SC_END + 16 <= 146432, "scan LDS (+ a 16-byte dump slot at SC_END)");
constexpr size_t SCS_MAT = 128 * 128;
__device__ __forceinline__ float* scs_B(float* base, int p, int j) { return base + (size_t)(p * 3 + j) * SCS_MAT; }
__device__ __forceinline__ float* scs_A(float* base, int p, int j) { return base + (size_t)(36 + p * 2 + (j - 1)) * SCS_MAT; }
template <int PASS>
__device__ __forceinline__ void ph_dn_scan(const bf16* QKVd, const bf16* TINV, const bf16* ATTN, const float* VEC, bf16* ODIR0, bf16* ODIR1, float* SCS, LAS unsigned char* lds, int wv) {
    const int xl = BID & 7, slot = BID >> 3;
    int p, j, cs; bool has_out, v_zero;
    if (PASS == 1) {
        if (slot < 24) { const int grp = xl * 3 + (slot >> 3), within = slot & 7; p = grp >> 1; j = 1 + (grp & 1); v_zero = (within >> 2) != 0; cs = within & 3; has_out = false; }
        else { const int s4 = slot - 24; int gi; if (xl < 4) gi = xl * 2 + (s4 >> 2); else { if (s4 >= 4) return; gi = 8 + (xl - 4); } p = gi; j = 0; cs = s4 & 3; has_out = true; v_zero = false; }
    } else {
        if (slot >= 20) return; const int v = xl * 20 + slot; if (v >= 144) return;
        const int grp = v >> 2; p = grp / 3; j = 1 + grp % 3; cs = v & 3; has_out = true; v_zero = false;
    }
    const int d = p / 6, h = p % 6;
    int tid_ = wv * 64 + lane_id_(); asm volatile("" : "+v"(tid_));
    const int tid = tid_, lane = tid & 63, g = lane >> 4, m16 = lane & 15, t4 = wv & 3;
    bf16* ODIR = d ? ODIR1 : ODIR0;
    v4u pfA[7], pfB[7];
    unsigned voff[7], loff[7];
#pragma unroll
    for (int k_ = 0; k_ < 7; ++k_) { int q_ = tid + 512 * k_;
        if (k_ < 4) { const int qq_ = q_ & 1023, row_ = qq_ >> 4, ch_ = qq_ & 15; voff[k_] = (unsigned)((d ? 63 - row_ : row_) * 4608 + ((k_ < 2 ? 768 : 0) + h * 128 + ch_ * 8) * 2); loff[k_] = (k_ < 2 ? SC_KT : SC_QT) + row_ * 272 + ch_ * 16; }
        else if (k_ < 6) { const int qq_ = q_ & 511, row_ = qq_ >> 3, ch_ = qq_ & 7; voff[k_] = (unsigned)(row_ * 128 + ch_ * 16); loff[k_] = (k_ == 4 ? SC_TI : SC_AT) + row_ * 144 + ch_ * 16; }
        else { const int qq_ = q_ - 3072;
            if (qq_ < 256) { const int row_ = qq_ >> 2, ch_ = qq_ & 3; voff[k_] = (unsigned)((d ? 63 - row_ : row_) * 4608 + (1536 + h * 128 + cs * 32 + ch_ * 8) * 2); loff[k_] = SC_VT + qq_ * 16; }
            else if (qq_ < 320) { voff[k_] = (unsigned)((qq_ - 256) * 16); loff[k_] = SC_VC + (qq_ - 256) * 16; }
            else { voff[k_] = 0u; loff[k_] = SC_END; } }
        if (!has_out && (k_ == 2 || k_ == 3 || k_ == 5)) { voff[k_] = 0u; loff[k_] = SC_END; } }
    const unsigned char* gK = (const unsigned char*)QKVd; const unsigned char* gT = (const unsigned char*)TINV; const unsigned char* gA = (const unsigned char*)ATTN; const unsigned char* gV = (const unsigned char*)VEC;
#define SC_LD1(dst, vo, basep) asm volatile("s_nop 4\n\tglobal_load_dwordx4 %0, %1, %2" : "=v"(dst) : "v"(vo), "s"(basep) : "memory")
#define SC_LOAD(pf, step) do { const int n_ = d ? 255 - (step) : (step); const size_t cb_ = (size_t)((n_ * 6 + h) * 2 + d); \
        const unsigned char* bK_ = gK + (size_t)n_ * 294912; const unsigned char* bT_ = gT + cb_ * 8192; const unsigned char* bA_ = has_out ? gA + cb_ * 8192 : bT_; const unsigned char* bQ_ = has_out ? bK_ : bT_; \
        const unsigned char* b6_ = (wv < 4) ? bK_ : gV + cb_ * 1024; \
        SC_LD1(pf[0], voff[0], bK_); SC_LD1(pf[1], voff[1], bK_); SC_LD1(pf[2], voff[2], bQ_); SC_LD1(pf[3], voff[3], bQ_); SC_LD1(pf[4], voff[4], bT_); SC_LD1(pf[5], voff[5], bA_); SC_LD1(pf[6], voff[6], b6_); } while (0)
#define SC_WRITE(pf, bufsel) do { LAS unsigned char* bb_ = lds + (bufsel) * SC_BUF; \
        _Pragma("unroll") for (int k_ = 0; k_ < 7; ++k_) *(LAS v4u*)(bb_ + loff[k_]) = pf[k_]; } while (0)
#define SC_BAR() do { asm volatile("s_waitcnt lgkmcnt(0)" ::: "memory"); __builtin_amdgcn_s_barrier(); asm volatile("" ::: "memory"); } while (0)
#define SC_WAIT(pf, N) asm volatile("s_waitcnt vmcnt(" #N ")" : "+v"(pf[0]), "+v"(pf[1]), "+v"(pf[2]), "+v"(pf[3]), "+v"(pf[4]), "+v"(pf[5]), "+v"(pf[6]) :: "memory")
#define SC_WAIT4(pf, N) asm volatile("s_waitcnt vmcnt(" #N ")" : "+v"(pf[0]), "+v"(pf[1]), "+v"(pf[4]), "+v"(pf[6]) :: "memory")
#define SC_OSTORE(stepo) do { if (has_out && wv >= 4) { const int no_ = d ? 255 - (stepo) : (stepo); \
        _Pragma("unroll") for (int ct = 0; ct < SC_NC; ++ct) _Pragma("unroll") for (int rg = 0; rg < 4; ++rg) { const int i_ = 16 * t4 + 4 * g + rg, tok_ = 64 * no_ + (d ? 63 - i_ : i_); \
            ODIR[(size_t)tok_ * 768 + h * 128 + cs * 32 + ct * 16 + m16] = (bf16)f2bf(oprev[ct][rg]); } } } while (0)
#define SC_STEP(s, PFW, PFL) do { const int s_ = (s); const int cur = s_ & 1; \
        LAS unsigned char* B = lds + cur * SC_BUF; \
        SC_LOAD(PFL, (s_ + 2 < s_end ? s_ + 2 : s_end - 1)); \
        if (s_ > s_beg) SC_OSTORE(s_ - 1); \
        const LAS float* VC = (const LAS float*)(B + SC_VC); \
        bf16x8_t sb[SC_NC][4]; \
        _Pragma("unroll") for (int ct = 0; ct < SC_NC; ++ct) _Pragma("unroll") for (int ks = 0; ks < 4; ++ks) sb[ct][ks] = *(const LAS bf16x8_t*)(lds + SC_ST + (16 * ct + m16) * 272 + (32 * ks + 8 * g) * 2); \
        f32x4 acc1[SC_NC]; \
        _Pragma("unroll") for (int ct = 0; ct < SC_NC; ++ct) acc1[ct] = (f32x4){0.f, 0.f, 0.f, 0.f}; \
        const f32x4 eG4 = *(const LAS f32x4*)(VC + 16 * t4 + 4 * g); \
        if (wv < 4 || has_out) { const LAS unsigned char* ap = B + (wv < 4 ? SC_KT : SC_QT) + (16 * t4 + m16) * 272 + 16 * g; \
          _Pragma("unroll") for (int ks = 0; ks < 4; ++ks) { const bf16x8_t a_ = *(const LAS bf16x8_t*)(ap + 64 * ks); \
              _Pragma("unroll") for (int ct = 0; ct < SC_NC; ++ct) acc1[ct] = MFMA16(a_, sb[ct][ks], acc1[ct]); } } \
        if (wv < 4) { const f32x4 be4 = *(const LAS f32x4*)(VC + 64 + 16 * t4 + 4 * g); \
            _Pragma("unroll") for (int ct = 0; ct < SC_NC; ++ct) { float r[4]; \
                _Pragma("unroll") for (int rg = 0; rg < 4; ++rg) { const float vv = v_zero ? 0.f : bf2f(*(const LAS unsigned short*)(B + SC_VT + (16 * t4 + 4 * g + rg) * 64 + (16 * ct + m16) * 2)); r[rg] = be4[rg] * (vv - eG4[rg] * acc1[ct][rg]); } \
                v2u w; w.x = pk2(r[0], r[1]); w.y = pk2(r[2], r[3]); *(LAS v2u*)(lds + SC_RT + (16 * ct + m16) * 144 + (16 * t4 + 4 * g) * 2) = w; } \
        } else { _Pragma("unroll") for (int ct = 0; ct < SC_NC; ++ct) _Pragma("unroll") for (int rg = 0; rg < 4; ++rg) acc1[ct][rg] *= eG4[rg]; } \
        SC_BAR(); \
        if (wv < 4) { const LAS unsigned char* ap = B + SC_TI + (16 * t4 + m16) * 144 + 16 * g; \
            const bf16x8_t a0_ = *(const LAS bf16x8_t*)ap, a1_ = *(const LAS bf16x8_t*)(ap + 64); \
            const f32x4 eL4 = *(const LAS f32x4*)(VC + 128 + 16 * t4 + 4 * g); \
            _Pragma("unroll") for (int ct = 0; ct < SC_NC; ++ct) { f32x4 vn = {0.f, 0.f, 0.f, 0.f}; \
                vn = MFMA16(a0_, *(const LAS bf16x8_t*)(lds + SC_RT + (16 * ct + m16) * 144 + (8 * g) * 2), vn); \
                vn = MFMA16(a1_, *(const LAS bf16x8_t*)(lds + SC_RT + (16 * ct + m16) * 144 + (32 + 8 * g) * 2), vn); \
                v2u w; w.x = pk2(vn[0], vn[1]); w.y = pk2(vn[2], vn[3]); *(LAS v2u*)(lds + SC_VNT + (16 * ct + m16) * 144 + (16 * t4 + 4 * g) * 2) = w; \
                v2u w2; w2.x = pk2(vn[0] * eL4[0], vn[1] * eL4[1]); w2.y = pk2(vn[2] * eL4[2], vn[3] * eL4[3]); *(LAS v2u*)(lds + SC_VST + (16 * ct + m16) * 144 + (16 * t4 + 4 * g) * 2) = w2; } } \
        SC_BAR(); \
        { bf16x8_t ka[2]; \
          _Pragma("unroll") for (int ks = 0; ks < 2; ++ks) { \
              const LAS unsigned char* tp = B + SC_KT + (32 * ks + 8 * g + (m16 >> 2)) * 272 + (16 * wv + 4 * (m16 & 3)) * 2; \
              const s16x4_t lo = __builtin_amdgcn_ds_read_tr16_b64_v4i16((LAS s16x4_t*)tp); \
              const s16x4_t hi = __builtin_amdgcn_ds_read_tr16_b64_v4i16((LAS s16x4_t*)(tp + 4 * 272)); \
              ka[ks] = (bf16x8_t){lo[0], lo[1], lo[2], lo[3], hi[0], hi[1], hi[2], hi[3]}; } \
          const float gl = VC[192]; \
          _Pragma("unroll") for (int ct = 0; ct < SC_NC; ++ct) { f32x4 acc3 = {0.f, 0.f, 0.f, 0.f}; \
              _Pragma("unroll") for (int ks = 0; ks < 2; ++ks) acc3 = MFMA16(ka[ks], *(const LAS bf16x8_t*)(lds + SC_VST + (16 * ct + m16) * 144 + (32 * ks + 8 * g) * 2), acc3); \
              _Pragma("unroll") for (int rg = 0; rg < 4; ++rg) Sreg[ct][rg] = gl * Sreg[ct][rg] + acc3[rg]; \
              v2u w; w.x = pk2(Sreg[ct][0], Sreg[ct][1]); w.y = pk2(Sreg[ct][2], Sreg[ct][3]); *(LAS v2u*)(lds + SC_ST + (16 * ct + m16) * 272 + (16 * wv + 4 * g) * 2) = w; } } \
        if (has_out && wv >= 4) { const LAS unsigned char* ap = B + SC_AT + (16 * t4 + m16) * 144 + 16 * g; \
            const bf16x8_t a0_ = *(const LAS bf16x8_t*)ap, a1_ = *(const LAS bf16x8_t*)(ap + 64); \
            _Pragma("unroll") for (int ct = 0; ct < SC_NC; ++ct) { \
                acc1[ct] = MFMA16(a0_, *(const LAS bf16x8_t*)(lds + SC_VNT + (16 * ct + m16) * 144 + (8 * g) * 2), acc1[ct]); \
                acc1[ct] = MFMA16(a1_, *(const LAS bf16x8_t*)(lds + SC_VNT + (16 * ct + m16) * 144 + (32 + 8 * g) * 2), acc1[ct]); \
                oprev[ct] = acc1[ct]; } } \
        SC_WAIT(PFW, 7); SC_WRITE(PFW, cur ^ 1); \
        SC_BAR(); } while (0)
    const int s_beg = 64 * j, s_end = s_beg + 64;
    SC_LOAD(pfA, s_beg);
    f32x4 Sreg[SC_NC], oprev[SC_NC];
#pragma unroll
    for (int ct = 0; ct < SC_NC; ++ct) { Sreg[ct] = (f32x4){0.f, 0.f, 0.f, 0.f}; oprev[ct] = (f32x4){0.f, 0.f, 0.f, 0.f}; }
    if (PASS == 1) {
        if (v_zero) {
#pragma unroll
            for (int ct = 0; ct < SC_NC; ++ct)
#pragma unroll
                for (int rg = 0; rg < 4; ++rg) Sreg[ct][rg] = (16 * wv + 4 * g + rg == 32 * cs + 16 * ct + m16) ? 1.f : 0.f;
        }
    } else {
        LAS float* blk0 = (LAS float*)(lds + SC_ST); LAS float* blk1 = blk0 + 128 * 33;
        blk0 = (LAS float*)(lds + SC_BUF); blk1 = blk0 + 128 * 33;
        const int a = tid >> 2, cq = tid & 3;
        float accv[8];
        { const float* bp = scs_B(SCS, p, 0) + (size_t)a * 128 + 32 * cs + 8 * cq; const f32x4 x0 = *(const f32x4*)bp, x1 = *(const f32x4*)(bp + 4);
          accv[0] = x0.x; accv[1] = x0.y; accv[2] = x0.z; accv[3] = x0.w; accv[4] = x1.x; accv[5] = x1.y; accv[6] = x1.z; accv[7] = x1.w; }
#pragma unroll 1
        for (int jj = 1; jj < j; ++jj) {
            LAS float* src = (jj & 1) ? blk0 : blk1;
#pragma unroll
            for (int e = 0; e < 8; ++e) src[a * 33 + 8 * cq + e] = accv[e];
            __syncthreads();
            { const float* bp = scs_B(SCS, p, jj) + (size_t)a * 128 + 32 * cs + 8 * cq; const f32x4 x0 = *(const f32x4*)bp, x1 = *(const f32x4*)(bp + 4);
              accv[0] = x0.x; accv[1] = x0.y; accv[2] = x0.z; accv[3] = x0.w; accv[4] = x1.x; accv[5] = x1.y; accv[6] = x1.z; accv[7] = x1.w; }
            const float* ar = scs_A(SCS, p, jj) + (size_t)a * 128;
#pragma unroll 4
            for (int b4 = 0; b4 < 128; b4 += 4) { const f32x4 av = *(const f32x4*)(ar + b4);
#pragma unroll
                for (int e = 0; e < 8; ++e) accv[e] += av.x * src[(b4 + 0) * 33 + 8 * cq + e] + av.y * src[(b4 + 1) * 33 + 8 * cq + e] + av.z * src[(b4 + 2) * 33 + 8 * cq + e] + av.w * src[(b4 + 3) * 33 + 8 * cq + e]; }
        }
        LAS float* fin = (j & 1) ? blk0 : blk1;
        __syncthreads();
#pragma unroll
        for (int e = 0; e < 8; ++e) fin[a * 33 + 8 * cq + e] = accv[e];
        __syncthreads();
#pragma unroll
        for (int ct = 0; ct < SC_NC; ++ct)
#pragma unroll
            for (int rg = 0; rg < 4; ++rg) Sreg[ct][rg] = fin[(16 * wv + 4 * g + rg) * 33 + 16 * ct + m16];
        __syncthreads();
    }
#pragma unroll
    for (int ct = 0; ct < SC_NC; ++ct) { v2u w; w.x = pk2(Sreg[ct][0], Sreg[ct][1]); w.y = pk2(Sreg[ct][2], Sreg[ct][3]); *(LAS v2u*)(lds + SC_ST + (16 * ct + m16) * 272 + (16 * wv + 4 * g) * 2) = w; }
    SC_WAIT(pfA, 0); SC_WRITE(pfA, s_beg & 1);
    SC_LOAD(pfB, s_beg + 1);
    __syncthreads();
#pragma unroll 1
    for (int s2 = s_beg; s2 < s_end; s2 += 2) {
        SC_STEP(s2, pfB, pfA);
        SC_STEP(s2 + 1, pfA, pfB);
    }
    asm volatile("s_waitcnt vmcnt(0)" : "+v"(pfA[0]), "+v"(pfA[1]), "+v"(pfA[2]), "+v"(pfA[3]), "+v"(pfA[4]), "+v"(pfA[5]), "+v"(pfA[6]),
                                        "+v"(pfB[0]), "+v"(pfB[1]), "+v"(pfB[2]), "+v"(pfB[3]), "+v"(pfB[4]), "+v"(pfB[5]), "+v"(pfB[6]) :: "memory");
    SC_OSTORE(s_end - 1);
    if (PASS == 1) {
        float* dst = (v_zero ? scs_A(SCS, p, j) : scs_B(SCS, p, j));
        if (j < 3) {
#pragma unroll
            for (int ct = 0; ct < SC_NC; ++ct)
#pragma unroll
                for (int rg = 0; rg < 4; ++rg) dst[(size_t)(16 * wv + 4 * g + rg) * 128 + 32 * cs + 16 * ct + m16] = Sreg[ct][rg];
        }
    }
    asm volatile("s_waitcnt vmcnt(0)" ::: "memory");
#undef SC_STEP
#undef SC_OSTORE
#undef SC_WAIT
#undef SC_WAIT4
#undef SC_BAR
#undef SC_LOAD
#undef SC_LD1
#undef SC_WRITE
}
constexpr int AT_PITCH = 144, AT_K = 0, AT_V = 192 * AT_PITCH, AT_GRP = 2 * 192 * AT_PITCH;
__device__ __forceinline__ void ph_attn(const bf16* PA, const float* rope, bf16* OG, float* LSE, LAS unsigned char* lds, int wv) {
    int tid_ = wv * 64 + lane_id_(); asm volatile("" : "+v"(tid_));
    const int tid = tid_, lane = tid & 63, g = lane >> 4, m16 = lane & 15, grp = wv >> 2, wq = wv & 3, tg = tid & 255;
    LAS unsigned char* Kl = lds + grp * AT_GRP + AT_K; LAS unsigned char* Vl = lds + grp * AT_GRP + AT_V;
#pragma unroll 1
    for (int pi = BID; pi < 1536; pi += GSZ) {
        const int u = 2 * pi + grp;
        const int hg = u & 3, w = (u >> 2) & 255, gi = u >> 10;
        const int dil = 1 << (2 * gi), L = S_ / dil, r = w & (dil - 1), nb = w >> (2 * gi), head = gi * 4 + hg;
#pragma unroll
        for (int k = 0; k < 3; ++k) {
            const int item = tg + 256 * k, row = item >> 2, c = item & 3, mm = nb * 64 - 64 + row;
            v4u o0 = {0u, 0u, 0u, 0u}, o1 = {0u, 0u, 0u, 0u};
            if (mm >= 0 && mm < L) {
                const int tok = mm * dil + r;
                const bf16* kp = PA + (size_t)tok * 2304 + 768 + head * 64 + 8 * c;
                const v4u x0 = *(const v4u*)kp, x1 = *(const v4u*)(kp + 32);
                const f32x4* cp = (const f32x4*)(rope + (size_t)tok * 32 + 8 * c); const f32x4* sp = (const f32x4*)(rope + (size_t)S_ * 32 + (size_t)tok * 32 + 8 * c);
                const f32x4 c0 = cp[0], c1 = cp[1], s0 = sp[0], s1 = sp[1];
                const float cs[8] = {c0.x, c0.y, c0.z, c0.w, c1.x, c1.y, c1.z, c1.w}, sn[8] = {s0.x, s0.y, s0.z, s0.w, s1.x, s1.y, s1.z, s1.w};
                const unsigned xa[4] = {x0.x, x0.y, x0.z, x0.w}, xb[4] = {x1.x, x1.y, x1.z, x1.w};
                unsigned ra[4], rb[4];
#pragma unroll
                for (int e = 0; e < 4; ++e) {
                    const float a0 = bflo(xa[e]), a1 = bfhi(xa[e]), b0 = bflo(xb[e]), b1 = bfhi(xb[e]);
                    ra[e] = pk2(a0 * cs[2 * e] - b0 * sn[2 * e], a1 * cs[2 * e + 1] - b1 * sn[2 * e + 1]);
                    rb[e] = pk2(b0 * cs[2 * e] + a0 * sn[2 * e], b1 * cs[2 * e + 1] + a1 * sn[2 * e + 1]);
                }
                o0.x = ra[0]; o0.y = ra[1]; o0.z = ra[2]; o0.w = ra[3]; o1.x = rb[0]; o1.y = rb[1]; o1.z = rb[2]; o1.w = rb[3];
            }
            *(LAS v4u*)(Kl + row * AT_PITCH + 16 * c) = o0; *(LAS v4u*)(Kl + row * AT_PITCH + 64 + 16 * c) = o1;
        }
#pragma unroll
        for (int k = 0; k < 6; ++k) {
            const int item = tg + 256 * k, row = item >> 3, c = item & 7, mm = nb * 64 - 64 + row;
            v4u o = {0u, 0u, 0u, 0u};
            if (mm >= 0 && mm < L) o = *(const v4u*)(PA + (size_t)(mm * dil + r) * 2304 + 1536 + head * 64 + 8 * c);
            *(LAS v4u*)(Vl + row * AT_PITCH + 16 * c) = o;
        }
        bf16x8_t bq0, bq1;
        const int qi = 16 * wq + m16, qtok = (nb * 64 + qi) * dil + r;
        {
            const bf16* qp = PA + (size_t)qtok * 2304 + head * 64 + 8 * g;
            const v4u x0 = *(const v4u*)qp, x1 = *(const v4u*)(qp + 32);
            const f32x4* cp = (const f32x4*)(rope + (size_t)qtok * 32 + 8 * g); const f32x4* sp = (const f32x4*)(rope + (size_t)S_ * 32 + (size_t)qtok * 32 + 8 * g);
            const f32x4 c0 = cp[0], c1 = cp[1], s0 = sp[0], s1 = sp[1];
            const float cs[8] = {c0.x, c0.y, c0.z, c0.w, c1.x, c1.y, c1.z, c1.w}, sn[8] = {s0.x, s0.y, s0.z, s0.w, s1.x, s1.y, s1.z, s1.w};
            const unsigned xa[4] = {x0.x, x0.y, x0.z, x0.w}, xb[4] = {x1.x, x1.y, x1.z, x1.w};
            v4u ra, rb; unsigned* rap = (unsigned*)&ra; unsigned* rbp = (unsigned*)&rb; (void)rap; (void)rbp;
            unsigned ta[4], tb[4];
#pragma unroll
            for (int e = 0; e < 4; ++e) {
                const float a0 = bflo(xa[e]), a1 = bfhi(xa[e]), b0 = bflo(xb[e]), b1 = bfhi(xb[e]);
                ta[e] = pk2(0.125f * (a0 * cs[2 * e] - b0 * sn[2 * e]), 0.125f * (a1 * cs[2 * e + 1] - b1 * sn[2 * e + 1]));
                tb[e] = pk2(0.125f * (b0 * cs[2 * e] + a0 * sn[2 * e]), 0.125f * (b1 * cs[2 * e + 1] + a1 * sn[2 * e + 1]));
            }
            ra.x = ta[0]; ra.y = ta[1]; ra.z = ta[2]; ra.w = ta[3]; rb.x = tb[0]; rb.y = tb[1]; rb.z = tb[2]; rb.w = tb[3];
            bq0 = __builtin_bit_cast(bf16x8_t, ra); bq1 = __builtin_bit_cast(bf16x8_t, rb);
        }
        __syncthreads();
        f32x4 st[12];
#pragma unroll
        for (int kt = 0; kt < 12; ++kt) {
            const LAS unsigned char* ap = Kl + (16 * kt + m16) * AT_PITCH + 16 * g;
            f32x4 z = {0.f, 0.f, 0.f, 0.f};
            z = MFMA16(*(const LAS bf16x8_t*)ap, bq0, z);
            st[kt] = MFMA16(*(const LAS bf16x8_t*)(ap + 64), bq1, z);
        }
        float mx = -1e30f;
#pragma unroll
        for (int kt = 0; kt < 12; ++kt)
#pragma unroll
            for (int rg = 0; rg < 4; ++rg) { const int j = 16 * kt + 4 * g + rg, dj = j - qi, mm = nb * 64 - 64 + j;
                const bool ok = (dj >= 0) && (dj <= 128) && (mm >= 0) && (mm < L);
                st[kt][rg] = ok ? st[kt][rg] : -1e30f; mx = fmaxf(mx, st[kt][rg]); }
        mx = fmaxf(mx, __shfl_xor(mx, 16)); mx = fmaxf(mx, __shfl_xor(mx, 32));
        float sum = 0.f;
#pragma unroll
        for (int kt = 0; kt < 12; ++kt)
#pragma unroll
            for (int rg = 0; rg < 4; ++rg) { const float p = __expf(st[kt][rg] - mx); st[kt][rg] = p; sum += p; }
        sum += __shfl_xor(sum, 16); sum += __shfl_xor(sum, 32);
        f32x4 o[4];
#pragma unroll
        for (int dt = 0; dt < 4; ++dt) o[dt] = (f32x4){0.f, 0.f, 0.f, 0.f};
#pragma unroll
        for (int kk = 0; kk < 6; ++kk) {
            v4u pb; pb.x = pk2(st[2 * kk][0], st[2 * kk][1]); pb.y = pk2(st[2 * kk][2], st[2 * kk][3]); pb.z = pk2(st[2 * kk + 1][0], st[2 * kk + 1][1]); pb.w = pk2(st[2 * kk + 1][2], st[2 * kk + 1][3]);
            const bf16x8_t b = __builtin_bit_cast(bf16x8_t, pb);
#pragma unroll
            for (int dt = 0; dt < 4; ++dt) {
                const LAS unsigned char* tp = Vl + (32 * kk + 4 * g + (m16 >> 2)) * AT_PITCH + (16 * dt + 4 * (m16 & 3)) * 2;
                const s16x4_t lo = __builtin_amdgcn_ds_read_tr16_b64_v4i16((LAS s16x4_t*)tp);
                const s16x4_t hi = __builtin_amdgcn_ds_read_tr16_b64_v4i16((LAS s16x4_t*)(tp + 16 * AT_PITCH));
                const bf16x8_t a = {lo[0], lo[1], lo[2], lo[3], hi[0], hi[1], hi[2], hi[3]};
                o[dt] = MFMA16(a, b, o[dt]);
            }
        }
        const float il = 1.0f / sum;
        bf16* op = OG + ((size_t)gi * S_ + qtok) * 256 + hg * 64 + 4 * g;
#pragma unroll
        for (int dt = 0; dt < 4; ++dt) { v2u wv2; wv2.x = pk2(o[dt][0] * il, o[dt][1] * il); wv2.y = pk2(o[dt][2] * il, o[dt][3] * il); *(v2u*)(op + 16 * dt) = wv2; }
        if (g == 0) LSE[((size_t)gi * S_ + qtok) * 4 + hg] = mx + logf(sum);
        __syncthreads();
    }
}
constexpr int LDS_RING = 146432, LDS_CTL_OFF = LDS_RING, LDS_BYTES = 147456;
constexpr int CW_BAR = 4096;
#ifndef PROBE_ID
#define PROBE_ID (-1)
#endif
__device__ __forceinline__ unsigned char* wsp() { return PWS; }
template <class Epi> __device__ __forceinline__ void run_gemm(LAS unsigned char* lds, const bf16* A, const bf16* Bt, int N, int K, const Epi& E, int wv) {
    pg8::Gemm g{A, Bt, S_, N, K, 0};
    pg8::StaticOrder S; S.init(S_, N, GSZ, BID);
    pg8::gemm_phase<Epi, pg8::StaticOrder, true, true>(lds, g, S, E, wv);
}
#define GRID_BAR() do { XcdBarrier b_; b_.bar = (unsigned*)(wsp() + WS_CTL) + CW_BAR; b_.st = (volatile LAS unsigned*)(lds + LDS_CTL_OFF + 320) + 8; b_.x = b_.st[2]; xcd_barrier(b_, wv); } while (0)
#define PHASE(id, ...) do { { __VA_ARGS__ } if (PROBE_ID == (id)) { GRID_BAR(); { __VA_ARGS__ } } } while (0)
#define WS_R_PTRS unsigned char* ws = wsp(); unsigned char* R = ws + WS_R; (void)R;

template <int l, int f> __device__ __forceinline__ void ffn_block(LAS unsigned char* lds, unsigned char* lds_raw, int wv) {
    constexpr int s = f * 2;
    PHASE(1, WS_R_PTRS
        pg8::EpiSwiglu E; E.O = (bf16*)(R + R_ACT); E.ldc = FF_; E.pad_ = 0; run_gemm(lds, (const bf16*)(ws + WS_H), (const bf16*)(ws + WS_W + (f ? W_FFIN1 : W_FFIN0)), 2 * FF_, 1024, E, wv); );
    GRID_BAR();
    PHASE(2, WS_R_PTRS
        pg8::EpiBf16P E; E.O = (bf16*)(R + R_Y); E.ldc = 1024; E.pad_ = 0; run_gemm(lds, (const bf16*)(R + R_ACT), (const bf16*)(ws + WS_W + (f ? W_FFOUT1 : W_FFOUT0)), 1024, FF_, E, wv); );
    GRID_BAR();
    {   WS_R_PTRS const float* MOD = (const float*)(ws + WS_MOD); const float* mod = MOD + l * 9216;
        RowArgs a; a.xi = (l == 0 && f == 0) ? PIN(0) : POUT; a.y = (const bf16*)(R + R_Y); a.xo = POUT; a.wpost = PIN(6) + (l * 3 + s) * 1024; a.gate = mod + (s * 3 + 2) * 1024; a.coef = 0.5f;
        if (f == 0) { a.h = (bf16*)(ws + WS_H); a.wpre = PIN(5) + (l * 3 + 1) * 1024; a.shift = mod + (1 * 3 + 0) * 1024; a.scale = mod + (1 * 3 + 1) * 1024; }
        else if (l == 0) { a.h = (bf16*)(ws + WS_H); a.wpre = PIN(5) + (1 * 3 + 0) * 1024; a.shift = MOD + 9216; a.scale = MOD + 9216 + 1024; }
        else { a.h = nullptr; a.wpre = nullptr; a.shift = nullptr; a.scale = nullptr; }
        ph_rows(a, wv);
        if (f == 1 && l == 0) ph_convert(1, lds_raw, wv); }
    GRID_BAR();
}
template <int l> __device__ __forceinline__ void mixer_block(LAS unsigned char* lds, unsigned char* lds_raw, int wv) {
    PHASE(3, WS_R_PTRS
        pg8::EpiInProj E; E.PA = (bf16*)(R + R_PA); E.PD = (bf16*)(R + R_PD); E.PZ = (bf16*)(R + R_PZ); E.AB = (float*)(R + R_AB);
        run_gemm(lds, (const bf16*)(ws + WS_H), (const bf16*)(ws + WS_W + W_IN), 5632, 1024, E, wv); );
    GRID_BAR();
    PHASE(4, WS_R_PTRS
        ph_attn((const bf16*)(R + R_PA), (const float*)(ws + WS_ROPE), (bf16*)(R + R_OG), (float*)(R + R_LSE), lds, wv); );
    GRID_BAR();
    PHASE(5, WS_R_PTRS
        ph_dnprep((const bf16*)(R + R_PD), (const float*)(R + R_AB), PIN(10) + (size_t)l * 5 * 2304, PIN(11) + l * 12, PIN(12) + l * 12, (bf16*)(R + R_QKVD), (float*)(R + R_GB),
                  (const bf16*)(R + R_OG), (const float*)(R + R_LSE), (bf16*)(R + R_OATT), wv); );
    GRID_BAR();
    PHASE(6, WS_R_PTRS
        ph_dn_pre((const bf16*)(R + R_QKVD), (const float*)(R + R_GB), (bf16*)(R + R_TINV), (bf16*)(R + R_ATTN), (float*)(R + R_VEC), lds_raw, wv); );
    GRID_BAR();
    PHASE(7, WS_R_PTRS
        ph_dn_scan<1>((const bf16*)(R + R_QKVD), (const bf16*)(R + R_TINV), (const bf16*)(R + R_ATTN), (const float*)(R + R_VEC), (bf16*)(R + R_ODIR0), (bf16*)(R + R_ODIR1), (float*)(ws + WS_W + W_FFIN0), lds, wv); );
    GRID_BAR();
    PHASE(13, WS_R_PTRS
        ph_dn_scan<2>((const bf16*)(R + R_QKVD), (const bf16*)(R + R_TINV), (const bf16*)(R + R_ATTN), (const float*)(R + R_VEC), (bf16*)(R + R_ODIR0), (bf16*)(R + R_ODIR1), (float*)(ws + WS_W + W_FFIN0), lds, wv); );
    GRID_BAR();
    PHASE(8, WS_R_PTRS
        pg8::EpiBf16P E; E.O = (bf16*)(R + R_PG); E.ldc = 2048; E.pad_ = 0;
        run_gemm(lds, (const bf16*)(ws + WS_H), (const bf16*)(ws + WS_W + W_IN) + (size_t)5632 * 1024, 2048, 1024, E, wv); );
    PHASE(9, WS_R_PTRS
        ph_final((const bf16*)(R + R_ODIR0), (const bf16*)(R + R_ODIR1), (const bf16*)(R + R_PZ), PIN(13) + l * 128, (bf16*)(R + R_ODN), wv); );
    GRID_BAR();
    PHASE(10, { WS_R_PTRS
        pg8::EpiGateF32 E; E.O = (float*)(R + R_T1); E.gate = (const bf16*)(R + R_PG); E.ldg = 2048; E.pad_ = 0;
        run_gemm(lds, (const bf16*)(R + R_OATT), (const bf16*)(ws + WS_W + W_BATT), 1024, 256, E, wv); }
        { WS_R_PTRS
        pg8::EpiGateAddBf16 E; E.O = (bf16*)(ws + WS_H); E.T1 = (const float*)(R + R_T1); E.gate = (const bf16*)(R + R_PG) + 1024; E.ldg = 2048; E.pad_ = 0;
        run_gemm(lds, (const bf16*)(R + R_ODN), (const bf16*)(ws + WS_W + W_BDN), 1024, 768, E, wv); } );
    GRID_BAR();
    PHASE(11, WS_R_PTRS
        pg8::EpiBf16P E; E.O = (bf16*)(R + R_Y2); E.ldc = 1024; E.pad_ = 0; run_gemm(lds, (const bf16*)(ws + WS_H), (const bf16*)(ws + WS_W + W_OUT), 1024, 1024, E, wv); );
    GRID_BAR();
    {   WS_R_PTRS const float* mod = (const float*)(ws + WS_MOD) + l * 9216;
        RowArgs a; a.xi = POUT; a.y = (const bf16*)(R + R_Y2); a.xo = POUT; a.h = (bf16*)(ws + WS_H); a.wpost = PIN(6) + (l * 3 + 1) * 1024; a.gate = mod + (1 * 3 + 2) * 1024; a.coef = 1.0f;
        a.wpre = PIN(5) + (l * 3 + 2) * 1024; a.shift = mod + (2 * 3 + 0) * 1024; a.scale = mod + (2 * 3 + 1) * 1024; ph_rows(a, wv); }
    GRID_BAR();
}
__global__ void __launch_bounds__(NTHREADS, 2) mega_fwd(Params P) {
    extern __shared__ __attribute__((aligned(16))) unsigned char lds_raw[];
    LAS unsigned char* lds = (LAS unsigned char*)lds_raw;
    const int wv = __builtin_amdgcn_readfirstlane((int)threadIdx.x >> 6);
    { const int tid0 = threadIdx.x;
      for (int u = tid0; u < (LDS_BYTES - LDS_CTL_OFF) / 4; u += NTHREADS) ((LAS unsigned*)(lds + LDS_CTL_OFF))[u] = 0u;
      __syncthreads();
      XcdBarrier b0 = xcd_barrier_post((unsigned*)(PWS + WS_CTL) + CW_BAR, (volatile LAS unsigned*)(lds + LDS_CTL_OFF + 320) + 8);
      if (tid0 == 0) ((volatile LAS unsigned*)(lds + LDS_CTL_OFF + 320))[10] = b0.x;
      __syncthreads(); }
    PHASE(0, ph_ada(lds_raw, wv); ph_rope(wv); ph_convert(0, lds_raw, wv); );
    GRID_BAR();
    PHASE(12, WS_R_PTRS float* MOD = (float*)(ws + WS_MOD);
      RowArgs a; a.xi = PIN(0); a.y = nullptr; a.xo = nullptr; a.h = (bf16*)(ws + WS_H); a.wpost = nullptr; a.gate = nullptr; a.wpre = PIN(5); a.shift = MOD; a.scale = MOD + 1024; a.coef = 0.f; ph_rows(a, wv); );
    GRID_BAR();
    ffn_block<0, 0>(lds, lds_raw, wv); mixer_block<0>(lds, lds_raw, wv); ffn_block<0, 1>(lds, lds_raw, wv);
    ffn_block<1, 0>(lds, lds_raw, wv); mixer_block<1>(lds, lds_raw, wv); ffn_block<1, 1>(lds, lds_raw, wv);
}

extern "C" void kernel_launch(void* const* d_in, const int* in_sizes, int n_in, void* d_out, int out_size, void* d_ws, size_t ws_size, hipStream_t stream) {
    static int grid = 0;
    if (grid == 0) {
        if (n_in != 17 || ws_size < WS_END) { fprintf(stderr, "kernel_launch: unexpected n_in %d / ws_size %zu\n", n_in, ws_size); grid = -1; return; }
        int dev = 0, cus = 0, per_cu = 0;
        if (hipGetDevice(&dev) != hipSuccess || hipDeviceGetAttribute(&cus, hipDeviceAttributeMultiprocessorCount, dev) != hipSuccess) { grid = -1; return; }
        if (hipFuncSetAttribute((const void*)mega_fwd, hipFuncAttributeMaxDynamicSharedMemorySize, LDS_BYTES) != hipSuccess) { fprintf(stderr, "kernel_launch: hipFuncSetAttribute failed\n"); grid = -1; return; }
        if (hipOccupancyMaxActiveBlocksPerMultiprocessor(&per_cu, (const void*)mega_fwd, NTHREADS, LDS_BYTES) != hipSuccess || per_cu < 1) { fprintf(stderr, "kernel_launch: occupancy query says %d\n", per_cu); per_cu = 1; }
        (void)hipGetLastError();
        grid = cus;
        if (grid > 256) grid = 256;
    }
    if (grid < 0) return;
    (void)hipMemsetAsync((char*)d_ws + WS_CTL, 0, 1 * MiB, stream);
    Params p{};
    for (int i = 0; i < 17; ++i) p.in[i] = (const float*)d_in[i];
    p.out = (float*)d_out; p.ws = (unsigned char*)d_ws;
    hipLaunchKernelGGL(mega_fwd, dim3(grid), dim3(NTHREADS), LDS_BYTES, stream, p);
}
```

```cpp
#include <hip/hip_runtime.h>
#include <cstdio>
#include <cstdint>
__device__ __forceinline__ int lane_id_() { int l; asm volatile("v_mbcnt_lo_u32_b32 %0, -1, 0\n\tv_mbcnt_hi_u32_b32 %0, -1, %0" : "=v"(l)); return l; }
namespace pg8 {
#define PG8_LAS __attribute__((address_space(3)))
typedef unsigned short bf16_t;
typedef short bf16x8 __attribute__((ext_vector_type(8)));
typedef float f32x4 __attribute__((ext_vector_type(4)));
typedef unsigned u32x4 __attribute__((ext_vector_type(4)));
constexpr int BM = 256, BK = 64, HALF = 128, HTB = HALF * BK * 2  , STAGE_BYTES = 8 * HTB, NXCD = 8, WGM = 8;

__host__ __device__ __forceinline__ int lds_byte(int r, int c) { const int st = (r >> 4) * 2 + (c >> 5), rr = r & 15, cc = c & 31, ob = rr * 64 + cc * 2; return st * 1024 + (ob ^ (((ob >> 9) & 1) << 5)); }
__host__ __device__ __forceinline__ void stage_rc(int b, int& R, int& C) { const int st = b / 1024, sb = b % 1024, swz = sb ^ (((sb >> 9) & 1) << 5); R = (st >> 1) * 16 + swz / 64; C = (st & 1) * 32 + (swz % 64) / 2; }
__host__ __device__ __forceinline__ int perm32(int rho) { const int n = rho >> 4, i = rho & 15; return 8 * (i >> 2) + 4 * n + (i & 3); }

struct Unit { int pm, pn; };
struct Gemm { const bf16_t* A; const bf16_t* Bt; int M, N, K, pad_; };

struct StaticOrder {
    int nM, nN, nwg, G, c;
    __host__ __device__ void init(int M, int N, int G_, int c_) { nM = M / BM; nN = N / BM; nwg = nM * nN; G = G_; c = c_; }
    __host__ __device__ bool next(int i, Unit& u) const {
        const long L = (long)i * G + c; if (L >= nwg) return false;
        int wgid = (int)L; { const int q = nwg / NXCD, r = nwg % NXCD, xcd = wgid % NXCD, off = wgid / NXCD; wgid = (xcd < r ? xcd * (q + 1) : r * (q + 1) + (xcd - r) * q) + off; }
        const int nig = WGM * nN, gid = wgid / nig, fm = gid * WGM, gsz = (nM - fm) < WGM ? (nM - fm) : WGM;
        u.pm = fm + ((wgid % nig) % gsz); u.pn = (wgid % nig) / gsz; return true;
    }
    __device__ __forceinline__ void a_ready(const Unit&) const {}
    __device__ __forceinline__ void done(const Unit&) const {}
};

__device__ __forceinline__ unsigned cvt_pk_bf16(float lo, float hi) { unsigned r; asm volatile("v_cvt_pk_bf16_f32 %0, %1, %2" : "=v"(r) : "v"(lo), "v"(hi)); return r; }
typedef float f32x2 __attribute__((ext_vector_type(2)));
__device__ __forceinline__ f32x2 gelu_pk(f32x2 v) {
    const f32x2 av = __builtin_elementwise_abs(v), d = av * 0.2316418882f + 1.0f;
    f32x2 t; t.x = __builtin_amdgcn_rcpf(d.x); t.y = __builtin_amdgcn_rcpf(d.y);
    f32x2 q = t * 0.5307027145f + (-0.7265760135f); q = q * t + 0.7107068705f; q = q * t + (-0.142248368f); q = q * t + 0.127414796f; q = q * t;
    const f32x2 s = (v * v) * (-0.72134752044f);
    f32x2 e; e.x = __builtin_amdgcn_exp2f(s.x); e.y = __builtin_amdgcn_exp2f(s.y);
    const f32x2 m = v * (q * e), r = v - m;
    f32x2 o; o.x = v.x < 0.f ? m.x : r.x; o.y = v.y < 0.f ? m.y : r.y; return o;
}

template <int ACT  > struct EpiBf16 {
    static constexpr bool PERM = true, AFTER_DRAIN = false; static_assert(ACT == 0 || ACT == 1, "EpiBf16: ACT is 0 (none) or 1 (gelu_pk)");
    bf16_t* O; int ldc; const float* bias; int split_cols; size_t split_stride; float scale0;
    __device__ __forceinline__ void operator()(const f32x4 (&acc)[2][2][4][2], const Unit& u, int wr, int wc, int fr, int fq) const {
        const int row0 = u.pm * BM + wr * 64 + fr; int colt = u.pn * BM; bf16_t* base = O;
        float sc = 1.f; if (split_cols) { const int t = colt / split_cols; base += (size_t)t * split_stride; colt -= t * split_cols; if (t == 0) sc = scale0; }
        const int col0 = colt + wc * 32 + 8 * fq, bcol0 = u.pn * BM + wc * 32 + 8 * fq;
        f32x4 bv[2][2];
#pragma unroll
        for (int bj = 0; bj < 2; ++bj)
#pragma unroll
            for (int n = 0; n < 2; ++n) bv[bj][n] = bias ? *(const f32x4*)(bias + bcol0 + bj * HALF + 4 * n) : (f32x4){0.f, 0.f, 0.f, 0.f};
#pragma unroll
        for (int ai = 0; ai < 2; ++ai)
#pragma unroll
            for (int m = 0; m < 4; ++m) { bf16_t* rowp = base + (size_t)(row0 + ai * HALF + m * 16) * ldc + col0;
#pragma unroll
                for (int bj = 0; bj < 2; ++bj) { f32x4 v0 = acc[ai][bj][m][0] + bv[bj][0], v1 = acc[ai][bj][m][1] + bv[bj][1];
                    if (ACT == 1) { f32x2 a = gelu_pk((f32x2){v0[0], v0[1]}), b = gelu_pk((f32x2){v0[2], v0[3]}), c = gelu_pk((f32x2){v1[0], v1[1]}), d = gelu_pk((f32x2){v1[2], v1[3]});
                        v0 = (f32x4){a.x, a.y, b.x, b.y}; v1 = (f32x4){c.x, c.y, d.x, d.y}; }
                    v0 = v0 * sc; v1 = v1 * sc; u32x4 w; w.x = cvt_pk_bf16(v0[0], v0[1]); w.y = cvt_pk_bf16(v0[2], v0[3]); w.z = cvt_pk_bf16(v1[0], v1[1]); w.w = cvt_pk_bf16(v1[2], v1[3]);
                    *(u32x4*)(rowp + bj * HALF) = w; } }
    }
};

struct PanelStats {
    unsigned* xbuf;
    unsigned* cnt;
    unsigned* tmo;
    int ntn; float eps;
    unsigned code;
    __device__ __forceinline__ bool run(const f32x4 (&v)[2][2][4][2], const Unit& u, int wr, int wc, int fr, int fq, PG8_LAS unsigned char* lds, int wid, int lane) const {
        typedef float f32x2v __attribute__((ext_vector_type(2)));
        PG8_LAS f32x2v* P = (PG8_LAS f32x2v*)lds;
        PG8_LAS f32x2v* S = (PG8_LAS f32x2v*)(lds + 8192);
        PG8_LAS unsigned* flag = (PG8_LAS unsigned*)(lds + 8192 + 2048);
#pragma unroll
        for (int ai = 0; ai < 2; ++ai)
#pragma unroll
            for (int m = 0; m < 4; ++m) {
                float s = 0.f;
#pragma unroll
                for (int bj = 0; bj < 2; ++bj)
#pragma unroll
                    for (int n = 0; n < 2; ++n) { const f32x4 x = v[ai][bj][m][n]; s += (x[0] + x[1]) + (x[2] + x[3]); }
                s += __shfl_xor(s, 16); s += __shfl_xor(s, 32);
                const float mw = s * (1.0f / 64.0f); float q = 0.f;
#pragma unroll
                for (int bj = 0; bj < 2; ++bj)
#pragma unroll
                    for (int n = 0; n < 2; ++n) { const f32x4 d = v[ai][bj][m][n] - mw; q += (d[0] * d[0] + d[1] * d[1]) + (d[2] * d[2] + d[3] * d[3]); }
                q += __shfl_xor(q, 16); q += __shfl_xor(q, 32);
                if (fq == 0) P[(ai * HALF + wr * 64 + m * 16 + fr) * 4 + wc] = (f32x2v){mw, q};
            }
        asm volatile("s_waitcnt lgkmcnt(0)" ::: "memory"); __builtin_amdgcn_s_barrier(); asm volatile("" ::: "memory");
#if defined(BROKEN_EXCHANGE_NO_WAIT)
#warning BROKEN CONTROL BUILD: the row-statistics exchange does not wait; results are wrong by design
        if (blockIdx.x >= 64) { const long long t0_ = clock64(); while (clock64() - t0_ < 60000) __builtin_amdgcn_s_sleep(8); }
#endif
        const int row = wid * 32 + (lane & 31);
        if (lane < 32) {
            const f32x2v a = P[row * 4 + 0], b = P[row * 4 + 1], c = P[row * 4 + 2], d = P[row * 4 + 3];
            const float mt = (a.x + b.x + c.x + d.x) * 0.25f;
            const float da = a.x - mt, db = b.x - mt, dc = c.x - mt, dd = d.x - mt;
            const float m2 = (a.y + b.y) + (c.y + d.y) + 64.0f * ((da * da + db * db) + (dc * dc + dd * dd));
            unsigned long long* slot = (unsigned long long*)xbuf + ((size_t)(u.pm * BM + row) * 4 + u.pn);
            __hip_atomic_store(slot, ((unsigned long long)__float_as_uint(m2) << 32) | __float_as_uint(mt), __ATOMIC_RELAXED, __HIP_MEMORY_SCOPE_AGENT);
        }
        asm volatile("s_waitcnt vmcnt(0)" ::: "memory");
        if (lane == 0) __hip_atomic_fetch_add(cnt + 64 * u.pm, 1u, __ATOMIC_RELAXED, __HIP_MEMORY_SCOPE_AGENT);
        if (wid == 0) {
            bool dead = false; const unsigned long long t0 = __builtin_amdgcn_s_memrealtime(); const unsigned want = 8u * (unsigned)ntn;
            for (;;) {
#if defined(BROKEN_EXCHANGE_NO_WAIT)
                break;
#endif
                if ((unsigned)__builtin_amdgcn_readfirstlane(__hip_atomic_load(cnt + 64 * u.pm, __ATOMIC_RELAXED, __HIP_MEMORY_SCOPE_AGENT)) >= want) break;
                if (__builtin_amdgcn_s_memrealtime() - t0 > 2000000ull) {
                    if (lane == 0) { unsigned expect = 0u; __hip_atomic_compare_exchange_strong(tmo + 1, &expect, code | (unsigned)(u.pm & 0xff), __ATOMIC_RELAXED, __ATOMIC_RELAXED, __HIP_MEMORY_SCOPE_AGENT);
                                     __hip_atomic_store(tmo, 1u, __ATOMIC_RELAXED, __HIP_MEMORY_SCOPE_AGENT); }
                    dead = true; break; }
                __builtin_amdgcn_s_sleep(2);
            }
            __builtin_amdgcn_fence(__ATOMIC_ACQUIRE, "agent");
            if (lane == 0) flag[0] = dead ? 1u : 0u;
        }
        asm volatile("s_waitcnt vmcnt(0) lgkmcnt(0)" ::: "memory"); __builtin_amdgcn_s_barrier(); asm volatile("" ::: "memory");
        const bool bad = flag[0] != 0u;
        if (lane < 32) {
            const unsigned long long* slot = (const unsigned long long*)xbuf + (size_t)(u.pm * BM + row) * 4; float mt[4], m2[4]; float ms = 0.f;
#pragma unroll
            for (int t = 0; t < 4; ++t) { if (t < ntn) { const unsigned long long w = __hip_atomic_load(slot + t, __ATOMIC_RELAXED, __HIP_MEMORY_SCOPE_AGENT); mt[t] = __uint_as_float((unsigned)w); m2[t] = __uint_as_float((unsigned)(w >> 32)); } else { mt[t] = 0.f; m2[t] = 0.f; } ms += mt[t]; }
            const float mean = ms / (float)ntn; float q = 0.f;
#pragma unroll
            for (int t = 0; t < 4; ++t) if (t < ntn) { const float dm = mt[t] - mean; q += m2[t] + 256.0f * dm * dm; }
            S[row] = (f32x2v){mean, 1.0f / sqrtf(q / (256.0f * (float)ntn) + eps)};
        }
        asm volatile("s_waitcnt lgkmcnt(0)" ::: "memory"); __builtin_amdgcn_s_barrier(); asm volatile("" ::: "memory");
        return bad;
    }
};
struct EpiLnRes {
    static constexpr bool PERM = false, AFTER_DRAIN = true;
    const float* base; float* out; int ldc; const float* bias; PanelStats st; unsigned poison;
    __device__ __forceinline__ void fused(f32x4 (&acc)[2][2][4][2], const Unit& u, int wr, int wc, int fr, int fq, PG8_LAS unsigned char* lds, int wid, int lane) const {
        typedef float f32x2v __attribute__((ext_vector_type(2)));
        const PG8_LAS f32x2v* S = (const PG8_LAS f32x2v*)(lds + 8192);
        const int col0 = u.pn * BM + wc * 32 + 4 * fq;
#pragma unroll
        for (int bj = 0; bj < 2; ++bj)
#pragma unroll
            for (int n = 0; n < 2; ++n) { const f32x4 bv = bias ? *(const f32x4*)(bias + col0 + bj * HALF + n * 16) : (f32x4){0.f, 0.f, 0.f, 0.f};
#pragma unroll
                for (int ai = 0; ai < 2; ++ai)
#pragma unroll
                    for (int m = 0; m < 4; ++m) acc[ai][bj][m][n] += bv; }
        f32x4 pre[4][2][2];
#pragma unroll
        for (int m = 0; m < 4; ++m) { const size_t off = (size_t)(u.pm * BM + wr * 64 + m * 16 + fr) * ldc + col0;
#pragma unroll
            for (int bj = 0; bj < 2; ++bj)
#pragma unroll
                for (int n = 0; n < 2; ++n) pre[m][bj][n] = *(const f32x4*)(base + off + bj * HALF + n * 16); }
        const bool bad = st.run(acc, u, wr, wc, fr, fq, lds, wid, lane) || poison != 0u;
        const float qnan = __builtin_nanf("");
#pragma unroll
        for (int ai = 0; ai < 2; ++ai)
#pragma unroll
            for (int m = 0; m < 4; ++m) { const int r = ai * HALF + wr * 64 + m * 16 + fr; const f32x2v sr = S[r]; const size_t off = (size_t)(u.pm * BM + r) * ldc + col0;
#pragma unroll
                for (int bj = 0; bj < 2; ++bj)
#pragma unroll
                    for (int n = 0; n < 2; ++n) { const f32x4 bs = ai == 0 ? pre[m][bj][n] : *(const f32x4*)(base + off + bj * HALF + n * 16); f32x4 o = bs + (acc[ai][bj][m][n] - sr.x) * sr.y;
                        if (bad) o = (f32x4){qnan, qnan, qnan, qnan}; *(f32x4*)(out + off + bj * HALF + n * 16) = o; }
                if (m & 1) asm volatile("" ::: "memory"); }
    }
};
struct EpiLnResLn {
    static constexpr bool PERM = false, AFTER_DRAIN = true;
    const float* base; float* out; bf16_t* xn; int ldc; const float* bias; PanelStats st1, st2; unsigned poison;
    __device__ __forceinline__ void fused(f32x4 (&acc)[2][2][4][2], const Unit& u, int wr, int wc, int fr, int fq, PG8_LAS unsigned char* lds, int wid, int lane) const {
        typedef float f32x2v __attribute__((ext_vector_type(2))); typedef unsigned u32x2v __attribute__((ext_vector_type(2)));
        const PG8_LAS f32x2v* S = (const PG8_LAS f32x2v*)(lds + 8192);
        const int col0 = u.pn * BM + wc * 32 + 4 * fq;
#pragma unroll
        for (int bj = 0; bj < 2; ++bj)
#pragma unroll
            for (int n = 0; n < 2; ++n) { const f32x4 bv = bias ? *(const f32x4*)(bias + col0 + bj * HALF + n * 16) : (f32x4){0.f, 0.f, 0.f, 0.f};
#pragma unroll
                for (int ai = 0; ai < 2; ++ai)
#pragma unroll
                    for (int m = 0; m < 4; ++m) acc[ai][bj][m][n] += bv; }
        bool bad = st1.run(acc, u, wr, wc, fr, fq, lds, wid, lane) || poison != 0u;
        const float qnan = __builtin_nanf("");
#pragma unroll
        for (int ai = 0; ai < 2; ++ai)
#pragma unroll
            for (int m = 0; m < 4; ++m) { const int r = ai * HALF + wr * 64 + m * 16 + fr; const f32x2v sr = S[r]; const size_t off = (size_t)(u.pm * BM + r) * ldc + col0;
#pragma unroll
                for (int bj = 0; bj < 2; ++bj)
#pragma unroll
                    for (int n = 0; n < 2; ++n) { const f32x4 bs = *(const f32x4*)(base + off + bj * HALF + n * 16); acc[ai][bj][m][n] = bs + (acc[ai][bj][m][n] - sr.x) * sr.y; }
                asm volatile("" : "+v"(acc[ai][0][m][0]), "+v"(acc[ai][0][m][1]), "+v"(acc[ai][1][m][0]), "+v"(acc[ai][1][m][1]));
                if (m & 1) asm volatile("" ::: "memory"); }
        const bool bad1 = bad;
        bad = st2.run(acc, u, wr, wc, fr, fq, lds, wid, lane) || bad;
#pragma unroll
        for (int ai = 0; ai < 2; ++ai)
#pragma unroll
            for (int m = 0; m < 4; ++m) { const int r = ai * HALF + wr * 64 + m * 16 + fr; const f32x2v sr = S[r]; const size_t off = (size_t)(u.pm * BM + r) * ldc + col0;
#pragma unroll
                for (int bj = 0; bj < 2; ++bj)
#pragma unroll
                    for (int n = 0; n < 2; ++n) { const f32x4 x1 = acc[ai][bj][m][n]; *(f32x4*)(out + off + bj * HALF + n * 16) = bad1 ? (f32x4){qnan, qnan, qnan, qnan} : x1;
                        const f32x4 o = (x1 - sr.x) * sr.y; u32x2v w; w.x = cvt_pk_bf16(o[0], o[1]); w.y = cvt_pk_bf16(o[2], o[3]);
                        if (bad) { w.x = 0x7fc07fc0u; w.y = 0x7fc07fc0u; } *(u32x2v*)(xn + off + bj * HALF + n * 16) = w; }
                asm volatile("" ::: "memory"); }
    }
};

template <class Epi, class Sched, bool ALIGN_EPI = false, bool SP2 = false>
__device__ __forceinline__ void gemm_phase(PG8_LAS unsigned char* lds, const Gemm g, const Sched& S, const Epi& E, int wv) {
    int tid_ = wv * 64 + lane_id_(); asm volatile("" : "+v"(tid_));
    const int tid = tid_, wid = __builtin_amdgcn_readfirstlane(tid >> 6), lane = tid & 63, wr = wid >> 2, wc = wid & 3, fr = lane & 15, fq = lane >> 4;
    const int K = g.K, nt = K / BK;
    unsigned voffA[2], voffB[2];
#pragma unroll
    for (int i = 0; i < 2; ++i) { int R, C; stage_rc(tid * 16 + i * 8192, R, C); const int Rb = Epi::PERM ? ((R & ~31) + perm32(R & 31)) : R;
        voffA[i] = (unsigned)(R * K + C) * 2u; voffB[i] = (unsigned)(Rb * K + C) * 2u; }
    const size_t kstep = (size_t)(BK * 2);
    const size_t hstep = (size_t)HALF * K * 2;
    const size_t tstep = 2 * hstep;
    const unsigned ldsw = (unsigned)wid * 1024u;
    const int aoff = lds_byte(wr * 64 + fr, fq * 8), boff = lds_byte(wc * 32 + fr, fq * 8);
#define PG8_SA(b, h) (((b) * 2 + (h)) * HTB)
#define PG8_SB(b, h) ((4 + (b) * 2 + (h)) * HTB)
#define PG8_STAGE(bufoff, gbase, voff) do { _Pragma("unroll") for (int _i = 0; _i < 2; ++_i) \
        __builtin_amdgcn_global_load_lds((const unsigned*)((const char*)(gbase) + (voff)[_i]), (PG8_LAS unsigned*)(lds + (bufoff) + ldsw + _i * 8192), 16, 0, 0); } while (0)
#define PG8_LDA(dst, b, h) do { _Pragma("unroll") for (int m = 0; m < 4; ++m) _Pragma("unroll") for (int k = 0; k < 2; ++k) dst[m][k] = *(const PG8_LAS bf16x8*)(lds + PG8_SA(b, h) + aoff + m * 2048 + k * 1024); } while (0)
#define PG8_LDB(dst, b, h) do { _Pragma("unroll") for (int n = 0; n < 2; ++n) _Pragma("unroll") for (int k = 0; k < 2; ++k) dst[n][k] = *(const PG8_LAS bf16x8*)(lds + PG8_SB(b, h) + boff + n * 2048 + k * 1024); } while (0)
#define PG8_MMA(ai, bj, At, Bt) do { __builtin_amdgcn_s_setprio(1); _Pragma("unroll") for (int m = 0; m < 4; ++m) _Pragma("unroll") for (int n = 0; n < 2; ++n) _Pragma("unroll") for (int k = 0; k < 2; ++k) \
        acc[ai][bj][m][n] = __builtin_amdgcn_mfma_f32_16x16x32_bf16(Bt[n][k], At[m][k], acc[ai][bj][m][n], 0, 0, 0); __builtin_amdgcn_s_setprio(0); } while (0)
#define PG8_WAIT_V(n) asm volatile("s_waitcnt vmcnt(" #n ")" ::: "memory")
#define PG8_WAIT_L(n) asm volatile("s_waitcnt lgkmcnt(" #n ")" ::: "memory")
#define PG8_BAR __builtin_amdgcn_s_barrier()
#define PG8_SCHED __builtin_amdgcn_sched_barrier(0)
    Unit cur, nxt; int ui = 0;
    if (!S.next(0, cur)) return;
    f32x4 acc[2][2][4][2];
#pragma unroll
    for (int a = 0; a < 2; ++a)
#pragma unroll
        for (int b = 0; b < 2; ++b)
#pragma unroll
            for (int m = 0; m < 4; ++m)
#pragma unroll
                for (int n = 0; n < 2; ++n) acc[a][b][m][n] = (f32x4){0.f, 0.f, 0.f, 0.f};
    bf16x8 At[4][2], B0[2][2], B1[2][2];
    const char* cA = (const char*)g.A + (size_t)cur.pm * tstep; const char* cB = (const char*)g.Bt + (size_t)cur.pn * tstep;
    S.a_ready(cur);
    if constexpr (SP2) {
        PG8_STAGE(PG8_SB(0, 0), cB, voffB); PG8_STAGE(PG8_SB(0, 1), cB + hstep, voffB); PG8_STAGE(PG8_SA(0, 0), cA, voffA); PG8_STAGE(PG8_SA(0, 1), cA + hstep, voffA);
        if (wr == 1) PG8_BAR;
        PG8_WAIT_V(2); PG8_BAR;
        PG8_STAGE(PG8_SB(1, 0), cB + kstep, voffB); PG8_STAGE(PG8_SA(1, 0), cA + kstep, voffA); PG8_STAGE(PG8_SB(1, 1), cB + hstep + kstep, voffB);
        PG8_WAIT_V(6); PG8_BAR;
    } else {
        PG8_STAGE(PG8_SB(0, 0), cB, voffB); PG8_STAGE(PG8_SA(0, 0), cA, voffA); PG8_STAGE(PG8_SB(0, 1), cB + hstep, voffB); PG8_STAGE(PG8_SA(0, 1), cA + hstep, voffA);
        if (wr == 1) PG8_BAR;
        PG8_WAIT_V(4); PG8_BAR;
        PG8_STAGE(PG8_SB(1, 0), cB + kstep, voffB); PG8_STAGE(PG8_SA(1, 0), cA + kstep, voffA); PG8_STAGE(PG8_SB(1, 1), cB + hstep + kstep, voffB);
        PG8_WAIT_V(6); PG8_BAR;
    }
    for (;;) {
        const bool has_next = S.next(ui + 1, nxt);
        const char* nA = has_next ? (const char*)g.A + (size_t)nxt.pm * tstep : cA; const char* nB = has_next ? (const char*)g.Bt + (size_t)nxt.pn * tstep : cB;
        for (int t = 0; t < nt; t += 2) {
            const bool last = (t == nt - 2);
            const char* a1 = cA + (size_t)(t + 1) * kstep;
            const char* a2 = last ? nA : cA + (size_t)(t + 2) * kstep; const char* b2 = last ? nB : cB + (size_t)(t + 2) * kstep;
            const char* a3 = a2 + kstep; const char* b3 = b2 + kstep;
            if (last && has_next) S.a_ready(nxt);
            if constexpr (SP2) {
            PG8_LDB(B0, 0, 0); PG8_LDB(B1, 0, 1); PG8_SCHED; PG8_LDA(At, 0, 0); PG8_STAGE(PG8_SA(1, 1), a1 + hstep, voffA);
            PG8_WAIT_V(8); PG8_WAIT_L(0); PG8_BAR; PG8_MMA(0, 0, At, B0); PG8_MMA(0, 1, At, B1); PG8_BAR; PG8_SCHED;
            PG8_LDA(At, 0, 1); PG8_STAGE(PG8_SB(0, 0), b2, voffB); PG8_STAGE(PG8_SB(0, 1), b2 + hstep, voffB); PG8_STAGE(PG8_SA(0, 0), a2, voffA);
            PG8_WAIT_V(8); PG8_WAIT_L(0); PG8_BAR; PG8_MMA(1, 0, At, B0); PG8_MMA(1, 1, At, B1); PG8_BAR; PG8_SCHED;
            PG8_LDB(B0, 1, 0); PG8_LDB(B1, 1, 1); PG8_SCHED; PG8_LDA(At, 1, 0); PG8_STAGE(PG8_SA(0, 1), a2 + hstep, voffA);
            PG8_WAIT_V(8); PG8_WAIT_L(0); PG8_BAR; PG8_MMA(0, 0, At, B0); PG8_MMA(0, 1, At, B1); PG8_BAR; PG8_SCHED;
            PG8_LDA(At, 1, 1); PG8_STAGE(PG8_SB(1, 0), b3, voffB); PG8_STAGE(PG8_SB(1, 1), b3 + hstep, voffB); PG8_STAGE(PG8_SA(1, 0), a3, voffA);
            PG8_WAIT_V(8); PG8_WAIT_L(0); PG8_BAR; PG8_MMA(1, 0, At, B0); PG8_MMA(1, 1, At, B1); PG8_BAR; PG8_SCHED;
            } else {
            PG8_LDB(B0, 0, 0); PG8_SCHED; PG8_LDA(At, 0, 0); PG8_STAGE(PG8_SA(1, 1), a1 + hstep, voffA);
            PG8_WAIT_L(8); PG8_BAR; PG8_WAIT_L(0); PG8_MMA(0, 0, At, B0); PG8_BAR; PG8_SCHED;
            PG8_LDB(B1, 0, 1); PG8_STAGE(PG8_SB(0, 0), b2, voffB);
            PG8_BAR; PG8_WAIT_L(0); PG8_MMA(0, 1, At, B1); PG8_BAR;
            PG8_LDA(At, 0, 1); PG8_STAGE(PG8_SA(0, 0), a2, voffA);
            PG8_BAR; PG8_WAIT_L(0); PG8_MMA(1, 0, At, B0); PG8_BAR; PG8_SCHED;
            PG8_STAGE(PG8_SB(0, 1), b2 + hstep, voffB);
            PG8_WAIT_V(6); PG8_BAR; PG8_MMA(1, 1, At, B1); PG8_BAR;
            PG8_LDB(B0, 1, 0); PG8_SCHED; PG8_LDA(At, 1, 0); PG8_STAGE(PG8_SA(0, 1), a2 + hstep, voffA);
            PG8_WAIT_L(8); PG8_BAR; PG8_WAIT_L(0); PG8_MMA(0, 0, At, B0); PG8_BAR; PG8_SCHED;
            PG8_LDB(B1, 1, 1); PG8_STAGE(PG8_SB(1, 0), b3, voffB);
            PG8_BAR; PG8_WAIT_L(0); PG8_MMA(0, 1, At, B1); PG8_BAR;
            PG8_LDA(At, 1, 1); PG8_STAGE(PG8_SA(1, 0), a3, voffA);
            PG8_BAR; PG8_WAIT_L(0); PG8_MMA(1, 0, At, B0); PG8_BAR; PG8_SCHED;
            PG8_STAGE(PG8_SB(1, 1), b3 + hstep, voffB);
            PG8_WAIT_V(6); PG8_BAR; PG8_MMA(1, 1, At, B1); PG8_BAR;
            }
        }
        if constexpr (ALIGN_EPI) { if (wr == 0) PG8_BAR; }
        if constexpr (!Epi::AFTER_DRAIN) { E(acc, cur, wr, wc, fr, fq); S.done(cur); }
        if (!has_next) break;
#pragma unroll
        for (int a = 0; a < 2; ++a)
#pragma unroll
            for (int b = 0; b < 2; ++b)
#pragma unroll
                for (int m = 0; m < 4; ++m)
#pragma unroll
                    for (int n = 0; n < 2; ++n) acc[a][b][m][n] = (f32x4){0.f, 0.f, 0.f, 0.f};
        cur = nxt; cA = nA; cB = nB; ++ui;
        if constexpr (ALIGN_EPI) { if (wr == 1) PG8_BAR; }
    }
    PG8_WAIT_V(0);
    if constexpr (!ALIGN_EPI) { if (wr == 0) PG8_BAR; }
    PG8_BAR;
    if constexpr (Epi::AFTER_DRAIN) { E.fused(acc, cur, wr, wc, fr, fq, lds, wid, lane); S.done(cur); }
#undef PG8_SA
#undef PG8_SB
#undef PG8_STAGE
#undef PG8_LDA
#undef PG8_LDB
#undef PG8_MMA
#undef PG8_WAIT_V
#undef PG8_WAIT_L
#undef PG8_BAR
#undef PG8_SCHED
}
}
constexpr int S_ = 16384, D_ = 1024, FF_ = 2816, NIN_ = 7448, NINP_ = 7680;
constexpr int NTHREADS = 512;
constexpr size_t MiB = 1u << 20;
constexpr size_t WS_CTL = 0;
constexpr size_t WS_MOD = 1 * MiB;
constexpr size_t WS_ROPE = 2 * MiB;
constexpr size_t WS_W = 6 * MiB;
constexpr size_t W_FFIN0 = 0, W_FFIN1 = 11 * MiB, W_FFOUT0 = 22 * MiB, W_FFOUT1 = 27 * MiB + MiB / 2, W_IN = 33 * MiB, W_BATT = 48 * MiB, W_BDN = 48 * MiB + MiB / 2, W_OUT = 50 * MiB;
constexpr size_t WS_H = 58 * MiB;
constexpr size_t WS_R = 90 * MiB;
constexpr size_t R_ACT = 0, R_Y = 88 * MiB;
constexpr size_t R_PA = 0, R_QKVD = 0, R_PG = 0, R_PD = 72 * MiB, R_TINV = 72 * MiB, R_ODIR1 = 120 * MiB, R_ODN = 72 * MiB, R_T1 = 96 * MiB, R_PZ = 144 * MiB, R_AB = 168 * MiB, R_GB = 170 * MiB,
                 R_OATT = 172 * MiB, R_ATTN = 180 * MiB, R_Y2 = 160 * MiB, R_OG = 228 * MiB, R_LSE = 252 * MiB, R_ODIR0 = 228 * MiB, R_VEC = 253 * MiB;
constexpr size_t WS_END = 352 * MiB;

typedef unsigned short bf16;
typedef unsigned v4u __attribute__((ext_vector_type(4)));
typedef unsigned v2u __attribute__((ext_vector_type(2)));
typedef float f32x4 __attribute__((ext_vector_type(4)));
typedef float f32x2 __attribute__((ext_vector_type(2)));
#define LAS __attribute__((address_space(3)))

typedef __bf16 bf16x2_hw __attribute__((ext_vector_type(2)));
__device__ __forceinline__ unsigned pk2(float lo, float hi) { f32x2 v = {lo, hi}; return __builtin_bit_cast(unsigned, __builtin_convertvector(v, bf16x2_hw)); }
__device__ __forceinline__ unsigned f2bf(float f) { return pk2(f, f) & 0xffffu; }
__device__ __forceinline__ float bf2f(unsigned short b) { return __builtin_bit_cast(float, (unsigned)b << 16); }
__device__ __forceinline__ float bflo(unsigned w) { return __builtin_bit_cast(float, w << 16); }
__device__ __forceinline__ float bfhi(unsigned w) { return __builtin_bit_cast(float, w & 0xffff0000u); }
__device__ __forceinline__ float wave_sum(float v) {
#pragma unroll
    for (int o = 1; o < 64; o <<= 1) v += __shfl_xor(v, o);
    return v;
}
__device__ __forceinline__ float sigmoidf_(float x) { return 1.0f / (1.0f + __expf(-x)); }
__device__ __forceinline__ float siluf_(float x) { return x / (1.0f + __expf(-x)); }

namespace pg8 {
struct EpiSwiglu {
    static constexpr bool PERM = true, AFTER_DRAIN = false;
    bf16_t* O; int ldc; int pad_;
    __device__ __forceinline__ void operator()(const f32x4 (&acc)[2][2][4][2], const Unit& u, int wr, int wc, int fr, int fq) const {
        const int row0 = u.pm * BM + wr * 64 + fr, col0 = u.pn * 128 + wc * 32 + 8 * fq;
#pragma unroll
        for (int ai = 0; ai < 2; ++ai)
#pragma unroll
            for (int m = 0; m < 4; ++m) {
                bf16_t* rowp = O + (size_t)(row0 + ai * HALF + m * 16) * ldc + col0;
                float v[8];
#pragma unroll
                for (int n = 0; n < 2; ++n)
#pragma unroll
                    for (int e = 0; e < 4; ++e) { const float g = acc[ai][0][m][n][e], uu = acc[ai][1][m][n][e]; v[n * 4 + e] = g * __builtin_amdgcn_rcpf(1.0f + __expf(-g)) * uu; }
                u32x4 w; w.x = cvt_pk_bf16(v[0], v[1]); w.y = cvt_pk_bf16(v[2], v[3]); w.z = cvt_pk_bf16(v[4], v[5]); w.w = cvt_pk_bf16(v[6], v[7]);
                *(u32x4*)rowp = w;
            }
    }
};
struct EpiBf16P {
    static constexpr bool PERM = true, AFTER_DRAIN = false;
    bf16_t* O; int ldc; int pad_;
    __device__ __forceinline__ void operator()(const f32x4 (&acc)[2][2][4][2], const Unit& u, int wr, int wc, int fr, int fq) const {
        const int row0 = u.pm * BM + wr * 64 + fr, col0 = u.pn * BM + wc * 32 + 8 * fq;
#pragma unroll
        for (int ai = 0; ai < 2; ++ai)
#pragma unroll
            for (int m = 0; m < 4; ++m) {
                bf16_t* rowp = O + (size_t)(row0 + ai * HALF + m * 16) * ldc + col0;
#pragma unroll
                for (int bj = 0; bj < 2; ++bj) { const f32x4 v0 = acc[ai][bj][m][0], v1 = acc[ai][bj][m][1];
                    u32x4 w; w.x = cvt_pk_bf16(v0[0], v0[1]); w.y = cvt_pk_bf16(v0[2], v0[3]); w.z = cvt_pk_bf16(v1[0], v1[1]); w.w = cvt_pk_bf16(v1[2], v1[3]);
                    *(u32x4*)(rowp + bj * HALF) = w; }
            }
    }
};
struct EpiF32 {
    static constexpr bool PERM = false, AFTER_DRAIN = false;
    float* O; int ldc; int pad_;
    __device__ __forceinline__ void operator()(const f32x4 (&acc)[2][2][4][2], const Unit& u, int wr, int wc, int fr, int fq) const {
        const int row0 = u.pm * BM + wr * 64 + fr, col0 = u.pn * BM + wc * 32 + 4 * fq;
#pragma unroll
        for (int ai = 0; ai < 2; ++ai)
#pragma unroll
            for (int m = 0; m < 4; ++m) {
                float* rowp = O + (size_t)(row0 + ai * HALF + m * 16) * ldc + col0;
#pragma unroll
                for (int bj = 0; bj < 2; ++bj)
#pragma unroll
                    for (int n = 0; n < 2; ++n) *(f32x4*)(rowp + bj * HALF + n * 16) = acc[ai][bj][m][n];
            }
    }
};
struct EpiInProj {
    static constexpr bool PERM = true, AFTER_DRAIN = false;
    bf16_t* PA; bf16_t* PD; bf16_t* PZ; float* AB;
    __device__ __forceinline__ void operator()(const f32x4 (&acc)[2][2][4][2], const Unit& u, int wr, int wc, int fr, int fq) const {
        const int row0 = u.pm * BM + wr * 64 + fr;
        if (u.pn == 21) {
            if (wc == 0) {
#pragma unroll
                for (int ai = 0; ai < 2; ++ai)
#pragma unroll
                    for (int m = 0; m < 4; ++m) {
                        float* rowp = AB + (size_t)(row0 + ai * HALF + m * 16) * 32 + 8 * fq;
                        *(f32x4*)rowp = acc[ai][0][m][0]; *(f32x4*)(rowp + 4) = acc[ai][0][m][1];
                    }
            }
            return;
        }
        bf16_t* base; int ldc, ct;
        if (u.pn < 9) { base = PA; ldc = 2304; ct = u.pn; } else if (u.pn < 18) { base = PD; ldc = 2304; ct = u.pn - 9; } else { base = PZ; ldc = 768; ct = u.pn - 18; }
        const int col0 = ct * BM + wc * 32 + 8 * fq;
#pragma unroll
        for (int ai = 0; ai < 2; ++ai)
#pragma unroll
            for (int m = 0; m < 4; ++m) {
                bf16_t* rowp = base + (size_t)(row0 + ai * HALF + m * 16) * ldc + col0;
#pragma unroll
                for (int bj = 0; bj < 2; ++bj) { const f32x4 v0 = acc[ai][bj][m][0], v1 = acc[ai][bj][m][1];
                    u32x4 w; w.x = cvt_pk_bf16(v0[0], v0[1]); w.y = cvt_pk_bf16(v0[2], v0[3]); w.z = cvt_pk_bf16(v1[0], v1[1]); w.w = cvt_pk_bf16(v1[2], v1[3]);
                    *(u32x4*)(rowp + bj * HALF) = w; }
            }
    }
};
struct EpiGateF32 {
    static constexpr bool PERM = false, AFTER_DRAIN = false;
    bf16_t* O; const bf16_t* gate; int ldg; int pad_;
    __device__ __forceinline__ void operator()(const f32x4 (&acc)[2][2][4][2], const Unit& u, int wr, int wc, int fr, int fq) const {
        const int row0 = u.pm * BM + wr * 64 + fr, col0 = u.pn * BM + wc * 32 + 4 * fq;
#pragma unroll
        for (int ai = 0; ai < 2; ++ai)
#pragma unroll
            for (int m = 0; m < 4; ++m) {
                const size_t r = (size_t)(row0 + ai * HALF + m * 16);
#pragma unroll
                for (int bj = 0; bj < 2; ++bj)
#pragma unroll
                    for (int n = 0; n < 2; ++n) { const int c = col0 + bj * HALF + n * 16;
                        const v2u gw = *(const v2u*)(gate + r * ldg + c);
                        f32x4 a = acc[ai][bj][m][n];
                        a[0] *= sigmoidf_(bflo(gw.x)); a[1] *= sigmoidf_(bfhi(gw.x)); a[2] *= sigmoidf_(bflo(gw.y)); a[3] *= sigmoidf_(bfhi(gw.y));
                        v2u w; w.x = cvt_pk_bf16(a[0], a[1]); w.y = cvt_pk_bf16(a[2], a[3]); *(v2u*)(O + r * 1024 + c) = w; }
            }
    }
};
struct EpiGateAddBf16 {
    static constexpr bool PERM = false, AFTER_DRAIN = false;
    bf16_t* O; const bf16_t* T1; const bf16_t* gate; int ldg; int pad_;
    __device__ __forceinline__ void operator()(const f32x4 (&acc)[2][2][4][2], const Unit& u, int wr, int wc, int fr, int fq) const {
        const int row0 = u.pm * BM + wr * 64 + fr, col0 = u.pn * BM + wc * 32 + 4 * fq;
#pragma unroll
        for (int ai = 0; ai < 2; ++ai)
#pragma unroll
            for (int m = 0; m < 4; ++m) {
                const size_t r = (size_t)(row0 + ai * HALF + m * 16);
#pragma unroll
                for (int bj = 0; bj < 2; ++bj)
#pragma unroll
                    for (int n = 0; n < 2; ++n) { const int c = col0 + bj * HALF + n * 16;
                        const v2u gw = *(const v2u*)(gate + r * ldg + c);
                        const v2u tw = *(const v2u*)(T1 + r * 1024 + c); const f32x4 t = {bflo(tw.x), bfhi(tw.x), bflo(tw.y), bfhi(tw.y)};
                        f32x4 a = acc[ai][bj][m][n];
                        a[0] = t[0] + a[0] * sigmoidf_(bflo(gw.x)); a[1] = t[1] + a[1] * sigmoidf_(bfhi(gw.x)); a[2] = t[2] + a[2] * sigmoidf_(bflo(gw.y)); a[3] = t[3] + a[3] * sigmoidf_(bfhi(gw.y));
                        v2u w; w.x = cvt_pk_bf16(a[0], a[1]); w.y = cvt_pk_bf16(a[2], a[3]);
                        *(v2u*)(O + r * 1024 + c) = w; }
            }
    }
};
}


#define GAS __attribute__((address_space(1)))
struct Params { const float* in[17]; float* out; unsigned char* ws; };
#define XB_TMO      128
#define XB_XCNT(j)  (256  + 64 * (j))
#define XB_XSUB(j)  (1280 + 64 * (j))
#define XB_XGEN(j)  (2304 + 64 * (j))
#define XB_TOP      3328
#define XB_TOPGEN   3392
#define XCD_BAR_WORDS 3456
#define XB_SPIN_CAP (1u << 18)

__device__ __forceinline__ unsigned xb_ld(unsigned* p)              { return __hip_atomic_load(p, __ATOMIC_RELAXED, __HIP_MEMORY_SCOPE_AGENT); }
__device__ __forceinline__ unsigned xb_add(unsigned* p, unsigned v) { return __hip_atomic_fetch_add(p, v, __ATOMIC_RELAXED, __HIP_MEMORY_SCOPE_AGENT); }
__device__ __forceinline__ unsigned xb_xcc_id() { return (unsigned)__builtin_amdgcn_s_getreg((3 << 11) | 20) & 0xFu; }
#define XB_SPIN(cond, bar) do { unsigned _sp = 0; while (cond) { __builtin_amdgcn_s_sleep(1); \
    if ((++_sp & 255u) == 0u) { if (xb_ld(&(bar)[XB_TMO])) break; if (_sp > XB_SPIN_CAP) { atomicAdd(&(bar)[XB_TMO], 1u); break; } } } } while (0)

struct XcdBarrier {
    unsigned* bar; unsigned x;
    volatile LAS unsigned* st;
};

__device__ __forceinline__ XcdBarrier xcd_barrier_post(unsigned* bar, volatile LAS unsigned* st) {
    XcdBarrier b; b.bar = bar; b.x = xb_xcc_id(); b.st = st;
    if (threadIdx.x == 0) (void)xb_add(&bar[XB_XCNT(b.x)], 1u);
    return b;
}
__device__ __forceinline__ void xcd_barrier_complete(unsigned* bar, unsigned x, unsigned& nloc, unsigned& nx) {
    const unsigned G = gridDim.x * gridDim.y * gridDim.z;
    unsigned sum, cnt, mine, sp = 0u;
    for (;;) {
        sum = 0u; cnt = 0u; mine = 0u;
#pragma unroll
        for (unsigned j = 0; j < 16; ++j) { const unsigned c = xb_ld(&bar[XB_XCNT(j)]); sum += c; cnt += (c > 0u) ? 1u : 0u; mine = (j == x) ? c : mine; }
        if (sum == G) break;
        __builtin_amdgcn_s_sleep(1);
        if ((++sp & 255u) == 0u) { if (xb_ld(&bar[XB_TMO])) break; if (sp > XB_SPIN_CAP) { atomicAdd(&bar[XB_TMO], 1u); break; } }
    }
    nloc = mine > 0u ? mine : 1u; nx = cnt > 0u ? cnt : 1u;
}

__device__ __forceinline__ void xcd_barrier(const XcdBarrier& b, int wv) {
    const bool leader_thread = (wv == 0) && (lane_id_() == 0);
    asm volatile("s_waitcnt vmcnt(0)" ::: "memory");
    __syncthreads();
    if (leader_thread) {
        unsigned* bar = b.bar;
        __builtin_amdgcn_s_waitcnt(0);
        unsigned nloc = b.st[0], nx = b.st[1];
        if (nloc == 0u) { xcd_barrier_complete(bar, b.x, nloc, nx); b.st[0] = nloc; b.st[1] = nx; }
        const unsigned old = xb_add(&bar[XB_XSUB(b.x)], 1u);
        const unsigned gen = old / nloc;
        if (old + 1u == (gen + 1u) * nloc) {
            __builtin_amdgcn_fence(__ATOMIC_RELEASE, "agent");
            asm volatile("s_waitcnt vmcnt(0)" ::: "memory");
            const unsigned og = xb_add(&bar[XB_TOP], 1u);
            const unsigned tg = og / nx;
            if (og + 1u == (tg + 1u) * nx) xb_add(&bar[XB_TOPGEN], 1u);
            else XB_SPIN(xb_ld(&bar[XB_TOPGEN]) == tg, bar);
            __builtin_amdgcn_fence(__ATOMIC_ACQUIRE, "agent");
            xb_add(&bar[XB_XGEN(b.x)], 1u);
            asm volatile("s_waitcnt vmcnt(0)" ::: "memory");
        } else {
            XB_SPIN(xb_ld(&bar[XB_XGEN(b.x)]) == gen, bar);
            __builtin_amdgcn_fence(__ATOMIC_ACQUIRE, "agent");
            asm volatile("s_waitcnt vmcnt(0)" ::: "memory");
        }
    }
    __syncthreads();
}

typedef const __attribute__((address_space(4))) unsigned char* ka_t;
__device__ __forceinline__ ka_t ka_() { ka_t k = (ka_t)__builtin_amdgcn_kernarg_segment_ptr(); asm volatile("" : "+s"(k)); return k; }
#define PIN(i) ((const float*)(const __attribute__((address_space(1))) float*)(*(const __attribute__((address_space(4))) unsigned long long*)(ka_() + 8 * (i))))
#define POUT ((float*)(__attribute__((address_space(1))) float*)(*(const __attribute__((address_space(4))) unsigned long long*)(ka_() + 136)))
#define PWS ((unsigned char*)(__attribute__((address_space(1))) unsigned char*)(*(const __attribute__((address_space(4))) unsigned long long*)(ka_() + 144)))
#define BID ((int)blockIdx.x)
#define GSZ ((int)gridDim.x)
__device__ __forceinline__ int srcmap(int mode, int n) {
    if (mode == 0) return n;
    if (mode == 1) return (n >> 8) * 128 + (n & 127) + ((n >> 7) & 1) * 2816;
    if (n < 5400) return n;
    if (n < 5632) return -1;
    if (n < 6656) return 5400 + (n - 5632);
    return 6424 + (n - 6656);
}
__device__ __forceinline__ void conv_item(const float* W, bf16* WT, int K, int Nsrc, int Ndst, int mode, int item, float* scr, int lane) {
    const int nblk = Ndst / 32, kb = item / nblk, nb = item % nblk, k0 = 64 * kb, n0 = 32 * nb;
    const int sc = srcmap(mode, n0 + (lane & 31));
#pragma unroll
    for (int i = 0; i < 32; ++i) { const int kk = 2 * i + (lane >> 5); scr[kk * 33 + (lane & 31)] = sc >= 0 ? W[(size_t)(k0 + kk) * Nsrc + sc] : 0.f; }
    __builtin_amdgcn_s_waitcnt(0xc07f); __builtin_amdgcn_wave_barrier();
    const int c = lane & 7;
#pragma unroll
    for (int j = 0; j < 4; ++j) { const int n = (lane >> 3) + 8 * j; const float* s = scr + (8 * c) * 33 + n;
        v4u o; o.x = pk2(s[0 * 33], s[1 * 33]); o.y = pk2(s[2 * 33], s[3 * 33]); o.z = pk2(s[4 * 33], s[5 * 33]); o.w = pk2(s[6 * 33], s[7 * 33]);
        *(v4u*)(WT + (size_t)(n0 + n) * K + k0 + 8 * c) = o; }
    __builtin_amdgcn_s_waitcnt(0xc07f); __builtin_amdgcn_wave_barrier();
}
__device__ __forceinline__ void ph_convert(int l, unsigned char* lds, int wv) {
    int tid_ = wv * 64 + lane_id_(); asm volatile("" : "+v"(tid_)); const int lane = tid_ & 63, wave = tid_ >> 6;
    float* scr = (float*)lds + wave * (64 * 33);
    unsigned char* wb = PWS + WS_W;
    constexpr int I_FI = 16 * 176, I_FO = 44 * 32, I_IN = 16 * 240, I_BA = 4 * 32, I_BD = 12 * 32, I_O = 16 * 32;
    constexpr int NIT = 2 * I_FI + 2 * I_FO + I_IN + I_BA + I_BD + I_O;
    for (int it = BID * 8 + wave; it < NIT; it += GSZ * 8) {
        int r = it;
        if (r < 2 * I_FI) { const int f = r / I_FI; conv_item(PIN(7) + ((size_t)l * 2 + f) * 1024 * 5632, (bf16*)(wb + (f ? W_FFIN1 : W_FFIN0)), 1024, 5632, 5632, 1, r % I_FI, scr, lane); continue; } r -= 2 * I_FI;
        if (r < 2 * I_FO) { const int f = r / I_FO; conv_item(PIN(8) + ((size_t)l * 2 + f) * 2816 * 1024, (bf16*)(wb + (f ? W_FFOUT1 : W_FFOUT0)), 2816, 1024, 1024, 0, r % I_FO, scr, lane); continue; } r -= 2 * I_FO;
        if (r < I_IN) { conv_item(PIN(9) + (size_t)l * 1024 * NIN_, (bf16*)(wb + W_IN), 1024, NIN_, NINP_, 2, r, scr, lane); continue; } r -= I_IN;
        if (r < I_BA) { conv_item(PIN(14) + (size_t)l * 256 * 1024, (bf16*)(wb + W_BATT), 256, 1024, 1024, 0, r, scr, lane); continue; } r -= I_BA;
        if (r < I_BD) { conv_item(PIN(15) + (size_t)l * 768 * 1024, (bf16*)(wb + W_BDN), 768, 1024, 1024, 0, r, scr, lane); continue; } r -= I_BD;
        conv_item(PIN(16) + (size_t)l * 1024 * 1024, (bf16*)(wb + W_OUT), 1024, 1024, 1024, 0, r, scr, lane);
    }
}
__device__ __forceinline__ void ph_ada(unsigned char* lds, int wv) {
    float* red = (float*)(lds + 72 * 1024);
    int tid_ = wv * 64 + lane_id_(); asm volatile("" : "+v"(tid_)); const int tid = tid_, lane = tid_ & 63, wave = tid_ >> 6;
    const float* c = PIN(1); const float* w_ada = PIN(3); const float* b_ada = PIN(4); float* mod = (float*)(PWS + WS_MOD);
    for (int u = BID; u < 72; u += GSZ) {
        const int l = u / 36, n0 = (u % 36) * 256;
        const float* W = w_ada + (size_t)l * 1024 * 9216 + (size_t)(wave * 128) * 9216 + n0 + 4 * lane;
        f32x4 acc = {0.f, 0.f, 0.f, 0.f};
#pragma unroll 1
        for (int k0 = 0; k0 < 128; k0 += 16) {
            f32x4 wv4[16];
#pragma unroll
            for (int kk = 0; kk < 16; ++kk) wv4[kk] = *(const f32x4*)(W + (size_t)(k0 + kk) * 9216);
#pragma unroll
            for (int kk = 0; kk < 16; ++kk) { const float cv = c[wave * 128 + k0 + kk]; const float sv = cv / (1.0f + __expf(-cv)); acc += sv * wv4[kk]; }
        }
        *(f32x4*)(red + wave * 256 + 4 * lane) = acc;
        __syncthreads();
        if (tid < 256) { float t = b_ada[l * 9216 + n0 + tid];
#pragma unroll
            for (int w = 0; w < 8; ++w) t += red[w * 256 + tid];
            mod[l * 9216 + n0 + tid] = t; }
        __syncthreads();
    }
}
__device__ const float ROPE_INV[32] = {1.000000000e+00f, 7.498942018e-01f, 5.623413324e-01f, 4.216965139e-01f, 3.162277639e-01f, 2.371373773e-01f, 1.778279394e-01f, 1.333521456e-01f, 1.000000015e-01f, 7.498942316e-02f, 5.623413250e-02f, 4.216964915e-02f, 3.162277490e-02f, 2.371373773e-02f, 1.778279431e-02f, 1.333521400e-02f, 9.999999776e-03f, 7.498942316e-03f, 5.623413250e-03f, 4.216964822e-03f, 3.162277630e-03f, 2.371373819e-03f, 1.778279431e-03f, 1.333521446e-03f, 1.000000047e-03f, 7.498941850e-04f, 5.623413017e-04f, 4.216965172e-04f, 3.162277571e-04f, 2.371373703e-04f, 1.778279402e-04f, 1.333521504e-04f};
__device__ __forceinline__ void ph_rope(int wv) {
    const int* pos = (const int*)PIN(2); float* tab = (float*)(PWS + WS_ROPE);
    int tid_ = wv * 64 + lane_id_(); asm volatile("" : "+v"(tid_));
    for (int idx = BID * NTHREADS + tid_; idx < S_ * 32; idx += GSZ * NTHREADS) {
        const int t = idx >> 5, i = idx & 31;
        const float inv = ROPE_INV[i];
        const float ang = (float)pos[t] * inv;
        float sn, cs; sincosf(ang, &sn, &cs);
        tab[idx] = cs; tab[S_ * 32 + idx] = sn;
    }
}
struct RowArgs { const float* xi; const bf16* y; float* xo; bf16* h; const float* wpost; const float* gate; const float* wpre; const float* shift; const float* scale; float coef; };
__device__ __forceinline__ void ph_rows(const RowArgs& a, int wv) {
    int tid_ = wv * 64 + lane_id_(); asm volatile("" : "+v"(tid_)); const int lane = tid_ & 63, wave = tid_ >> 6;
    for (int r = BID * 8 + wave; r < S_; r += GSZ * 8) {
        f32x4 x[4];
        const f32x4* xr = (const f32x4*)(a.xi + (size_t)r * D_) + lane;
#pragma unroll
        for (int j = 0; j < 4; ++j) x[j] = xr[64 * j];
        if (a.y) {
            f32x4 y[4]; float s = 0.f;
            const v2u* yr = (const v2u*)(a.y + (size_t)r * D_) + lane;
#pragma unroll
            for (int j = 0; j < 4; ++j) { const v2u yw = yr[64 * j]; y[j] = (f32x4){bflo(yw.x), bfhi(yw.x), bflo(yw.y), bfhi(yw.y)}; s += (y[j].x * y[j].x + y[j].y * y[j].y) + (y[j].z * y[j].z + y[j].w * y[j].w); }
            const float rs = 1.0f / sqrtf(wave_sum(s) * (1.f / D_) + 1e-6f);
#pragma unroll
            for (int j = 0; j < 4; ++j) { const f32x4 wp = ((const f32x4*)a.wpost)[lane + 64 * j], g = ((const f32x4*)a.gate)[lane + 64 * j];
                x[j] = x[j] + a.coef * g * ((y[j] * rs) * wp); }
            f32x4* xw = (f32x4*)(a.xo + (size_t)r * D_) + lane;
#pragma unroll
            for (int j = 0; j < 4; ++j) xw[64 * j] = x[j];
        }
        if (a.h) {
            float s = 0.f;
#pragma unroll
            for (int j = 0; j < 4; ++j) s += (x[j].x * x[j].x + x[j].y * x[j].y) + (x[j].z * x[j].z + x[j].w * x[j].w);
            const float rs = 1.0f / sqrtf(wave_sum(s) * (1.f / D_) + 1e-6f);
            v2u* hw = (v2u*)(a.h + (size_t)r * D_) + lane;
#pragma unroll
            for (int j = 0; j < 4; ++j) { const f32x4 wp = ((const f32x4*)a.wpre)[lane + 64 * j], sc = ((const f32x4*)a.scale)[lane + 64 * j], sh = ((const f32x4*)a.shift)[lane + 64 * j];
                const f32x4 v = ((x[j] * rs) * wp) * (1.0f + sc) + sh;
                v2u w; w.x = pk2(v.x, v.y); w.y = pk2(v.z, v.w); hw[64 * j] = w; }
        }
    }
}
constexpr int ATT_PITCH = 68;
__device__ __forceinline__ void ph_attn_v1(const bf16* PA, const float* rope, bf16* OG, float* LSE, unsigned char* lds, int wv) {
    float* qs = (float*)lds; float* ks = qs + 64 * ATT_PITCH; float* vs = ks + 192 * ATT_PITCH;
    int tid_ = wv * 64 + lane_id_(); asm volatile("" : "+v"(tid_)); const int tid = tid_, lane = tid & 63, wave = tid >> 6;
    for (int u = BID; u < 3072; u += GSZ) {
        const int hg = u & 3, w = (u >> 2) & 255, gi = u >> 10;
        const int dil = 1 << (2 * gi), L = S_ / dil, r = w % dil, nb = w / dil, head = gi * 4 + hg;
        __syncthreads();
        for (int rr = wave; rr < 448; rr += 8) {
            int mm, colbase; float* dst; bool rot; float sc = 1.f;
            if (rr < 64) { mm = nb * 64 + rr; colbase = head * 64; dst = qs + rr * ATT_PITCH; rot = true; sc = 0.125f; }
            else if (rr < 256) { mm = nb * 64 - 64 + (rr - 64); colbase = 768 + head * 64; dst = ks + (rr - 64) * ATT_PITCH; rot = true; }
            else { mm = nb * 64 - 64 + (rr - 256); colbase = 1536 + head * 64; dst = vs + (rr - 256) * ATT_PITCH; rot = false; }
            float val = 0.f;
            if (mm >= 0 && mm < L) {
                const int tok = mm * dil + r;
                val = bf2f(PA[(size_t)tok * 2304 + colbase + lane]);
                if (rot) {
                    const float other = __shfl_xor(val, 32);
                    const float cs = rope[tok * 32 + (lane & 31)], sn = rope[S_ * 32 + tok * 32 + (lane & 31)];
                    val = (lane < 32) ? (val * cs - other * sn) : (val * cs + other * sn);
                }
            }
            dst[lane] = val * sc;
        }
        __syncthreads();
        const int i = tid >> 3, part = tid & 7;
        float q[64], acc[64];
#pragma unroll
        for (int d = 0; d < 64; d += 4) { const f32x4 t = *(const f32x4*)(qs + i * ATT_PITCH + d); q[d] = t.x; q[d + 1] = t.y; q[d + 2] = t.z; q[d + 3] = t.w; }
#pragma unroll
        for (int d = 0; d < 64; ++d) acc[d] = 0.f;
        float m = -1e30f, l = 0.f;
        for (int jj = 0; jj < 24; ++jj) {
            const int j = part + 8 * jj, mm = nb * 64 - 64 + j, dj = j - 64 - i;
            const bool ok = (dj <= 64) && (dj >= -64) && (mm >= 0) && (mm < L);
            if (ok) {
                const float* kr = ks + j * ATT_PITCH; float s = 0.f;
#pragma unroll
                for (int d = 0; d < 64; d += 4) { const f32x4 t = *(const f32x4*)(kr + d); s += q[d] * t.x + q[d + 1] * t.y + q[d + 2] * t.z + q[d + 3] * t.w; }
                const float mn = fmaxf(m, s), al = __expf(m - mn), p = __expf(s - mn);
                l = l * al + p; m = mn;
                const float* vr = vs + j * ATT_PITCH;
#pragma unroll
                for (int d = 0; d < 64; d += 4) { const f32x4 t = *(const f32x4*)(vr + d);
                    acc[d] = acc[d] * al + p * t.x; acc[d + 1] = acc[d + 1] * al + p * t.y; acc[d + 2] = acc[d + 2] * al + p * t.z; acc[d + 3] = acc[d + 3] * al + p * t.w; }
            }
        }
        float mt = fmaxf(m, __shfl_xor(m, 1)); mt = fmaxf(mt, __shfl_xor(mt, 2)); mt = fmaxf(mt, __shfl_xor(mt, 4));
        const float f = __expf(m - mt);
        l *= f; l += __shfl_xor(l, 1); l += __shfl_xor(l, 2); l += __shfl_xor(l, 4);
#pragma unroll
        for (int d = 0; d < 64; ++d) acc[d] *= f;
        const bool b2 = part & 4, b1 = part & 2, b0 = part & 1;
        float r32[32], r16[16], r8[8];
#pragma unroll
        for (int d = 0; d < 32; ++d) { const float keep = b2 ? acc[32 + d] : acc[d], send = b2 ? acc[d] : acc[32 + d]; r32[d] = keep + __shfl_xor(send, 4); }
#pragma unroll
        for (int d = 0; d < 16; ++d) { const float keep = b1 ? r32[16 + d] : r32[d], send = b1 ? r32[d] : r32[16 + d]; r16[d] = keep + __shfl_xor(send, 2); }
#pragma unroll
        for (int d = 0; d < 8; ++d) { const float keep = b0 ? r16[8 + d] : r16[d], send = b0 ? r16[d] : r16[8 + d]; r8[d] = keep + __shfl_xor(send, 1); }
        const float il = 1.0f / l;
        const int tok = (nb * 64 + i) * dil + r;
        v4u o; o.x = pk2(r8[0] * il, r8[1] * il); o.y = pk2(r8[2] * il, r8[3] * il); o.z = pk2(r8[4] * il, r8[5] * il); o.w = pk2(r8[6] * il, r8[7] * il);
        *(v4u*)(OG + ((size_t)gi * S_ + tok) * 256 + hg * 64 + part * 8) = o;
        if (part == 0) LSE[((size_t)gi * S_ + tok) * 4 + hg] = mt + logf(l);
    }
}

__device__ __forceinline__ void ph_dnprep(const bf16* PD, const float* AB, const float* convw, const float* a_log, const float* dt_bias, bf16* QKVd, float* GB, const bf16* OG, const float* LSE, bf16* OATT, int wv) {
    int tid_ = wv * 64 + lane_id_(); asm volatile("" : "+v"(tid_)); const int tid = tid_, lane = tid_ & 63, wave = tid_ >> 6;
    for (int it = BID * 8 + wave; it < 1024 * 5; it += GSZ * 8) {
        const int tb = it / 5, sg = it % 5, c0 = sg * 512 + lane * 8, t0 = tb * 16;
        if (c0 < 2304) {
            const int seg = c0 >> 7;
            float cw[5][8];
#pragma unroll
            for (int j = 0; j < 5; ++j) { const f32x4 a = *(const f32x4*)(convw + j * 2304 + c0), b = *(const f32x4*)(convw + j * 2304 + c0 + 4);
                cw[j][0] = a.x; cw[j][1] = a.y; cw[j][2] = a.z; cw[j][3] = a.w; cw[j][4] = b.x; cw[j][5] = b.y; cw[j][6] = b.z; cw[j][7] = b.w; }
            v4u win[5];
#pragma unroll
            for (int j = 0; j < 4; ++j) { const int tt = t0 + j - 2; win[j + 1] = (tt >= 0) ? *(const v4u*)(PD + (size_t)tt * 2304 + c0) : (v4u){0u, 0u, 0u, 0u}; }
#pragma unroll
            for (int i = 0; i < 16; ++i) {
#pragma unroll
                for (int j = 0; j < 4; ++j) win[j] = win[j + 1];
                { const int tt = t0 + i + 2; win[4] = (tt < S_) ? *(const v4u*)(PD + (size_t)tt * 2304 + c0) : (v4u){0u, 0u, 0u, 0u}; }
                float a[8];
#pragma unroll
                for (int e = 0; e < 8; ++e) a[e] = 0.f;
#pragma unroll
                for (int j = 0; j < 5; ++j) { const unsigned wx[4] = {win[j].x, win[j].y, win[j].z, win[j].w};
#pragma unroll
                    for (int e = 0; e < 4; ++e) { a[2 * e] += bflo(wx[e]) * cw[j][2 * e]; a[2 * e + 1] += bfhi(wx[e]) * cw[j][2 * e + 1]; } }
                float ss = 0.f;
#pragma unroll
                for (int e = 0; e < 8; ++e) { a[e] = a[e] * __builtin_amdgcn_rcpf(1.0f + __expf(-a[e])); ss += a[e] * a[e]; }
                if (seg < 12) {
                    ss += __shfl_xor(ss, 1); ss += __shfl_xor(ss, 2); ss += __shfl_xor(ss, 4); ss += __shfl_xor(ss, 8);
                    const float sc = (1.0f / sqrtf(ss + 1e-6f)) * (seg < 6 ? 0.08838834764831845f : 1.0f);
#pragma unroll
                    for (int e = 0; e < 8; ++e) a[e] *= sc;
                }
                v4u o; o.x = pk2(a[0], a[1]); o.y = pk2(a[2], a[3]); o.z = pk2(a[4], a[5]); o.w = pk2(a[6], a[7]);
                *(v4u*)(QKVd + (size_t)(t0 + i) * 2304 + c0) = o;
            }
        }
    }
    for (int e = BID * NTHREADS + tid; e < S_ * 12; e += GSZ * NTHREADS) {
        const int t = e / 12, idx = e % 12;
        const float braw = AB[(size_t)t * 32 + idx], araw = AB[(size_t)t * 32 + 12 + idx];
        const float x = araw + dt_bias[idx];
        const float sp = fmaxf(x, 0.f) + log1pf(expf(-fabsf(x)));
        GB[(size_t)idx * S_ + t] = -expf(a_log[idx]) * sp;
        GB[(size_t)(12 + idx) * S_ + t] = 1.0f / (1.0f + expf(-braw));
    }
    for (int t = BID * 8 + wave; t < S_; t += GSZ * 8) {
        const int ch = 4 * lane, hg = lane >> 4;
        const float l0 = LSE[(size_t)t * 4 + hg], l1 = LSE[((size_t)S_ + t) * 4 + hg], l2 = LSE[((size_t)2 * S_ + t) * 4 + hg];
        const float mx = fmaxf(l0, fmaxf(l1, l2));
        float w0 = expf(l0 - mx), w1 = expf(l1 - mx), w2 = expf(l2 - mx);
        const float inv = 1.0f / (w0 + w1 + w2); w0 *= inv; w1 *= inv; w2 *= inv;
        const v2u a = *(const v2u*)(OG + (size_t)t * 256 + ch), b = *(const v2u*)(OG + ((size_t)S_ + t) * 256 + ch), cc = *(const v2u*)(OG + ((size_t)2 * S_ + t) * 256 + ch);
        v2u o;
        o.x = pk2(w0 * bflo(a.x) + w1 * bflo(b.x) + w2 * bflo(cc.x), w0 * bfhi(a.x) + w1 * bfhi(b.x) + w2 * bfhi(cc.x));
        o.y = pk2(w0 * bflo(a.y) + w1 * bflo(b.y) + w2 * bflo(cc.y), w0 * bfhi(a.y) + w1 * bfhi(b.y) + w2 * bfhi(cc.y));
        *(v2u*)(OATT + (size_t)t * 256 + ch) = o;
    }
}

__device__ __forceinline__ void ph_final(const bf16* ODIR0, const bf16* ODIR1, const bf16* PZ, const float* dnw, bf16* ODN, int wv) {
    int tid_ = wv * 64 + lane_id_(); asm volatile("" : "+v"(tid_)); const int lane = tid_ & 63, wave = tid_ >> 6;
    for (int t = BID * 8 + wave; t < S_; t += GSZ * 8) {
#pragma unroll
        for (int h = 0; h < 6; ++h) {
            const int c = h * 128 + 2 * lane;
            const unsigned wf = *(const unsigned*)(ODIR0 + (size_t)t * 768 + c), wb = *(const unsigned*)(ODIR1 + (size_t)t * 768 + c);
            float o0 = bflo(wf) + bflo(wb), o1 = bfhi(wf) + bfhi(wb);
            const float ms = wave_sum(o0 * o0 + o1 * o1) * (1.0f / 128.0f);
            const float sc = 1.0f / sqrtf(ms + 1e-6f);
            const unsigned zw = *(const unsigned*)(PZ + (size_t)t * 768 + c);
            const f32x2 nw = *(const f32x2*)(dnw + 2 * lane);
            o0 = o0 * sc * nw.x * siluf_(bflo(zw)); o1 = o1 * sc * nw.y * siluf_(bfhi(zw));
            *(unsigned*)(ODN + (size_t)t * 768 + c) = pk2(o0, o1);
        }
    }
}
typedef short bf16x8_t __attribute__((ext_vector_type(8)));
typedef short s16x4_t __attribute__((ext_vector_type(4)));
#define MFMA16(a, b, c) __builtin_amdgcn_mfma_f32_16x16x32_bf16((a), (b), (c), 0, 0, 0)

__device__ __forceinline__ void ph_dn_pre(const bf16* QKVd, const float* GB, bf16* TINV, bf16* ATTN, float* VEC, unsigned char* lds, int wv) {
    int tid_ = wv * 64 + lane_id_(); asm volatile("" : "+v"(tid_));
    const int tid = tid_, lane = tid & 63, g = lane >> 4, m16 = lane & 15;
    float* GR = (float*)lds; float* Ms = GR + 2 * 64 * 65; float* Gs = Ms + 2 * 64 * 68; float* Bs = Gs + 128;
    for (int u = BID; u < 1536; u += GSZ) {
        const int n = u / 6, h = u % 6;
        __syncthreads();
        {
            const int kind = wv >> 2, mt = wv & 3;
            const bf16* arow = QKVd + (size_t)(64 * n + 16 * mt + m16) * 2304 + (kind ? 0 : 768) + h * 128 + 8 * g;
            bf16x8_t a[4];
#pragma unroll
            for (int ks = 0; ks < 4; ++ks) a[ks] = *(const bf16x8_t*)(arow + 32 * ks);
#pragma unroll
            for (int nt = 0; nt < 4; ++nt) {
                const bf16* brow = QKVd + (size_t)(64 * n + 16 * nt + m16) * 2304 + 768 + h * 128 + 8 * g;
                f32x4 acc = {0.f, 0.f, 0.f, 0.f};
#pragma unroll
                for (int ks = 0; ks < 4; ++ks) acc = MFMA16(a[ks], *(const bf16x8_t*)(brow + 32 * ks), acc);
#pragma unroll
                for (int rg = 0; rg < 4; ++rg) GR[kind * 64 * 65 + (16 * mt + 4 * g + rg) * 65 + 16 * nt + m16] = acc[rg];
            }
        }
        if ((wv & 3) == 0) {
            const int d = wv >> 2, tok = 64 * n + (d ? 63 - lane : lane);
            float gv = GB[(size_t)(d * 6 + h) * S_ + tok]; const float be = GB[(size_t)(12 + d * 6 + h) * S_ + tok];
#pragma unroll
            for (int o = 1; o < 64; o <<= 1) { const float t = __shfl_up(gv, o); if (lane >= o) gv += t; }
            const float gl = __shfl(gv, 63);
            Gs[d * 64 + lane] = gv; Bs[d * 64 + lane] = be;
            float* vec = VEC + (size_t)(u * 2 + d) * 256;
            vec[lane] = __expf(gv); vec[64 + lane] = be; vec[128 + lane] = __expf(gl - gv); vec[192 + lane] = __expf(gl);
        }
        __syncthreads();
        {
            const int d = wv >> 2, tl = tid & 255, i = tl >> 2, jq = tl & 3, ii = d ? 63 - i : i;
            const float Gi = Gs[d * 64 + i], bi = Bs[d * 64 + i];
            unsigned pk[8];
#pragma unroll
            for (int jj = 0; jj < 16; jj += 2) {
                float at[2];
#pragma unroll
                for (int e = 0; e < 2; ++e) {
                    const int j = 16 * jq + jj + e, jx = d ? 63 - j : j;
                    const float dec = (j <= i) ? __expf(Gi - Gs[d * 64 + j]) : 0.f;
                    const float kk = GR[ii * 65 + jx], qk = GR[64 * 65 + ii * 65 + jx];
                    Ms[d * 64 * 68 + i * 68 + j] = (j < i) ? bi * kk * dec : 0.f;
                    at[e] = (j <= i) ? qk * dec : 0.f;
                }
                pk[jj >> 1] = pk2(at[0], at[1]);
            }
            v4u* dst = (v4u*)(ATTN + ((size_t)(u * 2 + d) * 64 + i) * 64 + 16 * jq);
            v4u o0; o0.x = pk[0]; o0.y = pk[1]; o0.z = pk[2]; o0.w = pk[3]; v4u o1; o1.x = pk[4]; o1.y = pk[5]; o1.z = pk[6]; o1.w = pk[7];
            dst[0] = o0; dst[1] = o1;
        }
        __syncthreads();
        if ((wv & 3) == 0) {
            const int d = wv >> 2, c = lane; const float* Md = Ms + d * 64 * 68;
            float x[64];
            x[0] = (c == 0) ? 1.f : 0.f;
#pragma unroll
            for (int i = 1; i < 64; ++i) {
                f32x4 mr[16];
#pragma unroll
                for (int j0 = 0; j0 < i; j0 += 4) mr[j0 >> 2] = *(const f32x4*)(Md + i * 68 + j0);
                float s0 = (i == c) ? 1.f : 0.f, s1 = 0.f, s2 = 0.f, s3 = 0.f;
#pragma unroll
                for (int j0 = 0; j0 < i; j0 += 4) { const f32x4 mv = mr[j0 >> 2];
                    s0 -= mv.x * x[j0]; if (j0 + 1 < i) s1 -= mv.y * x[j0 + 1]; if (j0 + 2 < i) s2 -= mv.z * x[j0 + 2]; if (j0 + 3 < i) s3 -= mv.w * x[j0 + 3]; }
                x[i] = (s0 + s1) + (s2 + s3);
            }
            bf16* outp = TINV + (size_t)(u * 2 + d) * 4096 + c;
#pragma unroll
            for (int i = 0; i < 64; ++i) outp[i * 64] = (bf16)f2bf(x[i]);
        }
    }
}

constexpr int SC_NC = 2;
constexpr int SC_KT = 0, SC_QT = 17408, SC_TI = 34816, SC_AT = 44032, SC_VT = 53248, SC_VC = SC_VT + 4096, SC_BUF = SC_VC + 1024;
constexpr int SC_ST = 2 * SC_BUF, SC_RT = SC_ST + 16 * SC_NC * 272, SC_VNT = SC_RT + 16 * SC_NC * 144, SC_VST = SC_VNT + 16 * SC_NC * 144, SC_END = SC_VST + 16 * SC_NC * 144;
static_assert(SC_END + 16 <= 146432, "scan LDS (+ a 16-byte dump slot at SC_END)");
constexpr size_t SCS_MAT = 128 * 128;
__device__ __forceinline__ float* scs_B(float* base, int p, int j) { return base + (size_t)(p * 3 + j) * SCS_MAT; }
__device__ __forceinline__ float* scs_A(float* base, int p, int j) { return base + (size_t)(36 + p * 2 + (j - 1)) * SCS_MAT; }
template <int PASS>
__device__ __forceinline__ void ph_dn_scan(const bf16* QKVd, const bf16* TINV, const bf16* ATTN, const float* VEC, bf16* ODIR0, bf16* ODIR1, float* SCS, LAS unsigned char* lds, int wv) {
    const int xl = BID & 7, slot = BID >> 3;
    int p, j, cs; bool has_out, v_zero;
    if (PASS == 1) {
        if (slot < 24) { const int grp = xl * 3 + (slot >> 3), within = slot & 7; p = grp >> 1; j = 1 + (grp & 1); v_zero = (within >> 2) != 0; cs = within & 3; has_out = false; }
        else { const int s4 = slot - 24; int gi; if (xl < 4) gi = xl * 2 + (s4 >> 2); else { if (s4 >= 4) return; gi = 8 + (xl - 4); } p = gi; j = 0; cs = s4 & 3; has_out = true; v_zero = false; }
    } else {
        if (slot >= 20) return; const int v = xl * 20 + slot; if (v >= 144) return;
        const int grp = v >> 2; p = grp / 3; j = 1 + grp % 3; cs = v & 3; has_out = true; v_zero = false;
    }
    const int d = p / 6, h = p % 6;
    int tid_ = wv * 64 + lane_id_(); asm volatile("" : "+v"(tid_));
    const int tid = tid_, lane = tid & 63, g = lane >> 4, m16 = lane & 15, t4 = wv & 3;
    bf16* ODIR = d ? ODIR1 : ODIR0;
    v4u pfA[7], pfB[7];
    unsigned voff[7], loff[7];
#pragma unroll
    for (int k_ = 0; k_ < 7; ++k_) { int q_ = tid + 512 * k_;
        if (k_ < 4) { const int qq_ = q_ & 1023, row_ = qq_ >> 4, ch_ = qq_ & 15; voff[k_] = (unsigned)((d ? 63 - row_ : row_) * 4608 + ((k_ < 2 ? 768 : 0) + h * 128 + ch_ * 8) * 2); loff[k_] = (k_ < 2 ? SC_KT : SC_QT) + row_ * 272 + ch_ * 16; }
        else if (k_ < 6) { const int qq_ = q_ & 511, row_ = qq_ >> 3, ch_ = qq_ & 7; voff[k_] = (unsigned)(row_ * 128 + ch_ * 16); loff[k_] = (k_ == 4 ? SC_TI : SC_AT) + row_ * 144 + ch_ * 16; }
        else { const int qq_ = q_ - 3072;
            if (qq_ < 256) { const int row_ = qq_ >> 2, ch_ = qq_ & 3; voff[k_] = (unsigned)((d ? 63 - row_ : row_) * 4608 + (1536 + h * 128 + cs * 32 + ch_ * 8) * 2); loff[k_] = SC_VT + qq_ * 16; }
            else if (qq_ < 320) { voff[k_] = (unsigned)((qq_ - 256) * 16); loff[k_] = SC_VC + (qq_ - 256) * 16; }
            else { voff[k_] = 0u; loff[k_] = SC_END; } }
        if (!has_out && (k_ == 2 || k_ == 3 || k_ == 5)) { voff[k_] = 0u; loff[k_] = SC_END; } }
    const unsigned char* gK = (const unsigned char*)QKVd; const unsigned char* gT = (const unsigned char*)TINV; const unsigned char* gA = (const unsigned char*)ATTN; const unsigned char* gV = (const unsigned char*)VEC;
#define SC_LD1(dst, vo, basep) asm volatile("s_nop 4\n\tglobal_load_dwordx4 %0, %1, %2" : "=v"(dst) : "v"(vo), "s"(basep) : "memory")
#define SC_LOAD(pf, step) do { const int n_ = d ? 255 - (step) : (step); const size_t cb_ = (size_t)((n_ * 6 + h) * 2 + d); \
        const unsigned char* bK_ = gK + (size_t)n_ * 294912; const unsigned char* bT_ = gT + cb_ * 8192; const unsigned char* bA_ = has_out ? gA + cb_ * 8192 : bT_; const unsigned char* bQ_ = has_out ? bK_ : bT_; \
        const unsigned char* b6_ = (wv < 4) ? bK_ : gV + cb_ * 1024; \
        SC_LD1(pf[0], voff[0], bK_); SC_LD1(pf[1], voff[1], bK_); SC_LD1(pf[2], voff[2], bQ_); SC_LD1(pf[3], voff[3], bQ_); SC_LD1(pf[4], voff[4], bT_); SC_LD1(pf[5], voff[5], bA_); SC_LD1(pf[6], voff[6], b6_); } while (0)
#define SC_WRITE(pf, bufsel) do { LAS unsigned char* bb_ = lds + (bufsel) * SC_BUF; \
        _Pragma("unroll") for (int k_ = 0; k_ < 7; ++k_) *(LAS v4u*)(bb_ + loff[k_]) = pf[k_]; } while (0)
#define SC_BAR() do { asm volatile("s_waitcnt lgkmcnt(0)" ::: "memory"); __builtin_amdgcn_s_barrier(); asm volatile("" ::: "memory"); } while (0)
#define SC_WAIT(pf, N) asm volatile("s_waitcnt vmcnt(" #N ")" : "+v"(pf[0]), "+v"(pf[1]), "+v"(pf[2]), "+v"(pf[3]), "+v"(pf[4]), "+v"(pf[5]), "+v"(pf[6]) :: "memory")
#define SC_WAIT4(pf, N) asm volatile("s_waitcnt vmcnt(" #N ")" : "+v"(pf[0]), "+v"(pf[1]), "+v"(pf[4]), "+v"(pf[6]) :: "memory")
#define SC_OSTORE(stepo) do { if (has_out && wv >= 4) { const int no_ = d ? 255 - (stepo) : (stepo); \
        _Pragma("unroll") for (int ct = 0; ct < SC_NC; ++ct) _Pragma("unroll") for (int rg = 0; rg < 4; ++rg) { const int i_ = 16 * t4 + 4 * g + rg, tok_ = 64 * no_ + (d ? 63 - i_ : i_); \
            ODIR[(size_t)tok_ * 768 + h * 128 + cs * 32 + ct * 16 + m16] = (bf16)f2bf(oprev[ct][rg]); } } } while (0)
#define SC_STEP(s, PFW, PFL) do { const int s_ = (s); const int cur = s_ & 1; \
        LAS unsigned char* B = lds + cur * SC_BUF; \
        SC_LOAD(PFL, (s_ + 2 < s_end ? s_ + 2 : s_end - 1)); \
        if (s_ > s_beg) SC_OSTORE(s_ - 1); \
        const LAS float* VC = (const LAS float*)(B + SC_VC); \
        bf16x8_t sb[SC_NC][4]; \
        _Pragma("unroll") for (int ct = 0; ct < SC_NC; ++ct) _Pragma("unroll") for (int ks = 0; ks < 4; ++ks) sb[ct][ks] = *(const LAS bf16x8_t*)(lds + SC_ST + (16 * ct + m16) * 272 + (32 * ks + 8 * g) * 2); \
        f32x4 acc1[SC_NC]; \
        _Pragma("unroll") for (int ct = 0; ct < SC_NC; ++ct) acc1[ct] = (f32x4){0.f, 0.f, 0.f, 0.f}; \
        const f32x4 eG4 = *(const LAS f32x4*)(VC + 16 * t4 + 4 * g); \
          \
        const f32x4 be4 = *(const LAS f32x4*)(VC + 64 + 16 * t4 + 4 * g), eL4 = *(const LAS f32x4*)(VC + 128 + 16 * t4 + 4 * g); const float gl = VC[192]; \
        bf16x8_t h2a0, h2a1, ka[2]; float vvh[SC_NC][4]; \
        { const LAS unsigned char* ap2 = B + ((wv < 4) ? SC_TI : SC_AT) + (16 * t4 + m16) * 144 + 16 * g; h2a0 = *(const LAS bf16x8_t*)ap2; h2a1 = *(const LAS bf16x8_t*)(ap2 + 64); } \
        _Pragma("unroll") for (int ks = 0; ks < 2; ++ks) { \
            const LAS unsigned char* tp = B + SC_KT + (32 * ks + 8 * g + (m16 >> 2)) * 272 + (16 * wv + 4 * (m16 & 3)) * 2; \
            const s16x4_t lo = __builtin_amdgcn_ds_read_tr16_b64_v4i16((LAS s16x4_t*)tp); \
            const s16x4_t hi = __builtin_amdgcn_ds_read_tr16_b64_v4i16((LAS s16x4_t*)(tp + 4 * 272)); \
            ka[ks] = (bf16x8_t){lo[0], lo[1], lo[2], lo[3], hi[0], hi[1], hi[2], hi[3]}; } \
        _Pragma("unroll") for (int ct = 0; ct < SC_NC; ++ct) _Pragma("unroll") for (int rg = 0; rg < 4; ++rg) vvh[ct][rg] = (v_zero || wv >= 4) ? 0.f : bf2f(*(const LAS unsigned short*)(B + SC_VT + (16 * t4 + 4 * g + rg) * 64 + (16 * ct + m16) * 2)); \
        if (wv < 4 || has_out) { const LAS unsigned char* ap = B + (wv < 4 ? SC_KT : SC_QT) + (16 * t4 + m16) * 272 + 16 * g; \
          _Pragma("unroll") for (int ks = 0; ks < 4; ++ks) { const bf16x8_t a_ = *(const LAS bf16x8_t*)(ap + 64 * ks); \
              _Pragma("unroll") for (int ct = 0; ct < SC_NC; ++ct) acc1[ct] = MFMA16(a_, sb[ct][ks], acc1[ct]); } } \
        if (wv < 4) { \
            _Pragma("unroll") for (int ct = 0; ct < SC_NC; ++ct) { float r[4]; \
                _Pragma("unroll") for (int rg = 0; rg < 4; ++rg) r[rg] = be4[rg] * (vvh[ct][rg] - eG4[rg] * acc1[ct][rg]); \
                v2u w; w.x = pk2(r[0], r[1]); w.y = pk2(r[2], r[3]); *(LAS v2u*)(lds + SC_RT + (16 * ct + m16) * 144 + (16 * t4 + 4 * g) * 2) = w; } \
        } else { _Pragma("unroll") for (int ct = 0; ct < SC_NC; ++ct) _Pragma("unroll") for (int rg = 0; rg < 4; ++rg) acc1[ct][rg] *= eG4[rg]; } \
        SC_BAR(); \
        if (wv < 4) { const bf16x8_t a0_ = h2a0, a1_ = h2a1; \
            _Pragma("unroll") for (int ct = 0; ct < SC_NC; ++ct) { f32x4 vn = {0.f, 0.f, 0.f, 0.f}; \
                vn = MFMA16(a0_, *(const LAS bf16x8_t*)(lds + SC_RT + (16 * ct + m16) * 144 + (8 * g) * 2), vn); \
                vn = MFMA16(a1_, *(const LAS bf16x8_t*)(lds + SC_RT + (16 * ct + m16) * 144 + (32 + 8 * g) * 2), vn); \
                v2u w; w.x = pk2(vn[0], vn[1]); w.y = pk2(vn[2], vn[3]); *(LAS v2u*)(lds + SC_VNT + (16 * ct + m16) * 144 + (16 * t4 + 4 * g) * 2) = w; \
                v2u w2; w2.x = pk2(vn[0] * eL4[0], vn[1] * eL4[1]); w2.y = pk2(vn[2] * eL4[2], vn[3] * eL4[3]); *(LAS v2u*)(lds + SC_VST + (16 * ct + m16) * 144 + (16 * t4 + 4 * g) * 2) = w2; } } \
        SC_BAR(); \
        { \
          _Pragma("unroll") for (int ct = 0; ct < SC_NC; ++ct) { f32x4 acc3 = {0.f, 0.f, 0.f, 0.f}; \
              _Pragma("unroll") for (int ks = 0; ks < 2; ++ks) acc3 = MFMA16(ka[ks], *(const LAS bf16x8_t*)(lds + SC_VST + (16 * ct + m16) * 144 + (32 * ks + 8 * g) * 2), acc3); \
              _Pragma("unroll") for (int rg = 0; rg < 4; ++rg) Sreg[ct][rg] = gl * Sreg[ct][rg] + acc3[rg]; \
              v2u w; w.x = pk2(Sreg[ct][0], Sreg[ct][1]); w.y = pk2(Sreg[ct][2], Sreg[ct][3]); *(LAS v2u*)(lds + SC_ST + (16 * ct + m16) * 272 + (16 * wv + 4 * g) * 2) = w; } } \
        if (has_out && wv >= 4) { const bf16x8_t a0_ = h2a0, a1_ = h2a1; \
            _Pragma("unroll") for (int ct = 0; ct < SC_NC; ++ct) { \
                acc1[ct] = MFMA16(a0_, *(const LAS bf16x8_t*)(lds + SC_VNT + (16 * ct + m16) * 144 + (8 * g) * 2), acc1[ct]); \
                acc1[ct] = MFMA16(a1_, *(const LAS bf16x8_t*)(lds + SC_VNT + (16 * ct + m16) * 144 + (32 + 8 * g) * 2), acc1[ct]); \
                oprev[ct] = acc1[ct]; } } \
        SC_WAIT(PFW, 7); SC_WRITE(PFW, cur ^ 1); \
        SC_BAR(); } while (0)
    const int s_beg = 64 * j, s_end = s_beg + 64;
    SC_LOAD(pfA, s_beg);
    f32x4 Sreg[SC_NC], oprev[SC_NC];
#pragma unroll
    for (int ct = 0; ct < SC_NC; ++ct) { Sreg[ct] = (f32x4){0.f, 0.f, 0.f, 0.f}; oprev[ct] = (f32x4){0.f, 0.f, 0.f, 0.f}; }
    if (PASS == 1) {
        if (v_zero) {
#pragma unroll
            for (int ct = 0; ct < SC_NC; ++ct)
#pragma unroll
                for (int rg = 0; rg < 4; ++rg) Sreg[ct][rg] = (16 * wv + 4 * g + rg == 32 * cs + 16 * ct + m16) ? 1.f : 0.f;
        }
    } else {
        LAS float* blk0 = (LAS float*)(lds + SC_ST); LAS float* blk1 = blk0 + 128 * 33;
        blk0 = (LAS float*)(lds + SC_BUF); blk1 = blk0 + 128 * 33;
        const int a = tid >> 2, cq = tid & 3;
        float accv[8];
        { const float* bp = scs_B(SCS, p, 0) + (size_t)a * 128 + 32 * cs + 8 * cq; const f32x4 x0 = *(const f32x4*)bp, x1 = *(const f32x4*)(bp + 4);
          accv[0] = x0.x; accv[1] = x0.y; accv[2] = x0.z; accv[3] = x0.w; accv[4] = x1.x; accv[5] = x1.y; accv[6] = x1.z; accv[7] = x1.w; }
#pragma unroll 1
        for (int jj = 1; jj < j; ++jj) {
            LAS float* src = (jj & 1) ? blk0 : blk1;
#pragma unroll
            for (int e = 0; e < 8; ++e) src[a * 33 + 8 * cq + e] = accv[e];
            __syncthreads();
            { const float* bp = scs_B(SCS, p, jj) + (size_t)a * 128 + 32 * cs + 8 * cq; const f32x4 x0 = *(const f32x4*)bp, x1 = *(const f32x4*)(bp + 4);
              accv[0] = x0.x; accv[1] = x0.y; accv[2] = x0.z; accv[3] = x0.w; accv[4] = x1.x; accv[5] = x1.y; accv[6] = x1.z; accv[7] = x1.w; }
            const float* ar = scs_A(SCS, p, jj) + (size_t)a * 128;
#pragma unroll 4
            for (int b4 = 0; b4 < 128; b4 += 4) { const f32x4 av = *(const f32x4*)(ar + b4);
#pragma unroll
                for (int e = 0; e < 8; ++e) accv[e] += av.x * src[(b4 + 0) * 33 + 8 * cq + e] + av.y * src[(b4 + 1) * 33 + 8 * cq + e] + av.z * src[(b4 + 2) * 33 + 8 * cq + e] + av.w * src[(b4 + 3) * 33 + 8 * cq + e]; }
        }
        LAS float* fin = (j & 1) ? blk0 : blk1;
        __syncthreads();
#pragma unroll
        for (int e = 0; e < 8; ++e) fin[a * 33 + 8 * cq + e] = accv[e];
        __syncthreads();
#pragma unroll
        for (int ct = 0; ct < SC_NC; ++ct)
#pragma unroll
            for (int rg = 0; rg < 4; ++rg) Sreg[ct][rg] = fin[(16 * wv + 4 * g + rg) * 33 + 16 * ct + m16];
        __syncthreads();
    }
#pragma unroll
    for (int ct = 0; ct < SC_NC; ++ct) { v2u w; w.x = pk2(Sreg[ct][0], Sreg[ct][1]); w.y = pk2(Sreg[ct][2], Sreg[ct][3]); *(LAS v2u*)(lds + SC_ST + (16 * ct + m16) * 272 + (16 * wv + 4 * g) * 2) = w; }
    SC_WAIT(pfA, 0); SC_WRITE(pfA, s_beg & 1);
    SC_LOAD(pfB, s_beg + 1);
    __syncthreads();
#pragma unroll 1
    for (int s2 = s_beg; s2 < s_end; s2 += 2) {
        SC_STEP(s2, pfB, pfA);
        SC_STEP(s2 + 1, pfA, pfB);
    }
    asm volatile("s_waitcnt vmcnt(0)" : "+v"(pfA[0]), "+v"(pfA[1]), "+v"(pfA[2]), "+v"(pfA[3]), "+v"(pfA[4]), "+v"(pfA[5]), "+v"(pfA[6]),
                                        "+v"(pfB[0]), "+v"(pfB[1]), "+v"(pfB[2]), "+v"(pfB[3]), "+v"(pfB[4]), "+v"(pfB[5]), "+v"(pfB[6]) :: "memory");
    SC_OSTORE(s_end - 1);
    if (PASS == 1) {
        float* dst = (v_zero ? scs_A(SCS, p, j) : scs_B(SCS, p, j));
        if (j < 3) {
#pragma unroll
            for (int ct = 0; ct < SC_NC; ++ct)
#pragma unroll
                for (int rg = 0; rg < 4; ++rg) dst[(size_t)(16 * wv + 4 * g + rg) * 128 + 32 * cs + 16 * ct + m16] = Sreg[ct][rg];
        }
    }
    asm volatile("s_waitcnt vmcnt(0)" ::: "memory");
#undef SC_STEP
#undef SC_OSTORE
#undef SC_WAIT
#undef SC_WAIT4
#undef SC_BAR
#undef SC_LOAD
#undef SC_LD1
#undef SC_WRITE
}
constexpr int AT_PITCH = 144, AT_K = 0, AT_V = 192 * AT_PITCH, AT_GRP = 2 * 192 * AT_PITCH;
__device__ __forceinline__ void ph_attn(const bf16* PA, const float* rope, bf16* OG, float* LSE, LAS unsigned char* lds, int wv) {
    int tid_ = wv * 64 + lane_id_(); asm volatile("" : "+v"(tid_));
    const int tid = tid_, lane = tid & 63, g = lane >> 4, m16 = lane & 15, grp = wv >> 2, wq = wv & 3, tg = tid & 255;
    LAS unsigned char* Kl = lds + grp * AT_GRP + AT_K; LAS unsigned char* Vl = lds + grp * AT_GRP + AT_V;
#pragma unroll 1
    for (int pi = BID; pi < 1536; pi += GSZ) {
        const int u = 2 * pi + grp;
        const int hg = u & 3, w = (u >> 2) & 255, gi = u >> 10;
        const int dil = 1 << (2 * gi), L = S_ / dil, r = w & (dil - 1), nb = w >> (2 * gi), head = gi * 4 + hg;
#pragma unroll
        for (int k = 0; k < 3; ++k) {
            const int item = tg + 256 * k, row = item >> 2, c = item & 3, mm = nb * 64 - 64 + row;
            v4u o0 = {0u, 0u, 0u, 0u}, o1 = {0u, 0u, 0u, 0u};
            if (mm >= 0 && mm < L) {
                const int tok = mm * dil + r;
                const bf16* kp = PA + (size_t)tok * 2304 + 768 + head * 64 + 8 * c;
                const v4u x0 = *(const v4u*)kp, x1 = *(const v4u*)(kp + 32);
                const f32x4* cp = (const f32x4*)(rope + (size_t)tok * 32 + 8 * c); const f32x4* sp = (const f32x4*)(rope + (size_t)S_ * 32 + (size_t)tok * 32 + 8 * c);
                const f32x4 c0 = cp[0], c1 = cp[1], s0 = sp[0], s1 = sp[1];
                const float cs[8] = {c0.x, c0.y, c0.z, c0.w, c1.x, c1.y, c1.z, c1.w}, sn[8] = {s0.x, s0.y, s0.z, s0.w, s1.x, s1.y, s1.z, s1.w};
                const unsigned xa[4] = {x0.x, x0.y, x0.z, x0.w}, xb[4] = {x1.x, x1.y, x1.z, x1.w};
                unsigned ra[4], rb[4];
#pragma unroll
                for (int e = 0; e < 4; ++e) {
                    const float a0 = bflo(xa[e]), a1 = bfhi(xa[e]), b0 = bflo(xb[e]), b1 = bfhi(xb[e]);
                    ra[e] = pk2(a0 * cs[2 * e] - b0 * sn[2 * e], a1 * cs[2 * e + 1] - b1 * sn[2 * e + 1]);
                    rb[e] = pk2(b0 * cs[2 * e] + a0 * sn[2 * e], b1 * cs[2 * e + 1] + a1 * sn[2 * e + 1]);
                }
                o0.x = ra[0]; o0.y = ra[1]; o0.z = ra[2]; o0.w = ra[3]; o1.x = rb[0]; o1.y = rb[1]; o1.z = rb[2]; o1.w = rb[3];
            }
            *(LAS v4u*)(Kl + row * AT_PITCH + 16 * c) = o0; *(LAS v4u*)(Kl + row * AT_PITCH + 64 + 16 * c) = o1;
        }
#pragma unroll
        for (int k = 0; k < 6; ++k) {
            const int item = tg + 256 * k, row = item >> 3, c = item & 7, mm = nb * 64 - 64 + row;
            v4u o = {0u, 0u, 0u, 0u};
            if (mm >= 0 && mm < L) o = *(const v4u*)(PA + (size_t)(mm * dil + r) * 2304 + 1536 + head * 64 + 8 * c);
            *(LAS v4u*)(Vl + row * AT_PITCH + 16 * c) = o;
        }
        bf16x8_t bq0, bq1;
        const int qi = 16 * wq + m16, qtok = (nb * 64 + qi) * dil + r;
        {
            const bf16* qp = PA + (size_t)qtok * 2304 + head * 64 + 8 * g;
            const v4u x0 = *(const v4u*)qp, x1 = *(const v4u*)(qp + 32);
            const f32x4* cp = (const f32x4*)(rope + (size_t)qtok * 32 + 8 * g); const f32x4* sp = (const f32x4*)(rope + (size_t)S_ * 32 + (size_t)qtok * 32 + 8 * g);
            const f32x4 c0 = cp[0], c1 = cp[1], s0 = sp[0], s1 = sp[1];
            const float cs[8] = {c0.x, c0.y, c0.z, c0.w, c1.x, c1.y, c1.z, c1.w}, sn[8] = {s0.x, s0.y, s0.z, s0.w, s1.x, s1.y, s1.z, s1.w};
            const unsigned xa[4] = {x0.x, x0.y, x0.z, x0.w}, xb[4] = {x1.x, x1.y, x1.z, x1.w};
            v4u ra, rb; unsigned* rap = (unsigned*)&ra; unsigned* rbp = (unsigned*)&rb; (void)rap; (void)rbp;
            unsigned ta[4], tb[4];
#pragma unroll
            for (int e = 0; e < 4; ++e) {
                const float a0 = bflo(xa[e]), a1 = bfhi(xa[e]), b0 = bflo(xb[e]), b1 = bfhi(xb[e]);
                ta[e] = pk2(0.125f * (a0 * cs[2 * e] - b0 * sn[2 * e]), 0.125f * (a1 * cs[2 * e + 1] - b1 * sn[2 * e + 1]));
                tb[e] = pk2(0.125f * (b0 * cs[2 * e] + a0 * sn[2 * e]), 0.125f * (b1 * cs[2 * e + 1] + a1 * sn[2 * e + 1]));
            }
            ra.x = ta[0]; ra.y = ta[1]; ra.z = ta[2]; ra.w = ta[3]; rb.x = tb[0]; rb.y = tb[1]; rb.z = tb[2]; rb.w = tb[3];
            bq0 = __builtin_bit_cast(bf16x8_t, ra); bq1 = __builtin_bit_cast(bf16x8_t, rb);
        }
        __syncthreads();
        f32x4 st[12];
#pragma unroll
        for (int kt = 0; kt < 12; ++kt) {
            const LAS unsigned char* ap = Kl + (16 * kt + m16) * AT_PITCH + 16 * g;
            f32x4 z = {0.f, 0.f, 0.f, 0.f};
            z = MFMA16(*(const LAS bf16x8_t*)ap, bq0, z);
            st[kt] = MFMA16(*(const LAS bf16x8_t*)(ap + 64), bq1, z);
        }
        float mx = -1e30f;
#pragma unroll
        for (int kt = 0; kt < 12; ++kt)
#pragma unroll
            for (int rg = 0; rg < 4; ++rg) { const int j = 16 * kt + 4 * g + rg, dj = j - qi, mm = nb * 64 - 64 + j;
                const bool ok = (dj >= 0) && (dj <= 128) && (mm >= 0) && (mm < L);
                st[kt][rg] = ok ? st[kt][rg] : -1e30f; mx = fmaxf(mx, st[kt][rg]); }
        mx = fmaxf(mx, __shfl_xor(mx, 16)); mx = fmaxf(mx, __shfl_xor(mx, 32));
        float sum = 0.f;
#pragma unroll
        for (int kt = 0; kt < 12; ++kt)
#pragma unroll
            for (int rg = 0; rg < 4; ++rg) { const float p = __expf(st[kt][rg] - mx); st[kt][rg] = p; sum += p; }
        sum += __shfl_xor(sum, 16); sum += __shfl_xor(sum, 32);
        f32x4 o[4];
#pragma unroll
        for (int dt = 0; dt < 4; ++dt) o[dt] = (f32x4){0.f, 0.f, 0.f, 0.f};
#pragma unroll
        for (int kk = 0; kk < 6; ++kk) {
            v4u pb; pb.x = pk2(st[2 * kk][0], st[2 * kk][1]); pb.y = pk2(st[2 * kk][2], st[2 * kk][3]); pb.z = pk2(st[2 * kk + 1][0], st[2 * kk + 1][1]); pb.w = pk2(st[2 * kk + 1][2], st[2 * kk + 1][3]);
            const bf16x8_t b = __builtin_bit_cast(bf16x8_t, pb);
#pragma unroll
            for (int dt = 0; dt < 4; ++dt) {
                const LAS unsigned char* tp = Vl + (32 * kk + 4 * g + (m16 >> 2)) * AT_PITCH + (16 * dt + 4 * (m16 & 3)) * 2;
                const s16x4_t lo = __builtin_amdgcn_ds_read_tr16_b64_v4i16((LAS s16x4_t*)tp);
                const s16x4_t hi = __builtin_amdgcn_ds_read_tr16_b64_v4i16((LAS s16x4_t*)(tp + 16 * AT_PITCH));
                const bf16x8_t a = {lo[0], lo[1], lo[2], lo[3], hi[0], hi[1], hi[2], hi[3]};
                o[dt] = MFMA16(a, b, o[dt]);
            }
        }
        const float il = 1.0f / sum;
        bf16* op = OG + ((size_t)gi * S_ + qtok) * 256 + hg * 64 + 4 * g;
#pragma unroll
        for (int dt = 0; dt < 4; ++dt) { v2u wv2; wv2.x = pk2(o[dt][0] * il, o[dt][1] * il); wv2.y = pk2(o[dt][2] * il, o[dt][3] * il); *(v2u*)(op + 16 * dt) = wv2; }
        if (g == 0) LSE[((size_t)gi * S_ + qtok) * 4 + hg] = mx + logf(sum);
        __syncthreads();
    }
}
constexpr int LDS_RING = 146432, LDS_CTL_OFF = LDS_RING, LDS_BYTES = 147456;
constexpr int CW_BAR = 4096;
#ifndef PROBE_ID
#define PROBE_ID (-1)
#endif
__device__ __forceinline__ unsigned char* wsp() { return PWS; }
template <class Epi> __device__ __forceinline__ void run_gemm(LAS unsigned char* lds, const bf16* A, const bf16* Bt, int N, int K, const Epi& E, int wv) {
    pg8::Gemm g{A, Bt, S_, N, K, 0};
    pg8::StaticOrder S; S.init(S_, N, GSZ, BID);
    pg8::gemm_phase<Epi, pg8::StaticOrder, true, true>(lds, g, S, E, wv);
}
#define GRID_BAR() do { XcdBarrier b_; b_.bar = (unsigned*)(wsp() + WS_CTL) + CW_BAR; b_.st = (volatile LAS unsigned*)(lds + LDS_CTL_OFF + 320) + 8; b_.x = b_.st[2]; xcd_barrier(b_, wv); } while (0)
#define PHASE(id, ...) do { { constexpr int PROBE_REP = 0; __VA_ARGS__ } if (PROBE_ID == (id)) { GRID_BAR(); { constexpr int PROBE_REP = 1; __VA_ARGS__ } } } while (0)
#define WS_R_PTRS unsigned char* ws = wsp(); unsigned char* R = ws + WS_R; (void)R;

template <int l, int f> __device__ __forceinline__ void ffn_block(LAS unsigned char* lds, unsigned char* lds_raw, int wv) {
    constexpr int s = f * 2;
    PHASE(1, WS_R_PTRS
        pg8::EpiSwiglu E; E.O = (bf16*)(R + R_ACT); E.ldc = FF_; E.pad_ = 0; run_gemm(lds, (const bf16*)(ws + WS_H), (const bf16*)(ws + WS_W + (f ? W_FFIN1 : W_FFIN0)), 2 * FF_, 1024, E, wv); );
    GRID_BAR();
    PHASE(2, WS_R_PTRS
        pg8::EpiBf16P E; E.O = (bf16*)(R + R_Y); E.ldc = 1024; E.pad_ = 0; run_gemm(lds, (const bf16*)(R + R_ACT), (const bf16*)(ws + WS_W + (f ? W_FFOUT1 : W_FFOUT0)), 1024, FF_, E, wv); );
    GRID_BAR();
    {   WS_R_PTRS const float* MOD = (const float*)(ws + WS_MOD); const float* mod = MOD + l * 9216;
        RowArgs a; a.xi = (l == 0 && f == 0) ? PIN(0) : POUT; a.y = (const bf16*)(R + R_Y); a.xo = POUT; a.wpost = PIN(6) + (l * 3 + s) * 1024; a.gate = mod + (s * 3 + 2) * 1024; a.coef = 0.5f;
        if (f == 0) { a.h = (bf16*)(ws + WS_H); a.wpre = PIN(5) + (l * 3 + 1) * 1024; a.shift = mod + (1 * 3 + 0) * 1024; a.scale = mod + (1 * 3 + 1) * 1024; }
        else if (l == 0) { a.h = (bf16*)(ws + WS_H); a.wpre = PIN(5) + (1 * 3 + 0) * 1024; a.shift = MOD + 9216; a.scale = MOD + 9216 + 1024; }
        else { a.h = nullptr; a.wpre = nullptr; a.shift = nullptr; a.scale = nullptr; }
        ph_rows(a, wv);
        if (f == 1 && l == 0) ph_convert(1, lds_raw, wv); }
    GRID_BAR();
}
template <int l> __device__ __forceinline__ void mixer_block(LAS unsigned char* lds, unsigned char* lds_raw, int wv) {
    PHASE(3, WS_R_PTRS
        pg8::EpiInProj E; E.PA = (bf16*)(R + R_PA); E.PD = (bf16*)(R + R_PD); E.PZ = (bf16*)(R + R_PZ); E.AB = (float*)(R + R_AB);
        run_gemm(lds, (const bf16*)(ws + WS_H), (const bf16*)(ws + WS_W + W_IN), 5632, 1024, E, wv); );
    GRID_BAR();
    PHASE(4, WS_R_PTRS
        ph_attn((const bf16*)(R + R_PA), (const float*)(ws + WS_ROPE), (bf16*)(R + R_OG), (float*)(R + R_LSE), lds, wv); );
    GRID_BAR();
    PHASE(5, WS_R_PTRS
        ph_dnprep((const bf16*)(R + R_PD), (const float*)(R + R_AB), PIN(10) + (size_t)l * 5 * 2304, PIN(11) + l * 12, PIN(12) + l * 12, (bf16*)(R + R_QKVD), (float*)(R + R_GB),
                  (const bf16*)(R + R_OG), (const float*)(R + R_LSE), (bf16*)(R + R_OATT), wv); );
    GRID_BAR();
    PHASE(6, WS_R_PTRS
        ph_dn_pre((const bf16*)(R + R_QKVD), (const float*)(R + R_GB), (bf16*)(R + R_TINV), (bf16*)(R + R_ATTN), (float*)(R + R_VEC), lds_raw, wv); );
    GRID_BAR();
    PHASE(7, WS_R_PTRS
        ph_dn_scan<1>((const bf16*)(R + R_QKVD), (const bf16*)(R + R_TINV), (const bf16*)(R + R_ATTN), (const float*)(R + R_VEC), (bf16*)(R + R_ODIR0), (bf16*)(R + R_ODIR1), (float*)(ws + WS_W + W_FFIN0), lds, wv); );
    GRID_BAR();
    PHASE(13, WS_R_PTRS
        ph_dn_scan<2>((const bf16*)(R + R_QKVD), (const bf16*)(R + R_TINV), (const bf16*)(R + R_ATTN), (const float*)(R + R_VEC), (bf16*)(R + R_ODIR0), (bf16*)(R + R_ODIR1), (float*)(ws + WS_W + W_FFIN0), lds, wv); );
    GRID_BAR();
    PHASE(8, WS_R_PTRS
        pg8::EpiBf16P E; E.O = (bf16*)(R + R_PG); E.ldc = 2048; E.pad_ = 0;
        run_gemm(lds, (const bf16*)(ws + WS_H), (const bf16*)(ws + WS_W + W_IN) + (size_t)5632 * 1024, 2048, 1024, E, wv); );
    PHASE(9, WS_R_PTRS
        ph_final((const bf16*)(R + R_ODIR0), (const bf16*)(R + R_ODIR1), (const bf16*)(R + R_PZ), PIN(13) + l * 128, (bf16*)(R + R_ODN), wv); );
    GRID_BAR();
    PHASE(10, { WS_R_PTRS
        pg8::EpiGateF32 E; E.O = (bf16*)(R + R_T1); E.gate = (const bf16*)(R + R_PG); E.ldg = 2048; E.pad_ = 0;
        run_gemm(lds, (const bf16*)(R + R_OATT), (const bf16*)(ws + WS_W + W_BATT), 1024, 256, E, wv); }
        { WS_R_PTRS
        pg8::EpiGateAddBf16 E; E.O = (bf16*)(ws + WS_H); E.T1 = (const bf16*)(R + R_T1); E.gate = (const bf16*)(R + R_PG) + 1024; E.ldg = 2048; E.pad_ = 0;
        run_gemm(lds, (const bf16*)(R + R_ODN), (const bf16*)(ws + WS_W + W_BDN), 1024, 768, E, wv); } );
    GRID_BAR();
    PHASE(11, WS_R_PTRS
        pg8::EpiBf16P E; E.O = (bf16*)(R + R_Y2); E.ldc = 1024; E.pad_ = 0; run_gemm(lds, (const bf16*)(ws + WS_H), (const bf16*)(ws + WS_W + W_OUT), 1024, 1024, E, wv); );
    GRID_BAR();
    {   WS_R_PTRS const float* mod = (const float*)(ws + WS_MOD) + l * 9216;
        RowArgs a; a.xi = POUT; a.y = (const bf16*)(R + R_Y2); a.xo = POUT; a.h = (bf16*)(ws + WS_H); a.wpost = PIN(6) + (l * 3 + 1) * 1024; a.gate = mod + (1 * 3 + 2) * 1024; a.coef = 1.0f;
        a.wpre = PIN(5) + (l * 3 + 2) * 1024; a.shift = mod + (2 * 3 + 0) * 1024; a.scale = mod + (2 * 3 + 1) * 1024; ph_rows(a, wv); }
    GRID_BAR();
}
__global__ void __launch_bounds__(NTHREADS, 2) mega_fwd(Params P) {
    extern __shared__ __attribute__((aligned(16))) unsigned char lds_raw[];
    LAS unsigned char* lds = (LAS unsigned char*)lds_raw;
    const int wv = __builtin_amdgcn_readfirstlane((int)threadIdx.x >> 6);
    { const int tid0 = threadIdx.x;
      for (int u = tid0; u < (LDS_BYTES - LDS_CTL_OFF) / 4; u += NTHREADS) ((LAS unsigned*)(lds + LDS_CTL_OFF))[u] = 0u;
      __syncthreads();
      XcdBarrier b0 = xcd_barrier_post((unsigned*)(PWS + WS_CTL) + CW_BAR, (volatile LAS unsigned*)(lds + LDS_CTL_OFF + 320) + 8);
      if (tid0 == 0) ((volatile LAS unsigned*)(lds + LDS_CTL_OFF + 320))[10] = b0.x;
      __syncthreads(); }
    PHASE(0, ph_ada(lds_raw, wv); ph_rope(wv); ph_convert(0, lds_raw, wv); );
    GRID_BAR();
    PHASE(12, WS_R_PTRS float* MOD = (float*)(ws + WS_MOD);
      RowArgs a; a.xi = PIN(0); a.y = nullptr; a.xo = nullptr; a.h = (bf16*)(ws + WS_H); a.wpost = nullptr; a.gate = nullptr; a.wpre = PIN(5); a.shift = MOD; a.scale = MOD + 1024; a.coef = 0.f; ph_rows(a, wv); );
    GRID_BAR();
    ffn_block<0, 0>(lds, lds_raw, wv); mixer_block<0>(lds, lds_raw, wv); ffn_block<0, 1>(lds, lds_raw, wv);
    ffn_block<1, 0>(lds, lds_raw, wv); mixer_block<1>(lds, lds_raw, wv); ffn_block<1, 1>(lds, lds_raw, wv);
}

extern "C" void kernel_launch(void* const* d_in, const int* in_sizes, int n_in, void* d_out, int out_size, void* d_ws, size_t ws_size, hipStream_t stream) {
    static int grid = 0;
    if (grid == 0) {
        if (n_in != 17 || ws_size < WS_END) { fprintf(stderr, "kernel_launch: unexpected n_in %d / ws_size %zu\n", n_in, ws_size); grid = -1; return; }
        int dev = 0, cus = 0, per_cu = 0;
        if (hipGetDevice(&dev) != hipSuccess || hipDeviceGetAttribute(&cus, hipDeviceAttributeMultiprocessorCount, dev) != hipSuccess) { grid = -1; return; }
        if (hipFuncSetAttribute((const void*)mega_fwd, hipFuncAttributeMaxDynamicSharedMemorySize, LDS_BYTES) != hipSuccess) { fprintf(stderr, "kernel_launch: hipFuncSetAttribute failed\n"); grid = -1; return; }
        if (hipOccupancyMaxActiveBlocksPerMultiprocessor(&per_cu, (const void*)mega_fwd, NTHREADS, LDS_BYTES) != hipSuccess || per_cu < 1) { fprintf(stderr, "kernel_launch: occupancy query says %d\n", per_cu); per_cu = 1; }
        (void)hipGetLastError();
        grid = cus;
        if (grid > 256) grid = 256;
    }
    if (grid < 0) return;
    (void)hipMemsetAsync((char*)d_ws + WS_CTL, 0, 1 * MiB, stream);
    Params p{};
    for (int i = 0; i < 17; ++i) p.in[i] = (const float*)d_in[i];
    p.out = (float*)d_out; p.ws = (unsigned char*)d_ws;
    hipLaunchKernelGGL(mega_fwd, dim3(grid), dim3(NTHREADS), LDS_BYTES, stream, p);
}
```

```cpp
#include <hip/hip_runtime.h>
#include <cstdio>
#include <cstdint>
__device__ __forceinline__ int lane_id_() { int l; asm volatile("v_mbcnt_lo_u32_b32 %0, -1, 0\n\tv_mbcnt_hi_u32_b32 %0, -1, %0" : "=v"(l)); return l; }
namespace pg8 {
#define PG8_LAS __attribute__((address_space(3)))
typedef unsigned short bf16_t;
typedef short bf16x8 __attribute__((ext_vector_type(8)));
typedef float f32x4 __attribute__((ext_vector_type(4)));
typedef unsigned u32x4 __attribute__((ext_vector_type(4)));
constexpr int BM = 256, BK = 64, HALF = 128, HTB = HALF * BK * 2  , STAGE_BYTES = 8 * HTB, NXCD = 8, WGM = 8;

__host__ __device__ __forceinline__ int lds_byte(int r, int c) { const int st = (r >> 4) * 2 + (c >> 5), rr = r & 15, cc = c & 31, ob = rr * 64 + cc * 2; return st * 1024 + (ob ^ (((ob >> 9) & 1) << 5)); }
__host__ __device__ __forceinline__ void stage_rc(int b, int& R, int& C) { const int st = b / 1024, sb = b % 1024, swz = sb ^ (((sb >> 9) & 1) << 5); R = (st >> 1) * 16 + swz / 64; C = (st & 1) * 32 + (swz % 64) / 2; }
__host__ __device__ __forceinline__ int perm32(int rho) { const int n = rho >> 4, i = rho & 15; return 8 * (i >> 2) + 4 * n + (i & 3); }

struct Unit { int pm, pn; };
struct Gemm { const bf16_t* A; const bf16_t* Bt; int M, N, K, pad_; };

struct StaticOrder {
    int nM, nN, nwg, G, c;
    __host__ __device__ void init(int M, int N, int G_, int c_) { nM = M / BM; nN = N / BM; nwg = nM * nN; G = G_; c = c_; }
    __host__ __device__ bool next(int i, Unit& u) const {
        const long L = (long)i * G + c; if (L >= nwg) return false;
        int wgid = (int)L; { const int q = nwg / NXCD, r = nwg % NXCD, xcd = wgid % NXCD, off = wgid / NXCD; wgid = (xcd < r ? xcd * (q + 1) : r * (q + 1) + (xcd - r) * q) + off; }
        const int nig = WGM * nN, gid = wgid / nig, fm = gid * WGM, gsz = (nM - fm) < WGM ? (nM - fm) : WGM;
        u.pm = fm + ((wgid % nig) % gsz); u.pn = (wgid % nig) / gsz; return true;
    }
    __device__ __forceinline__ void a_ready(const Unit&) const {}
    __device__ __forceinline__ void done(const Unit&) const {}
};

__device__ __forceinline__ unsigned cvt_pk_bf16(float lo, float hi) { unsigned r; asm volatile("v_cvt_pk_bf16_f32 %0, %1, %2" : "=v"(r) : "v"(lo), "v"(hi)); return r; }
typedef float f32x2 __attribute__((ext_vector_type(2)));
__device__ __forceinline__ f32x2 gelu_pk(f32x2 v) {
    const f32x2 av = __builtin_elementwise_abs(v), d = av * 0.2316418882f + 1.0f;
    f32x2 t; t.x = __builtin_amdgcn_rcpf(d.x); t.y = __builtin_amdgcn_rcpf(d.y);
    f32x2 q = t * 0.5307027145f + (-0.7265760135f); q = q * t + 0.7107068705f; q = q * t + (-0.142248368f); q = q * t + 0.127414796f; q = q * t;
    const f32x2 s = (v * v) * (-0.72134752044f);
    f32x2 e; e.x = __builtin_amdgcn_exp2f(s.x); e.y = __builtin_amdgcn_exp2f(s.y);
    const f32x2 m = v * (q * e), r = v - m;
    f32x2 o; o.x = v.x < 0.f ? m.x : r.x; o.y = v.y < 0.f ? m.y : r.y; return o;
}

template <int ACT  > struct EpiBf16 {
    static constexpr bool PERM = true, AFTER_DRAIN = false; static_assert(ACT == 0 || ACT == 1, "EpiBf16: ACT is 0 (none) or 1 (gelu_pk)");
    bf16_t* O; int ldc; const float* bias; int split_cols; size_t split_stride; float scale0;
    __device__ __forceinline__ void operator()(const f32x4 (&acc)[2][2][4][2], const Unit& u, int wr, int wc, int fr, int fq) const {
        const int row0 = u.pm * BM + wr * 64 + fr; int colt = u.pn * BM; bf16_t* base = O;
        float sc = 1.f; if (split_cols) { const int t = colt / split_cols; base += (size_t)t * split_stride; colt -= t * split_cols; if (t == 0) sc = scale0; }
        const int col0 = colt + wc * 32 + 8 * fq, bcol0 = u.pn * BM + wc * 32 + 8 * fq;
        f32x4 bv[2][2];
#pragma unroll
        for (int bj = 0; bj < 2; ++bj)
#pragma unroll
            for (int n = 0; n < 2; ++n) bv[bj][n] = bias ? *(const f32x4*)(bias + bcol0 + bj * HALF + 4 * n) : (f32x4){0.f, 0.f, 0.f, 0.f};
#pragma unroll
        for (int ai = 0; ai < 2; ++ai)
#pragma unroll
            for (int m = 0; m < 4; ++m) { bf16_t* rowp = base + (size_t)(row0 + ai * HALF + m * 16) * ldc + col0;
#pragma unroll
                for (int bj = 0; bj < 2; ++bj) { f32x4 v0 = acc[ai][bj][m][0] + bv[bj][0], v1 = acc[ai][bj][m][1] + bv[bj][1];
                    if (ACT == 1) { f32x2 a = gelu_pk((f32x2){v0[0], v0[1]}), b = gelu_pk((f32x2){v0[2], v0[3]}), c = gelu_pk((f32x2){v1[0], v1[1]}), d = gelu_pk((f32x2){v1[2], v1[3]});
                        v0 = (f32x4){a.x, a.y, b.x, b.y}; v1 = (f32x4){c.x, c.y, d.x, d.y}; }
                    v0 = v0 * sc; v1 = v1 * sc; u32x4 w; w.x = cvt_pk_bf16(v0[0], v0[1]); w.y = cvt_pk_bf16(v0[2], v0[3]); w.z = cvt_pk_bf16(v1[0], v1[1]); w.w = cvt_pk_bf16(v1[2], v1[3]);
                    *(u32x4*)(rowp + bj * HALF) = w; } }
    }
};

struct PanelStats {
    unsigned* xbuf;
    unsigned* cnt;
    unsigned* tmo;
    int ntn; float eps;
    unsigned code;
    __device__ __forceinline__ bool run(const f32x4 (&v)[2][2][4][2], const Unit& u, int wr, int wc, int fr, int fq, PG8_LAS unsigned char* lds, int wid, int lane) const {
        typedef float f32x2v __attribute__((ext_vector_type(2)));
        PG8_LAS f32x2v* P = (PG8_LAS f32x2v*)lds;
        PG8_LAS f32x2v* S = (PG8_LAS f32x2v*)(lds + 8192);
        PG8_LAS unsigned* flag = (PG8_LAS unsigned*)(lds + 8192 + 2048);
#pragma unroll
        for (int ai = 0; ai < 2; ++ai)
#pragma unroll
            for (int m = 0; m < 4; ++m) {
                float s = 0.f;
#pragma unroll
                for (int bj = 0; bj < 2; ++bj)
#pragma unroll
                    for (int n = 0; n < 2; ++n) { const f32x4 x = v[ai][bj][m][n]; s += (x[0] + x[1]) + (x[2] + x[3]); }
                s += __shfl_xor(s, 16); s += __shfl_xor(s, 32);
                const float mw = s * (1.0f / 64.0f); float q = 0.f;
#pragma unroll
                for (int bj = 0; bj < 2; ++bj)
#pragma unroll
                    for (int n = 0; n < 2; ++n) { const f32x4 d = v[ai][bj][m][n] - mw; q += (d[0] * d[0] + d[1] * d[1]) + (d[2] * d[2] + d[3] * d[3]); }
                q += __shfl_xor(q, 16); q += __shfl_xor(q, 32);
                if (fq == 0) P[(ai * HALF + wr * 64 + m * 16 + fr) * 4 + wc] = (f32x2v){mw, q};
            }
        asm volatile("s_waitcnt lgkmcnt(0)" ::: "memory"); __builtin_amdgcn_s_barrier(); asm volatile("" ::: "memory");
#if defined(BROKEN_EXCHANGE_NO_WAIT)
#warning BROKEN CONTROL BUILD: the row-statistics exchange does not wait; results are wrong by design
        if (blockIdx.x >= 64) { const long long t0_ = clock64(); while (clock64() - t0_ < 60000) __builtin_amdgcn_s_sleep(8); }
#endif
        const int row = wid * 32 + (lane & 31);
        if (lane < 32) {
            const f32x2v a = P[row * 4 + 0], b = P[row * 4 + 1], c = P[row * 4 + 2], d = P[row * 4 + 3];
            const float mt = (a.x + b.x + c.x + d.x) * 0.25f;
            const float da = a.x - mt, db = b.x - mt, dc = c.x - mt, dd = d.x - mt;
            const float m2 = (a.y + b.y) + (c.y + d.y) + 64.0f * ((da * da + db * db) + (dc * dc + dd * dd));
            unsigned long long* slot = (unsigned long long*)xbuf + ((size_t)(u.pm * BM + row) * 4 + u.pn);
            __hip_atomic_store(slot, ((unsigned long long)__float_as_uint(m2) << 32) | __float_as_uint(mt), __ATOMIC_RELAXED, __HIP_MEMORY_SCOPE_AGENT);
        }
        asm volatile("s_waitcnt vmcnt(0)" ::: "memory");
        if (lane == 0) __hip_atomic_fetch_add(cnt + 64 * u.pm, 1u, __ATOMIC_RELAXED, __HIP_MEMORY_SCOPE_AGENT);
        if (wid == 0) {
            bool dead = false; const unsigned long long t0 = __builtin_amdgcn_s_memrealtime(); const unsigned want = 8u * (unsigned)ntn;
            for (;;) {
#if defined(BROKEN_EXCHANGE_NO_WAIT)
                break;
#endif
                if ((unsigned)__builtin_amdgcn_readfirstlane(__hip_atomic_load(cnt + 64 * u.pm, __ATOMIC_RELAXED, __HIP_MEMORY_SCOPE_AGENT)) >= want) break;
                if (__builtin_amdgcn_s_memrealtime() - t0 > 2000000ull) {
                    if (lane == 0) { unsigned expect = 0u; __hip_atomic_compare_exchange_strong(tmo + 1, &expect, code | (unsigned)(u.pm & 0xff), __ATOMIC_RELAXED, __ATOMIC_RELAXED, __HIP_MEMORY_SCOPE_AGENT);
                                     __hip_atomic_store(tmo, 1u, __ATOMIC_RELAXED, __HIP_MEMORY_SCOPE_AGENT); }
                    dead = true; break; }
                __builtin_amdgcn_s_sleep(2);
            }
            __builtin_amdgcn_fence(__ATOMIC_ACQUIRE, "agent");
            if (lane == 0) flag[0] = dead ? 1u : 0u;
        }
        asm volatile("s_waitcnt vmcnt(0) lgkmcnt(0)" ::: "memory"); __builtin_amdgcn_s_barrier(); asm volatile("" ::: "memory");
        const bool bad = flag[0] != 0u;
        if (lane < 32) {
            const unsigned long long* slot = (const unsigned long long*)xbuf + (size_t)(u.pm * BM + row) * 4; float mt[4], m2[4]; float ms = 0.f;
#pragma unroll
            for (int t = 0; t < 4; ++t) { if (t < ntn) { const unsigned long long w = __hip_atomic_load(slot + t, __ATOMIC_RELAXED, __HIP_MEMORY_SCOPE_AGENT); mt[t] = __uint_as_float((unsigned)w); m2[t] = __uint_as_float((unsigned)(w >> 32)); } else { mt[t] = 0.f; m2[t] = 0.f; } ms += mt[t]; }
            const float mean = ms / (float)ntn; float q = 0.f;
#pragma unroll
            for (int t = 0; t < 4; ++t) if (t < ntn) { const float dm = mt[t] - mean; q += m2[t] + 256.0f * dm * dm; }
            S[row] = (f32x2v){mean, 1.0f / sqrtf(q / (256.0f * (float)ntn) + eps)};
        }
        asm volatile("s_waitcnt lgkmcnt(0)" ::: "memory"); __builtin_amdgcn_s_barrier(); asm volatile("" ::: "memory");
        return bad;
    }
};
struct EpiLnRes {
    static constexpr bool PERM = false, AFTER_DRAIN = true;
    const float* base; float* out; int ldc; const float* bias; PanelStats st; unsigned poison;
    __device__ __forceinline__ void fused(f32x4 (&acc)[2][2][4][2], const Unit& u, int wr, int wc, int fr, int fq, PG8_LAS unsigned char* lds, int wid, int lane) const {
        typedef float f32x2v __attribute__((ext_vector_type(2)));
        const PG8_LAS f32x2v* S = (const PG8_LAS f32x2v*)(lds + 8192);
        const int col0 = u.pn * BM + wc * 32 + 4 * fq;
#pragma unroll
        for (int bj = 0; bj < 2; ++bj)
#pragma unroll
            for (int n = 0; n < 2; ++n) { const f32x4 bv = bias ? *(const f32x4*)(bias + col0 + bj * HALF + n * 16) : (f32x4){0.f, 0.f, 0.f, 0.f};
#pragma unroll
                for (int ai = 0; ai < 2; ++ai)
#pragma unroll
                    for (int m = 0; m < 4; ++m) acc[ai][bj][m][n] += bv; }
        f32x4 pre[4][2][2];
#pragma unroll
        for (int m = 0; m < 4; ++m) { const size_t off = (size_t)(u.pm * BM + wr * 64 + m * 16 + fr) * ldc + col0;
#pragma unroll
            for (int bj = 0; bj < 2; ++bj)
#pragma unroll
                for (int n = 0; n < 2; ++n) pre[m][bj][n] = *(const f32x4*)(base + off + bj * HALF + n * 16); }
        const bool bad = st.run(acc, u, wr, wc, fr, fq, lds, wid, lane) || poison != 0u;
        const float qnan = __builtin_nanf("");
#pragma unroll
        for (int ai = 0; ai < 2; ++ai)
#pragma unroll
            for (int m = 0; m < 4; ++m) { const int r = ai * HALF + wr * 64 + m * 16 + fr; const f32x2v sr = S[r]; const size_t off = (size_t)(u.pm * BM + r) * ldc + col0;
#pragma unroll
                for (int bj = 0; bj < 2; ++bj)
#pragma unroll
                    for (int n = 0; n < 2; ++n) { const f32x4 bs = ai == 0 ? pre[m][bj][n] : *(const f32x4*)(base + off + bj * HALF + n * 16); f32x4 o = bs + (acc[ai][bj][m][n] - sr.x) * sr.y;
                        if (bad) o = (f32x4){qnan, qnan, qnan, qnan}; *(f32x4*)(out + off + bj * HALF + n * 16) = o; }
                if (m & 1) asm volatile("" ::: "memory"); }
    }
};
struct EpiLnResLn {
    static constexpr bool PERM = false, AFTER_DRAIN = true;
    const float* base; float* out; bf16_t* xn; int ldc; const float* bias; PanelStats st1, st2; unsigned poison;
    __device__ __forceinline__ void fused(f32x4 (&acc)[2][2][4][2], const Unit& u, int wr, int wc, int fr, int fq, PG8_LAS unsigned char* lds, int wid, int lane) const {
        typedef float f32x2v __attribute__((ext_vector_type(2))); typedef unsigned u32x2v __attribute__((ext_vector_type(2)));
        const PG8_LAS f32x2v* S = (const PG8_LAS f32x2v*)(lds + 8192);
        const int col0 = u.pn * BM + wc * 32 + 4 * fq;
#pragma unroll
        for (int bj = 0; bj < 2; ++bj)
#pragma unroll
            for (int n = 0; n < 2; ++n) { const f32x4 bv = bias ? *(const f32x4*)(bias + col0 + bj * HALF + n * 16) : (f32x4){0.f, 0.f, 0.f, 0.f};
#pragma unroll
                for (int ai = 0; ai < 2; ++ai)
#pragma unroll
                    for (int m = 0; m < 4; ++m) acc[ai][bj][m][n] += bv; }
        bool bad = st1.run(acc, u, wr, wc, fr, fq, lds, wid, lane) || poison != 0u;
        const float qnan = __builtin_nanf("");
#pragma unroll
        for (int ai = 0; ai < 2; ++ai)
#pragma unroll
            for (int m = 0; m < 4; ++m) { const int r = ai * HALF + wr * 64 + m * 16 + fr; const f32x2v sr = S[r]; const size_t off = (size_t)(u.pm * BM + r) * ldc + col0;
#pragma unroll
                for (int bj = 0; bj < 2; ++bj)
#pragma unroll
                    for (int n = 0; n < 2; ++n) { const f32x4 bs = *(const f32x4*)(base + off + bj * HALF + n * 16); acc[ai][bj][m][n] = bs + (acc[ai][bj][m][n] - sr.x) * sr.y; }
                asm volatile("" : "+v"(acc[ai][0][m][0]), "+v"(acc[ai][0][m][1]), "+v"(acc[ai][1][m][0]), "+v"(acc[ai][1][m][1]));
                if (m & 1) asm volatile("" ::: "memory"); }
        const bool bad1 = bad;
        bad = st2.run(acc, u, wr, wc, fr, fq, lds, wid, lane) || bad;
#pragma unroll
        for (int ai = 0; ai < 2; ++ai)
#pragma unroll
            for (int m = 0; m < 4; ++m) { const int r = ai * HALF + wr * 64 + m * 16 + fr; const f32x2v sr = S[r]; const size_t off = (size_t)(u.pm * BM + r) * ldc + col0;
#pragma unroll
                for (int bj = 0; bj < 2; ++bj)
#pragma unroll
                    for (int n = 0; n < 2; ++n) { const f32x4 x1 = acc[ai][bj][m][n]; *(f32x4*)(out + off + bj * HALF + n * 16) = bad1 ? (f32x4){qnan, qnan, qnan, qnan} : x1;
                        const f32x4 o = (x1 - sr.x) * sr.y; u32x2v w; w.x = cvt_pk_bf16(o[0], o[1]); w.y = cvt_pk_bf16(o[2], o[3]);
                        if (bad) { w.x = 0x7fc07fc0u; w.y = 0x7fc07fc0u; } *(u32x2v*)(xn + off + bj * HALF + n * 16) = w; }
                asm volatile("" ::: "memory"); }
    }
};

template <class Epi, class Sched, bool ALIGN_EPI = false, bool SP2 = false>
__device__ __forceinline__ void gemm_phase(PG8_LAS unsigned char* lds, const Gemm g, const Sched& S, const Epi& E, int wv) {
    int tid_ = wv * 64 + lane_id_(); asm volatile("" : "+v"(tid_));
    const int tid = tid_, wid = __builtin_amdgcn_readfirstlane(tid >> 6), lane = tid & 63, wr = wid >> 2, wc = wid & 3, fr = lane & 15, fq = lane >> 4;
    const int K = g.K, nt = K / BK;
    unsigned voffA[2], voffB[2];
#pragma unroll
    for (int i = 0; i < 2; ++i) { int R, C; stage_rc(tid * 16 + i * 8192, R, C); const int Rb = Epi::PERM ? ((R & ~31) + perm32(R & 31)) : R;
        voffA[i] = (unsigned)(R * K + C) * 2u; voffB[i] = (unsigned)(Rb * K + C) * 2u; }
    const size_t kstep = (size_t)(BK * 2);
    const size_t hstep = (size_t)HALF * K * 2;
    const size_t tstep = 2 * hstep;
    const unsigned ldsw = (unsigned)wid * 1024u;
    const int aoff = lds_byte(wr * 64 + fr, fq * 8), boff = lds_byte(wc * 32 + fr, fq * 8);
#define PG8_SA(b, h) (((b) * 2 + (h)) * HTB)
#define PG8_SB(b, h) ((4 + (b) * 2 + (h)) * HTB)
#define PG8_STAGE(bufoff, gbase, voff) do { _Pragma("unroll") for (int _i = 0; _i < 2; ++_i) \
        __builtin_amdgcn_global_load_lds((const unsigned*)((const char*)(gbase) + (voff)[_i]), (PG8_LAS unsigned*)(lds + (bufoff) + ldsw + _i * 8192), 16, 0, 0); } while (0)
#define PG8_LDA(dst, b, h) do { _Pragma("unroll") for (int m = 0; m < 4; ++m) _Pragma("unroll") for (int k = 0; k < 2; ++k) dst[m][k] = *(const PG8_LAS bf16x8*)(lds + PG8_SA(b, h) + aoff + m * 2048 + k * 1024); } while (0)
#define PG8_LDB(dst, b, h) do { _Pragma("unroll") for (int n = 0; n < 2; ++n) _Pragma("unroll") for (int k = 0; k < 2; ++k) dst[n][k] = *(const PG8_LAS bf16x8*)(lds + PG8_SB(b, h) + boff + n * 2048 + k * 1024); } while (0)
#define PG8_MMA(ai, bj, At, Bt) do { __builtin_amdgcn_s_setprio(1); _Pragma("unroll") for (int m = 0; m < 4; ++m) _Pragma("unroll") for (int n = 0; n < 2; ++n) _Pragma("unroll") for (int k = 0; k < 2; ++k) \
        acc[ai][bj][m][n] = __builtin_amdgcn_mfma_f32_16x16x32_bf16(Bt[n][k], At[m][k], acc[ai][bj][m][n], 0, 0, 0); __builtin_amdgcn_s_setprio(0); } while (0)
#define PG8_WAIT_V(n) asm volatile("s_waitcnt vmcnt(" #n ")" ::: "memory")
#define PG8_WAIT_L(n) asm volatile("s_waitcnt lgkmcnt(" #n ")" ::: "memory")
#define PG8_BAR __builtin_amdgcn_s_barrier()
#define PG8_SCHED __builtin_amdgcn_sched_barrier(0)
    Unit cur, nxt; int ui = 0;
    if (!S.next(0, cur)) return;
    f32x4 acc[2][2][4][2];
#pragma unroll
    for (int a = 0; a < 2; ++a)
#pragma unroll
        for (int b = 0; b < 2; ++b)
#pragma unroll
            for (int m = 0; m < 4; ++m)
#pragma unroll
                for (int n = 0; n < 2; ++n) acc[a][b][m][n] = (f32x4){0.f, 0.f, 0.f, 0.f};
    bf16x8 At[4][2], B0[2][2], B1[2][2];
    const char* cA = (const char*)g.A + (size_t)cur.pm * tstep; const char* cB = (const char*)g.Bt + (size_t)cur.pn * tstep;
    S.a_ready(cur);
    if constexpr (SP2) {
        PG8_STAGE(PG8_SB(0, 0), cB, voffB); PG8_STAGE(PG8_SB(0, 1), cB + hstep, voffB); PG8_STAGE(PG8_SA(0, 0), cA, voffA); PG8_STAGE(PG8_SA(0, 1), cA + hstep, voffA);
        if (wr == 1) PG8_BAR;
        PG8_WAIT_V(2); PG8_BAR;
        PG8_STAGE(PG8_SB(1, 0), cB + kstep, voffB); PG8_STAGE(PG8_SA(1, 0), cA + kstep, voffA); PG8_STAGE(PG8_SB(1, 1), cB + hstep + kstep, voffB);
        PG8_WAIT_V(6); PG8_BAR;
    } else {
        PG8_STAGE(PG8_SB(0, 0), cB, voffB); PG8_STAGE(PG8_SA(0, 0), cA, voffA); PG8_STAGE(PG8_SB(0, 1), cB + hstep, voffB); PG8_STAGE(PG8_SA(0, 1), cA + hstep, voffA);
        if (wr == 1) PG8_BAR;
        PG8_WAIT_V(4); PG8_BAR;
        PG8_STAGE(PG8_SB(1, 0), cB + kstep, voffB); PG8_STAGE(PG8_SA(1, 0), cA + kstep, voffA); PG8_STAGE(PG8_SB(1, 1), cB + hstep + kstep, voffB);
        PG8_WAIT_V(6); PG8_BAR;
    }
    for (;;) {
        const bool has_next = S.next(ui + 1, nxt);
        const char* nA = has_next ? (const char*)g.A + (size_t)nxt.pm * tstep : cA; const char* nB = has_next ? (const char*)g.Bt + (size_t)nxt.pn * tstep : cB;
        for (int t = 0; t < nt; t += 2) {
            const bool last = (t == nt - 2);
            const char* a1 = cA + (size_t)(t + 1) * kstep;
            const char* a2 = last ? nA : cA + (size_t)(t + 2) * kstep; const char* b2 = last ? nB : cB + (size_t)(t + 2) * kstep;
            const char* a3 = a2 + kstep; const char* b3 = b2 + kstep;
            if (last && has_next) S.a_ready(nxt);
            if constexpr (SP2) {
            PG8_LDB(B0, 0, 0); PG8_LDB(B1, 0, 1); PG8_SCHED; PG8_LDA(At, 0, 0); PG8_STAGE(PG8_SA(1, 1), a1 + hstep, voffA);
            PG8_WAIT_V(8); PG8_WAIT_L(0); PG8_BAR; PG8_MMA(0, 0, At, B0); PG8_MMA(0, 1, At, B1); PG8_BAR; PG8_SCHED;
            PG8_LDA(At, 0, 1); PG8_STAGE(PG8_SB(0, 0), b2, voffB); PG8_STAGE(PG8_SB(0, 1), b2 + hstep, voffB); PG8_STAGE(PG8_SA(0, 0), a2, voffA);
            PG8_WAIT_V(8); PG8_WAIT_L(0); PG8_BAR; PG8_MMA(1, 0, At, B0); PG8_MMA(1, 1, At, B1); PG8_BAR; PG8_SCHED;
            PG8_LDB(B0, 1, 0); PG8_LDB(B1, 1, 1); PG8_SCHED; PG8_LDA(At, 1, 0); PG8_STAGE(PG8_SA(0, 1), a2 + hstep, voffA);
            PG8_WAIT_V(8); PG8_WAIT_L(0); PG8_BAR; PG8_MMA(0, 0, At, B0); PG8_MMA(0, 1, At, B1); PG8_BAR; PG8_SCHED;
            PG8_LDA(At, 1, 1); PG8_STAGE(PG8_SB(1, 0), b3, voffB); PG8_STAGE(PG8_SB(1, 1), b3 + hstep, voffB); PG8_STAGE(PG8_SA(1, 0), a3, voffA);
            PG8_WAIT_V(8); PG8_WAIT_L(0); PG8_BAR; PG8_MMA(1, 0, At, B0); PG8_MMA(1, 1, At, B1); PG8_BAR; PG8_SCHED;
            } else {
            PG8_LDB(B0, 0, 0); PG8_SCHED; PG8_LDA(At, 0, 0); PG8_STAGE(PG8_SA(1, 1), a1 + hstep, voffA);
            PG8_WAIT_L(8); PG8_BAR; PG8_WAIT_L(0); PG8_MMA(0, 0, At, B0); PG8_BAR; PG8_SCHED;
            PG8_LDB(B1, 0, 1); PG8_STAGE(PG8_SB(0, 0), b2, voffB);
            PG8_BAR; PG8_WAIT_L(0); PG8_MMA(0, 1, At, B1); PG8_BAR;
            PG8_LDA(At, 0, 1); PG8_STAGE(PG8_SA(0, 0), a2, voffA);
            PG8_BAR; PG8_WAIT_L(0); PG8_MMA(1, 0, At, B0); PG8_BAR; PG8_SCHED;
            PG8_STAGE(PG8_SB(0, 1), b2 + hstep, voffB);
            PG8_WAIT_V(6); PG8_BAR; PG8_MMA(1, 1, At, B1); PG8_BAR;
            PG8_LDB(B0, 1, 0); PG8_SCHED; PG8_LDA(At, 1, 0); PG8_STAGE(PG8_SA(0, 1), a2 + hstep, voffA);
            PG8_WAIT_L(8); PG8_BAR; PG8_WAIT_L(0); PG8_MMA(0, 0, At, B0); PG8_BAR; PG8_SCHED;
            PG8_LDB(B1, 1, 1); PG8_STAGE(PG8_SB(1, 0), b3, voffB);
            PG8_BAR; PG8_WAIT_L(0); PG8_MMA(0, 1, At, B1); PG8_BAR;
            PG8_LDA(At, 1, 1); PG8_STAGE(PG8_SA(1, 0), a3, voffA);
            PG8_BAR; PG8_WAIT_L(0); PG8_MMA(1, 0, At, B0); PG8_BAR; PG8_SCHED;
            PG8_STAGE(PG8_SB(1, 1), b3 + hstep, voffB);
            PG8_WAIT_V(6); PG8_BAR; PG8_MMA(1, 1, At, B1); PG8_BAR;
            }
        }
        if constexpr (ALIGN_EPI) { if (wr == 0) PG8_BAR; }
        if constexpr (!Epi::AFTER_DRAIN) { E(acc, cur, wr, wc, fr, fq); S.done(cur); }
        if (!has_next) break;
#pragma unroll
        for (int a = 0; a < 2; ++a)
#pragma unroll
            for (int b = 0; b < 2; ++b)
#pragma unroll
                for (int m = 0; m < 4; ++m)
#pragma unroll
                    for (int n = 0; n < 2; ++n) acc[a][b][m][n] = (f32x4){0.f, 0.f, 0.f, 0.f};
        cur = nxt; cA = nA; cB = nB; ++ui;
        if constexpr (ALIGN_EPI) { if (wr == 1) PG8_BAR; }
    }
    PG8_WAIT_V(0);
    if constexpr (!ALIGN_EPI) { if (wr == 0) PG8_BAR; }
    PG8_BAR;
    if constexpr (Epi::AFTER_DRAIN) { E.fused(acc, cur, wr, wc, fr, fq, lds, wid, lane); S.done(cur); }
#undef PG8_SA
#undef PG8_SB
#undef PG8_STAGE
#undef PG8_LDA
#undef PG8_LDB
#undef PG8_MMA
#undef PG8_WAIT_V
#undef PG8_WAIT_L
#undef PG8_BAR
#undef PG8_SCHED
}
}
constexpr int S_ = 16384, D_ = 1024, FF_ = 2816, NIN_ = 7448, NINP_ = 7680;
constexpr int NTHREADS = 512;
constexpr size_t MiB = 1u << 20;
constexpr size_t WS_CTL = 0;
constexpr size_t WS_MOD = 1 * MiB;
constexpr size_t WS_ROPE = 2 * MiB;
constexpr size_t WS_W = 6 * MiB;
constexpr size_t W_FFIN0 = 0, W_FFIN1 = 11 * MiB, W_FFOUT0 = 22 * MiB, W_FFOUT1 = 27 * MiB + MiB / 2, W_IN = 33 * MiB, W_BATT = 48 * MiB, W_BDN = 48 * MiB + MiB / 2, W_OUT = 50 * MiB;
constexpr size_t WS_H = 58 * MiB;
constexpr size_t WS_R = 90 * MiB;
constexpr size_t R_ACT = 0, R_Y = 88 * MiB;
constexpr size_t R_PA = 0, R_QKVD = 0, R_PG = 0, R_PD = 72 * MiB, R_TINV = 72 * MiB, R_ODIR1 = 120 * MiB, R_ODN = 72 * MiB, R_T1 = 96 * MiB, R_PZ = 144 * MiB, R_AB = 168 * MiB, R_GB = 170 * MiB,
                 R_OATT = 172 * MiB, R_ATTN = 180 * MiB, R_Y2 = 160 * MiB, R_OG = 228 * MiB, R_LSE = 252 * MiB, R_ODIR0 = 228 * MiB, R_VEC = 253 * MiB;
constexpr size_t WS_END = 352 * MiB;

typedef unsigned short bf16;
typedef unsigned v4u __attribute__((ext_vector_type(4)));
typedef unsigned v2u __attribute__((ext_vector_type(2)));
typedef float f32x4 __attribute__((ext_vector_type(4)));
typedef float f32x2 __attribute__((ext_vector_type(2)));
#define LAS __attribute__((address_space(3)))

typedef __bf16 bf16x2_hw __attribute__((ext_vector_type(2)));
__device__ __forceinline__ unsigned pk2(float lo, float hi) { f32x2 v = {lo, hi}; return __builtin_bit_cast(unsigned, __builtin_convertvector(v, bf16x2_hw)); }
__device__ __forceinline__ unsigned f2bf(float f) { return pk2(f, f) & 0xffffu; }
__device__ __forceinline__ float bf2f(unsigned short b) { return __builtin_bit_cast(float, (unsigned)b << 16); }
__device__ __forceinline__ float bflo(unsigned w) { return __builtin_bit_cast(float, w << 16); }
__device__ __forceinline__ float bfhi(unsigned w) { return __builtin_bit_cast(float, w & 0xffff0000u); }
__device__ __forceinline__ float wave_sum(float v) {
#pragma unroll
    for (int o = 1; o < 64; o <<= 1) v += __shfl_xor(v, o);
    return v;
}
__device__ __forceinline__ float sigmoidf_(float x) { return 1.0f / (1.0f + __expf(-x)); }
__device__ __forceinline__ float siluf_(float x) { return x / (1.0f + __expf(-x)); }

namespace pg8 {
struct EpiSwiglu {
    static constexpr bool PERM = true, AFTER_DRAIN = false;
    bf16_t* O; int ldc; int pad_;
    __device__ __forceinline__ void operator()(const f32x4 (&acc)[2][2][4][2], const Unit& u, int wr, int wc, int fr, int fq) const {
        const int row0 = u.pm * BM + wr * 64 + fr, col0 = u.pn * 128 + wc * 32 + 8 * fq;
#pragma unroll
        for (int ai = 0; ai < 2; ++ai)
#pragma unroll
            for (int m = 0; m < 4; ++m) {
                bf16_t* rowp = O + (size_t)(row0 + ai * HALF + m * 16) * ldc + col0;
                float v[8];
#pragma unroll
                for (int n = 0; n < 2; ++n)
#pragma unroll
                    for (int e = 0; e < 4; ++e) { const float g = acc[ai][0][m][n][e], uu = acc[ai][1][m][n][e]; v[n * 4 + e] = g * __builtin_amdgcn_rcpf(1.0f + __expf(-g)) * uu; }
                u32x4 w; w.x = cvt_pk_bf16(v[0], v[1]); w.y = cvt_pk_bf16(v[2], v[3]); w.z = cvt_pk_bf16(v[4], v[5]); w.w = cvt_pk_bf16(v[6], v[7]);
                *(u32x4*)rowp = w;
            }
    }
};
struct EpiBf16P {
    static constexpr bool PERM = true, AFTER_DRAIN = false;
    bf16_t* O; int ldc; int pad_;
    __device__ __forceinline__ void operator()(const f32x4 (&acc)[2][2][4][2], const Unit& u, int wr, int wc, int fr, int fq) const {
        const int row0 = u.pm * BM + wr * 64 + fr, col0 = u.pn * BM + wc * 32 + 8 * fq;
#pragma unroll
        for (int ai = 0; ai < 2; ++ai)
#pragma unroll
            for (int m = 0; m < 4; ++m) {
                bf16_t* rowp = O + (size_t)(row0 + ai * HALF + m * 16) * ldc + col0;
#pragma unroll
                for (int bj = 0; bj < 2; ++bj) { const f32x4 v0 = acc[ai][bj][m][0], v1 = acc[ai][bj][m][1];
                    u32x4 w; w.x = cvt_pk_bf16(v0[0], v0[1]); w.y = cvt_pk_bf16(v0[2], v0[3]); w.z = cvt_pk_bf16(v1[0], v1[1]); w.w = cvt_pk_bf16(v1[2], v1[3]);
                    *(u32x4*)(rowp + bj * HALF) = w; }
            }
    }
};
struct EpiF32 {
    static constexpr bool PERM = false, AFTER_DRAIN = false;
    float* O; int ldc; int pad_;
    __device__ __forceinline__ void operator()(const f32x4 (&acc)[2][2][4][2], const Unit& u, int wr, int wc, int fr, int fq) const {
        const int row0 = u.pm * BM + wr * 64 + fr, col0 = u.pn * BM + wc * 32 + 4 * fq;
#pragma unroll
        for (int ai = 0; ai < 2; ++ai)
#pragma unroll
            for (int m = 0; m < 4; ++m) {
                float* rowp = O + (size_t)(row0 + ai * HALF + m * 16) * ldc + col0;
#pragma unroll
                for (int bj = 0; bj < 2; ++bj)
#pragma unroll
                    for (int n = 0; n < 2; ++n) *(f32x4*)(rowp + bj * HALF + n * 16) = acc[ai][bj][m][n];
            }
    }
};
struct EpiInProj {
    static constexpr bool PERM = true, AFTER_DRAIN = false;
    bf16_t* PA; bf16_t* PD; bf16_t* PZ; float* AB;
    __device__ __forceinline__ void operator()(const f32x4 (&acc)[2][2][4][2], const Unit& u, int wr, int wc, int fr, int fq) const {
        const int row0 = u.pm * BM + wr * 64 + fr;
        if (u.pn == 21) {
            if (wc == 0) {
#pragma unroll
                for (int ai = 0; ai < 2; ++ai)
#pragma unroll
                    for (int m = 0; m < 4; ++m) {
                        float* rowp = AB + (size_t)(row0 + ai * HALF + m * 16) * 32 + 8 * fq;
                        *(f32x4*)rowp = acc[ai][0][m][0]; *(f32x4*)(rowp + 4) = acc[ai][0][m][1];
                    }
            }
            return;
        }
        bf16_t* base; int ldc, ct;
        if (u.pn < 9) { base = PA; ldc = 2304; ct = u.pn; } else if (u.pn < 18) { base = PD; ldc = 2304; ct = u.pn - 9; } else { base = PZ; ldc = 768; ct = u.pn - 18; }
        const int col0 = ct * BM + wc * 32 + 8 * fq;
#pragma unroll
        for (int ai = 0; ai < 2; ++ai)
#pragma unroll
            for (int m = 0; m < 4; ++m) {
                bf16_t* rowp = base + (size_t)(row0 + ai * HALF + m * 16) * ldc + col0;
#pragma unroll
                for (int bj = 0; bj < 2; ++bj) { const f32x4 v0 = acc[ai][bj][m][0], v1 = acc[ai][bj][m][1];
                    u32x4 w; w.x = cvt_pk_bf16(v0[0], v0[1]); w.y = cvt_pk_bf16(v0[2], v0[3]); w.z = cvt_pk_bf16(v1[0], v1[1]); w.w = cvt_pk_bf16(v1[2], v1[3]);
                    *(u32x4*)(rowp + bj * HALF) = w; }
            }
    }
};
struct EpiGateF32 {
    static constexpr bool PERM = false, AFTER_DRAIN = false;
    bf16_t* O; const bf16_t* gate; int ldg; int pad_;
    __device__ __forceinline__ void operator()(const f32x4 (&acc)[2][2][4][2], const Unit& u, int wr, int wc, int fr, int fq) const {
        const int row0 = u.pm * BM + wr * 64 + fr, col0 = u.pn * BM + wc * 32 + 4 * fq;
#pragma unroll
        for (int ai = 0; ai < 2; ++ai)
#pragma unroll
            for (int m = 0; m < 4; ++m) {
                const size_t r = (size_t)(row0 + ai * HALF + m * 16);
#pragma unroll
                for (int bj = 0; bj < 2; ++bj)
#pragma unroll
                    for (int n = 0; n < 2; ++n) { const int c = col0 + bj * HALF + n * 16;
                        const v2u gw = *(const v2u*)(gate + r * ldg + c);
                        f32x4 a = acc[ai][bj][m][n];
                        a[0] *= sigmoidf_(bflo(gw.x)); a[1] *= sigmoidf_(bfhi(gw.x)); a[2] *= sigmoidf_(bflo(gw.y)); a[3] *= sigmoidf_(bfhi(gw.y));
                        v2u w; w.x = cvt_pk_bf16(a[0], a[1]); w.y = cvt_pk_bf16(a[2], a[3]); *(v2u*)(O + r * 1024 + c) = w; }
            }
    }
};
struct EpiGateAddBf16 {
    static constexpr bool PERM = false, AFTER_DRAIN = false;
    bf16_t* O; const bf16_t* T1; const bf16_t* gate; int ldg; int pad_;
    __device__ __forceinline__ void operator()(const f32x4 (&acc)[2][2][4][2], const Unit& u, int wr, int wc, int fr, int fq) const {
        const int row0 = u.pm * BM + wr * 64 + fr, col0 = u.pn * BM + wc * 32 + 4 * fq;
#pragma unroll
        for (int ai = 0; ai < 2; ++ai)
#pragma unroll
            for (int m = 0; m < 4; ++m) {
                const size_t r = (size_t)(row0 + ai * HALF + m * 16);
#pragma unroll
                for (int bj = 0; bj < 2; ++bj)
#pragma unroll
                    for (int n = 0; n < 2; ++n) { const int c = col0 + bj * HALF + n * 16;
                        const v2u gw = *(const v2u*)(gate + r * ldg + c);
                        const v2u tw = *(const v2u*)(T1 + r * 1024 + c); const f32x4 t = {bflo(tw.x), bfhi(tw.x), bflo(tw.y), bfhi(tw.y)};
                        f32x4 a = acc[ai][bj][m][n];
                        a[0] = t[0] + a[0] * sigmoidf_(bflo(gw.x)); a[1] = t[1] + a[1] * sigmoidf_(bfhi(gw.x)); a[2] = t[2] + a[2] * sigmoidf_(bflo(gw.y)); a[3] = t[3] + a[3] * sigmoidf_(bfhi(gw.y));
                        v2u w; w.x = cvt_pk_bf16(a[0], a[1]); w.y = cvt_pk_bf16(a[2], a[3]);
                        *(v2u*)(O + r * 1024 + c) = w; }
            }
    }
};
}


#define GAS __attribute__((address_space(1)))
struct Params { const float* in[17]; float* out; unsigned char* ws; };
#define XB_TMO      128
#define XB_XCNT(j)  (256  + 64 * (j))
#define XB_XSUB(j)  (1280 + 64 * (j))
#define XB_XGEN(j)  (2304 + 64 * (j))
#define XB_TOP      3328
#define XB_TOPGEN   3392
#define XCD_BAR_WORDS 3456
#define XB_SPIN_CAP (1u << 18)

__device__ __forceinline__ unsigned xb_ld(unsigned* p)              { return __hip_atomic_load(p, __ATOMIC_RELAXED, __HIP_MEMORY_SCOPE_AGENT); }
__device__ __forceinline__ unsigned xb_add(unsigned* p, unsigned v) { return __hip_atomic_fetch_add(p, v, __ATOMIC_RELAXED, __HIP_MEMORY_SCOPE_AGENT); }
__device__ __forceinline__ unsigned xb_xcc_id() { return (unsigned)__builtin_amdgcn_s_getreg((3 << 11) | 20) & 0xFu; }
#define XB_SPIN(cond, bar) do { unsigned _sp = 0; while (cond) { __builtin_amdgcn_s_sleep(1); \
    if ((++_sp & 255u) == 0u) { if (xb_ld(&(bar)[XB_TMO])) break; if (_sp > XB_SPIN_CAP) { atomicAdd(&(bar)[XB_TMO], 1u); break; } } } } while (0)

struct XcdBarrier {
    unsigned* bar; unsigned x;
    volatile LAS unsigned* st;
};

__device__ __forceinline__ XcdBarrier xcd_barrier_post(unsigned* bar, volatile LAS unsigned* st) {
    XcdBarrier b; b.bar = bar; b.x = xb_xcc_id(); b.st = st;
    if (threadIdx.x == 0) (void)xb_add(&bar[XB_XCNT(b.x)], 1u);
    return b;
}
__device__ __forceinline__ void xcd_barrier_complete(unsigned* bar, unsigned x, unsigned& nloc, unsigned& nx) {
    const unsigned G = gridDim.x * gridDim.y * gridDim.z;
    unsigned sum, cnt, mine, sp = 0u;
    for (;;) {
        sum = 0u; cnt = 0u; mine = 0u;
#pragma unroll
        for (unsigned j = 0; j < 16; ++j) { const unsigned c = xb_ld(&bar[XB_XCNT(j)]); sum += c; cnt += (c > 0u) ? 1u : 0u; mine = (j == x) ? c : mine; }
        if (sum == G) break;
        __builtin_amdgcn_s_sleep(1);
        if ((++sp & 255u) == 0u) { if (xb_ld(&bar[XB_TMO])) break; if (sp > XB_SPIN_CAP) { atomicAdd(&bar[XB_TMO], 1u); break; } }
    }
    nloc = mine > 0u ? mine : 1u; nx = cnt > 0u ? cnt : 1u;
}

__device__ __forceinline__ void xcd_barrier(const XcdBarrier& b, int wv) {
    const bool leader_thread = (wv == 0) && (lane_id_() == 0);
    asm volatile("s_waitcnt vmcnt(0)" ::: "memory");
    __syncthreads();
    if (leader_thread) {
        unsigned* bar = b.bar;
        __builtin_amdgcn_s_waitcnt(0);
        unsigned nloc = b.st[0], nx = b.st[1];
        if (nloc == 0u) { xcd_barrier_complete(bar, b.x, nloc, nx); b.st[0] = nloc; b.st[1] = nx; }
        const unsigned old = xb_add(&bar[XB_XSUB(b.x)], 1u);
        const unsigned gen = old / nloc;
        if (old + 1u == (gen + 1u) * nloc) {
            __builtin_amdgcn_fence(__ATOMIC_RELEASE, "agent");
            asm volatile("s_waitcnt vmcnt(0)" ::: "memory");
            const unsigned og = xb_add(&bar[XB_TOP], 1u);
            const unsigned tg = og / nx;
            if (og + 1u == (tg + 1u) * nx) xb_add(&bar[XB_TOPGEN], 1u);
            else XB_SPIN(xb_ld(&bar[XB_TOPGEN]) == tg, bar);
            __builtin_amdgcn_fence(__ATOMIC_ACQUIRE, "agent");
            xb_add(&bar[XB_XGEN(b.x)], 1u);
            asm volatile("s_waitcnt vmcnt(0)" ::: "memory");
        } else {
            XB_SPIN(xb_ld(&bar[XB_XGEN(b.x)]) == gen, bar);
            __builtin_amdgcn_fence(__ATOMIC_ACQUIRE, "agent");
            asm volatile("s_waitcnt vmcnt(0)" ::: "memory");
        }
    }
    __syncthreads();
}

typedef const __attribute__((address_space(4))) unsigned char* ka_t;
__device__ __forceinline__ ka_t ka_() { ka_t k = (ka_t)__builtin_amdgcn_kernarg_segment_ptr(); asm volatile("" : "+s"(k)); return k; }
#define PIN(i) ((const float*)(const __attribute__((address_space(1))) float*)(*(const __attribute__((address_space(4))) unsigned long long*)(ka_() + 8 * (i))))
#define POUT ((float*)(__attribute__((address_space(1))) float*)(*(const __attribute__((address_space(4))) unsigned long long*)(ka_() + 136)))
#define PWS ((unsigned char*)(__attribute__((address_space(1))) unsigned char*)(*(const __attribute__((address_space(4))) unsigned long long*)(ka_() + 144)))
#define BID ((int)blockIdx.x)
#define GSZ ((int)gridDim.x)
__device__ __forceinline__ int srcmap(int mode, int n) {
    if (mode == 0) return n;
    if (mode == 1) return (n >> 8) * 128 + (n & 127) + ((n >> 7) & 1) * 2816;
    if (n < 5400) return n;
    if (n < 5632) return -1;
    if (n < 6656) return 5400 + (n - 5632);
    return 6424 + (n - 6656);
}
__device__ __forceinline__ void conv_item(const float* W, bf16* WT, int K, int Nsrc, int Ndst, int mode, int item, float* scr, int lane) {
    const int nblk = Ndst / 64, kb = item / nblk, nb = item % nblk, k0 = 64 * kb, n0 = 64 * nb;
    const int r = lane >> 4, q = lane & 15;
    const int sc = srcmap(mode, n0 + 4 * q);
    f32x4 v[16];
#pragma unroll
    for (int i = 0; i < 16; ++i) { const int kk = 4 * i + r; v[i] = sc >= 0 ? *(const f32x4*)(W + (size_t)(k0 + kk) * Nsrc + sc) : (f32x4){0.f, 0.f, 0.f, 0.f}; }
#pragma unroll
    for (int i = 0; i < 16; ++i) { const int kk = 4 * i + r; *(f32x4*)(scr + kk * 68 + 4 * (q ^ ((kk >> 3) & 7))) = v[i]; }
    __builtin_amdgcn_s_waitcnt(0xc07f); __builtin_amdgcn_wave_barrier();
    const int c = lane & 7;
#pragma unroll
    for (int j = 0; j < 8; ++j) { const int n = (lane >> 3) + 8 * j; float s[8];
#pragma unroll
        for (int e = 0; e < 8; ++e) s[e] = scr[(8 * c + e) * 68 + 4 * ((n >> 2) ^ c) + (n & 3)];
        v4u o; o.x = pk2(s[0], s[1]); o.y = pk2(s[2], s[3]); o.z = pk2(s[4], s[5]); o.w = pk2(s[6], s[7]);
        *(v4u*)(WT + (size_t)(n0 + n) * K + k0 + 8 * c) = o; }
    __builtin_amdgcn_s_waitcnt(0xc07f); __builtin_amdgcn_wave_barrier();
}
__device__ __forceinline__ void ph_convert(int l, unsigned char* lds, int wv) {
    int tid_ = wv * 64 + lane_id_(); asm volatile("" : "+v"(tid_)); const int lane = tid_ & 63, wave = tid_ >> 6;
    float* scr = (float*)lds + wave * (64 * 68);
    unsigned char* wb = PWS + WS_W;
    constexpr int I_FI = 16 * 88, I_FO = 44 * 16, I_IN = 16 * 120, I_BA = 4 * 16, I_BD = 12 * 16, I_O = 16 * 16;
    constexpr int NIT = 2 * I_FI + 2 * I_FO + I_IN + I_BA + I_BD + I_O;
    for (int it = BID * 8 + wave; it < NIT; it += GSZ * 8) {
        int r = it;
        if (r < 2 * I_FI) { const int f = r / I_FI; conv_item(PIN(7) + ((size_t)l * 2 + f) * 1024 * 5632, (bf16*)(wb + (f ? W_FFIN1 : W_FFIN0)), 1024, 5632, 5632, 1, r % I_FI, scr, lane); continue; } r -= 2 * I_FI;
        if (r < 2 * I_FO) { const int f = r / I_FO; conv_item(PIN(8) + ((size_t)l * 2 + f) * 2816 * 1024, (bf16*)(wb + (f ? W_FFOUT1 : W_FFOUT0)), 2816, 1024, 1024, 0, r % I_FO, scr, lane); continue; } r -= 2 * I_FO;
        if (r < I_IN) { conv_item(PIN(9) + (size_t)l * 1024 * NIN_, (bf16*)(wb + W_IN), 1024, NIN_, NINP_, 2, r, scr, lane); continue; } r -= I_IN;
        if (r < I_BA) { conv_item(PIN(14) + (size_t)l * 256 * 1024, (bf16*)(wb + W_BATT), 256, 1024, 1024, 0, r, scr, lane); continue; } r -= I_BA;
        if (r < I_BD) { conv_item(PIN(15) + (size_t)l * 768 * 1024, (bf16*)(wb + W_BDN), 768, 1024, 1024, 0, r, scr, lane); continue; } r -= I_BD;
        conv_item(PIN(16) + (size_t)l * 1024 * 1024, (bf16*)(wb + W_OUT), 1024, 1024, 1024, 0, r, scr, lane);
    }
}
__device__ __forceinline__ void ph_ada(unsigned char* lds, int wv) {
    float* red = (float*)(lds + 72 * 1024);
    int tid_ = wv * 64 + lane_id_(); asm volatile("" : "+v"(tid_)); const int tid = tid_, lane = tid_ & 63, wave = tid_ >> 6;
    const float* c = PIN(1); const float* w_ada = PIN(3); const float* b_ada = PIN(4); float* mod = (float*)(PWS + WS_MOD);
    for (int u = BID; u < 72; u += GSZ) {
        const int l = u / 36, n0 = (u % 36) * 256;
        const float* W = w_ada + (size_t)l * 1024 * 9216 + (size_t)(wave * 128) * 9216 + n0 + 4 * lane;
        f32x4 acc = {0.f, 0.f, 0.f, 0.f};
#pragma unroll 1
        for (int k0 = 0; k0 < 128; k0 += 16) {
            f32x4 wv4[16];
#pragma unroll
            for (int kk = 0; kk < 16; ++kk) wv4[kk] = *(const f32x4*)(W + (size_t)(k0 + kk) * 9216);
#pragma unroll
            for (int kk = 0; kk < 16; ++kk) { const float cv = c[wave * 128 + k0 + kk]; const float sv = cv / (1.0f + __expf(-cv)); acc += sv * wv4[kk]; }
        }
        *(f32x4*)(red + wave * 256 + 4 * lane) = acc;
        __syncthreads();
        if (tid < 256) { float t = b_ada[l * 9216 + n0 + tid];
#pragma unroll
            for (int w = 0; w < 8; ++w) t += red[w * 256 + tid];
            mod[l * 9216 + n0 + tid] = t; }
        __syncthreads();
    }
}
__device__ const float ROPE_INV[32] = {1.000000000e+00f, 7.498942018e-01f, 5.623413324e-01f, 4.216965139e-01f, 3.162277639e-01f, 2.371373773e-01f, 1.778279394e-01f, 1.333521456e-01f, 1.000000015e-01f, 7.498942316e-02f, 5.623413250e-02f, 4.216964915e-02f, 3.162277490e-02f, 2.371373773e-02f, 1.778279431e-02f, 1.333521400e-02f, 9.999999776e-03f, 7.498942316e-03f, 5.623413250e-03f, 4.216964822e-03f, 3.162277630e-03f, 2.371373819e-03f, 1.778279431e-03f, 1.333521446e-03f, 1.000000047e-03f, 7.498941850e-04f, 5.623413017e-04f, 4.216965172e-04f, 3.162277571e-04f, 2.371373703e-04f, 1.778279402e-04f, 1.333521504e-04f};
__device__ __forceinline__ void ph_rope(int wv) {
    const int* pos = (const int*)PIN(2); float* tab = (float*)(PWS + WS_ROPE);
    int tid_ = wv * 64 + lane_id_(); asm volatile("" : "+v"(tid_));
    for (int idx = BID * NTHREADS + tid_; idx < S_ * 32; idx += GSZ * NTHREADS) {
        const int t = idx >> 5, i = idx & 31;
        const float inv = ROPE_INV[i];
        const float ang = (float)pos[t] * inv;
        float sn, cs; sincosf(ang, &sn, &cs);
        tab[idx] = cs; tab[S_ * 32 + idx] = sn;
    }
}
struct RowArgs { const float* xi32; const bf16* xib; const bf16* y; float* xo32; bf16* xob; bf16* h; const float* wpost; const float* gate; const float* wpre; const float* shift; const float* scale; float coef; };
constexpr int XB_PITCH = 2048;
__device__ __forceinline__ void ph_rows(const RowArgs& a, int wv) {
    int tid_ = wv * 64 + lane_id_(); asm volatile("" : "+v"(tid_)); const int lane = tid_ & 63, wave = tid_ >> 6;
    f32x4 cpost[4], pa[4], pb[4];
#pragma unroll
    for (int j = 0; j < 4; ++j) { cpost[j] = (f32x4){0.f, 0.f, 0.f, 0.f}; pa[j] = cpost[j]; pb[j] = cpost[j]; }
    if (a.y) {
#pragma unroll
        for (int j = 0; j < 4; ++j) { const f32x4 wp = ((const f32x4*)a.wpost)[lane + 64 * j], g = ((const f32x4*)a.gate)[lane + 64 * j]; cpost[j] = a.coef * g * wp; } }
    if (a.h) {
#pragma unroll
        for (int j = 0; j < 4; ++j) { const f32x4 wp = ((const f32x4*)a.wpre)[lane + 64 * j], sc = ((const f32x4*)a.scale)[lane + 64 * j]; pa[j] = wp * (1.0f + sc); pb[j] = ((const f32x4*)a.shift)[lane + 64 * j]; } }
    for (int r = BID * 8 + wave; r < S_; r += GSZ * 8) {
        f32x4 x[4];
        if (a.xi32) {
            const f32x4* xr = (const f32x4*)(a.xi32 + (size_t)r * D_) + lane;
#pragma unroll
            for (int j = 0; j < 4; ++j) x[j] = xr[64 * j];
        } else {
            const v2u* xr = (const v2u*)(a.xib + (size_t)r * XB_PITCH) + lane;
#pragma unroll
            for (int j = 0; j < 4; ++j) { const v2u xw = xr[64 * j]; x[j] = (f32x4){bflo(xw.x), bfhi(xw.x), bflo(xw.y), bfhi(xw.y)}; }
        }
        if (a.y) {
            f32x4 y[4]; float s = 0.f;
            const v2u* yr = (const v2u*)(a.y + (size_t)r * D_) + lane;
#pragma unroll
            for (int j = 0; j < 4; ++j) { const v2u yw = yr[64 * j]; y[j] = (f32x4){bflo(yw.x), bfhi(yw.x), bflo(yw.y), bfhi(yw.y)}; s += (y[j].x * y[j].x + y[j].y * y[j].y) + (y[j].z * y[j].z + y[j].w * y[j].w); }
            const float rs = 1.0f / sqrtf(wave_sum(s) * (1.f / D_) + 1e-6f);
#pragma unroll
            for (int j = 0; j < 4; ++j) x[j] = x[j] + (y[j] * rs) * cpost[j];
            if (a.xo32) {
                f32x4* xw = (f32x4*)(a.xo32 + (size_t)r * D_) + lane;
#pragma unroll
                for (int j = 0; j < 4; ++j) xw[64 * j] = x[j];
            } else {
                v2u* xw = (v2u*)(a.xob + (size_t)r * XB_PITCH) + lane;
#pragma unroll
                for (int j = 0; j < 4; ++j) { v2u w; w.x = pk2(x[j].x, x[j].y); w.y = pk2(x[j].z, x[j].w); xw[64 * j] = w; }
            }
        }
        if (a.h) {
            float s = 0.f;
#pragma unroll
            for (int j = 0; j < 4; ++j) s += (x[j].x * x[j].x + x[j].y * x[j].y) + (x[j].z * x[j].z + x[j].w * x[j].w);
            const float rs = 1.0f / sqrtf(wave_sum(s) * (1.f / D_) + 1e-6f);
            v2u* hw = (v2u*)(a.h + (size_t)r * D_) + lane;
#pragma unroll
            for (int j = 0; j < 4; ++j) { const f32x4 v = (x[j] * rs) * pa[j] + pb[j];
                v2u w; w.x = pk2(v.x, v.y); w.y = pk2(v.z, v.w); hw[64 * j] = w; }
        }
    }
}
constexpr int ATT_PITCH = 68;
__device__ __forceinline__ void ph_attn_v1(const bf16* PA, const float* rope, bf16* OG, float* LSE, unsigned char* lds, int wv) {
    float* qs = (float*)lds; float* ks = qs + 64 * ATT_PITCH; float* vs = ks + 192 * ATT_PITCH;
    int tid_ = wv * 64 + lane_id_(); asm volatile("" : "+v"(tid_)); const int tid = tid_, lane = tid & 63, wave = tid >> 6;
    for (int u = BID; u < 3072; u += GSZ) {
        const int hg = u & 3, w = (u >> 2) & 255, gi = u >> 10;
        const int dil = 1 << (2 * gi), L = S_ / dil, r = w % dil, nb = w / dil, head = gi * 4 + hg;
        __syncthreads();
        for (int rr = wave; rr < 448; rr += 8) {
            int mm, colbase; float* dst; bool rot; float sc = 1.f;
            if (rr < 64) { mm = nb * 64 + rr; colbase = head * 64; dst = qs + rr * ATT_PITCH; rot = true; sc = 0.125f; }
            else if (rr < 256) { mm = nb * 64 - 64 + (rr - 64); colbase = 768 + head * 64; dst = ks + (rr - 64) * ATT_PITCH; rot = true; }
            else { mm = nb * 64 - 64 + (rr - 256); colbase = 1536 + head * 64; dst = vs + (rr - 256) * ATT_PITCH; rot = false; }
            float val = 0.f;
            if (mm >= 0 && mm < L) {
                const int tok = mm * dil + r;
                val = bf2f(PA[(size_t)tok * 2304 + colbase + lane]);
                if (rot) {
                    const float other = __shfl_xor(val, 32);
                    const float cs = rope[tok * 32 + (lane & 31)], sn = rope[S_ * 32 + tok * 32 + (lane & 31)];
                    val = (lane < 32) ? (val * cs - other * sn) : (val * cs + other * sn);
                }
            }
            dst[lane] = val * sc;
        }
        __syncthreads();
        const int i = tid >> 3, part = tid & 7;
        float q[64], acc[64];
#pragma unroll
        for (int d = 0; d < 64; d += 4) { const f32x4 t = *(const f32x4*)(qs + i * ATT_PITCH + d); q[d] = t.x; q[d + 1] = t.y; q[d + 2] = t.z; q[d + 3] = t.w; }
#pragma unroll
        for (int d = 0; d < 64; ++d) acc[d] = 0.f;
        float m = -1e30f, l = 0.f;
        for (int jj = 0; jj < 24; ++jj) {
            const int j = part + 8 * jj, mm = nb * 64 - 64 + j, dj = j - 64 - i;
            const bool ok = (dj <= 64) && (dj >= -64) && (mm >= 0) && (mm < L);
            if (ok) {
                const float* kr = ks + j * ATT_PITCH; float s = 0.f;
#pragma unroll
                for (int d = 0; d < 64; d += 4) { const f32x4 t = *(const f32x4*)(kr + d); s += q[d] * t.x + q[d + 1] * t.y + q[d + 2] * t.z + q[d + 3] * t.w; }
                const float mn = fmaxf(m, s), al = __expf(m - mn), p = __expf(s - mn);
                l = l * al + p; m = mn;
                const float* vr = vs + j * ATT_PITCH;
#pragma unroll
                for (int d = 0; d < 64; d += 4) { const f32x4 t = *(const f32x4*)(vr + d);
                    acc[d] = acc[d] * al + p * t.x; acc[d + 1] = acc[d + 1] * al + p * t.y; acc[d + 2] = acc[d + 2] * al + p * t.z; acc[d + 3] = acc[d + 3] * al + p * t.w; }
            }
        }
        float mt = fmaxf(m, __shfl_xor(m, 1)); mt = fmaxf(mt, __shfl_xor(mt, 2)); mt = fmaxf(mt, __shfl_xor(mt, 4));
        const float f = __expf(m - mt);
        l *= f; l += __shfl_xor(l, 1); l += __shfl_xor(l, 2); l += __shfl_xor(l, 4);
#pragma unroll
        for (int d = 0; d < 64; ++d) acc[d] *= f;
        const bool b2 = part & 4, b1 = part & 2, b0 = part & 1;
        float r32[32], r16[16], r8[8];
#pragma unroll
        for (int d = 0; d < 32; ++d) { const float keep = b2 ? acc[32 + d] : acc[d], send = b2 ? acc[d] : acc[32 + d]; r32[d] = keep + __shfl_xor(send, 4); }
#pragma unroll
        for (int d = 0; d < 16; ++d) { const float keep = b1 ? r32[16 + d] : r32[d], send = b1 ? r32[d] : r32[16 + d]; r16[d] = keep + __shfl_xor(send, 2); }
#pragma unroll
        for (int d = 0; d < 8; ++d) { const float keep = b0 ? r16[8 + d] : r16[d], send = b0 ? r16[d] : r16[8 + d]; r8[d] = keep + __shfl_xor(send, 1); }
        const float il = 1.0f / l;
        const int tok = (nb * 64 + i) * dil + r;
        v4u o; o.x = pk2(r8[0] * il, r8[1] * il); o.y = pk2(r8[2] * il, r8[3] * il); o.z = pk2(r8[4] * il, r8[5] * il); o.w = pk2(r8[6] * il, r8[7] * il);
        *(v4u*)(OG + ((size_t)gi * S_ + tok) * 256 + hg * 64 + part * 8) = o;
        if (part == 0) LSE[((size_t)gi * S_ + tok) * 4 + hg] = mt + logf(l);
    }
}

__device__ __forceinline__ void ph_dnprep(const bf16* PD, const float* AB, const float* convw, const float* a_log, const float* dt_bias, bf16* QKVd, float* GB, const bf16* OG, const float* LSE, bf16* OATT, int wv) {
    int tid_ = wv * 64 + lane_id_(); asm volatile("" : "+v"(tid_)); const int tid = tid_, lane = tid_ & 63, wave = tid_ >> 6;
    for (int it = BID * 8 + wave; it < 2048 * 5; it += GSZ * 8) {
        const int tb = it / 5, sg = it % 5, c0 = sg * 512 + lane * 8, t0 = tb * 8;
        if (c0 < 2304) {
            const int seg = c0 >> 7;
            float cw[5][8];
#pragma unroll
            for (int j = 0; j < 5; ++j) { const f32x4 a = *(const f32x4*)(convw + j * 2304 + c0), b = *(const f32x4*)(convw + j * 2304 + c0 + 4);
                cw[j][0] = a.x; cw[j][1] = a.y; cw[j][2] = a.z; cw[j][3] = a.w; cw[j][4] = b.x; cw[j][5] = b.y; cw[j][6] = b.z; cw[j][7] = b.w; }
            v4u rows[12];
#pragma unroll
            for (int j = 0; j < 12; ++j) { const int tt = t0 + j - 2; rows[j] = (tt >= 0 && tt < S_) ? *(const v4u*)(PD + (size_t)tt * 2304 + c0) : (v4u){0u, 0u, 0u, 0u}; }
#pragma unroll
            for (int i = 0; i < 8; ++i) {
                float a[8];
#pragma unroll
                for (int e = 0; e < 8; ++e) a[e] = 0.f;
#pragma unroll
                for (int j = 0; j < 5; ++j) { const unsigned wx[4] = {rows[i + j].x, rows[i + j].y, rows[i + j].z, rows[i + j].w};
#pragma unroll
                    for (int e = 0; e < 4; ++e) { a[2 * e] += bflo(wx[e]) * cw[j][2 * e]; a[2 * e + 1] += bfhi(wx[e]) * cw[j][2 * e + 1]; } }
                float ss = 0.f;
#pragma unroll
                for (int e = 0; e < 8; ++e) { a[e] = a[e] * __builtin_amdgcn_rcpf(1.0f + __expf(-a[e])); ss += a[e] * a[e]; }
                if (seg < 12) {
                    ss += __shfl_xor(ss, 1); ss += __shfl_xor(ss, 2); ss += __shfl_xor(ss, 4); ss += __shfl_xor(ss, 8);
                    const float sc = (1.0f / sqrtf(ss + 1e-6f)) * (seg < 6 ? 0.08838834764831845f : 1.0f);
#pragma unroll
                    for (int e = 0; e < 8; ++e) a[e] *= sc;
                }
                v4u o; o.x = pk2(a[0], a[1]); o.y = pk2(a[2], a[3]); o.z = pk2(a[4], a[5]); o.w = pk2(a[6], a[7]);
                *(v4u*)(QKVd + (size_t)(t0 + i) * 2304 + c0) = o;
            }
        }
    }
    for (int e = BID * NTHREADS + tid; e < S_ * 12; e += GSZ * NTHREADS) {
        const int t = e / 12, idx = e % 12;
        const float braw = AB[(size_t)t * 32 + idx], araw = AB[(size_t)t * 32 + 12 + idx];
        const float x = araw + dt_bias[idx];
        const float sp = fmaxf(x, 0.f) + log1pf(expf(-fabsf(x)));
        GB[(size_t)idx * S_ + t] = -expf(a_log[idx]) * sp;
        GB[(size_t)(12 + idx) * S_ + t] = 1.0f / (1.0f + expf(-braw));
    }
#pragma unroll 4
    for (int t = BID * 8 + wave; t < S_; t += GSZ * 8) {
        const int ch = 4 * lane, hg = lane >> 4;
        const float l0 = LSE[(size_t)t * 4 + hg], l1 = LSE[((size_t)S_ + t) * 4 + hg], l2 = LSE[((size_t)2 * S_ + t) * 4 + hg];
        const float mx = fmaxf(l0, fmaxf(l1, l2));
        float w0 = expf(l0 - mx), w1 = expf(l1 - mx), w2 = expf(l2 - mx);
        const float inv = 1.0f / (w0 + w1 + w2); w0 *= inv; w1 *= inv; w2 *= inv;
        const v2u a = *(const v2u*)(OG + (size_t)t * 256 + ch), b = *(const v2u*)(OG + ((size_t)S_ + t) * 256 + ch), cc = *(const v2u*)(OG + ((size_t)2 * S_ + t) * 256 + ch);
        v2u o;
        o.x = pk2(w0 * bflo(a.x) + w1 * bflo(b.x) + w2 * bflo(cc.x), w0 * bfhi(a.x) + w1 * bfhi(b.x) + w2 * bfhi(cc.x));
        o.y = pk2(w0 * bflo(a.y) + w1 * bflo(b.y) + w2 * bflo(cc.y), w0 * bfhi(a.y) + w1 * bfhi(b.y) + w2 * bfhi(cc.y));
        *(v2u*)(OATT + (size_t)t * 256 + ch) = o;
    }
}

__device__ __forceinline__ void ph_final(const bf16* ODIR0, const bf16* ODIR1, const bf16* PZ, const float* dnw, bf16* ODN, int wv) {
    int tid_ = wv * 64 + lane_id_(); asm volatile("" : "+v"(tid_)); const int lane = tid_ & 63, wave = tid_ >> 6;
    for (int t = BID * 8 + wave; t < S_; t += GSZ * 8) {
#pragma unroll
        for (int h = 0; h < 6; ++h) {
            const int c = h * 128 + 2 * lane;
            const unsigned wf = *(const unsigned*)(ODIR0 + (size_t)t * 768 + c), wb = *(const unsigned*)(ODIR1 + (size_t)t * 768 + c);
            float o0 = bflo(wf) + bflo(wb), o1 = bfhi(wf) + bfhi(wb);
            const float ms = wave_sum(o0 * o0 + o1 * o1) * (1.0f / 128.0f);
            const float sc = 1.0f / sqrtf(ms + 1e-6f);
            const unsigned zw = *(const unsigned*)(PZ + (size_t)t * 768 + c);
            const f32x2 nw = *(const f32x2*)(dnw + 2 * lane);
            o0 = o0 * sc * nw.x * siluf_(bflo(zw)); o1 = o1 * sc * nw.y * siluf_(bfhi(zw));
            *(unsigned*)(ODN + (size_t)t * 768 + c) = pk2(o0, o1);
        }
    }
}
typedef short bf16x8_t __attribute__((ext_vector_type(8)));
typedef short s16x4_t __attribute__((ext_vector_type(4)));
#define MFMA16(a, b, c) __builtin_amdgcn_mfma_f32_16x16x32_bf16((a), (b), (c), 0, 0, 0)

__device__ __forceinline__ void ph_dn_pre(const bf16* QKVd, const float* GB, bf16* TINV, bf16* ATTN, float* VEC, unsigned char* lds, int wv) {
    int tid_ = wv * 64 + lane_id_(); asm volatile("" : "+v"(tid_));
    const int tid = tid_, lane = tid & 63, g = lane >> 4, m16 = lane & 15, half = wv >> 2, hw = wv & 3, tl = tid & 255;
    float* GR = (float*)(lds + half * 69120); float* Ms = GR + 2 * 64 * 65; float* Gs = Ms + 2 * 64 * 68; float* Bs = Gs + 128;
#define DN_GRAM_CUMSUM(UU) do { const int u_ = (UU), n_ = u_ / 6, h_ = u_ % 6; \
        {     \
            const int kind = hw - 2; \
            bf16x8_t a[4][4]; \
            _Pragma("unroll") for (int mm = 0; mm < 4; ++mm) { const bf16* arow = QKVd + (size_t)(64 * n_ + 16 * mm + m16) * 2304 + (kind ? 0 : 768) + h_ * 128 + 8 * g; \
                _Pragma("unroll") for (int ks = 0; ks < 4; ++ks) a[mm][ks] = *(const bf16x8_t*)(arow + 32 * ks); } \
            _Pragma("unroll") for (int nt = 0; nt < 4; ++nt) { \
                const bf16* brow = QKVd + (size_t)(64 * n_ + 16 * nt + m16) * 2304 + 768 + h_ * 128 + 8 * g; \
                bf16x8_t bfr[4]; \
                _Pragma("unroll") for (int ks = 0; ks < 4; ++ks) bfr[ks] = *(const bf16x8_t*)(brow + 32 * ks); \
                _Pragma("unroll") for (int mm = 0; mm < 4; ++mm) { f32x4 acc = {0.f, 0.f, 0.f, 0.f}; \
                    _Pragma("unroll") for (int ks = 0; ks < 4; ++ks) acc = MFMA16(a[mm][ks], bfr[ks], acc); \
                    _Pragma("unroll") for (int rg = 0; rg < 4; ++rg) GR[kind * 64 * 65 + (16 * mm + 4 * g + rg) * 65 + 16 * nt + m16] = acc[rg]; } } } \
        {     \
            const int d = hw - 2, tok = 64 * n_ + (d ? 63 - lane : lane); \
            float gv = GB[(size_t)(d * 6 + h_) * S_ + tok]; const float be = GB[(size_t)(12 + d * 6 + h_) * S_ + tok]; \
            _Pragma("unroll") for (int o = 1; o < 64; o <<= 1) { const float t = __shfl_up(gv, o); if (lane >= o) gv += t; } \
            const float gl = __shfl(gv, 63); \
            Gs[d * 64 + lane] = gv; Bs[d * 64 + lane] = be; \
            float* vec = VEC + (size_t)(u_ * 2 + d) * 256; \
            vec[lane] = __expf(gv); vec[64 + lane] = be; vec[128 + lane] = __expf(gl - gv); vec[192 + lane] = __expf(gl); } } while (0)
    if (BID < 768 && hw >= 2) DN_GRAM_CUMSUM(2 * BID + half);
    for (int up = BID; up < 768; up += GSZ) {
        const int u = 2 * up + half;
        __syncthreads();
        {
            const int d = tl >> 7, i = (tl & 127) >> 1, jh = tl & 1, ii = d ? 63 - i : i;
            const float Gi = Gs[d * 64 + i], bi = Bs[d * 64 + i];
#pragma unroll
            for (int jb = 0; jb < 2; ++jb) {
                unsigned pk[8];
#pragma unroll
                for (int jj = 0; jj < 16; jj += 2) {
                    float at[2];
#pragma unroll
                    for (int e = 0; e < 2; ++e) {
                        const int j = 32 * jh + 16 * jb + jj + e, jx = d ? 63 - j : j;
                        const float dec = (j <= i) ? __expf(Gi - Gs[d * 64 + j]) : 0.f;
                        const float kk = GR[ii * 65 + jx], qk = GR[64 * 65 + ii * 65 + jx];
                        Ms[d * 64 * 68 + i * 68 + j] = (j < i) ? bi * kk * dec : 0.f;
                        at[e] = (j <= i) ? qk * dec : 0.f;
                    }
                    pk[jj >> 1] = pk2(at[0], at[1]);
                }
                v4u* dst = (v4u*)(ATTN + ((size_t)(u * 2 + d) * 64 + i) * 64 + 32 * jh + 16 * jb);
                v4u o0; o0.x = pk[0]; o0.y = pk[1]; o0.z = pk[2]; o0.w = pk[3]; v4u o1; o1.x = pk[4]; o1.y = pk[5]; o1.z = pk[6]; o1.w = pk[7];
                dst[0] = o0; dst[1] = o1;
            }
        }
        __syncthreads();
        if (hw >= 2) { if (up + GSZ < 768) DN_GRAM_CUMSUM(2 * (up + GSZ) + half); }
        else {
            const int d = hw, c = lane; const float* Md = Ms + d * 64 * 68;
            float x[64];
            x[0] = (c == 0) ? 1.f : 0.f;
#pragma unroll
            for (int i = 1; i < 64; ++i) {
                f32x4 mr[16];
#pragma unroll
                for (int j0 = 0; j0 < i; j0 += 4) mr[j0 >> 2] = *(const f32x4*)(Md + i * 68 + j0);
                float s0 = (i == c) ? 1.f : 0.f, s1 = 0.f, s2 = 0.f, s3 = 0.f;
#pragma unroll
                for (int j0 = 0; j0 < i; j0 += 4) { const f32x4 mv = mr[j0 >> 2];
                    s0 -= mv.x * x[j0]; if (j0 + 1 < i) s1 -= mv.y * x[j0 + 1]; if (j0 + 2 < i) s2 -= mv.z * x[j0 + 2]; if (j0 + 3 < i) s3 -= mv.w * x[j0 + 3]; }
                x[i] = (s0 + s1) + (s2 + s3);
            }
            bf16* outp = TINV + (size_t)(u * 2 + d) * 4096 + c;
#pragma unroll
            for (int i = 0; i < 64; ++i) outp[i * 64] = (bf16)f2bf(x[i]);
        }
    }
}

__device__ __forceinline__ int sw256(int row, int chunk) { return row * 256 + 16 * (chunk ^ (row & 15)); }
__device__ __forceinline__ int sw128(int row, int chunk) { return row * 128 + 16 * (chunk ^ (row & 7)); }
constexpr int SC_NC = 2;
constexpr int SC_KT = 0, SC_QT = 16384, SC_TI = 32768, SC_AT = 40960, SC_VT = 49152, SC_VC = SC_VT + 4096, SC_BUF = SC_VC + 1024;
constexpr int SC_ST = 2 * SC_BUF, SC_RT = SC_ST + 16 * SC_NC * 256, SC_VNT = SC_RT + 16 * SC_NC * 128, SC_VST = SC_VNT + 16 * SC_NC * 128, SC_END = SC_VST + 16 * SC_NC * 128;
constexpr int SC_OT = SC_END + 16;
static_assert(SC_OT + 2 * 64 * 80 <= 146432, "scan LDS (+ a 16-byte dump slot at SC_END, + the o tile)");
constexpr size_t SCS_MAT = 128 * 128;
__device__ __forceinline__ float* scs_B(float* base, int p, int j) { return base + (size_t)(p * 3 + j) * SCS_MAT; }
__device__ __forceinline__ float* scs_A(float* base, int p, int j) { return base + (size_t)(36 + p * 2 + (j - 1)) * SCS_MAT; }
#if defined(SCT) && SCT == 2
#define SC_DMA_ON(s) ((s) < s_beg + 1)
#else
#define SC_DMA_ON(s) true
#endif
#if defined(SCT) && SCT == 3
#define SC_SKIP2 true
#else
#define SC_SKIP2 false
#endif
#if defined(SCT) && SCT >= 2
#define SC_NOST true
#else
#define SC_NOST false
#endif
#define SCT_ACC ((float*)((unsigned char*)SCS - (WS_W + W_FFIN0) + WS_CTL + 524288))
template <int PASS>
__device__ __forceinline__ void scan_task(int vb, const bf16* QKVd, const bf16* TINV, const bf16* ATTN, const float* VEC, bf16* ODIR0, bf16* ODIR1, float* SCS, LAS unsigned char* lds, int wv) {
    const int xl = vb & 7, slot = vb >> 3;
    int p, j, cs; bool has_out, v_zero;
    if (PASS == 1) {
        if (slot < 24) { const int grp = xl * 3 + (slot >> 3), within = slot & 7; p = grp >> 1; j = 1 + (grp & 1); v_zero = (within >> 2) != 0; cs = within & 3; has_out = false; }
        else { const int s4 = slot - 24; int gi; if (xl < 4) gi = xl * 2 + (s4 >> 2); else { if (s4 >= 4) return; gi = 8 + (xl - 4); } p = gi; j = 0; cs = s4 & 3; has_out = false; v_zero = false; }
    } else {
        if (slot >= 24) return; const int v = xl * 24 + slot;
        const int grp = v >> 2; p = grp >> 2; j = grp & 3; cs = v & 3; has_out = true; v_zero = false;
    }
    const int d = p / 6, h = p % 6;
    int tid_ = wv * 64 + lane_id_(); asm volatile("" : "+v"(tid_));
    const int tid = tid_, lane = tid & 63, g = lane >> 4, m16 = lane & 15;
    bf16* ODIR = d ? ODIR1 : ODIR0;
    const int hw = wv - 2;
    unsigned voff[9];
#pragma unroll
    for (int k_ = 0; k_ < 9; ++k_) { const int pc = hw + 6 * k_; unsigned v_ = 0;
        if (pc < 32) { const int q_ = pc & 15, row_ = 4 * q_ + (lane >> 4), ch_ = (lane & 15) ^ (row_ & 15); v_ = (unsigned)((d ? 63 - row_ : row_) * 4608 + ((pc < 16 ? 768 : 0) + h * 128 + ch_ * 8) * 2); }
        else if (pc < 48) { const int t_ = pc & 7, row_ = 8 * t_ + (lane >> 3), ch_ = (lane & 7) ^ (row_ & 7); v_ = (unsigned)(row_ * 128 + ch_ * 16); }
        else if (pc < 52) { const int row_ = 16 * (pc - 48) + (lane >> 2), ch_ = lane & 3; v_ = (unsigned)((d ? 63 - row_ : row_) * 4608 + (1536 + h * 128 + cs * 32 + ch_ * 8) * 2); }
        else v_ = (unsigned)(lane * 16);
        voff[k_] = v_; }
    const unsigned char* gK = (const unsigned char*)QKVd; const unsigned char* gT = (const unsigned char*)TINV; const unsigned char* gA = (const unsigned char*)ATTN; const unsigned char* gV = (const unsigned char*)VEC;
    const unsigned lds0 = (unsigned)(size_t)lds;
#define SC_GLDS(gsrc, ldst) do { unsigned keep_; asm volatile("s_mov_b32 %0, m0\n\ts_mov_b32 m0, %2\n\ts_nop 0\n\tglobal_load_lds_dwordx4 %1, off\n\ts_mov_b32 m0, %0" : "=&s"(keep_) : "v"(gsrc), "s"(ldst) : "memory"); } while (0)
#define SC_DMA(step, bufsel) do { if (wv >= 2) { const int n_ = d ? 255 - (step) : (step); const size_t cb_ = (size_t)((n_ * 6 + h) * 2 + d); \
        const unsigned char* bK_ = gK + (size_t)n_ * 294912; const unsigned char* bT_ = gT + cb_ * 8192; const unsigned char* bA_ = gA + cb_ * 8192; const unsigned char* bV_ = gV + cb_ * 1024; \
        const unsigned lb_ = lds0 + (bufsel) * SC_BUF; \
        int hw_ = hw; asm volatile("" : "+s"(hw_));        \
        _Pragma("unroll") for (int k_ = 0; k_ < 9; ++k_) { const int pc = hw_ + 6 * k_; const unsigned vo_ = voff[k_]; \
            if (pc < 16) SC_GLDS(bK_ + vo_, (unsigned)__builtin_amdgcn_readfirstlane((int)(lb_ + SC_KT + 1024 * pc))); \
            else if (pc < 32) { if (has_out) SC_GLDS(bK_ + vo_, (unsigned)__builtin_amdgcn_readfirstlane((int)(lb_ + SC_QT + 1024 * (pc - 16)))); } \
            else if (pc < 40) SC_GLDS(bT_ + vo_, (unsigned)__builtin_amdgcn_readfirstlane((int)(lb_ + SC_TI + 1024 * (pc - 32)))); \
            else if (pc < 48) { if (has_out) SC_GLDS(bA_ + vo_, (unsigned)__builtin_amdgcn_readfirstlane((int)(lb_ + SC_AT + 1024 * (pc - 40)))); } \
            else if (pc < 52) { if (!v_zero) SC_GLDS(bK_ + vo_, (unsigned)__builtin_amdgcn_readfirstlane((int)(lb_ + SC_VT + 1024 * (pc - 48)))); } \
            else if (pc == 52) SC_GLDS(bV_ + vo_, (unsigned)__builtin_amdgcn_readfirstlane((int)(lb_ + SC_VC))); } } } while (0)
#define SC_BAR() do { asm volatile("s_waitcnt lgkmcnt(0)" ::: "memory"); __builtin_amdgcn_s_barrier(); asm volatile("" ::: "memory"); } while (0)
#define SC_DRAIN() asm volatile("s_waitcnt vmcnt(0)" ::: "memory")
#define SC_OSTORE(stepo) SC_OSTORE_T(stepo, tid)
#define SC_OSTORE_T(stepo, TIDV) do { if (has_out && wv >= 4 && !SC_NOST) { const int no_ = d ? 255 - (stepo) : (stepo); const int tl_ = (TIDV) - 256, row_ = tl_ >> 2, ch_ = tl_ & 3; \
        const v4u ov_ = *(const LAS v4u*)(lds + SC_OT + ((stepo) & 1) * 5120 + row_ * 80 + ch_ * 16); const int tok_ = 64 * no_ + (d ? 63 - row_ : row_); \
        *(v4u*)(ODIR + (size_t)tok_ * 768 + h * 128 + cs * 32 + ch_ * 8) = ov_; } } while (0)
#define SC_PACK(t0, t1) __builtin_bit_cast(bf16x8_t, (v4u){pk2((t0)[0], (t0)[1]), pk2((t0)[2], (t0)[3]), pk2((t1)[0], (t1)[1]), pk2((t1)[2], (t1)[3])})
#define SC_MROW(rt) (32 * ((rt) >> 1) + 8 * (m16 >> 2) + 4 * ((rt) & 1) + (m16 & 3))
#define SC_GROW(rt) (32 * ((rt) >> 1) + 8 * g + 4 * ((rt) & 1))
#define SC_A256(base, rt, ks) (*(const LAS bf16x8_t*)((base) + sw256(SC_MROW(rt), 4 * (ks) + g)))
#define SC_A128(base, rt, ks) (*(const LAS bf16x8_t*)((base) + sw128(SC_MROW(rt), 4 * (ks) + g)))
#define SC_KTF(kt, ks) ({ const int tr0_ = 32 * (ks) + 8 * g + (m16 >> 2), tc_ = 4 * ((kt) >> 1) + (m16 & 3), tsub_ = 8 * ((kt) & 1); \
        const s16x4_t lo_ = __builtin_amdgcn_ds_read_tr16_b64_v4i16((LAS s16x4_t*)(B + SC_KT + sw256(tr0_, tc_) + tsub_)); \
        const s16x4_t hi_ = __builtin_amdgcn_ds_read_tr16_b64_v4i16((LAS s16x4_t*)(B + SC_KT + sw256(tr0_ + 4, tc_) + tsub_)); \
        (bf16x8_t){lo_[0], lo_[1], lo_[2], lo_[3], hi_[0], hi_[1], hi_[2], hi_[3]}; })
#define SC_STEP(s) do { const int s_ = (s); const int cur = s_ & 1; \
        LAS unsigned char* B = lds + cur * SC_BUF; \
        if (wv >= 2) { \
            if (s_ + 1 < s_end && SC_DMA_ON(s_)) SC_DMA(s_ + 1, cur ^ 1); \
            if (s_ > s_beg) SC_OSTORE(s_ - 1); \
            SC_DRAIN(); \
        } else { \
              \
            const LAS float* VC = (const LAS float*)(B + SC_VC); \
            bf16x8_t sbf[4]; \
            _Pragma("unroll") for (int ks = 0; ks < 4; ++ks) sbf[ks] = SC_PACK(Sreg[2 * ks], Sreg[2 * ks + 1]); \
            bf16x8_t fa[16]; f32x4 eG4[4], be4[4]; s16x4_t vt[4]; \
            _Pragma("unroll") for (int rt = 0; rt < 4; ++rt) _Pragma("unroll") for (int ks = 0; ks < 4; ++ks) fa[4 * rt + ks] = SC_A256(B + SC_KT, rt, ks); \
            __builtin_amdgcn_sched_barrier(0); \
            f32x4 acck[4], accq[4]; \
            _Pragma("unroll") for (int rt = 0; rt < 4; ++rt) { acck[rt] = (f32x4){0.f, 0.f, 0.f, 0.f}; accq[rt] = acck[rt]; } \
            _Pragma("unroll") for (int ks = 0; ks < 4; ++ks) _Pragma("unroll") for (int rt = 0; rt < 4; ++rt) acck[rt] = MFMA16(fa[4 * rt + ks], sbf[ks], acck[rt]); \
            __builtin_amdgcn_sched_barrier(0); \
            bf16x8_t fq[16], ft[6]; \
            _Pragma("unroll") for (int rt = 0; rt < 4; ++rt) { eG4[rt] = *(const LAS f32x4*)(VC + SC_GROW(rt)); be4[rt] = *(const LAS f32x4*)(VC + 64 + SC_GROW(rt)); \
                vt[rt] = (s16x4_t){0, 0, 0, 0}; \
                if (!v_zero) vt[rt] = __builtin_amdgcn_ds_read_tr16_b64_v4i16((LAS s16x4_t*)(B + SC_VT + (SC_GROW(rt) + (m16 >> 2)) * 64 + (16 * wv + 4 * (m16 & 3)) * 2)); } \
            if (has_out) { _Pragma("unroll") for (int rt = 0; rt < 2; ++rt) _Pragma("unroll") for (int ks = 0; ks < 4; ++ks) fq[4 * rt + ks] = SC_A256(B + SC_QT, rt, ks); } \
            _Pragma("unroll") for (int rt = 0; rt < 4; ++rt) ft[rt] = SC_A128(B + SC_TI, rt, 0); \
            ft[4] = SC_A128(B + SC_TI, 2, 1); ft[5] = SC_A128(B + SC_TI, 3, 1); \
            __builtin_amdgcn_sched_barrier(0); \
            f32x4 rr[4]; \
            _Pragma("unroll") for (int rt = 0; rt < 4; ++rt) _Pragma("unroll") for (int rg = 0; rg < 4; ++rg) rr[rt][rg] = be4[rt][rg] * (bf2f((unsigned short)vt[rt][rg]) - eG4[rt][rg] * acck[rt][rg]); \
            const bf16x8_t rb0 = SC_PACK(rr[0], rr[1]), rb1 = SC_PACK(rr[2], rr[3]); \
            if (has_out) { _Pragma("unroll") for (int ks = 0; ks < 4; ++ks) _Pragma("unroll") for (int rt = 0; rt < 2; ++rt) accq[rt] = MFMA16(fq[4 * rt + ks], sbf[ks], accq[rt]); } \
            __builtin_amdgcn_sched_barrier(0); \
            if (has_out) { _Pragma("unroll") for (int rt = 2; rt < 4; ++rt) _Pragma("unroll") for (int ks = 0; ks < 4; ++ks) fq[4 * rt + ks] = SC_A256(B + SC_QT, rt, ks); } \
            __builtin_amdgcn_sched_barrier(0); \
            f32x4 vn[4]; \
            _Pragma("unroll") for (int rt = 0; rt < 4; ++rt) vn[rt] = MFMA16(ft[rt], rb0, ((f32x4){0.f, 0.f, 0.f, 0.f})); \
            vn[2] = MFMA16(ft[4], rb1, vn[2]); vn[3] = MFMA16(ft[5], rb1, vn[3]); \
            if (has_out) { _Pragma("unroll") for (int ks = 0; ks < 4; ++ks) _Pragma("unroll") for (int rt = 2; rt < 4; ++rt) accq[rt] = MFMA16(fq[4 * rt + ks], sbf[ks], accq[rt]); } \
            __builtin_amdgcn_sched_barrier(0); \
            bf16x8_t fat[6], fk[16]; f32x4 eL4[4]; \
            if (has_out) { _Pragma("unroll") for (int rt = 0; rt < 4; ++rt) fat[rt] = SC_A128(B + SC_AT, rt, 0); \
                fat[4] = SC_A128(B + SC_AT, 2, 1); fat[5] = SC_A128(B + SC_AT, 3, 1); } \
            _Pragma("unroll") for (int kt = 0; kt < 4; ++kt) _Pragma("unroll") for (int ks = 0; ks < 2; ++ks) fk[2 * kt + ks] = SC_KTF(kt, ks); \
            _Pragma("unroll") for (int rt = 0; rt < 4; ++rt) eL4[rt] = *(const LAS f32x4*)(VC + 128 + SC_GROW(rt)); \
            const float gl = VC[192]; \
            __builtin_amdgcn_sched_barrier(0); \
            if (has_out) { _Pragma("unroll") for (int rt = 0; rt < 4; ++rt) _Pragma("unroll") for (int rg = 0; rg < 4; ++rg) accq[rt][rg] *= eG4[rt][rg]; \
                const bf16x8_t nb0 = SC_PACK(vn[0], vn[1]), nb1 = SC_PACK(vn[2], vn[3]); \
                _Pragma("unroll") for (int rt = 0; rt < 4; ++rt) accq[rt] = MFMA16(fat[rt], nb0, accq[rt]); \
                accq[2] = MFMA16(fat[4], nb1, accq[2]); accq[3] = MFMA16(fat[5], nb1, accq[3]); } \
            _Pragma("unroll") for (int rt = 0; rt < 4; ++rt) _Pragma("unroll") for (int rg = 0; rg < 4; ++rg) vn[rt][rg] *= eL4[rt][rg]; \
            const bf16x8_t vb0 = SC_PACK(vn[0], vn[1]), vb1 = SC_PACK(vn[2], vn[3]); \
            __builtin_amdgcn_sched_barrier(0); \
            _Pragma("unroll") for (int kt = 4; kt < 8; ++kt) _Pragma("unroll") for (int ks = 0; ks < 2; ++ks) fk[2 * kt + ks] = SC_KTF(kt, ks); \
            __builtin_amdgcn_sched_barrier(0); \
            f32x4 acc3[8]; \
            _Pragma("unroll") for (int kt = 0; kt < 4; ++kt) acc3[kt] = MFMA16(fk[2 * kt], vb0, ((f32x4){0.f, 0.f, 0.f, 0.f})); \
            _Pragma("unroll") for (int kt = 0; kt < 4; ++kt) acc3[kt] = MFMA16(fk[2 * kt + 1], vb1, acc3[kt]); \
            if (has_out) { _Pragma("unroll") for (int rt = 0; rt < 4; ++rt) _Pragma("unroll") for (int rg = 0; rg < 4; ++rg) \
                *(LAS unsigned short*)(lds + SC_OT + cur * 5120 + (SC_GROW(rt) + rg) * 80 + (16 * wv + m16) * 2) = (unsigned short)f2bf(accq[rt][rg]); } \
            _Pragma("unroll") for (int kt = 0; kt < 4; ++kt) _Pragma("unroll") for (int rg = 0; rg < 4; ++rg) Sreg[kt][rg] = gl * Sreg[kt][rg] + acc3[kt][rg]; \
            _Pragma("unroll") for (int kt = 4; kt < 8; ++kt) acc3[kt] = MFMA16(fk[2 * kt], vb0, ((f32x4){0.f, 0.f, 0.f, 0.f})); \
            _Pragma("unroll") for (int kt = 4; kt < 8; ++kt) acc3[kt] = MFMA16(fk[2 * kt + 1], vb1, acc3[kt]); \
            _Pragma("unroll") for (int kt = 4; kt < 8; ++kt) _Pragma("unroll") for (int rg = 0; rg < 4; ++rg) Sreg[kt][rg] = gl * Sreg[kt][rg] + acc3[kt][rg]; \
        } \
        SC_BAR(); } while (0)
    const int s_beg = 64 * j, s_end = s_beg + 64;
    SC_DMA(s_beg, s_beg & 1);
    f32x4 Sreg[8];
#pragma unroll
    for (int kt = 0; kt < 8; ++kt) Sreg[kt] = (f32x4){0.f, 0.f, 0.f, 0.f};
    const int scol = 16 * (wv & 1) + m16;
    if (PASS == 1) {
        if (v_zero) {
#pragma unroll
            for (int kt = 0; kt < 8; ++kt)
#pragma unroll
                for (int rg = 0; rg < 4; ++rg) Sreg[kt][rg] = (SC_GROW(kt) + rg == 32 * cs + scol) ? 1.f : 0.f;
        }
    } else {
        LAS float* blk0 = (LAS float*)(lds + SC_ST); LAS float* blk1 = blk0 + 128 * 33;
        blk0 = (LAS float*)(lds + SC_BUF); blk1 = blk0 + 128 * 33;
        const int a = tid >> 2, cq = tid & 3;
        float accv[8];
        { const float* bp = scs_B(SCS, p, 0) + (size_t)a * 128 + 32 * cs + 8 * cq; const f32x4 x0 = *(const f32x4*)bp, x1 = *(const f32x4*)(bp + 4);
          accv[0] = x0.x; accv[1] = x0.y; accv[2] = x0.z; accv[3] = x0.w; accv[4] = x1.x; accv[5] = x1.y; accv[6] = x1.z; accv[7] = x1.w; }
        if (j == 0) {
#pragma unroll
            for (int e = 0; e < 8; ++e) accv[e] = 0.f; }
#pragma unroll 1
        for (int jj = 1; jj < j; ++jj) {
            LAS float* src = (jj & 1) ? blk0 : blk1;
#pragma unroll
            for (int e = 0; e < 8; ++e) src[a * 33 + 8 * cq + e] = accv[e];
            __syncthreads();
            { const float* bp = scs_B(SCS, p, jj) + (size_t)a * 128 + 32 * cs + 8 * cq; const f32x4 x0 = *(const f32x4*)bp, x1 = *(const f32x4*)(bp + 4);
              accv[0] = x0.x; accv[1] = x0.y; accv[2] = x0.z; accv[3] = x0.w; accv[4] = x1.x; accv[5] = x1.y; accv[6] = x1.z; accv[7] = x1.w; }
            const float* ar = scs_A(SCS, p, jj) + (size_t)a * 128;
#pragma unroll 4
            for (int b4 = 0; b4 < 128; b4 += 4) { const f32x4 av = *(const f32x4*)(ar + b4);
#pragma unroll
                for (int e = 0; e < 8; ++e) accv[e] += av.x * src[(b4 + 0) * 33 + 8 * cq + e] + av.y * src[(b4 + 1) * 33 + 8 * cq + e] + av.z * src[(b4 + 2) * 33 + 8 * cq + e] + av.w * src[(b4 + 3) * 33 + 8 * cq + e]; }
        }
        LAS float* fin = (j & 1) ? blk0 : blk1;
        __syncthreads();
#pragma unroll
        for (int e = 0; e < 8; ++e) fin[a * 33 + 8 * cq + e] = accv[e];
        __syncthreads();
#pragma unroll
        for (int kt = 0; kt < 8; ++kt)
#pragma unroll
            for (int rg = 0; rg < 4; ++rg) Sreg[kt][rg] = fin[(SC_GROW(kt) + rg) * 33 + scol];
        __syncthreads();
    }
    SC_DRAIN();
    __syncthreads();
#if defined(SCT) && SCT != 0
    const unsigned long long tq0_ = __builtin_amdgcn_s_memtime();
#endif
#pragma unroll 1
    for (int s2 = s_beg; s2 < s_end; ++s2) SC_STEP(s2);
#if defined(SCT) && SCT != 0
    if (PASS == 2 && tid == 0) { const unsigned long long tq1_ = __builtin_amdgcn_s_memtime(); atomicAdd(SCT_ACC, (float)(tq1_ - tq0_) * (1.f / (64.f * 384.f))); }
#endif
    { int tid2_ = tid; asm volatile("" : "+v"(tid2_)); SC_OSTORE_T(s_end - 1, tid2_); }
    if (PASS == 1) {
        float* dst = (v_zero ? scs_A(SCS, p, j) : scs_B(SCS, p, j));
        if (j < 3 && !SC_NOST) {
            if (wv < 2) {
#pragma unroll
                for (int kt = 0; kt < 8; ++kt)
#pragma unroll
                    for (int rg = 0; rg < 4; ++rg) dst[(size_t)(SC_GROW(kt) + rg) * 128 + 32 * cs + scol] = Sreg[kt][rg];
            }
        }
    }
    asm volatile("s_waitcnt vmcnt(0)" ::: "memory");
#undef SC_STEP
#undef SC_OSTORE
#undef SC_OSTORE_T
#undef SC_DRAIN
#undef SC_BAR
#undef SC_DMA
#undef SC_PACK
#undef SC_MROW
#undef SC_GROW
#undef SC_KTF
#undef SC_A256
#undef SC_A128
#undef SC_GLDS
}
template <int PASS>
__device__ __forceinline__ void ph_dn_scan(const bf16* QKVd, const bf16* TINV, const bf16* ATTN, const float* VEC, bf16* ODIR0, bf16* ODIR1, float* SCS, LAS unsigned char* lds, int wv) {
#pragma unroll 1
    for (int vb = BID; vb < 256; vb += GSZ) {
        scan_task<PASS>(vb, QKVd, TINV, ATTN, VEC, ODIR0, ODIR1, SCS, lds, wv);
        __syncthreads();
    }
}
constexpr int AT_PITCH = 144, AT_K = 0, AT_V = 192 * AT_PITCH, AT_GRP = 2 * 192 * AT_PITCH;
__device__ __forceinline__ void ph_attn(const bf16* PA, const float* rope, bf16* OG, float* LSE, LAS unsigned char* lds, int wv) {
    int tid_ = wv * 64 + lane_id_(); asm volatile("" : "+v"(tid_));
    const int tid = tid_, lane = tid & 63, g = lane >> 4, m16 = lane & 15, grp = wv >> 2, wq = wv & 3, tg = tid & 255;
    LAS unsigned char* Kl = lds + grp * AT_GRP + AT_K; LAS unsigned char* Vl = lds + grp * AT_GRP + AT_V;
#pragma unroll 1
    for (int pi = BID; pi < 1536; pi += GSZ) {
        const int u = 2 * pi + grp;
        const int hg = u & 3, w = (u >> 2) & 255, gi = u >> 10;
        const int dil = 1 << (2 * gi), L = S_ / dil, r = w & (dil - 1), nb = w >> (2 * gi), head = gi * 4 + hg;
#pragma unroll
        for (int k = 0; k < 3; ++k) {
            const int item = tg + 256 * k, row = item >> 2, c = item & 3, mm = nb * 64 - 64 + row;
            v4u o0 = {0u, 0u, 0u, 0u}, o1 = {0u, 0u, 0u, 0u};
            if (mm >= 0 && mm < L) {
                const int tok = mm * dil + r;
                const bf16* kp = PA + (size_t)tok * 2304 + 768 + head * 64 + 8 * c;
                const v4u x0 = *(const v4u*)kp, x1 = *(const v4u*)(kp + 32);
                const f32x4* cp = (const f32x4*)(rope + (size_t)tok * 32 + 8 * c); const f32x4* sp = (const f32x4*)(rope + (size_t)S_ * 32 + (size_t)tok * 32 + 8 * c);
                const f32x4 c0 = cp[0], c1 = cp[1], s0 = sp[0], s1 = sp[1];
                const float cs[8] = {c0.x, c0.y, c0.z, c0.w, c1.x, c1.y, c1.z, c1.w}, sn[8] = {s0.x, s0.y, s0.z, s0.w, s1.x, s1.y, s1.z, s1.w};
                const unsigned xa[4] = {x0.x, x0.y, x0.z, x0.w}, xb[4] = {x1.x, x1.y, x1.z, x1.w};
                unsigned ra[4], rb[4];
#pragma unroll
                for (int e = 0; e < 4; ++e) {
                    const float a0 = bflo(xa[e]), a1 = bfhi(xa[e]), b0 = bflo(xb[e]), b1 = bfhi(xb[e]);
                    ra[e] = pk2(a0 * cs[2 * e] - b0 * sn[2 * e], a1 * cs[2 * e + 1] - b1 * sn[2 * e + 1]);
                    rb[e] = pk2(b0 * cs[2 * e] + a0 * sn[2 * e], b1 * cs[2 * e + 1] + a1 * sn[2 * e + 1]);
                }
                o0.x = ra[0]; o0.y = ra[1]; o0.z = ra[2]; o0.w = ra[3]; o1.x = rb[0]; o1.y = rb[1]; o1.z = rb[2]; o1.w = rb[3];
            }
            *(LAS v4u*)(Kl + row * AT_PITCH + 16 * c) = o0; *(LAS v4u*)(Kl + row * AT_PITCH + 64 + 16 * c) = o1;
        }
#pragma unroll
        for (int k = 0; k < 6; ++k) {
            const int item = tg + 256 * k, row = item >> 3, c = item & 7, mm = nb * 64 - 64 + row;
            v4u o = {0u, 0u, 0u, 0u};
            if (mm >= 0 && mm < L) o = *(const v4u*)(PA + (size_t)(mm * dil + r) * 2304 + 1536 + head * 64 + 8 * c);
            *(LAS v4u*)(Vl + row * AT_PITCH + 16 * c) = o;
        }
        bf16x8_t bq0, bq1;
        const int qi = 16 * wq + m16, qtok = (nb * 64 + qi) * dil + r;
        {
            const bf16* qp = PA + (size_t)qtok * 2304 + head * 64 + 8 * g;
            const v4u x0 = *(const v4u*)qp, x1 = *(const v4u*)(qp + 32);
            const f32x4* cp = (const f32x4*)(rope + (size_t)qtok * 32 + 8 * g); const f32x4* sp = (const f32x4*)(rope + (size_t)S_ * 32 + (size_t)qtok * 32 + 8 * g);
            const f32x4 c0 = cp[0], c1 = cp[1], s0 = sp[0], s1 = sp[1];
            const float cs[8] = {c0.x, c0.y, c0.z, c0.w, c1.x, c1.y, c1.z, c1.w}, sn[8] = {s0.x, s0.y, s0.z, s0.w, s1.x, s1.y, s1.z, s1.w};
            const unsigned xa[4] = {x0.x, x0.y, x0.z, x0.w}, xb[4] = {x1.x, x1.y, x1.z, x1.w};
            v4u ra, rb; unsigned* rap = (unsigned*)&ra; unsigned* rbp = (unsigned*)&rb; (void)rap; (void)rbp;
            unsigned ta[4], tb[4];
#pragma unroll
            for (int e = 0; e < 4; ++e) {
                const float a0 = bflo(xa[e]), a1 = bfhi(xa[e]), b0 = bflo(xb[e]), b1 = bfhi(xb[e]);
                ta[e] = pk2(0.125f * (a0 * cs[2 * e] - b0 * sn[2 * e]), 0.125f * (a1 * cs[2 * e + 1] - b1 * sn[2 * e + 1]));
                tb[e] = pk2(0.125f * (b0 * cs[2 * e] + a0 * sn[2 * e]), 0.125f * (b1 * cs[2 * e + 1] + a1 * sn[2 * e + 1]));
            }
            ra.x = ta[0]; ra.y = ta[1]; ra.z = ta[2]; ra.w = ta[3]; rb.x = tb[0]; rb.y = tb[1]; rb.z = tb[2]; rb.w = tb[3];
            bq0 = __builtin_bit_cast(bf16x8_t, ra); bq1 = __builtin_bit_cast(bf16x8_t, rb);
        }
        __syncthreads();
        f32x4 st[12];
#pragma unroll
        for (int kt = 0; kt < 12; ++kt) {
            const LAS unsigned char* ap = Kl + (16 * kt + m16) * AT_PITCH + 16 * g;
            f32x4 z = {0.f, 0.f, 0.f, 0.f};
            z = MFMA16(*(const LAS bf16x8_t*)ap, bq0, z);
            st[kt] = MFMA16(*(const LAS bf16x8_t*)(ap + 64), bq1, z);
        }
        float mx = -1e30f;
#pragma unroll
        for (int kt = 0; kt < 12; ++kt)
#pragma unroll
            for (int rg = 0; rg < 4; ++rg) { const int j = 16 * kt + 4 * g + rg, dj = j - qi, mm = nb * 64 - 64 + j;
                const bool ok = (dj >= 0) && (dj <= 128) && (mm >= 0) && (mm < L);
                st[kt][rg] = ok ? st[kt][rg] : -1e30f; mx = fmaxf(mx, st[kt][rg]); }
        mx = fmaxf(mx, __shfl_xor(mx, 16)); mx = fmaxf(mx, __shfl_xor(mx, 32));
        float sum = 0.f;
#pragma unroll
        for (int kt = 0; kt < 12; ++kt)
#pragma unroll
            for (int rg = 0; rg < 4; ++rg) { const float p = __expf(st[kt][rg] - mx); st[kt][rg] = p; sum += p; }
        sum += __shfl_xor(sum, 16); sum += __shfl_xor(sum, 32);
        f32x4 o[4];
#pragma unroll
        for (int dt = 0; dt < 4; ++dt) o[dt] = (f32x4){0.f, 0.f, 0.f, 0.f};
#pragma unroll
        for (int kk = 0; kk < 6; ++kk) {
            v4u pb; pb.x = pk2(st[2 * kk][0], st[2 * kk][1]); pb.y = pk2(st[2 * kk][2], st[2 * kk][3]); pb.z = pk2(st[2 * kk + 1][0], st[2 * kk + 1][1]); pb.w = pk2(st[2 * kk + 1][2], st[2 * kk + 1][3]);
            const bf16x8_t b = __builtin_bit_cast(bf16x8_t, pb);
#pragma unroll
            for (int dt = 0; dt < 4; ++dt) {
                const LAS unsigned char* tp = Vl + (32 * kk + 4 * g + (m16 >> 2)) * AT_PITCH + (16 * dt + 4 * (m16 & 3)) * 2;
                const s16x4_t lo = __builtin_amdgcn_ds_read_tr16_b64_v4i16((LAS s16x4_t*)tp);
                const s16x4_t hi = __builtin_amdgcn_ds_read_tr16_b64_v4i16((LAS s16x4_t*)(tp + 16 * AT_PITCH));
                const bf16x8_t a = {lo[0], lo[1], lo[2], lo[3], hi[0], hi[1], hi[2], hi[3]};
                o[dt] = MFMA16(a, b, o[dt]);
            }
        }
        const float il = 1.0f / sum;
        bf16* op = OG + ((size_t)gi * S_ + qtok) * 256 + hg * 64 + 4 * g;
#pragma unroll
        for (int dt = 0; dt < 4; ++dt) { v2u wv2; wv2.x = pk2(o[dt][0] * il, o[dt][1] * il); wv2.y = pk2(o[dt][2] * il, o[dt][3] * il); *(v2u*)(op + 16 * dt) = wv2; }
        if (g == 0) LSE[((size_t)gi * S_ + qtok) * 4 + hg] = mx + logf(sum);
        __syncthreads();
    }
}
constexpr int LDS_RING = 146432, LDS_CTL_OFF = LDS_RING, LDS_BYTES = 147456;
constexpr int CW_BAR = 4096;
#ifndef PROBE_ID
#define PROBE_ID (-1)
#endif
__device__ __forceinline__ unsigned char* wsp() { return PWS; }
template <class Epi> __device__ __forceinline__ void run_gemm(LAS unsigned char* lds, const bf16* A, const bf16* Bt, int N, int K, const Epi& E, int wv) {
    pg8::Gemm g{A, Bt, S_, N, K, 0};
    pg8::StaticOrder S; S.init(S_, N, GSZ, BID);
    pg8::gemm_phase<Epi, pg8::StaticOrder, true, true>(lds, g, S, E, wv);
}
#define GRID_BAR() do { XcdBarrier b_; b_.bar = (unsigned*)(wsp() + WS_CTL) + CW_BAR; b_.st = (volatile LAS unsigned*)(lds + LDS_CTL_OFF + 320) + 8; b_.x = b_.st[2]; xcd_barrier(b_, wv); } while (0)
#define PHASE(id, ...) do { { constexpr int PROBE_REP = 0; __VA_ARGS__ } if (PROBE_ID == (id)) { GRID_BAR(); { constexpr int PROBE_REP = 1; __VA_ARGS__ } } } while (0)
#define WS_R_PTRS unsigned char* ws = wsp(); unsigned char* R = ws + WS_R; (void)R;

template <int l, int f> __device__ __forceinline__ void ffn_block(LAS unsigned char* lds, unsigned char* lds_raw, int wv) {
    constexpr int s = f * 2;
    PHASE(1, WS_R_PTRS
        pg8::EpiSwiglu E; E.O = (bf16*)(R + R_ACT); E.ldc = FF_; E.pad_ = 0; run_gemm(lds, (const bf16*)(ws + WS_H), (const bf16*)(ws + WS_W + (f ? W_FFIN1 : W_FFIN0)), 2 * FF_, 1024, E, wv); );
    GRID_BAR();
    PHASE(2, WS_R_PTRS
        pg8::EpiBf16P E; E.O = (bf16*)(R + R_Y); E.ldc = 1024; E.pad_ = 0; run_gemm(lds, (const bf16*)(R + R_ACT), (const bf16*)(ws + WS_W + (f ? W_FFOUT1 : W_FFOUT0)), 1024, FF_, E, wv); );
    GRID_BAR();
    {   WS_R_PTRS const float* MOD = (const float*)(ws + WS_MOD); const float* mod = MOD + l * 9216;
        RowArgs a; a.xi32 = (l == 0 && f == 0) ? PIN(0) : nullptr; a.xib = (const bf16*)POUT; a.y = (const bf16*)(R + R_Y); a.xo32 = (l == 1 && f == 1) ? POUT : nullptr; a.xob = (bf16*)POUT; a.wpost = PIN(6) + (l * 3 + s) * 1024; a.gate = mod + (s * 3 + 2) * 1024; a.coef = 0.5f;
        if (f == 0) { a.h = (bf16*)(ws + WS_H); a.wpre = PIN(5) + (l * 3 + 1) * 1024; a.shift = mod + (1 * 3 + 0) * 1024; a.scale = mod + (1 * 3 + 1) * 1024; }
        else if (l == 0) { a.h = (bf16*)(ws + WS_H); a.wpre = PIN(5) + (1 * 3 + 0) * 1024; a.shift = MOD + 9216; a.scale = MOD + 9216 + 1024; }
        else { a.h = nullptr; a.wpre = nullptr; a.shift = nullptr; a.scale = nullptr; }
        ph_rows(a, wv);
        if (f == 1 && l == 0) ph_convert(1, lds_raw, wv); }
    GRID_BAR();
}
template <int l> __device__ __forceinline__ void mixer_block(LAS unsigned char* lds, unsigned char* lds_raw, int wv) {
    PHASE(3, WS_R_PTRS
        pg8::EpiInProj E; E.PA = (bf16*)(R + R_PA); E.PD = (bf16*)(R + R_PD); E.PZ = (bf16*)(R + R_PZ); E.AB = (float*)(R + R_AB);
        run_gemm(lds, (const bf16*)(ws + WS_H), (const bf16*)(ws + WS_W + W_IN), 5632, 1024, E, wv); );
    GRID_BAR();
    PHASE(4, WS_R_PTRS
        ph_attn((const bf16*)(R + R_PA), (const float*)(ws + WS_ROPE), (bf16*)(R + R_OG), (float*)(R + R_LSE), lds, wv); );
    GRID_BAR();
    PHASE(5, WS_R_PTRS
        ph_dnprep((const bf16*)(R + R_PD), (const float*)(R + R_AB), PIN(10) + (size_t)l * 5 * 2304, PIN(11) + l * 12, PIN(12) + l * 12, (bf16*)(R + R_QKVD), (float*)(R + R_GB),
                  (const bf16*)(R + R_OG), (const float*)(R + R_LSE), (bf16*)(R + R_OATT), wv); );
    GRID_BAR();
    PHASE(6, WS_R_PTRS
        ph_dn_pre((const bf16*)(R + R_QKVD), (const float*)(R + R_GB), (bf16*)(R + R_TINV), (bf16*)(R + R_ATTN), (float*)(R + R_VEC), lds_raw, wv); );
    GRID_BAR();
    PHASE(7, WS_R_PTRS
        ph_dn_scan<1>((const bf16*)(R + R_QKVD), (const bf16*)(R + R_TINV), (const bf16*)(R + R_ATTN), (const float*)(R + R_VEC), (bf16*)(R + R_ODIR0), (bf16*)(R + R_ODIR1), (float*)(ws + WS_W + W_FFIN0), lds, wv); );
    GRID_BAR();
    PHASE(13, WS_R_PTRS
        ph_dn_scan<2>((const bf16*)(R + R_QKVD), (const bf16*)(R + R_TINV), (const bf16*)(R + R_ATTN), (const float*)(R + R_VEC), (bf16*)(R + R_ODIR0), (bf16*)(R + R_ODIR1), (float*)(ws + WS_W + W_FFIN0), lds, wv); );
    GRID_BAR();
    PHASE(8, WS_R_PTRS
        pg8::EpiBf16P E; E.O = (bf16*)(R + R_PG); E.ldc = 2048; E.pad_ = 0;
        run_gemm(lds, (const bf16*)(ws + WS_H), (const bf16*)(ws + WS_W + W_IN) + (size_t)5632 * 1024, 2048, 1024, E, wv); );
    PHASE(9, WS_R_PTRS
        ph_final((const bf16*)(R + R_ODIR0), (const bf16*)(R + R_ODIR1), (const bf16*)(R + R_PZ), PIN(13) + l * 128, (bf16*)(R + R_ODN), wv); );
    GRID_BAR();
    PHASE(10, { WS_R_PTRS
        pg8::EpiGateF32 E; E.O = (bf16*)(R + R_T1); E.gate = (const bf16*)(R + R_PG); E.ldg = 2048; E.pad_ = 0;
        run_gemm(lds, (const bf16*)(R + R_OATT), (const bf16*)(ws + WS_W + W_BATT), 1024, 256, E, wv); }
        { WS_R_PTRS
        pg8::EpiGateAddBf16 E; E.O = (bf16*)(ws + WS_H); E.T1 = (const bf16*)(R + R_T1); E.gate = (const bf16*)(R + R_PG) + 1024; E.ldg = 2048; E.pad_ = 0;
        run_gemm(lds, (const bf16*)(R + R_ODN), (const bf16*)(ws + WS_W + W_BDN), 1024, 768, E, wv); } );
    GRID_BAR();
    PHASE(11, WS_R_PTRS
        pg8::EpiBf16P E; E.O = (bf16*)(R + R_Y2); E.ldc = 1024; E.pad_ = 0; run_gemm(lds, (const bf16*)(ws + WS_H), (const bf16*)(ws + WS_W + W_OUT), 1024, 1024, E, wv); );
    GRID_BAR();
    {   WS_R_PTRS const float* mod = (const float*)(ws + WS_MOD) + l * 9216;
        RowArgs a; a.xi32 = nullptr; a.xib = (const bf16*)POUT; a.y = (const bf16*)(R + R_Y2); a.xo32 = nullptr; a.xob = (bf16*)POUT; a.h = (bf16*)(ws + WS_H); a.wpost = PIN(6) + (l * 3 + 1) * 1024; a.gate = mod + (1 * 3 + 2) * 1024; a.coef = 1.0f;
        a.wpre = PIN(5) + (l * 3 + 2) * 1024; a.shift = mod + (2 * 3 + 0) * 1024; a.scale = mod + (2 * 3 + 1) * 1024; ph_rows(a, wv); }
    GRID_BAR();
}
__global__ void __launch_bounds__(NTHREADS, 2) mega_fwd(Params P) {
    extern __shared__ __attribute__((aligned(16))) unsigned char lds_raw[];
    LAS unsigned char* lds = (LAS unsigned char*)lds_raw;
    const int wv = __builtin_amdgcn_readfirstlane((int)threadIdx.x >> 6);
    { const int tid0 = threadIdx.x;
      for (int u = tid0; u < (LDS_BYTES - LDS_CTL_OFF) / 4; u += NTHREADS) ((LAS unsigned*)(lds + LDS_CTL_OFF))[u] = 0u;
      __syncthreads();
      XcdBarrier b0 = xcd_barrier_post((unsigned*)(PWS + WS_CTL) + CW_BAR, (volatile LAS unsigned*)(lds + LDS_CTL_OFF + 320) + 8);
      if (tid0 == 0) ((volatile LAS unsigned*)(lds + LDS_CTL_OFF + 320))[10] = b0.x;
      __syncthreads(); }
    PHASE(0, ph_ada(lds_raw, wv); ph_rope(wv); ); PHASE(14, ph_convert(0, lds_raw, wv); );
    GRID_BAR();
    PHASE(12, WS_R_PTRS float* MOD = (float*)(ws + WS_MOD);
      RowArgs a; a.xi32 = PIN(0); a.xib = nullptr; a.y = nullptr; a.xo32 = nullptr; a.xob = nullptr; a.h = (bf16*)(ws + WS_H); a.wpost = nullptr; a.gate = nullptr; a.wpre = PIN(5); a.shift = MOD; a.scale = MOD + 1024; a.coef = 0.f; ph_rows(a, wv); );
    GRID_BAR();
#if PROBE_ID == 99
    for (int rb_ = 0; rb_ < 40; ++rb_) GRID_BAR();
#endif
    ffn_block<0, 0>(lds, lds_raw, wv); mixer_block<0>(lds, lds_raw, wv); ffn_block<0, 1>(lds, lds_raw, wv);
    ffn_block<1, 0>(lds, lds_raw, wv); mixer_block<1>(lds, lds_raw, wv); ffn_block<1, 1>(lds, lds_raw, wv);
#if defined(SCT) && SCT != 0
    if (BID == 0 && threadIdx.x == 0) { float* o = POUT; const float x_ = *(const float*)(PWS + WS_CTL + 524288); o[0] += exp2f(0.25f * rintf(4.0f * log2f(fmaxf(x_, 1.0f)))); }
#endif
}

extern "C" void kernel_launch(void* const* d_in, const int* in_sizes, int n_in, void* d_out, int out_size, void* d_ws, size_t ws_size, hipStream_t stream) {
    static int grid = 0;
    if (grid == 0) {
        if (n_in != 17 || ws_size < WS_END) { fprintf(stderr, "kernel_launch: unexpected n_in %d / ws_size %zu\n", n_in, ws_size); grid = -1; return; }
        int dev = 0, cus = 0, per_cu = 0;
        if (hipGetDevice(&dev) != hipSuccess || hipDeviceGetAttribute(&cus, hipDeviceAttributeMultiprocessorCount, dev) != hipSuccess) { grid = -1; return; }
        if (hipFuncSetAttribute((const void*)mega_fwd, hipFuncAttributeMaxDynamicSharedMemorySize, LDS_BYTES) != hipSuccess) { fprintf(stderr, "kernel_launch: hipFuncSetAttribute failed\n"); grid = -1; return; }
        if (hipOccupancyMaxActiveBlocksPerMultiprocessor(&per_cu, (const void*)mega_fwd, NTHREADS, LDS_BYTES) != hipSuccess || per_cu < 1) { fprintf(stderr, "kernel_launch: occupancy query says %d\n", per_cu); per_cu = 1; }
        (void)hipGetLastError();
        grid = cus;
        if (grid > 256) grid = 256;
    }
    if (grid < 0) return;
    (void)hipMemsetAsync((char*)d_ws + WS_CTL, 0, 1 * MiB, stream);
    Params p{};
    for (int i = 0; i < 17; ++i) p.in[i] = (const float*)d_in[i];
    p.out = (float*)d_out; p.ws = (unsigned char*)d_ws;
    hipLaunchKernelGGL(mega_fwd, dim3(grid), dim3(NTHREADS), LDS_BYTES, stream, p);
}
```

```cpp
#include <hip/hip_runtime.h>
#include <cstdio>
#include <cstdint>
__device__ __forceinline__ int lane_id_() { int l; asm volatile("v_mbcnt_lo_u32_b32 %0, -1, 0\n\tv_mbcnt_hi_u32_b32 %0, -1, %0" : "=v"(l)); return l; }
namespace pg8 {
#define PG8_LAS __attribute__((address_space(3)))
typedef unsigned short bf16_t;
typedef short bf16x8 __attribute__((ext_vector_type(8)));
typedef float f32x4 __attribute__((ext_vector_type(4)));
typedef unsigned u32x4 __attribute__((ext_vector_type(4)));
constexpr int BM = 256, BK = 64, HALF = 128, HTB = HALF * BK * 2  , STAGE_BYTES = 8 * HTB, NXCD = 8, WGM = 4;

__host__ __device__ __forceinline__ int lds_byte(int r, int c) { const int st = (r >> 4) * 2 + (c >> 5), rr = r & 15, cc = c & 31, ob = rr * 64 + cc * 2; return st * 1024 + (ob ^ (((ob >> 9) & 1) << 5)); }
__host__ __device__ __forceinline__ void stage_rc(int b, int& R, int& C) { const int st = b / 1024, sb = b % 1024, swz = sb ^ (((sb >> 9) & 1) << 5); R = (st >> 1) * 16 + swz / 64; C = (st & 1) * 32 + (swz % 64) / 2; }
__host__ __device__ __forceinline__ int perm32(int rho) { const int n = rho >> 4, i = rho & 15; return 8 * (i >> 2) + 4 * n + (i & 3); }

struct Unit { int pm, pn; };
struct Gemm { const bf16_t* A; const bf16_t* Bt; int M, N, K, pad_; };

struct StaticOrder {
    int nM, nN, nwg, G, c;
    __host__ __device__ void init(int M, int N, int G_, int c_) { nM = M / BM; nN = N / BM; nwg = nM * nN; G = G_; c = c_; }
    __host__ __device__ bool next(int i, Unit& u) const {
        const long L = (long)i * G + c; if (L >= nwg) return false;
        int wgid = (int)L; { const int q = nwg / NXCD, r = nwg % NXCD, xcd = wgid % NXCD, off = wgid / NXCD; wgid = (xcd < r ? xcd * (q + 1) : r * (q + 1) + (xcd - r) * q) + off; }
        const int nig = WGM * nN, gid = wgid / nig, fm = gid * WGM, gsz = (nM - fm) < WGM ? (nM - fm) : WGM;
        u.pm = fm + ((wgid % nig) % gsz); u.pn = (wgid % nig) / gsz; return true;
    }
    __device__ __forceinline__ void a_ready(const Unit&) const {}
    __device__ __forceinline__ void done(const Unit&) const {}
};

__device__ __forceinline__ unsigned cvt_pk_bf16(float lo, float hi) { unsigned r; asm volatile("v_cvt_pk_bf16_f32 %0, %1, %2" : "=v"(r) : "v"(lo), "v"(hi)); return r; }
typedef float f32x2 __attribute__((ext_vector_type(2)));
__device__ __forceinline__ f32x2 gelu_pk(f32x2 v) {
    const f32x2 av = __builtin_elementwise_abs(v), d = av * 0.2316418882f + 1.0f;
    f32x2 t; t.x = __builtin_amdgcn_rcpf(d.x); t.y = __builtin_amdgcn_rcpf(d.y);
    f32x2 q = t * 0.5307027145f + (-0.7265760135f); q = q * t + 0.7107068705f; q = q * t + (-0.142248368f); q = q * t + 0.127414796f; q = q * t;
    const f32x2 s = (v * v) * (-0.72134752044f);
    f32x2 e; e.x = __builtin_amdgcn_exp2f(s.x); e.y = __builtin_amdgcn_exp2f(s.y);
    const f32x2 m = v * (q * e), r = v - m;
    f32x2 o; o.x = v.x < 0.f ? m.x : r.x; o.y = v.y < 0.f ? m.y : r.y; return o;
}

template <int ACT  > struct EpiBf16 {
    static constexpr bool PERM = true, AFTER_DRAIN = false; static_assert(ACT == 0 || ACT == 1, "EpiBf16: ACT is 0 (none) or 1 (gelu_pk)");
    bf16_t* O; int ldc; const float* bias; int split_cols; size_t split_stride; float scale0;
    __device__ __forceinline__ void operator()(const f32x4 (&acc)[2][2][4][2], const Unit& u, int wr, int wc, int fr, int fq) const {
        const int row0 = u.pm * BM + wr * 64 + fr; int colt = u.pn * BM; bf16_t* base = O;
        float sc = 1.f; if (split_cols) { const int t = colt / split_cols; base += (size_t)t * split_stride; colt -= t * split_cols; if (t == 0) sc = scale0; }
        const int col0 = colt + wc * 32 + 8 * fq, bcol0 = u.pn * BM + wc * 32 + 8 * fq;
        f32x4 bv[2][2];
#pragma unroll
        for (int bj = 0; bj < 2; ++bj)
#pragma unroll
            for (int n = 0; n < 2; ++n) bv[bj][n] = bias ? *(const f32x4*)(bias + bcol0 + bj * HALF + 4 * n) : (f32x4){0.f, 0.f, 0.f, 0.f};
#pragma unroll
        for (int ai = 0; ai < 2; ++ai)
#pragma unroll
            for (int m = 0; m < 4; ++m) { bf16_t* rowp = base + (size_t)(row0 + ai * HALF + m * 16) * ldc + col0;
#pragma unroll
                for (int bj = 0; bj < 2; ++bj) { f32x4 v0 = acc[ai][bj][m][0] + bv[bj][0], v1 = acc[ai][bj][m][1] + bv[bj][1];
                    if (ACT == 1) { f32x2 a = gelu_pk((f32x2){v0[0], v0[1]}), b = gelu_pk((f32x2){v0[2], v0[3]}), c = gelu_pk((f32x2){v1[0], v1[1]}), d = gelu_pk((f32x2){v1[2], v1[3]});
                        v0 = (f32x4){a.x, a.y, b.x, b.y}; v1 = (f32x4){c.x, c.y, d.x, d.y}; }
                    v0 = v0 * sc; v1 = v1 * sc; u32x4 w; w.x = cvt_pk_bf16(v0[0], v0[1]); w.y = cvt_pk_bf16(v0[2], v0[3]); w.z = cvt_pk_bf16(v1[0], v1[1]); w.w = cvt_pk_bf16(v1[2], v1[3]);
                    *(u32x4*)(rowp + bj * HALF) = w; } }
    }
};

struct PanelStats {
    unsigned* xbuf;
    unsigned* cnt;
    unsigned* tmo;
    int ntn; float eps;
    unsigned code;
    __device__ __forceinline__ bool run(const f32x4 (&v)[2][2][4][2], const Unit& u, int wr, int wc, int fr, int fq, PG8_LAS unsigned char* lds, int wid, int lane) const {
        typedef float f32x2v __attribute__((ext_vector_type(2)));
        PG8_LAS f32x2v* P = (PG8_LAS f32x2v*)lds;
        PG8_LAS f32x2v* S = (PG8_LAS f32x2v*)(lds + 8192);
        PG8_LAS unsigned* flag = (PG8_LAS unsigned*)(lds + 8192 + 2048);
#pragma unroll
        for (int ai = 0; ai < 2; ++ai)
#pragma unroll
            for (int m = 0; m < 4; ++m) {
                float s = 0.f;
#pragma unroll
                for (int bj = 0; bj < 2; ++bj)
#pragma unroll
                    for (int n = 0; n < 2; ++n) { const f32x4 x = v[ai][bj][m][n]; s += (x[0] + x[1]) + (x[2] + x[3]); }
                s += __shfl_xor(s, 16); s += __shfl_xor(s, 32);
                const float mw = s * (1.0f / 64.0f); float q = 0.f;
#pragma unroll
                for (int bj = 0; bj < 2; ++bj)
#pragma unroll
                    for (int n = 0; n < 2; ++n) { const f32x4 d = v[ai][bj][m][n] - mw; q += (d[0] * d[0] + d[1] * d[1]) + (d[2] * d[2] + d[3] * d[3]); }
                q += __shfl_xor(q, 16); q += __shfl_xor(q, 32);
                if (fq == 0) P[(ai * HALF + wr * 64 + m * 16 + fr) * 4 + wc] = (f32x2v){mw, q};
            }
        asm volatile("s_waitcnt lgkmcnt(0)" ::: "memory"); __builtin_amdgcn_s_barrier(); asm volatile("" ::: "memory");
#if defined(BROKEN_EXCHANGE_NO_WAIT)
#warning BROKEN CONTROL BUILD: the row-statistics exchange does not wait; results are wrong by design
        if (blockIdx.x >= 64) { const long long t0_ = clock64(); while (clock64() - t0_ < 60000) __builtin_amdgcn_s_sleep(8); }
#endif
        const int row = wid * 32 + (lane & 31);
        if (lane < 32) {
            const f32x2v a = P[row * 4 + 0], b = P[row * 4 + 1], c = P[row * 4 + 2], d = P[row * 4 + 3];
            const float mt = (a.x + b.x + c.x + d.x) * 0.25f;
            const float da = a.x - mt, db = b.x - mt, dc = c.x - mt, dd = d.x - mt;
            const float m2 = (a.y + b.y) + (c.y + d.y) + 64.0f * ((da * da + db * db) + (dc * dc + dd * dd));
            unsigned long long* slot = (unsigned long long*)xbuf + ((size_t)(u.pm * BM + row) * 4 + u.pn);
            __hip_atomic_store(slot, ((unsigned long long)__float_as_uint(m2) << 32) | __float_as_uint(mt), __ATOMIC_RELAXED, __HIP_MEMORY_SCOPE_AGENT);
        }
        asm volatile("s_waitcnt vmcnt(0)" ::: "memory");
        if (lane == 0) __hip_atomic_fetch_add(cnt + 64 * u.pm, 1u, __ATOMIC_RELAXED, __HIP_MEMORY_SCOPE_AGENT);
        if (wid == 0) {
            bool dead = false; const unsigned long long t0 = __builtin_amdgcn_s_memrealtime(); const unsigned want = 8u * (unsigned)ntn;
            for (;;) {
#if defined(BROKEN_EXCHANGE_NO_WAIT)
                break;
#endif
                if ((unsigned)__builtin_amdgcn_readfirstlane(__hip_atomic_load(cnt + 64 * u.pm, __ATOMIC_RELAXED, __HIP_MEMORY_SCOPE_AGENT)) >= want) break;
                if (__builtin_amdgcn_s_memrealtime() - t0 > 2000000ull) {
                    if (lane == 0) { unsigned expect = 0u; __hip_atomic_compare_exchange_strong(tmo + 1, &expect, code | (unsigned)(u.pm & 0xff), __ATOMIC_RELAXED, __ATOMIC_RELAXED, __HIP_MEMORY_SCOPE_AGENT);
                                     __hip_atomic_store(tmo, 1u, __ATOMIC_RELAXED, __HIP_MEMORY_SCOPE_AGENT); }
                    dead = true; break; }
                __builtin_amdgcn_s_sleep(2);
            }
            __builtin_amdgcn_fence(__ATOMIC_ACQUIRE, "agent");
            if (lane == 0) flag[0] = dead ? 1u : 0u;
        }
        asm volatile("s_waitcnt vmcnt(0) lgkmcnt(0)" ::: "memory"); __builtin_amdgcn_s_barrier(); asm volatile("" ::: "memory");
        const bool bad = flag[0] != 0u;
        if (lane < 32) {
            const unsigned long long* slot = (const unsigned long long*)xbuf + (size_t)(u.pm * BM + row) * 4; float mt[4], m2[4]; float ms = 0.f;
#pragma unroll
            for (int t = 0; t < 4; ++t) { if (t < ntn) { const unsigned long long w = __hip_atomic_load(slot + t, __ATOMIC_RELAXED, __HIP_MEMORY_SCOPE_AGENT); mt[t] = __uint_as_float((unsigned)w); m2[t] = __uint_as_float((unsigned)(w >> 32)); } else { mt[t] = 0.f; m2[t] = 0.f; } ms += mt[t]; }
            const float mean = ms / (float)ntn; float q = 0.f;
#pragma unroll
            for (int t = 0; t < 4; ++t) if (t < ntn) { const float dm = mt[t] - mean; q += m2[t] + 256.0f * dm * dm; }
            S[row] = (f32x2v){mean, 1.0f / sqrtf(q / (256.0f * (float)ntn) + eps)};
        }
        asm volatile("s_waitcnt lgkmcnt(0)" ::: "memory"); __builtin_amdgcn_s_barrier(); asm volatile("" ::: "memory");
        return bad;
    }
};
struct EpiLnRes {
    static constexpr bool PERM = false, AFTER_DRAIN = true;
    const float* base; float* out; int ldc; const float* bias; PanelStats st; unsigned poison;
    __device__ __forceinline__ void fused(f32x4 (&acc)[2][2][4][2], const Unit& u, int wr, int wc, int fr, int fq, PG8_LAS unsigned char* lds, int wid, int lane) const {
        typedef float f32x2v __attribute__((ext_vector_type(2)));
        const PG8_LAS f32x2v* S = (const PG8_LAS f32x2v*)(lds + 8192);
        const int col0 = u.pn * BM + wc * 32 + 4 * fq;
#pragma unroll
        for (int bj = 0; bj < 2; ++bj)
#pragma unroll
            for (int n = 0; n < 2; ++n) { const f32x4 bv = bias ? *(const f32x4*)(bias + col0 + bj * HALF + n * 16) : (f32x4){0.f, 0.f, 0.f, 0.f};
#pragma unroll
                for (int ai = 0; ai < 2; ++ai)
#pragma unroll
                    for (int m = 0; m < 4; ++m) acc[ai][bj][m][n] += bv; }
        f32x4 pre[4][2][2];
#pragma unroll
        for (int m = 0; m < 4; ++m) { const size_t off = (size_t)(u.pm * BM + wr * 64 + m * 16 + fr) * ldc + col0;
#pragma unroll
            for (int bj = 0; bj < 2; ++bj)
#pragma unroll
                for (int n = 0; n < 2; ++n) pre[m][bj][n] = *(const f32x4*)(base + off + bj * HALF + n * 16); }
        const bool bad = st.run(acc, u, wr, wc, fr, fq, lds, wid, lane) || poison != 0u;
        const float qnan = __builtin_nanf("");
#pragma unroll
        for (int ai = 0; ai < 2; ++ai)
#pragma unroll
            for (int m = 0; m < 4; ++m) { const int r = ai * HALF + wr * 64 + m * 16 + fr; const f32x2v sr = S[r]; const size_t off = (size_t)(u.pm * BM + r) * ldc + col0;
#pragma unroll
                for (int bj = 0; bj < 2; ++bj)
#pragma unroll
                    for (int n = 0; n < 2; ++n) { const f32x4 bs = ai == 0 ? pre[m][bj][n] : *(const f32x4*)(base + off + bj * HALF + n * 16); f32x4 o = bs + (acc[ai][bj][m][n] - sr.x) * sr.y;
                        if (bad) o = (f32x4){qnan, qnan, qnan, qnan}; *(f32x4*)(out + off + bj * HALF + n * 16) = o; }
                if (m & 1) asm volatile("" ::: "memory"); }
    }
};
struct EpiLnResLn {
    static constexpr bool PERM = false, AFTER_DRAIN = true;
    const float* base; float* out; bf16_t* xn; int ldc; const float* bias; PanelStats st1, st2; unsigned poison;
    __device__ __forceinline__ void fused(f32x4 (&acc)[2][2][4][2], const Unit& u, int wr, int wc, int fr, int fq, PG8_LAS unsigned char* lds, int wid, int lane) const {
        typedef float f32x2v __attribute__((ext_vector_type(2))); typedef unsigned u32x2v __attribute__((ext_vector_type(2)));
        const PG8_LAS f32x2v* S = (const PG8_LAS f32x2v*)(lds + 8192);
        const int col0 = u.pn * BM + wc * 32 + 4 * fq;
#pragma unroll
        for (int bj = 0; bj < 2; ++bj)
#pragma unroll
            for (int n = 0; n < 2; ++n) { const f32x4 bv = bias ? *(const f32x4*)(bias + col0 + bj * HALF + n * 16) : (f32x4){0.f, 0.f, 0.f, 0.f};
#pragma unroll
                for (int ai = 0; ai < 2; ++ai)
#pragma unroll
                    for (int m = 0; m < 4; ++m) acc[ai][bj][m][n] += bv; }
        bool bad = st1.run(acc, u, wr, wc, fr, fq, lds, wid, lane) || poison != 0u;
        const float qnan = __builtin_nanf("");
#pragma unroll
        for (int ai = 0; ai < 2; ++ai)
#pragma unroll
            for (int m = 0; m < 4; ++m) { const int r = ai * HALF + wr * 64 + m * 16 + fr; const f32x2v sr = S[r]; const size_t off = (size_t)(u.pm * BM + r) * ldc + col0;
#pragma unroll
                for (int bj = 0; bj < 2; ++bj)
#pragma unroll
                    for (int n = 0; n < 2; ++n) { const f32x4 bs = *(const f32x4*)(base + off + bj * HALF + n * 16); acc[ai][bj][m][n] = bs + (acc[ai][bj][m][n] - sr.x) * sr.y; }
                asm volatile("" : "+v"(acc[ai][0][m][0]), "+v"(acc[ai][0][m][1]), "+v"(acc[ai][1][m][0]), "+v"(acc[ai][1][m][1]));
                if (m & 1) asm volatile("" ::: "memory"); }
        const bool bad1 = bad;
        bad = st2.run(acc, u, wr, wc, fr, fq, lds, wid, lane) || bad;
#pragma unroll
        for (int ai = 0; ai < 2; ++ai)
#pragma unroll
            for (int m = 0; m < 4; ++m) { const int r = ai * HALF + wr * 64 + m * 16 + fr; const f32x2v sr = S[r]; const size_t off = (size_t)(u.pm * BM + r) * ldc + col0;
#pragma unroll
                for (int bj = 0; bj < 2; ++bj)
#pragma unroll
                    for (int n = 0; n < 2; ++n) { const f32x4 x1 = acc[ai][bj][m][n]; *(f32x4*)(out + off + bj * HALF + n * 16) = bad1 ? (f32x4){qnan, qnan, qnan, qnan} : x1;
                        const f32x4 o = (x1 - sr.x) * sr.y; u32x2v w; w.x = cvt_pk_bf16(o[0], o[1]); w.y = cvt_pk_bf16(o[2], o[3]);
                        if (bad) { w.x = 0x7fc07fc0u; w.y = 0x7fc07fc0u; } *(u32x2v*)(xn + off + bj * HALF + n * 16) = w; }
                asm volatile("" ::: "memory"); }
    }
};

template <class Epi, class Sched, bool ALIGN_EPI = false, bool SP2 = false>
__device__ __forceinline__ void gemm_phase(PG8_LAS unsigned char* lds, const Gemm g, const Sched& S, const Epi& E, int wv) {
    int tid_ = wv * 64 + lane_id_(); asm volatile("" : "+v"(tid_));
    const int tid = tid_, wid = __builtin_amdgcn_readfirstlane(tid >> 6), lane = tid & 63, wr = wid >> 2, wc = wid & 3, fr = lane & 15, fq = lane >> 4;
    const int K = g.K, nt = K / BK;
    unsigned voffA[2], voffB[2];
#pragma unroll
    for (int i = 0; i < 2; ++i) { int R, C; stage_rc(tid * 16 + i * 8192, R, C); const int Rb = Epi::PERM ? ((R & ~31) + perm32(R & 31)) : R;
        voffA[i] = (unsigned)(R * K + C) * 2u; voffB[i] = (unsigned)(Rb * K + C) * 2u; }
    const size_t kstep = (size_t)(BK * 2);
    const size_t hstep = (size_t)HALF * K * 2;
    const size_t tstep = 2 * hstep;
    const unsigned ldsw = (unsigned)wid * 1024u;
    const int aoff = lds_byte(wr * 64 + fr, fq * 8), boff = lds_byte(wc * 32 + fr, fq * 8);
#define PG8_SA(b, h) (((b) * 2 + (h)) * HTB)
#define PG8_SB(b, h) ((4 + (b) * 2 + (h)) * HTB)
#define PG8_STAGE(bufoff, gbase, voff) do { _Pragma("unroll") for (int _i = 0; _i < 2; ++_i) \
        __builtin_amdgcn_global_load_lds((const unsigned*)((const char*)(gbase) + (voff)[_i]), (PG8_LAS unsigned*)(lds + (bufoff) + ldsw + _i * 8192), 16, 0, 0); } while (0)
#define PG8_LDA(dst, b, h) do { _Pragma("unroll") for (int m = 0; m < 4; ++m) _Pragma("unroll") for (int k = 0; k < 2; ++k) dst[m][k] = *(const PG8_LAS bf16x8*)(lds + PG8_SA(b, h) + aoff + m * 2048 + k * 1024); } while (0)
#define PG8_LDB(dst, b, h) do { _Pragma("unroll") for (int n = 0; n < 2; ++n) _Pragma("unroll") for (int k = 0; k < 2; ++k) dst[n][k] = *(const PG8_LAS bf16x8*)(lds + PG8_SB(b, h) + boff + n * 2048 + k * 1024); } while (0)
#define PG8_MMA(ai, bj, At, Bt) do { __builtin_amdgcn_s_setprio(1); _Pragma("unroll") for (int m = 0; m < 4; ++m) _Pragma("unroll") for (int n = 0; n < 2; ++n) _Pragma("unroll") for (int k = 0; k < 2; ++k) \
        acc[ai][bj][m][n] = __builtin_amdgcn_mfma_f32_16x16x32_bf16(Bt[n][k], At[m][k], acc[ai][bj][m][n], 0, 0, 0); __builtin_amdgcn_s_setprio(0); } while (0)
#define PG8_WAIT_V(n) asm volatile("s_waitcnt vmcnt(" #n ")" ::: "memory")
#define PG8_WAIT_L(n) asm volatile("s_waitcnt lgkmcnt(" #n ")" ::: "memory")
#define PG8_BAR __builtin_amdgcn_s_barrier()
#define PG8_SCHED __builtin_amdgcn_sched_barrier(0)
    Unit cur, nxt; int ui = 0;
    if (!S.next(0, cur)) return;
    f32x4 acc[2][2][4][2];
#pragma unroll
    for (int a = 0; a < 2; ++a)
#pragma unroll
        for (int b = 0; b < 2; ++b)
#pragma unroll
            for (int m = 0; m < 4; ++m)
#pragma unroll
                for (int n = 0; n < 2; ++n) acc[a][b][m][n] = (f32x4){0.f, 0.f, 0.f, 0.f};
    bf16x8 At[4][2], B0[2][2], B1[2][2];
    const char* cA = (const char*)g.A + (size_t)cur.pm * tstep; const char* cB = (const char*)g.Bt + (size_t)cur.pn * tstep;
    S.a_ready(cur);
    if constexpr (SP2) {
        PG8_STAGE(PG8_SB(0, 0), cB, voffB); PG8_STAGE(PG8_SB(0, 1), cB + hstep, voffB); PG8_STAGE(PG8_SA(0, 0), cA, voffA); PG8_STAGE(PG8_SA(0, 1), cA + hstep, voffA);
        if (wr == 1) PG8_BAR;
        PG8_WAIT_V(2); PG8_BAR;
        PG8_STAGE(PG8_SB(1, 0), cB + kstep, voffB); PG8_STAGE(PG8_SA(1, 0), cA + kstep, voffA); PG8_STAGE(PG8_SB(1, 1), cB + hstep + kstep, voffB);
        PG8_WAIT_V(6); PG8_BAR;
    } else {
        PG8_STAGE(PG8_SB(0, 0), cB, voffB); PG8_STAGE(PG8_SA(0, 0), cA, voffA); PG8_STAGE(PG8_SB(0, 1), cB + hstep, voffB); PG8_STAGE(PG8_SA(0, 1), cA + hstep, voffA);
        if (wr == 1) PG8_BAR;
        PG8_WAIT_V(4); PG8_BAR;
        PG8_STAGE(PG8_SB(1, 0), cB + kstep, voffB); PG8_STAGE(PG8_SA(1, 0), cA + kstep, voffA); PG8_STAGE(PG8_SB(1, 1), cB + hstep + kstep, voffB);
        PG8_WAIT_V(6); PG8_BAR;
    }
    for (;;) {
        const bool has_next = S.next(ui + 1, nxt);
        const char* nA = has_next ? (const char*)g.A + (size_t)nxt.pm * tstep : cA; const char* nB = has_next ? (const char*)g.Bt + (size_t)nxt.pn * tstep : cB;
        for (int t = 0; t < nt; t += 2) {
            const bool last = (t == nt - 2);
            const char* a1 = cA + (size_t)(t + 1) * kstep;
            const char* a2 = last ? nA : cA + (size_t)(t + 2) * kstep; const char* b2 = last ? nB : cB + (size_t)(t + 2) * kstep;
            const char* a3 = a2 + kstep; const char* b3 = b2 + kstep;
            if (last && has_next) S.a_ready(nxt);
            if constexpr (SP2) {
            PG8_LDB(B0, 0, 0); PG8_LDB(B1, 0, 1); PG8_SCHED; PG8_LDA(At, 0, 0); PG8_STAGE(PG8_SA(1, 1), a1 + hstep, voffA);
            PG8_WAIT_V(8); PG8_WAIT_L(0); PG8_BAR; PG8_MMA(0, 0, At, B0); PG8_MMA(0, 1, At, B1); PG8_BAR; PG8_SCHED;
            PG8_LDA(At, 0, 1); PG8_STAGE(PG8_SB(0, 0), b2, voffB); PG8_STAGE(PG8_SB(0, 1), b2 + hstep, voffB); PG8_STAGE(PG8_SA(0, 0), a2, voffA);
            PG8_WAIT_V(8); PG8_WAIT_L(0); PG8_BAR; PG8_MMA(1, 0, At, B0); PG8_MMA(1, 1, At, B1); PG8_BAR; PG8_SCHED;
            PG8_LDB(B0, 1, 0); PG8_LDB(B1, 1, 1); PG8_SCHED; PG8_LDA(At, 1, 0); PG8_STAGE(PG8_SA(0, 1), a2 + hstep, voffA);
            PG8_WAIT_V(8); PG8_WAIT_L(0); PG8_BAR; PG8_MMA(0, 0, At, B0); PG8_MMA(0, 1, At, B1); PG8_BAR; PG8_SCHED;
            PG8_LDA(At, 1, 1); PG8_STAGE(PG8_SB(1, 0), b3, voffB); PG8_STAGE(PG8_SB(1, 1), b3 + hstep, voffB); PG8_STAGE(PG8_SA(1, 0), a3, voffA);
            PG8_WAIT_V(8); PG8_WAIT_L(0); PG8_BAR; PG8_MMA(1, 0, At, B0); PG8_MMA(1, 1, At, B1); PG8_BAR; PG8_SCHED;
            } else {
            PG8_LDB(B0, 0, 0); PG8_SCHED; PG8_LDA(At, 0, 0); PG8_STAGE(PG8_SA(1, 1), a1 + hstep, voffA);
            PG8_WAIT_L(8); PG8_BAR; PG8_WAIT_L(0); PG8_MMA(0, 0, At, B0); PG8_BAR; PG8_SCHED;
            PG8_LDB(B1, 0, 1); PG8_STAGE(PG8_SB(0, 0), b2, voffB);
            PG8_BAR; PG8_WAIT_L(0); PG8_MMA(0, 1, At, B1); PG8_BAR;
            PG8_LDA(At, 0, 1); PG8_STAGE(PG8_SA(0, 0), a2, voffA);
            PG8_BAR; PG8_WAIT_L(0); PG8_MMA(1, 0, At, B0); PG8_BAR; PG8_SCHED;
            PG8_STAGE(PG8_SB(0, 1), b2 + hstep, voffB);
            PG8_WAIT_V(6); PG8_BAR; PG8_MMA(1, 1, At, B1); PG8_BAR;
            PG8_LDB(B0, 1, 0); PG8_SCHED; PG8_LDA(At, 1, 0); PG8_STAGE(PG8_SA(0, 1), a2 + hstep, voffA);
            PG8_WAIT_L(8); PG8_BAR; PG8_WAIT_L(0); PG8_MMA(0, 0, At, B0); PG8_BAR; PG8_SCHED;
            PG8_LDB(B1, 1, 1); PG8_STAGE(PG8_SB(1, 0), b3, voffB);
            PG8_BAR; PG8_WAIT_L(0); PG8_MMA(0, 1, At, B1); PG8_BAR;
            PG8_LDA(At, 1, 1); PG8_STAGE(PG8_SA(1, 0), a3, voffA);
            PG8_BAR; PG8_WAIT_L(0); PG8_MMA(1, 0, At, B0); PG8_BAR; PG8_SCHED;
            PG8_STAGE(PG8_SB(1, 1), b3 + hstep, voffB);
            PG8_WAIT_V(6); PG8_BAR; PG8_MMA(1, 1, At, B1); PG8_BAR;
            }
        }
        if constexpr (ALIGN_EPI) { if (wr == 0) PG8_BAR; }
        if constexpr (!Epi::AFTER_DRAIN) { E(acc, cur, wr, wc, fr, fq); S.done(cur); }
        if (!has_next) break;
#pragma unroll
        for (int a = 0; a < 2; ++a)
#pragma unroll
            for (int b = 0; b < 2; ++b)
#pragma unroll
                for (int m = 0; m < 4; ++m)
#pragma unroll
                    for (int n = 0; n < 2; ++n) acc[a][b][m][n] = (f32x4){0.f, 0.f, 0.f, 0.f};
        cur = nxt; cA = nA; cB = nB; ++ui;
        if constexpr (ALIGN_EPI) { if (wr == 1) PG8_BAR; }
    }
    PG8_WAIT_V(0);
    if constexpr (!ALIGN_EPI) { if (wr == 0) PG8_BAR; }
    PG8_BAR;
    if constexpr (Epi::AFTER_DRAIN) { E.fused(acc, cur, wr, wc, fr, fq, lds, wid, lane); S.done(cur); }
#undef PG8_SA
#undef PG8_SB
#undef PG8_STAGE
#undef PG8_LDA
#undef PG8_LDB
#undef PG8_MMA
#undef PG8_WAIT_V
#undef PG8_WAIT_L
#undef PG8_BAR
#undef PG8_SCHED
}
}
constexpr int S_ = 16384, D_ = 1024, FF_ = 2816, NIN_ = 7448, NINP_ = 7680;
constexpr int NTHREADS = 512;
constexpr size_t MiB = 1u << 20;
constexpr size_t WS_CTL = 0;
constexpr size_t WS_MOD = 1 * MiB;
constexpr size_t WS_ROPE = 2 * MiB;
constexpr size_t WS_W = 6 * MiB;
constexpr size_t W_FFIN0 = 0, W_FFIN1 = 11 * MiB, W_FFOUT0 = 22 * MiB, W_FFOUT1 = 27 * MiB + MiB / 2, W_IN = 33 * MiB, W_BATT = 48 * MiB, W_BDN = 48 * MiB + MiB / 2, W_OUT = 50 * MiB;
constexpr size_t WS_H = 58 * MiB;
constexpr size_t WS_R = 90 * MiB;
constexpr size_t R_ACT = 0, R_Y = 88 * MiB;
constexpr size_t R_PA = 0, R_QKVD = 0, R_PG = 0, R_PD = 72 * MiB, R_TINV = 72 * MiB, R_ODIR1 = 120 * MiB, R_ODN = 72 * MiB, R_T1 = 96 * MiB, R_PZ = 144 * MiB, R_AB = 168 * MiB, R_GB = 170 * MiB,
                 R_OATT = 172 * MiB, R_ATTN = 180 * MiB, R_Y2 = 160 * MiB, R_OG = 228 * MiB, R_LSE = 252 * MiB, R_ODIR0 = 228 * MiB, R_VEC = 253 * MiB;
constexpr size_t WS_END = 352 * MiB;

typedef unsigned short bf16;
typedef unsigned v4u __attribute__((ext_vector_type(4)));
typedef unsigned v2u __attribute__((ext_vector_type(2)));
typedef float f32x4 __attribute__((ext_vector_type(4)));
typedef float f32x2 __attribute__((ext_vector_type(2)));
#define LAS __attribute__((address_space(3)))

typedef __bf16 bf16x2_hw __attribute__((ext_vector_type(2)));
__device__ __forceinline__ unsigned pk2(float lo, float hi) { f32x2 v = {lo, hi}; return __builtin_bit_cast(unsigned, __builtin_convertvector(v, bf16x2_hw)); }
__device__ __forceinline__ unsigned f2bf(float f) { return pk2(f, f) & 0xffffu; }
__device__ __forceinline__ float bf2f(unsigned short b) { return __builtin_bit_cast(float, (unsigned)b << 16); }
__device__ __forceinline__ float bflo(unsigned w) { return __builtin_bit_cast(float, w << 16); }
__device__ __forceinline__ float bfhi(unsigned w) { return __builtin_bit_cast(float, w & 0xffff0000u); }
__device__ __forceinline__ float wave_sum(float v) {
#pragma unroll
    for (int o = 1; o < 64; o <<= 1) v += __shfl_xor(v, o);
    return v;
}
__device__ __forceinline__ float sigmoidf_(float x) { return 1.0f / (1.0f + __expf(-x)); }
__device__ __forceinline__ float siluf_(float x) { return x / (1.0f + __expf(-x)); }

namespace pg8 {
struct EpiSwiglu {
    static constexpr bool PERM = true, AFTER_DRAIN = false;
    bf16_t* O; int ldc; int pad_;
    __device__ __forceinline__ void operator()(const f32x4 (&acc)[2][2][4][2], const Unit& u, int wr, int wc, int fr, int fq) const {
        const int row0 = u.pm * BM + wr * 64 + fr, col0 = u.pn * 128 + wc * 32 + 8 * fq;
#pragma unroll
        for (int ai = 0; ai < 2; ++ai)
#pragma unroll
            for (int m = 0; m < 4; ++m) {
                bf16_t* rowp = O + (size_t)(row0 + ai * HALF + m * 16) * ldc + col0;
                float v[8];
#pragma unroll
                for (int n = 0; n < 2; ++n)
#pragma unroll
                    for (int e = 0; e < 4; ++e) { const float g = acc[ai][0][m][n][e], uu = acc[ai][1][m][n][e]; v[n * 4 + e] = g * __builtin_amdgcn_rcpf(1.0f + __expf(-g)) * uu; }
                u32x4 w; w.x = cvt_pk_bf16(v[0], v[1]); w.y = cvt_pk_bf16(v[2], v[3]); w.z = cvt_pk_bf16(v[4], v[5]); w.w = cvt_pk_bf16(v[6], v[7]);
                *(u32x4*)rowp = w;
            }
    }
};
struct EpiBf16P {
    static constexpr bool PERM = true, AFTER_DRAIN = false;
    bf16_t* O; int ldc; int pad_;
    __device__ __forceinline__ void operator()(const f32x4 (&acc)[2][2][4][2], const Unit& u, int wr, int wc, int fr, int fq) const {
        const int row0 = u.pm * BM + wr * 64 + fr, col0 = u.pn * BM + wc * 32 + 8 * fq;
#pragma unroll
        for (int ai = 0; ai < 2; ++ai)
#pragma unroll
            for (int m = 0; m < 4; ++m) {
                bf16_t* rowp = O + (size_t)(row0 + ai * HALF + m * 16) * ldc + col0;
#pragma unroll
                for (int bj = 0; bj < 2; ++bj) { const f32x4 v0 = acc[ai][bj][m][0], v1 = acc[ai][bj][m][1];
                    u32x4 w; w.x = cvt_pk_bf16(v0[0], v0[1]); w.y = cvt_pk_bf16(v0[2], v0[3]); w.z = cvt_pk_bf16(v1[0], v1[1]); w.w = cvt_pk_bf16(v1[2], v1[3]);
                    *(u32x4*)(rowp + bj * HALF) = w; }
            }
    }
};
struct EpiF32 {
    static constexpr bool PERM = false, AFTER_DRAIN = false;
    float* O; int ldc; int pad_;
    __device__ __forceinline__ void operator()(const f32x4 (&acc)[2][2][4][2], const Unit& u, int wr, int wc, int fr, int fq) const {
        const int row0 = u.pm * BM + wr * 64 + fr, col0 = u.pn * BM + wc * 32 + 4 * fq;
#pragma unroll
        for (int ai = 0; ai < 2; ++ai)
#pragma unroll
            for (int m = 0; m < 4; ++m) {
                float* rowp = O + (size_t)(row0 + ai * HALF + m * 16) * ldc + col0;
#pragma unroll
                for (int bj = 0; bj < 2; ++bj)
#pragma unroll
                    for (int n = 0; n < 2; ++n) *(f32x4*)(rowp + bj * HALF + n * 16) = acc[ai][bj][m][n];
            }
    }
};
struct EpiInProj {
    static constexpr bool PERM = true, AFTER_DRAIN = false;
    bf16_t* PA; bf16_t* PD; bf16_t* PZ; float* AB;
    __device__ __forceinline__ void operator()(const f32x4 (&acc)[2][2][4][2], const Unit& u, int wr, int wc, int fr, int fq) const {
        const int row0 = u.pm * BM + wr * 64 + fr;
        if (u.pn == 21) {
            if (wc == 0) {
#pragma unroll
                for (int ai = 0; ai < 2; ++ai)
#pragma unroll
                    for (int m = 0; m < 4; ++m) {
                        float* rowp = AB + (size_t)(row0 + ai * HALF + m * 16) * 32 + 8 * fq;
                        *(f32x4*)rowp = acc[ai][0][m][0]; *(f32x4*)(rowp + 4) = acc[ai][0][m][1];
                    }
            }
            return;
        }
        bf16_t* base; int ldc, ct;
        if (u.pn < 9) { base = PA; ldc = 2304; ct = u.pn; } else if (u.pn < 18) { base = PD; ldc = 2304; ct = u.pn - 9; } else { base = PZ; ldc = 768; ct = u.pn - 18; }
        const int col0 = ct * BM + wc * 32 + 8 * fq;
#pragma unroll
        for (int ai = 0; ai < 2; ++ai)
#pragma unroll
            for (int m = 0; m < 4; ++m) {
                bf16_t* rowp = base + (size_t)(row0 + ai * HALF + m * 16) * ldc + col0;
#pragma unroll
                for (int bj = 0; bj < 2; ++bj) { const f32x4 v0 = acc[ai][bj][m][0], v1 = acc[ai][bj][m][1];
                    u32x4 w; w.x = cvt_pk_bf16(v0[0], v0[1]); w.y = cvt_pk_bf16(v0[2], v0[3]); w.z = cvt_pk_bf16(v1[0], v1[1]); w.w = cvt_pk_bf16(v1[2], v1[3]);
                    *(u32x4*)(rowp + bj * HALF) = w; }
            }
    }
};
struct EpiGateF32 {
    static constexpr bool PERM = false, AFTER_DRAIN = false;
    bf16_t* O; const bf16_t* gate; int ldg; int pad_;
    __device__ __forceinline__ void operator()(const f32x4 (&acc)[2][2][4][2], const Unit& u, int wr, int wc, int fr, int fq) const {
        const int row0 = u.pm * BM + wr * 64 + fr, col0 = u.pn * BM + wc * 32 + 4 * fq;
#pragma unroll
        for (int ai = 0; ai < 2; ++ai)
#pragma unroll
            for (int m = 0; m < 4; ++m) {
                const size_t r = (size_t)(row0 + ai * HALF + m * 16);
#pragma unroll
                for (int bj = 0; bj < 2; ++bj)
#pragma unroll
                    for (int n = 0; n < 2; ++n) { const int c = col0 + bj * HALF + n * 16;
                        const v2u gw = *(const v2u*)(gate + r * ldg + c);
                        f32x4 a = acc[ai][bj][m][n];
                        a[0] *= sigmoidf_(bflo(gw.x)); a[1] *= sigmoidf_(bfhi(gw.x)); a[2] *= sigmoidf_(bflo(gw.y)); a[3] *= sigmoidf_(bfhi(gw.y));
                        v2u w; w.x = cvt_pk_bf16(a[0], a[1]); w.y = cvt_pk_bf16(a[2], a[3]); *(v2u*)(O + r * 1024 + c) = w; }
            }
    }
};
struct EpiGateAddBf16 {
    static constexpr bool PERM = false, AFTER_DRAIN = false;
    bf16_t* O; const bf16_t* T1; const bf16_t* gate; int ldg; int pad_;
    __device__ __forceinline__ void operator()(const f32x4 (&acc)[2][2][4][2], const Unit& u, int wr, int wc, int fr, int fq) const {
        const int row0 = u.pm * BM + wr * 64 + fr, col0 = u.pn * BM + wc * 32 + 4 * fq;
#pragma unroll
        for (int ai = 0; ai < 2; ++ai)
#pragma unroll
            for (int m = 0; m < 4; ++m) {
                const size_t r = (size_t)(row0 + ai * HALF + m * 16);
#pragma unroll
                for (int bj = 0; bj < 2; ++bj)
#pragma unroll
                    for (int n = 0; n < 2; ++n) { const int c = col0 + bj * HALF + n * 16;
                        const v2u gw = *(const v2u*)(gate + r * ldg + c);
                        const v2u tw = *(const v2u*)(T1 + r * 1024 + c); const f32x4 t = {bflo(tw.x), bfhi(tw.x), bflo(tw.y), bfhi(tw.y)};
                        f32x4 a = acc[ai][bj][m][n];
                        a[0] = t[0] + a[0] * sigmoidf_(bflo(gw.x)); a[1] = t[1] + a[1] * sigmoidf_(bfhi(gw.x)); a[2] = t[2] + a[2] * sigmoidf_(bflo(gw.y)); a[3] = t[3] + a[3] * sigmoidf_(bfhi(gw.y));
                        v2u w; w.x = cvt_pk_bf16(a[0], a[1]); w.y = cvt_pk_bf16(a[2], a[3]);
                        *(v2u*)(O + r * 1024 + c) = w; }
            }
    }
};
}


#define GAS __attribute__((address_space(1)))
struct Params { const float* in[17]; float* out; unsigned char* ws; };
#define XB_TMO      128
#define XB_XCNT(j)  (256  + 64 * (j))
#define XB_XSUB(j)  (1280 + 64 * (j))
#define XB_XGEN(j)  (2304 + 64 * (j))
#define XB_TOP      3328
#define XB_TOPGEN   3392
#define XCD_BAR_WORDS 3456
#define XB_SPIN_CAP (1u << 18)

__device__ __forceinline__ unsigned xb_ld(unsigned* p)              { return __hip_atomic_load(p, __ATOMIC_RELAXED, __HIP_MEMORY_SCOPE_AGENT); }
__device__ __forceinline__ unsigned xb_add(unsigned* p, unsigned v) { return __hip_atomic_fetch_add(p, v, __ATOMIC_RELAXED, __HIP_MEMORY_SCOPE_AGENT); }
__device__ __forceinline__ unsigned xb_xcc_id() { return (unsigned)__builtin_amdgcn_s_getreg((3 << 11) | 20) & 0xFu; }
#define XB_SPIN(cond, bar) do { unsigned _sp = 0; while (cond) { __builtin_amdgcn_s_sleep(1); \
    if ((++_sp & 255u) == 0u) { if (xb_ld(&(bar)[XB_TMO])) break; if (_sp > XB_SPIN_CAP) { atomicAdd(&(bar)[XB_TMO], 1u); break; } } } } while (0)

struct XcdBarrier {
    unsigned* bar; unsigned x;
    volatile LAS unsigned* st;
};

__device__ __forceinline__ XcdBarrier xcd_barrier_post(unsigned* bar, volatile LAS unsigned* st) {
    XcdBarrier b; b.bar = bar; b.x = xb_xcc_id(); b.st = st;
    if (threadIdx.x == 0) (void)xb_add(&bar[XB_XCNT(b.x)], 1u);
    return b;
}
__device__ __forceinline__ void xcd_barrier_complete(unsigned* bar, unsigned x, unsigned& nloc, unsigned& nx) {
    const unsigned G = gridDim.x * gridDim.y * gridDim.z;
    unsigned sum, cnt, mine, sp = 0u;
    for (;;) {
        sum = 0u; cnt = 0u; mine = 0u;
#pragma unroll
        for (unsigned j = 0; j < 16; ++j) { const unsigned c = xb_ld(&bar[XB_XCNT(j)]); sum += c; cnt += (c > 0u) ? 1u : 0u; mine = (j == x) ? c : mine; }
        if (sum == G) break;
        __builtin_amdgcn_s_sleep(1);
        if ((++sp & 255u) == 0u) { if (xb_ld(&bar[XB_TMO])) break; if (sp > XB_SPIN_CAP) { atomicAdd(&bar[XB_TMO], 1u); break; } }
    }
    nloc = mine > 0u ? mine : 1u; nx = cnt > 0u ? cnt : 1u;
}

__device__ __forceinline__ void xcd_barrier(const XcdBarrier& b, int wv) {
    const bool leader_thread = (wv == 0) && (lane_id_() == 0);
    asm volatile("s_waitcnt vmcnt(0)" ::: "memory");
    __syncthreads();
    if (leader_thread) {
        unsigned* bar = b.bar;
        __builtin_amdgcn_s_waitcnt(0);
        unsigned nloc = b.st[0], nx = b.st[1];
        if (nloc == 0u) { xcd_barrier_complete(bar, b.x, nloc, nx); b.st[0] = nloc; b.st[1] = nx; }
        const unsigned old = xb_add(&bar[XB_XSUB(b.x)], 1u);
        const unsigned gen = old / nloc;
        if (old + 1u == (gen + 1u) * nloc) {
            __builtin_amdgcn_fence(__ATOMIC_RELEASE, "agent");
            asm volatile("s_waitcnt vmcnt(0)" ::: "memory");
            const unsigned og = xb_add(&bar[XB_TOP], 1u);
            const unsigned tg = og / nx;
            if (og + 1u == (tg + 1u) * nx) xb_add(&bar[XB_TOPGEN], 1u);
            else XB_SPIN(xb_ld(&bar[XB_TOPGEN]) == tg, bar);
            __builtin_amdgcn_fence(__ATOMIC_ACQUIRE, "agent");
            xb_add(&bar[XB_XGEN(b.x)], 1u);
            asm volatile("s_waitcnt vmcnt(0)" ::: "memory");
        } else {
            XB_SPIN(xb_ld(&bar[XB_XGEN(b.x)]) == gen, bar);
            __builtin_amdgcn_fence(__ATOMIC_ACQUIRE, "agent");
            asm volatile("s_waitcnt vmcnt(0)" ::: "memory");
        }
    }
    __syncthreads();
}

typedef const __attribute__((address_space(4))) unsigned char* ka_t;
__device__ __forceinline__ ka_t ka_() { ka_t k = (ka_t)__builtin_amdgcn_kernarg_segment_ptr(); asm volatile("" : "+s"(k)); return k; }
#define PIN(i) ((const float*)(const __attribute__((address_space(1))) float*)(*(const __attribute__((address_space(4))) unsigned long long*)(ka_() + 8 * (i))))
#define POUT ((float*)(__attribute__((address_space(1))) float*)(*(const __attribute__((address_space(4))) unsigned long long*)(ka_() + 136)))
#define PWS ((unsigned char*)(__attribute__((address_space(1))) unsigned char*)(*(const __attribute__((address_space(4))) unsigned long long*)(ka_() + 144)))
#define BID ((int)blockIdx.x)
#define GSZ ((int)gridDim.x)
__device__ __forceinline__ int srcmap(int mode, int n) {
    if (mode == 0) return n;
    if (mode == 1) return (n >> 8) * 128 + (n & 127) + ((n >> 7) & 1) * 2816;
    if (n < 5400) return n;
    if (n < 5632) return -1;
    if (n < 6656) return 5400 + (n - 5632);
    return 6424 + (n - 6656);
}
__device__ __forceinline__ void conv_item(const float* W, bf16* WT, int K, int Nsrc, int Ndst, int mode, int item, float* scr, int lane) {
    const int nblk = Ndst / 64, kb = item / nblk, nb = item % nblk, k0 = 64 * kb, n0 = 64 * nb;
    const int r = lane >> 4, q = lane & 15;
    const int sc = srcmap(mode, n0 + 4 * q);
    f32x4 v[16];
#pragma unroll
    for (int i = 0; i < 16; ++i) { const int kk = 4 * i + r; v[i] = sc >= 0 ? *(const f32x4*)(W + (size_t)(k0 + kk) * Nsrc + sc) : (f32x4){0.f, 0.f, 0.f, 0.f}; }
#pragma unroll
    for (int i = 0; i < 16; ++i) { const int kk = 4 * i + r; *(f32x4*)(scr + kk * 68 + 4 * (q ^ ((kk >> 3) & 7))) = v[i]; }
    __builtin_amdgcn_s_waitcnt(0xc07f); __builtin_amdgcn_wave_barrier();
    const int c = lane & 7;
#pragma unroll
    for (int j = 0; j < 8; ++j) { const int n = (lane >> 3) + 8 * j; float s[8];
#pragma unroll
        for (int e = 0; e < 8; ++e) s[e] = scr[(8 * c + e) * 68 + 4 * ((n >> 2) ^ c) + (n & 3)];
        v4u o; o.x = pk2(s[0], s[1]); o.y = pk2(s[2], s[3]); o.z = pk2(s[4], s[5]); o.w = pk2(s[6], s[7]);
        *(v4u*)(WT + (size_t)(n0 + n) * K + k0 + 8 * c) = o; }
    __builtin_amdgcn_s_waitcnt(0xc07f); __builtin_amdgcn_wave_barrier();
}
__device__ __forceinline__ void ph_convert(int l, unsigned char* lds, int wv) {
    int tid_ = wv * 64 + lane_id_(); asm volatile("" : "+v"(tid_)); const int lane = tid_ & 63, wave = tid_ >> 6;
    float* scr = (float*)lds + wave * (64 * 68);
    unsigned char* wb = PWS + WS_W;
    constexpr int I_FI = 16 * 88, I_FO = 44 * 16, I_IN = 16 * 120, I_BA = 4 * 16, I_BD = 12 * 16, I_O = 16 * 16;
    constexpr int NIT = 2 * I_FI + 2 * I_FO + I_IN + I_BA + I_BD + I_O;
    for (int it = BID * 8 + wave; it < NIT; it += GSZ * 8) {
        int r = it;
        if (r < 2 * I_FI) { const int f = r / I_FI; conv_item(PIN(7) + ((size_t)l * 2 + f) * 1024 * 5632, (bf16*)(wb + (f ? W_FFIN1 : W_FFIN0)), 1024, 5632, 5632, 1, r % I_FI, scr, lane); continue; } r -= 2 * I_FI;
        if (r < 2 * I_FO) { const int f = r / I_FO; conv_item(PIN(8) + ((size_t)l * 2 + f) * 2816 * 1024, (bf16*)(wb + (f ? W_FFOUT1 : W_FFOUT0)), 2816, 1024, 1024, 0, r % I_FO, scr, lane); continue; } r -= 2 * I_FO;
        if (r < I_IN) { conv_item(PIN(9) + (size_t)l * 1024 * NIN_, (bf16*)(wb + W_IN), 1024, NIN_, NINP_, 2, r, scr, lane); continue; } r -= I_IN;
        if (r < I_BA) { conv_item(PIN(14) + (size_t)l * 256 * 1024, (bf16*)(wb + W_BATT), 256, 1024, 1024, 0, r, scr, lane); continue; } r -= I_BA;
        if (r < I_BD) { conv_item(PIN(15) + (size_t)l * 768 * 1024, (bf16*)(wb + W_BDN), 768, 1024, 1024, 0, r, scr, lane); continue; } r -= I_BD;
        conv_item(PIN(16) + (size_t)l * 1024 * 1024, (bf16*)(wb + W_OUT), 1024, 1024, 1024, 0, r, scr, lane);
    }
}
__device__ __forceinline__ void ph_ada(unsigned char* lds, int wv) {
    float* red = (float*)(lds + 72 * 1024);
    int tid_ = wv * 64 + lane_id_(); asm volatile("" : "+v"(tid_)); const int tid = tid_, lane = tid_ & 63, wave = tid_ >> 6;
    const float* c = PIN(1); const float* w_ada = PIN(3); const float* b_ada = PIN(4); float* mod = (float*)(PWS + WS_MOD);
    for (int u = BID; u < 72; u += GSZ) {
        const int l = u / 36, n0 = (u % 36) * 256;
        const float* W = w_ada + (size_t)l * 1024 * 9216 + (size_t)(wave * 128) * 9216 + n0 + 4 * lane;
        f32x4 acc = {0.f, 0.f, 0.f, 0.f};
#pragma unroll 1
        for (int k0 = 0; k0 < 128; k0 += 16) {
            f32x4 wv4[16];
#pragma unroll
            for (int kk = 0; kk < 16; ++kk) wv4[kk] = *(const f32x4*)(W + (size_t)(k0 + kk) * 9216);
#pragma unroll
            for (int kk = 0; kk < 16; ++kk) { const float cv = c[wave * 128 + k0 + kk]; const float sv = cv / (1.0f + __expf(-cv)); acc += sv * wv4[kk]; }
        }
        *(f32x4*)(red + wave * 256 + 4 * lane) = acc;
        __syncthreads();
        if (tid < 256) { float t = b_ada[l * 9216 + n0 + tid];
#pragma unroll
            for (int w = 0; w < 8; ++w) t += red[w * 256 + tid];
            mod[l * 9216 + n0 + tid] = t; }
        __syncthreads();
    }
}
__device__ const float ROPE_INV[32] = {1.000000000e+00f, 7.498942018e-01f, 5.623413324e-01f, 4.216965139e-01f, 3.162277639e-01f, 2.371373773e-01f, 1.778279394e-01f, 1.333521456e-01f, 1.000000015e-01f, 7.498942316e-02f, 5.623413250e-02f, 4.216964915e-02f, 3.162277490e-02f, 2.371373773e-02f, 1.778279431e-02f, 1.333521400e-02f, 9.999999776e-03f, 7.498942316e-03f, 5.623413250e-03f, 4.216964822e-03f, 3.162277630e-03f, 2.371373819e-03f, 1.778279431e-03f, 1.333521446e-03f, 1.000000047e-03f, 7.498941850e-04f, 5.623413017e-04f, 4.216965172e-04f, 3.162277571e-04f, 2.371373703e-04f, 1.778279402e-04f, 1.333521504e-04f};
__device__ __forceinline__ void ph_rope(int wv) {
    const int* pos = (const int*)PIN(2); float* tab = (float*)(PWS + WS_ROPE);
    int tid_ = wv * 64 + lane_id_(); asm volatile("" : "+v"(tid_));
    for (int idx = BID * NTHREADS + tid_; idx < S_ * 32; idx += GSZ * NTHREADS) {
        const int t = idx >> 5, i = idx & 31;
        const float inv = ROPE_INV[i];
        const float ang = (float)pos[t] * inv;
        float sn, cs; sincosf(ang, &sn, &cs);
        tab[idx] = cs; tab[S_ * 32 + idx] = sn;
    }
}
struct RowArgs { const float* xi32; const bf16* xib; const bf16* y; float* xo32; bf16* xob; bf16* h; const float* wpost; const float* gate; const float* wpre; const float* shift; const float* scale; float coef; };
constexpr int XB_PITCH = 2048;
__device__ __forceinline__ void ph_rows(const RowArgs& a, int wv) {
    int tid_ = wv * 64 + lane_id_(); asm volatile("" : "+v"(tid_)); const int lane = tid_ & 63, wave = tid_ >> 6;
    f32x4 cpost[4], pa[4], pb[4];
#pragma unroll
    for (int j = 0; j < 4; ++j) { cpost[j] = (f32x4){0.f, 0.f, 0.f, 0.f}; pa[j] = cpost[j]; pb[j] = cpost[j]; }
    if (a.y) {
#pragma unroll
        for (int j = 0; j < 4; ++j) { const f32x4 wp = ((const f32x4*)a.wpost)[lane + 64 * j], g = ((const f32x4*)a.gate)[lane + 64 * j]; cpost[j] = a.coef * g * wp; } }
    if (a.h) {
#pragma unroll
        for (int j = 0; j < 4; ++j) { const f32x4 wp = ((const f32x4*)a.wpre)[lane + 64 * j], sc = ((const f32x4*)a.scale)[lane + 64 * j]; pa[j] = wp * (1.0f + sc); pb[j] = ((const f32x4*)a.shift)[lane + 64 * j]; } }
    for (int r = BID * 8 + wave; r < S_; r += GSZ * 8) {
        f32x4 x[4];
        if (a.xi32) {
            const f32x4* xr = (const f32x4*)(a.xi32 + (size_t)r * D_) + lane;
#pragma unroll
            for (int j = 0; j < 4; ++j) x[j] = xr[64 * j];
        } else {
            const v2u* xr = (const v2u*)(a.xib + (size_t)r * XB_PITCH) + lane;
#pragma unroll
            for (int j = 0; j < 4; ++j) { const v2u xw = xr[64 * j]; x[j] = (f32x4){bflo(xw.x), bfhi(xw.x), bflo(xw.y), bfhi(xw.y)}; }
        }
        if (a.y) {
            f32x4 y[4]; float s = 0.f;
            const v2u* yr = (const v2u*)(a.y + (size_t)r * D_) + lane;
#pragma unroll
            for (int j = 0; j < 4; ++j) { const v2u yw = yr[64 * j]; y[j] = (f32x4){bflo(yw.x), bfhi(yw.x), bflo(yw.y), bfhi(yw.y)}; s += (y[j].x * y[j].x + y[j].y * y[j].y) + (y[j].z * y[j].z + y[j].w * y[j].w); }
            const float rs = 1.0f / sqrtf(wave_sum(s) * (1.f / D_) + 1e-6f);
#pragma unroll
            for (int j = 0; j < 4; ++j) x[j] = x[j] + (y[j] * rs) * cpost[j];
            if (a.xo32) {
                f32x4* xw = (f32x4*)(a.xo32 + (size_t)r * D_) + lane;
#pragma unroll
                for (int j = 0; j < 4; ++j) xw[64 * j] = x[j];
            } else {
                v2u* xw = (v2u*)(a.xob + (size_t)r * XB_PITCH) + lane;
#pragma unroll
                for (int j = 0; j < 4; ++j) { v2u w; w.x = pk2(x[j].x, x[j].y); w.y = pk2(x[j].z, x[j].w); xw[64 * j] = w; }
            }
        }
        if (a.h) {
            float s = 0.f;
#pragma unroll
            for (int j = 0; j < 4; ++j) s += (x[j].x * x[j].x + x[j].y * x[j].y) + (x[j].z * x[j].z + x[j].w * x[j].w);
            const float rs = 1.0f / sqrtf(wave_sum(s) * (1.f / D_) + 1e-6f);
            v2u* hw = (v2u*)(a.h + (size_t)r * D_) + lane;
#pragma unroll
            for (int j = 0; j < 4; ++j) { const f32x4 v = (x[j] * rs) * pa[j] + pb[j];
                v2u w; w.x = pk2(v.x, v.y); w.y = pk2(v.z, v.w); hw[64 * j] = w; }
        }
    }
}
constexpr int ATT_PITCH = 68;
__device__ __forceinline__ void ph_attn_v1(const bf16* PA, const float* rope, bf16* OG, float* LSE, unsigned char* lds, int wv) {
    float* qs = (float*)lds; float* ks = qs + 64 * ATT_PITCH; float* vs = ks + 192 * ATT_PITCH;
    int tid_ = wv * 64 + lane_id_(); asm volatile("" : "+v"(tid_)); const int tid = tid_, lane = tid & 63, wave = tid >> 6;
    for (int u = BID; u < 3072; u += GSZ) {
        const int hg = u & 3, w = (u >> 2) & 255, gi = u >> 10;
        const int dil = 1 << (2 * gi), L = S_ / dil, r = w % dil, nb = w / dil, head = gi * 4 + hg;
        __syncthreads();
        for (int rr = wave; rr < 448; rr += 8) {
            int mm, colbase; float* dst; bool rot; float sc = 1.f;
            if (rr < 64) { mm = nb * 64 + rr; colbase = head * 64; dst = qs + rr * ATT_PITCH; rot = true; sc = 0.125f; }
            else if (rr < 256) { mm = nb * 64 - 64 + (rr - 64); colbase = 768 + head * 64; dst = ks + (rr - 64) * ATT_PITCH; rot = true; }
            else { mm = nb * 64 - 64 + (rr - 256); colbase = 1536 + head * 64; dst = vs + (rr - 256) * ATT_PITCH; rot = false; }
            float val = 0.f;
            if (mm >= 0 && mm < L) {
                const int tok = mm * dil + r;
                val = bf2f(PA[(size_t)tok * 2304 + colbase + lane]);
                if (rot) {
                    const float other = __shfl_xor(val, 32);
                    const float cs = rope[tok * 32 + (lane & 31)], sn = rope[S_ * 32 + tok * 32 + (lane & 31)];
                    val = (lane < 32) ? (val * cs - other * sn) : (val * cs + other * sn);
                }
            }
            dst[lane] = val * sc;
        }
        __syncthreads();
        const int i = tid >> 3, part = tid & 7;
        float q[64], acc[64];
#pragma unroll
        for (int d = 0; d < 64; d += 4) { const f32x4 t = *(const f32x4*)(qs + i * ATT_PITCH + d); q[d] = t.x; q[d + 1] = t.y; q[d + 2] = t.z; q[d + 3] = t.w; }
#pragma unroll
        for (int d = 0; d < 64; ++d) acc[d] = 0.f;
        float m = -1e30f, l = 0.f;
        for (int jj = 0; jj < 24; ++jj) {
            const int j = part + 8 * jj, mm = nb * 64 - 64 + j, dj = j - 64 - i;
            const bool ok = (dj <= 64) && (dj >= -64) && (mm >= 0) && (mm < L);
            if (ok) {
                const float* kr = ks + j * ATT_PITCH; float s = 0.f;
#pragma unroll
                for (int d = 0; d < 64; d += 4) { const f32x4 t = *(const f32x4*)(kr + d); s += q[d] * t.x + q[d + 1] * t.y + q[d + 2] * t.z + q[d + 3] * t.w; }
                const float mn = fmaxf(m, s), al = __expf(m - mn), p = __expf(s - mn);
                l = l * al + p; m = mn;
                const float* vr = vs + j * ATT_PITCH;
#pragma unroll
                for (int d = 0; d < 64; d += 4) { const f32x4 t = *(const f32x4*)(vr + d);
                    acc[d] = acc[d] * al + p * t.x; acc[d + 1] = acc[d + 1] * al + p * t.y; acc[d + 2] = acc[d + 2] * al + p * t.z; acc[d + 3] = acc[d + 3] * al + p * t.w; }
            }
        }
        float mt = fmaxf(m, __shfl_xor(m, 1)); mt = fmaxf(mt, __shfl_xor(mt, 2)); mt = fmaxf(mt, __shfl_xor(mt, 4));
        const float f = __expf(m - mt);
        l *= f; l += __shfl_xor(l, 1); l += __shfl_xor(l, 2); l += __shfl_xor(l, 4);
#pragma unroll
        for (int d = 0; d < 64; ++d) acc[d] *= f;
        const bool b2 = part & 4, b1 = part & 2, b0 = part & 1;
        float r32[32], r16[16], r8[8];
#pragma unroll
        for (int d = 0; d < 32; ++d) { const float keep = b2 ? acc[32 + d] : acc[d], send = b2 ? acc[d] : acc[32 + d]; r32[d] = keep + __shfl_xor(send, 4); }
#pragma unroll
        for (int d = 0; d < 16; ++d) { const float keep = b1 ? r32[16 + d] : r32[d], send = b1 ? r32[d] : r32[16 + d]; r16[d] = keep + __shfl_xor(send, 2); }
#pragma unroll
        for (int d = 0; d < 8; ++d) { const float keep = b0 ? r16[8 + d] : r16[d], send = b0 ? r16[d] : r16[8 + d]; r8[d] = keep + __shfl_xor(send, 1); }
        const float il = 1.0f / l;
        const int tok = (nb * 64 + i) * dil + r;
        v4u o; o.x = pk2(r8[0] * il, r8[1] * il); o.y = pk2(r8[2] * il, r8[3] * il); o.z = pk2(r8[4] * il, r8[5] * il); o.w = pk2(r8[6] * il, r8[7] * il);
        *(v4u*)(OG + ((size_t)gi * S_ + tok) * 256 + hg * 64 + part * 8) = o;
        if (part == 0) LSE[((size_t)gi * S_ + tok) * 4 + hg] = mt + logf(l);
    }
}

__device__ __forceinline__ void ph_dnprep(const bf16* PD, const float* AB, const float* convw, const float* a_log, const float* dt_bias, bf16* QKVd, float* GB, const bf16* OG, const float* LSE, bf16* OATT, int wv) {
    int tid_ = wv * 64 + lane_id_(); asm volatile("" : "+v"(tid_)); const int tid = tid_, lane = tid_ & 63, wave = tid_ >> 6;
    for (int it = BID * 8 + wave; it < 1024 * 5; it += GSZ * 8) {
        const int tb = it / 5, sg = it % 5, c0 = sg * 512 + lane * 8, t0 = tb * 16;
        if (c0 < 2304) {
            const int seg = c0 >> 7;
            float cw[5][8];
#pragma unroll
            for (int j = 0; j < 5; ++j) { const f32x4 a = *(const f32x4*)(convw + j * 2304 + c0), b = *(const f32x4*)(convw + j * 2304 + c0 + 4);
                cw[j][0] = a.x; cw[j][1] = a.y; cw[j][2] = a.z; cw[j][3] = a.w; cw[j][4] = b.x; cw[j][5] = b.y; cw[j][6] = b.z; cw[j][7] = b.w; }
            v4u rows[20];
#pragma unroll
            for (int j = 0; j < 20; ++j) { const int tt = t0 + j - 2; rows[j] = (tt >= 0 && tt < S_) ? *(const v4u*)(PD + (size_t)tt * 2304 + c0) : (v4u){0u, 0u, 0u, 0u}; }
#pragma unroll
            for (int i = 0; i < 16; ++i) {
                float a[8];
#pragma unroll
                for (int e = 0; e < 8; ++e) a[e] = 0.f;
#pragma unroll
                for (int j = 0; j < 5; ++j) { const unsigned wx[4] = {rows[i + j].x, rows[i + j].y, rows[i + j].z, rows[i + j].w};
#pragma unroll
                    for (int e = 0; e < 4; ++e) { a[2 * e] += bflo(wx[e]) * cw[j][2 * e]; a[2 * e + 1] += bfhi(wx[e]) * cw[j][2 * e + 1]; } }
                float ss = 0.f;
#pragma unroll
                for (int e = 0; e < 8; ++e) { a[e] = a[e] * __builtin_amdgcn_rcpf(1.0f + __expf(-a[e])); ss += a[e] * a[e]; }
                if (seg < 12) {
                    ss += __shfl_xor(ss, 1); ss += __shfl_xor(ss, 2); ss += __shfl_xor(ss, 4); ss += __shfl_xor(ss, 8);
                    const float sc = (1.0f / sqrtf(ss + 1e-6f)) * (seg < 6 ? 0.08838834764831845f : 1.0f);
#pragma unroll
                    for (int e = 0; e < 8; ++e) a[e] *= sc;
                }
                v4u o; o.x = pk2(a[0], a[1]); o.y = pk2(a[2], a[3]); o.z = pk2(a[4], a[5]); o.w = pk2(a[6], a[7]);
                *(v4u*)(QKVd + (size_t)(t0 + i) * 2304 + c0) = o;
            }
        }
    }
    for (int e = BID * NTHREADS + tid; e < S_ * 12; e += GSZ * NTHREADS) {
        const int t = e / 12, idx = e % 12;
        const float braw = AB[(size_t)t * 32 + idx], araw = AB[(size_t)t * 32 + 12 + idx];
        const float x = araw + dt_bias[idx];
        const float sp = fmaxf(x, 0.f) + log1pf(expf(-fabsf(x)));
        GB[(size_t)idx * S_ + t] = -expf(a_log[idx]) * sp;
        GB[(size_t)(12 + idx) * S_ + t] = 1.0f / (1.0f + expf(-braw));
    }
#pragma unroll 4
    for (int t = BID * 8 + wave; t < S_; t += GSZ * 8) {
        const int ch = 4 * lane, hg = lane >> 4;
        const float l0 = LSE[(size_t)t * 4 + hg], l1 = LSE[((size_t)S_ + t) * 4 + hg], l2 = LSE[((size_t)2 * S_ + t) * 4 + hg];
        const float mx = fmaxf(l0, fmaxf(l1, l2));
        float w0 = expf(l0 - mx), w1 = expf(l1 - mx), w2 = expf(l2 - mx);
        const float inv = 1.0f / (w0 + w1 + w2); w0 *= inv; w1 *= inv; w2 *= inv;
        const v2u a = *(const v2u*)(OG + (size_t)t * 256 + ch), b = *(const v2u*)(OG + ((size_t)S_ + t) * 256 + ch), cc = *(const v2u*)(OG + ((size_t)2 * S_ + t) * 256 + ch);
        v2u o;
        o.x = pk2(w0 * bflo(a.x) + w1 * bflo(b.x) + w2 * bflo(cc.x), w0 * bfhi(a.x) + w1 * bfhi(b.x) + w2 * bfhi(cc.x));
        o.y = pk2(w0 * bflo(a.y) + w1 * bflo(b.y) + w2 * bflo(cc.y), w0 * bfhi(a.y) + w1 * bfhi(b.y) + w2 * bfhi(cc.y));
        *(v2u*)(OATT + (size_t)t * 256 + ch) = o;
    }
}

__device__ __forceinline__ void ph_final(const bf16* ODIR0, const bf16* ODIR1, const bf16* PZ, const float* dnw, bf16* ODN, int wv) {
    int tid_ = wv * 64 + lane_id_(); asm volatile("" : "+v"(tid_)); const int lane = tid_ & 63, wave = tid_ >> 6;
    for (int t = BID * 8 + wave; t < S_; t += GSZ * 8) {
#pragma unroll
        for (int h = 0; h < 6; ++h) {
            const int c = h * 128 + 2 * lane;
            const unsigned wf = *(const unsigned*)(ODIR0 + (size_t)t * 768 + c), wb = *(const unsigned*)(ODIR1 + (size_t)t * 768 + c);
            float o0 = bflo(wf) + bflo(wb), o1 = bfhi(wf) + bfhi(wb);
            const float ms = wave_sum(o0 * o0 + o1 * o1) * (1.0f / 128.0f);
            const float sc = 1.0f / sqrtf(ms + 1e-6f);
            const unsigned zw = *(const unsigned*)(PZ + (size_t)t * 768 + c);
            const f32x2 nw = *(const f32x2*)(dnw + 2 * lane);
            o0 = o0 * sc * nw.x * siluf_(bflo(zw)); o1 = o1 * sc * nw.y * siluf_(bfhi(zw));
            *(unsigned*)(ODN + (size_t)t * 768 + c) = pk2(o0, o1);
        }
    }
}
typedef short bf16x8_t __attribute__((ext_vector_type(8)));
typedef short s16x4_t __attribute__((ext_vector_type(4)));
#define MFMA16(a, b, c) __builtin_amdgcn_mfma_f32_16x16x32_bf16((a), (b), (c), 0, 0, 0)

__device__ __forceinline__ void ph_dn_pre(const bf16* QKVd, const float* GB, bf16* TINV, bf16* ATTN, float* VEC, unsigned char* lds, int wv) {
    int tid_ = wv * 64 + lane_id_(); asm volatile("" : "+v"(tid_));
    const int tid = tid_, lane = tid & 63, g = lane >> 4, m16 = lane & 15, half = wv >> 2, hw = wv & 3, tl = tid & 255;
    float* GR = (float*)(lds + half * 69120); float* Ms = GR + 2 * 64 * 65; float* Gs = Ms + 2 * 64 * 68; float* Bs = Gs + 128;
#define DN_GRAM_CUMSUM(UU) do { const int u_ = (UU), n_ = u_ / 6, h_ = u_ % 6; \
        {     \
            const int kind = hw - 2; \
            bf16x8_t a[4][4]; \
            _Pragma("unroll") for (int mm = 0; mm < 4; ++mm) { const bf16* arow = QKVd + (size_t)(64 * n_ + 16 * mm + m16) * 2304 + (kind ? 0 : 768) + h_ * 128 + 8 * g; \
                _Pragma("unroll") for (int ks = 0; ks < 4; ++ks) a[mm][ks] = *(const bf16x8_t*)(arow + 32 * ks); } \
            _Pragma("unroll") for (int nt = 0; nt < 4; ++nt) { \
                const bf16* brow = QKVd + (size_t)(64 * n_ + 16 * nt + m16) * 2304 + 768 + h_ * 128 + 8 * g; \
                bf16x8_t bfr[4]; \
                _Pragma("unroll") for (int ks = 0; ks < 4; ++ks) bfr[ks] = *(const bf16x8_t*)(brow + 32 * ks); \
                _Pragma("unroll") for (int mm = 0; mm < 4; ++mm) { f32x4 acc = {0.f, 0.f, 0.f, 0.f}; \
                    _Pragma("unroll") for (int ks = 0; ks < 4; ++ks) acc = MFMA16(a[mm][ks], bfr[ks], acc); \
                    _Pragma("unroll") for (int rg = 0; rg < 4; ++rg) GR[kind * 64 * 65 + (16 * mm + 4 * g + rg) * 65 + 16 * nt + m16] = acc[rg]; } } } \
        {     \
            const int d = hw - 2, tok = 64 * n_ + (d ? 63 - lane : lane); \
            float gv = GB[(size_t)(d * 6 + h_) * S_ + tok]; const float be = GB[(size_t)(12 + d * 6 + h_) * S_ + tok]; \
            _Pragma("unroll") for (int o = 1; o < 64; o <<= 1) { const float t = __shfl_up(gv, o); if (lane >= o) gv += t; } \
            const float gl = __shfl(gv, 63); \
            Gs[d * 64 + lane] = gv; Bs[d * 64 + lane] = be; \
            float* vec = VEC + (size_t)(u_ * 2 + d) * 256; \
            vec[lane] = __expf(gv); vec[64 + lane] = be; vec[128 + lane] = __expf(gl - gv); vec[192 + lane] = __expf(gl); } } while (0)
    if (BID < 768 && hw >= 2) DN_GRAM_CUMSUM(2 * BID + half);
    for (int up = BID; up < 768; up += GSZ) {
        const int u = 2 * up + half;
        __syncthreads();
        {
            const int d = tl >> 7, i = (tl & 127) >> 1, jh = tl & 1, ii = d ? 63 - i : i;
            const float Gi = Gs[d * 64 + i], bi = Bs[d * 64 + i];
#pragma unroll
            for (int jb = 0; jb < 2; ++jb) {
                unsigned pk[8];
#pragma unroll
                for (int jj = 0; jj < 16; jj += 2) {
                    float at[2];
#pragma unroll
                    for (int e = 0; e < 2; ++e) {
                        const int j = 32 * jh + 16 * jb + jj + e, jx = d ? 63 - j : j;
                        const float dec = (j <= i) ? __expf(Gi - Gs[d * 64 + j]) : 0.f;
                        const float kk = GR[ii * 65 + jx], qk = GR[64 * 65 + ii * 65 + jx];
                        Ms[d * 64 * 68 + i * 68 + j] = (j < i) ? bi * kk * dec : 0.f;
                        at[e] = (j <= i) ? qk * dec : 0.f;
                    }
                    pk[jj >> 1] = pk2(at[0], at[1]);
                }
                v4u* dst = (v4u*)(ATTN + ((size_t)(u * 2 + d) * 64 + i) * 64 + 32 * jh + 16 * jb);
                v4u o0; o0.x = pk[0]; o0.y = pk[1]; o0.z = pk[2]; o0.w = pk[3]; v4u o1; o1.x = pk[4]; o1.y = pk[5]; o1.z = pk[6]; o1.w = pk[7];
                dst[0] = o0; dst[1] = o1;
            }
        }
        __syncthreads();
        if (hw >= 2) { if (up + GSZ < 768) DN_GRAM_CUMSUM(2 * (up + GSZ) + half); }
        else {
            const int d = hw, c = lane; const float* Md = Ms + d * 64 * 68;
            float x[64];
            x[0] = (c == 0) ? 1.f : 0.f;
#pragma unroll
            for (int i = 1; i < 64; ++i) {
                f32x4 mr[16];
#pragma unroll
                for (int j0 = 0; j0 < i; j0 += 4) mr[j0 >> 2] = *(const f32x4*)(Md + i * 68 + j0);
                float s0 = (i == c) ? 1.f : 0.f, s1 = 0.f, s2 = 0.f, s3 = 0.f;
#pragma unroll
                for (int j0 = 0; j0 < i; j0 += 4) { const f32x4 mv = mr[j0 >> 2];
                    s0 -= mv.x * x[j0]; if (j0 + 1 < i) s1 -= mv.y * x[j0 + 1]; if (j0 + 2 < i) s2 -= mv.z * x[j0 + 2]; if (j0 + 3 < i) s3 -= mv.w * x[j0 + 3]; }
                x[i] = (s0 + s1) + (s2 + s3);
            }
            bf16* outp = TINV + (size_t)(u * 2 + d) * 4096 + c;
#pragma unroll
            for (int i = 0; i < 64; ++i) outp[i * 64] = (bf16)f2bf(x[i]);
        }
    }
}

__device__ __forceinline__ int sw256(int row, int chunk) { return row * 256 + 16 * (chunk ^ (row & 15)); }
__device__ __forceinline__ int sw128(int row, int chunk) { return row * 128 + 16 * (chunk ^ (row & 7)); }
constexpr int SC_NC = 2;
constexpr int SC_KT = 0, SC_QT = 16384, SC_TI = 32768, SC_AT = 40960, SC_VT = 49152, SC_VC = SC_VT + 4096, SC_BUF = SC_VC + 1024;
constexpr int SC_ST = 2 * SC_BUF, SC_RT = SC_ST + 16 * SC_NC * 256, SC_VNT = SC_RT + 16 * SC_NC * 128, SC_VST = SC_VNT + 16 * SC_NC * 128, SC_END = SC_VST + 16 * SC_NC * 128;
constexpr int SC_OT = SC_END + 16;
static_assert(SC_OT + 2 * 64 * 80 <= 146432, "scan LDS (+ a 16-byte dump slot at SC_END, + the o tile)");
constexpr size_t SCS_MAT = 128 * 128;
__device__ __forceinline__ float* scs_B(float* base, int p, int j) { return base + (size_t)(p * 3 + j) * SCS_MAT; }
__device__ __forceinline__ float* scs_A(float* base, int p, int j) { return base + (size_t)(36 + p * 2 + (j - 1)) * SCS_MAT; }
#if defined(SCT) && SCT == 2
#define SC_DMA_ON(s) ((s) < s_beg + 1)
#else
#define SC_DMA_ON(s) true
#endif
#if defined(SCT) && SCT == 3
#define SC_SKIP2 true
#else
#define SC_SKIP2 false
#endif
#if defined(SCT) && SCT >= 2
#define SC_NOST true
#else
#define SC_NOST false
#endif
#define SCT_ACC ((float*)((unsigned char*)SCS - (WS_W + W_FFIN0) + WS_CTL + 524288))
template <int PASS>
__device__ __forceinline__ void scan_task(int vb, const bf16* QKVd, const bf16* TINV, const bf16* ATTN, const float* VEC, bf16* ODIR0, bf16* ODIR1, float* SCS, LAS unsigned char* lds, int wv) {
    const int xl = vb & 7, slot = vb >> 3;
    int p, j, cs; bool has_out, v_zero;
    if (PASS == 1) {
        if (slot < 24) { const int grp = xl * 3 + (slot >> 3), within = slot & 7; p = grp >> 1; j = 1 + (grp & 1); v_zero = (within >> 2) != 0; cs = within & 3; has_out = false; }
        else { const int s4 = slot - 24; int gi; if (xl < 4) gi = xl * 2 + (s4 >> 2); else { if (s4 >= 4) return; gi = 8 + (xl - 4); } p = gi; j = 0; cs = s4 & 3; has_out = false; v_zero = false; }
    } else {
        if (slot >= 24) return; const int v = xl * 24 + slot;
        const int grp = v >> 2; p = grp >> 2; j = grp & 3; cs = v & 3; has_out = true; v_zero = false;
    }
    const int d = p / 6, h = p % 6;
    int tid_ = wv * 64 + lane_id_(); asm volatile("" : "+v"(tid_));
    const int tid = tid_, lane = tid & 63, g = lane >> 4, m16 = lane & 15;
    bf16* ODIR = d ? ODIR1 : ODIR0;
    const int hw = wv - 2;
    unsigned voff[9];
#pragma unroll
    for (int k_ = 0; k_ < 9; ++k_) { const int pc = hw + 6 * k_; unsigned v_ = 0;
        if (pc < 32) { const int q_ = pc & 15, row_ = 4 * q_ + (lane >> 4), ch_ = (lane & 15) ^ (row_ & 15); v_ = (unsigned)((d ? 63 - row_ : row_) * 4608 + ((pc < 16 ? 768 : 0) + h * 128 + ch_ * 8) * 2); }
        else if (pc < 48) { const int t_ = pc & 7, row_ = 8 * t_ + (lane >> 3), ch_ = (lane & 7) ^ (row_ & 7); v_ = (unsigned)(row_ * 128 + ch_ * 16); }
        else if (pc < 52) { const int row_ = 16 * (pc - 48) + (lane >> 2), ch_ = lane & 3; v_ = (unsigned)((d ? 63 - row_ : row_) * 4608 + (1536 + h * 128 + cs * 32 + ch_ * 8) * 2); }
        else v_ = (unsigned)(lane * 16);
        voff[k_] = v_; }
    const unsigned char* gK = (const unsigned char*)QKVd; const unsigned char* gT = (const unsigned char*)TINV; const unsigned char* gA = (const unsigned char*)ATTN; const unsigned char* gV = (const unsigned char*)VEC;
    const unsigned lds0 = (unsigned)(size_t)lds;
#define SC_GLDS(gsrc, ldst) do { unsigned keep_; asm volatile("s_mov_b32 %0, m0\n\ts_mov_b32 m0, %2\n\ts_nop 0\n\tglobal_load_lds_dwordx4 %1, off\n\ts_mov_b32 m0, %0" : "=&s"(keep_) : "v"(gsrc), "s"(ldst) : "memory"); } while (0)
#define SC_DMA(step, bufsel) do { if (wv >= 2) { const int n_ = d ? 255 - (step) : (step); const size_t cb_ = (size_t)((n_ * 6 + h) * 2 + d); \
        const unsigned char* bK_ = gK + (size_t)n_ * 294912; const unsigned char* bT_ = gT + cb_ * 8192; const unsigned char* bA_ = gA + cb_ * 8192; const unsigned char* bV_ = gV + cb_ * 1024; \
        const unsigned lb_ = lds0 + (bufsel) * SC_BUF; \
        int hw_ = hw; asm volatile("" : "+s"(hw_));        \
        _Pragma("unroll") for (int k_ = 0; k_ < 9; ++k_) { const int pc = hw_ + 6 * k_; const unsigned vo_ = voff[k_]; \
            if (pc < 16) SC_GLDS(bK_ + vo_, (unsigned)__builtin_amdgcn_readfirstlane((int)(lb_ + SC_KT + 1024 * pc))); \
            else if (pc < 32) { if (has_out) SC_GLDS(bK_ + vo_, (unsigned)__builtin_amdgcn_readfirstlane((int)(lb_ + SC_QT + 1024 * (pc - 16)))); } \
            else if (pc < 40) SC_GLDS(bT_ + vo_, (unsigned)__builtin_amdgcn_readfirstlane((int)(lb_ + SC_TI + 1024 * (pc - 32)))); \
            else if (pc < 48) { if (has_out) SC_GLDS(bA_ + vo_, (unsigned)__builtin_amdgcn_readfirstlane((int)(lb_ + SC_AT + 1024 * (pc - 40)))); } \
            else if (pc < 52) { if (!v_zero) SC_GLDS(bK_ + vo_, (unsigned)__builtin_amdgcn_readfirstlane((int)(lb_ + SC_VT + 1024 * (pc - 48)))); } \
            else if (pc == 52) SC_GLDS(bV_ + vo_, (unsigned)__builtin_amdgcn_readfirstlane((int)(lb_ + SC_VC))); } } } while (0)
#define SC_BAR() do { asm volatile("s_waitcnt lgkmcnt(0)" ::: "memory"); __builtin_amdgcn_s_barrier(); asm volatile("" ::: "memory"); } while (0)
#define SC_DRAIN() asm volatile("s_waitcnt vmcnt(0)" ::: "memory")
#define SC_OSTORE(stepo) SC_OSTORE_T(stepo, tid)
#define SC_OSTORE_T(stepo, TIDV) do { if (has_out && wv >= 4 && !SC_NOST) { const int no_ = d ? 255 - (stepo) : (stepo); const int tl_ = (TIDV) - 256, row_ = tl_ >> 2, ch_ = tl_ & 3; \
        const v4u ov_ = *(const LAS v4u*)(lds + SC_OT + ((stepo) & 1) * 5120 + row_ * 80 + ch_ * 16); const int tok_ = 64 * no_ + (d ? 63 - row_ : row_); \
        *(v4u*)(ODIR + (size_t)tok_ * 768 + h * 128 + cs * 32 + ch_ * 8) = ov_; } } while (0)
#define SC_PACK(t0, t1) __builtin_bit_cast(bf16x8_t, (v4u){pk2((t0)[0], (t0)[1]), pk2((t0)[2], (t0)[3]), pk2((t1)[0], (t1)[1]), pk2((t1)[2], (t1)[3])})
#define SC_MROW(rt) (32 * ((rt) >> 1) + 8 * (m16 >> 2) + 4 * ((rt) & 1) + (m16 & 3))
#define SC_GROW(rt) (32 * ((rt) >> 1) + 8 * g + 4 * ((rt) & 1))
#define SC_A256(base, rt, ks) (*(const LAS bf16x8_t*)((base) + sw256(SC_MROW(rt), 4 * (ks) + g)))
#define SC_A128(base, rt, ks) (*(const LAS bf16x8_t*)((base) + sw128(SC_MROW(rt), 4 * (ks) + g)))
#define SC_KTF(kt, ks) ({ const int tr0_ = 32 * (ks) + 8 * g + (m16 >> 2), tc_ = 4 * ((kt) >> 1) + (m16 & 3), tsub_ = 8 * ((kt) & 1); \
        const s16x4_t lo_ = __builtin_amdgcn_ds_read_tr16_b64_v4i16((LAS s16x4_t*)(B + SC_KT + sw256(tr0_, tc_) + tsub_)); \
        const s16x4_t hi_ = __builtin_amdgcn_ds_read_tr16_b64_v4i16((LAS s16x4_t*)(B + SC_KT + sw256(tr0_ + 4, tc_) + tsub_)); \
        (bf16x8_t){lo_[0], lo_[1], lo_[2], lo_[3], hi_[0], hi_[1], hi_[2], hi_[3]}; })
#define SC_STEP(s) do { const int s_ = (s); const int cur = s_ & 1; \
        LAS unsigned char* B = lds + cur * SC_BUF; \
        if (wv >= 2) { \
            if (s_ + 1 < s_end && SC_DMA_ON(s_)) SC_DMA(s_ + 1, cur ^ 1); \
            if (s_ > s_beg) SC_OSTORE(s_ - 1); \
            SC_DRAIN(); \
        } else { \
              \
            const LAS float* VC = (const LAS float*)(B + SC_VC); \
            bf16x8_t sbf[4]; \
            _Pragma("unroll") for (int ks = 0; ks < 4; ++ks) sbf[ks] = SC_PACK(Sreg[2 * ks], Sreg[2 * ks + 1]); \
            bf16x8_t fa[16]; f32x4 eG4[4], be4[4]; s16x4_t vt[4]; \
            _Pragma("unroll") for (int rt = 0; rt < 4; ++rt) _Pragma("unroll") for (int ks = 0; ks < 4; ++ks) fa[4 * rt + ks] = SC_A256(B + SC_KT, rt, ks); \
            __builtin_amdgcn_sched_barrier(0); \
            f32x4 acck[4], accq[4]; \
            _Pragma("unroll") for (int rt = 0; rt < 4; ++rt) { acck[rt] = (f32x4){0.f, 0.f, 0.f, 0.f}; accq[rt] = acck[rt]; } \
            _Pragma("unroll") for (int ks = 0; ks < 4; ++ks) _Pragma("unroll") for (int rt = 0; rt < 4; ++rt) acck[rt] = MFMA16(fa[4 * rt + ks], sbf[ks], acck[rt]); \
            __builtin_amdgcn_sched_barrier(0); \
            bf16x8_t fq[16], ft[6]; \
            _Pragma("unroll") for (int rt = 0; rt < 4; ++rt) { eG4[rt] = *(const LAS f32x4*)(VC + SC_GROW(rt)); be4[rt] = *(const LAS f32x4*)(VC + 64 + SC_GROW(rt)); \
                vt[rt] = (s16x4_t){0, 0, 0, 0}; \
                if (!v_zero) vt[rt] = __builtin_amdgcn_ds_read_tr16_b64_v4i16((LAS s16x4_t*)(B + SC_VT + (SC_GROW(rt) + (m16 >> 2)) * 64 + (16 * wv + 4 * (m16 & 3)) * 2)); } \
            if (has_out) { _Pragma("unroll") for (int rt = 0; rt < 2; ++rt) _Pragma("unroll") for (int ks = 0; ks < 4; ++ks) fq[4 * rt + ks] = SC_A256(B + SC_QT, rt, ks); } \
            _Pragma("unroll") for (int rt = 0; rt < 4; ++rt) ft[rt] = SC_A128(B + SC_TI, rt, 0); \
            ft[4] = SC_A128(B + SC_TI, 2, 1); ft[5] = SC_A128(B + SC_TI, 3, 1); \
            __builtin_amdgcn_sched_barrier(0); \
            f32x4 rr[4]; \
            _Pragma("unroll") for (int rt = 0; rt < 4; ++rt) _Pragma("unroll") for (int rg = 0; rg < 4; ++rg) rr[rt][rg] = be4[rt][rg] * (bf2f((unsigned short)vt[rt][rg]) - eG4[rt][rg] * acck[rt][rg]); \
            const bf16x8_t rb0 = SC_PACK(rr[0], rr[1]), rb1 = SC_PACK(rr[2], rr[3]); \
            if (has_out) { _Pragma("unroll") for (int ks = 0; ks < 4; ++ks) _Pragma("unroll") for (int rt = 0; rt < 2; ++rt) accq[rt] = MFMA16(fq[4 * rt + ks], sbf[ks], accq[rt]); } \
            __builtin_amdgcn_sched_barrier(0); \
            if (has_out) { _Pragma("unroll") for (int rt = 2; rt < 4; ++rt) _Pragma("unroll") for (int ks = 0; ks < 4; ++ks) fq[4 * rt + ks] = SC_A256(B + SC_QT, rt, ks); } \
            __builtin_amdgcn_sched_barrier(0); \
            f32x4 vn[4]; \
            _Pragma("unroll") for (int rt = 0; rt < 4; ++rt) vn[rt] = MFMA16(ft[rt], rb0, ((f32x4){0.f, 0.f, 0.f, 0.f})); \
            vn[2] = MFMA16(ft[4], rb1, vn[2]); vn[3] = MFMA16(ft[5], rb1, vn[3]); \
            if (has_out) { _Pragma("unroll") for (int ks = 0; ks < 4; ++ks) _Pragma("unroll") for (int rt = 2; rt < 4; ++rt) accq[rt] = MFMA16(fq[4 * rt + ks], sbf[ks], accq[rt]); } \
            __builtin_amdgcn_sched_barrier(0); \
            bf16x8_t fat[6], fk[16]; f32x4 eL4[4]; \
            if (has_out) { _Pragma("unroll") for (int rt = 0; rt < 4; ++rt) fat[rt] = SC_A128(B + SC_AT, rt, 0); \
                fat[4] = SC_A128(B + SC_AT, 2, 1); fat[5] = SC_A128(B + SC_AT, 3, 1); } \
            _Pragma("unroll") for (int kt = 0; kt < 4; ++kt) _Pragma("unroll") for (int ks = 0; ks < 2; ++ks) fk[2 * kt + ks] = SC_KTF(kt, ks); \
            _Pragma("unroll") for (int rt = 0; rt < 4; ++rt) eL4[rt] = *(const LAS f32x4*)(VC + 128 + SC_GROW(rt)); \
            const float gl = VC[192]; \
            __builtin_amdgcn_sched_barrier(0); \
            if (has_out) { _Pragma("unroll") for (int rt = 0; rt < 4; ++rt) _Pragma("unroll") for (int rg = 0; rg < 4; ++rg) accq[rt][rg] *= eG4[rt][rg]; \
                const bf16x8_t nb0 = SC_PACK(vn[0], vn[1]), nb1 = SC_PACK(vn[2], vn[3]); \
                _Pragma("unroll") for (int rt = 0; rt < 4; ++rt) accq[rt] = MFMA16(fat[rt], nb0, accq[rt]); \
                accq[2] = MFMA16(fat[4], nb1, accq[2]); accq[3] = MFMA16(fat[5], nb1, accq[3]); } \
            _Pragma("unroll") for (int rt = 0; rt < 4; ++rt) _Pragma("unroll") for (int rg = 0; rg < 4; ++rg) vn[rt][rg] *= eL4[rt][rg]; \
            const bf16x8_t vb0 = SC_PACK(vn[0], vn[1]), vb1 = SC_PACK(vn[2], vn[3]); \
            __builtin_amdgcn_sched_barrier(0); \
            _Pragma("unroll") for (int kt = 4; kt < 8; ++kt) _Pragma("unroll") for (int ks = 0; ks < 2; ++ks) fk[2 * kt + ks] = SC_KTF(kt, ks); \
            __builtin_amdgcn_sched_barrier(0); \
            f32x4 acc3[8]; \
            _Pragma("unroll") for (int kt = 0; kt < 4; ++kt) acc3[kt] = MFMA16(fk[2 * kt], vb0, ((f32x4){0.f, 0.f, 0.f, 0.f})); \
            _Pragma("unroll") for (int kt = 0; kt < 4; ++kt) acc3[kt] = MFMA16(fk[2 * kt + 1], vb1, acc3[kt]); \
            if (has_out) { _Pragma("unroll") for (int rt = 0; rt < 4; ++rt) _Pragma("unroll") for (int rg = 0; rg < 4; ++rg) \
                *(LAS unsigned short*)(lds + SC_OT + cur * 5120 + (SC_GROW(rt) + rg) * 80 + (16 * wv + m16) * 2) = (unsigned short)f2bf(accq[rt][rg]); } \
            _Pragma("unroll") for (int kt = 0; kt < 4; ++kt) _Pragma("unroll") for (int rg = 0; rg < 4; ++rg) Sreg[kt][rg] = gl * Sreg[kt][rg] + acc3[kt][rg]; \
            _Pragma("unroll") for (int kt = 4; kt < 8; ++kt) acc3[kt] = MFMA16(fk[2 * kt], vb0, ((f32x4){0.f, 0.f, 0.f, 0.f})); \
            _Pragma("unroll") for (int kt = 4; kt < 8; ++kt) acc3[kt] = MFMA16(fk[2 * kt + 1], vb1, acc3[kt]); \
            _Pragma("unroll") for (int kt = 4; kt < 8; ++kt) _Pragma("unroll") for (int rg = 0; rg < 4; ++rg) Sreg[kt][rg] = gl * Sreg[kt][rg] + acc3[kt][rg]; \
        } \
        SC_BAR(); } while (0)
    const int s_beg = 64 * j, s_end = s_beg + 64;
    SC_DMA(s_beg, s_beg & 1);
    f32x4 Sreg[8];
#pragma unroll
    for (int kt = 0; kt < 8; ++kt) Sreg[kt] = (f32x4){0.f, 0.f, 0.f, 0.f};
    const int scol = 16 * (wv & 1) + m16;
    if (PASS == 1) {
        if (v_zero) {
#pragma unroll
            for (int kt = 0; kt < 8; ++kt)
#pragma unroll
                for (int rg = 0; rg < 4; ++rg) Sreg[kt][rg] = (SC_GROW(kt) + rg == 32 * cs + scol) ? 1.f : 0.f;
        }
    } else {
        LAS float* blk0 = (LAS float*)(lds + SC_ST); LAS float* blk1 = blk0 + 128 * 33;
        blk0 = (LAS float*)(lds + SC_BUF); blk1 = blk0 + 128 * 33;
        const int a = tid >> 2, cq = tid & 3;
        float accv[8];
        { const float* bp = scs_B(SCS, p, 0) + (size_t)a * 128 + 32 * cs + 8 * cq; const f32x4 x0 = *(const f32x4*)bp, x1 = *(const f32x4*)(bp + 4);
          accv[0] = x0.x; accv[1] = x0.y; accv[2] = x0.z; accv[3] = x0.w; accv[4] = x1.x; accv[5] = x1.y; accv[6] = x1.z; accv[7] = x1.w; }
        if (j == 0) {
#pragma unroll
            for (int e = 0; e < 8; ++e) accv[e] = 0.f; }
#pragma unroll 1
        for (int jj = 1; jj < j; ++jj) {
            LAS float* src = (jj & 1) ? blk0 : blk1;
#pragma unroll
            for (int e = 0; e < 8; ++e) src[a * 33 + 8 * cq + e] = accv[e];
            __syncthreads();
            { const float* bp = scs_B(SCS, p, jj) + (size_t)a * 128 + 32 * cs + 8 * cq; const f32x4 x0 = *(const f32x4*)bp, x1 = *(const f32x4*)(bp + 4);
              accv[0] = x0.x; accv[1] = x0.y; accv[2] = x0.z; accv[3] = x0.w; accv[4] = x1.x; accv[5] = x1.y; accv[6] = x1.z; accv[7] = x1.w; }
            const float* ar = scs_A(SCS, p, jj) + (size_t)a * 128;
#pragma unroll 4
            for (int b4 = 0; b4 < 128; b4 += 4) { const f32x4 av = *(const f32x4*)(ar + b4);
#pragma unroll
                for (int e = 0; e < 8; ++e) accv[e] += av.x * src[(b4 + 0) * 33 + 8 * cq + e] + av.y * src[(b4 + 1) * 33 + 8 * cq + e] + av.z * src[(b4 + 2) * 33 + 8 * cq + e] + av.w * src[(b4 + 3) * 33 + 8 * cq + e]; }
        }
        LAS float* fin = (j & 1) ? blk0 : blk1;
        __syncthreads();
#pragma unroll
        for (int e = 0; e < 8; ++e) fin[a * 33 + 8 * cq + e] = accv[e];
        __syncthreads();
#pragma unroll
        for (int kt = 0; kt < 8; ++kt)
#pragma unroll
            for (int rg = 0; rg < 4; ++rg) Sreg[kt][rg] = fin[(SC_GROW(kt) + rg) * 33 + scol];
        __syncthreads();
    }
    SC_DRAIN();
    __syncthreads();
#if defined(SCT) && SCT != 0
    const unsigned long long tq0_ = __builtin_amdgcn_s_memtime();
#endif
#pragma unroll 1
    for (int s2 = s_beg; s2 < s_end; ++s2) SC_STEP(s2);
#if defined(SCT) && SCT != 0
    if (PASS == 2 && tid == 0) { const unsigned long long tq1_ = __builtin_amdgcn_s_memtime(); atomicAdd(SCT_ACC, (float)(tq1_ - tq0_) * (1.f / (64.f * 384.f))); }
#endif
    { int tid2_ = tid; asm volatile("" : "+v"(tid2_)); SC_OSTORE_T(s_end - 1, tid2_); }
    if (PASS == 1) {
        float* dst = (v_zero ? scs_A(SCS, p, j) : scs_B(SCS, p, j));
        if (j < 3 && !SC_NOST) {
            if (wv < 2) {
#pragma unroll
                for (int kt = 0; kt < 8; ++kt)
#pragma unroll
                    for (int rg = 0; rg < 4; ++rg) dst[(size_t)(SC_GROW(kt) + rg) * 128 + 32 * cs + scol] = Sreg[kt][rg];
            }
        }
    }
    asm volatile("s_waitcnt vmcnt(0)" ::: "memory");
#undef SC_STEP
#undef SC_OSTORE
#undef SC_OSTORE_T
#undef SC_DRAIN
#undef SC_BAR
#undef SC_DMA
#undef SC_PACK
#undef SC_MROW
#undef SC_GROW
#undef SC_KTF
#undef SC_A256
#undef SC_A128
#undef SC_GLDS
}
template <int PASS>
__device__ __forceinline__ void ph_dn_scan(const bf16* QKVd, const bf16* TINV, const bf16* ATTN, const float* VEC, bf16* ODIR0, bf16* ODIR1, float* SCS, LAS unsigned char* lds, int wv) {
#pragma unroll 1
    for (int vb = BID; vb < 256; vb += GSZ) {
        scan_task<PASS>(vb, QKVd, TINV, ATTN, VEC, ODIR0, ODIR1, SCS, lds, wv);
        __syncthreads();
    }
}
constexpr int AT_PITCH = 144, AT_K = 0, AT_V = 192 * AT_PITCH, AT_GRP = 2 * 192 * AT_PITCH;
__device__ __forceinline__ void ph_attn(const bf16* PA, const float* rope, bf16* OG, float* LSE, LAS unsigned char* lds, int wv) {
    int tid_ = wv * 64 + lane_id_(); asm volatile("" : "+v"(tid_));
    const int tid = tid_, lane = tid & 63, g = lane >> 4, m16 = lane & 15, grp = wv >> 2, wq = wv & 3, tg = tid & 255;
    LAS unsigned char* Kl = lds + grp * AT_GRP + AT_K; LAS unsigned char* Vl = lds + grp * AT_GRP + AT_V;
#pragma unroll 1
    for (int pi = BID; pi < 1536; pi += GSZ) {
        const int u = 2 * pi + grp;
        const int hg = u & 3, w = (u >> 2) & 255, gi = u >> 10;
        const int dil = 1 << (2 * gi), L = S_ / dil, r = w & (dil - 1), nb = w >> (2 * gi), head = gi * 4 + hg;
#pragma unroll
        for (int k = 0; k < 3; ++k) {
            const int item = tg + 256 * k, row = item >> 2, c = item & 3, mm = nb * 64 - 64 + row;
            v4u o0 = {0u, 0u, 0u, 0u}, o1 = {0u, 0u, 0u, 0u};
            if (mm >= 0 && mm < L) {
                const int tok = mm * dil + r;
                const bf16* kp = PA + (size_t)tok * 2304 + 768 + head * 64 + 8 * c;
                const v4u x0 = *(const v4u*)kp, x1 = *(const v4u*)(kp + 32);
                const f32x4* cp = (const f32x4*)(rope + (size_t)tok * 32 + 8 * c); const f32x4* sp = (const f32x4*)(rope + (size_t)S_ * 32 + (size_t)tok * 32 + 8 * c);
                const f32x4 c0 = cp[0], c1 = cp[1], s0 = sp[0], s1 = sp[1];
                const float cs[8] = {c0.x, c0.y, c0.z, c0.w, c1.x, c1.y, c1.z, c1.w}, sn[8] = {s0.x, s0.y, s0.z, s0.w, s1.x, s1.y, s1.z, s1.w};
                const unsigned xa[4] = {x0.x, x0.y, x0.z, x0.w}, xb[4] = {x1.x, x1.y, x1.z, x1.w};
                unsigned ra[4], rb[4];
#pragma unroll
                for (int e = 0; e < 4; ++e) {
                    const float a0 = bflo(xa[e]), a1 = bfhi(xa[e]), b0 = bflo(xb[e]), b1 = bfhi(xb[e]);
                    ra[e] = pk2(a0 * cs[2 * e] - b0 * sn[2 * e], a1 * cs[2 * e + 1] - b1 * sn[2 * e + 1]);
                    rb[e] = pk2(b0 * cs[2 * e] + a0 * sn[2 * e], b1 * cs[2 * e + 1] + a1 * sn[2 * e + 1]);
                }
                o0.x = ra[0]; o0.y = ra[1]; o0.z = ra[2]; o0.w = ra[3]; o1.x = rb[0]; o1.y = rb[1]; o1.z = rb[2]; o1.w = rb[3];
            }
            *(LAS v4u*)(Kl + row * AT_PITCH + 16 * c) = o0; *(LAS v4u*)(Kl + row * AT_PITCH + 64 + 16 * c) = o1;
        }
#pragma unroll
        for (int k = 0; k < 6; ++k) {
            const int item = tg + 256 * k, row = item >> 3, c = item & 7, mm = nb * 64 - 64 + row;
            v4u o = {0u, 0u, 0u, 0u};
            if (mm >= 0 && mm < L) o = *(const v4u*)(PA + (size_t)(mm * dil + r) * 2304 + 1536 + head * 64 + 8 * c);
            *(LAS v4u*)(Vl + row * AT_PITCH + 16 * c) = o;
        }
        bf16x8_t bq0, bq1;
        const int qi = 16 * wq + m16, qtok = (nb * 64 + qi) * dil + r;
        {
            const bf16* qp = PA + (size_t)qtok * 2304 + head * 64 + 8 * g;
            const v4u x0 = *(const v4u*)qp, x1 = *(const v4u*)(qp + 32);
            const f32x4* cp = (const f32x4*)(rope + (size_t)qtok * 32 + 8 * g); const f32x4* sp = (const f32x4*)(rope + (size_t)S_ * 32 + (size_t)qtok * 32 + 8 * g);
            const f32x4 c0 = cp[0], c1 = cp[1], s0 = sp[0], s1 = sp[1];
            const float cs[8] = {c0.x, c0.y, c0.z, c0.w, c1.x, c1.y, c1.z, c1.w}, sn[8] = {s0.x, s0.y, s0.z, s0.w, s1.x, s1.y, s1.z, s1.w};
            const unsigned xa[4] = {x0.x, x0.y, x0.z, x0.w}, xb[4] = {x1.x, x1.y, x1.z, x1.w};
            v4u ra, rb; unsigned* rap = (unsigned*)&ra; unsigned* rbp = (unsigned*)&rb; (void)rap; (void)rbp;
            unsigned ta[4], tb[4];
#pragma unroll
            for (int e = 0; e < 4; ++e) {
                const float a0 = bflo(xa[e]), a1 = bfhi(xa[e]), b0 = bflo(xb[e]), b1 = bfhi(xb[e]);
                ta[e] = pk2(0.125f * (a0 * cs[2 * e] - b0 * sn[2 * e]), 0.125f * (a1 * cs[2 * e + 1] - b1 * sn[2 * e + 1]));
                tb[e] = pk2(0.125f * (b0 * cs[2 * e] + a0 * sn[2 * e]), 0.125f * (b1 * cs[2 * e + 1] + a1 * sn[2 * e + 1]));
            }
            ra.x = ta[0]; ra.y = ta[1]; ra.z = ta[2]; ra.w = ta[3]; rb.x = tb[0]; rb.y = tb[1]; rb.z = tb[2]; rb.w = tb[3];
            bq0 = __builtin_bit_cast(bf16x8_t, ra); bq1 = __builtin_bit_cast(bf16x8_t, rb);
        }
        __syncthreads();
        f32x4 st[12];
#pragma unroll
        for (int kt = 0; kt < 12; ++kt) {
            const LAS unsigned char* ap = Kl + (16 * kt + m16) * AT_PITCH + 16 * g;
            f32x4 z = {0.f, 0.f, 0.f, 0.f};
            z = MFMA16(*(const LAS bf16x8_t*)ap, bq0, z);
            st[kt] = MFMA16(*(const LAS bf16x8_t*)(ap + 64), bq1, z);
        }
        float mx = -1e30f;
#pragma unroll
        for (int kt = 0; kt < 12; ++kt)
#pragma unroll
            for (int rg = 0; rg < 4; ++rg) { const int j = 16 * kt + 4 * g + rg, dj = j - qi, mm = nb * 64 - 64 + j;
                const bool ok = (dj >= 0) && (dj <= 128) && (mm >= 0) && (mm < L);
                st[kt][rg] = ok ? st[kt][rg] : -1e30f; mx = fmaxf(mx, st[kt][rg]); }
        mx = fmaxf(mx, __shfl_xor(mx, 16)); mx = fmaxf(mx, __shfl_xor(mx, 32));
        float sum = 0.f;
#pragma unroll
        for (int kt = 0; kt < 12; ++kt)
#pragma unroll
            for (int rg = 0; rg < 4; ++rg) { const float p = __expf(st[kt][rg] - mx); st[kt][rg] = p; sum += p; }
        sum += __shfl_xor(sum, 16); sum += __shfl_xor(sum, 32);
        f32x4 o[4];
#pragma unroll
        for (int dt = 0; dt < 4; ++dt) o[dt] = (f32x4){0.f, 0.f, 0.f, 0.f};
#pragma unroll
        for (int kk = 0; kk < 6; ++kk) {
            v4u pb; pb.x = pk2(st[2 * kk][0], st[2 * kk][1]); pb.y = pk2(st[2 * kk][2], st[2 * kk][3]); pb.z = pk2(st[2 * kk + 1][0], st[2 * kk + 1][1]); pb.w = pk2(st[2 * kk + 1][2], st[2 * kk + 1][3]);
            const bf16x8_t b = __builtin_bit_cast(bf16x8_t, pb);
#pragma unroll
            for (int dt = 0; dt < 4; ++dt) {
                const LAS unsigned char* tp = Vl + (32 * kk + 4 * g + (m16 >> 2)) * AT_PITCH + (16 * dt + 4 * (m16 & 3)) * 2;
                const s16x4_t lo = __builtin_amdgcn_ds_read_tr16_b64_v4i16((LAS s16x4_t*)tp);
                const s16x4_t hi = __builtin_amdgcn_ds_read_tr16_b64_v4i16((LAS s16x4_t*)(tp + 16 * AT_PITCH));
                const bf16x8_t a = {lo[0], lo[1], lo[2], lo[3], hi[0], hi[1], hi[2], hi[3]};
                o[dt] = MFMA16(a, b, o[dt]);
            }
        }
        const float il = 1.0f / sum;
        bf16* op = OG + ((size_t)gi * S_ + qtok) * 256 + hg * 64 + 4 * g;
#pragma unroll
        for (int dt = 0; dt < 4; ++dt) { v2u wv2; wv2.x = pk2(o[dt][0] * il, o[dt][1] * il); wv2.y = pk2(o[dt][2] * il, o[dt][3] * il); *(v2u*)(op + 16 * dt) = wv2; }
        if (g == 0) LSE[((size_t)gi * S_ + qtok) * 4 + hg] = mx + logf(sum);
        __syncthreads();
    }
}
constexpr int LDS_RING = 146432, LDS_CTL_OFF = LDS_RING, LDS_BYTES = 147456;
constexpr int CW_BAR = 4096;
#ifndef PROBE_ID
#define PROBE_ID (-1)
#endif
__device__ __forceinline__ unsigned char* wsp() { return PWS; }
template <class Epi> __device__ __forceinline__ void run_gemm(LAS unsigned char* lds, const bf16* A, const bf16* Bt, int N, int K, const Epi& E, int wv) {
    pg8::Gemm g{A, Bt, S_, N, K, 0};
    pg8::StaticOrder S; S.init(S_, N, GSZ, BID);
    pg8::gemm_phase<Epi, pg8::StaticOrder, true, true>(lds, g, S, E, wv);
}
#define GRID_BAR() do { XcdBarrier b_; b_.bar = (unsigned*)(wsp() + WS_CTL) + CW_BAR; b_.st = (volatile LAS unsigned*)(lds + LDS_CTL_OFF + 320) + 8; b_.x = b_.st[2]; xcd_barrier(b_, wv); } while (0)
#define PHASE(id, ...) do { { constexpr int PROBE_REP = 0; __VA_ARGS__ } if (PROBE_ID == (id)) { GRID_BAR(); { constexpr int PROBE_REP = 1; __VA_ARGS__ } } } while (0)
#define WS_R_PTRS unsigned char* ws = wsp(); unsigned char* R = ws + WS_R; (void)R;

template <int l, int f> __device__ __forceinline__ void ffn_block(LAS unsigned char* lds, unsigned char* lds_raw, int wv) {
    constexpr int s = f * 2;
    PHASE(1, WS_R_PTRS
        pg8::EpiSwiglu E; E.O = (bf16*)(R + R_ACT); E.ldc = FF_; E.pad_ = 0; run_gemm(lds, (const bf16*)(ws + WS_H), (const bf16*)(ws + WS_W + (f ? W_FFIN1 : W_FFIN0)), 2 * FF_, 1024, E, wv); );
    GRID_BAR();
    PHASE(2, WS_R_PTRS
        pg8::EpiBf16P E; E.O = (bf16*)(R + R_Y); E.ldc = 1024; E.pad_ = 0; run_gemm(lds, (const bf16*)(R + R_ACT), (const bf16*)(ws + WS_W + (f ? W_FFOUT1 : W_FFOUT0)), 1024, FF_, E, wv); );
    GRID_BAR();
    {   WS_R_PTRS const float* MOD = (const float*)(ws + WS_MOD); const float* mod = MOD + l * 9216;
        RowArgs a; a.xi32 = (l == 0 && f == 0) ? PIN(0) : nullptr; a.xib = (const bf16*)POUT; a.y = (const bf16*)(R + R_Y); a.xo32 = (l == 1 && f == 1) ? POUT : nullptr; a.xob = (bf16*)POUT; a.wpost = PIN(6) + (l * 3 + s) * 1024; a.gate = mod + (s * 3 + 2) * 1024; a.coef = 0.5f;
        if (f == 0) { a.h = (bf16*)(ws + WS_H); a.wpre = PIN(5) + (l * 3 + 1) * 1024; a.shift = mod + (1 * 3 + 0) * 1024; a.scale = mod + (1 * 3 + 1) * 1024; }
        else if (l == 0) { a.h = (bf16*)(ws + WS_H); a.wpre = PIN(5) + (1 * 3 + 0) * 1024; a.shift = MOD + 9216; a.scale = MOD + 9216 + 1024; }
        else { a.h = nullptr; a.wpre = nullptr; a.shift = nullptr; a.scale = nullptr; }
        ph_rows(a, wv);
        if (f == 1 && l == 0) ph_convert(1, lds_raw, wv); }
    GRID_BAR();
}
template <int l> __device__ __forceinline__ void mixer_block(LAS unsigned char* lds, unsigned char* lds_raw, int wv) {
    PHASE(3, WS_R_PTRS
        pg8::EpiInProj E; E.PA = (bf16*)(R + R_PA); E.PD = (bf16*)(R + R_PD); E.PZ = (bf16*)(R + R_PZ); E.AB = (float*)(R + R_AB);
        run_gemm(lds, (const bf16*)(ws + WS_H), (const bf16*)(ws + WS_W + W_IN), 5632, 1024, E, wv); );
    GRID_BAR();
    PHASE(4, WS_R_PTRS
        ph_attn((const bf16*)(R + R_PA), (const float*)(ws + WS_ROPE), (bf16*)(R + R_OG), (float*)(R + R_LSE), lds, wv); );
    GRID_BAR();
    PHASE(5, WS_R_PTRS
        ph_dnprep((const bf16*)(R + R_PD), (const float*)(R + R_AB), PIN(10) + (size_t)l * 5 * 2304, PIN(11) + l * 12, PIN(12) + l * 12, (bf16*)(R + R_QKVD), (float*)(R + R_GB),
                  (const bf16*)(R + R_OG), (const float*)(R + R_LSE), (bf16*)(R + R_OATT), wv); );
    GRID_BAR();
    PHASE(6, WS_R_PTRS
        ph_dn_pre((const bf16*)(R + R_QKVD), (const float*)(R + R_GB), (bf16*)(R + R_TINV), (bf16*)(R + R_ATTN), (float*)(R + R_VEC), lds_raw, wv); );
    GRID_BAR();
    PHASE(7, WS_R_PTRS
        ph_dn_scan<1>((const bf16*)(R + R_QKVD), (const bf16*)(R + R_TINV), (const bf16*)(R + R_ATTN), (const float*)(R + R_VEC), (bf16*)(R + R_ODIR0), (bf16*)(R + R_ODIR1), (float*)(ws + WS_W + W_FFIN0), lds, wv); );
    GRID_BAR();
    PHASE(13, WS_R_PTRS
        ph_dn_scan<2>((const bf16*)(R + R_QKVD), (const bf16*)(R + R_TINV), (const bf16*)(R + R_ATTN), (const float*)(R + R_VEC), (bf16*)(R + R_ODIR0), (bf16*)(R + R_ODIR1), (float*)(ws + WS_W + W_FFIN0), lds, wv); );
    GRID_BAR();
    PHASE(8, WS_R_PTRS
        pg8::EpiBf16P E; E.O = (bf16*)(R + R_PG); E.ldc = 2048; E.pad_ = 0;
        run_gemm(lds, (const bf16*)(ws + WS_H), (const bf16*)(ws + WS_W + W_IN) + (size_t)5632 * 1024, 2048, 1024, E, wv); );
    PHASE(9, WS_R_PTRS
        ph_final((const bf16*)(R + R_ODIR0), (const bf16*)(R + R_ODIR1), (const bf16*)(R + R_PZ), PIN(13) + l * 128, (bf16*)(R + R_ODN), wv); );
    GRID_BAR();
    PHASE(10, { WS_R_PTRS
        pg8::EpiGateF32 E; E.O = (bf16*)(R + R_T1); E.gate = (const bf16*)(R + R_PG); E.ldg = 2048; E.pad_ = 0;
        run_gemm(lds, (const bf16*)(R + R_OATT), (const bf16*)(ws + WS_W + W_BATT), 1024, 256, E, wv); }
        { WS_R_PTRS
        pg8::EpiGateAddBf16 E; E.O = (bf16*)(ws + WS_H); E.T1 = (const bf16*)(R + R_T1); E.gate = (const bf16*)(R + R_PG) + 1024; E.ldg = 2048; E.pad_ = 0;
        run_gemm(lds, (const bf16*)(R + R_ODN), (const bf16*)(ws + WS_W + W_BDN), 1024, 768, E, wv); } );
    GRID_BAR();
    PHASE(11, WS_R_PTRS
        pg8::EpiBf16P E; E.O = (bf16*)(R + R_Y2); E.ldc = 1024; E.pad_ = 0; run_gemm(lds, (const bf16*)(ws + WS_H), (const bf16*)(ws + WS_W + W_OUT), 1024, 1024, E, wv); );
    GRID_BAR();
    {   WS_R_PTRS const float* mod = (const float*)(ws + WS_MOD) + l * 9216;
        RowArgs a; a.xi32 = nullptr; a.xib = (const bf16*)POUT; a.y = (const bf16*)(R + R_Y2); a.xo32 = nullptr; a.xob = (bf16*)POUT; a.h = (bf16*)(ws + WS_H); a.wpost = PIN(6) + (l * 3 + 1) * 1024; a.gate = mod + (1 * 3 + 2) * 1024; a.coef = 1.0f;
        a.wpre = PIN(5) + (l * 3 + 2) * 1024; a.shift = mod + (2 * 3 + 0) * 1024; a.scale = mod + (2 * 3 + 1) * 1024; ph_rows(a, wv); }
    GRID_BAR();
}
__global__ void __launch_bounds__(NTHREADS, 2) mega_fwd(Params P) {
    extern __shared__ __attribute__((aligned(16))) unsigned char lds_raw[];
    LAS unsigned char* lds = (LAS unsigned char*)lds_raw;
    const int wv = __builtin_amdgcn_readfirstlane((int)threadIdx.x >> 6);
    { const int tid0 = threadIdx.x;
      for (int u = tid0; u < (LDS_BYTES - LDS_CTL_OFF) / 4; u += NTHREADS) ((LAS unsigned*)(lds + LDS_CTL_OFF))[u] = 0u;
      __syncthreads();
      XcdBarrier b0 = xcd_barrier_post((unsigned*)(PWS + WS_CTL) + CW_BAR, (volatile LAS unsigned*)(lds + LDS_CTL_OFF + 320) + 8);
      if (tid0 == 0) ((volatile LAS unsigned*)(lds + LDS_CTL_OFF + 320))[10] = b0.x;
      __syncthreads(); }
    PHASE(0, ph_ada(lds_raw, wv); ph_rope(wv); ); PHASE(14, ph_convert(0, lds_raw, wv); );
    GRID_BAR();
    PHASE(12, WS_R_PTRS float* MOD = (float*)(ws + WS_MOD);
      RowArgs a; a.xi32 = PIN(0); a.xib = nullptr; a.y = nullptr; a.xo32 = nullptr; a.xob = nullptr; a.h = (bf16*)(ws + WS_H); a.wpost = nullptr; a.gate = nullptr; a.wpre = PIN(5); a.shift = MOD; a.scale = MOD + 1024; a.coef = 0.f; ph_rows(a, wv); );
    GRID_BAR();
#if PROBE_ID == 99
    for (int rb_ = 0; rb_ < 40; ++rb_) GRID_BAR();
#endif
    ffn_block<0, 0>(lds, lds_raw, wv); mixer_block<0>(lds, lds_raw, wv); ffn_block<0, 1>(lds, lds_raw, wv);
    ffn_block<1, 0>(lds, lds_raw, wv); mixer_block<1>(lds, lds_raw, wv); ffn_block<1, 1>(lds, lds_raw, wv);
#if defined(SCT) && SCT != 0
    if (BID == 0 && threadIdx.x == 0) { float* o = POUT; const float x_ = *(const float*)(PWS + WS_CTL + 524288); o[0] += exp2f(0.25f * rintf(4.0f * log2f(fmaxf(x_, 1.0f)))); }
#endif
}

extern "C" void kernel_launch(void* const* d_in, const int* in_sizes, int n_in, void* d_out, int out_size, void* d_ws, size_t ws_size, hipStream_t stream) {
    static int grid = 0;
    if (grid == 0) {
        if (n_in != 17 || ws_size < WS_END) { fprintf(stderr, "kernel_launch: unexpected n_in %d / ws_size %zu\n", n_in, ws_size); grid = -1; return; }
        int dev = 0, cus = 0, per_cu = 0;
        if (hipGetDevice(&dev) != hipSuccess || hipDeviceGetAttribute(&cus, hipDeviceAttributeMultiprocessorCount, dev) != hipSuccess) { grid = -1; return; }
        if (hipFuncSetAttribute((const void*)mega_fwd, hipFuncAttributeMaxDynamicSharedMemorySize, LDS_BYTES) != hipSuccess) { fprintf(stderr, "kernel_launch: hipFuncSetAttribute failed\n"); grid = -1; return; }
        if (hipOccupancyMaxActiveBlocksPerMultiprocessor(&per_cu, (const void*)mega_fwd, NTHREADS, LDS_BYTES) != hipSuccess || per_cu < 1) { fprintf(stderr, "kernel_launch: occupancy query says %d\n", per_cu); per_cu = 1; }
        (void)hipGetLastError();
        grid = cus;
        if (grid > 256) grid = 256;
    }
    if (grid < 0) return;
    (void)hipMemsetAsync((char*)d_ws + WS_CTL, 0, 1 * MiB, stream);
    Params p{};
    for (int i = 0; i < 17; ++i) p.in[i] = (const float*)d_in[i];
    p.out = (float*)d_out; p.ws = (unsigned char*)d_ws;
    hipLaunchKernelGGL(mega_fwd, dim3(grid), dim3(NTHREADS), LDS_BYTES, stream, p);
}
```
